# Optimizing an MI355X kernel written in HIP

```python
import jax, jax.numpy as jnp
from jax import lax
import numpy as np

D_MODEL = 1024
BATCH = 8
SEQ = 4096
DEPTH = 1

N_META = 16
EPS = 1e-6
NEG = -1e30
M_HEADS = 8
M_DQK = 64
M_DV = 128
M_CHUNK = 64
A_HEADS = 8
A_NOPE = 128
A_ROPE = 64
A_DV = 128
Q_LORA = 256
KV_LORA = 128
ROPE_THETA = 10000.0
Q_BLOCK = 128
N_EXPERTS = 32
TOP_K = 4
D_FF = 1024
SWIGLU_ALPHA = 1.702
SWIGLU_LIMIT = 7.0
MOE_BLOCK = 128
IN_SIZES = (M_HEADS * M_DQK, M_HEADS * M_DQK, M_HEADS * M_DV, M_HEADS * M_DV,
            2 * M_HEADS, 2 * M_HEADS, Q_LORA, KV_LORA, A_ROPE, 2 * D_MODEL)
D_IN = sum(IN_SIZES)
IN_OFFSETS = tuple(int(s) for s in np.cumsum(IN_SIZES)[:-1])

kernel_name = 'hybrid_mlstm_mla_moe_encoder'


def rms_norm(x, g):
    xf = x.astype(jnp.float32)
    y = xf * lax.rsqrt(jnp.mean(xf * xf, axis=-1, keepdims=True) + EPS)
    return (y * g.astype(jnp.float32)).astype(x.dtype)


def rope(x, pos):
    half = x.shape[-1] // 2
    freqs = ROPE_THETA ** (-jnp.arange(half, dtype=jnp.float32) / half)
    ang = pos.astype(jnp.float32)[:, None] * freqs[None, :]
    cos, sin = jnp.cos(ang).astype(x.dtype), jnp.sin(ang).astype(x.dtype)
    x1, x2 = x[..., :half], x[..., half:]
    return jnp.concatenate([x1 * cos - x2 * sin, x1 * sin + x2 * cos], axis=-1)


def mlstm_scan(q, k, v, li, lf):
    B, H, Lp, _ = q.shape
    nc = Lp // M_CHUNK

    def chunks(a):
        a = a.reshape(B, H, nc, M_CHUNK, *a.shape[3:])
        return jnp.moveaxis(a, 2, 0)

    tril = jnp.tril(jnp.ones((M_CHUNK, M_CHUNK), dtype=bool))

    def step(carry, inp):
        C, n, m = carry
        qc, kc, vc, lic, lfc = inp
        b = jnp.cumsum(lfc, axis=-1)
        dmat = jnp.where(tril, b[..., :, None] - b[..., None, :] + lic[..., None, :], NEG)
        m_inter = b + m[..., None]
        m_t = jnp.maximum(m_inter, dmat.max(axis=-1))
        w = jnp.exp(dmat - m_t[..., None]) * jnp.einsum('bhtd,bhsd->bhts', qc, kc)
        s_inter = jnp.exp(m_inter - m_t)
        num = s_inter[..., None] * jnp.einsum('bhtd,bhdv->bhtv', qc, C) + jnp.einsum('bhts,bhsv->bhtv', w, vc)
        den = s_inter * jnp.einsum('bhtd,bhd->bht', qc, n) + w.sum(axis=-1)
        h = num / jnp.maximum(jnp.abs(den), jnp.exp(-m_t))[..., None]
        b_last = b[..., -1]
        g = b_last[..., None] - b + lic
        m_new = jnp.maximum(b_last + m, g.max(axis=-1))
        decay = jnp.exp(b_last + m - m_new)
        wk = jnp.exp(g - m_new[..., None])
        C_new = decay[..., None, None] * C + jnp.einsum('bhs,bhsd,bhsv->bhdv', wk, kc, vc)
        n_new = decay[..., None] * n + jnp.einsum('bhs,bhsd->bhd', wk, kc)
        return (C_new, n_new, m_new), h

    init = (jnp.zeros((B, H, q.shape[-1], v.shape[-1]), jnp.float32),
            jnp.zeros((B, H, q.shape[-1]), jnp.float32),
            jnp.zeros((B, H), jnp.float32))
    _, hs = lax.scan(step, init, (chunks(q), chunks(k), chunks(v), chunks(li), chunks(lf)))
    return jnp.moveaxis(hs, 0, 2).reshape(B, H, Lp, v.shape[-1])


def mlstm_branch(q, k, v, o_pre, i_pre, f_pre, b_i, b_f, g_norm):
    B, L, _ = q.shape
    pad = M_CHUNK - N_META
    Lp = L + pad

    def heads(a, d):
        a = a.astype(jnp.float32).reshape(B, L, M_HEADS, d)
        a = jnp.pad(a, ((0, 0), (pad, 0), (0, 0), (0, 0)))
        return a.transpose(0, 2, 1, 3)

    qh = heads(q, M_DQK) * (M_DQK ** -0.5)
    kh = heads(k, M_DQK)
    vh = heads(v, M_DV)
    valid = (jnp.arange(Lp) >= pad)[None, :, None, None]
    i_all = jnp.pad(i_pre.astype(jnp.float32).reshape(B, L, 2, M_HEADS) + b_i.astype(jnp.float32),
                    ((0, 0), (pad, 0), (0, 0), (0, 0)))
    f_all = jnp.pad(f_pre.astype(jnp.float32).reshape(B, L, 2, M_HEADS) + b_f.astype(jnp.float32),
                    ((0, 0), (pad, 0), (0, 0), (0, 0)))
    li = jnp.where(valid, i_all, NEG).transpose(0, 2, 3, 1)
    lf = jnp.where(valid, jax.nn.log_sigmoid(f_all), 0.0).transpose(0, 2, 3, 1)
    flip = lambda a: jnp.flip(a, axis=2)
    h_fwd = mlstm_scan(qh, kh, vh, li[:, 0], lf[:, 0])
    h_bwd = flip(mlstm_scan(flip(qh), flip(kh), flip(vh), flip(li[:, 1]), flip(lf[:, 1])))
    h = (h_fwd + h_bwd)[:, :, pad:]
    h = rms_norm(h, g_norm[:, None, :])
    h = h.transpose(0, 2, 1, 3).reshape(B, L, M_HEADS * M_DV).astype(q.dtype)
    return h * jax.nn.sigmoid(o_pre.astype(jnp.float32)).astype(q.dtype)


def mla_branch(cq, ckv, k_rope, w_uq, w_ukv, g_q, g_kv, pos):
    B, L, _ = cq.shape
    q = jnp.einsum('blr,rhd->bhld', rms_norm(cq, g_q), w_uq)
    q_nope, q_rope = q[..., :A_NOPE], rope(q[..., A_NOPE:], pos)
    kv = jnp.einsum('blr,rhd->bhld', rms_norm(ckv, g_kv), w_ukv)
    k_nope, v = kv[..., :A_NOPE], kv[..., A_NOPE:]
    k_r = rope(k_rope, pos)
    scale = (A_NOPE + A_ROPE) ** -0.5

    def attend(qn, qr):
        s = jnp.einsum('bhqd,bhkd->bhqk', qn, k_nope) + jnp.einsum('bhqd,bkd->bhqk', qr, k_r)
        p = jax.nn.softmax(s.astype(jnp.float32) * scale, axis=-1).astype(v.dtype)
        return jnp.einsum('bhqk,bhkd->bhqd', p, v)

    out_meta = attend(q_nope[:, :, :N_META], q_rope[:, :, :N_META])
    nb = (L - N_META) // Q_BLOCK

    def blocks(a):
        a = a[:, :, N_META:].reshape(B, A_HEADS, nb, Q_BLOCK, a.shape[-1])
        return jnp.moveaxis(a, 2, 0)

    out_real = lax.map(lambda qs: attend(qs[0], qs[1]), (blocks(q_nope), blocks(q_rope)))
    out_real = jnp.moveaxis(out_real, 0, 2).reshape(B, A_HEADS, L - N_META, A_DV)
    out = jnp.concatenate([out_meta, out_real], axis=2)
    return out.transpose(0, 2, 1, 3).reshape(B, L, A_HEADS * A_DV)


def moe(x, w_router, b_router, w1, b1, w2, b2):
    B, L, D = x.shape
    xt = x.reshape(-1, D)
    T = xt.shape[0]
    logits = (xt @ w_router).astype(jnp.float32) + b_router.astype(jnp.float32)
    top_val, top_idx = lax.top_k(logits, TOP_K)
    gates = jax.nn.softmax(top_val, axis=-1)
    n = T * TOP_K
    flat_e = top_idx.reshape(-1)
    flat_tok = jnp.repeat(jnp.arange(T, dtype=jnp.int32), TOP_K)
    flat_w = gates.reshape(-1)
    order = jnp.argsort(flat_e)
    sorted_e = flat_e[order]
    counts = jnp.bincount(flat_e, length=N_EXPERTS)
    start = jnp.cumsum(counts) - counts
    padded = (counts + MOE_BLOCK - 1) // MOE_BLOCK * MOE_BLOCK
    padded_end = jnp.cumsum(padded)
    padded_start = padded_end - padded
    dest = padded_start[sorted_e] + jnp.arange(n, dtype=jnp.int32) - start[sorted_e]
    nb = -(-n // MOE_BLOCK) + N_EXPERTS
    buf_tok = jnp.full((nb * MOE_BLOCK,), T, jnp.int32).at[dest].set(flat_tok[order])
    buf_w = jnp.zeros((nb * MOE_BLOCK,), jnp.float32).at[dest].set(flat_w[order])
    block_e = jnp.minimum(jnp.searchsorted(padded_end, jnp.arange(nb, dtype=jnp.int32) * MOE_BLOCK, side='right'),
                          N_EXPERTS - 1)
    x_pad = jnp.concatenate([xt, jnp.zeros((1, D), xt.dtype)], axis=0)

    def expert_block(args):
        toks, wts, e = args
        hid = x_pad[toks] @ w1[e] + b1[e]
        glu = jnp.minimum(hid[..., :D_FF], SWIGLU_LIMIT)
        lin = jnp.clip(hid[..., D_FF:], -SWIGLU_LIMIT, SWIGLU_LIMIT)
        act = glu * jax.nn.sigmoid(SWIGLU_ALPHA * glu) * (lin + 1)
        return (act @ w2[e] + b2[e]).astype(jnp.float32) * wts[:, None]

    yb = lax.map(expert_block, (buf_tok.reshape(nb, MOE_BLOCK), buf_w.reshape(nb, MOE_BLOCK), block_e))
    y = jnp.zeros((T + 1, D), jnp.float32).at[buf_tok].add(yb.reshape(-1, D))[:T]
    return y.astype(x.dtype).reshape(B, L, D)


def setup_inputs(seed: int = 0) -> dict:
    key = jax.random.key(seed)
    ks = jax.random.split(key, 22)
    f32 = jnp.float32

    def nrm(k, shape, scale):
        return jax.random.normal(k, shape, f32) * scale

    def gain(k, shape):
        return 1.0 + 0.02 * jax.random.normal(k, shape, f32)

    f_bias = jnp.linspace(3.0, 6.0, M_HEADS, dtype=f32)[None, None, :]
    return {
        'x': nrm(ks[0], (BATCH, SEQ, D_MODEL), 1.0),
        'meta_tokens': nrm(ks[1], (N_META, D_MODEL), 1.0),
        'norm_mix': gain(ks[2], (DEPTH, D_MODEL)),
        'w_in': nrm(ks[3], (DEPTH, D_MODEL, D_IN), D_MODEL ** -0.5),
        'm_b_i': nrm(ks[4], (DEPTH, 2, M_HEADS), 0.1),
        'm_b_f': f_bias + nrm(ks[5], (DEPTH, 2, M_HEADS), 0.1),
        'm_norm': gain(ks[6], (DEPTH, M_HEADS, M_DV)),
        'w_m_proj': nrm(ks[7], (DEPTH, M_HEADS * M_DV, D_MODEL), (M_HEADS * M_DV) ** -0.5),
        'a_w_uq': nrm(ks[8], (DEPTH, Q_LORA, A_HEADS, A_NOPE + A_ROPE), Q_LORA ** -0.5),
        'a_w_ukv': nrm(ks[9], (DEPTH, KV_LORA, A_HEADS, A_NOPE + A_DV), KV_LORA ** -0.5),
        'a_norm_q': gain(ks[10], (DEPTH, Q_LORA)),
        'a_norm_kv': gain(ks[11], (DEPTH, KV_LORA)),
        'w_a_proj': nrm(ks[12], (DEPTH, A_HEADS * A_DV, D_MODEL), (A_HEADS * A_DV) ** -0.5),
        'w_out': nrm(ks[13], (DEPTH, D_MODEL, D_MODEL), D_MODEL ** -0.5),
        'norm_ffn': gain(ks[14], (DEPTH, D_MODEL)),
        'w_router': nrm(ks[15], (DEPTH, D_MODEL, N_EXPERTS), D_MODEL ** -0.5),
        'b_router': nrm(ks[16], (DEPTH, N_EXPERTS), 0.01),
        'w1': nrm(ks[17], (DEPTH, N_EXPERTS, D_MODEL, 2 * D_FF), D_MODEL ** -0.5),
        'b1': nrm(ks[18], (DEPTH, N_EXPERTS, 2 * D_FF), 0.01),
        'w2': nrm(ks[19], (DEPTH, N_EXPERTS, D_FF, D_MODEL), D_FF ** -0.5),
        'b2': nrm(ks[20], (DEPTH, N_EXPERTS, D_MODEL), 0.01),
        'norm_final': gain(ks[21], (D_MODEL,)),
    }


def reference(x, meta_tokens, norm_mix, w_in, m_b_i, m_b_f, m_norm, w_m_proj,
              a_w_uq, a_w_ukv, a_norm_q, a_norm_kv, w_a_proj, w_out,
              norm_ffn, w_router, b_router, w1, b1, w2, b2, norm_final):
    B = x.shape[0]
    meta = jnp.broadcast_to(meta_tokens.astype(x.dtype)[None], (B, N_META, D_MODEL))
    h = jnp.concatenate([meta, x], axis=1)
    pos = jnp.arange(h.shape[1], dtype=jnp.int32)
    for l in range(DEPTH):
        u = rms_norm(h, norm_mix[l])
        z = u @ w_in[l]
        m_q, m_k, m_v, m_o, m_i, m_f, a_cq, a_ckv, a_kr, gate_pre = jnp.split(z, list(IN_OFFSETS), axis=-1)
        y_m = mlstm_branch(m_q, m_k, m_v, m_o, m_i, m_f, m_b_i[l], m_b_f[l], m_norm[l]) @ w_m_proj[l]
        y_a = mla_branch(a_cq, a_ckv, a_kr, a_w_uq[l], a_w_ukv[l], a_norm_q[l], a_norm_kv[l], pos) @ w_a_proj[l]
        gates = jax.nn.sigmoid(gate_pre.astype(jnp.float32)).astype(h.dtype)
        mixed = gates[..., :D_MODEL] * y_m + gates[..., D_MODEL:] * y_a
        h = h + mixed @ w_out[l]
        h = h + moe(rms_norm(h, norm_ffn[l]), w_router[l], b_router[l], w1[l], b1[l], w2[l], b2[l])
    return rms_norm(h, norm_final)[:, N_META:]
```

```cpp
#include <hip/hip_runtime.h>
#include <hip/hip_cooperative_groups.h>
#include <cstdio>
#include <cstdint>

typedef unsigned short bf16_t;
__device__ __forceinline__ float bf2f(bf16_t v) { return __uint_as_float(((unsigned)v) << 16); }
__device__ __forceinline__ bf16_t f2bf(float f) { unsigned u = __float_as_uint(f); return (bf16_t)((u + 0x7fffu + ((u >> 16) & 1u)) >> 16); }

constexpr int NB = 8, SEQ = 4096, NT = NB * SEQ, DM = 1024, NMETA = 16, LTOT = SEQ + NMETA;
constexpr int DIN = 5600;
constexpr int OFF_Q = 0, OFF_K = 512, OFF_V = 1024, OFF_O = 2048, OFF_I = 3072, OFF_F = 3088, OFF_CQ = 3104, OFF_CKV = 3360, OFF_KR = 3488, OFF_G = 3552;
constexpr int KVROWS = 4160;
constexpr int NEXP = 32, DFF = 1024;
constexpr int NSLOT = NT * 4 + NEXP * 256;
constexpr float EPS = 1e-6f;
constexpr int CNT_STRIDE = 16;
constexpr float QSCALE = 0.07216878364870322f * 1.4426950408889634f;

constexpr size_t ws_al(size_t x) { return (x + 255) & ~(size_t)255; }
constexpr size_t WS_BAR = 0;
constexpr size_t WS_CNT = WS_BAR + 16384;
constexpr size_t WS_SLOT_TOK = WS_CNT + ws_al(4096);
constexpr size_t WS_TOPI = WS_SLOT_TOK + ws_al((size_t)NSLOT*4);
constexpr size_t WS_TOPW = WS_TOPI + ws_al((size_t)NT*16);
constexpr size_t WS_RANK = WS_TOPW + ws_al((size_t)NT*16);
constexpr size_t WS_SLOTS = WS_RANK + ws_al((size_t)NT*16);
constexpr size_t WS_UM = WS_SLOTS + ws_al((size_t)NT*16);
constexpr size_t WS_ZM = WS_UM + ws_al((size_t)NMETA*DM*4);
constexpr size_t WS_ROPE = WS_ZM + ws_al((size_t)NMETA*DIN*4);
constexpr size_t WS_RSQ = WS_ROPE + ws_al((size_t)LTOT*64*4);
constexpr size_t WS_GI = WS_RSQ + ws_al((size_t)NT*4);
constexpr size_t WS_GF = WS_GI + ws_al((size_t)NT*64);
constexpr size_t WS_NF = WS_GF + ws_al((size_t)NT*64);
constexpr size_t WS_NB_ = WS_NF + ws_al((size_t)4096*256);
constexpr size_t WS_MF = WS_NB_ + ws_al((size_t)4096*256);
constexpr size_t WS_MB = WS_MF + ws_al((size_t)4096*4);
constexpr size_t WS_Kc = WS_MB + ws_al((size_t)4096*4);
constexpr size_t WS_WinT = WS_Kc + ws_al((size_t)NB*KVROWS*192*2);
constexpr size_t WS_WinT8 = WS_WinT + ws_al((size_t)5632*DM*2);
constexpr size_t WS_W1T = WS_WinT8 + ws_al((size_t)3072*DM);
constexpr size_t WS_W2T = WS_W1T + ws_al((size_t)NEXP*2048*DM*2);
constexpr size_t WS_WmT = WS_W2T + ws_al((size_t)NEXP*DM*DFF*2);
constexpr size_t WS_WoutT = WS_WmT + ws_al((size_t)DM*DM*2);
constexpr size_t WS_WoT = WS_WoutT + ws_al((size_t)DM*DM*2);
constexpr size_t WS_WqT = WS_WoT + ws_al((size_t)DM*DM*2);
constexpr size_t WS_CKV = WS_WqT + ws_al((size_t)1536*256*2);
constexpr size_t WS_KR = WS_CKV + ws_al((size_t)NT*128*4);
constexpr size_t WS_CQb = WS_KR + ws_al((size_t)NT*64*4);
constexpr size_t WS_GATE = WS_CQb + ws_al((size_t)NT*256*2);
constexpr size_t WS_WQF = WS_GATE + ws_al((size_t)NT*2048*2);
constexpr size_t WS_WOF = WS_WQF + ws_al((size_t)256*1536*4);
constexpr size_t WS_U = WS_WOF + ws_al((size_t)1024*1024*4);
constexpr size_t WS_Qm = WS_U + ws_al((size_t)NT*DM*2);
constexpr size_t WS_Km = WS_Qm + ws_al((size_t)NT*512*2);
constexpr size_t WS_Vm = WS_Km + ws_al((size_t)NT*512*2);
constexpr size_t WS_OG = WS_Vm + ws_al((size_t)NT*1024*2);
constexpr size_t WS_QP = WS_OG + ws_al((size_t)NT*1024*2);
constexpr size_t WS_CB = WS_QP + ws_al((size_t)NT*1536*2);
constexpr size_t WS_HM = WS_CB + ws_al((size_t)4096*8192*2);
constexpr size_t WS_OA = WS_HM + ws_al((size_t)NT*DM*2);
constexpr size_t WS_TOTAL = WS_OA + ws_al((size_t)NT*DM*2);
constexpr size_t WS_ACT = WS_U, WS_YB = WS_ACT + ws_al((size_t)NSLOT * DFF * 2), WS_MOE_END = WS_YB + ws_al((size_t)NSLOT * DM * 2);
constexpr size_t WS_U8 = WS_CB;
constexpr size_t WS_CF = WS_U, WS_MIX = WS_Qm, WS_XN2 = WS_HM, WS_CQ = WS_HM;
static_assert(WS_MOE_END <= WS_TOTAL && WS_XN2 >= WS_YB, "MoE overlay layout");
struct Params {
    const float *x, *meta, *norm_mix, *w_in, *m_b_i, *m_b_f, *m_norm, *w_m_proj, *a_w_uq, *a_w_ukv, *a_norm_q, *a_norm_kv, *w_a_proj, *w_out,
        *norm_ffn, *w_router, *b_router, *w1, *b1, *w2, *b2, *norm_final;
    float* out; char* ws;
    __host__ __device__ __forceinline__ int* CNT() const { return (int*)(ws + WS_CNT); }
    __host__ __device__ __forceinline__ unsigned* BAR() const { return (unsigned*)(ws + WS_BAR); }
    __host__ __device__ __forceinline__ unsigned char* WinT8() const { return (unsigned char*)(ws + WS_WinT8); }
    __host__ __device__ __forceinline__ unsigned char* U8() const { return (unsigned char*)(ws + WS_U8); }
    __host__ __device__ __forceinline__ int* SLOT_TOK() const { return (int*)(ws + WS_SLOT_TOK); }
    __host__ __device__ __forceinline__ int* TOPI() const { return (int*)(ws + WS_TOPI); }
    __host__ __device__ __forceinline__ float* TOPW() const { return (float*)(ws + WS_TOPW); }
    __host__ __device__ __forceinline__ int* RANK() const { return (int*)(ws + WS_RANK); }
    __host__ __device__ __forceinline__ int* SLOTS() const { return (int*)(ws + WS_SLOTS); }
    __host__ __device__ __forceinline__ float* UM() const { return (float*)(ws + WS_UM); }
    __host__ __device__ __forceinline__ float* ZM() const { return (float*)(ws + WS_ZM); }
    __host__ __device__ __forceinline__ float* ROPE() const { return (float*)(ws + WS_ROPE); }
    __host__ __device__ __forceinline__ float* RSQ() const { return (float*)(ws + WS_RSQ); }
    __host__ __device__ __forceinline__ float* GI() const { return (float*)(ws + WS_GI); }
    __host__ __device__ __forceinline__ float* GF() const { return (float*)(ws + WS_GF); }
    __host__ __device__ __forceinline__ float* NF() const { return (float*)(ws + WS_NF); }
    __host__ __device__ __forceinline__ float* NB_() const { return (float*)(ws + WS_NB_); }
    __host__ __device__ __forceinline__ float* MF() const { return (float*)(ws + WS_MF); }
    __host__ __device__ __forceinline__ float* MB() const { return (float*)(ws + WS_MB); }
    __host__ __device__ __forceinline__ bf16_t* Kc() const { return (bf16_t*)(ws + WS_Kc); }
    __host__ __device__ __forceinline__ bf16_t* WinT() const { return (bf16_t*)(ws + WS_WinT); }
    __host__ __device__ __forceinline__ bf16_t* W1T() const { return (bf16_t*)(ws + WS_W1T); }
    __host__ __device__ __forceinline__ bf16_t* W2T() const { return (bf16_t*)(ws + WS_W2T); }
    __host__ __device__ __forceinline__ bf16_t* WmT() const { return (bf16_t*)(ws + WS_WmT); }
    __host__ __device__ __forceinline__ bf16_t* WoutT() const { return (bf16_t*)(ws + WS_WoutT); }
    __host__ __device__ __forceinline__ bf16_t* WoT() const { return (bf16_t*)(ws + WS_WoT); }
    __host__ __device__ __forceinline__ bf16_t* WqT() const { return (bf16_t*)(ws + WS_WqT); }
    __host__ __device__ __forceinline__ float* CKV() const { return (float*)(ws + WS_CKV); }
    __host__ __device__ __forceinline__ float* KR() const { return (float*)(ws + WS_KR); }
    __host__ __device__ __forceinline__ bf16_t* CQb() const { return (bf16_t*)(ws + WS_CQb); }
    __host__ __device__ __forceinline__ bf16_t* GATE() const { return (bf16_t*)(ws + WS_GATE); }
    __host__ __device__ __forceinline__ float* WQF() const { return (float*)(ws + WS_WQF); }
    __host__ __device__ __forceinline__ float* WOF() const { return (float*)(ws + WS_WOF); }
    __host__ __device__ __forceinline__ bf16_t* U() const { return (bf16_t*)(ws + WS_U); }
    __host__ __device__ __forceinline__ bf16_t* Qm() const { return (bf16_t*)(ws + WS_Qm); }
    __host__ __device__ __forceinline__ bf16_t* Km() const { return (bf16_t*)(ws + WS_Km); }
    __host__ __device__ __forceinline__ bf16_t* Vm() const { return (bf16_t*)(ws + WS_Vm); }
    __host__ __device__ __forceinline__ bf16_t* OG() const { return (bf16_t*)(ws + WS_OG); }
    __host__ __device__ __forceinline__ bf16_t* QP() const { return (bf16_t*)(ws + WS_QP); }
    __host__ __device__ __forceinline__ bf16_t* CB() const { return (bf16_t*)(ws + WS_CB); }
    __host__ __device__ __forceinline__ bf16_t* HM() const { return (bf16_t*)(ws + WS_HM); }
    __host__ __device__ __forceinline__ bf16_t* OA() const { return (bf16_t*)(ws + WS_OA); }
    __host__ __device__ __forceinline__ bf16_t* ACT() const { return (bf16_t*)(ws + WS_ACT); }
    __host__ __device__ __forceinline__ bf16_t* YB() const { return (bf16_t*)(ws + WS_YB); }
    __host__ __device__ __forceinline__ bf16_t* CF() const { return (bf16_t*)(ws + WS_CF); }
    __host__ __device__ __forceinline__ bf16_t* MIX() const { return (bf16_t*)(ws + WS_MIX); }
    __host__ __device__ __forceinline__ bf16_t* XN2() const { return (bf16_t*)(ws + WS_XN2); }
    __host__ __device__ __forceinline__ float* CQ() const { return (float*)(ws + WS_CQ); }
};

__device__ __forceinline__ float wave_sum(float v) {
#pragma unroll
    for (int o = 1; o < 64; o <<= 1) v += __shfl_xor(v, o);
    return v;
}
__device__ __forceinline__ float sigmoidf_(float v) { return __builtin_amdgcn_rcpf(1.f + __expf(-v)); }
__device__ __forceinline__ float logsigmoidf_(float v) { return fminf(v, 0.f) - __logf(1.f + __expf(-fabsf(v))); }

__global__ void __launch_bounds__(256) k_prep_rows(Params p) {
    const int lane = threadIdx.x & 63, gw = (blockIdx.x * 256 + threadIdx.x) >> 6, ngw = (gridDim.x * 256) >> 6;
    for (int r = gw; r < NT + NMETA; r += ngw) {
        const float* src = r < NT ? p.x + (size_t)r * DM : p.meta + (size_t)(r - NT) * DM;
        float4 v[4]; float ss = 0.f;
#pragma unroll
        for (int j = 0; j < 4; ++j) { v[j] = *(const float4*)(src + (j * 64 + lane) * 4); ss += v[j].x * v[j].x + v[j].y * v[j].y + v[j].z * v[j].z + v[j].w * v[j].w; }
        const float rstd = rsqrtf(wave_sum(ss) * (1.f / DM) + EPS);
#pragma unroll
        for (int j = 0; j < 4; ++j) {
            const int c = (j * 64 + lane) * 4; const float4 g = *(const float4*)(p.norm_mix + c);
            const float a0 = v[j].x * rstd * g.x, a1 = v[j].y * rstd * g.y, a2 = v[j].z * rstd * g.z, a3 = v[j].w * rstd * g.w;
            if (r < NT) { bf16_t* d = p.U() + (size_t)r * DM + c; d[0] = f2bf(a0); d[1] = f2bf(a1); d[2] = f2bf(a2); d[3] = f2bf(a3); }
            else { float* d = p.UM() + (size_t)(r - NT) * DM + c; d[0] = a0; d[1] = a1; d[2] = a2; d[3] = a3; }
        }
    }
}

__global__ void __launch_bounds__(256) k_fold(Params p) {
    const long gid = (long)blockIdx.x * 256 + threadIdx.x, gn = (long)gridDim.x * 256;
    for (long i = gid; i < 256L * 1536; i += gn) {
        const int r = (int)(i / 1536), hc = (int)(i % 1536), h = hc / 192, c = hc % 192;
        const float* uq = p.a_w_uq + ((size_t)r * 8 + h) * 192; float acc;
        if (c >= 128) acc = uq[c];
        else { const float* kv = p.a_w_ukv + ((size_t)c * 8 + h) * 256; acc = 0.f; for (int d = 0; d < 128; ++d) acc += uq[d] * kv[d]; }
        p.WQF()[i] = acc;
    }
    for (long i = gid; i < 1024L * 1024; i += gn) {
        const int hc = (int)(i >> 10), n = (int)(i & 1023), h = hc >> 7, c = hc & 127;
        const float* kv = p.a_w_ukv + ((size_t)c * 8 + h) * 256 + 128; const float* ap = p.w_a_proj + (size_t)(h * 128) * DM + n;
        float acc = 0.f; for (int d = 0; d < 128; ++d) acc += kv[d] * ap[(size_t)d * DM];
        p.WOF()[i] = acc;
    }
    for (long i = gid; i < (long)LTOT * 32; i += gn) {
        const int pos = (int)(i >> 5), f = (int)(i & 31);
        const float freq = powf(10000.f, -(float)f / 32.f), ang = (float)pos * freq; float s, c; sincosf(ang, &s, &c);
        p.ROPE()[i * 2] = c; p.ROPE()[i * 2 + 1] = s;
    }
}

__global__ void __launch_bounds__(256) k_meta_proj(Params p) {
    const int gid = blockIdx.x * 256 + threadIdx.x;
    if (gid >= NMETA * DIN) return;
    const int j = gid / DIN, n = gid % DIN; const float* u = p.UM() + (size_t)j * DM; float acc = 0.f;
    for (int k = 0; k < DM; ++k) acc += u[k] * p.w_in[(size_t)k * DIN + n];
    p.ZM()[gid] = acc;
}

template <class P> __global__ void __launch_bounds__(256) k_sgemm(P q) {
    __shared__ float As[16][68]; __shared__ float Bs[16][68];
    const int ntn = (q.N + 63) / 64, ntm = q.M / 64, tid = threadIdx.x, tx = tid & 15, ty = tid >> 4;
    for (int tile = blockIdx.x; tile < ntm * ntn; tile += gridDim.x) {
        const int tm = tile / ntn, tn = tile % ntn; int ctx = 0;
        if (!q.setup(tm, ctx)) continue;
        float acc[4][4];
#pragma unroll
        for (int i = 0; i < 4; ++i)
#pragma unroll
            for (int j = 0; j < 4; ++j) acc[i][j] = 0.f;
        const int arow = tm * 64 + (tid >> 2), ak = (tid & 3) * 4, bk = tid >> 4, bcol = tn * 64 + (tid & 15) * 4;
        for (int k0 = 0; k0 < q.K; k0 += 16) {
            const float4 av = q.a4(ctx, arow, k0 + ak);
            const float4 bv = bcol < q.N ? q.b4(ctx, k0 + bk, bcol) : make_float4(0.f, 0.f, 0.f, 0.f);
            __syncthreads();
            As[ak + 0][tid >> 2] = av.x; As[ak + 1][tid >> 2] = av.y; As[ak + 2][tid >> 2] = av.z; As[ak + 3][tid >> 2] = av.w;
            *(float4*)&Bs[bk][(tid & 15) * 4] = bv;
            __syncthreads();
#pragma unroll
            for (int kk = 0; kk < 16; ++kk) {
                const float4 a = *(const float4*)&As[kk][ty * 4]; const float4 b = *(const float4*)&Bs[kk][tx * 4];
                const float aa[4] = {a.x, a.y, a.z, a.w}, bb[4] = {b.x, b.y, b.z, b.w};
#pragma unroll
                for (int i = 0; i < 4; ++i)
#pragma unroll
                    for (int j = 0; j < 4; ++j) acc[i][j] += aa[i] * bb[j];
            }
        }
        const int col = tn * 64 + tx * 4;
        if (col < q.N) {
#pragma unroll
            for (int i = 0; i < 4; ++i) q.epi(ctx, tm * 64 + ty * 4 + i, col, acc[i]);
        }
    }
}
__device__ __forceinline__ float4 ld_bf4(const bf16_t* p) { const uint2 w = *(const uint2*)p; return make_float4(__uint_as_float(w.x << 16), __uint_as_float(w.x & 0xffff0000u), __uint_as_float(w.y << 16), __uint_as_float(w.y & 0xffff0000u)); }

struct ProbIn {
    Params p; int M, N, K, pad;
    __device__ bool setup(int, int&) const { return true; }
    __device__ float4 a4(int, int row, int k) const { return ld_bf4(p.U() + (size_t)row * DM + k); }
    __device__ float4 b4(int, int k, int col) const { return *(const float4*)(p.w_in + (size_t)k * DIN + col); }
    __device__ void epi(int, int row, int col, const float (&v)[4]) const {
#pragma unroll
        for (int j = 0; j < 4; ++j) {
            const int c = col + j; const float z = v[j];
            if (c < OFF_K) p.Qm()[(size_t)row * 512 + c] = f2bf(z * 0.125f);
            else if (c < OFF_V) p.Km()[(size_t)row * 512 + (c - OFF_K)] = f2bf(z);
            else if (c < OFF_O) p.Vm()[(size_t)row * 1024 + (c - OFF_V)] = f2bf(z);
            else if (c < OFF_I) p.OG()[(size_t)row * 1024 + (c - OFF_O)] = f2bf(sigmoidf_(z));
            else if (c < OFF_F) p.GI()[(size_t)row * 16 + (c - OFF_I)] = z + p.m_b_i[c - OFF_I];
            else if (c < OFF_CQ) p.GF()[(size_t)row * 16 + (c - OFF_F)] = logsigmoidf_(z + p.m_b_f[c - OFF_F]);
            else if (c < OFF_CKV) p.CQ()[(size_t)row * 256 + (c - OFF_CQ)] = z;
            else if (c < OFF_KR) p.CKV()[(size_t)row * 128 + (c - OFF_CKV)] = z;
            else if (c < OFF_G) p.KR()[(size_t)row * 64 + (c - OFF_KR)] = z;
            else p.GATE()[(size_t)row * 2048 + (c - OFF_G)] = f2bf(sigmoidf_(z));
        }
    }
};

__global__ void __launch_bounds__(256) k_kprep(Params p) {
    const int lane = threadIdx.x & 63, gw = (blockIdx.x * 256 + threadIdx.x) >> 6, ngw = (gridDim.x * 256) >> 6;
    for (int i = gw; i < NB * KVROWS; i += ngw) {
        const int b = i / KVROWS, key = i % KVROWS; bf16_t* dst = p.Kc() + (size_t)i * 192;
        if (key >= LTOT) { dst[lane] = 0; dst[64 + lane] = 0; dst[128 + lane] = 0; continue; }
        const float *ckv, *kr; int pos;
        if (key < SEQ) { const size_t r = (size_t)b * SEQ + key; ckv = p.CKV() + r * 128; kr = p.KR() + r * 64; pos = NMETA + key; }
        else { const int j = key - SEQ; ckv = p.ZM() + (size_t)j * DIN + OFF_CKV; kr = p.ZM() + (size_t)j * DIN + OFF_KR; pos = j; }
        const float c0 = ckv[lane], c1 = ckv[64 + lane];
        const float rstd = rsqrtf(wave_sum(c0 * c0 + c1 * c1) * (1.f / 128.f) + EPS);
        dst[lane] = f2bf(c0 * rstd * p.a_norm_kv[lane]); dst[64 + lane] = f2bf(c1 * rstd * p.a_norm_kv[64 + lane]);
        if (lane < 32) {
            const float x1 = kr[lane], x2 = kr[32 + lane], cs = p.ROPE()[((size_t)pos * 32 + lane) * 2], sn = p.ROPE()[((size_t)pos * 32 + lane) * 2 + 1];
            dst[128 + lane] = f2bf(x1 * cs - x2 * sn); dst[160 + lane] = f2bf(x1 * sn + x2 * cs);
        }
    }
    for (int r = gw; r < NT; r += ngw) {
        float* cq = p.CQ() + (size_t)r * 256; float v[4]; float ss = 0.f;
#pragma unroll
        for (int j = 0; j < 4; ++j) { v[j] = cq[j * 64 + lane]; ss += v[j] * v[j]; }
        const float rstd = rsqrtf(wave_sum(ss) * (1.f / 256.f) + EPS);
#pragma unroll
        for (int j = 0; j < 4; ++j) cq[j * 64 + lane] = v[j] * rstd * p.a_norm_q[j * 64 + lane];
    }
}

struct ProbQ {
    Params p; int M, N, K, pad;
    __device__ bool setup(int, int&) const { return true; }
    __device__ float4 a4(int, int row, int k) const { return *(const float4*)(p.CQ() + (size_t)row * 256 + k); }
    __device__ float4 b4(int, int k, int col) const { return *(const float4*)(p.WQF() + (size_t)k * 1536 + col); }
    __device__ void epi(int, int row, int col, const float (&v)[4]) const {
        const int h = col / 192, c = col % 192;
        if (c < 128) {
#pragma unroll
            for (int j = 0; j < 4; ++j) p.QP()[(size_t)row * 1536 + col + j] = f2bf(v[j] * QSCALE);
        } else {
#pragma unroll
            for (int j = 0; j < 4; ++j) p.QP()[(size_t)row * 1536 + col + j] = f2bf(v[j] * QSCALE);
        }
        (void)h;
    }
};
__global__ void __launch_bounds__(256) k_rope_q(Params p) {
    const long gid = (long)blockIdx.x * 256 + threadIdx.x;
    if (gid >= (long)NT * 8 * 32) return;
    const int i = (int)(gid & 31), h = (int)((gid >> 5) & 7); const long r = gid >> 8; const int pos = NMETA + (int)(r % SEQ);
    bf16_t* q = p.QP() + (size_t)r * 1536 + h * 192 + 128;
    const float x1 = bf2f(q[i]), x2 = bf2f(q[32 + i]), cs = p.ROPE()[((size_t)pos * 32 + i) * 2], sn = p.ROPE()[((size_t)pos * 32 + i) * 2 + 1];
    q[i] = f2bf(x1 * cs - x2 * sn); q[32 + i] = f2bf(x1 * sn + x2 * cs);
}

__global__ void __launch_bounds__(256) k_mlstm_scan(Params p) {
    __shared__ float ks[64][65]; __shared__ float vs[64][128]; __shared__ float wk[64]; __shared__ float li[64], lf[64]; __shared__ float sc[2];
    const int tid = threadIdx.x, b = blockIdx.x >> 4, h = (blockIdx.x >> 1) & 7, dir = blockIdx.x & 1;
    const int d = tid >> 2, vq = tid & 3;
    float C[32]; float n = 0.f, m = 0.f;
#pragma unroll
    for (int i = 0; i < 32; ++i) C[i] = 0.f;
    bf16_t* CS = dir ? p.CB() : p.CF(); float* NS = dir ? p.NB_() : p.NF(); float* MS = dir ? p.MB() : p.MF();
    const int nsteps = dir ? 64 : 65;
    for (int st = 0; st < nsteps; ++st) {
        const int c = dir ? 63 - st : st - 1;
        if (c >= 0) {
            const size_t sidx = ((size_t)(b * 8 + h) * 64 + c);
            bf16_t* cd = CS + sidx * 8192 + d * 128 + vq * 32;
#pragma unroll
            for (int i = 0; i < 32; ++i) cd[i] = f2bf(C[i]);
            if (vq == 0) NS[sidx * 64 + d] = n;
            if (tid == 0) MS[sidx] = m;
            if ((dir == 0 && c == 63) || (dir == 1 && c == 0)) break;
        }
        const int npos = c < 0 ? NMETA : 64;
        __syncthreads();
        for (int e = tid; e < 64 * 64; e += 256) { const int j = e >> 6, dd = e & 63; float v = 0.f;
            if (j < npos) { if (c < 0) v = p.ZM()[(size_t)j * DIN + OFF_K + h * 64 + dd]; else { const int t = dir ? 63 - j : j; v = bf2f(p.Km()[((size_t)b * SEQ + c * 64 + t) * 512 + h * 64 + dd]); } }
            ks[j][dd] = v; }
        for (int e = tid; e < 64 * 128; e += 256) { const int j = e >> 7, dd = e & 127; float v = 0.f;
            if (j < npos) { if (c < 0) v = p.ZM()[(size_t)j * DIN + OFF_V + h * 128 + dd]; else { const int t = dir ? 63 - j : j; v = bf2f(p.Vm()[((size_t)b * SEQ + c * 64 + t) * 1024 + h * 128 + dd]); } }
            vs[j][dd] = v; }
        if (tid < 64) { float a = -1e30f, f = 0.f; const int j = tid;
            if (j < npos) { if (c < 0) { a = p.ZM()[(size_t)j * DIN + OFF_I + h] + p.m_b_i[h]; f = logsigmoidf_(p.ZM()[(size_t)j * DIN + OFF_F + h] + p.m_b_f[h]); }
                            else { const int t = dir ? 63 - j : j; const size_t r = (size_t)b * SEQ + c * 64 + t; a = p.GI()[r * 16 + dir * 8 + h]; f = p.GF()[r * 16 + dir * 8 + h]; } }
            li[j] = a; lf[j] = f; }
        __syncthreads();
        if (tid == 0) {
            float bl = 0.f; for (int j = 0; j < npos; ++j) bl += lf[j];
            float bc = 0.f, gmax = -1e30f;
            for (int j = 0; j < npos; ++j) { bc += lf[j]; const float g = bl - bc + li[j]; wk[j] = g; gmax = fmaxf(gmax, g); }
            const float mnew = fmaxf(bl + m, gmax);
            for (int j = 0; j < 64; ++j) wk[j] = j < npos ? __expf(wk[j] - mnew) : 0.f;
            sc[0] = __expf(bl + m - mnew); sc[1] = mnew;
        }
        __syncthreads();
        const float decay = sc[0]; m = sc[1];
#pragma unroll
        for (int i = 0; i < 32; ++i) C[i] *= decay;
        n *= decay;
        for (int j = 0; j < npos; ++j) { const float kw = wk[j] * ks[j][d]; n += kw;
#pragma unroll
            for (int i = 0; i < 32; ++i) C[i] += kw * vs[j][vq * 32 + i]; }
    }
}

constexpr int MO_LDS = (64 * 65 * 3 + 64 * 128 * 2 + 64 * 8) * 4;
__global__ void __launch_bounds__(256) k_mlstm_out(Params p) {
    extern __shared__ __attribute__((aligned(16))) float sm[];
    float (*qs)[65] = (float (*)[65])sm; float (*ks)[65] = (float (*)[65])(sm + 64 * 65); float (*Ws)[65] = (float (*)[65])(sm + 2 * 64 * 65);
    float (*vs)[128] = (float (*)[128])(sm + 3 * 64 * 65); float (*Cs)[128] = (float (*)[128])(sm + 3 * 64 * 65 + 64 * 128);
    float* sx = sm + 3 * 64 * 65 + 2 * 64 * 128; float *li = sx, *lf = sx + 64, *bt = sx + 128, *mt = sx + 192, *as = sx + 256, *ns = sx + 320, *msc = sx + 384;
    const int tid = threadIdx.x, c = blockIdx.x & 63, h = (blockIdx.x >> 6) & 7, b = blockIdx.x >> 9;
    const int t = tid >> 2, vq = tid & 3; const size_t r0 = (size_t)b * SEQ + c * 64;
    for (int e = tid; e < 64 * 64; e += 256) { const int j = e >> 6, dd = e & 63; qs[j][dd] = bf2f(p.Qm()[(r0 + j) * 512 + h * 64 + dd]); ks[j][dd] = bf2f(p.Km()[(r0 + j) * 512 + h * 64 + dd]); }
    for (int e = tid; e < 64 * 128; e += 256) { const int j = e >> 7, dd = e & 127; vs[j][dd] = bf2f(p.Vm()[(r0 + j) * 1024 + h * 128 + dd]); }
    __syncthreads();
    float S[16];
#pragma unroll
    for (int i = 0; i < 16; ++i) { const int s = vq * 16 + i; float a = 0.f;
#pragma unroll 4
        for (int dd = 0; dd < 64; ++dd) a += qs[t][dd] * ks[s][dd]; S[i] = a; }
    float hacc[32];
#pragma unroll
    for (int i = 0; i < 32; ++i) hacc[i] = 0.f;
#pragma unroll 1
    for (int dir = 0; dir < 2; ++dir) {
        const size_t sidx = ((size_t)(b * 8 + h) * 64 + c);
        const bf16_t* CS = (dir ? p.CB() : p.CF()) + sidx * 8192; const float* NS = (dir ? p.NB_() : p.NF()) + sidx * 64; const float* MS = (dir ? p.MB() : p.MF()) + sidx;
        __syncthreads();
        for (int e = tid; e < 64 * 128; e += 256) Cs[e >> 7][e & 127] = bf2f(CS[e]);
        if (tid < 64) { ns[tid] = NS[tid]; li[tid] = p.GI()[(r0 + tid) * 16 + dir * 8 + h]; lf[tid] = p.GF()[(r0 + tid) * 16 + dir * 8 + h]; }
        if (tid == 0) msc[0] = MS[0];
        __syncthreads();
        if (tid == 0) {
            const float m = msc[0]; float bc = 0.f, pm = -1e30f;
            if (dir == 0) { for (int j = 0; j < 64; ++j) { bc += lf[j]; const float a = li[j] - bc; as[j] = a; pm = fmaxf(pm, a); bt[j] = bc; mt[j] = fmaxf(bc + m, bc + pm); } }
            else { for (int j = 63; j >= 0; --j) { bc += lf[j]; const float a = li[j] - bc; as[j] = a; pm = fmaxf(pm, a); bt[j] = bc; mt[j] = fmaxf(bc + m, bc + pm); } }
        }
        __syncthreads();
        const float m = msc[0], b_t = bt[t], m_t = mt[t];
#pragma unroll
        for (int i = 0; i < 16; ++i) { const int s = vq * 16 + i; const bool valid = dir ? (s >= t) : (s <= t); Ws[t][s] = valid ? __expf(b_t + as[s] - m_t) * S[i] : 0.f; }
        __syncthreads();
        const float s_inter = __expf(b_t + m - m_t);
        float num[32]; float den = 0.f, qn = 0.f;
#pragma unroll
        for (int i = 0; i < 32; ++i) num[i] = 0.f;
#pragma unroll 2
        for (int dd = 0; dd < 64; ++dd) { const float qv = qs[t][dd]; qn += qv * ns[dd];
#pragma unroll
            for (int i = 0; i < 32; ++i) num[i] += qv * Cs[dd][vq * 32 + i]; }
#pragma unroll
        for (int i = 0; i < 32; ++i) num[i] *= s_inter;
        den = s_inter * qn;
#pragma unroll 2
        for (int s = 0; s < 64; ++s) { const float w = Ws[t][s]; den += w;
#pragma unroll
            for (int i = 0; i < 32; ++i) num[i] += w * vs[s][vq * 32 + i]; }
        const float inv = 1.f / fmaxf(fabsf(den), __expf(-m_t));
#pragma unroll
        for (int i = 0; i < 32; ++i) hacc[i] += num[i] * inv;
    }
    float ss = 0.f;
#pragma unroll
    for (int i = 0; i < 32; ++i) ss += hacc[i] * hacc[i];
    ss += __shfl_xor(ss, 1); ss += __shfl_xor(ss, 2);
    const float rstd = rsqrtf(ss * (1.f / 128.f) + EPS);
#pragma unroll
    for (int i = 0; i < 32; ++i) { const int col = h * 128 + vq * 32 + i; const size_t o = (r0 + t) * 1024 + col;
        p.HM()[o] = f2bf(hacc[i] * rstd * p.m_norm[col] * bf2f(p.OG()[o])); }
}

__global__ void __launch_bounds__(256) k_attn(Params p) {
    __shared__ float kt[32][192];
    const int tid = threadIdx.x, qi = tid >> 2, sl = tid & 3, qb = blockIdx.x & 63, h = (blockIdx.x >> 6) & 7, b = blockIdx.x >> 9;
    const size_t r = (size_t)b * SEQ + qb * 64 + qi;
    float q[48], o[32]; float m = -1e30f, l = 0.f;
#pragma unroll
    for (int i = 0; i < 48; ++i) q[i] = bf2f(p.QP()[r * 1536 + h * 192 + i * 4 + sl]);
#pragma unroll
    for (int i = 0; i < 32; ++i) o[i] = 0.f;
    const bf16_t* Kb = p.Kc() + (size_t)b * KVROWS * 192;
#pragma unroll 1
    for (int tile = 0; tile < KVROWS / 32; ++tile) {
        __syncthreads();
        for (int e = tid; e < 32 * 192; e += 256) kt[e / 192][e % 192] = bf2f(Kb[(size_t)tile * 32 * 192 + e]);
        __syncthreads();
#pragma unroll 1
        for (int g = 0; g < 4; ++g) {
            float s[8]; float tmax = -1e30f;
#pragma unroll
            for (int j = 0; j < 8; ++j) { float a = 0.f; const float* kr = &kt[g * 8 + j][sl];
#pragma unroll
                for (int i = 0; i < 48; ++i) a += q[i] * kr[i * 4];
                a += __shfl_xor(a, 1); a += __shfl_xor(a, 2);
                if (tile * 32 + g * 8 + j >= LTOT) a = -1e30f;
                s[j] = a; tmax = fmaxf(tmax, a); }
            const float mn = fmaxf(m, tmax), alpha = exp2f(m - mn); m = mn; l *= alpha;
#pragma unroll
            for (int i = 0; i < 32; ++i) o[i] *= alpha;
#pragma unroll
            for (int j = 0; j < 8; ++j) { const float pj = (tile * 32 + g * 8 + j >= LTOT) ? 0.f : exp2f(s[j] - mn); l += pj; const float* kr = &kt[g * 8 + j][sl];
#pragma unroll
                for (int i = 0; i < 32; ++i) o[i] += pj * kr[i * 4]; }
        }
    }
    const float inv = 1.f / l;
#pragma unroll
    for (int i = 0; i < 32; ++i) p.OA()[r * 1024 + h * 128 + i * 4 + sl] = f2bf(o[i] * inv);
}

struct ProbYm {
    Params p; int M, N, K, pad;
    __device__ bool setup(int, int&) const { return true; }
    __device__ float4 a4(int, int row, int k) const { return ld_bf4(p.HM() + (size_t)row * DM + k); }
    __device__ float4 b4(int, int k, int col) const { return *(const float4*)(p.w_m_proj + (size_t)k * DM + col); }
    __device__ void epi(int, int row, int col, const float (&v)[4]) const {
#pragma unroll
        for (int j = 0; j < 4; ++j) p.MIX()[(size_t)row * DM + col + j] = f2bf(v[j] * bf2f(p.GATE()[(size_t)row * 2048 + col + j]));
    }
};
struct ProbYa {
    Params p; int M, N, K, pad;
    __device__ bool setup(int, int&) const { return true; }
    __device__ float4 a4(int, int row, int k) const { return ld_bf4(p.OA() + (size_t)row * DM + k); }
    __device__ float4 b4(int, int k, int col) const { return *(const float4*)(p.WOF() + (size_t)k * DM + col); }
    __device__ void epi(int, int row, int col, const float (&v)[4]) const {
#pragma unroll
        for (int j = 0; j < 4; ++j) { const size_t o = (size_t)row * DM + col + j; p.MIX()[o] = f2bf(bf2f(p.MIX()[o]) + v[j] * bf2f(p.GATE()[(size_t)row * 2048 + 1024 + col + j])); }
    }
};
struct ProbOut {
    Params p; int M, N, K, pad;
    __device__ bool setup(int, int&) const { return true; }
    __device__ float4 a4(int, int row, int k) const { return ld_bf4(p.MIX() + (size_t)row * DM + k); }
    __device__ float4 b4(int, int k, int col) const { return *(const float4*)(p.w_out + (size_t)k * DM + col); }
    __device__ void epi(int, int row, int col, const float (&v)[4]) const {
        const float4 xv = *(const float4*)(p.x + (size_t)row * DM + col);
        *(float4*)(p.out + (size_t)row * DM + col) = make_float4(xv.x + v[0], xv.y + v[1], xv.z + v[2], xv.w + v[3]);
    }
};

__global__ void __launch_bounds__(256) k_route(Params p) {
    __shared__ float xn[8][1024];
    const int tid = threadIdx.x, lane = tid & 63, w = tid >> 6;
    for (int base = blockIdx.x * 8; base < NT; base += gridDim.x * 8) {
        __syncthreads();
        for (int rr = 0; rr < 2; ++rr) {
            const int row = base + w * 2 + rr; const float* src = p.out + (size_t)row * DM;
            float4 v[4]; float ss = 0.f;
#pragma unroll
            for (int j = 0; j < 4; ++j) { v[j] = *(const float4*)(src + (j * 64 + lane) * 4); ss += v[j].x * v[j].x + v[j].y * v[j].y + v[j].z * v[j].z + v[j].w * v[j].w; }
            const float rstd = rsqrtf(wave_sum(ss) * (1.f / DM) + EPS);
#pragma unroll
            for (int j = 0; j < 4; ++j) { const int c = (j * 64 + lane) * 4; const float4 g = *(const float4*)(p.norm_ffn + c);
                const float a0 = v[j].x * rstd * g.x, a1 = v[j].y * rstd * g.y, a2 = v[j].z * rstd * g.z, a3 = v[j].w * rstd * g.w;
                float* d = &xn[w * 2 + rr][c]; d[0] = a0; d[1] = a1; d[2] = a2; d[3] = a3;
                bf16_t* o = p.XN2() + (size_t)row * DM + c; o[0] = f2bf(a0); o[1] = f2bf(a1); o[2] = f2bf(a2); o[3] = f2bf(a3); }
        }
        __syncthreads();
        const int rloc = w * 2 + (lane >> 5), e = lane & 31, row = base + rloc;
        float acc = p.b_router[e];
        for (int k = 0; k < DM; ++k) acc += xn[rloc][k] * p.w_router[(size_t)k * NEXP + e];
        float val = acc; int ti[4]; float tv[4];
#pragma unroll
        for (int kk = 0; kk < 4; ++kk) {
            float best = val; int bi = e;
#pragma unroll
            for (int o = 1; o < 32; o <<= 1) { const float ov = __shfl_xor(best, o); const int oi = __shfl_xor(bi, o); if (ov > best || (ov == best && oi < bi)) { best = ov; bi = oi; } }
            ti[kk] = bi; tv[kk] = best; if (e == bi) val = -3.0e38f;
        }
        if (e == 0) {
            const float mx = tv[0]; float ex[4], sum = 0.f;
#pragma unroll
            for (int kk = 0; kk < 4; ++kk) { ex[kk] = __expf(tv[kk] - mx); sum += ex[kk]; }
#pragma unroll
            for (int kk = 0; kk < 4; ++kk) { p.TOPI()[row * 4 + kk] = ti[kk]; p.TOPW()[row * 4 + kk] = ex[kk] / sum; p.RANK()[row * 4 + kk] = atomicAdd(&p.CNT()[ti[kk] * CNT_STRIDE], 1); }
        }
    }
}
__device__ __forceinline__ int expert_pstart(const int* cnt, int e) { int s = 0; for (int i = 0; i < e; ++i) s += (cnt[i * CNT_STRIDE] + 255) / 256 * 256; return s; }
__global__ void __launch_bounds__(256) k_scatter(Params p) {
    __shared__ int ps[NEXP];
    if (threadIdx.x < NEXP) ps[threadIdx.x] = expert_pstart(p.CNT(), threadIdx.x);
    __syncthreads();
    const int gid = blockIdx.x * 256 + threadIdx.x; if (gid >= NT * 4) return;
    const int slot = ps[p.TOPI()[gid]] + p.RANK()[gid]; p.SLOTS()[gid] = slot; p.SLOT_TOK()[slot] = gid >> 2;
}

struct ProbM1 {
    Params p; int M, N, K, pad;
    __device__ bool setup(int tm, int& e) const {
        int s = 0; e = -1;
        for (int i = 0; i < NEXP; ++i) { const int pc = (p.CNT()[i * CNT_STRIDE] + 255) / 256 * 256; if (tm * 64 < s + pc) { e = i; break; } s += pc; }
        return e >= 0;
    }
    __device__ float4 a4(int, int row, int k) const { const int tok = p.SLOT_TOK()[row]; return tok < 0 ? make_float4(0.f, 0.f, 0.f, 0.f) : ld_bf4(p.XN2() + (size_t)tok * DM + k); }
    __device__ float4 b4(int e, int k, int col) const { const float* w = p.w1 + ((size_t)e * DM + k) * 2048 + (col >> 1); const float2 g = *(const float2*)w, l = *(const float2*)(w + 1024); return make_float4(g.x, l.x, g.y, l.y); }
    __device__ void epi(int e, int row, int col, const float (&v)[4]) const {
#pragma unroll
        for (int j = 0; j < 2; ++j) { const int c = (col >> 1) + j; const float g0 = v[2 * j] + p.b1[(size_t)e * 2048 + c], l0 = v[2 * j + 1] + p.b1[(size_t)e * 2048 + 1024 + c];
            const float glu = fminf(g0, 7.f), lin = fminf(fmaxf(l0, -7.f), 7.f);
            p.ACT()[(size_t)row * DFF + c] = f2bf(glu * sigmoidf_(1.702f * glu) * (lin + 1.f)); }
    }
};
struct ProbM2 {
    Params p; int M, N, K, pad;
    __device__ bool setup(int tm, int& e) const {
        int s = 0; e = -1;
        for (int i = 0; i < NEXP; ++i) { const int pc = (p.CNT()[i * CNT_STRIDE] + 255) / 256 * 256; if (tm * 64 < s + pc) { e = i; break; } s += pc; }
        return e >= 0;
    }
    __device__ float4 a4(int, int row, int k) const { return ld_bf4(p.ACT() + (size_t)row * DFF + k); }
    __device__ float4 b4(int e, int k, int col) const { return *(const float4*)(p.w2 + ((size_t)e * DFF + k) * DM + col); }
    __device__ void epi(int e, int row, int col, const float (&v)[4]) const {
#pragma unroll
        for (int j = 0; j < 4; ++j) p.YB()[(size_t)row * DM + col + j] = f2bf(v[j] + p.b2[(size_t)e * DM + col + j]);
    }
};

__global__ void __launch_bounds__(256) k_combine(Params p) {
    const int lane = threadIdx.x & 63, gw = (blockIdx.x * 256 + threadIdx.x) >> 6, ngw = (gridDim.x * 256) >> 6;
    for (int r = gw; r < NT; r += ngw) {
        float4 v[4];
#pragma unroll
        for (int j = 0; j < 4; ++j) v[j] = *(const float4*)(p.out + (size_t)r * DM + (j * 64 + lane) * 4);
#pragma unroll
        for (int kk = 0; kk < 4; ++kk) { const float w = p.TOPW()[r * 4 + kk]; const bf16_t* y = p.YB() + (size_t)p.SLOTS()[r * 4 + kk] * DM;
#pragma unroll
            for (int j = 0; j < 4; ++j) { const float4 t = ld_bf4(y + (j * 64 + lane) * 4); v[j].x += w * t.x; v[j].y += w * t.y; v[j].z += w * t.z; v[j].w += w * t.w; } }
        float ss = 0.f;
#pragma unroll
        for (int j = 0; j < 4; ++j) ss += v[j].x * v[j].x + v[j].y * v[j].y + v[j].z * v[j].z + v[j].w * v[j].w;
        const float rstd = rsqrtf(wave_sum(ss) * (1.f / DM) + EPS);
#pragma unroll
        for (int j = 0; j < 4; ++j) { const int c = (j * 64 + lane) * 4; const float4 g = *(const float4*)(p.norm_final + c);
            *(float4*)(p.out + (size_t)r * DM + c) = make_float4(v[j].x * rstd * g.x, v[j].y * rstd * g.y, v[j].z * rstd * g.z, v[j].w * rstd * g.w); }
    }
}

#define LAS __attribute__((address_space(3)))
typedef short bf16x8 __attribute__((ext_vector_type(8)));
typedef float f32x4 __attribute__((ext_vector_type(4)));
typedef float f32x2 __attribute__((ext_vector_type(2)));
typedef unsigned u32x4 __attribute__((ext_vector_type(4)));
typedef unsigned u32x2 __attribute__((ext_vector_type(2)));
typedef int v4i __attribute__((ext_vector_type(4)));
typedef int v8i __attribute__((ext_vector_type(8)));

constexpr int MK_THREADS = 512;
constexpr int RING_BYTES = 131072, MISC_OFF = RING_BYTES, MK_LDS = 147456;
constexpr int NIN_PAD = 5632;

namespace pg8 {
constexpr int BM = 256, BK = 64, HALF = 128, HTB = HALF * BK * 2, NXCD = 8, WGM = 8;
__host__ __device__ __forceinline__ int lds_byte(int r, int c) { const int st = (r >> 4) * 2 + (c >> 5), rr = r & 15, cc = c & 31, ob = rr * 64 + cc * 2; return st * 1024 + (ob ^ (((ob >> 9) & 1) << 5)); }
__host__ __device__ __forceinline__ void stage_rc(int b, int& R, int& C) { const int st = b / 1024, sb = b % 1024, swz = sb ^ (((sb >> 9) & 1) << 5); R = (st >> 1) * 16 + swz / 64; C = (st & 1) * 32 + (swz % 64) / 2; }
__host__ __device__ __forceinline__ int perm32(int rho) { const int n = rho >> 4, i = rho & 15; return 8 * (i >> 2) + 4 * n + (i & 3); }
__device__ __forceinline__ unsigned cvt_pk_bf16(float lo, float hi) { unsigned r; asm volatile("v_cvt_pk_bf16_f32 %0, %1, %2" : "=v"(r) : "v"(lo), "v"(hi)); return r; }

struct Unit { int pm, pn, e; const char* A; const char* B; };

struct StaticOrder {
    int nM, nN, nwg, G, c; const char* A; const char* Bt; size_t btile;
    __device__ void init(int M, int N, int K, int G_, int c_, const void* A_, const void* Bt_) { nM = M / BM; nN = N / BM; nwg = nM * nN; G = G_; c = c_; A = (const char*)A_; Bt = (const char*)Bt_; btile = (size_t)BM * K * 2; }
    __device__ bool next(int i, Unit& u) const {
        const long L = (long)i * G + c; if (L >= nwg) return false;
        int wgid = (int)L; { const int q = nwg / NXCD, r = nwg % NXCD, xcd = wgid % NXCD, off = wgid / NXCD; wgid = (xcd < r ? xcd * (q + 1) : r * (q + 1) + (xcd - r) * q) + off; }
        const int nig = WGM * nN, gid = wgid / nig, fm = gid * WGM, gsz = (nM - fm) < WGM ? (nM - fm) : WGM;
        u.pm = fm + ((wgid % nig) % gsz); u.pn = (wgid % nig) / gsz; u.e = 0; u.A = A; u.B = Bt + (size_t)u.pn * btile; return true;
    }
    __device__ __forceinline__ int arow(int r) const { return r; }
};
struct MoeOrder {
    const volatile LAS int* tstart;
    int npn, G, c; const char* A; const char* W; size_t wexp, btile; const int* rowidx;
    __device__ bool next(int i, Unit& u) const {
        const long L = (long)i * G + c; const int ntile = tstart[NEXP]; if (L >= (long)ntile * npn) return false;
        const int mt = (int)(L / npn), pn = (int)(L % npn); int e = 0;
#pragma unroll 1
        for (int k = 1; k < NEXP; ++k) e += (tstart[k] <= mt) ? 1 : 0;
        u.pm = mt; u.pn = pn; u.e = e; u.A = A; u.B = W + (size_t)e * wexp + (size_t)pn * btile; return true;
    }
    __device__ __forceinline__ int arow(int r) const { if (!rowidx) return r; const int t = rowidx[r]; return t < 0 ? 0 : t; }
};

template <class Epi, class Sched, bool F8 = false>
__device__ __forceinline__ void gemm_phase(LAS unsigned char* lds, const int K, const int lda, const Sched& S, const Epi& E) {
    const int tid = threadIdx.x, wid = __builtin_amdgcn_readfirstlane(tid >> 6), lane = tid & 63, wr = wid >> 2, wc = wid & 3, fr = lane & 15, fq = lane >> 4;
    const int nt = K / BK;
    unsigned voffB[2];
#pragma unroll
    for (int i = 0; i < 2; ++i) { int R, C; stage_rc(tid * 16 + i * 8192, R, C); const int Rb = Epi::PERM ? ((R & ~31) + perm32(R & 31)) : R; voffB[i] = (unsigned)(Rb * K + C) * 2u; }
    const size_t kstep = (size_t)(BK * 2);
    const size_t hstepB = (size_t)HALF * K * 2;
    const unsigned ldsw = (unsigned)wid * 1024u;
    const int aoff = lds_byte(wr * 64 + fr, fq * 8), boff = lds_byte(wc * 32 + fr, fq * 8);
#define PG8_SA(b, h) (((b) * 2 + (h)) * HTB)
#define PG8_SB(b, h) ((4 + (b) * 2 + (h)) * HTB)
#define PG8_STAGE(bufoff, gbase, voff) do { _Pragma("unroll") for (int _i = 0; _i < 2; ++_i) \
        __builtin_amdgcn_global_load_lds((const unsigned*)((const char*)(gbase) + (voff)[_i]), (LAS unsigned*)(lds + (bufoff) + ldsw + _i * 8192), 16, 0, 0); } while (0)
#define PG8_STAGE_B(bufoff, gbase) do { if constexpr (F8) { const u32x2 vo_ = *(const LAS u32x2*)vslot; const unsigned vv_[2] = {vo_[0], vo_[1]}; PG8_STAGE(bufoff, gbase, vv_); } else PG8_STAGE(bufoff, gbase, voffB); } while (0)
#define PG8_STAGE_A(bufoff, gbase, h) do { if constexpr (F8) { const u32x2 vo_ = *(const LAS u32x2*)(vslot + 2 + 2 * (h)); const unsigned vv_[2] = {vo_[0], vo_[1]}; PG8_STAGE(bufoff, gbase, vv_); } else PG8_STAGE(bufoff, gbase, vc[h]); } while (0)
#define PG8_LDA(dst, b, h) do { _Pragma("unroll") for (int m = 0; m < 4; ++m) _Pragma("unroll") for (int k = 0; k < 2; ++k) dst[m][k] = *(const LAS bf16x8*)(lds + PG8_SA(b, h) + aoff + m * 2048 + k * 1024); } while (0)
#define PG8_LDB(dst, b, h) do { _Pragma("unroll") for (int n = 0; n < 2; ++n) _Pragma("unroll") for (int k = 0; k < 2; ++k) dst[n][k] = *(const LAS bf16x8*)(lds + PG8_SB(b, h) + boff + n * 2048 + k * 1024); } while (0)
#define PG8_MMA(ai, bj, At, Bt) do { __builtin_amdgcn_s_setprio(1); _Pragma("unroll") for (int m = 0; m < 4; ++m) _Pragma("unroll") for (int n = 0; n < 2; ++n) _Pragma("unroll") for (int k = 0; k < 2; ++k) \
        acc[ai][bj][m][n] = __builtin_amdgcn_mfma_f32_16x16x32_bf16(Bt[n][k], At[m][k], acc[ai][bj][m][n], 0, 0, 0); __builtin_amdgcn_s_setprio(0); } while (0)
#define PG8_LDA8(dst, b, h) do { _Pragma("unroll") for (int m = 0; m < 4; ++m) dst[m] = __builtin_shufflevector(*(const LAS v4i*)(lds + PG8_SA(b, h) + aoff + m * 2048), *(const LAS v4i*)(lds + PG8_SA(b, h) + aoff + m * 2048 + 1024), 0, 1, 2, 3, 4, 5, 6, 7); } while (0)
#define PG8_LDB8(dst, b, h) do { _Pragma("unroll") for (int n = 0; n < 2; ++n) dst[n] = __builtin_shufflevector(*(const LAS v4i*)(lds + PG8_SB(b, h) + boff + n * 2048), *(const LAS v4i*)(lds + PG8_SB(b, h) + boff + n * 2048 + 1024), 0, 1, 2, 3, 4, 5, 6, 7); } while (0)
#define PG8_MMA8(ai, bj, At, Bt) do { __builtin_amdgcn_s_setprio(1); _Pragma("unroll") for (int m = 0; m < 4; ++m) _Pragma("unroll") for (int n = 0; n < 2; ++n) \
        acc[ai][bj][m][n] = __builtin_amdgcn_mfma_scale_f32_16x16x128_f8f6f4(Bt[n], At[m], acc[ai][bj][m][n], 0, 0, 0, 122, 0, 127); __builtin_amdgcn_s_setprio(0); } while (0)
#define PG8_XLDA(b, h) do { if constexpr (F8) PG8_LDA8(At8, b, h); else PG8_LDA(At, b, h); } while (0)
#define PG8_XLDB0(b, h) do { if constexpr (F8) PG8_LDB8(B08, b, h); else PG8_LDB(B0, b, h); } while (0)
#define PG8_XLDB1(b, h) do { if constexpr (F8) PG8_LDB8(B18, b, h); else PG8_LDB(B1, b, h); } while (0)
#define PG8_XMM0(ai, bj) do { if constexpr (F8) PG8_MMA8(ai, bj, At8, B08); else PG8_MMA(ai, bj, At, B0); } while (0)
#define PG8_XMM1(ai, bj) do { if constexpr (F8) PG8_MMA8(ai, bj, At8, B18); else PG8_MMA(ai, bj, At, B1); } while (0)
#define PG8_WAIT_V(n) asm volatile("s_waitcnt vmcnt(" #n ")" ::: "memory")
#define PG8_WAIT_L(n) asm volatile("s_waitcnt lgkmcnt(" #n ")" ::: "memory")
#define PG8_BAR __builtin_amdgcn_s_barrier()
#define PG8_SCHED __builtin_amdgcn_sched_barrier(0)
#define PG8_VOFF(dst, u) do { int _tt = tid; asm volatile("" : "+v"(_tt)); _Pragma("unroll") for (int _i = 0; _i < 2; ++_i) { int _R, _C; stage_rc(_tt * 16 + _i * 8192, _R, _C); \
        _Pragma("unroll") for (int _h = 0; _h < 2; ++_h) dst[_h][_i] = (unsigned)(S.arow((u).pm * BM + _h * HALF + _R) * lda + _C) * 2u; } } while (0)
    Unit cur, nxt; int ui = 0;
    if (!S.next(0, cur)) return;
    f32x4 acc[2][2][4][2];
#pragma unroll
    for (int a = 0; a < 2; ++a)
#pragma unroll
        for (int b = 0; b < 2; ++b)
#pragma unroll
            for (int m = 0; m < 4; ++m)
#pragma unroll
                for (int n = 0; n < 2; ++n) acc[a][b][m][n] = (f32x4){0.f, 0.f, 0.f, 0.f};
    bf16x8 At[4][2], B0[2][2], B1[2][2]; v8i At8[4], B08[2], B18[2];
    unsigned vc[2][2], vn[2][2];
    LAS unsigned* vslot = (LAS unsigned*)(lds + MISC_OFF + 1024) + tid * 6;
    PG8_VOFF(vc, cur);
    if constexpr (F8) { vslot[0] = voffB[0]; vslot[1] = voffB[1]; vslot[2] = vc[0][0]; vslot[3] = vc[0][1]; vslot[4] = vc[1][0]; vslot[5] = vc[1][1]; }
    const char* cA = cur.A; const char* cB = cur.B;
    PG8_STAGE_B(PG8_SB(0, 0), cB); PG8_STAGE_B(PG8_SB(0, 1), cB + hstepB); PG8_STAGE_A(PG8_SA(0, 0), cA, 0); PG8_STAGE_A(PG8_SA(0, 1), cA, 1);
    if (wr == 1) PG8_BAR;
    PG8_WAIT_V(2); PG8_BAR;
    PG8_STAGE_B(PG8_SB(1, 0), cB + kstep); PG8_STAGE_A(PG8_SA(1, 0), cA + kstep, 0); PG8_STAGE_B(PG8_SB(1, 1), cB + hstepB + kstep);
    PG8_WAIT_V(6); PG8_BAR;
    for (;;) {
        const bool has_next = S.next(ui + 1, nxt);
        const char* nA = has_next ? nxt.A : cA; const char* nB = has_next ? nxt.B : cB;
#pragma unroll 1
        for (int t = 0; t < nt; t += 2) {
            const bool last = (t == nt - 2);
            const char* a1 = cA + (size_t)(t + 1) * kstep;
            const char* a2 = last ? nA : cA + (size_t)(t + 2) * kstep; const char* b2 = last ? nB : cB + (size_t)(t + 2) * kstep;
            const char* a3 = a2 + kstep; const char* b3 = b2 + kstep;
            if (last && has_next) { PG8_VOFF(vn, nxt); }
            PG8_XLDB0(0, 0); PG8_XLDB1(0, 1); PG8_SCHED; PG8_XLDA(0, 0); PG8_STAGE_A(PG8_SA(1, 1), a1, 1);
            PG8_WAIT_V(8); PG8_WAIT_L(0); PG8_BAR; PG8_XMM0(0, 0); PG8_XMM1(0, 1); PG8_BAR; PG8_SCHED;
            if (last && has_next) {
                if constexpr (F8) { vslot[2] = vn[0][0]; vslot[3] = vn[0][1]; vslot[4] = vn[1][0]; vslot[5] = vn[1][1]; }
                else {
#pragma unroll
                for (int h = 0; h < 2; ++h)
#pragma unroll
                    for (int i = 0; i < 2; ++i) vc[h][i] = vn[h][i];
                }
            }
            PG8_XLDA(0, 1); PG8_STAGE_B(PG8_SB(0, 0), b2); PG8_STAGE_B(PG8_SB(0, 1), b2 + hstepB); PG8_STAGE_A(PG8_SA(0, 0), a2, 0);
            PG8_WAIT_V(8); PG8_WAIT_L(0); PG8_BAR; PG8_XMM0(1, 0); PG8_XMM1(1, 1); PG8_BAR; PG8_SCHED;
            PG8_XLDB0(1, 0); PG8_XLDB1(1, 1); PG8_SCHED; PG8_XLDA(1, 0); PG8_STAGE_A(PG8_SA(0, 1), a2, 1);
            PG8_WAIT_V(8); PG8_WAIT_L(0); PG8_BAR; PG8_XMM0(0, 0); PG8_XMM1(0, 1); PG8_BAR; PG8_SCHED;
            PG8_XLDA(1, 1); PG8_STAGE_B(PG8_SB(1, 0), b3); PG8_STAGE_B(PG8_SB(1, 1), b3 + hstepB); PG8_STAGE_A(PG8_SA(1, 0), a3, 0);
            PG8_WAIT_V(8); PG8_WAIT_L(0); PG8_BAR; PG8_XMM0(1, 0); PG8_XMM1(1, 1); PG8_BAR; PG8_SCHED;
        }
        if (wr == 0) PG8_BAR;
        E(acc, cur, wr, wc, fr, fq);
        if (!has_next) break;
#pragma unroll
        for (int a = 0; a < 2; ++a)
#pragma unroll
            for (int b = 0; b < 2; ++b)
#pragma unroll
                for (int m = 0; m < 4; ++m)
#pragma unroll
                    for (int n = 0; n < 2; ++n) acc[a][b][m][n] = (f32x4){0.f, 0.f, 0.f, 0.f};
        cur = nxt; cA = nA; cB = nB; ++ui;
        if (wr == 1) PG8_BAR;
    }
    PG8_WAIT_V(0);
    PG8_BAR;
#undef PG8_SA
#undef PG8_SB
#undef PG8_STAGE
#undef PG8_STAGE_A
#undef PG8_STAGE_B
#undef PG8_LDA
#undef PG8_LDB
#undef PG8_MMA
#undef PG8_MMA8
#undef PG8_LDA8
#undef PG8_LDB8
#undef PG8_XLDA
#undef PG8_XLDB0
#undef PG8_XLDB1
#undef PG8_XMM0
#undef PG8_XMM1
#undef PG8_WAIT_V
#undef PG8_WAIT_L
#undef PG8_BAR
#undef PG8_SCHED
#undef PG8_VOFF
}
}

__device__ __forceinline__ unsigned pk4_fp8(float a, float b, float c, float d) { int p = 0; p = __builtin_amdgcn_cvt_pk_fp8_f32(a, b, p, false); p = __builtin_amdgcn_cvt_pk_fp8_f32(c, d, p, true); return (unsigned)p; }
constexpr float W8_SCALE = 32.f;
__device__ __forceinline__ void st8_bf16(bf16_t* dst, const f32x4 v0, const f32x4 v1) {
    u32x4 w; w.x = pg8::cvt_pk_bf16(v0[0], v0[1]); w.y = pg8::cvt_pk_bf16(v0[2], v0[3]); w.z = pg8::cvt_pk_bf16(v1[0], v1[1]); w.w = pg8::cvt_pk_bf16(v1[2], v1[3]);
    *(u32x4*)dst = w;
}
__device__ __forceinline__ void ld8_bf16(const bf16_t* src, f32x4& v0, f32x4& v1) {
    const u32x4 w = *(const u32x4*)src;
    v0 = (f32x4){__uint_as_float(w.x << 16), __uint_as_float(w.x & 0xffff0000u), __uint_as_float(w.y << 16), __uint_as_float(w.y & 0xffff0000u)};
    v1 = (f32x4){__uint_as_float(w.z << 16), __uint_as_float(w.z & 0xffff0000u), __uint_as_float(w.w << 16), __uint_as_float(w.w & 0xffff0000u)};
}
__device__ __forceinline__ f32x4 sig4(f32x4 v) { return (f32x4){sigmoidf_(v[0]), sigmoidf_(v[1]), sigmoidf_(v[2]), sigmoidf_(v[3])}; }

template <int PART> struct EpiIn {
    static constexpr bool PERM = true;
    Params p;
    __device__ __forceinline__ void operator()(const f32x4 (&acc)[2][2][4][2], const pg8::Unit& u, int wr, int wc, int fr, int fq) const {
        const int pn = u.pn; const size_t row0 = (size_t)u.pm * 256 + wr * 64 + fr; const int cl0 = wc * 32 + 8 * fq;
        if (PART == 1 || pn < 21) {
            bf16_t* base; int ld, c0; int mode;
            if (PART != 1 && pn < 2) { base = p.Qm(); ld = 512; c0 = pn * 256; mode = 1; }
            else if (PART != 1 && pn < 4) { base = p.Km(); ld = 512; c0 = (pn - 2) * 256; mode = 0; }
            else if (PART != 1 && pn < 8) { base = p.Vm(); ld = 1024; c0 = (pn - 4) * 256; mode = 0; }
            else if (PART != 0 && pn < 12) { base = p.OG(); ld = 1024; c0 = (pn - 8) * 256; mode = 2; }
            else if (PART != 0 && pn < 20) { base = p.GATE(); ld = 2048; c0 = (pn - 12) * 256; mode = 2; }
            else { base = nullptr; ld = 256; c0 = 0; mode = 3; }
#pragma unroll
            for (int ai = 0; ai < 2; ++ai)
#pragma unroll
                for (int m = 0; m < 4; ++m) { const size_t r = row0 + ai * 128 + m * 16;
#pragma unroll
                    for (int bj = 0; bj < 2; ++bj) { f32x4 v0 = acc[ai][bj][m][0], v1 = acc[ai][bj][m][1]; const int c = c0 + bj * 128 + cl0;
                        if (PART != 1 && mode == 3) { float* d = p.CQ() + r * 256 + c; *(f32x4*)d = v0; *(f32x4*)(d + 4) = v1; }
                        else { if (PART != 1 && mode == 1) { v0 = v0 * 0.125f; v1 = v1 * 0.125f; } else if (PART != 0 && mode == 2) { v0 = sig4(v0); v1 = sig4(v1); }
                               st8_bf16(base + r * ld + c, v0, v1); } } }
        } else if (PART != 1) {
#pragma unroll
            for (int ai = 0; ai < 2; ++ai)
#pragma unroll
                for (int m = 0; m < 4; ++m) { const size_t r = row0 + ai * 128 + m * 16;
                    { float* d = p.CKV() + r * 128 + cl0; *(f32x4*)d = acc[ai][0][m][0]; *(f32x4*)(d + 4) = acc[ai][0][m][1]; }
                    const f32x4 v0 = acc[ai][1][m][0], v1 = acc[ai][1][m][1];
                    if (wc < 2) { float* d = p.KR() + r * 64 + cl0; *(f32x4*)d = v0; *(f32x4*)(d + 4) = v1; }
                    else if (wc == 2) { const int g = 8 * (fq & 1);
                        if (fq < 2) { float* d = p.GI() + r * 16 + g; const f32x4 b0 = *(const f32x4*)(p.m_b_i + g), b1 = *(const f32x4*)(p.m_b_i + g + 4); *(f32x4*)d = v0 + b0; *(f32x4*)(d + 4) = v1 + b1; }
                        else { float* d = p.GF() + r * 16 + g; const f32x4 b0 = *(const f32x4*)(p.m_b_f + g), b1 = *(const f32x4*)(p.m_b_f + g + 4);
                            *(f32x4*)d = (f32x4){logsigmoidf_(v0[0] + b0[0]), logsigmoidf_(v0[1] + b0[1]), logsigmoidf_(v0[2] + b0[2]), logsigmoidf_(v0[3] + b0[3])};
                            *(f32x4*)(d + 4) = (f32x4){logsigmoidf_(v1[0] + b1[0]), logsigmoidf_(v1[1] + b1[1]), logsigmoidf_(v1[2] + b1[2]), logsigmoidf_(v1[3] + b1[3])}; } } }
        }
    }
};
template <int PART> struct EpiInP {
    static constexpr bool PERM = true;
    Params p;
    __device__ __forceinline__ void operator()(const f32x4 (&acc)[2][2][4][2], const pg8::Unit& u, int wr, int wc, int fr, int fq) const {
        pg8::Unit v = u; v.pn = PART == 0 ? (u.pn < 8 ? u.pn : u.pn + 12) : u.pn + 8;
        EpiIn<PART> E{p}; E(acc, v, wr, wc, fr, fq);
    }
};
struct EpiQ {
    static constexpr bool PERM = true;
    Params p;
    __device__ __forceinline__ void operator()(const f32x4 (&acc)[2][2][4][2], const pg8::Unit& u, int wr, int wc, int fr, int fq) const {
        const size_t row0 = (size_t)u.pm * 256 + wr * 64 + fr;
#pragma unroll
        for (int ai = 0; ai < 2; ++ai)
#pragma unroll
            for (int m = 0; m < 4; ++m) { const size_t r = row0 + ai * 128 + m * 16; const float rs = p.RSQ()[r] * QSCALE; const int pos = NMETA + (int)(r & (SEQ - 1));
#pragma unroll
                for (int bj = 0; bj < 2; ++bj) { const int c = u.pn * 256 + bj * 128 + wc * 32 + 8 * fq; const int local = c % 192;
                    f32x4 v0 = acc[ai][bj][m][0] * rs, v1 = acc[ai][bj][m][1] * rs;
                    if (local >= 128) { const int i0 = (local - 128) >> 1; const float* rp = p.ROPE() + ((size_t)pos * 32 + i0) * 2;
                        const f32x4 cs0 = *(const f32x4*)rp, cs1 = *(const f32x4*)(rp + 4);
                        const f32x4 o0 = (f32x4){v0[0] * cs0[0] - v0[1] * cs0[1], v0[0] * cs0[1] + v0[1] * cs0[0], v0[2] * cs0[2] - v0[3] * cs0[3], v0[2] * cs0[3] + v0[3] * cs0[2]};
                        const f32x4 o1 = (f32x4){v1[0] * cs1[0] - v1[1] * cs1[1], v1[0] * cs1[1] + v1[1] * cs1[0], v1[2] * cs1[2] - v1[3] * cs1[3], v1[2] * cs1[3] + v1[3] * cs1[2]};
                        v0 = o0; v1 = o1; }
                    st8_bf16(p.QP() + r * 1536 + c, v0, v1); }
                asm volatile("" ::: "memory"); }
    }
};
template <int PASS> struct EpiMix {
    static constexpr bool PERM = true;
    Params p;
    __device__ __forceinline__ void operator()(const f32x4 (&acc)[2][2][4][2], const pg8::Unit& u, int wr, int wc, int fr, int fq) const {
        const size_t row0 = (size_t)u.pm * 256 + wr * 64 + fr;
#pragma unroll
        for (int ai = 0; ai < 2; ++ai)
#pragma unroll
            for (int m = 0; m < 4; ++m) { const size_t r = row0 + ai * 128 + m * 16;
#pragma unroll
                for (int bj = 0; bj < 2; ++bj) { const int c = u.pn * 256 + bj * 128 + wc * 32 + 8 * fq;
                    f32x4 g0, g1; ld8_bf16(p.GATE() + r * 2048 + PASS * 1024 + c, g0, g1);
                    f32x4 v0 = acc[ai][bj][m][0] * g0, v1 = acc[ai][bj][m][1] * g1;
                    if (PASS == 1) { f32x4 m0, m1; ld8_bf16(p.MIX() + r * 1024 + c, m0, m1); v0 = v0 + m0; v1 = v1 + m1; }
                    st8_bf16(p.MIX() + r * 1024 + c, v0, v1); } }
    }
};
struct EpiOut {
    static constexpr bool PERM = false;
    Params p;
    __device__ __forceinline__ void operator()(const f32x4 (&acc)[2][2][4][2], const pg8::Unit& u, int wr, int wc, int fr, int fq) const {
        const size_t row0 = (size_t)u.pm * 256 + wr * 64 + fr; const int col0 = u.pn * 256 + wc * 32 + 4 * fq;
#pragma unroll
        for (int ai = 0; ai < 2; ++ai)
#pragma unroll
            for (int m = 0; m < 4; ++m) { const size_t off = (row0 + ai * 128 + m * 16) * DM + col0;
#pragma unroll
                for (int bj = 0; bj < 2; ++bj)
#pragma unroll
                    for (int n = 0; n < 2; ++n) { const f32x4 xv = *(const f32x4*)(p.x + off + bj * 128 + n * 16); *(f32x4*)(p.out + off + bj * 128 + n * 16) = xv + acc[ai][bj][m][n]; } }
    }
};
struct EpiM1 {
    static constexpr bool PERM = true;
    Params p;
    __device__ __forceinline__ void operator()(const f32x4 (&acc)[2][2][4][2], const pg8::Unit& u, int wr, int wc, int fr, int fq) const {
        const size_t row0 = (size_t)u.pm * 256 + wr * 64 + fr; const int c = u.pn * 128 + wc * 32 + 8 * fq;
        const float* bg = p.b1 + (size_t)u.e * 2048 + c; const f32x4 bg0 = *(const f32x4*)bg, bg1 = *(const f32x4*)(bg + 4), bl0 = *(const f32x4*)(bg + 1024), bl1 = *(const f32x4*)(bg + 1028);
#pragma unroll
        for (int ai = 0; ai < 2; ++ai)
#pragma unroll
            for (int m = 0; m < 4; ++m) { const size_t r = row0 + ai * 128 + m * 16;
                const f32x4 g0 = acc[ai][0][m][0] + bg0, g1 = acc[ai][0][m][1] + bg1, l0 = acc[ai][1][m][0] + bl0, l1 = acc[ai][1][m][1] + bl1; f32x4 a0, a1;
#pragma unroll
                for (int j = 0; j < 4; ++j) { const float gg = fminf(g0[j], 7.f), ll = fminf(fmaxf(l0[j], -7.f), 7.f); a0[j] = gg * sigmoidf_(1.702f * gg) * (ll + 1.f);
                    const float gh = fminf(g1[j], 7.f), lh = fminf(fmaxf(l1[j], -7.f), 7.f); a1[j] = gh * sigmoidf_(1.702f * gh) * (lh + 1.f); }
                u32x2 o8; o8.x = pk4_fp8(a0[0], a0[1], a0[2], a0[3]); o8.y = pk4_fp8(a1[0], a1[1], a1[2], a1[3]); *(u32x2*)((unsigned char*)p.ACT() + r * DFF + c) = o8; }
    }
};
struct EpiM2 {
    static constexpr bool PERM = true;
    Params p;
    __device__ __forceinline__ void operator()(const f32x4 (&acc)[2][2][4][2], const pg8::Unit& u, int wr, int wc, int fr, int fq) const {
        const size_t row0 = (size_t)u.pm * 256 + wr * 64 + fr;
#pragma unroll
        for (int bj = 0; bj < 2; ++bj) { const int c = u.pn * 256 + bj * 128 + wc * 32 + 8 * fq; const float* bb = p.b2 + (size_t)u.e * DM + c; const f32x4 b0 = *(const f32x4*)bb, b1 = *(const f32x4*)(bb + 4);
#pragma unroll
            for (int ai = 0; ai < 2; ++ai)
#pragma unroll
                for (int m = 0; m < 4; ++m) { const size_t r = row0 + ai * 128 + m * 16; st8_bf16(p.YB() + r * DM + c, acc[ai][bj][m][0] + b0, acc[ai][bj][m][1] + b1); } }
    }
};

__device__ __forceinline__ float4 ntld4(const float* p) { const f32x4 v = __builtin_nontemporal_load((const f32x4*)p); return make_float4(v[0], v[1], v[2], v[3]); }
__device__ __forceinline__ uint2 ntld2u(const bf16_t* p) { const u32x2 v = __builtin_nontemporal_load((const u32x2*)p); return make_uint2(v[0], v[1]); }
__device__ __forceinline__ unsigned pk2(float lo, float hi) { return (unsigned)f2bf(lo) | ((unsigned)f2bf(hi) << 16); }
struct TrDesc { const float* W; bf16_t* WT; int ldw, K, dr0, sc0, nvalid, k0, f8; };
__device__ __forceinline__ void tr_load(const TrDesc& d, float4 (&v)[16], int lane) {
    const int lr = lane >> 4, lc = (lane & 15) * 4;
#pragma unroll
    for (int i = 0; i < 16; ++i) v[i] = (lc < d.nvalid) ? ntld4(d.W + (size_t)(d.k0 + i * 4 + lr) * d.ldw + d.sc0 + lc) : make_float4(0.f, 0.f, 0.f, 0.f);
}
__device__ __forceinline__ void tr_finish(const TrDesc& d, const float4 (&v)[16], LAS float* scr, int lane) {
    const int lr = lane >> 4, lc = (lane & 15) * 4;
#pragma unroll
    for (int i = 0; i < 16; ++i) { LAS float* q = scr + (i * 4 + lr) * 65 + lc; q[0] = v[i].x; q[1] = v[i].y; q[2] = v[i].z; q[3] = v[i].w; }
    asm volatile("s_waitcnt lgkmcnt(0)" ::: "memory");
    const int c = lane & 7;
    if (d.f8) {
#pragma unroll
        for (int j = 0; j < 8; ++j) { const int n = (lane >> 3) + 8 * j; const LAS float* s = scr + (8 * c) * 65 + n;
            u32x2 o; o.x = pk4_fp8(s[0 * 65] * W8_SCALE, s[1 * 65] * W8_SCALE, s[2 * 65] * W8_SCALE, s[3 * 65] * W8_SCALE); o.y = pk4_fp8(s[4 * 65] * W8_SCALE, s[5 * 65] * W8_SCALE, s[6 * 65] * W8_SCALE, s[7 * 65] * W8_SCALE);
            *(u32x2*)((unsigned char*)d.WT + (size_t)(d.dr0 + n) * d.K + d.k0 + 8 * c) = o; }
    } else {
#pragma unroll
    for (int j = 0; j < 8; ++j) { const int n = (lane >> 3) + 8 * j; const LAS float* s = scr + (8 * c) * 65 + n;
        u32x4 o; o.x = pk2(s[0 * 65], s[1 * 65]); o.y = pk2(s[2 * 65], s[3 * 65]); o.z = pk2(s[4 * 65], s[5 * 65]); o.w = pk2(s[6 * 65], s[7 * 65]);
        *(u32x4*)(d.WT + (size_t)(d.dr0 + n) * d.K + d.k0 + 8 * c) = o; }
    }
    asm volatile("s_waitcnt lgkmcnt(0)" ::: "memory");
}
__device__ __forceinline__ int win_src_col(int np, int& nvalid) {
    nvalid = 64;
    if (np < 3072) return np;
    if (np < 5120) return OFF_G + (np - 3072);
    if (np < 5376) return OFF_CQ + (np - 5120);
    if (np < 5504) return OFF_CKV + (np - 5376);
    if (np < 5568) return OFF_KR + (np - 5504);
    nvalid = 32; return OFF_I;
}

__device__ __forceinline__ void phase_prologue(const Params& p, LAS unsigned char* lds, int vcu, int G, int sub) {
#define SUBP(x) (sub == 0 || sub == (x))
    const int tid = threadIdx.x, lane = tid & 63, wave = tid >> 6;
    const int gw = vcu * 8 + wave, NGW = G * 8;
    LAS float* scr = (LAS float*)(lds + wave * 16640);
    if (SUBP(1)) for (int it = vcu; it < 88; it += G) {
        LAS float* um = (LAS float*)lds;
        LAS float* red = (LAS float*)(lds + 65536);
        __syncthreads();
        for (int j = wave * 2; j < wave * 2 + 2; ++j) {
            const float* src = p.meta + (size_t)j * DM; float4 v[4]; float ss = 0.f;
#pragma unroll
            for (int q = 0; q < 4; ++q) { v[q] = *(const float4*)(src + (q * 64 + lane) * 4); ss += v[q].x * v[q].x + v[q].y * v[q].y + v[q].z * v[q].z + v[q].w * v[q].w; }
            const float rstd = rsqrtf(wave_sum(ss) * (1.f / DM) + EPS);
#pragma unroll
            for (int q = 0; q < 4; ++q) { const int c = (q * 64 + lane) * 4; const float4 g = *(const float4*)(p.norm_mix + c);
                um[j * 1024 + c] = v[q].x * rstd * g.x; um[j * 1024 + c + 1] = v[q].y * rstd * g.y; um[j * 1024 + c + 2] = v[q].z * rstd * g.z; um[j * 1024 + c + 3] = v[q].w * rstd * g.w; }
        }
        __syncthreads();
        const int n = it * 64 + lane; const bool okn = n < DIN;
        float a[16];
#pragma unroll
        for (int j = 0; j < 16; ++j) a[j] = 0.f;
#pragma unroll 8
        for (int kk = 0; kk < 128; ++kk) { const int kq = wave * 128 + kk; const float w = okn ? p.w_in[(size_t)kq * DIN + n] : 0.f;
#pragma unroll
            for (int j = 0; j < 16; ++j) a[j] += um[j * 1024 + kq] * w; }
#pragma unroll
        for (int j = 0; j < 16; ++j) red[(wave * 16 + j) * 64 + lane] = a[j];
        __syncthreads();
        for (int o = tid; o < 1024; o += MK_THREADS) { const int j = o >> 6, nl = o & 63; float s = 0.f;
#pragma unroll
            for (int w8 = 0; w8 < 8; ++w8) s += red[(w8 * 16 + j) * 64 + nl];
            if (it * 64 + nl < DIN) p.ZM()[(size_t)j * DIN + it * 64 + nl] = s; }
        __syncthreads();
    }
    constexpr int I_INA = 16 * 40, I_INB = 16 * 48, I_IN = I_INA + I_INB, I_W1 = NEXP * 16 * 32, I_W2 = NEXP * 16 * 16, I_SQ = 16 * 16;
    constexpr int NITEMS = I_IN + I_W1 + I_W2 + 2 * I_SQ;
    auto decode = [&](int it, TrDesc& d) {
        int r = it;
        if (r < I_INA) { const int kb = r / 40, nb = r % 40, np = nb * 64, nl = np < 2048 ? np : np + 3072; int nv; const int sc = win_src_col(nl, nv); d = TrDesc{p.w_in, p.WinT(), DIN, DM, np, sc, nv, kb * 64, 0}; return; } r -= I_INA;
        if (r < I_INB) { const int kb = r / 48, nb = r % 48, np = nb * 64; int nv; const int sc = win_src_col(2048 + np, nv); d = TrDesc{p.w_in, (bf16_t*)p.WinT8(), DIN, DM, np, sc, nv, kb * 64, 1}; return; } r -= I_INB;
        if (r < I_W1) { const int e = r / 512, q = r % 512, kb = q / 32, nb = q % 32, np = nb * 64, pn = np >> 8, bj = (np >> 7) & 1, j = np & 127;
            d = TrDesc{p.w1 + (size_t)e * DM * 2048, (bf16_t*)((unsigned char*)p.W1T() + (size_t)e * 2048 * DM), 2048, DM, np, 1024 * bj + 128 * pn + j, 64, kb * 64, 1}; return; } r -= I_W1;
        if (r < I_W2) { const int e = r / 256, q = r % 256, kb = q / 16, nb = q % 16; d = TrDesc{p.w2 + (size_t)e * DFF * DM, (bf16_t*)((unsigned char*)p.W2T() + (size_t)e * DM * DFF), DM, DFF, nb * 64, nb * 64, 64, kb * 64, 1}; return; } r -= I_W2;
        if (r < I_SQ) { const int kb = r / 16, nb = r % 16; d = TrDesc{p.w_m_proj, p.WmT(), DM, DM, nb * 64, nb * 64, 64, kb * 64, 0}; return; } r -= I_SQ;
        { const int kb = r / 16, nb = r % 16; d = TrDesc{p.w_out, p.WoutT(), DM, DM, nb * 64, nb * 64, 64, kb * 64, 0}; }
    };
    if (SUBP(2)) {
        float4 va[16], vb[16]; TrDesc da, db; int it = gw;
        if (it < NITEMS) { decode(it, da); tr_load(da, va, lane); }
#pragma unroll 1
        while (it < NITEMS) {
            const int it1 = it + NGW; if (it1 < NITEMS) { decode(it1, db); tr_load(db, vb, lane); }
            tr_finish(da, va, scr, lane);
            if (it1 >= NITEMS) break;
            const int it2 = it1 + NGW; if (it2 < NITEMS) { decode(it2, da); tr_load(da, va, lane); }
            tr_finish(db, vb, scr, lane);
            it = it2;
        }
    }
    if (SUBP(3)) for (int r = gw * 4; r < NT; r += NGW * 4) {
        const float* s0 = p.x + (size_t)r * DM; float4 v[16];
#pragma unroll
        for (int q = 0; q < 4; ++q)
#pragma unroll
            for (int j = 0; j < 4; ++j) v[q * 4 + j] = ntld4(s0 + (size_t)q * DM + (j * 64 + lane) * 4);
        float rs[4];
#pragma unroll
        for (int q = 0; q < 4; ++q) { float s = 0.f;
#pragma unroll
            for (int j = 0; j < 4; ++j) { const float4 t = v[q * 4 + j]; s += t.x * t.x + t.y * t.y + t.z * t.z + t.w * t.w; }
            rs[q] = rsqrtf(wave_sum(s) * (1.f / DM) + EPS); }
#pragma unroll
        for (int j = 0; j < 4; ++j) { const int c = (j * 64 + lane) * 4; const float4 g = *(const float4*)(p.norm_mix + c);
#pragma unroll
            for (int q = 0; q < 4; ++q) { const float4 t = v[q * 4 + j]; const float rr = rs[q];
                const float u0 = t.x * rr * g.x, u1 = t.y * rr * g.y, u2 = t.z * rr * g.z, u3 = t.w * rr * g.w;
                u32x2 o; o.x = pk2(u0, u1); o.y = pk2(u2, u3); *(u32x2*)(p.U() + (size_t)(r + q) * DM + c) = o;
                *(unsigned*)(p.U8() + (size_t)(r + q) * DM + c) = pk4_fp8(u0, u1, u2, u3); } }
    }
    const long gid = (long)vcu * MK_THREADS + tid, gn = (long)G * MK_THREADS;
    if (SUBP(4)) for (long i = gid; i < (long)LTOT * 32; i += gn) {
        const int pos = (int)(i >> 5), f = (int)(i & 31);
        const float freq = powf(10000.f, -(float)f / 32.f), ang = (float)pos * freq; float s, c; sincosf(ang, &s, &c);
        p.ROPE()[i * 2] = c; p.ROPE()[i * 2 + 1] = s;
    }
    const int rot_wo = (vcu + 40) & 255;
    if (SUBP(5)) for (long i = (long)rot_wo * MK_THREADS + tid; i < 8L * 8 * 1024; i += gn) {
        const int n = (int)(i & 1023), hcg = __builtin_amdgcn_readfirstlane((int)(i >> 10)), h = hcg >> 3, c0 = (hcg & 7) * 16;
        const float* ap = p.w_a_proj + (size_t)(h * 128) * DM + n; const float* kv = p.a_w_ukv + ((size_t)c0 * 8 + h) * 256 + 128;
        float acc[16];
#pragma unroll
        for (int q = 0; q < 16; ++q) acc[q] = 0.f;
#pragma unroll 4
        for (int d = 0; d < 128; ++d) { const float b = ap[(size_t)d * DM];
#pragma unroll
            for (int q = 0; q < 16; ++q) acc[q] += kv[(size_t)q * 2048 + d] * b; }
        u32x4 o0, o1; o0.x = pk2(acc[0], acc[1]); o0.y = pk2(acc[2], acc[3]); o0.z = pk2(acc[4], acc[5]); o0.w = pk2(acc[6], acc[7]);
        o1.x = pk2(acc[8], acc[9]); o1.y = pk2(acc[10], acc[11]); o1.z = pk2(acc[12], acc[13]); o1.w = pk2(acc[14], acc[15]);
        bf16_t* dst = p.WoT() + (size_t)n * 1024 + h * 128 + c0; *(u32x4*)dst = o0; *(u32x4*)(dst + 8) = o1;
    }
    if (SUBP(6)) for (int t = ((vcu + 168) & 255) * 8 + wave; t < 8 * 128; t += NGW) {
        const int h = t >> 7, c = t & 127; const float2 kvv = *(const float2*)(p.a_w_ukv + ((size_t)c * 8 + h) * 256 + 2 * lane);
#pragma unroll 1
        for (int r0 = 0; r0 < 256; r0 += 64) { float keep = 0.f;
#pragma unroll 8
            for (int rr = 0; rr < 64; ++rr) { const float2 u = *(const float2*)(p.a_w_uq + ((size_t)(r0 + rr) * 8 + h) * 192 + 2 * lane);
                const float s = wave_sum(u.x * kvv.x + u.y * kvv.y); if (lane == rr) keep = s; }
            p.WqT()[(size_t)(h * 192 + c) * 256 + r0 + lane] = f2bf(keep * p.a_norm_q[r0 + lane]); }
    }
    if (SUBP(6)) for (long i = gid; i < 8L * 64 * 256; i += gn) {
        const int r = (int)(i & 255), hq = (int)(i >> 8), h = hq >> 6, q = hq & 63;
        p.WqT()[(size_t)(h * 192 + 128 + q) * 256 + r] = f2bf(p.a_w_uq[((size_t)r * 8 + h) * 192 + 128 + (q >> 1) + 32 * (q & 1)] * p.a_norm_q[r]);
    }
}

#undef SUBP
__device__ __forceinline__ void phase_kprep(const Params& p, int vcu, int G) {
    const int lane = threadIdx.x & 63, gw = vcu * 8 + (threadIdx.x >> 6), NGW = G * 8;
    const float gk0 = p.a_norm_kv[lane], gk1 = p.a_norm_kv[64 + lane];
    for (int r0 = gw * 4; r0 < NT; r0 += NGW * 4) {
        float c0[4], c1[4], x1[4], x2[4], cs[4], sn[4];
#pragma unroll
        for (int q = 0; q < 4; ++q) { const size_t r = (size_t)r0 + q; const int pos = NMETA + (int)(r & (SEQ - 1));
            c0[q] = p.CKV()[r * 128 + lane]; c1[q] = p.CKV()[r * 128 + 64 + lane];
            const int l32 = lane & 31; x1[q] = p.KR()[r * 64 + l32]; x2[q] = p.KR()[r * 64 + 32 + l32];
            const float2 t = *(const float2*)(p.ROPE() + ((size_t)pos * 32 + l32) * 2); cs[q] = t.x; sn[q] = t.y; }
#pragma unroll
        for (int q = 0; q < 4; ++q) { const size_t r = (size_t)r0 + q; const int b = (int)(r >> 12), key = (int)(r & (SEQ - 1));
            bf16_t* dst = p.Kc() + ((size_t)b * KVROWS + key) * 192;
            const float rstd = rsqrtf(wave_sum(c0[q] * c0[q] + c1[q] * c1[q]) * (1.f / 128.f) + EPS);
            dst[lane] = f2bf(c0[q] * rstd * gk0); dst[64 + lane] = f2bf(c1[q] * rstd * gk1);
            if (lane < 32) *(unsigned*)(dst + 128 + 2 * lane) = pk2(x1[q] * cs[q] - x2[q] * sn[q], x1[q] * sn[q] + x2[q] * cs[q]); }
    }
    for (int i = gw; i < NB * 64; i += NGW) {
        const int b = i >> 6, j = i & 63; bf16_t* dst = p.Kc() + ((size_t)b * KVROWS + SEQ + j) * 192;
        if (j >= NMETA) { dst[lane] = 0; dst[64 + lane] = 0; dst[128 + lane] = 0; continue; }
        const float* ckv = p.ZM() + (size_t)j * DIN + OFF_CKV; const float* kr = p.ZM() + (size_t)j * DIN + OFF_KR;
        const float c0 = ckv[lane], c1 = ckv[64 + lane];
        const float rstd = rsqrtf(wave_sum(c0 * c0 + c1 * c1) * (1.f / 128.f) + EPS);
        dst[lane] = f2bf(c0 * rstd * gk0); dst[64 + lane] = f2bf(c1 * rstd * gk1);
        if (lane < 32) { const float x1 = kr[lane], x2 = kr[32 + lane], cs = p.ROPE()[((size_t)j * 32 + lane) * 2], sn = p.ROPE()[((size_t)j * 32 + lane) * 2 + 1];
            *(unsigned*)(dst + 128 + 2 * lane) = pk2(x1 * cs - x2 * sn, x1 * sn + x2 * cs); }
    }
    for (int r0 = gw * 4; r0 < NT; r0 += NGW * 4) {
        float4 v[4];
#pragma unroll
        for (int q = 0; q < 4; ++q) v[q] = ntld4(p.CQ() + (size_t)(r0 + q) * 256 + lane * 4);
#pragma unroll
        for (int q = 0; q < 4; ++q) { u32x2 o; o.x = pk2(v[q].x, v[q].y); o.y = pk2(v[q].z, v[q].w);
            const float a = __uint_as_float(o.x << 16), b = __uint_as_float(o.x & 0xffff0000u), c = __uint_as_float(o.y << 16), d = __uint_as_float(o.y & 0xffff0000u);
            const float ss = wave_sum(a * a + b * b + c * c + d * d);
            *(u32x2*)(p.CQb() + (size_t)(r0 + q) * 256 + lane * 4) = o;
            if (lane == 0) p.RSQ()[r0 + q] = rsqrtf(ss * (1.f / 256.f) + EPS); }
    }
}

__device__ __forceinline__ void moe_tile_table(const Params& p, volatile LAS int* tst) {
    __syncthreads();
    if (threadIdx.x == 0) { int s = 0; for (int e = 0; e < NEXP; ++e) { tst[e] = s; s += (p.CNT()[e * CNT_STRIDE] + 255) / 256; } tst[NEXP] = s; }
    __syncthreads();
}

namespace att {
using s16x4 = __attribute__((ext_vector_type(4))) short;
using f32x16 = __attribute__((ext_vector_type(16))) float;
constexpr int KN_B = 16384, KR_B = 8192, V_B = 16384;
constexpr int L_KN = 0, L_KR = 2 * KN_B, L_WS = L_KR + 2 * KR_B, L_QR = L_WS + 8 * 256, L_END = L_QR + 8 * 4096;
constexpr float THR = 8.f;
#define KSWZ(row, colB) ((row) * 256 + ((colB) ^ (((((row) & 3) << 2) | (((row) >> 2) & 3)) << 4)))
#define RSWZ(row, colB) ((row) * 128 + ((colB) ^ ((((row) >> 1) & 7) << 4)))
#define SBAR() __builtin_amdgcn_sched_barrier(0)
__device__ __forceinline__ int crow(int r, int hi) { return (r & 3) + 8 * (r >> 2) + 4 * hi; }
__device__ __forceinline__ unsigned cvtpk(float lo, float hi) { unsigned r; asm volatile("v_cvt_pk_bf16_f32 %0, %1, %2" : "=v"(r) : "v"(lo), "v"(hi)); return r; }

__device__ __forceinline__ void partialSM(f32x16& p0, f32x16& p1, float& m_reg, float& alpha) {
    float pmax = p0[0];
#pragma unroll
    for (int r = 1; r < 16; ++r) pmax = fmaxf(pmax, p0[r]);
#pragma unroll
    for (int r = 0; r < 16; ++r) pmax = fmaxf(pmax, p1[r]);
    { auto rr = __builtin_amdgcn_permlane32_swap(__float_as_uint(pmax), __float_as_uint(pmax), false, false);
      pmax = fmaxf(__uint_as_float(rr[0]), __uint_as_float(rr[1])); }
    float mn;
    if (__builtin_expect(__all(pmax - m_reg <= THR), 1)) { mn = m_reg; alpha = 1.f; }
    else { mn = fmaxf(m_reg, pmax); alpha = __builtin_amdgcn_exp2f(m_reg - mn); m_reg = mn; }
#pragma unroll
    for (int r = 0; r < 16; ++r) p0[r] = p0[r] - mn;
#pragma unroll
    for (int r = 0; r < 16; ++r) p1[r] = p1[r] - mn;
#pragma unroll
    for (int r = 0; r < 16; ++r) p0[r] = __builtin_amdgcn_exp2f(p0[r]);
}
__device__ __forceinline__ void finishSM(f32x16& p0, f32x16& p1, float alpha, float& l_reg, bf16x8& pa0, bf16x8& pa1, bf16x8& pa2, bf16x8& pa3) {
#pragma unroll
    for (int r = 0; r < 16; ++r) p1[r] = __builtin_amdgcn_exp2f(p1[r]);
    float ps = 0;
#pragma unroll
    for (int r = 0; r < 16; ++r) ps += p0[r];
#pragma unroll
    for (int r = 0; r < 16; ++r) ps += p1[r];
    { auto rr = __builtin_amdgcn_permlane32_swap(__float_as_uint(ps), __float_as_uint(ps), false, false);
      ps = __uint_as_float(rr[0]) + __uint_as_float(rr[1]); }
    l_reg = l_reg * alpha + ps;
#define PK4(P, BASE, OUT) do { unsigned a0 = cvtpk(P[BASE + 0], P[BASE + 1]), a1 = cvtpk(P[BASE + 2], P[BASE + 3]);   \
    unsigned b0 = cvtpk(P[BASE + 4], P[BASE + 5]), b1 = cvtpk(P[BASE + 6], P[BASE + 7]);                              \
    auto r0 = __builtin_amdgcn_permlane32_swap(a0, b0, false, false); auto r1 = __builtin_amdgcn_permlane32_swap(a1, b1, false, false); \
    u32x4 w = {r0[0], r1[0], r0[1], r1[1]}; OUT = *reinterpret_cast<bf16x8*>(&w); } while (0)
    PK4(p0, 0, pa0); PK4(p0, 8, pa1); PK4(p1, 0, pa2); PK4(p1, 8, pa3);
#undef PK4
}
__device__ __forceinline__ void qkt(f32x16& p0, f32x16& p1, const char* Kn, const char* Kr, const bf16x8* qr, const char* qrl, int r32, int hi) {
    p0 = f32x16{}; p1 = f32x16{};
#pragma unroll
    for (int d0 = 0; d0 < 8; ++d0) { const int cb = (d0 * 16 + hi * 8) * 2;
        const bf16x8 b0 = *reinterpret_cast<const bf16x8*>(Kn + KSWZ(r32, cb));
        const bf16x8 b1 = *reinterpret_cast<const bf16x8*>(Kn + KSWZ(32 + r32, cb));
        p0 = __builtin_amdgcn_mfma_f32_32x32x16_bf16(b0, qr[d0], p0, 0, 0, 0);
        p1 = __builtin_amdgcn_mfma_f32_32x32x16_bf16(b1, qr[d0], p1, 0, 0, 0); }
#pragma unroll
    for (int d0 = 0; d0 < 4; ++d0) { const int cb = (d0 * 16 + hi * 8) * 2;
        const bf16x8 b0 = *reinterpret_cast<const bf16x8*>(Kr + RSWZ(r32, cb));
        const bf16x8 b1 = *reinterpret_cast<const bf16x8*>(Kr + RSWZ(32 + r32, cb));
        const bf16x8 qf = *reinterpret_cast<const bf16x8*>(qrl + d0 * 1024);
        p0 = __builtin_amdgcn_mfma_f32_32x32x16_bf16(b0, qf, p0, 0, 0, 0);
        p1 = __builtin_amdgcn_mfma_f32_32x32x16_bf16(b1, qf, p1, 0, 0, 0); }
}
__device__ __forceinline__ int v_st(int k, int c) { const int kk = (k & ~0xC) | ((k & 4) << 1) | ((k & 8) >> 1); return ((kk >> 3) * 4 + (c >> 5)) * 512 + ((kk & 7) * 32 + (c & 31)) * 2; }
__device__ __forceinline__ int v_rd_base(int lane) { return ((lane & 3) << 3) | (((lane >> 2) & 3) << 6) | (((lane >> 4) & 1) << 5) | (((lane >> 5) & 1) << 8); }
constexpr int v_rd_off(int d0, int ks, int half) { return d0 * 512 + ks * 4096 + half * 2048; }
template <int OFF> __device__ __forceinline__ s16x4 tr_read(int vb) { s16x4 r; asm volatile("ds_read_b64_tr_b16 %0, %1 offset:%2" : "=&v"(r) : "v"(vb), "i"(OFF) : "memory"); return r; }
template <int C> __device__ __forceinline__ void pv_one(f32x16& od, int bt0, int bt1, bf16x8 pa0, bf16x8 pa1, bf16x8 pa2, bf16x8 pa3) {
    const int a0 = bt0 ^ (C << 6), a1 = bt1 ^ (C << 6);
    const s16x4 l0 = tr_read<0>(a0), h0 = tr_read<0>(a1), l1 = tr_read<4096>(a0), h1 = tr_read<4096>(a1);
    const s16x4 l2 = tr_read<8192>(a0), h2 = tr_read<8192>(a1), l3 = tr_read<12288>(a0), h3 = tr_read<12288>(a1);
    asm volatile("s_waitcnt lgkmcnt(0)" ::: "memory"); SBAR();
#define PK(L, H) (bf16x8){L[0], L[1], L[2], L[3], H[0], H[1], H[2], H[3]}
    od = __builtin_amdgcn_mfma_f32_32x32x16_bf16(pa0, PK(l0, h0), od, 0, 0, 0);
    od = __builtin_amdgcn_mfma_f32_32x32x16_bf16(pa1, PK(l1, h1), od, 0, 0, 0);
    od = __builtin_amdgcn_mfma_f32_32x32x16_bf16(pa2, PK(l2, h2), od, 0, 0, 0);
    od = __builtin_amdgcn_mfma_f32_32x32x16_bf16(pa3, PK(l3, h3), od, 0, 0, 0);
#undef PK
}
__device__ __forceinline__ void pv_d0(f32x16* o, int bt0, int bt1, bf16x8 pa0, bf16x8 pa1, bf16x8 pa2, bf16x8 pa3) {
    pv_one<0>(o[0], bt0, bt1, pa0, pa1, pa2, pa3); pv_one<1>(o[1], bt0, bt1, pa0, pa1, pa2, pa3); pv_one<2>(o[2], bt0, bt1, pa0, pa1, pa2, pa3); pv_one<3>(o[3], bt0, bt1, pa0, pa1, pa2, pa3);
}
__device__ __forceinline__ int tr_base(int lane, int t) {
    const int h = lane >> 5, blk = (lane >> 4) & 1, q = (lane & 15) >> 2, p = lane & 3, row = 8 * h + 4 * t + q, ch = 2 * blk + (p >> 1);
    return KSWZ(row, ch * 16) + 8 * (p & 1);
}

__device__ __forceinline__ void attn_unit(const bf16_t* __restrict__ Qb, const bf16_t* __restrict__ Kb, bf16_t* __restrict__ Ob, char* lds) {
    const int tid = threadIdx.x, wid = tid >> 6, lane = tid & 63, r32 = lane & 31, hi = lane >> 5;
    char* Kn_l = lds + L_KN; char* Kr_l = lds + L_KR;
    float* ws = (float*)(lds + L_WS) + wid * 64; float* li_l = ws; float* al_l = ws + 32;
    float m_reg = -1e30f, l_reg = 0; f32x16 o[4] = {}; bf16x8 qr[8];
    const bf16_t* Qw = Qb + (size_t)(wid * 32 + r32) * 1536 + hi * 8;
    char* qrl = lds + L_QR + wid * 4096 + lane * 16;
#pragma unroll
    for (int d0 = 0; d0 < 8; ++d0) qr[d0] = *reinterpret_cast<const bf16x8*>(Qw + d0 * 16);
#pragma unroll
    for (int d0 = 0; d0 < 4; ++d0) *reinterpret_cast<bf16x8*>(qrl + d0 * 1024) = *reinterpret_cast<const bf16x8*>(Qw + (8 + d0) * 16);
    const int sr = tid >> 3, sc8 = tid & 7;
    const int kst0 = KSWZ(sr, sc8 * 16), kst1 = KSWZ(sr, 128 + sc8 * 16), rst = RSWZ(sr, sc8 * 16);
    const int bt0 = (int)(uintptr_t)Kn_l + tr_base(lane, 0), bt1 = (int)(uintptr_t)Kn_l + tr_base(lane, 1);
    bf16x8 s0, s1, s2;
#define SLOAD(mt) do { const bf16_t* kp = Kb + (size_t)((mt) * 64 + sr) * 192 + sc8 * 8; s0 = *reinterpret_cast<const bf16x8*>(kp); s1 = *reinterpret_cast<const bf16x8*>(kp + 64); s2 = *reinterpret_cast<const bf16x8*>(kp + 128); } while (0)
#define SWRITE(b) do { *(bf16x8*)(Kn_l + (b) * KN_B + kst0) = s0; *(bf16x8*)(Kn_l + (b) * KN_B + kst1) = s1; *(bf16x8*)(Kr_l + (b) * KR_B + rst) = s2; } while (0)
#define RESC(a) do { if (__any((a) < 1.f)) { if (hi == 0) al_l[r32] = (a); asm volatile("s_waitcnt lgkmcnt(0)" ::: "memory"); \
        _Pragma("unroll") for (int d = 0; d < 4; ++d) _Pragma("unroll") for (int r = 0; r < 16; ++r) o[d][r] *= al_l[crow(r, hi)]; } } while (0)
    f32x16 pA0, pA1, pB0, pB1; float alA, alB; bf16x8 pa0, pa1, pa2, pa3;
    constexpr int NTL = 65;
    SLOAD(64); asm volatile("s_waitcnt vmcnt(0)" ::: "memory"); SWRITE(0); __syncthreads();
    qkt(pA0, pA1, Kn_l, Kr_l, qr, qrl, r32, hi);
#pragma unroll
    for (int r = 8; r < 16; ++r) pA0[r] = -1e30f;
#pragma unroll
    for (int r = 0; r < 16; ++r) pA1[r] = -1e30f;
    partialSM(pA0, pA1, m_reg, alA);
    SLOAD(0); asm volatile("s_waitcnt vmcnt(0)" ::: "memory"); SWRITE(1); __syncthreads();
#pragma unroll 1
    for (int j = 1; j + 1 < NTL; j += 2) {
        SBAR(); qkt(pB0, pB1, Kn_l + KN_B, Kr_l + KR_B, qr, qrl, r32, hi);
        finishSM(pA0, pA1, alA, l_reg, pa0, pa1, pa2, pa3); SBAR();
        SLOAD(j); SBAR();
        pv_d0(o, bt0, bt1, pa0, pa1, pa2, pa3); partialSM(pB0, pB1, m_reg, alB);
        __syncthreads(); asm volatile("s_waitcnt vmcnt(0)" ::: "memory"); SWRITE(0);
        RESC(alB); __syncthreads();
        SBAR(); qkt(pA0, pA1, Kn_l, Kr_l, qr, qrl, r32, hi);
        finishSM(pB0, pB1, alB, l_reg, pa0, pa1, pa2, pa3); SBAR();
        if (j + 2 < NTL) SLOAD(j + 1); SBAR();
        pv_d0(o, bt0 + KN_B, bt1 + KN_B, pa0, pa1, pa2, pa3); partialSM(pA0, pA1, m_reg, alA);
        __syncthreads(); asm volatile("s_waitcnt vmcnt(0)" ::: "memory"); if (j + 2 < NTL) SWRITE(1);
        RESC(alA); __syncthreads();
    }
    finishSM(pA0, pA1, alA, l_reg, pa0, pa1, pa2, pa3); SBAR();
    pv_d0(o, bt0, bt1, pa0, pa1, pa2, pa3);
    if (hi == 0) li_l[r32] = l_reg; asm volatile("s_waitcnt lgkmcnt(0)" ::: "memory");
    float rli[16];
#pragma unroll
    for (int r = 0; r < 16; ++r) rli[r] = __builtin_amdgcn_rcpf(li_l[crow(r, hi)]);
    __syncthreads();
    { bf16_t* stg = (bf16_t*)(lds + wid * 8192);
#pragma unroll
      for (int r = 0; r < 16; ++r) { const int orow = crow(r, hi);
#pragma unroll
          for (int d0 = 0; d0 < 4; ++d0) stg[orow * 128 + d0 * 32 + r32] = f2bf(o[d0][r] * rli[r]); }
      asm volatile("s_waitcnt lgkmcnt(0)" ::: "memory");
      bf16_t* Ow = Ob + (size_t)(wid * 32 + (lane >> 4)) * 1024 + (lane & 15) * 8; const bf16_t* sr_ = stg + (lane >> 4) * 128 + (lane & 15) * 8;
#pragma unroll 2
      for (int i = 0; i < 8; ++i) { *(u32x4*)(Ow + (size_t)i * 4096) = *(const u32x4*)(sr_ + i * 512); } }
    __syncthreads();
#undef SLOAD
#undef SWRITE
#undef RESC
}
#undef KSWZ
#undef RSWZ
#undef SBAR
}

__device__ __forceinline__ void phase_attn(const Params& p, char* lds, int vcu, int G) {
    if (__builtin_amdgcn_readfirstlane((int)threadIdx.x) >= 256) __builtin_amdgcn_s_setprio(1);
    for (int u = vcu; u < NB * 8 * 16; u += G) {
        const int b = u >> 7, h = (u >> 4) & 7, qb = u & 15;
        const size_t r0 = (size_t)b * SEQ + qb * 256;
        att::attn_unit(p.QP() + r0 * 1536 + h * 192, p.Kc() + (size_t)b * KVROWS * 192, p.OA() + r0 * 1024 + h * 128, lds);
    }
    __builtin_amdgcn_s_setprio(0);
}

namespace ml {
using att::s16x4; using att::f32x16; using att::crow; using att::cvtpk; using att::v_st; using att::v_rd_base; using att::tr_read; using att::v_rd_off;
#define RSWZ(row, colB) ((row) * 128 + ((colB) ^ ((((row) >> 1) & 7) << 4)))
#define SBAR() __builtin_amdgcn_sched_barrier(0)
__device__ __forceinline__ void pv_blk(f32x16& od, int vb, bf16x8 pa0, bf16x8 pa1, bf16x8 pa2, bf16x8 pa3) {
    const s16x4 l0 = tr_read<v_rd_off(0, 0, 0)>(vb), h0 = tr_read<v_rd_off(0, 0, 1)>(vb), l1 = tr_read<v_rd_off(0, 1, 0)>(vb), h1 = tr_read<v_rd_off(0, 1, 1)>(vb);
    const s16x4 l2 = tr_read<v_rd_off(0, 2, 0)>(vb), h2 = tr_read<v_rd_off(0, 2, 1)>(vb), l3 = tr_read<v_rd_off(0, 3, 0)>(vb), h3 = tr_read<v_rd_off(0, 3, 1)>(vb);
    asm volatile("s_waitcnt lgkmcnt(0)" ::: "memory"); SBAR();
#define PK(L, H) (bf16x8){L[0], L[1], L[2], L[3], H[0], H[1], H[2], H[3]}
    od = __builtin_amdgcn_mfma_f32_32x32x16_bf16(pa0, PK(l0, h0), od, 0, 0, 0);
    od = __builtin_amdgcn_mfma_f32_32x32x16_bf16(pa1, PK(l1, h1), od, 0, 0, 0);
    od = __builtin_amdgcn_mfma_f32_32x32x16_bf16(pa2, PK(l2, h2), od, 0, 0, 0);
    od = __builtin_amdgcn_mfma_f32_32x32x16_bf16(pa3, PK(l3, h3), od, 0, 0, 0);
}
template <int KS0> __device__ __forceinline__ void pv_blk2(f32x16& od, int vb, bf16x8 pa, bf16x8 pb) {
    const s16x4 l0 = tr_read<v_rd_off(0, KS0, 0)>(vb), h0 = tr_read<v_rd_off(0, KS0, 1)>(vb), l1 = tr_read<v_rd_off(0, KS0 + 1, 0)>(vb), h1 = tr_read<v_rd_off(0, KS0 + 1, 1)>(vb);
    asm volatile("s_waitcnt lgkmcnt(0)" ::: "memory"); SBAR();
    od = __builtin_amdgcn_mfma_f32_32x32x16_bf16(pa, PK(l0, h0), od, 0, 0, 0);
    od = __builtin_amdgcn_mfma_f32_32x32x16_bf16(pb, PK(l1, h1), od, 0, 0, 0);
}
__device__ __forceinline__ void tt_blk(f32x16& od, int va, int vb) {
    const s16x4 al0 = tr_read<v_rd_off(0, 0, 0)>(va), ah0 = tr_read<v_rd_off(0, 0, 1)>(va), al1 = tr_read<v_rd_off(0, 1, 0)>(va), ah1 = tr_read<v_rd_off(0, 1, 1)>(va);
    const s16x4 al2 = tr_read<v_rd_off(0, 2, 0)>(va), ah2 = tr_read<v_rd_off(0, 2, 1)>(va), al3 = tr_read<v_rd_off(0, 3, 0)>(va), ah3 = tr_read<v_rd_off(0, 3, 1)>(va);
    const s16x4 l0 = tr_read<v_rd_off(0, 0, 0)>(vb), h0 = tr_read<v_rd_off(0, 0, 1)>(vb), l1 = tr_read<v_rd_off(0, 1, 0)>(vb), h1 = tr_read<v_rd_off(0, 1, 1)>(vb);
    const s16x4 l2 = tr_read<v_rd_off(0, 2, 0)>(vb), h2 = tr_read<v_rd_off(0, 2, 1)>(vb), l3 = tr_read<v_rd_off(0, 3, 0)>(vb), h3 = tr_read<v_rd_off(0, 3, 1)>(vb);
    asm volatile("s_waitcnt lgkmcnt(0)" ::: "memory"); SBAR();
    od = __builtin_amdgcn_mfma_f32_32x32x16_bf16(PK(al0, ah0), PK(l0, h0), od, 0, 0, 0);
    od = __builtin_amdgcn_mfma_f32_32x32x16_bf16(PK(al1, ah1), PK(l1, h1), od, 0, 0, 0);
    od = __builtin_amdgcn_mfma_f32_32x32x16_bf16(PK(al2, ah2), PK(l2, h2), od, 0, 0, 0);
    od = __builtin_amdgcn_mfma_f32_32x32x16_bf16(PK(al3, ah3), PK(l3, h3), od, 0, 0, 0);
#undef PK
}
#define PK4(P, BASE, OUT) do { unsigned a0 = cvtpk(P[BASE + 0], P[BASE + 1]), a1 = cvtpk(P[BASE + 2], P[BASE + 3]);   \
    unsigned b0 = cvtpk(P[BASE + 4], P[BASE + 5]), b1 = cvtpk(P[BASE + 6], P[BASE + 7]);                              \
    auto r0 = __builtin_amdgcn_permlane32_swap(a0, b0, false, false); auto r1 = __builtin_amdgcn_permlane32_swap(a1, b1, false, false); \
    u32x4 w = {r0[0], r1[0], r0[1], r1[1]}; OUT = *reinterpret_cast<bf16x8*>(&w); } while (0)
__device__ __forceinline__ float half_swap_add(float v) { auto rr = __builtin_amdgcn_permlane32_swap(__float_as_uint(v), __float_as_uint(v), false, false); return __uint_as_float(rr[0]) + __uint_as_float(rr[1]); }
__device__ __forceinline__ bf16x8 scale8(bf16x8 v, float s) {
    const u32x4 w = *reinterpret_cast<const u32x4*>(&v); u32x4 o;
    o.x = cvtpk(__uint_as_float(w.x << 16) * s, __uint_as_float(w.x & 0xffff0000u) * s); o.y = cvtpk(__uint_as_float(w.y << 16) * s, __uint_as_float(w.y & 0xffff0000u) * s);
    o.z = cvtpk(__uint_as_float(w.z << 16) * s, __uint_as_float(w.z & 0xffff0000u) * s); o.w = cvtpk(__uint_as_float(w.w << 16) * s, __uint_as_float(w.w & 0xffff0000u) * s);
    return *reinterpret_cast<bf16x8*>(&o);
}
__device__ __forceinline__ bf16x8 f8_to_bf(const float* p, bool ok) {
    if (!ok) return (bf16x8){0, 0, 0, 0, 0, 0, 0, 0};
    const f32x4 a = *(const f32x4*)p, b = *(const f32x4*)(p + 4); u32x4 o = {cvtpk(a[0], a[1]), cvtpk(a[2], a[3]), cvtpk(b[0], b[1]), cvtpk(b[2], b[3])};
    return *reinterpret_cast<bf16x8*>(&o);
}
template <int K> __device__ __forceinline__ float dpp_shr(float v, float ident) {
    return __int_as_float(__builtin_amdgcn_update_dpp(__float_as_int(ident), __float_as_int(v), 0x110 | K, 0xf, 0xf, false));
}
__device__ __forceinline__ float rdlane(float v, int l) { return __int_as_float(__builtin_amdgcn_readlane(__float_as_int(v), l)); }
__device__ __forceinline__ float wave_incl_sum(float v, int lane) {
    v += dpp_shr<1>(v, 0.f); v += dpp_shr<2>(v, 0.f); v += dpp_shr<4>(v, 0.f); v += dpp_shr<8>(v, 0.f);
    const float s0 = rdlane(v, 15), s1 = rdlane(v, 31), s2 = rdlane(v, 47); const int row = lane >> 4;
    return v + (row >= 1 ? s0 : 0.f) + (row >= 2 ? s1 : 0.f) + (row >= 3 ? s2 : 0.f);
}
__device__ __forceinline__ float wave_incl_max(float v, int lane) {
    const float NI = -3.0e38f;
    v = fmaxf(v, dpp_shr<1>(v, NI)); v = fmaxf(v, dpp_shr<2>(v, NI)); v = fmaxf(v, dpp_shr<4>(v, NI)); v = fmaxf(v, dpp_shr<8>(v, NI));
    const float s0 = rdlane(v, 15), s1 = rdlane(v, 31), s2 = rdlane(v, 47); const int row = lane >> 4;
    return fmaxf(fmaxf(v, row >= 1 ? s0 : NI), fmaxf(row >= 2 ? s1 : NI, row >= 3 ? s2 : NI));
}
__device__ __forceinline__ float wave_max(float v) {
    const float NI = -3.0e38f;
    v = fmaxf(v, dpp_shr<1>(v, NI)); v = fmaxf(v, dpp_shr<2>(v, NI)); v = fmaxf(v, dpp_shr<4>(v, NI)); v = fmaxf(v, dpp_shr<8>(v, NI));
    return fmaxf(fmaxf(rdlane(v, 15), rdlane(v, 31)), fmaxf(rdlane(v, 47), rdlane(v, 63)));
}

constexpr int SC_BUF = 32768;
__device__ __forceinline__ void scan_unit(const Params& p, int b, int h, int dir, char* lds) {
    const int tid = threadIdx.x, wid = tid >> 6, lane = tid & 63, r32 = lane & 31, hi = lane >> 5, db = wid & 1, vq = wid >> 1;
    const int sr = tid >> 3, sc8 = tid & 7;
    const int kst = v_st(sr, sc8 * 8), vst0 = v_st(sr, sc8 * 8), vst1 = v_st(sr, 64 + sc8 * 8);
    const int va0 = (int)(uintptr_t)lds + v_rd_base(lane) + db * 512, vb0 = (int)(uintptr_t)lds + 16384 + v_rd_base(lane) + vq * 512;
    bf16_t* CS = dir ? p.CB() : p.CF(); float* NS = dir ? p.NB_() : p.NF(); float* MS = dir ? p.MB() : p.MF();
    const size_t sbase = (size_t)(b * 8 + h) * 64;
    f32x16 acc = {}; float nacc = 0.f, m = 0.f, decay_prev = 1.f;
    const int nsteps = dir ? 64 : 65;
    bf16x8 sk, sv0, sv1; float gli, glf;
#define ML_LOAD(st) do { const int c_ = dir ? 63 - (st) : (st) - 1; \
        if (c_ < 0) { const float* z = p.ZM() + (size_t)(sr & 15) * DIN; const bool okr = sr < NMETA; \
            sk = f8_to_bf(z + OFF_K + h * 64 + sc8 * 8, okr); sv0 = f8_to_bf(z + OFF_V + h * 128 + sc8 * 8, okr); sv1 = f8_to_bf(z + OFF_V + h * 128 + 64 + sc8 * 8, okr); \
            const float* zl = p.ZM() + (size_t)(lane & 15) * DIN; gli = lane < NMETA ? zl[OFF_I + h] + p.m_b_i[h] : -1e30f; glf = lane < NMETA ? logsigmoidf_(zl[OFF_F + h] + p.m_b_f[h]) : 0.f; } \
        else { const size_t r_ = (size_t)b * SEQ + c_ * 64 + sr; sk = *reinterpret_cast<const bf16x8*>(p.Km() + r_ * 512 + h * 64 + sc8 * 8); \
            sv0 = *reinterpret_cast<const bf16x8*>(p.Vm() + r_ * 1024 + h * 128 + sc8 * 8); sv1 = *reinterpret_cast<const bf16x8*>(p.Vm() + r_ * 1024 + h * 128 + 64 + sc8 * 8); \
            const size_t rg = (size_t)b * SEQ + c_ * 64 + (dir ? 63 - lane : lane); gli = p.GI()[rg * 16 + dir * 8 + h]; glf = p.GF()[rg * 16 + dir * 8 + h]; } } while (0)
#define ML_GATES(decay_, mnew_, wk_) do { const float bc_ = wave_incl_sum(glf, lane); const float bl_ = rdlane(bc_, 63); const float g_ = bl_ - bc_ + gli; \
        mnew_ = fmaxf(bl_ + m, wave_max(g_)); decay_ = __expf(bl_ + m - mnew_); wk_ = __expf(g_ - mnew_); } while (0)
    ML_LOAD(0);
    float decay, mnew, wk;
    { asm volatile("s_waitcnt vmcnt(0)" ::: "memory"); ML_GATES(decay, mnew, wk);
      const float w = __shfl(wk, dir ? 63 - sr : sr);
      *(bf16x8*)(lds + kst) = sk; *(bf16x8*)(lds + 16384 + vst0) = scale8(sv0, w); *(bf16x8*)(lds + 16384 + vst1) = scale8(sv1, w); }
    __syncthreads();
#pragma unroll 1
    for (int st = 0; st < nsteps; ++st) {
        const int c = dir ? 63 - st : st - 1, buf = st & 1;
        if (wid == 0 && st > 0) { float s_ = 0.f; const float* np_ = (const float*)(lds + 65536) + ((st - 1) & 1) * 512;
#pragma unroll
            for (int w8 = 0; w8 < 8; ++w8) s_ += np_[w8 * 64 + lane];
            nacc = nacc * decay_prev + s_; }
        if (c >= 0) {
            const size_t sidx = sbase + c; bf16_t* cd = CS + sidx * 8192 + (size_t)(db * 32) * 128 + vq * 32 + r32;
#pragma unroll
            for (int r = 0; r < 16; ++r) cd[(size_t)crow(r, hi) * 128] = f2bf(acc[r]);
            if (wid == 0) NS[sidx * 64 + lane] = nacc;
            if (tid == 0) MS[sidx] = m;
        }
        if (st == nsteps - 1) break;
        if (st + 1 < nsteps - 1) ML_LOAD(st + 1);
#pragma unroll
        for (int r = 0; r < 16; ++r) acc[r] *= decay;
        tt_blk(acc, va0 + buf * SC_BUF, vb0 + buf * SC_BUF);
        {
            float s_ = 0.f;
#pragma unroll
            for (int q = 0; q < 8; ++q) { const int s = wid * 8 + q; const float w = __shfl(wk, dir ? 63 - s : s); s_ += w * bf2f(*(const bf16_t*)(lds + buf * SC_BUF + v_st(s, lane))); }
            ((float*)(lds + 65536))[(st & 1) * 512 + wid * 64 + lane] = s_;
        }
        decay_prev = decay;
        m = mnew;
        if (st + 1 < nsteps - 1) {
            asm volatile("s_waitcnt vmcnt(0)" ::: "memory"); ML_GATES(decay, mnew, wk);
            const float w = __shfl(wk, dir ? 63 - sr : sr); char* lb = lds + (buf ^ 1) * SC_BUF;
            *(bf16x8*)(lb + kst) = sk; *(bf16x8*)(lb + 16384 + vst0) = scale8(sv0, w); *(bf16x8*)(lb + 16384 + vst1) = scale8(sv1, w);
        }
        __syncthreads();
    }
    __syncthreads();
#undef ML_LOAD
#undef ML_GATES
}

constexpr int O_K = 0, O_V = 8192, O_CF = 24576, O_CB = 40960, O_T = 57344, O_ARR = 122880, O_WS = 125440, O_END = 127488;
struct OutPre { bf16x8 kk, v0, v1, f0, f1, b0, b1, q0, q1, q2, q3; float li, lf, mm, nn; };
__device__ __forceinline__ void out_load(const Params& p, int u, OutPre& R) {
    const int tid = threadIdx.x, wid = tid >> 6, lane = tid & 63, r32 = lane & 31, hi = lane >> 5, tb = wid & 1;
    const int b = u >> 9, h = u & 7, c = (u >> 3) & 63; const size_t r0 = (size_t)b * SEQ + c * 64, sidx = (size_t)(b * 8 + h) * 64 + c;
    const int sr = tid >> 3, sc8 = tid & 7;
    R.kk = *reinterpret_cast<const bf16x8*>(p.Km() + (r0 + sr) * 512 + h * 64 + sc8 * 8);
    const bf16_t* vp = p.Vm() + (r0 + sr) * 1024 + h * 128 + sc8 * 8; R.v0 = *reinterpret_cast<const bf16x8*>(vp); R.v1 = *reinterpret_cast<const bf16x8*>(vp + 64);
    const bf16_t* cf = p.CF() + sidx * 8192 + (size_t)sr * 128 + sc8 * 8; R.f0 = *reinterpret_cast<const bf16x8*>(cf); R.f1 = *reinterpret_cast<const bf16x8*>(cf + 64);
    const bf16_t* cb = p.CB() + sidx * 8192 + (size_t)sr * 128 + sc8 * 8; R.b0 = *reinterpret_cast<const bf16x8*>(cb); R.b1 = *reinterpret_cast<const bf16x8*>(cb + 64);
    const bf16_t* qp = p.Qm() + (r0 + tb * 32 + r32) * 512 + h * 64 + hi * 8;
    R.q0 = *reinterpret_cast<const bf16x8*>(qp); R.q1 = *reinterpret_cast<const bf16x8*>(qp + 16); R.q2 = *reinterpret_cast<const bf16x8*>(qp + 32); R.q3 = *reinterpret_cast<const bf16x8*>(qp + 48);
    R.li = 0.f; R.lf = 0.f; R.mm = 0.f; R.nn = 0.f;
    if (wid < 2) { const int dir = wid, t = dir ? 63 - lane : lane; R.li = p.GI()[(r0 + t) * 16 + dir * 8 + h]; R.lf = p.GF()[(r0 + t) * 16 + dir * 8 + h]; R.mm = (dir ? p.MB() : p.MF())[sidx]; }
    else if (wid < 4) { const int dir = wid - 2; R.nn = (dir ? p.NB_() : p.NF())[sidx * 64 + lane]; }
}
__device__ __forceinline__ void phase_mlstm_out_body(const Params& p, char* lds, int vcu, int G) {
    const int tid = threadIdx.x, wid = tid >> 6, lane = tid & 63, r32 = lane & 31, hi = lane >> 5, tb = wid & 1, vq = wid >> 1;
    const int sr = tid >> 3, sc8 = tid & 7;
    float* arr = (float*)(lds + O_ARR);
    float* nbuf = arr + 512;
    float* wsc = (float*)(lds + O_WS) + wid * 64;
    const int NU = NB * 8 * 64;
    OutPre R;
    if (vcu < NU) out_load(p, vcu, R);
#pragma unroll 1
    for (int u = vcu; u < NU; u += G) {
        const int b = u >> 9, h = u & 7, c = (u >> 3) & 63; const size_t r0 = (size_t)b * SEQ + c * 64;
        { *(bf16x8*)(lds + O_K + RSWZ(sr, sc8 * 16)) = R.kk;
          const int s0 = v_st(sr, sc8 * 8), s1 = v_st(sr, 64 + sc8 * 8);
          *(bf16x8*)(lds + O_V + s0) = R.v0; *(bf16x8*)(lds + O_V + s1) = R.v1; *(bf16x8*)(lds + O_CF + s0) = R.f0; *(bf16x8*)(lds + O_CF + s1) = R.f1; *(bf16x8*)(lds + O_CB + s0) = R.b0; *(bf16x8*)(lds + O_CB + s1) = R.b1; }
        if (wid < 2) {
            const int dir = wid, t = dir ? 63 - lane : lane; const float m = R.mm;
            const float bc = wave_incl_sum(R.lf, lane), a = R.li - bc, pm = wave_incl_max(a, lane), mx = fmaxf(m, pm);
            float* ar = arr + dir * 256;
            ar[t] = -mx * 1.4426950408889634f; ar[64 + t] = a * 1.4426950408889634f; ar[128 + t] = __expf(m - mx); ar[192 + t] = __expf(-(bc + mx));
        } else if (wid < 4) nbuf[(wid - 2) * 64 + lane] = R.nn;
        bf16x8 qr[4] = {R.q0, R.q1, R.q2, R.q3};
        __syncthreads();
        if (u + G < NU) out_load(p, u + G, R);
        const int ocol = h * 128 + sc8 * 16; const size_t oo = (r0 + sr) * 1024 + ocol;
        const u32x4 og0 = *(const u32x4*)(p.OG() + oo), og1 = *(const u32x4*)(p.OG() + oo + 8);
        const f32x4 n0 = *(const f32x4*)(p.m_norm + ocol), n1 = *(const f32x4*)(p.m_norm + ocol + 4), n2 = *(const f32x4*)(p.m_norm + ocol + 8), n3 = *(const f32x4*)(p.m_norm + ocol + 12);
        const int dir = (wid >> 1) & 1, vh = wid >> 2;
        float qn;
        { const float* nv = nbuf + dir * 64 + hi * 8; float s_ = 0.f;
#pragma unroll
          for (int d0 = 0; d0 < 4; ++d0) { const u32x4 w = *reinterpret_cast<const u32x4*>(&qr[d0]); const f32x4 n0 = *(const f32x4*)(nv + d0 * 16), n1 = *(const f32x4*)(nv + d0 * 16 + 4);
              s_ += __uint_as_float(w.x << 16) * n0[0] + __uint_as_float(w.x & 0xffff0000u) * n0[1] + __uint_as_float(w.y << 16) * n0[2] + __uint_as_float(w.y & 0xffff0000u) * n0[3]
                  + __uint_as_float(w.z << 16) * n1[0] + __uint_as_float(w.z & 0xffff0000u) * n1[1] + __uint_as_float(w.w << 16) * n1[2] + __uint_as_float(w.w & 0xffff0000u) * n1[3]; }
          qn = half_swap_add(s_); }
        f32x16 p0 = {}, p1 = {};
        const bool has0 = !(dir == 1 && tb == 1), has1 = !(dir == 0 && tb == 0);
#pragma unroll
        for (int d0 = 0; d0 < 4; ++d0) { const int cb = (d0 * 16 + hi * 8) * 2;
            if (has0) { const bf16x8 k0 = *reinterpret_cast<const bf16x8*>(lds + O_K + RSWZ(r32, cb)); p0 = __builtin_amdgcn_mfma_f32_32x32x16_bf16(k0, qr[d0], p0, 0, 0, 0); }
            if (has1) { const bf16x8 k1 = *reinterpret_cast<const bf16x8*>(lds + O_K + RSWZ(32 + r32, cb)); p1 = __builtin_amdgcn_mfma_f32_32x32x16_bf16(k1, qr[d0], p1, 0, 0, 0); } }
        const int t = tb * 32 + r32;
        const int vbase = (int)(uintptr_t)lds + v_rd_base(lane) + vh * 1024;
#define W_FULL(P, W, SB) _Pragma("unroll") for (int g = 0; g < 4; ++g) { const f32x4 ct = *(const f32x4*)(ar + 64 + (SB) + 8 * g + 4 * hi); \
            _Pragma("unroll") for (int q = 0; q < 4; ++q) { const float x = __builtin_amdgcn_exp2f(rt + ct[q]) * P[4 * g + q]; W[4 * g + q] = x; rs += x; } }
#define W_DIAG(P, W, SB) _Pragma("unroll") for (int g = 0; g < 4; ++g) { const f32x4 ct = *(const f32x4*)(ar + 64 + (SB) + 8 * g + 4 * hi); \
            _Pragma("unroll") for (int q = 0; q < 4; ++q) { const int sl = 8 * g + 4 * hi + q; const bool ok = dir ? (sl >= r32) : (sl <= r32); \
                const float x = ok ? __builtin_amdgcn_exp2f(rt + ct[q]) * P[4 * g + q] : 0.f; W[4 * g + q] = x; rs += x; } }
        {
            const float* ar = arr + dir * 256; const float rt = ar[t], sint = ar[128 + t], efl = ar[192 + t];
            f32x16 w0, w1; float rs = 0.f;
            if (tb == 0) { W_DIAG(p0, w0, 0) if (dir == 1) { W_FULL(p1, w1, 32) } }
            else         { W_DIAG(p1, w1, 32) if (dir == 0) { W_FULL(p0, w0, 0) } }
            rs = half_swap_add(rs);
            bf16x8 pa0, pa1, pa2, pa3;
            if (has0) { PK4(w0, 0, pa0); PK4(w0, 8, pa1); }
            if (has1) { PK4(w1, 0, pa2); PK4(w1, 8, pa3); }
            const float den = rs + sint * qn, inv = 1.f / fmaxf(fabsf(den), efl);
            if (hi == 0) { wsc[r32] = sint; wsc[32 + r32] = inv; }
            f32x16 o0 = {}, o1 = {};
            pv_blk(o0, vbase + (dir ? O_CB : O_CF), qr[0], qr[1], qr[2], qr[3]);
            pv_blk(o1, vbase + (dir ? O_CB : O_CF) + 512, qr[0], qr[1], qr[2], qr[3]);
            asm volatile("s_waitcnt lgkmcnt(0)" ::: "memory");
#pragma unroll
            for (int g = 0; g < 4; ++g) { const f32x4 sc = *(const f32x4*)(wsc + 8 * g + 4 * hi);
#pragma unroll
                for (int q = 0; q < 4; ++q) { o0[4 * g + q] *= sc[q]; o1[4 * g + q] *= sc[q]; } }
            if (has0) { pv_blk2<0>(o0, vbase + O_V, pa0, pa1); pv_blk2<0>(o1, vbase + O_V + 512, pa0, pa1); }
            if (has1) { pv_blk2<2>(o0, vbase + O_V, pa2, pa3); pv_blk2<2>(o1, vbase + O_V + 512, pa2, pa3); }
            float* T = (float*)(lds + O_T + dir * 32768) + (size_t)(tb * 32) * 128 + vh * 64 + r32;
#pragma unroll
            for (int g = 0; g < 4; ++g) { const f32x4 sc = *(const f32x4*)(wsc + 32 + 8 * g + 4 * hi);
#pragma unroll
                for (int q = 0; q < 4; ++q) { const int rw = 8 * g + 4 * hi + q; T[rw * 128] = o0[4 * g + q] * sc[q]; T[rw * 128 + 32] = o1[4 * g + q] * sc[q]; } }
        }
#undef W_FULL
#undef W_DIAG
        __syncthreads();
        { const float* T = (const float*)(lds + O_T) + sr * 128 + sc8 * 16; f32x4 v[4]; float ss = 0.f;
#pragma unroll
          for (int q = 0; q < 4; ++q) { v[q] = *(const f32x4*)(T + q * 4) + *(const f32x4*)(T + 8192 + q * 4); ss += v[q][0] * v[q][0] + v[q][1] * v[q][1] + v[q][2] * v[q][2] + v[q][3] * v[q][3]; }
          ss += __shfl_xor(ss, 1); ss += __shfl_xor(ss, 2); ss += __shfl_xor(ss, 4);
          const float rstd = rsqrtf(ss * (1.f / 128.f) + EPS);
          const f32x4 g0 = (f32x4){__uint_as_float(og0.x << 16), __uint_as_float(og0.x & 0xffff0000u), __uint_as_float(og0.y << 16), __uint_as_float(og0.y & 0xffff0000u)};
          const f32x4 g1 = (f32x4){__uint_as_float(og0.z << 16), __uint_as_float(og0.z & 0xffff0000u), __uint_as_float(og0.w << 16), __uint_as_float(og0.w & 0xffff0000u)};
          const f32x4 g2 = (f32x4){__uint_as_float(og1.x << 16), __uint_as_float(og1.x & 0xffff0000u), __uint_as_float(og1.y << 16), __uint_as_float(og1.y & 0xffff0000u)};
          const f32x4 g3 = (f32x4){__uint_as_float(og1.z << 16), __uint_as_float(og1.z & 0xffff0000u), __uint_as_float(og1.w << 16), __uint_as_float(og1.w & 0xffff0000u)};
          st8_bf16(p.HM() + oo, v[0] * rstd * n0 * g0, v[1] * rstd * n1 * g1); st8_bf16(p.HM() + oo + 8, v[2] * rstd * n2 * g2, v[3] * rstd * n3 * g3); }
    }
    __syncthreads();
}
#undef PK4
#undef RSWZ
#undef SBAR
}

__device__ __forceinline__ void phase_mlstm_scan(const Params& p, char* lds, int vcu, int G) {
    for (int u = vcu; u < NB * 8 * 2; u += G) ml::scan_unit(p, u >> 4, (u >> 1) & 7, u & 1, lds);
}
__device__ __forceinline__ void phase_mlstm_out(const Params& p, char* lds, int vcu, int G) {
    ml::phase_mlstm_out_body(p, lds, vcu, G);
}

#define RS_STEP(IN, OUT, N, BIT, MASK) _Pragma("unroll") for (int i_ = 0; i_ < (N); ++i_) { const float keep_ = (BIT) ? IN[(N) + i_] : IN[i_], send_ = (BIT) ? IN[i_] : IN[(N) + i_]; OUT[i_] = keep_ + __shfl_xor(send_, (MASK)); }
__device__ __forceinline__ float route_reduce(const float (&v)[32], int lane) {
    const int b5 = (lane >> 5) & 1, b4 = (lane >> 4) & 1, b3 = (lane >> 3) & 1, b2 = (lane >> 2) & 1, b1 = (lane >> 1) & 1;
    float a16[16], a8[8], a4[4], a2[2], a1[1];
    RS_STEP(v, a16, 16, b5, 32) RS_STEP(a16, a8, 8, b4, 16) RS_STEP(a8, a4, 4, b3, 8) RS_STEP(a4, a2, 2, b2, 4) RS_STEP(a2, a1, 1, b1, 2)
    return a1[0] + __shfl_xor(a1[0], 1);
}
__device__ __forceinline__ int route_rank(float val, int myexp) {
    int cnt = 0;
#pragma unroll
    for (int e = 0; e < 32; ++e) { const float ve = __int_as_float(__builtin_amdgcn_readlane(__float_as_int(val), 2 * e)); cnt += (ve > val || (ve == val && e < myexp)) ? 1 : 0; }
    return cnt;
}
__device__ __forceinline__ void phase_route(const Params& p, char* lds, int vcu, int G) {
    constexpr int XST = 1028;
    float* xs = (float*)lds;
    float* part = (float*)(lds + 65792);
    unsigned short* ent = (unsigned short*)(lds + 84224);
    int* lcount = (int*)(lds + 88320); int* lbase = lcount + 32;
    float* rec = (float*)(lds + 88576);
    const int tid = threadIdx.x, lane = tid & 63, w = tid >> 6, q4 = lane >> 4, l15 = lane & 15;
    __syncthreads();
    if (tid < 32) lcount[tid] = 0;
    float breg0[32], breg1[32];
#pragma unroll
    for (int i = 0; i < 32; ++i) { const float* wr = p.w_router + (size_t)(128 * w + 4 * i + q4) * NEXP + l15; breg0[i] = wr[0]; breg1[i] = wr[16]; }
    const int te = lane & 31, tsel = lane >> 5;
    const float mybias = p.b_router[te];
    int nloc = 0;
    float4 pa_[4], pb_[4];
    if (vcu * 16 < NT) {
#pragma unroll
        for (int j = 0; j < 4; ++j) { pa_[j] = ntld4(p.out + (size_t)(vcu * 16 + w * 2) * DM + (j * 64 + lane) * 4); pb_[j] = ntld4(p.out + (size_t)(vcu * 16 + w * 2 + 1) * DM + (j * 64 + lane) * 4); } }
#pragma unroll 1
    for (int base = vcu * 16; base < NT; base += G * 16, nloc += 16) {
        const int row0 = base + w * 2;
        float4 xa[4], xb[4]; float sa = 0.f, sb = 0.f;
#pragma unroll
        for (int j = 0; j < 4; ++j) { xa[j] = pa_[j]; xb[j] = pb_[j]; }
        { const int nb_ = base + G * 16; if (nb_ < NT) {
#pragma unroll
            for (int j = 0; j < 4; ++j) { pa_[j] = ntld4(p.out + (size_t)(nb_ + w * 2) * DM + (j * 64 + lane) * 4); pb_[j] = ntld4(p.out + (size_t)(nb_ + w * 2 + 1) * DM + (j * 64 + lane) * 4); } } }
#pragma unroll
        for (int j = 0; j < 4; ++j) { sa += xa[j].x * xa[j].x + xa[j].y * xa[j].y + xa[j].z * xa[j].z + xa[j].w * xa[j].w; sb += xb[j].x * xb[j].x + xb[j].y * xb[j].y + xb[j].z * xb[j].z + xb[j].w * xb[j].w; }
        const float ra = rsqrtf(wave_sum(sa) * (1.f / DM) + EPS), rb = rsqrtf(wave_sum(sb) * (1.f / DM) + EPS);
#pragma unroll
        for (int j = 0; j < 4; ++j) { const int c = (j * 64 + lane) * 4; const float4 g = *(const float4*)(p.norm_ffn + c);
            xa[j] = make_float4(xa[j].x * ra * g.x, xa[j].y * ra * g.y, xa[j].z * ra * g.z, xa[j].w * ra * g.w);
            xb[j] = make_float4(xb[j].x * rb * g.x, xb[j].y * rb * g.y, xb[j].z * rb * g.z, xb[j].w * rb * g.w);
            *(float4*)&xs[(w * 2) * XST + c] = xa[j]; *(float4*)&xs[(w * 2 + 1) * XST + c] = xb[j];
            *(unsigned*)((unsigned char*)p.XN2() + (size_t)row0 * DM + c) = pk4_fp8(xa[j].x, xa[j].y, xa[j].z, xa[j].w);
            *(unsigned*)((unsigned char*)p.XN2() + (size_t)(row0 + 1) * DM + c) = pk4_fp8(xb[j].x, xb[j].y, xb[j].z, xb[j].w); }
        __syncthreads();
        f32x4 acc0 = {0.f, 0.f, 0.f, 0.f}, acc1 = {0.f, 0.f, 0.f, 0.f};
        const float* xp = xs + l15 * XST + 128 * w + q4;
#pragma unroll
        for (int i = 0; i < 32; ++i) { const float a = xp[4 * i];
            acc0 = __builtin_amdgcn_mfma_f32_16x16x4f32(a, breg0[i], acc0, 0, 0, 0); acc1 = __builtin_amdgcn_mfma_f32_16x16x4f32(a, breg1[i], acc1, 0, 0, 0); }
#pragma unroll
        for (int r = 0; r < 4; ++r) { part[(w * 16 + 4 * q4 + r) * 32 + l15] = acc0[r]; part[(w * 16 + 4 * q4 + r) * 32 + 16 + l15] = acc1[r]; }
        __syncthreads();
        float val = mybias;
#pragma unroll
        for (int w8 = 0; w8 < 8; ++w8) val += part[(w8 * 16 + 2 * w + tsel) * 32 + te];
        int cnt = 0;
#pragma unroll
        for (int e = 0; e < 32; ++e) { const float v0 = __int_as_float(__builtin_amdgcn_readlane(__float_as_int(val), e)), v1 = __int_as_float(__builtin_amdgcn_readlane(__float_as_int(val), 32 + e));
            const float ve = tsel ? v1 : v0; cnt += (ve > val || (ve == val && e < te)) ? 1 : 0; }
        float* rc = rec + w * 16 + tsel * 8;
        if (cnt < 4) { rc[cnt * 2] = __int_as_float(te); rc[cnt * 2 + 1] = val; }
        asm volatile("s_waitcnt lgkmcnt(0)" ::: "memory");
        if (te == 0) {
            const int row = row0 + tsel, tl = nloc + w * 2 + tsel; float ex[4], sum = 0.f; int tx[4];
#pragma unroll
            for (int kk = 0; kk < 4; ++kk) { tx[kk] = __float_as_int(rc[kk * 2]); ex[kk] = __expf(rc[kk * 2 + 1] - rc[1]); sum += ex[kk]; }
            const float inv = 1.f / sum;
#pragma unroll
            for (int kk = 0; kk < 4; ++kk) { const int e = tx[kk]; p.TOPI()[row * 4 + kk] = e; p.TOPW()[row * 4 + kk] = ex[kk] * inv;
                const int lr = atomicAdd(&lcount[e], 1); ent[tl * 4 + kk] = (unsigned short)(e | (lr << 5)); }
        }
        asm volatile("s_waitcnt lgkmcnt(0)" ::: "memory");
    }
    __syncthreads();
    if (tid < 32) lbase[tid] = atomicAdd(&p.CNT()[tid * CNT_STRIDE], lcount[tid]);
    __syncthreads();
    for (int idx = tid; idx < nloc * 4; idx += MK_THREADS) { const int tl = idx >> 2, row = vcu * 16 + (tl >> 4) * G * 16 + (tl & 15); const unsigned en = ent[idx];
        p.RANK()[row * 4 + (idx & 3)] = lbase[en & 31] + (int)(en >> 5); }
    __syncthreads();
}
#undef RS_STEP
__device__ __forceinline__ void phase_scatter(const Params& p, char* lds, int vcu, int G) {
    int* ps = (int*)lds;
    __syncthreads();
    if (threadIdx.x == 0) { int s = 0; for (int e = 0; e < NEXP; ++e) { ps[e] = s; s += (p.CNT()[e * CNT_STRIDE] + 255) / 256 * 256; } }
    __syncthreads();
    for (int gid = vcu * MK_THREADS + threadIdx.x; gid < NT * 4; gid += G * MK_THREADS) { const int slot = ps[p.TOPI()[gid]] + p.RANK()[gid]; p.SLOTS()[gid] = slot; p.SLOT_TOK()[slot] = gid >> 2; }
    __syncthreads();
}
__device__ __forceinline__ void phase_combine(const Params& p, int vcu, int G, float* dst) {
    const int lane = threadIdx.x & 63, gw = vcu * 8 + (threadIdx.x >> 6), NGW = G * 8;
    for (int r = gw * 2; r < NT; r += NGW * 2) {
        int sl[8]; float tw[8];
#pragma unroll
        for (int q = 0; q < 8; ++q) { sl[q] = p.SLOTS()[r * 4 + q]; tw[q] = p.TOPW()[r * 4 + q]; }
        float4 v[8];
#pragma unroll
        for (int j = 0; j < 4; ++j) { v[j] = ntld4(p.out + (size_t)r * DM + (j * 64 + lane) * 4); v[4 + j] = ntld4(p.out + (size_t)(r + 1) * DM + (j * 64 + lane) * 4); }
        uint2 y[8][4];
#pragma unroll
        for (int q = 0; q < 8; ++q)
#pragma unroll
            for (int j = 0; j < 4; ++j) y[q][j] = ntld2u(p.YB() + (size_t)sl[q] * DM + (j * 64 + lane) * 4);
#pragma unroll
        for (int q = 0; q < 8; ++q) { const float w = tw[q]; const int o = (q >> 2) * 4;
#pragma unroll
            for (int j = 0; j < 4; ++j) { const uint2 t = y[q][j];
                v[o + j].x += w * __uint_as_float(t.x << 16); v[o + j].y += w * __uint_as_float(t.x & 0xffff0000u); v[o + j].z += w * __uint_as_float(t.y << 16); v[o + j].w += w * __uint_as_float(t.y & 0xffff0000u); } }
        float sa = 0.f, sb = 0.f;
#pragma unroll
        for (int j = 0; j < 4; ++j) { sa += v[j].x * v[j].x + v[j].y * v[j].y + v[j].z * v[j].z + v[j].w * v[j].w; sb += v[4 + j].x * v[4 + j].x + v[4 + j].y * v[4 + j].y + v[4 + j].z * v[4 + j].z + v[4 + j].w * v[4 + j].w; }
        const float ra = rsqrtf(wave_sum(sa) * (1.f / DM) + EPS), rb = rsqrtf(wave_sum(sb) * (1.f / DM) + EPS);
#pragma unroll
        for (int j = 0; j < 4; ++j) { const int c = (j * 64 + lane) * 4; const float4 g = *(const float4*)(p.norm_final + c);
            *(float4*)(dst + (size_t)r * DM + c) = make_float4(v[j].x * ra * g.x, v[j].y * ra * g.y, v[j].z * ra * g.z, v[j].w * ra * g.w);
            *(float4*)(dst + (size_t)(r + 1) * DM + c) = make_float4(v[4 + j].x * rb * g.x, v[4 + j].y * rb * g.y, v[4 + j].z * rb * g.z, v[4 + j].w * rb * g.w); }
    }
}
__device__ __forceinline__ void phase_init_ctl(const Params& p, int vcu, int G) {
    if (vcu == 0) for (int i = threadIdx.x; i < NEXP * CNT_STRIDE; i += MK_THREADS) p.CNT()[i] = 0;
    for (int i = vcu * MK_THREADS + threadIdx.x; i < NSLOT; i += G * MK_THREADS) p.SLOT_TOK()[i] = -1;
}

#define XB_TMO      128
#define XB_XCNT(j)  (256  + 64 * (j))
#define XB_XSUB(j)  (1280 + 64 * (j))
#define XB_XGEN(j)  (2304 + 64 * (j))
#define XB_TOP      3328
#define XB_TOPGEN   3392
#define XCD_BAR_WORDS 3456
#define XB_SPIN_CAP (1u << 20)
__device__ __forceinline__ unsigned xb_ld(unsigned* p)              { return __hip_atomic_load(p, __ATOMIC_RELAXED, __HIP_MEMORY_SCOPE_AGENT); }
__device__ __forceinline__ unsigned xb_add(unsigned* p, unsigned v) { return __hip_atomic_fetch_add(p, v, __ATOMIC_RELAXED, __HIP_MEMORY_SCOPE_AGENT); }
__device__ __forceinline__ unsigned xb_xcc_id() { return (unsigned)__builtin_amdgcn_s_getreg((3 << 11) | 20) & 0xFu; }
#define XB_SPIN(cond, bar) do { unsigned _sp = 0; while (cond) { __builtin_amdgcn_s_sleep(1); \
    if ((++_sp & 255u) == 0u) { if (xb_ld(&(bar)[XB_TMO])) break; if (_sp > XB_SPIN_CAP) { atomicAdd(&(bar)[XB_TMO], 1u); break; } } } } while (0)
struct XcdBarrier { unsigned* bar; unsigned x; volatile LAS unsigned* st; };
__device__ __forceinline__ XcdBarrier xcd_barrier_post(unsigned* bar, volatile LAS unsigned* st) {
    XcdBarrier b; b.bar = bar; b.x = xb_xcc_id(); b.st = st;
    if (threadIdx.x == 0) (void)xb_add(&bar[XB_XCNT(b.x)], 1u);
    return b;
}
__device__ __forceinline__ void xcd_barrier_complete(unsigned* bar, unsigned x, unsigned& nloc, unsigned& nx) {
    const unsigned G = gridDim.x * gridDim.y * gridDim.z;
    unsigned sum, cnt, mine, sp = 0u;
    for (;;) {
        sum = 0u; cnt = 0u; mine = 0u;
#pragma unroll
        for (unsigned j = 0; j < 16; ++j) { const unsigned c = xb_ld(&bar[XB_XCNT(j)]); sum += c; cnt += (c > 0u) ? 1u : 0u; mine = (j == x) ? c : mine; }
        if (sum == G) break;
        __builtin_amdgcn_s_sleep(1);
        if ((++sp & 255u) == 0u) { if (xb_ld(&bar[XB_TMO])) break; if (sp > XB_SPIN_CAP) { atomicAdd(&bar[XB_TMO], 1u); break; } }
    }
    nloc = mine > 0u ? mine : 1u; nx = cnt > 0u ? cnt : 1u;
}
__device__ __forceinline__ void xcd_barrier(const XcdBarrier& b) {
    asm volatile("s_waitcnt vmcnt(0)" ::: "memory");
    __syncthreads();
    if (threadIdx.x == 0) {
        unsigned* bar = b.bar;
        __builtin_amdgcn_s_waitcnt(0);
        unsigned nloc = b.st[0], nx = b.st[1];
        if (nloc == 0u) { xcd_barrier_complete(bar, b.x, nloc, nx); b.st[0] = nloc; b.st[1] = nx; }
        const unsigned old = xb_add(&bar[XB_XSUB(b.x)], 1u);
        const unsigned gen = old / nloc;
        if (old + 1u == (gen + 1u) * nloc) {
            __builtin_amdgcn_fence(__ATOMIC_RELEASE, "agent");
            asm volatile("s_waitcnt vmcnt(0)" ::: "memory");
            const unsigned og = xb_add(&bar[XB_TOP], 1u);
            const unsigned tg = og / nx;
            if (og + 1u == (tg + 1u) * nx) xb_add(&bar[XB_TOPGEN], 1u);
            else XB_SPIN(xb_ld(&bar[XB_TOPGEN]) == tg, bar);
            __builtin_amdgcn_fence(__ATOMIC_ACQUIRE, "agent");
            xb_add(&bar[XB_XGEN(b.x)], 1u);
            asm volatile("s_waitcnt vmcnt(0)" ::: "memory");
        } else {
            XB_SPIN(xb_ld(&bar[XB_XGEN(b.x)]) == gen, bar);
            __builtin_amdgcn_fence(__ATOMIC_ACQUIRE, "agent");
            asm volatile("s_waitcnt vmcnt(0)" ::: "memory");
        }
    }
    __syncthreads();
}

struct MkArgs { Params p; int ph_lo, ph_hi, sub, pad; };
enum { PH_PRO = 0, PH_INPROJ = 1, PH_MSCAN = 2, PH_QPROJ = 3, PH_MOUT = 4, PH_ATTN = 5, PH_YM = 6, PH_YA = 7, PH_OUT = 8, PH_ROUTE = 9, PH_SCATTER = 10, PH_M1 = 11, PH_M2 = 12, PH_COMBINE = 13, PH_END = 14 };

__global__ void __launch_bounds__(MK_THREADS, 2) mk_fwd(MkArgs a) {
    extern __shared__ __attribute__((aligned(16))) unsigned char lds_raw[];
    LAS unsigned char* lds = (LAS unsigned char*)lds_raw;
    const Params& p = *(const Params*)__builtin_amdgcn_kernarg_segment_ptr();
    const int G = gridDim.x, bx = blockIdx.x;
    const int vcu = (G % 8 == 0) ? (bx % 8) * (G / 8) + bx / 8 : bx;
    cooperative_groups::grid_group grid = cooperative_groups::this_grid();
    const int lo = a.ph_lo, hi = a.ph_hi;
    volatile LAS unsigned* bst = (volatile LAS unsigned*)(lds + MK_LDS - 16);
    if (threadIdx.x < 4) bst[threadIdx.x] = 0u;
    __syncthreads();
    XcdBarrier xbar; xbar.bar = p.BAR(); xbar.x = 0; xbar.st = bst;
    if (hi - lo > 1) xbar = xcd_barrier_post(p.BAR(), bst);
#ifndef PHASE_MASK
#define PHASE_MASK 0xffffffffu
#endif
#define IN(k) (((PHASE_MASK >> (k)) & 1u) && lo <= (k) && (k) < hi)
#define SEAM(k) do { if (IN(k) && IN((k) + 1)) { if (a.sub == 0x7fffffff) grid.sync(); else xcd_barrier(xbar); } } while (0)
#ifndef PROBE_PHASE
#define PROBE_PHASE -1
#endif
#ifndef PROBE_REPS
#define PROBE_REPS 2
#endif
#define REPS(k) ((k) == PROBE_PHASE ? PROBE_REPS : 1)
    if (IN(PH_PRO)) for (int rep_ = 0; rep_ < REPS(PH_PRO); ++rep_) { if (rep_) xcd_barrier(xbar); phase_init_ctl(p, vcu, G); phase_prologue(p, lds, vcu, G, a.sub); } SEAM(PH_PRO);
    if (IN(PH_INPROJ)) for (int rep_ = 0; rep_ < REPS(PH_INPROJ); ++rep_) { if (rep_) xcd_barrier(xbar); { pg8::StaticOrder S; S.init(NT, 2560, DM, G, bx, p.U(), p.WinT()); EpiInP<0> E{p}; pg8::gemm_phase<EpiInP<0>, pg8::StaticOrder>(lds, DM, DM, S, E); }
        { pg8::StaticOrder S; S.init(NT, 3072, DM / 2, G, bx, p.U8(), p.WinT8()); EpiInP<1> E{p}; pg8::gemm_phase<EpiInP<1>, pg8::StaticOrder, true>(lds, DM / 2, DM / 2, S, E); } } SEAM(PH_INPROJ);
    if (IN(PH_MSCAN)) for (int rep_ = 0; rep_ < REPS(PH_MSCAN); ++rep_) { if (rep_) xcd_barrier(xbar);
        { const int half = (bx >> 3) & 1, idx = (bx & 7) * 16 + (bx >> 4);
            if (half == 0) { if (a.sub != 2) phase_mlstm_scan(p, (char*)lds_raw, idx, 128); }
            else if (a.sub != 1) { phase_kprep(p, idx, 128);
                asm volatile("s_waitcnt vmcnt(0)" ::: "memory"); __syncthreads();
                if (threadIdx.x == 0) { unsigned* cw = p.BAR() + 3584; __builtin_amdgcn_fence(__ATOMIC_RELEASE, "agent"); asm volatile("s_waitcnt vmcnt(0)" ::: "memory");
                    xb_add(cw, 1u); unsigned sp = 0; while (xb_ld(cw) < 128u * (unsigned)(rep_ + 1)) { __builtin_amdgcn_s_sleep(2); if (++sp > (1u << 22)) break; }
                    __builtin_amdgcn_fence(__ATOMIC_ACQUIRE, "agent"); asm volatile("s_waitcnt vmcnt(0)" ::: "memory"); }
                __syncthreads();
                pg8::StaticOrder S; S.init(NT, 1536, 256, 128, idx, p.CQb(), p.WqT()); EpiQ E{p}; pg8::gemm_phase<EpiQ, pg8::StaticOrder>(lds, 256, 256, S, E); } }
        } SEAM(PH_MSCAN);
    if (IN(PH_MOUT)) for (int rep_ = 0; rep_ < REPS(PH_MOUT); ++rep_) { if (rep_) xcd_barrier(xbar); phase_mlstm_out(p, (char*)lds_raw, vcu, G); }
    if (IN(PH_ATTN)) for (int rep_ = 0; rep_ < REPS(PH_ATTN); ++rep_) { if (rep_) xcd_barrier(xbar); phase_attn(p, (char*)lds_raw, vcu, G); } SEAM(PH_ATTN);
    if (IN(PH_YM)) for (int rep_ = 0; rep_ < REPS(PH_YM); ++rep_) { if (rep_) xcd_barrier(xbar); pg8::StaticOrder S; S.init(NT, DM, DM, G, bx, p.HM(), p.WmT()); EpiMix<0> E{p}; pg8::gemm_phase<EpiMix<0>, pg8::StaticOrder>(lds, DM, DM, S, E); }
    if (IN(PH_YA)) for (int rep_ = 0; rep_ < REPS(PH_YA); ++rep_) { if (rep_) xcd_barrier(xbar); pg8::StaticOrder S; S.init(NT, DM, DM, G, bx, p.OA(), p.WoT()); EpiMix<1> E{p}; pg8::gemm_phase<EpiMix<1>, pg8::StaticOrder>(lds, DM, DM, S, E); } SEAM(PH_YA);
    if (IN(PH_OUT)) for (int rep_ = 0; rep_ < REPS(PH_OUT); ++rep_) { if (rep_) xcd_barrier(xbar); pg8::StaticOrder S; S.init(NT, DM, DM, G, bx, p.MIX(), p.WoutT()); EpiOut E{p}; pg8::gemm_phase<EpiOut, pg8::StaticOrder>(lds, DM, DM, S, E); } SEAM(PH_OUT);
    if (IN(PH_ROUTE)) for (int rep_ = 0; rep_ < REPS(PH_ROUTE); ++rep_) { if (rep_) xcd_barrier(xbar); phase_route(p, (char*)lds_raw, vcu, G); } SEAM(PH_ROUTE);
    if (IN(PH_SCATTER)) for (int rep_ = 0; rep_ < REPS(PH_SCATTER); ++rep_) { if (rep_) xcd_barrier(xbar); phase_scatter(p, (char*)lds_raw, vcu, G); } SEAM(PH_SCATTER);
    if (IN(PH_M1)) for (int rep_ = 0; rep_ < REPS(PH_M1); ++rep_) { if (rep_) xcd_barrier(xbar); volatile LAS int* tst = (volatile LAS int*)(lds + MISC_OFF); moe_tile_table(p, tst);
        pg8::MoeOrder S; S.tstart = tst; S.npn = 8; S.G = G; S.c = bx; S.A = (const char*)p.XN2(); S.W = (const char*)p.W1T(); S.wexp = (size_t)2048 * DM; S.btile = (size_t)256 * DM;     S.rowidx = p.SLOT_TOK();
        EpiM1 E{p}; pg8::gemm_phase<EpiM1, pg8::MoeOrder, true>(lds, DM / 2, DM / 2, S, E); } SEAM(PH_M1);
    if (IN(PH_M2)) for (int rep_ = 0; rep_ < REPS(PH_M2); ++rep_) { if (rep_) xcd_barrier(xbar); volatile LAS int* tst = (volatile LAS int*)(lds + MISC_OFF); moe_tile_table(p, tst);
        pg8::MoeOrder S; S.tstart = tst; S.npn = 4; S.G = G; S.c = bx; S.A = (const char*)p.ACT(); S.W = (const char*)p.W2T(); S.wexp = (size_t)DM * DFF; S.btile = (size_t)256 * DFF; S.rowidx = nullptr;
        EpiM2 E{p}; pg8::gemm_phase<EpiM2, pg8::MoeOrder, true>(lds, DFF / 2, DFF / 2, S, E); } SEAM(PH_M2);
    if (IN(PH_COMBINE)) for (int rep_ = 0; rep_ < REPS(PH_COMBINE); ++rep_) { if (rep_) xcd_barrier(xbar); phase_combine(p, vcu, G, a.sub ? (float*)p.ACT() : p.out); }
#undef IN
#undef SEAM
}

#ifndef ONE_LAUNCH
#define ONE_LAUNCH 1
#endif
#ifndef PROBE_DUP
#define PROBE_DUP -1
#endif
#ifndef PROBE_SUB
#define PROBE_SUB 0
#endif
#ifndef PROBE_DUP_N
#define PROBE_DUP_N 1
#endif
#ifndef FAST_INPROJ
#define FAST_INPROJ 1
#endif
#ifndef FAST_QPROJ
#define FAST_QPROJ 1
#endif
#ifndef FAST_MIX
#define FAST_MIX 1
#endif
#ifndef FAST_MOE
#define FAST_MOE 1
#endif
#ifndef FAST_ATTN
#define FAST_ATTN 1
#endif
#ifndef FAST_MLSTM
#define FAST_MLSTM 1
#endif
static void launch_mk(const Params& p, int lo, int hi, int grid, hipStream_t stream, int sub = 0) {
    MkArgs a{}; a.p = p; a.ph_lo = lo; a.ph_hi = hi; a.sub = sub;
    hipLaunchKernelGGL(mk_fwd, dim3(grid), dim3(MK_THREADS), MK_LDS, stream, a);
}
extern "C" void kernel_launch(void* const* d_in, const int* in_sizes, int n_in, void* d_out, int out_size, void* d_ws, size_t ws_size, hipStream_t stream) {
    static int ok = 0, grid = 0;
    if (!ok) {
        if (n_in != 22 || in_sizes[0] != NT * DM || out_size != NT * DM) { fprintf(stderr, "kernel_launch: unexpected shapes (n_in %d, x %d, out %d)\n", n_in, n_in > 0 ? in_sizes[0] : -1, out_size); return; }
        (void)hipFuncSetAttribute((const void*)k_mlstm_out, hipFuncAttributeMaxDynamicSharedMemorySize, MO_LDS);
        (void)hipFuncSetAttribute((const void*)mk_fwd, hipFuncAttributeMaxDynamicSharedMemorySize, MK_LDS);
        int dev = 0, cus = 0, per_cu = 0; (void)hipGetDevice(&dev); (void)hipDeviceGetAttribute(&cus, hipDeviceAttributeMultiprocessorCount, dev);
        (void)hipOccupancyMaxActiveBlocksPerMultiprocessor(&per_cu, (const void*)mk_fwd, MK_THREADS, MK_LDS);
        if (per_cu < 1) { fprintf(stderr, "kernel_launch: occupancy query says %d blocks/CU\n", per_cu); per_cu = 1; }
        if (cus != 256) { fprintf(stderr, "kernel_launch: built for a 256-CU device (got %d CUs)\n", cus); return; }
        grid = 256;
        ok = 1;
    }
    Params p{};
    const float** ins = (const float**)&p.x;
    for (int i = 0; i < 22; ++i) ins[i] = (const float*)d_in[i];
    p.out = (float*)d_out;
    p.ws = (char*)d_ws;
    if (WS_TOTAL > ws_size) { fprintf(stderr, "kernel_launch: workspace too small (%zu > %zu)\n", (size_t)WS_TOTAL, ws_size); return; }
    (void)hipMemsetAsync(p.BAR(), 0, 16384, stream);
#if ONE_LAUNCH
    { MkArgs a{}; a.p = p; a.ph_lo = 0; a.ph_hi = PH_END; void* args[] = {&a};
      hipError_t e = hipLaunchCooperativeKernel((const void*)mk_fwd, dim3(grid), dim3(MK_THREADS), args, MK_LDS, stream);
      if (e != hipSuccess) fprintf(stderr, "kernel_launch: cooperative launch failed: %s (grid %d)\n", hipGetErrorString(e), grid); }
#else
    for (int ph = 0; ph < PH_END; ++ph) { if (ph == PH_COMBINE && PROBE_DUP == PH_COMBINE) { launch_mk(p, ph, ph + 1, grid, stream, 1); launch_mk(p, ph, ph + 1, grid, stream, 0); continue; }
        launch_mk(p, ph, ph + 1, grid, stream);
        for (int d = 0; d < ((ph == PROBE_DUP) ? PROBE_DUP_N : 0); ++d) { if (ph == PH_ROUTE) (void)hipMemsetAsync(p.CNT(), 0, 4096, stream); launch_mk(p, ph, ph + 1, grid, stream, PROBE_SUB); } }
#endif
}
```

```cpp
#include <hip/hip_runtime.h>
#include <hip/hip_cooperative_groups.h>
#include <cstdio>
#include <cstdint>

typedef unsigned short bf16_t;
__device__ __forceinline__ float bf2f(bf16_t v) { return __uint_as_float(((unsigned)v) << 16); }
__device__ __forceinline__ bf16_t f2bf(float f) { unsigned u = __float_as_uint(f); return (bf16_t)((u + 0x7fffu + ((u >> 16) & 1u)) >> 16); }

constexpr int NB = 8, SEQ = 4096, NT = NB * SEQ, DM = 1024, NMETA = 16, LTOT = SEQ + NMETA;
constexpr int DIN = 5600;
constexpr int OFF_Q = 0, OFF_K = 512, OFF_V = 1024, OFF_O = 2048, OFF_I = 3072, OFF_F = 3088, OFF_CQ = 3104, OFF_CKV = 3360, OFF_KR = 3488, OFF_G = 3552;
constexpr int KVROWS = 4160;
constexpr int NEXP = 32, DFF = 1024;
constexpr int NSLOT = NT * 4 + NEXP * 256;
constexpr float EPS = 1e-6f;
constexpr int CNT_STRIDE = 16;
constexpr float QSCALE = 0.07216878364870322f * 1.4426950408889634f;

constexpr size_t ws_al(size_t x) { return (x + 255) & ~(size_t)255; }
constexpr size_t WS_BAR = 0;
constexpr size_t WS_CNT = WS_BAR + 16384;
constexpr size_t WS_SLOT_TOK = WS_CNT + ws_al(4096);
constexpr size_t WS_TOPI = WS_SLOT_TOK + ws_al((size_t)NSLOT*4);
constexpr size_t WS_TOPW = WS_TOPI + ws_al((size_t)NT*16);
constexpr size_t WS_RANK = WS_TOPW + ws_al((size_t)NT*16);
constexpr size_t WS_SLOTS = WS_RANK + ws_al((size_t)NT*16);
constexpr size_t WS_UM = WS_SLOTS + ws_al((size_t)NT*16);
constexpr size_t WS_ZM = WS_UM + ws_al((size_t)NMETA*DM*4);
constexpr size_t WS_ROPE = WS_ZM + ws_al((size_t)NMETA*DIN*4);
constexpr size_t WS_RSQ = WS_ROPE + ws_al((size_t)LTOT*64*4);
constexpr size_t WS_GI = WS_RSQ + ws_al((size_t)NT*4);
constexpr size_t WS_GF = WS_GI + ws_al((size_t)NT*64);
constexpr size_t WS_NF = WS_GF + ws_al((size_t)NT*64);
constexpr size_t WS_NB_ = WS_NF + ws_al((size_t)4096*256);
constexpr size_t WS_MF = WS_NB_ + ws_al((size_t)4096*256);
constexpr size_t WS_MB = WS_MF + ws_al((size_t)4096*4);
constexpr size_t WS_Kc = WS_MB + ws_al((size_t)4096*4);
constexpr size_t WS_WinT = WS_Kc + ws_al((size_t)NB*KVROWS*192*2);
constexpr size_t WS_WinT8 = WS_WinT + ws_al((size_t)5632*DM*2);
constexpr size_t WS_W1T = WS_WinT8 + ws_al((size_t)3072*DM);
constexpr size_t WS_W2T = WS_W1T + ws_al((size_t)NEXP*2048*DM*2);
constexpr size_t WS_WmT = WS_W2T + ws_al((size_t)NEXP*DM*DFF*2);
constexpr size_t WS_WoutT = WS_WmT + ws_al((size_t)DM*DM*2);
constexpr size_t WS_WoT = WS_WoutT + ws_al((size_t)DM*DM*2);
constexpr size_t WS_WqT = WS_WoT + ws_al((size_t)DM*DM*2);
constexpr size_t WS_CKV = WS_WqT + ws_al((size_t)1536*256*2);
constexpr size_t WS_KR = WS_CKV + ws_al((size_t)NT*128*4);
constexpr size_t WS_CQb = WS_KR + ws_al((size_t)NT*64*4);
constexpr size_t WS_GATE = WS_CQb + ws_al((size_t)NT*256*2);
constexpr size_t WS_WQF = WS_GATE + ws_al((size_t)NT*2048*2);
constexpr size_t WS_WOF = WS_WQF + ws_al((size_t)256*1536*4);
constexpr size_t WS_U = WS_WOF + ws_al((size_t)1024*1024*4);
constexpr size_t WS_Qm = WS_U + ws_al((size_t)NT*DM*2);
constexpr size_t WS_Km = WS_Qm + ws_al((size_t)NT*512*2);
constexpr size_t WS_Vm = WS_Km + ws_al((size_t)NT*512*2);
constexpr size_t WS_OG = WS_Vm + ws_al((size_t)NT*1024*2);
constexpr size_t WS_QP = WS_OG + ws_al((size_t)NT*1024*2);
constexpr size_t WS_CB = WS_QP + ws_al((size_t)NT*1536*2);
constexpr size_t WS_HM = WS_CB + ws_al((size_t)4096*8192*2);
constexpr size_t WS_OA = WS_HM + ws_al((size_t)NT*DM*2);
constexpr size_t WS_TOTAL = WS_OA + ws_al((size_t)NT*DM*2);
constexpr size_t WS_ACT = WS_U, WS_YB = WS_ACT + ws_al((size_t)NSLOT * DFF * 2), WS_MOE_END = WS_YB + ws_al((size_t)NSLOT * DM * 2);
constexpr size_t WS_U8 = WS_CB;
constexpr size_t WS_CF = WS_U, WS_MIX = WS_Qm, WS_XN2 = WS_HM, WS_CQ = WS_HM;
static_assert(WS_MOE_END <= WS_TOTAL && WS_XN2 >= WS_YB, "MoE overlay layout");
struct Params {
    const float *x, *meta, *norm_mix, *w_in, *m_b_i, *m_b_f, *m_norm, *w_m_proj, *a_w_uq, *a_w_ukv, *a_norm_q, *a_norm_kv, *w_a_proj, *w_out,
        *norm_ffn, *w_router, *b_router, *w1, *b1, *w2, *b2, *norm_final;
    float* out; char* ws;
    __host__ __device__ __forceinline__ int* CNT() const { return (int*)(ws + WS_CNT); }
    __host__ __device__ __forceinline__ unsigned* BAR() const { return (unsigned*)(ws + WS_BAR); }
    __host__ __device__ __forceinline__ unsigned char* WinT8() const { return (unsigned char*)(ws + WS_WinT8); }
    __host__ __device__ __forceinline__ unsigned char* U8() const { return (unsigned char*)(ws + WS_U8); }
    __host__ __device__ __forceinline__ int* SLOT_TOK() const { return (int*)(ws + WS_SLOT_TOK); }
    __host__ __device__ __forceinline__ int* TOPI() const { return (int*)(ws + WS_TOPI); }
    __host__ __device__ __forceinline__ float* TOPW() const { return (float*)(ws + WS_TOPW); }
    __host__ __device__ __forceinline__ int* RANK() const { return (int*)(ws + WS_RANK); }
    __host__ __device__ __forceinline__ int* SLOTS() const { return (int*)(ws + WS_SLOTS); }
    __host__ __device__ __forceinline__ float* UM() const { return (float*)(ws + WS_UM); }
    __host__ __device__ __forceinline__ float* ZM() const { return (float*)(ws + WS_ZM); }
    __host__ __device__ __forceinline__ float* ROPE() const { return (float*)(ws + WS_ROPE); }
    __host__ __device__ __forceinline__ float* RSQ() const { return (float*)(ws + WS_RSQ); }
    __host__ __device__ __forceinline__ float* GI() const { return (float*)(ws + WS_GI); }
    __host__ __device__ __forceinline__ float* GF() const { return (float*)(ws + WS_GF); }
    __host__ __device__ __forceinline__ float* NF() const { return (float*)(ws + WS_NF); }
    __host__ __device__ __forceinline__ float* NB_() const { return (float*)(ws + WS_NB_); }
    __host__ __device__ __forceinline__ float* MF() const { return (float*)(ws + WS_MF); }
    __host__ __device__ __forceinline__ float* MB() const { return (float*)(ws + WS_MB); }
    __host__ __device__ __forceinline__ bf16_t* Kc() const { return (bf16_t*)(ws + WS_Kc); }
    __host__ __device__ __forceinline__ bf16_t* WinT() const { return (bf16_t*)(ws + WS_WinT); }
    __host__ __device__ __forceinline__ bf16_t* W1T() const { return (bf16_t*)(ws + WS_W1T); }
    __host__ __device__ __forceinline__ bf16_t* W2T() const { return (bf16_t*)(ws + WS_W2T); }
    __host__ __device__ __forceinline__ bf16_t* WmT() const { return (bf16_t*)(ws + WS_WmT); }
    __host__ __device__ __forceinline__ bf16_t* WoutT() const { return (bf16_t*)(ws + WS_WoutT); }
    __host__ __device__ __forceinline__ bf16_t* WoT() const { return (bf16_t*)(ws + WS_WoT); }
    __host__ __device__ __forceinline__ bf16_t* WqT() const { return (bf16_t*)(ws + WS_WqT); }
    __host__ __device__ __forceinline__ float* CKV() const { return (float*)(ws + WS_CKV); }
    __host__ __device__ __forceinline__ float* KR() const { return (float*)(ws + WS_KR); }
    __host__ __device__ __forceinline__ bf16_t* CQb() const { return (bf16_t*)(ws + WS_CQb); }
    __host__ __device__ __forceinline__ bf16_t* GATE() const { return (bf16_t*)(ws + WS_GATE); }
    __host__ __device__ __forceinline__ float* WQF() const { return (float*)(ws + WS_WQF); }
    __host__ __device__ __forceinline__ float* WOF() const { return (float*)(ws + WS_WOF); }
    __host__ __device__ __forceinline__ bf16_t* U() const { return (bf16_t*)(ws + WS_U); }
    __host__ __device__ __forceinline__ bf16_t* Qm() const { return (bf16_t*)(ws + WS_Qm); }
    __host__ __device__ __forceinline__ bf16_t* Km() const { return (bf16_t*)(ws + WS_Km); }
    __host__ __device__ __forceinline__ bf16_t* Vm() const { return (bf16_t*)(ws + WS_Vm); }
    __host__ __device__ __forceinline__ bf16_t* OG() const { return (bf16_t*)(ws + WS_OG); }
    __host__ __device__ __forceinline__ bf16_t* QP() const { return (bf16_t*)(ws + WS_QP); }
    __host__ __device__ __forceinline__ bf16_t* CB() const { return (bf16_t*)(ws + WS_CB); }
    __host__ __device__ __forceinline__ bf16_t* HM() const { return (bf16_t*)(ws + WS_HM); }
    __host__ __device__ __forceinline__ bf16_t* OA() const { return (bf16_t*)(ws + WS_OA); }
    __host__ __device__ __forceinline__ bf16_t* ACT() const { return (bf16_t*)(ws + WS_ACT); }
    __host__ __device__ __forceinline__ bf16_t* YB() const { return (bf16_t*)(ws + WS_YB); }
    __host__ __device__ __forceinline__ bf16_t* CF() const { return (bf16_t*)(ws + WS_CF); }
    __host__ __device__ __forceinline__ bf16_t* MIX() const { return (bf16_t*)(ws + WS_MIX); }
    __host__ __device__ __forceinline__ bf16_t* XN2() const { return (bf16_t*)(ws + WS_XN2); }
    __host__ __device__ __forceinline__ float* CQ() const { return (float*)(ws + WS_CQ); }
};

__device__ __forceinline__ float wave_sum(float v) {
#pragma unroll
    for (int o = 1; o < 64; o <<= 1) v += __shfl_xor(v, o);
    return v;
}
__device__ __forceinline__ float sigmoidf_(float v) { return __builtin_amdgcn_rcpf(1.f + __expf(-v)); }
__device__ __forceinline__ float logsigmoidf_(float v) { return fminf(v, 0.f) - __logf(1.f + __expf(-fabsf(v))); }

__global__ void __launch_bounds__(256) k_prep_rows(Params p) {
    const int lane = threadIdx.x & 63, gw = (blockIdx.x * 256 + threadIdx.x) >> 6, ngw = (gridDim.x * 256) >> 6;
    for (int r = gw; r < NT + NMETA; r += ngw) {
        const float* src = r < NT ? p.x + (size_t)r * DM : p.meta + (size_t)(r - NT) * DM;
        float4 v[4]; float ss = 0.f;
#pragma unroll
        for (int j = 0; j < 4; ++j) { v[j] = *(const float4*)(src + (j * 64 + lane) * 4); ss += v[j].x * v[j].x + v[j].y * v[j].y + v[j].z * v[j].z + v[j].w * v[j].w; }
        const float rstd = rsqrtf(wave_sum(ss) * (1.f / DM) + EPS);
#pragma unroll
        for (int j = 0; j < 4; ++j) {
            const int c = (j * 64 + lane) * 4; const float4 g = *(const float4*)(p.norm_mix + c);
            const float a0 = v[j].x * rstd * g.x, a1 = v[j].y * rstd * g.y, a2 = v[j].z * rstd * g.z, a3 = v[j].w * rstd * g.w;
            if (r < NT) { bf16_t* d = p.U() + (size_t)r * DM + c; d[0] = f2bf(a0); d[1] = f2bf(a1); d[2] = f2bf(a2); d[3] = f2bf(a3); }
            else { float* d = p.UM() + (size_t)(r - NT) * DM + c; d[0] = a0; d[1] = a1; d[2] = a2; d[3] = a3; }
        }
    }
}

__global__ void __launch_bounds__(256) k_fold(Params p) {
    const long gid = (long)blockIdx.x * 256 + threadIdx.x, gn = (long)gridDim.x * 256;
    for (long i = gid; i < 256L * 1536; i += gn) {
        const int r = (int)(i / 1536), hc = (int)(i % 1536), h = hc / 192, c = hc % 192;
        const float* uq = p.a_w_uq + ((size_t)r * 8 + h) * 192; float acc;
        if (c >= 128) acc = uq[c];
        else { const float* kv = p.a_w_ukv + ((size_t)c * 8 + h) * 256; acc = 0.f; for (int d = 0; d < 128; ++d) acc += uq[d] * kv[d]; }
        p.WQF()[i] = acc;
    }
    for (long i = gid; i < 1024L * 1024; i += gn) {
        const int hc = (int)(i >> 10), n = (int)(i & 1023), h = hc >> 7, c = hc & 127;
        const float* kv = p.a_w_ukv + ((size_t)c * 8 + h) * 256 + 128; const float* ap = p.w_a_proj + (size_t)(h * 128) * DM + n;
        float acc = 0.f; for (int d = 0; d < 128; ++d) acc += kv[d] * ap[(size_t)d * DM];
        p.WOF()[i] = acc;
    }
    for (long i = gid; i < (long)LTOT * 32; i += gn) {
        const int pos = (int)(i >> 5), f = (int)(i & 31);
        const float freq = powf(10000.f, -(float)f / 32.f), ang = (float)pos * freq; float s, c; sincosf(ang, &s, &c);
        p.ROPE()[i * 2] = c; p.ROPE()[i * 2 + 1] = s;
    }
}

__global__ void __launch_bounds__(256) k_meta_proj(Params p) {
    const int gid = blockIdx.x * 256 + threadIdx.x;
    if (gid >= NMETA * DIN) return;
    const int j = gid / DIN, n = gid % DIN; const float* u = p.UM() + (size_t)j * DM; float acc = 0.f;
    for (int k = 0; k < DM; ++k) acc += u[k] * p.w_in[(size_t)k * DIN + n];
    p.ZM()[gid] = acc;
}

template <class P> __global__ void __launch_bounds__(256) k_sgemm(P q) {
    __shared__ float As[16][68]; __shared__ float Bs[16][68];
    const int ntn = (q.N + 63) / 64, ntm = q.M / 64, tid = threadIdx.x, tx = tid & 15, ty = tid >> 4;
    for (int tile = blockIdx.x; tile < ntm * ntn; tile += gridDim.x) {
        const int tm = tile / ntn, tn = tile % ntn; int ctx = 0;
        if (!q.setup(tm, ctx)) continue;
        float acc[4][4];
#pragma unroll
        for (int i = 0; i < 4; ++i)
#pragma unroll
            for (int j = 0; j < 4; ++j) acc[i][j] = 0.f;
        const int arow = tm * 64 + (tid >> 2), ak = (tid & 3) * 4, bk = tid >> 4, bcol = tn * 64 + (tid & 15) * 4;
        for (int k0 = 0; k0 < q.K; k0 += 16) {
            const float4 av = q.a4(ctx, arow, k0 + ak);
            const float4 bv = bcol < q.N ? q.b4(ctx, k0 + bk, bcol) : make_float4(0.f, 0.f, 0.f, 0.f);
            __syncthreads();
            As[ak + 0][tid >> 2] = av.x; As[ak + 1][tid >> 2] = av.y; As[ak + 2][tid >> 2] = av.z; As[ak + 3][tid >> 2] = av.w;
            *(float4*)&Bs[bk][(tid & 15) * 4] = bv;
            __syncthreads();
#pragma unroll
            for (int kk = 0; kk < 16; ++kk) {
                const float4 a = *(const float4*)&As[kk][ty * 4]; const float4 b = *(const float4*)&Bs[kk][tx * 4];
                const float aa[4] = {a.x, a.y, a.z, a.w}, bb[4] = {b.x, b.y, b.z, b.w};
#pragma unroll
                for (int i = 0; i < 4; ++i)
#pragma unroll
                    for (int j = 0; j < 4; ++j) acc[i][j] += aa[i] * bb[j];
            }
        }
        const int col = tn * 64 + tx * 4;
        if (col < q.N) {
#pragma unroll
            for (int i = 0; i < 4; ++i) q.epi(ctx, tm * 64 + ty * 4 + i, col, acc[i]);
        }
    }
}
__device__ __forceinline__ float4 ld_bf4(const bf16_t* p) { const uint2 w = *(const uint2*)p; return make_float4(__uint_as_float(w.x << 16), __uint_as_float(w.x & 0xffff0000u), __uint_as_float(w.y << 16), __uint_as_float(w.y & 0xffff0000u)); }

struct ProbIn {
    Params p; int M, N, K, pad;
    __device__ bool setup(int, int&) const { return true; }
    __device__ float4 a4(int, int row, int k) const { return ld_bf4(p.U() + (size_t)row * DM + k); }
    __device__ float4 b4(int, int k, int col) const { return *(const float4*)(p.w_in + (size_t)k * DIN + col); }
    __device__ void epi(int, int row, int col, const float (&v)[4]) const {
#pragma unroll
        for (int j = 0; j < 4; ++j) {
            const int c = col + j; const float z = v[j];
            if (c < OFF_K) p.Qm()[(size_t)row * 512 + c] = f2bf(z * 0.125f);
            else if (c < OFF_V) p.Km()[(size_t)row * 512 + (c - OFF_K)] = f2bf(z);
            else if (c < OFF_O) p.Vm()[(size_t)row * 1024 + (c - OFF_V)] = f2bf(z);
            else if (c < OFF_I) p.OG()[(size_t)row * 1024 + (c - OFF_O)] = f2bf(sigmoidf_(z));
            else if (c < OFF_F) p.GI()[(size_t)row * 16 + (c - OFF_I)] = z + p.m_b_i[c - OFF_I];
            else if (c < OFF_CQ) p.GF()[(size_t)row * 16 + (c - OFF_F)] = logsigmoidf_(z + p.m_b_f[c - OFF_F]);
            else if (c < OFF_CKV) p.CQ()[(size_t)row * 256 + (c - OFF_CQ)] = z;
            else if (c < OFF_KR) p.CKV()[(size_t)row * 128 + (c - OFF_CKV)] = z;
            else if (c < OFF_G) p.KR()[(size_t)row * 64 + (c - OFF_KR)] = z;
            else p.GATE()[(size_t)row * 2048 + (c - OFF_G)] = f2bf(sigmoidf_(z));
        }
    }
};

__global__ void __launch_bounds__(256) k_kprep(Params p) {
    const int lane = threadIdx.x & 63, gw = (blockIdx.x * 256 + threadIdx.x) >> 6, ngw = (gridDim.x * 256) >> 6;
    for (int i = gw; i < NB * KVROWS; i += ngw) {
        const int b = i / KVROWS, key = i % KVROWS; bf16_t* dst = p.Kc() + (size_t)i * 192;
        if (key >= LTOT) { dst[lane] = 0; dst[64 + lane] = 0; dst[128 + lane] = 0; continue; }
        const float *ckv, *kr; int pos;
        if (key < SEQ) { const size_t r = (size_t)b * SEQ + key; ckv = p.CKV() + r * 128; kr = p.KR() + r * 64; pos = NMETA + key; }
        else { const int j = key - SEQ; ckv = p.ZM() + (size_t)j * DIN + OFF_CKV; kr = p.ZM() + (size_t)j * DIN + OFF_KR; pos = j; }
        const float c0 = ckv[lane], c1 = ckv[64 + lane];
        const float rstd = rsqrtf(wave_sum(c0 * c0 + c1 * c1) * (1.f / 128.f) + EPS);
        dst[lane] = f2bf(c0 * rstd * p.a_norm_kv[lane]); dst[64 + lane] = f2bf(c1 * rstd * p.a_norm_kv[64 + lane]);
        if (lane < 32) {
            const float x1 = kr[lane], x2 = kr[32 + lane], cs = p.ROPE()[((size_t)pos * 32 + lane) * 2], sn = p.ROPE()[((size_t)pos * 32 + lane) * 2 + 1];
            dst[128 + lane] = f2bf(x1 * cs - x2 * sn); dst[160 + lane] = f2bf(x1 * sn + x2 * cs);
        }
    }
    for (int r = gw; r < NT; r += ngw) {
        float* cq = p.CQ() + (size_t)r * 256; float v[4]; float ss = 0.f;
#pragma unroll
        for (int j = 0; j < 4; ++j) { v[j] = cq[j * 64 + lane]; ss += v[j] * v[j]; }
        const float rstd = rsqrtf(wave_sum(ss) * (1.f / 256.f) + EPS);
#pragma unroll
        for (int j = 0; j < 4; ++j) cq[j * 64 + lane] = v[j] * rstd * p.a_norm_q[j * 64 + lane];
    }
}

struct ProbQ {
    Params p; int M, N, K, pad;
    __device__ bool setup(int, int&) const { return true; }
    __device__ float4 a4(int, int row, int k) const { return *(const float4*)(p.CQ() + (size_t)row * 256 + k); }
    __device__ float4 b4(int, int k, int col) const { return *(const float4*)(p.WQF() + (size_t)k * 1536 + col); }
    __device__ void epi(int, int row, int col, const float (&v)[4]) const {
        const int h = col / 192, c = col % 192;
        if (c < 128) {
#pragma unroll
            for (int j = 0; j < 4; ++j) p.QP()[(size_t)row * 1536 + col + j] = f2bf(v[j] * QSCALE);
        } else {
#pragma unroll
            for (int j = 0; j < 4; ++j) p.QP()[(size_t)row * 1536 + col + j] = f2bf(v[j] * QSCALE);
        }
        (void)h;
    }
};
__global__ void __launch_bounds__(256) k_rope_q(Params p) {
    const long gid = (long)blockIdx.x * 256 + threadIdx.x;
    if (gid >= (long)NT * 8 * 32) return;
    const int i = (int)(gid & 31), h = (int)((gid >> 5) & 7); const long r = gid >> 8; const int pos = NMETA + (int)(r % SEQ);
    bf16_t* q = p.QP() + (size_t)r * 1536 + h * 192 + 128;
    const float x1 = bf2f(q[i]), x2 = bf2f(q[32 + i]), cs = p.ROPE()[((size_t)pos * 32 + i) * 2], sn = p.ROPE()[((size_t)pos * 32 + i) * 2 + 1];
    q[i] = f2bf(x1 * cs - x2 * sn); q[32 + i] = f2bf(x1 * sn + x2 * cs);
}

__global__ void __launch_bounds__(256) k_mlstm_scan(Params p) {
    __shared__ float ks[64][65]; __shared__ float vs[64][128]; __shared__ float wk[64]; __shared__ float li[64], lf[64]; __shared__ float sc[2];
    const int tid = threadIdx.x, b = blockIdx.x >> 4, h = (blockIdx.x >> 1) & 7, dir = blockIdx.x & 1;
    const int d = tid >> 2, vq = tid & 3;
    float C[32]; float n = 0.f, m = 0.f;
#pragma unroll
    for (int i = 0; i < 32; ++i) C[i] = 0.f;
    bf16_t* CS = dir ? p.CB() : p.CF(); float* NS = dir ? p.NB_() : p.NF(); float* MS = dir ? p.MB() : p.MF();
    const int nsteps = dir ? 64 : 65;
    for (int st = 0; st < nsteps; ++st) {
        const int c = dir ? 63 - st : st - 1;
        if (c >= 0) {
            const size_t sidx = ((size_t)(b * 8 + h) * 64 + c);
            bf16_t* cd = CS + sidx * 8192 + d * 128 + vq * 32;
#pragma unroll
            for (int i = 0; i < 32; ++i) cd[i] = f2bf(C[i]);
            if (vq == 0) NS[sidx * 64 + d] = n;
            if (tid == 0) MS[sidx] = m;
            if ((dir == 0 && c == 63) || (dir == 1 && c == 0)) break;
        }
        const int npos = c < 0 ? NMETA : 64;
        __syncthreads();
        for (int e = tid; e < 64 * 64; e += 256) { const int j = e >> 6, dd = e & 63; float v = 0.f;
            if (j < npos) { if (c < 0) v = p.ZM()[(size_t)j * DIN + OFF_K + h * 64 + dd]; else { const int t = dir ? 63 - j : j; v = bf2f(p.Km()[((size_t)b * SEQ + c * 64 + t) * 512 + h * 64 + dd]); } }
            ks[j][dd] = v; }
        for (int e = tid; e < 64 * 128; e += 256) { const int j = e >> 7, dd = e & 127; float v = 0.f;
            if (j < npos) { if (c < 0) v = p.ZM()[(size_t)j * DIN + OFF_V + h * 128 + dd]; else { const int t = dir ? 63 - j : j; v = bf2f(p.Vm()[((size_t)b * SEQ + c * 64 + t) * 1024 + h * 128 + dd]); } }
            vs[j][dd] = v; }
        if (tid < 64) { float a = -1e30f, f = 0.f; const int j = tid;
            if (j < npos) { if (c < 0) { a = p.ZM()[(size_t)j * DIN + OFF_I + h] + p.m_b_i[h]; f = logsigmoidf_(p.ZM()[(size_t)j * DIN + OFF_F + h] + p.m_b_f[h]); }
                            else { const int t = dir ? 63 - j : j; const size_t r = (size_t)b * SEQ + c * 64 + t; a = p.GI()[r * 16 + dir * 8 + h]; f = p.GF()[r * 16 + dir * 8 + h]; } }
            li[j] = a; lf[j] = f; }
        __syncthreads();
        if (tid == 0) {
            float bl = 0.f; for (int j = 0; j < npos; ++j) bl += lf[j];
            float bc = 0.f, gmax = -1e30f;
            for (int j = 0; j < npos; ++j) { bc += lf[j]; const float g = bl - bc + li[j]; wk[j] = g; gmax = fmaxf(gmax, g); }
            const float mnew = fmaxf(bl + m, gmax);
            for (int j = 0; j < 64; ++j) wk[j] = j < npos ? __expf(wk[j] - mnew) : 0.f;
            sc[0] = __expf(bl + m - mnew); sc[1] = mnew;
        }
        __syncthreads();
        const float decay = sc[0]; m = sc[1];
#pragma unroll
        for (int i = 0; i < 32; ++i) C[i] *= decay;
        n *= decay;
        for (int j = 0; j < npos; ++j) { const float kw = wk[j] * ks[j][d]; n += kw;
#pragma unroll
            for (int i = 0; i < 32; ++i) C[i] += kw * vs[j][vq * 32 + i]; }
    }
}

constexpr int MO_LDS = (64 * 65 * 3 + 64 * 128 * 2 + 64 * 8) * 4;
__global__ void __launch_bounds__(256) k_mlstm_out(Params p) {
    extern __shared__ __attribute__((aligned(16))) float sm[];
    float (*qs)[65] = (float (*)[65])sm; float (*ks)[65] = (float (*)[65])(sm + 64 * 65); float (*Ws)[65] = (float (*)[65])(sm + 2 * 64 * 65);
    float (*vs)[128] = (float (*)[128])(sm + 3 * 64 * 65); float (*Cs)[128] = (float (*)[128])(sm + 3 * 64 * 65 + 64 * 128);
    float* sx = sm + 3 * 64 * 65 + 2 * 64 * 128; float *li = sx, *lf = sx + 64, *bt = sx + 128, *mt = sx + 192, *as = sx + 256, *ns = sx + 320, *msc = sx + 384;
    const int tid = threadIdx.x, c = blockIdx.x & 63, h = (blockIdx.x >> 6) & 7, b = blockIdx.x >> 9;
    const int t = tid >> 2, vq = tid & 3; const size_t r0 = (size_t)b * SEQ + c * 64;
    for (int e = tid; e < 64 * 64; e += 256) { const int j = e >> 6, dd = e & 63; qs[j][dd] = bf2f(p.Qm()[(r0 + j) * 512 + h * 64 + dd]); ks[j][dd] = bf2f(p.Km()[(r0 + j) * 512 + h * 64 + dd]); }
    for (int e = tid; e < 64 * 128; e += 256) { const int j = e >> 7, dd = e & 127; vs[j][dd] = bf2f(p.Vm()[(r0 + j) * 1024 + h * 128 + dd]); }
    __syncthreads();
    float S[16];
#pragma unroll
    for (int i = 0; i < 16; ++i) { const int s = vq * 16 + i; float a = 0.f;
#pragma unroll 4
        for (int dd = 0; dd < 64; ++dd) a += qs[t][dd] * ks[s][dd]; S[i] = a; }
    float hacc[32];
#pragma unroll
    for (int i = 0; i < 32; ++i) hacc[i] = 0.f;
#pragma unroll 1
    for (int dir = 0; dir < 2; ++dir) {
        const size_t sidx = ((size_t)(b * 8 + h) * 64 + c);
        const bf16_t* CS = (dir ? p.CB() : p.CF()) + sidx * 8192; const float* NS = (dir ? p.NB_() : p.NF()) + sidx * 64; const float* MS = (dir ? p.MB() : p.MF()) + sidx;
        __syncthreads();
        for (int e = tid; e < 64 * 128; e += 256) Cs[e >> 7][e & 127] = bf2f(CS[e]);
        if (tid < 64) { ns[tid] = NS[tid]; li[tid] = p.GI()[(r0 + tid) * 16 + dir * 8 + h]; lf[tid] = p.GF()[(r0 + tid) * 16 + dir * 8 + h]; }
        if (tid == 0) msc[0] = MS[0];
        __syncthreads();
        if (tid == 0) {
            const float m = msc[0]; float bc = 0.f, pm = -1e30f;
            if (dir == 0) { for (int j = 0; j < 64; ++j) { bc += lf[j]; const float a = li[j] - bc; as[j] = a; pm = fmaxf(pm, a); bt[j] = bc; mt[j] = fmaxf(bc + m, bc + pm); } }
            else { for (int j = 63; j >= 0; --j) { bc += lf[j]; const float a = li[j] - bc; as[j] = a; pm = fmaxf(pm, a); bt[j] = bc; mt[j] = fmaxf(bc + m, bc + pm); } }
        }
        __syncthreads();
        const float m = msc[0], b_t = bt[t], m_t = mt[t];
#pragma unroll
        for (int i = 0; i < 16; ++i) { const int s = vq * 16 + i; const bool valid = dir ? (s >= t) : (s <= t); Ws[t][s] = valid ? __expf(b_t + as[s] - m_t) * S[i] : 0.f; }
        __syncthreads();
        const float s_inter = __expf(b_t + m - m_t);
        float num[32]; float den = 0.f, qn = 0.f;
#pragma unroll
        for (int i = 0; i < 32; ++i) num[i] = 0.f;
#pragma unroll 2
        for (int dd = 0; dd < 64; ++dd) { const float qv = qs[t][dd]; qn += qv * ns[dd];
#pragma unroll
            for (int i = 0; i < 32; ++i) num[i] += qv * Cs[dd][vq * 32 + i]; }
#pragma unroll
        for (int i = 0; i < 32; ++i) num[i] *= s_inter;
        den = s_inter * qn;
#pragma unroll 2
        for (int s = 0; s < 64; ++s) { const float w = Ws[t][s]; den += w;
#pragma unroll
            for (int i = 0; i < 32; ++i) num[i] += w * vs[s][vq * 32 + i]; }
        const float inv = 1.f / fmaxf(fabsf(den), __expf(-m_t));
#pragma unroll
        for (int i = 0; i < 32; ++i) hacc[i] += num[i] * inv;
    }
    float ss = 0.f;
#pragma unroll
    for (int i = 0; i < 32; ++i) ss += hacc[i] * hacc[i];
    ss += __shfl_xor(ss, 1); ss += __shfl_xor(ss, 2);
    const float rstd = rsqrtf(ss * (1.f / 128.f) + EPS);
#pragma unroll
    for (int i = 0; i < 32; ++i) { const int col = h * 128 + vq * 32 + i; const size_t o = (r0 + t) * 1024 + col;
        p.HM()[o] = f2bf(hacc[i] * rstd * p.m_norm[col] * bf2f(p.OG()[o])); }
}

__global__ void __launch_bounds__(256) k_attn(Params p) {
    __shared__ float kt[32][192];
    const int tid = threadIdx.x, qi = tid >> 2, sl = tid & 3, qb = blockIdx.x & 63, h = (blockIdx.x >> 6) & 7, b = blockIdx.x >> 9;
    const size_t r = (size_t)b * SEQ + qb * 64 + qi;
    float q[48], o[32]; float m = -1e30f, l = 0.f;
#pragma unroll
    for (int i = 0; i < 48; ++i) q[i] = bf2f(p.QP()[r * 1536 + h * 192 + i * 4 + sl]);
#pragma unroll
    for (int i = 0; i < 32; ++i) o[i] = 0.f;
    const bf16_t* Kb = p.Kc() + (size_t)b * KVROWS * 192;
#pragma unroll 1
    for (int tile = 0; tile < KVROWS / 32; ++tile) {
        __syncthreads();
        for (int e = tid; e < 32 * 192; e += 256) kt[e / 192][e % 192] = bf2f(Kb[(size_t)tile * 32 * 192 + e]);
        __syncthreads();
#pragma unroll 1
        for (int g = 0; g < 4; ++g) {
            float s[8]; float tmax = -1e30f;
#pragma unroll
            for (int j = 0; j < 8; ++j) { float a = 0.f; const float* kr = &kt[g * 8 + j][sl];
#pragma unroll
                for (int i = 0; i < 48; ++i) a += q[i] * kr[i * 4];
                a += __shfl_xor(a, 1); a += __shfl_xor(a, 2);
                if (tile * 32 + g * 8 + j >= LTOT) a = -1e30f;
                s[j] = a; tmax = fmaxf(tmax, a); }
            const float mn = fmaxf(m, tmax), alpha = exp2f(m - mn); m = mn; l *= alpha;
#pragma unroll
            for (int i = 0; i < 32; ++i) o[i] *= alpha;
#pragma unroll
            for (int j = 0; j < 8; ++j) { const float pj = (tile * 32 + g * 8 + j >= LTOT) ? 0.f : exp2f(s[j] - mn); l += pj; const float* kr = &kt[g * 8 + j][sl];
#pragma unroll
                for (int i = 0; i < 32; ++i) o[i] += pj * kr[i * 4]; }
        }
    }
    const float inv = 1.f / l;
#pragma unroll
    for (int i = 0; i < 32; ++i) p.OA()[r * 1024 + h * 128 + i * 4 + sl] = f2bf(o[i] * inv);
}

struct ProbYm {
    Params p; int M, N, K, pad;
    __device__ bool setup(int, int&) const { return true; }
    __device__ float4 a4(int, int row, int k) const { return ld_bf4(p.HM() + (size_t)row * DM + k); }
    __device__ float4 b4(int, int k, int col) const { return *(const float4*)(p.w_m_proj + (size_t)k * DM + col); }
    __device__ void epi(int, int row, int col, const float (&v)[4]) const {
#pragma unroll
        for (int j = 0; j < 4; ++j) p.MIX()[(size_t)row * DM + col + j] = f2bf(v[j] * bf2f(p.GATE()[(size_t)row * 2048 + col + j]));
    }
};
struct ProbYa {
    Params p; int M, N, K, pad;
    __device__ bool setup(int, int&) const { return true; }
    __device__ float4 a4(int, int row, int k) const { return ld_bf4(p.OA() + (size_t)row * DM + k); }
    __device__ float4 b4(int, int k, int col) const { return *(const float4*)(p.WOF() + (size_t)k * DM + col); }
    __device__ void epi(int, int row, int col, const float (&v)[4]) const {
#pragma unroll
        for (int j = 0; j < 4; ++j) { const size_t o = (size_t)row * DM + col + j; p.MIX()[o] = f2bf(bf2f(p.MIX()[o]) + v[j] * bf2f(p.GATE()[(size_t)row * 2048 + 1024 + col + j])); }
    }
};
struct ProbOut {
    Params p; int M, N, K, pad;
    __device__ bool setup(int, int&) const { return true; }
    __device__ float4 a4(int, int row, int k) const { return ld_bf4(p.MIX() + (size_t)row * DM + k); }
    __device__ float4 b4(int, int k, int col) const { return *(const float4*)(p.w_out + (size_t)k * DM + col); }
    __device__ void epi(int, int row, int col, const float (&v)[4]) const {
        const float4 xv = *(const float4*)(p.x + (size_t)row * DM + col);
        *(float4*)(p.out + (size_t)row * DM + col) = make_float4(xv.x + v[0], xv.y + v[1], xv.z + v[2], xv.w + v[3]);
    }
};

__global__ void __launch_bounds__(256) k_route(Params p) {
    __shared__ float xn[8][1024];
    const int tid = threadIdx.x, lane = tid & 63, w = tid >> 6;
    for (int base = blockIdx.x * 8; base < NT; base += gridDim.x * 8) {
        __syncthreads();
        for (int rr = 0; rr < 2; ++rr) {
            const int row = base + w * 2 + rr; const float* src = p.out + (size_t)row * DM;
            float4 v[4]; float ss = 0.f;
#pragma unroll
            for (int j = 0; j < 4; ++j) { v[j] = *(const float4*)(src + (j * 64 + lane) * 4); ss += v[j].x * v[j].x + v[j].y * v[j].y + v[j].z * v[j].z + v[j].w * v[j].w; }
            const float rstd = rsqrtf(wave_sum(ss) * (1.f / DM) + EPS);
#pragma unroll
            for (int j = 0; j < 4; ++j) { const int c = (j * 64 + lane) * 4; const float4 g = *(const float4*)(p.norm_ffn + c);
                const float a0 = v[j].x * rstd * g.x, a1 = v[j].y * rstd * g.y, a2 = v[j].z * rstd * g.z, a3 = v[j].w * rstd * g.w;
                float* d = &xn[w * 2 + rr][c]; d[0] = a0; d[1] = a1; d[2] = a2; d[3] = a3;
                bf16_t* o = p.XN2() + (size_t)row * DM + c; o[0] = f2bf(a0); o[1] = f2bf(a1); o[2] = f2bf(a2); o[3] = f2bf(a3); }
        }
        __syncthreads();
        const int rloc = w * 2 + (lane >> 5), e = lane & 31, row = base + rloc;
        float acc = p.b_router[e];
        for (int k = 0; k < DM; ++k) acc += xn[rloc][k] * p.w_router[(size_t)k * NEXP + e];
        float val = acc; int ti[4]; float tv[4];
#pragma unroll
        for (int kk = 0; kk < 4; ++kk) {
            float best = val; int bi = e;
#pragma unroll
            for (int o = 1; o < 32; o <<= 1) { const float ov = __shfl_xor(best, o); const int oi = __shfl_xor(bi, o); if (ov > best || (ov == best && oi < bi)) { best = ov; bi = oi; } }
            ti[kk] = bi; tv[kk] = best; if (e == bi) val = -3.0e38f;
        }
        if (e == 0) {
            const float mx = tv[0]; float ex[4], sum = 0.f;
#pragma unroll
            for (int kk = 0; kk < 4; ++kk) { ex[kk] = __expf(tv[kk] - mx); sum += ex[kk]; }
#pragma unroll
            for (int kk = 0; kk < 4; ++kk) { p.TOPI()[row * 4 + kk] = ti[kk]; p.TOPW()[row * 4 + kk] = ex[kk] / sum; p.RANK()[row * 4 + kk] = atomicAdd(&p.CNT()[ti[kk] * CNT_STRIDE], 1); }
        }
    }
}
__device__ __forceinline__ int expert_pstart(const int* cnt, int e) { int s = 0; for (int i = 0; i < e; ++i) s += (cnt[i * CNT_STRIDE] + 255) / 256 * 256; return s; }
__global__ void __launch_bounds__(256) k_scatter(Params p) {
    __shared__ int ps[NEXP];
    if (threadIdx.x < NEXP) ps[threadIdx.x] = expert_pstart(p.CNT(), threadIdx.x);
    __syncthreads();
    const int gid = blockIdx.x * 256 + threadIdx.x; if (gid >= NT * 4) return;
    const int slot = ps[p.TOPI()[gid]] + p.RANK()[gid]; p.SLOTS()[gid] = slot; p.SLOT_TOK()[slot] = gid >> 2;
}

struct ProbM1 {
    Params p; int M, N, K, pad;
    __device__ bool setup(int tm, int& e) const {
        int s = 0; e = -1;
        for (int i = 0; i < NEXP; ++i) { const int pc = (p.CNT()[i * CNT_STRIDE] + 255) / 256 * 256; if (tm * 64 < s + pc) { e = i; break; } s += pc; }
        return e >= 0;
    }
    __device__ float4 a4(int, int row, int k) const { const int tok = p.SLOT_TOK()[row]; return tok < 0 ? make_float4(0.f, 0.f, 0.f, 0.f) : ld_bf4(p.XN2() + (size_t)tok * DM + k); }
    __device__ float4 b4(int e, int k, int col) const { const float* w = p.w1 + ((size_t)e * DM + k) * 2048 + (col >> 1); const float2 g = *(const float2*)w, l = *(const float2*)(w + 1024); return make_float4(g.x, l.x, g.y, l.y); }
    __device__ void epi(int e, int row, int col, const float (&v)[4]) const {
#pragma unroll
        for (int j = 0; j < 2; ++j) { const int c = (col >> 1) + j; const float g0 = v[2 * j] + p.b1[(size_t)e * 2048 + c], l0 = v[2 * j + 1] + p.b1[(size_t)e * 2048 + 1024 + c];
            const float glu = fminf(g0, 7.f), lin = fminf(fmaxf(l0, -7.f), 7.f);
            p.ACT()[(size_t)row * DFF + c] = f2bf(glu * sigmoidf_(1.702f * glu) * (lin + 1.f)); }
    }
};
struct ProbM2 {
    Params p; int M, N, K, pad;
    __device__ bool setup(int tm, int& e) const {
        int s = 0; e = -1;
        for (int i = 0; i < NEXP; ++i) { const int pc = (p.CNT()[i * CNT_STRIDE] + 255) / 256 * 256; if (tm * 64 < s + pc) { e = i; break; } s += pc; }
        return e >= 0;
    }
    __device__ float4 a4(int, int row, int k) const { return ld_bf4(p.ACT() + (size_t)row * DFF + k); }
    __device__ float4 b4(int e, int k, int col) const { return *(const float4*)(p.w2 + ((size_t)e * DFF + k) * DM + col); }
    __device__ void epi(int e, int row, int col, const float (&v)[4]) const {
#pragma unroll
        for (int j = 0; j < 4; ++j) p.YB()[(size_t)row * DM + col + j] = f2bf(v[j] + p.b2[(size_t)e * DM + col + j]);
    }
};

__global__ void __launch_bounds__(256) k_combine(Params p) {
    const int lane = threadIdx.x & 63, gw = (blockIdx.x * 256 + threadIdx.x) >> 6, ngw = (gridDim.x * 256) >> 6;
    for (int r = gw; r < NT; r += ngw) {
        float4 v[4];
#pragma unroll
        for (int j = 0; j < 4; ++j) v[j] = *(const float4*)(p.out + (size_t)r * DM + (j * 64 + lane) * 4);
#pragma unroll
        for (int kk = 0; kk < 4; ++kk) { const float w = p.TOPW()[r * 4 + kk]; const bf16_t* y = p.YB() + (size_t)p.SLOTS()[r * 4 + kk] * DM;
#pragma unroll
            for (int j = 0; j < 4; ++j) { const float4 t = ld_bf4(y + (j * 64 + lane) * 4); v[j].x += w * t.x; v[j].y += w * t.y; v[j].z += w * t.z; v[j].w += w * t.w; } }
        float ss = 0.f;
#pragma unroll
        for (int j = 0; j < 4; ++j) ss += v[j].x * v[j].x + v[j].y * v[j].y + v[j].z * v[j].z + v[j].w * v[j].w;
        const float rstd = rsqrtf(wave_sum(ss) * (1.f / DM) + EPS);
#pragma unroll
        for (int j = 0; j < 4; ++j) { const int c = (j * 64 + lane) * 4; const float4 g = *(const float4*)(p.norm_final + c);
            *(float4*)(p.out + (size_t)r * DM + c) = make_float4(v[j].x * rstd * g.x, v[j].y * rstd * g.y, v[j].z * rstd * g.z, v[j].w * rstd * g.w); }
    }
}

#define LAS __attribute__((address_space(3)))
typedef short bf16x8 __attribute__((ext_vector_type(8)));
typedef float f32x4 __attribute__((ext_vector_type(4)));
typedef float f32x2 __attribute__((ext_vector_type(2)));
typedef unsigned u32x4 __attribute__((ext_vector_type(4)));
typedef unsigned u32x2 __attribute__((ext_vector_type(2)));
typedef int v4i __attribute__((ext_vector_type(4)));
typedef int v8i __attribute__((ext_vector_type(8)));

constexpr int MK_THREADS = 512;
constexpr int RING_BYTES = 131072, MISC_OFF = RING_BYTES, MK_LDS = 147456;
constexpr int NIN_PAD = 5632;

namespace pg8 {
constexpr int BM = 256, BK = 64, HALF = 128, HTB = HALF * BK * 2, NXCD = 8, WGM = 8;
__host__ __device__ __forceinline__ int lds_byte(int r, int c) { const int st = (r >> 4) * 2 + (c >> 5), rr = r & 15, cc = c & 31, ob = rr * 64 + cc * 2; return st * 1024 + (ob ^ (((ob >> 9) & 1) << 5)); }
__host__ __device__ __forceinline__ void stage_rc(int b, int& R, int& C) { const int st = b / 1024, sb = b % 1024, swz = sb ^ (((sb >> 9) & 1) << 5); R = (st >> 1) * 16 + swz / 64; C = (st & 1) * 32 + (swz % 64) / 2; }
__host__ __device__ __forceinline__ int perm32(int rho) { const int n = rho >> 4, i = rho & 15; return 8 * (i >> 2) + 4 * n + (i & 3); }
__device__ __forceinline__ unsigned cvt_pk_bf16(float lo, float hi) { unsigned r; asm volatile("v_cvt_pk_bf16_f32 %0, %1, %2" : "=v"(r) : "v"(lo), "v"(hi)); return r; }

struct Unit { int pm, pn, e; const char* A; const char* B; };

struct StaticOrder {
    int nM, nN, nwg, G, c; const char* A; const char* Bt; size_t btile;
    __device__ void init(int M, int N, int K, int G_, int c_, const void* A_, const void* Bt_) { nM = M / BM; nN = N / BM; nwg = nM * nN; G = G_; c = c_; A = (const char*)A_; Bt = (const char*)Bt_; btile = (size_t)BM * K * 2; }
    __device__ bool next(int i, Unit& u) const {
        const long L = (long)i * G + c; if (L >= nwg) return false;
        int wgid = (int)L; { const int q = nwg / NXCD, r = nwg % NXCD, xcd = wgid % NXCD, off = wgid / NXCD; wgid = (xcd < r ? xcd * (q + 1) : r * (q + 1) + (xcd - r) * q) + off; }
        const int nig = WGM * nN, gid = wgid / nig, fm = gid * WGM, gsz = (nM - fm) < WGM ? (nM - fm) : WGM;
        u.pm = fm + ((wgid % nig) % gsz); u.pn = (wgid % nig) / gsz; u.e = 0; u.A = A; u.B = Bt + (size_t)u.pn * btile; return true;
    }
    __device__ __forceinline__ int arow(int r) const { return r; }
    static constexpr bool HAS_BIAS = false;
    __device__ __forceinline__ const float* bias_src(const Unit&, int) const { return nullptr; }
};
struct MoeOrder {
    const volatile LAS int* tstart;
    int npn, G, c; const char* A; const char* W; size_t wexp, btile; const int* rowidx;
    const float* bias; int bsplit;
    __device__ bool next(int i, Unit& u) const {
        const long L = (long)i * G + c; const int ntile = tstart[NEXP]; if (L >= (long)ntile * npn) return false;
        const int mt = (int)(L / npn), pn = (int)(L % npn);
        const int k = (int)(threadIdx.x & 31u); const int tv = tstart[k];
        const int e = __builtin_popcount((unsigned)__ballot(k >= 1 && tv <= mt));
        u.pm = mt; u.pn = pn; u.e = e; u.A = A; u.B = W + (size_t)e * wexp + (size_t)pn * btile; return true;
    }
    __device__ __forceinline__ int arow(int r) const { if (!rowidx) return r; const int t = rowidx[r]; return t < 0 ? 0 : t; }
    static constexpr bool HAS_BIAS = true;
    __device__ __forceinline__ const float* bias_src(const Unit& u, int lane) const {
        return bsplit ? bias + (size_t)u.e * 2048 + (lane >> 5) * 1024 + u.pn * 128 + (lane & 31) * 4 : bias + (size_t)u.e * 1024 + u.pn * 256 + lane * 4; }
};

template <class Epi, class Sched, bool F8 = false>
__device__ __forceinline__ void gemm_phase(LAS unsigned char* lds, const int K, const int lda, const Sched& S, const Epi& E) {
    const int tid = threadIdx.x, wid = __builtin_amdgcn_readfirstlane(tid >> 6), lane = tid & 63, wr = wid >> 2, wc = wid & 3, fr = lane & 15, fq = lane >> 4;
    const int nt = K / BK;
    unsigned voffB[2];
#pragma unroll
    for (int i = 0; i < 2; ++i) { int R, C; stage_rc(tid * 16 + i * 8192, R, C); const int Rb = Epi::PERM ? ((R & ~31) + perm32(R & 31)) : R; voffB[i] = (unsigned)(Rb * K + C) * 2u; }
    const size_t kstep = (size_t)(BK * 2);
    const size_t hstepB = (size_t)HALF * K * 2;
    const unsigned ldsw = (unsigned)wid * 1024u;
    const int aoff = lds_byte(wr * 64 + fr, fq * 8), boff = lds_byte(wc * 32 + fr, fq * 8);
#define PG8_SA(b, h) (((b) * 2 + (h)) * HTB)
#define PG8_SB(b, h) ((4 + (b) * 2 + (h)) * HTB)
#define PG8_STAGE(bufoff, gbase, voff) do { _Pragma("unroll") for (int _i = 0; _i < 2; ++_i) \
        __builtin_amdgcn_global_load_lds((const unsigned*)((const char*)(gbase) + (voff)[_i]), (LAS unsigned*)(lds + (bufoff) + ldsw + _i * 8192), 16, 0, 0); } while (0)
#define PG8_STAGE_B(bufoff, gbase) do { if constexpr (F8) { const u32x2 vo_ = *(const LAS u32x2*)vslot; const unsigned vv_[2] = {vo_[0], vo_[1]}; PG8_STAGE(bufoff, gbase, vv_); } else PG8_STAGE(bufoff, gbase, voffB); } while (0)
#define PG8_STAGE_A(bufoff, gbase, h) do { if constexpr (F8) { const u32x2 vo_ = *(const LAS u32x2*)(vslot + 2 + 2 * (h)); const unsigned vv_[2] = {vo_[0], vo_[1]}; PG8_STAGE(bufoff, gbase, vv_); } else PG8_STAGE(bufoff, gbase, vc[h]); } while (0)
#define PG8_LDA(dst, b, h) do { _Pragma("unroll") for (int m = 0; m < 4; ++m) _Pragma("unroll") for (int k = 0; k < 2; ++k) dst[m][k] = *(const LAS bf16x8*)(lds + PG8_SA(b, h) + aoff + m * 2048 + k * 1024); } while (0)
#define PG8_LDB(dst, b, h) do { _Pragma("unroll") for (int n = 0; n < 2; ++n) _Pragma("unroll") for (int k = 0; k < 2; ++k) dst[n][k] = *(const LAS bf16x8*)(lds + PG8_SB(b, h) + boff + n * 2048 + k * 1024); } while (0)
#define PG8_MMA(ai, bj, At, Bt) do { __builtin_amdgcn_s_setprio(1); _Pragma("unroll") for (int m = 0; m < 4; ++m) _Pragma("unroll") for (int n = 0; n < 2; ++n) _Pragma("unroll") for (int k = 0; k < 2; ++k) \
        acc[ai][bj][m][n] = __builtin_amdgcn_mfma_f32_16x16x32_bf16(Bt[n][k], At[m][k], acc[ai][bj][m][n], 0, 0, 0); __builtin_amdgcn_s_setprio(0); } while (0)
#define PG8_LDA8(dst, b, h) do { _Pragma("unroll") for (int m = 0; m < 4; ++m) dst[m] = __builtin_shufflevector(*(const LAS v4i*)(lds + PG8_SA(b, h) + aoff + m * 2048), *(const LAS v4i*)(lds + PG8_SA(b, h) + aoff + m * 2048 + 1024), 0, 1, 2, 3, 4, 5, 6, 7); } while (0)
#define PG8_LDB8(dst, b, h) do { _Pragma("unroll") for (int n = 0; n < 2; ++n) dst[n] = __builtin_shufflevector(*(const LAS v4i*)(lds + PG8_SB(b, h) + boff + n * 2048), *(const LAS v4i*)(lds + PG8_SB(b, h) + boff + n * 2048 + 1024), 0, 1, 2, 3, 4, 5, 6, 7); } while (0)
#define PG8_MMA8(ai, bj, At, Bt) do { __builtin_amdgcn_s_setprio(1); _Pragma("unroll") for (int m = 0; m < 4; ++m) _Pragma("unroll") for (int n = 0; n < 2; ++n) \
        acc[ai][bj][m][n] = __builtin_amdgcn_mfma_scale_f32_16x16x128_f8f6f4(Bt[n], At[m], acc[ai][bj][m][n], 0, 0, 0, 122, 0, 127); __builtin_amdgcn_s_setprio(0); } while (0)
#define PG8_XLDA(b, h) do { if constexpr (F8) PG8_LDA8(At8, b, h); else PG8_LDA(At, b, h); } while (0)
#define PG8_XLDB0(b, h) do { if constexpr (F8) PG8_LDB8(B08, b, h); else PG8_LDB(B0, b, h); } while (0)
#define PG8_XLDB1(b, h) do { if constexpr (F8) PG8_LDB8(B18, b, h); else PG8_LDB(B1, b, h); } while (0)
#define PG8_XMM0(ai, bj) do { if constexpr (F8) PG8_MMA8(ai, bj, At8, B08); else PG8_MMA(ai, bj, At, B0); } while (0)
#define PG8_XMM1(ai, bj) do { if constexpr (F8) PG8_MMA8(ai, bj, At8, B18); else PG8_MMA(ai, bj, At, B1); } while (0)
#define PG8_WAIT_V(n) asm volatile("s_waitcnt vmcnt(" #n ")" ::: "memory")
#define PG8_WAIT_L(n) asm volatile("s_waitcnt lgkmcnt(" #n ")" ::: "memory")
#define PG8_BAR __builtin_amdgcn_s_barrier()
#define PG8_SCHED __builtin_amdgcn_sched_barrier(0)
#define PG8_VOFF(dst, u) do { int _tt = tid; asm volatile("" : "+v"(_tt)); _Pragma("unroll") for (int _i = 0; _i < 2; ++_i) { int _R, _C; stage_rc(_tt * 16 + _i * 8192, _R, _C); \
        _Pragma("unroll") for (int _h = 0; _h < 2; ++_h) dst[_h][_i] = (unsigned)(S.arow((u).pm * BM + _h * HALF + _R) * lda + _C) * 2u; } } while (0)
    constexpr bool HB = Sched::HAS_BIAS;
    LAS float* bias_l = (LAS float*)(lds + MISC_OFF + 13312);
#define PG8_BIAS(u) do { if constexpr (HB) { if (wid == 0) __builtin_amdgcn_global_load_lds((const unsigned*)S.bias_src(u, lane), (LAS unsigned*)bias_l, 16, 0, 0); } } while (0)
#define PG8_ACC_INIT() do { f32x4 bv_[2][2]; _Pragma("unroll") for (int b = 0; b < 2; ++b) _Pragma("unroll") for (int n = 0; n < 2; ++n) { \
        if constexpr (HB) bv_[b][n] = *(const LAS f32x4*)(bias_l + b * 128 + wc * 32 + 8 * fq + 4 * n); else bv_[b][n] = (f32x4){0.f, 0.f, 0.f, 0.f}; } \
        _Pragma("unroll") for (int a = 0; a < 2; ++a) _Pragma("unroll") for (int b = 0; b < 2; ++b) _Pragma("unroll") for (int m = 0; m < 4; ++m) _Pragma("unroll") for (int n = 0; n < 2; ++n) acc[a][b][m][n] = bv_[b][n]; } while (0)
    Unit cur, nxt; int ui = 0;
    if (!S.next(0, cur)) return;
    f32x4 acc[2][2][4][2];
    bf16x8 At[4][2], B0[2][2], B1[2][2]; v8i At8[4], B08[2], B18[2];
    unsigned vc[2][2], vn[2][2];
    LAS unsigned* vslot = (LAS unsigned*)(lds + MISC_OFF + 1024) + tid * 6;
    PG8_VOFF(vc, cur);
    if constexpr (F8) { vslot[0] = voffB[0]; vslot[1] = voffB[1]; vslot[2] = vc[0][0]; vslot[3] = vc[0][1]; vslot[4] = vc[1][0]; vslot[5] = vc[1][1]; }
    const char* cA = cur.A; const char* cB = cur.B;
    PG8_BIAS(cur);
    PG8_STAGE_B(PG8_SB(0, 0), cB); PG8_STAGE_B(PG8_SB(0, 1), cB + hstepB); PG8_STAGE_A(PG8_SA(0, 0), cA, 0); PG8_STAGE_A(PG8_SA(0, 1), cA, 1);
    if (wr == 1) PG8_BAR;
    PG8_WAIT_V(2); PG8_BAR;
    PG8_STAGE_B(PG8_SB(1, 0), cB + kstep); PG8_STAGE_A(PG8_SA(1, 0), cA + kstep, 0); PG8_STAGE_B(PG8_SB(1, 1), cB + hstepB + kstep);
    PG8_WAIT_V(6); PG8_BAR;
    PG8_ACC_INIT();
    for (;;) {
        const bool has_next = S.next(ui + 1, nxt);
        const char* nA = has_next ? nxt.A : cA; const char* nB = has_next ? nxt.B : cB;
#pragma unroll 1
        for (int t = 0; t < nt; t += 2) {
            const bool last = (t == nt - 2);
            const char* a1 = cA + (size_t)(t + 1) * kstep;
            const char* a2 = last ? nA : cA + (size_t)(t + 2) * kstep; const char* b2 = last ? nB : cB + (size_t)(t + 2) * kstep;
            const char* a3 = a2 + kstep; const char* b3 = b2 + kstep;
            if (last && has_next) { PG8_VOFF(vn, nxt); PG8_BIAS(nxt); }
            PG8_XLDB0(0, 0); PG8_XLDB1(0, 1); PG8_SCHED; PG8_XLDA(0, 0); PG8_STAGE_A(PG8_SA(1, 1), a1, 1);
            PG8_WAIT_V(8); PG8_WAIT_L(0); PG8_BAR; PG8_XMM0(0, 0); PG8_XMM1(0, 1); PG8_BAR; PG8_SCHED;
            if (last && has_next) {
                if constexpr (F8) { vslot[2] = vn[0][0]; vslot[3] = vn[0][1]; vslot[4] = vn[1][0]; vslot[5] = vn[1][1]; }
                else {
#pragma unroll
                for (int h = 0; h < 2; ++h)
#pragma unroll
                    for (int i = 0; i < 2; ++i) vc[h][i] = vn[h][i];
                }
            }
            PG8_XLDA(0, 1); PG8_STAGE_B(PG8_SB(0, 0), b2); PG8_STAGE_B(PG8_SB(0, 1), b2 + hstepB); PG8_STAGE_A(PG8_SA(0, 0), a2, 0);
            PG8_WAIT_V(8); PG8_WAIT_L(0); PG8_BAR; PG8_XMM0(1, 0); PG8_XMM1(1, 1); PG8_BAR; PG8_SCHED;
            PG8_XLDB0(1, 0); PG8_XLDB1(1, 1); PG8_SCHED; PG8_XLDA(1, 0); PG8_STAGE_A(PG8_SA(0, 1), a2, 1);
            PG8_WAIT_V(8); PG8_WAIT_L(0); PG8_BAR; PG8_XMM0(0, 0); PG8_XMM1(0, 1); PG8_BAR; PG8_SCHED;
            PG8_XLDA(1, 1); PG8_STAGE_B(PG8_SB(1, 0), b3); PG8_STAGE_B(PG8_SB(1, 1), b3 + hstepB); PG8_STAGE_A(PG8_SA(1, 0), a3, 0);
            PG8_WAIT_V(8); PG8_WAIT_L(0); PG8_BAR; PG8_XMM0(1, 0); PG8_XMM1(1, 1); PG8_BAR; PG8_SCHED;
        }
        if (wr == 0) PG8_BAR;
        E(acc, cur, wr, wc, fr, fq);
        if (!has_next) break;
        PG8_ACC_INIT();
        cur = nxt; cA = nA; cB = nB; ++ui;
        if (wr == 1) PG8_BAR;
    }
    PG8_WAIT_V(0);
    PG8_BAR;
#undef PG8_SA
#undef PG8_SB
#undef PG8_STAGE
#undef PG8_STAGE_A
#undef PG8_STAGE_B
#undef PG8_LDA
#undef PG8_LDB
#undef PG8_MMA
#undef PG8_MMA8
#undef PG8_LDA8
#undef PG8_LDB8
#undef PG8_XLDA
#undef PG8_XLDB0
#undef PG8_XLDB1
#undef PG8_XMM0
#undef PG8_XMM1
#undef PG8_WAIT_V
#undef PG8_WAIT_L
#undef PG8_BAR
#undef PG8_SCHED
#undef PG8_VOFF
#undef PG8_BIAS
#undef PG8_ACC_INIT
}
}

__device__ __forceinline__ unsigned pk4_fp8(float a, float b, float c, float d) { int p = 0; p = __builtin_amdgcn_cvt_pk_fp8_f32(a, b, p, false); p = __builtin_amdgcn_cvt_pk_fp8_f32(c, d, p, true); return (unsigned)p; }
constexpr float W8_SCALE = 32.f;
__device__ __forceinline__ void st8_bf16(bf16_t* dst, const f32x4 v0, const f32x4 v1) {
    u32x4 w; w.x = pg8::cvt_pk_bf16(v0[0], v0[1]); w.y = pg8::cvt_pk_bf16(v0[2], v0[3]); w.z = pg8::cvt_pk_bf16(v1[0], v1[1]); w.w = pg8::cvt_pk_bf16(v1[2], v1[3]);
    *(u32x4*)dst = w;
}
__device__ __forceinline__ void ld8_bf16(const bf16_t* src, f32x4& v0, f32x4& v1) {
    const u32x4 w = *(const u32x4*)src;
    v0 = (f32x4){__uint_as_float(w.x << 16), __uint_as_float(w.x & 0xffff0000u), __uint_as_float(w.y << 16), __uint_as_float(w.y & 0xffff0000u)};
    v1 = (f32x4){__uint_as_float(w.z << 16), __uint_as_float(w.z & 0xffff0000u), __uint_as_float(w.w << 16), __uint_as_float(w.w & 0xffff0000u)};
}
__device__ __forceinline__ f32x4 sig4(f32x4 v) { return (f32x4){sigmoidf_(v[0]), sigmoidf_(v[1]), sigmoidf_(v[2]), sigmoidf_(v[3])}; }

template <int PART> struct EpiIn {
    static constexpr bool PERM = true;
    Params p;
    __device__ __forceinline__ void operator()(const f32x4 (&acc)[2][2][4][2], const pg8::Unit& u, int wr, int wc, int fr, int fq) const {
        const int pn = u.pn; const size_t row0 = (size_t)u.pm * 256 + wr * 64 + fr; const int cl0 = wc * 32 + 8 * fq;
        if (PART == 1 || pn < 21) {
            bf16_t* base; int ld, c0; int mode;
            if (PART != 1 && pn < 2) { base = p.Qm(); ld = 512; c0 = pn * 256; mode = 1; }
            else if (PART != 1 && pn < 4) { base = p.Km(); ld = 512; c0 = (pn - 2) * 256; mode = 0; }
            else if (PART != 1 && pn < 8) { base = p.Vm(); ld = 1024; c0 = (pn - 4) * 256; mode = 0; }
            else if (PART != 0 && pn < 12) { base = p.OG(); ld = 1024; c0 = (pn - 8) * 256; mode = 2; }
            else if (PART != 0 && pn < 20) { base = p.GATE(); ld = 2048; c0 = (pn - 12) * 256; mode = 2; }
            else { base = nullptr; ld = 256; c0 = 0; mode = 3; }
#pragma unroll
            for (int ai = 0; ai < 2; ++ai)
#pragma unroll
                for (int m = 0; m < 4; ++m) { const size_t r = row0 + ai * 128 + m * 16;
#pragma unroll
                    for (int bj = 0; bj < 2; ++bj) { f32x4 v0 = acc[ai][bj][m][0], v1 = acc[ai][bj][m][1]; const int c = c0 + bj * 128 + cl0;
                        if (PART != 1 && mode == 3) { float* d = p.CQ() + r * 256 + c; *(f32x4*)d = v0; *(f32x4*)(d + 4) = v1; }
                        else { if (PART != 1 && mode == 1) { v0 = v0 * 0.125f; v1 = v1 * 0.125f; } else if (PART != 0 && mode == 2) { v0 = sig4(v0); v1 = sig4(v1); }
                               st8_bf16(base + r * ld + c, v0, v1); } } }
        } else if (PART != 1) {
#pragma unroll
            for (int ai = 0; ai < 2; ++ai)
#pragma unroll
                for (int m = 0; m < 4; ++m) { const size_t r = row0 + ai * 128 + m * 16;
                    { float* d = p.CKV() + r * 128 + cl0; *(f32x4*)d = acc[ai][0][m][0]; *(f32x4*)(d + 4) = acc[ai][0][m][1]; }
                    const f32x4 v0 = acc[ai][1][m][0], v1 = acc[ai][1][m][1];
                    if (wc < 2) { float* d = p.KR() + r * 64 + cl0; *(f32x4*)d = v0; *(f32x4*)(d + 4) = v1; }
                    else if (wc == 2) { const int g = 8 * (fq & 1);
                        if (fq < 2) { float* d = p.GI() + r * 16 + g; const f32x4 b0 = *(const f32x4*)(p.m_b_i + g), b1 = *(const f32x4*)(p.m_b_i + g + 4); *(f32x4*)d = v0 + b0; *(f32x4*)(d + 4) = v1 + b1; }
                        else { float* d = p.GF() + r * 16 + g; const f32x4 b0 = *(const f32x4*)(p.m_b_f + g), b1 = *(const f32x4*)(p.m_b_f + g + 4);
                            *(f32x4*)d = (f32x4){logsigmoidf_(v0[0] + b0[0]), logsigmoidf_(v0[1] + b0[1]), logsigmoidf_(v0[2] + b0[2]), logsigmoidf_(v0[3] + b0[3])};
                            *(f32x4*)(d + 4) = (f32x4){logsigmoidf_(v1[0] + b1[0]), logsigmoidf_(v1[1] + b1[1]), logsigmoidf_(v1[2] + b1[2]), logsigmoidf_(v1[3] + b1[3])}; } } }
        }
    }
};
template <int PART> struct EpiInP {
    static constexpr bool PERM = true;
    Params p;
    __device__ __forceinline__ void operator()(const f32x4 (&acc)[2][2][4][2], const pg8::Unit& u, int wr, int wc, int fr, int fq) const {
        pg8::Unit v = u; v.pn = PART == 0 ? (u.pn < 8 ? u.pn : u.pn + 12) : u.pn + 8;
        EpiIn<PART> E{p}; E(acc, v, wr, wc, fr, fq);
    }
};
struct EpiQ {
    static constexpr bool PERM = true;
    Params p;
    __device__ __forceinline__ void operator()(const f32x4 (&acc)[2][2][4][2], const pg8::Unit& u, int wr, int wc, int fr, int fq) const {
        const size_t row0 = (size_t)u.pm * 256 + wr * 64 + fr;
#pragma unroll
        for (int ai = 0; ai < 2; ++ai)
#pragma unroll
            for (int m = 0; m < 4; ++m) { const size_t r = row0 + ai * 128 + m * 16; const float rs = p.RSQ()[r] * QSCALE; const int pos = NMETA + (int)(r & (SEQ - 1));
#pragma unroll
                for (int bj = 0; bj < 2; ++bj) { const int c = u.pn * 256 + bj * 128 + wc * 32 + 8 * fq; const int local = c % 192;
                    f32x4 v0 = acc[ai][bj][m][0] * rs, v1 = acc[ai][bj][m][1] * rs;
                    if (local >= 128) { const int i0 = (local - 128) >> 1; const float* rp = p.ROPE() + ((size_t)pos * 32 + i0) * 2;
                        const f32x4 cs0 = *(const f32x4*)rp, cs1 = *(const f32x4*)(rp + 4);
                        const f32x4 o0 = (f32x4){v0[0] * cs0[0] - v0[1] * cs0[1], v0[0] * cs0[1] + v0[1] * cs0[0], v0[2] * cs0[2] - v0[3] * cs0[3], v0[2] * cs0[3] + v0[3] * cs0[2]};
                        const f32x4 o1 = (f32x4){v1[0] * cs1[0] - v1[1] * cs1[1], v1[0] * cs1[1] + v1[1] * cs1[0], v1[2] * cs1[2] - v1[3] * cs1[3], v1[2] * cs1[3] + v1[3] * cs1[2]};
                        v0 = o0; v1 = o1; }
                    st8_bf16(p.QP() + r * 1536 + c, v0, v1); }
                asm volatile("" ::: "memory"); }
    }
};
template <int PASS> struct EpiMix {
    static constexpr bool PERM = true;
    Params p;
    __device__ __forceinline__ void operator()(const f32x4 (&acc)[2][2][4][2], const pg8::Unit& u, int wr, int wc, int fr, int fq) const {
        const size_t row0 = (size_t)u.pm * 256 + wr * 64 + fr;
#pragma unroll
        for (int ai = 0; ai < 2; ++ai)
#pragma unroll
            for (int m = 0; m < 4; ++m) { const size_t r = row0 + ai * 128 + m * 16;
#pragma unroll
                for (int bj = 0; bj < 2; ++bj) { const int c = u.pn * 256 + bj * 128 + wc * 32 + 8 * fq;
                    f32x4 g0, g1; ld8_bf16(p.GATE() + r * 2048 + PASS * 1024 + c, g0, g1);
                    f32x4 v0 = acc[ai][bj][m][0] * g0, v1 = acc[ai][bj][m][1] * g1;
                    if (PASS == 1) { f32x4 m0, m1; ld8_bf16(p.MIX() + r * 1024 + c, m0, m1); v0 = v0 + m0; v1 = v1 + m1; }
                    st8_bf16(p.MIX() + r * 1024 + c, v0, v1); } }
    }
};
struct EpiOut {
    static constexpr bool PERM = false;
    Params p;
    __device__ __forceinline__ void operator()(const f32x4 (&acc)[2][2][4][2], const pg8::Unit& u, int wr, int wc, int fr, int fq) const {
        const size_t row0 = (size_t)u.pm * 256 + wr * 64 + fr; const int col0 = u.pn * 256 + wc * 32 + 4 * fq;
#pragma unroll
        for (int ai = 0; ai < 2; ++ai)
#pragma unroll
            for (int m = 0; m < 4; ++m) { const size_t off = (row0 + ai * 128 + m * 16) * DM + col0;
#pragma unroll
                for (int bj = 0; bj < 2; ++bj)
#pragma unroll
                    for (int n = 0; n < 2; ++n) { const f32x4 xv = *(const f32x4*)(p.x + off + bj * 128 + n * 16); *(f32x4*)(p.out + off + bj * 128 + n * 16) = xv + acc[ai][bj][m][n]; } }
    }
};
struct EpiM1 {
    static constexpr bool PERM = true;
    Params p;
    __device__ __forceinline__ void operator()(const f32x4 (&acc)[2][2][4][2], const pg8::Unit& u, int wr, int wc, int fr, int fq) const {
        const size_t row0 = (size_t)u.pm * 256 + wr * 64 + fr; const int c = u.pn * 128 + wc * 32 + 8 * fq;
#pragma unroll
        for (int ai = 0; ai < 2; ++ai)
#pragma unroll
            for (int m = 0; m < 4; ++m) { const size_t r = row0 + ai * 128 + m * 16;
                const f32x4 g0 = acc[ai][0][m][0], g1 = acc[ai][0][m][1], l0 = acc[ai][1][m][0], l1 = acc[ai][1][m][1]; f32x4 a0, a1;
#pragma unroll
                for (int j = 0; j < 4; ++j) { const float gg = fminf(g0[j], 7.f), ll = fminf(fmaxf(l0[j], -7.f), 7.f); a0[j] = gg * sigmoidf_(1.702f * gg) * (ll + 1.f);
                    const float gh = fminf(g1[j], 7.f), lh = fminf(fmaxf(l1[j], -7.f), 7.f); a1[j] = gh * sigmoidf_(1.702f * gh) * (lh + 1.f); }
                u32x2 o8; o8.x = pk4_fp8(a0[0], a0[1], a0[2], a0[3]); o8.y = pk4_fp8(a1[0], a1[1], a1[2], a1[3]); *(u32x2*)((unsigned char*)p.ACT() + r * DFF + c) = o8; }
    }
};
struct EpiM2 {
    static constexpr bool PERM = true;
    Params p;
    __device__ __forceinline__ void operator()(const f32x4 (&acc)[2][2][4][2], const pg8::Unit& u, int wr, int wc, int fr, int fq) const {
        const size_t row0 = (size_t)u.pm * 256 + wr * 64 + fr;
#pragma unroll
        for (int bj = 0; bj < 2; ++bj) { const int c = u.pn * 256 + bj * 128 + wc * 32 + 8 * fq;
#pragma unroll
            for (int ai = 0; ai < 2; ++ai)
#pragma unroll
                for (int m = 0; m < 4; ++m) { const size_t r = row0 + ai * 128 + m * 16; st8_bf16(p.YB() + r * DM + c, acc[ai][bj][m][0], acc[ai][bj][m][1]); } }
    }
};

__device__ __forceinline__ float4 ntld4(const float* p) { const f32x4 v = __builtin_nontemporal_load((const f32x4*)p); return make_float4(v[0], v[1], v[2], v[3]); }
__device__ __forceinline__ uint2 ntld2u(const bf16_t* p) { const u32x2 v = __builtin_nontemporal_load((const u32x2*)p); return make_uint2(v[0], v[1]); }
__device__ __forceinline__ unsigned pk2(float lo, float hi) { return (unsigned)f2bf(lo) | ((unsigned)f2bf(hi) << 16); }
struct TrDesc { const float* W; bf16_t* WT; int ldw, K, dr0, sc0, nvalid, k0, f8; };
__device__ __forceinline__ void tr_load(const TrDesc& d, float4 (&v)[16], int lane) {
    const int lr = lane >> 4, lc = (lane & 15) * 4;
#pragma unroll
    for (int i = 0; i < 16; ++i) v[i] = (lc < d.nvalid) ? ntld4(d.W + (size_t)(d.k0 + i * 4 + lr) * d.ldw + d.sc0 + lc) : make_float4(0.f, 0.f, 0.f, 0.f);
}
__device__ __forceinline__ void tr_finish(const TrDesc& d, const float4 (&v)[16], LAS float* scr, int lane) {
    const int lr = lane >> 4, lc = (lane & 15) * 4;
#pragma unroll
    for (int i = 0; i < 16; ++i) { LAS float* q = scr + (i * 4 + lr) * 65 + lc; q[0] = v[i].x; q[1] = v[i].y; q[2] = v[i].z; q[3] = v[i].w; }
    asm volatile("s_waitcnt lgkmcnt(0)" ::: "memory");
    const int c = lane & 7;
    if (d.f8) {
#pragma unroll
        for (int j = 0; j < 8; ++j) { const int n = (lane >> 3) + 8 * j; const LAS float* s = scr + (8 * c) * 65 + n;
            u32x2 o; o.x = pk4_fp8(s[0 * 65] * W8_SCALE, s[1 * 65] * W8_SCALE, s[2 * 65] * W8_SCALE, s[3 * 65] * W8_SCALE); o.y = pk4_fp8(s[4 * 65] * W8_SCALE, s[5 * 65] * W8_SCALE, s[6 * 65] * W8_SCALE, s[7 * 65] * W8_SCALE);
            *(u32x2*)((unsigned char*)d.WT + (size_t)(d.dr0 + n) * d.K + d.k0 + 8 * c) = o; }
    } else {
#pragma unroll
    for (int j = 0; j < 8; ++j) { const int n = (lane >> 3) + 8 * j; const LAS float* s = scr + (8 * c) * 65 + n;
        u32x4 o; o.x = pk2(s[0 * 65], s[1 * 65]); o.y = pk2(s[2 * 65], s[3 * 65]); o.z = pk2(s[4 * 65], s[5 * 65]); o.w = pk2(s[6 * 65], s[7 * 65]);
        *(u32x4*)(d.WT + (size_t)(d.dr0 + n) * d.K + d.k0 + 8 * c) = o; }
    }
    asm volatile("s_waitcnt lgkmcnt(0)" ::: "memory");
}
__device__ __forceinline__ int win_src_col(int np, int& nvalid) {
    nvalid = 64;
    if (np < 3072) return np;
    if (np < 5120) return OFF_G + (np - 3072);
    if (np < 5376) return OFF_CQ + (np - 5120);
    if (np < 5504) return OFF_CKV + (np - 5376);
    if (np < 5568) return OFF_KR + (np - 5504);
    nvalid = 32; return OFF_I;
}

__device__ __forceinline__ void phase_prologue(const Params& p, LAS unsigned char* lds, int vcu, int G, int sub) {
#define SUBP(x) (sub == 0 || sub == (x))
    const int tid = threadIdx.x, lane = tid & 63, wave = tid >> 6;
    const int gw = vcu * 8 + wave, NGW = G * 8;
    LAS float* scr = (LAS float*)(lds + wave * 16640);
    if (SUBP(1)) for (int it = vcu; it < 88; it += G) {
        LAS float* um = (LAS float*)lds;
        LAS float* red = (LAS float*)(lds + 65536);
        __syncthreads();
        for (int j = wave * 2; j < wave * 2 + 2; ++j) {
            const float* src = p.meta + (size_t)j * DM; float4 v[4]; float ss = 0.f;
#pragma unroll
            for (int q = 0; q < 4; ++q) { v[q] = *(const float4*)(src + (q * 64 + lane) * 4); ss += v[q].x * v[q].x + v[q].y * v[q].y + v[q].z * v[q].z + v[q].w * v[q].w; }
            const float rstd = rsqrtf(wave_sum(ss) * (1.f / DM) + EPS);
#pragma unroll
            for (int q = 0; q < 4; ++q) { const int c = (q * 64 + lane) * 4; const float4 g = *(const float4*)(p.norm_mix + c);
                um[j * 1024 + c] = v[q].x * rstd * g.x; um[j * 1024 + c + 1] = v[q].y * rstd * g.y; um[j * 1024 + c + 2] = v[q].z * rstd * g.z; um[j * 1024 + c + 3] = v[q].w * rstd * g.w; }
        }
        __syncthreads();
        const int n = it * 64 + lane; const bool okn = n < DIN;
        float a[16];
#pragma unroll
        for (int j = 0; j < 16; ++j) a[j] = 0.f;
#pragma unroll 8
        for (int kk = 0; kk < 128; ++kk) { const int kq = wave * 128 + kk; const float w = okn ? p.w_in[(size_t)kq * DIN + n] : 0.f;
#pragma unroll
            for (int j = 0; j < 16; ++j) a[j] += um[j * 1024 + kq] * w; }
#pragma unroll
        for (int j = 0; j < 16; ++j) red[(wave * 16 + j) * 64 + lane] = a[j];
        __syncthreads();
        for (int o = tid; o < 1024; o += MK_THREADS) { const int j = o >> 6, nl = o & 63; float s = 0.f;
#pragma unroll
            for (int w8 = 0; w8 < 8; ++w8) s += red[(w8 * 16 + j) * 64 + nl];
            if (it * 64 + nl < DIN) p.ZM()[(size_t)j * DIN + it * 64 + nl] = s; }
        __syncthreads();
    }
    constexpr int I_INA = 16 * 40, I_INB = 16 * 48, I_IN = I_INA + I_INB, I_W1 = NEXP * 16 * 32, I_W2 = NEXP * 16 * 16, I_SQ = 16 * 16;
    constexpr int NITEMS = I_IN + I_W1 + I_W2 + 2 * I_SQ;
    auto decode = [&](int it, TrDesc& d) {
        int r = it;
        if (r < I_INA) { const int kb = r / 40, nb = r % 40, np = nb * 64, nl = np < 2048 ? np : np + 3072; int nv; const int sc = win_src_col(nl, nv); d = TrDesc{p.w_in, p.WinT(), DIN, DM, np, sc, nv, kb * 64, 0}; return; } r -= I_INA;
        if (r < I_INB) { const int kb = r / 48, nb = r % 48, np = nb * 64; int nv; const int sc = win_src_col(2048 + np, nv); d = TrDesc{p.w_in, (bf16_t*)p.WinT8(), DIN, DM, np, sc, nv, kb * 64, 1}; return; } r -= I_INB;
        if (r < I_W1) { const int e = r / 512, q = r % 512, kb = q / 32, nb = q % 32, np = nb * 64, pn = np >> 8, bj = (np >> 7) & 1, j = np & 127;
            d = TrDesc{p.w1 + (size_t)e * DM * 2048, (bf16_t*)((unsigned char*)p.W1T() + (size_t)e * 2048 * DM), 2048, DM, np, 1024 * bj + 128 * pn + j, 64, kb * 64, 1}; return; } r -= I_W1;
        if (r < I_W2) { const int e = r / 256, q = r % 256, kb = q / 16, nb = q % 16; d = TrDesc{p.w2 + (size_t)e * DFF * DM, (bf16_t*)((unsigned char*)p.W2T() + (size_t)e * DM * DFF), DM, DFF, nb * 64, nb * 64, 64, kb * 64, 1}; return; } r -= I_W2;
        if (r < I_SQ) { const int kb = r / 16, nb = r % 16; d = TrDesc{p.w_m_proj, p.WmT(), DM, DM, nb * 64, nb * 64, 64, kb * 64, 0}; return; } r -= I_SQ;
        { const int kb = r / 16, nb = r % 16; d = TrDesc{p.w_out, p.WoutT(), DM, DM, nb * 64, nb * 64, 64, kb * 64, 0}; }
    };
    if (SUBP(2)) {
        float4 va[16], vb[16]; TrDesc da, db; int it = gw;
        if (it < NITEMS) { decode(it, da); tr_load(da, va, lane); }
#pragma unroll 1
        while (it < NITEMS) {
            const int it1 = it + NGW; if (it1 < NITEMS) { decode(it1, db); tr_load(db, vb, lane); }
            tr_finish(da, va, scr, lane);
            if (it1 >= NITEMS) break;
            const int it2 = it1 + NGW; if (it2 < NITEMS) { decode(it2, da); tr_load(da, va, lane); }
            tr_finish(db, vb, scr, lane);
            it = it2;
        }
    }
    if (SUBP(3)) for (int r = gw * 4; r < NT; r += NGW * 4) {
        const float* s0 = p.x + (size_t)r * DM; float4 v[16];
#pragma unroll
        for (int q = 0; q < 4; ++q)
#pragma unroll
            for (int j = 0; j < 4; ++j) v[q * 4 + j] = ntld4(s0 + (size_t)q * DM + (j * 64 + lane) * 4);
        float rs[4];
#pragma unroll
        for (int q = 0; q < 4; ++q) { float s = 0.f;
#pragma unroll
            for (int j = 0; j < 4; ++j) { const float4 t = v[q * 4 + j]; s += t.x * t.x + t.y * t.y + t.z * t.z + t.w * t.w; }
            rs[q] = rsqrtf(wave_sum(s) * (1.f / DM) + EPS); }
#pragma unroll
        for (int j = 0; j < 4; ++j) { const int c = (j * 64 + lane) * 4; const float4 g = *(const float4*)(p.norm_mix + c);
#pragma unroll
            for (int q = 0; q < 4; ++q) { const float4 t = v[q * 4 + j]; const float rr = rs[q];
                const float u0 = t.x * rr * g.x, u1 = t.y * rr * g.y, u2 = t.z * rr * g.z, u3 = t.w * rr * g.w;
                u32x2 o; o.x = pk2(u0, u1); o.y = pk2(u2, u3); *(u32x2*)(p.U() + (size_t)(r + q) * DM + c) = o;
                *(unsigned*)(p.U8() + (size_t)(r + q) * DM + c) = pk4_fp8(u0, u1, u2, u3); } }
    }
    const long gid = (long)vcu * MK_THREADS + tid, gn = (long)G * MK_THREADS;
    if (SUBP(4)) for (long i = gid; i < (long)LTOT * 32; i += gn) {
        const int pos = (int)(i >> 5), f = (int)(i & 31);
        const float freq = powf(10000.f, -(float)f / 32.f), ang = (float)pos * freq; float s, c; sincosf(ang, &s, &c);
        p.ROPE()[i * 2] = c; p.ROPE()[i * 2 + 1] = s;
    }
    const int rot_wo = (vcu + 40) & 255;
    if (SUBP(5)) for (long i = (long)rot_wo * MK_THREADS + tid; i < 8L * 8 * 1024; i += gn) {
        const int n = (int)(i & 1023), hcg = __builtin_amdgcn_readfirstlane((int)(i >> 10)), h = hcg >> 3, c0 = (hcg & 7) * 16;
        const float* ap = p.w_a_proj + (size_t)(h * 128) * DM + n; const float* kv = p.a_w_ukv + ((size_t)c0 * 8 + h) * 256 + 128;
        float acc[16];
#pragma unroll
        for (int q = 0; q < 16; ++q) acc[q] = 0.f;
#pragma unroll 4
        for (int d = 0; d < 128; ++d) { const float b = ap[(size_t)d * DM];
#pragma unroll
            for (int q = 0; q < 16; ++q) acc[q] += kv[(size_t)q * 2048 + d] * b; }
        u32x4 o0, o1; o0.x = pk2(acc[0], acc[1]); o0.y = pk2(acc[2], acc[3]); o0.z = pk2(acc[4], acc[5]); o0.w = pk2(acc[6], acc[7]);
        o1.x = pk2(acc[8], acc[9]); o1.y = pk2(acc[10], acc[11]); o1.z = pk2(acc[12], acc[13]); o1.w = pk2(acc[14], acc[15]);
        bf16_t* dst = p.WoT() + (size_t)n * 1024 + h * 128 + c0; *(u32x4*)dst = o0; *(u32x4*)(dst + 8) = o1;
    }
    if (SUBP(6)) for (int t = ((vcu + 168) & 255) * 8 + wave; t < 8 * 128; t += NGW) {
        const int h = t >> 7, c = t & 127; const float2 kvv = *(const float2*)(p.a_w_ukv + ((size_t)c * 8 + h) * 256 + 2 * lane);
#pragma unroll 1
        for (int r0 = 0; r0 < 256; r0 += 64) { float keep = 0.f;
#pragma unroll 8
            for (int rr = 0; rr < 64; ++rr) { const float2 u = *(const float2*)(p.a_w_uq + ((size_t)(r0 + rr) * 8 + h) * 192 + 2 * lane);
                const float s = wave_sum(u.x * kvv.x + u.y * kvv.y); if (lane == rr) keep = s; }
            p.WqT()[(size_t)(h * 192 + c) * 256 + r0 + lane] = f2bf(keep * p.a_norm_q[r0 + lane]); }
    }
    if (SUBP(6)) for (long i = gid; i < 8L * 64 * 256; i += gn) {
        const int r = (int)(i & 255), hq = (int)(i >> 8), h = hq >> 6, q = hq & 63;
        p.WqT()[(size_t)(h * 192 + 128 + q) * 256 + r] = f2bf(p.a_w_uq[((size_t)r * 8 + h) * 192 + 128 + (q >> 1) + 32 * (q & 1)] * p.a_norm_q[r]);
    }
}

#undef SUBP
__device__ __forceinline__ void phase_kprep(const Params& p, int vcu, int G) {
    const int lane = threadIdx.x & 63, gw = vcu * 8 + (threadIdx.x >> 6), NGW = G * 8;
    const float gk0 = p.a_norm_kv[lane], gk1 = p.a_norm_kv[64 + lane];
    for (int r0 = gw * 4; r0 < NT; r0 += NGW * 4) {
        float c0[4], c1[4], x1[4], x2[4], cs[4], sn[4];
#pragma unroll
        for (int q = 0; q < 4; ++q) { const size_t r = (size_t)r0 + q; const int pos = NMETA + (int)(r & (SEQ - 1));
            c0[q] = p.CKV()[r * 128 + lane]; c1[q] = p.CKV()[r * 128 + 64 + lane];
            const int l32 = lane & 31; x1[q] = p.KR()[r * 64 + l32]; x2[q] = p.KR()[r * 64 + 32 + l32];
            const float2 t = *(const float2*)(p.ROPE() + ((size_t)pos * 32 + l32) * 2); cs[q] = t.x; sn[q] = t.y; }
#pragma unroll
        for (int q = 0; q < 4; ++q) { const size_t r = (size_t)r0 + q; const int b = (int)(r >> 12), key = (int)(r & (SEQ - 1));
            bf16_t* dst = p.Kc() + ((size_t)b * KVROWS + key) * 192;
            const float rstd = rsqrtf(wave_sum(c0[q] * c0[q] + c1[q] * c1[q]) * (1.f / 128.f) + EPS);
            dst[lane] = f2bf(c0[q] * rstd * gk0); dst[64 + lane] = f2bf(c1[q] * rstd * gk1);
            if (lane < 32) *(unsigned*)(dst + 128 + 2 * lane) = pk2(x1[q] * cs[q] - x2[q] * sn[q], x1[q] * sn[q] + x2[q] * cs[q]); }
    }
    for (int i = gw; i < NB * 64; i += NGW) {
        const int b = i >> 6, j = i & 63; bf16_t* dst = p.Kc() + ((size_t)b * KVROWS + SEQ + j) * 192;
        if (j >= NMETA) { dst[lane] = 0; dst[64 + lane] = 0; dst[128 + lane] = 0; continue; }
        const float* ckv = p.ZM() + (size_t)j * DIN + OFF_CKV; const float* kr = p.ZM() + (size_t)j * DIN + OFF_KR;
        const float c0 = ckv[lane], c1 = ckv[64 + lane];
        const float rstd = rsqrtf(wave_sum(c0 * c0 + c1 * c1) * (1.f / 128.f) + EPS);
        dst[lane] = f2bf(c0 * rstd * gk0); dst[64 + lane] = f2bf(c1 * rstd * gk1);
        if (lane < 32) { const float x1 = kr[lane], x2 = kr[32 + lane], cs = p.ROPE()[((size_t)j * 32 + lane) * 2], sn = p.ROPE()[((size_t)j * 32 + lane) * 2 + 1];
            *(unsigned*)(dst + 128 + 2 * lane) = pk2(x1 * cs - x2 * sn, x1 * sn + x2 * cs); }
    }
    for (int r0 = gw * 4; r0 < NT; r0 += NGW * 4) {
        float4 v[4];
#pragma unroll
        for (int q = 0; q < 4; ++q) v[q] = ntld4(p.CQ() + (size_t)(r0 + q) * 256 + lane * 4);
#pragma unroll
        for (int q = 0; q < 4; ++q) { u32x2 o; o.x = pk2(v[q].x, v[q].y); o.y = pk2(v[q].z, v[q].w);
            const float a = __uint_as_float(o.x << 16), b = __uint_as_float(o.x & 0xffff0000u), c = __uint_as_float(o.y << 16), d = __uint_as_float(o.y & 0xffff0000u);
            const float ss = wave_sum(a * a + b * b + c * c + d * d);
            *(u32x2*)(p.CQb() + (size_t)(r0 + q) * 256 + lane * 4) = o;
            if (lane == 0) p.RSQ()[r0 + q] = rsqrtf(ss * (1.f / 256.f) + EPS); }
    }
}

__device__ __forceinline__ void moe_tile_table(const Params& p, volatile LAS int* tst) {
    __syncthreads();
    if (threadIdx.x == 0) { int s = 0; for (int e = 0; e < NEXP; ++e) { tst[e] = s; s += (p.CNT()[e * CNT_STRIDE] + 255) / 256; } tst[NEXP] = s; }
    __syncthreads();
}

namespace att {
using s16x4 = __attribute__((ext_vector_type(4))) short;
using f32x16 = __attribute__((ext_vector_type(16))) float;
constexpr int KN_B = 16384, KR_B = 8192, V_B = 16384;
constexpr int L_KN = 0, L_KR = 2 * KN_B, L_WS = L_KR + 2 * KR_B, L_QR = L_WS + 8 * 256, L_END = L_QR + 8 * 4096;
constexpr float THR = 8.f;
#define KSWZ(row, colB) ((row) * 256 + ((colB) ^ (((((row) & 3) << 2) | (((row) >> 2) & 3)) << 4)))
#define RSWZ(row, colB) ((row) * 128 + ((colB) ^ ((((row) >> 1) & 7) << 4)))
#define SBAR() __builtin_amdgcn_sched_barrier(0)
__device__ __forceinline__ int crow(int r, int hi) { return (r & 3) + 8 * (r >> 2) + 4 * hi; }
__device__ __forceinline__ unsigned cvtpk(float lo, float hi) { unsigned r; asm volatile("v_cvt_pk_bf16_f32 %0, %1, %2" : "=v"(r) : "v"(lo), "v"(hi)); return r; }

__device__ __forceinline__ void partialSM(f32x16& p0, f32x16& p1, float& m_reg, float& alpha) {
    float pmax = p0[0];
#pragma unroll
    for (int r = 1; r < 16; ++r) pmax = fmaxf(pmax, p0[r]);
#pragma unroll
    for (int r = 0; r < 16; ++r) pmax = fmaxf(pmax, p1[r]);
    { auto rr = __builtin_amdgcn_permlane32_swap(__float_as_uint(pmax), __float_as_uint(pmax), false, false);
      pmax = fmaxf(__uint_as_float(rr[0]), __uint_as_float(rr[1])); }
    float mn;
    if (__builtin_expect(__all(pmax - m_reg <= THR), 1)) { mn = m_reg; alpha = 1.f; }
    else { mn = fmaxf(m_reg, pmax); alpha = __builtin_amdgcn_exp2f(m_reg - mn); m_reg = mn; }
#pragma unroll
    for (int r = 0; r < 16; ++r) p0[r] = p0[r] - mn;
#pragma unroll
    for (int r = 0; r < 16; ++r) p1[r] = p1[r] - mn;
#pragma unroll
    for (int r = 0; r < 16; ++r) p0[r] = __builtin_amdgcn_exp2f(p0[r]);
}
__device__ __forceinline__ void finishSM(f32x16& p0, f32x16& p1, float alpha, float& l_reg, bf16x8& pa0, bf16x8& pa1, bf16x8& pa2, bf16x8& pa3) {
#pragma unroll
    for (int r = 0; r < 16; ++r) p1[r] = __builtin_amdgcn_exp2f(p1[r]);
    float ps = 0;
#pragma unroll
    for (int r = 0; r < 16; ++r) ps += p0[r];
#pragma unroll
    for (int r = 0; r < 16; ++r) ps += p1[r];
    { auto rr = __builtin_amdgcn_permlane32_swap(__float_as_uint(ps), __float_as_uint(ps), false, false);
      ps = __uint_as_float(rr[0]) + __uint_as_float(rr[1]); }
    l_reg = l_reg * alpha + ps;
#define PK4(P, BASE, OUT) do { unsigned a0 = cvtpk(P[BASE + 0], P[BASE + 1]), a1 = cvtpk(P[BASE + 2], P[BASE + 3]);   \
    unsigned b0 = cvtpk(P[BASE + 4], P[BASE + 5]), b1 = cvtpk(P[BASE + 6], P[BASE + 7]);                              \
    auto r0 = __builtin_amdgcn_permlane32_swap(a0, b0, false, false); auto r1 = __builtin_amdgcn_permlane32_swap(a1, b1, false, false); \
    u32x4 w = {r0[0], r1[0], r0[1], r1[1]}; OUT = *reinterpret_cast<bf16x8*>(&w); } while (0)
    PK4(p0, 0, pa0); PK4(p0, 8, pa1); PK4(p1, 0, pa2); PK4(p1, 8, pa3);
#undef PK4
}
__device__ __forceinline__ void qkt(f32x16& p0, f32x16& p1, const char* Kn, const char* Kr, const bf16x8* qr, const char* qrl, int r32, int hi) {
    p0 = f32x16{}; p1 = f32x16{};
#pragma unroll
    for (int d0 = 0; d0 < 8; ++d0) { const int cb = (d0 * 16 + hi * 8) * 2;
        const bf16x8 b0 = *reinterpret_cast<const bf16x8*>(Kn + KSWZ(r32, cb));
        const bf16x8 b1 = *reinterpret_cast<const bf16x8*>(Kn + KSWZ(32 + r32, cb));
        p0 = __builtin_amdgcn_mfma_f32_32x32x16_bf16(b0, qr[d0], p0, 0, 0, 0);
        p1 = __builtin_amdgcn_mfma_f32_32x32x16_bf16(b1, qr[d0], p1, 0, 0, 0); }
#pragma unroll
    for (int d0 = 0; d0 < 4; ++d0) { const int cb = (d0 * 16 + hi * 8) * 2;
        const bf16x8 b0 = *reinterpret_cast<const bf16x8*>(Kr + RSWZ(r32, cb));
        const bf16x8 b1 = *reinterpret_cast<const bf16x8*>(Kr + RSWZ(32 + r32, cb));
        const bf16x8 qf = *reinterpret_cast<const bf16x8*>(qrl + d0 * 1024);
        p0 = __builtin_amdgcn_mfma_f32_32x32x16_bf16(b0, qf, p0, 0, 0, 0);
        p1 = __builtin_amdgcn_mfma_f32_32x32x16_bf16(b1, qf, p1, 0, 0, 0); }
}
__device__ __forceinline__ int v_st(int k, int c) { const int kk = (k & ~0xC) | ((k & 4) << 1) | ((k & 8) >> 1); return ((kk >> 3) * 4 + (c >> 5)) * 512 + ((kk & 7) * 32 + (c & 31)) * 2; }
__device__ __forceinline__ int v_rd_base(int lane) { return ((lane & 3) << 3) | (((lane >> 2) & 3) << 6) | (((lane >> 4) & 1) << 5) | (((lane >> 5) & 1) << 8); }
constexpr int v_rd_off(int d0, int ks, int half) { return d0 * 512 + ks * 4096 + half * 2048; }
template <int OFF> __device__ __forceinline__ s16x4 tr_read(int vb) { s16x4 r; asm volatile("ds_read_b64_tr_b16 %0, %1 offset:%2" : "=&v"(r) : "v"(vb), "i"(OFF) : "memory"); return r; }
template <int C> __device__ __forceinline__ void pv_one(f32x16& od, int bt0, int bt1, bf16x8 pa0, bf16x8 pa1, bf16x8 pa2, bf16x8 pa3) {
    const int a0 = bt0 ^ (C << 6), a1 = bt1 ^ (C << 6);
    const s16x4 l0 = tr_read<0>(a0), h0 = tr_read<0>(a1), l1 = tr_read<4096>(a0), h1 = tr_read<4096>(a1);
    const s16x4 l2 = tr_read<8192>(a0), h2 = tr_read<8192>(a1), l3 = tr_read<12288>(a0), h3 = tr_read<12288>(a1);
    asm volatile("s_waitcnt lgkmcnt(0)" ::: "memory"); SBAR();
#define PK(L, H) (bf16x8){L[0], L[1], L[2], L[3], H[0], H[1], H[2], H[3]}
    od = __builtin_amdgcn_mfma_f32_32x32x16_bf16(pa0, PK(l0, h0), od, 0, 0, 0);
    od = __builtin_amdgcn_mfma_f32_32x32x16_bf16(pa1, PK(l1, h1), od, 0, 0, 0);
    od = __builtin_amdgcn_mfma_f32_32x32x16_bf16(pa2, PK(l2, h2), od, 0, 0, 0);
    od = __builtin_amdgcn_mfma_f32_32x32x16_bf16(pa3, PK(l3, h3), od, 0, 0, 0);
#undef PK
}
__device__ __forceinline__ void pv_d0(f32x16* o, int bt0, int bt1, bf16x8 pa0, bf16x8 pa1, bf16x8 pa2, bf16x8 pa3) {
    pv_one<0>(o[0], bt0, bt1, pa0, pa1, pa2, pa3); pv_one<1>(o[1], bt0, bt1, pa0, pa1, pa2, pa3); pv_one<2>(o[2], bt0, bt1, pa0, pa1, pa2, pa3); pv_one<3>(o[3], bt0, bt1, pa0, pa1, pa2, pa3);
}
__device__ __forceinline__ int tr_base(int lane, int t) {
    const int h = lane >> 5, blk = (lane >> 4) & 1, q = (lane & 15) >> 2, p = lane & 3, row = 8 * h + 4 * t + q, ch = 2 * blk + (p >> 1);
    return KSWZ(row, ch * 16) + 8 * (p & 1);
}

__device__ __forceinline__ void attn_unit(const bf16_t* __restrict__ Qb, const bf16_t* __restrict__ Kb, bf16_t* __restrict__ Ob, char* lds) {
    const int tid = threadIdx.x, wid = tid >> 6, lane = tid & 63, r32 = lane & 31, hi = lane >> 5;
    char* Kn_l = lds + L_KN; char* Kr_l = lds + L_KR;
    float* ws = (float*)(lds + L_WS) + wid * 64; float* li_l = ws; float* al_l = ws + 32;
    float m_reg = -1e30f, l_reg = 0; f32x16 o[4] = {}; bf16x8 qr[8];
    const bf16_t* Qw = Qb + (size_t)(wid * 32 + r32) * 1536 + hi * 8;
    char* qrl = lds + L_QR + wid * 4096 + lane * 16;
#pragma unroll
    for (int d0 = 0; d0 < 8; ++d0) qr[d0] = *reinterpret_cast<const bf16x8*>(Qw + d0 * 16);
#pragma unroll
    for (int d0 = 0; d0 < 4; ++d0) *reinterpret_cast<bf16x8*>(qrl + d0 * 1024) = *reinterpret_cast<const bf16x8*>(Qw + (8 + d0) * 16);
    const int sr = tid >> 3, sc8 = tid & 7;
    const int kst0 = KSWZ(sr, sc8 * 16), kst1 = KSWZ(sr, 128 + sc8 * 16), rst = RSWZ(sr, sc8 * 16);
    const int bt0 = (int)(uintptr_t)Kn_l + tr_base(lane, 0), bt1 = (int)(uintptr_t)Kn_l + tr_base(lane, 1);
    bf16x8 s0, s1, s2;
#define SLOAD(mt) do { const bf16_t* kp = Kb + (size_t)((mt) * 64 + sr) * 192 + sc8 * 8; s0 = *reinterpret_cast<const bf16x8*>(kp); s1 = *reinterpret_cast<const bf16x8*>(kp + 64); s2 = *reinterpret_cast<const bf16x8*>(kp + 128); } while (0)
#define SWRITE(b) do { *(bf16x8*)(Kn_l + (b) * KN_B + kst0) = s0; *(bf16x8*)(Kn_l + (b) * KN_B + kst1) = s1; *(bf16x8*)(Kr_l + (b) * KR_B + rst) = s2; } while (0)
#define RESC(a) do { if (__any((a) < 1.f)) { if (hi == 0) al_l[r32] = (a); asm volatile("s_waitcnt lgkmcnt(0)" ::: "memory"); \
        _Pragma("unroll") for (int d = 0; d < 4; ++d) _Pragma("unroll") for (int r = 0; r < 16; ++r) o[d][r] *= al_l[crow(r, hi)]; } } while (0)
    f32x16 pA0, pA1, pB0, pB1; float alA, alB; bf16x8 pa0, pa1, pa2, pa3;
    constexpr int NTL = 65;
    SLOAD(64); asm volatile("s_waitcnt vmcnt(0)" ::: "memory"); SWRITE(0); __syncthreads();
    qkt(pA0, pA1, Kn_l, Kr_l, qr, qrl, r32, hi);
#pragma unroll
    for (int r = 8; r < 16; ++r) pA0[r] = -1e30f;
#pragma unroll
    for (int r = 0; r < 16; ++r) pA1[r] = -1e30f;
    partialSM(pA0, pA1, m_reg, alA);
    SLOAD(0); asm volatile("s_waitcnt vmcnt(0)" ::: "memory"); SWRITE(1); __syncthreads();
#pragma unroll 1
    for (int j = 1; j + 1 < NTL; j += 2) {
        SBAR(); qkt(pB0, pB1, Kn_l + KN_B, Kr_l + KR_B, qr, qrl, r32, hi);
        finishSM(pA0, pA1, alA, l_reg, pa0, pa1, pa2, pa3); SBAR();
        SLOAD(j); SBAR();
        pv_d0(o, bt0, bt1, pa0, pa1, pa2, pa3); partialSM(pB0, pB1, m_reg, alB);
        __syncthreads(); asm volatile("s_waitcnt vmcnt(0)" ::: "memory"); SWRITE(0);
        RESC(alB); __syncthreads();
        SBAR(); qkt(pA0, pA1, Kn_l, Kr_l, qr, qrl, r32, hi);
        finishSM(pB0, pB1, alB, l_reg, pa0, pa1, pa2, pa3); SBAR();
        if (j + 2 < NTL) SLOAD(j + 1); SBAR();
        pv_d0(o, bt0 + KN_B, bt1 + KN_B, pa0, pa1, pa2, pa3); partialSM(pA0, pA1, m_reg, alA);
        __syncthreads(); asm volatile("s_waitcnt vmcnt(0)" ::: "memory"); if (j + 2 < NTL) SWRITE(1);
        RESC(alA); __syncthreads();
    }
    finishSM(pA0, pA1, alA, l_reg, pa0, pa1, pa2, pa3); SBAR();
    pv_d0(o, bt0, bt1, pa0, pa1, pa2, pa3);
    if (hi == 0) li_l[r32] = l_reg; asm volatile("s_waitcnt lgkmcnt(0)" ::: "memory");
    float rli[16];
#pragma unroll
    for (int r = 0; r < 16; ++r) rli[r] = __builtin_amdgcn_rcpf(li_l[crow(r, hi)]);
    bf16_t* Ow = Ob + (size_t)(wid * 32) * 1024;
#pragma unroll
    for (int r = 0; r < 16; ++r) { const int orow = crow(r, hi);
#pragma unroll
        for (int d0 = 0; d0 < 4; ++d0) Ow[(size_t)orow * 1024 + d0 * 32 + r32] = f2bf(o[d0][r] * rli[r]); }
    __syncthreads();
#undef SLOAD
#undef SWRITE
#undef RESC
}
#undef KSWZ
#undef RSWZ
#undef SBAR
}

__device__ __forceinline__ void phase_attn(const Params& p, char* lds, int vcu, int G) {
    for (int u = vcu; u < NB * 8 * 16; u += G) {
        const int b = u >> 7, h = (u >> 4) & 7, qb = u & 15;
        const size_t r0 = (size_t)b * SEQ + qb * 256;
        att::attn_unit(p.QP() + r0 * 1536 + h * 192, p.Kc() + (size_t)b * KVROWS * 192, p.OA() + r0 * 1024 + h * 128, lds);
    }
}

namespace ml {
using att::s16x4; using att::f32x16; using att::crow; using att::cvtpk; using att::v_st; using att::v_rd_base; using att::tr_read; using att::v_rd_off;
#define RSWZ(row, colB) ((row) * 128 + ((colB) ^ ((((row) >> 1) & 7) << 4)))
#define SBAR() __builtin_amdgcn_sched_barrier(0)
__device__ __forceinline__ void pv_blk(f32x16& od, int vb, bf16x8 pa0, bf16x8 pa1, bf16x8 pa2, bf16x8 pa3) {
    const s16x4 l0 = tr_read<v_rd_off(0, 0, 0)>(vb), h0 = tr_read<v_rd_off(0, 0, 1)>(vb), l1 = tr_read<v_rd_off(0, 1, 0)>(vb), h1 = tr_read<v_rd_off(0, 1, 1)>(vb);
    const s16x4 l2 = tr_read<v_rd_off(0, 2, 0)>(vb), h2 = tr_read<v_rd_off(0, 2, 1)>(vb), l3 = tr_read<v_rd_off(0, 3, 0)>(vb), h3 = tr_read<v_rd_off(0, 3, 1)>(vb);
    asm volatile("s_waitcnt lgkmcnt(0)" ::: "memory"); SBAR();
#define PK(L, H) (bf16x8){L[0], L[1], L[2], L[3], H[0], H[1], H[2], H[3]}
    od = __builtin_amdgcn_mfma_f32_32x32x16_bf16(pa0, PK(l0, h0), od, 0, 0, 0);
    od = __builtin_amdgcn_mfma_f32_32x32x16_bf16(pa1, PK(l1, h1), od, 0, 0, 0);
    od = __builtin_amdgcn_mfma_f32_32x32x16_bf16(pa2, PK(l2, h2), od, 0, 0, 0);
    od = __builtin_amdgcn_mfma_f32_32x32x16_bf16(pa3, PK(l3, h3), od, 0, 0, 0);
}
template <int KS0> __device__ __forceinline__ void pv_blk2(f32x16& od, int vb, bf16x8 pa, bf16x8 pb) {
    const s16x4 l0 = tr_read<v_rd_off(0, KS0, 0)>(vb), h0 = tr_read<v_rd_off(0, KS0, 1)>(vb), l1 = tr_read<v_rd_off(0, KS0 + 1, 0)>(vb), h1 = tr_read<v_rd_off(0, KS0 + 1, 1)>(vb);
    asm volatile("s_waitcnt lgkmcnt(0)" ::: "memory"); SBAR();
    od = __builtin_amdgcn_mfma_f32_32x32x16_bf16(pa, PK(l0, h0), od, 0, 0, 0);
    od = __builtin_amdgcn_mfma_f32_32x32x16_bf16(pb, PK(l1, h1), od, 0, 0, 0);
}
__device__ __forceinline__ void tt_blk(f32x16& od, int va, int vb) {
    const s16x4 al0 = tr_read<v_rd_off(0, 0, 0)>(va), ah0 = tr_read<v_rd_off(0, 0, 1)>(va), al1 = tr_read<v_rd_off(0, 1, 0)>(va), ah1 = tr_read<v_rd_off(0, 1, 1)>(va);
    const s16x4 al2 = tr_read<v_rd_off(0, 2, 0)>(va), ah2 = tr_read<v_rd_off(0, 2, 1)>(va), al3 = tr_read<v_rd_off(0, 3, 0)>(va), ah3 = tr_read<v_rd_off(0, 3, 1)>(va);
    const s16x4 l0 = tr_read<v_rd_off(0, 0, 0)>(vb), h0 = tr_read<v_rd_off(0, 0, 1)>(vb), l1 = tr_read<v_rd_off(0, 1, 0)>(vb), h1 = tr_read<v_rd_off(0, 1, 1)>(vb);
    const s16x4 l2 = tr_read<v_rd_off(0, 2, 0)>(vb), h2 = tr_read<v_rd_off(0, 2, 1)>(vb), l3 = tr_read<v_rd_off(0, 3, 0)>(vb), h3 = tr_read<v_rd_off(0, 3, 1)>(vb);
    asm volatile("s_waitcnt lgkmcnt(0)" ::: "memory"); SBAR();
    od = __builtin_amdgcn_mfma_f32_32x32x16_bf16(PK(al0, ah0), PK(l0, h0), od, 0, 0, 0);
    od = __builtin_amdgcn_mfma_f32_32x32x16_bf16(PK(al1, ah1), PK(l1, h1), od, 0, 0, 0);
    od = __builtin_amdgcn_mfma_f32_32x32x16_bf16(PK(al2, ah2), PK(l2, h2), od, 0, 0, 0);
    od = __builtin_amdgcn_mfma_f32_32x32x16_bf16(PK(al3, ah3), PK(l3, h3), od, 0, 0, 0);
#undef PK
}
#define PK4(P, BASE, OUT) do { unsigned a0 = cvtpk(P[BASE + 0], P[BASE + 1]), a1 = cvtpk(P[BASE + 2], P[BASE + 3]);   \
    unsigned b0 = cvtpk(P[BASE + 4], P[BASE + 5]), b1 = cvtpk(P[BASE + 6], P[BASE + 7]);                              \
    auto r0 = __builtin_amdgcn_permlane32_swap(a0, b0, false, false); auto r1 = __builtin_amdgcn_permlane32_swap(a1, b1, false, false); \
    u32x4 w = {r0[0], r1[0], r0[1], r1[1]}; OUT = *reinterpret_cast<bf16x8*>(&w); } while (0)
__device__ __forceinline__ float half_swap_add(float v) { auto rr = __builtin_amdgcn_permlane32_swap(__float_as_uint(v), __float_as_uint(v), false, false); return __uint_as_float(rr[0]) + __uint_as_float(rr[1]); }
__device__ __forceinline__ bf16x8 scale8(bf16x8 v, float s) {
    const u32x4 w = *reinterpret_cast<const u32x4*>(&v); u32x4 o;
    o.x = cvtpk(__uint_as_float(w.x << 16) * s, __uint_as_float(w.x & 0xffff0000u) * s); o.y = cvtpk(__uint_as_float(w.y << 16) * s, __uint_as_float(w.y & 0xffff0000u) * s);
    o.z = cvtpk(__uint_as_float(w.z << 16) * s, __uint_as_float(w.z & 0xffff0000u) * s); o.w = cvtpk(__uint_as_float(w.w << 16) * s, __uint_as_float(w.w & 0xffff0000u) * s);
    return *reinterpret_cast<bf16x8*>(&o);
}
__device__ __forceinline__ bf16x8 f8_to_bf(const float* p, bool ok) {
    if (!ok) return (bf16x8){0, 0, 0, 0, 0, 0, 0, 0};
    const f32x4 a = *(const f32x4*)p, b = *(const f32x4*)(p + 4); u32x4 o = {cvtpk(a[0], a[1]), cvtpk(a[2], a[3]), cvtpk(b[0], b[1]), cvtpk(b[2], b[3])};
    return *reinterpret_cast<bf16x8*>(&o);
}
template <int K> __device__ __forceinline__ float dpp_shr(float v, float ident) {
    return __int_as_float(__builtin_amdgcn_update_dpp(__float_as_int(ident), __float_as_int(v), 0x110 | K, 0xf, 0xf, false));
}
__device__ __forceinline__ float rdlane(float v, int l) { return __int_as_float(__builtin_amdgcn_readlane(__float_as_int(v), l)); }
__device__ __forceinline__ float wave_incl_sum(float v, int lane) {
    v += dpp_shr<1>(v, 0.f); v += dpp_shr<2>(v, 0.f); v += dpp_shr<4>(v, 0.f); v += dpp_shr<8>(v, 0.f);
    const float s0 = rdlane(v, 15), s1 = rdlane(v, 31), s2 = rdlane(v, 47); const int row = lane >> 4;
    return v + (row >= 1 ? s0 : 0.f) + (row >= 2 ? s1 : 0.f) + (row >= 3 ? s2 : 0.f);
}
__device__ __forceinline__ float wave_incl_max(float v, int lane) {
    const float NI = -3.0e38f;
    v = fmaxf(v, dpp_shr<1>(v, NI)); v = fmaxf(v, dpp_shr<2>(v, NI)); v = fmaxf(v, dpp_shr<4>(v, NI)); v = fmaxf(v, dpp_shr<8>(v, NI));
    const float s0 = rdlane(v, 15), s1 = rdlane(v, 31), s2 = rdlane(v, 47); const int row = lane >> 4;
    return fmaxf(fmaxf(v, row >= 1 ? s0 : NI), fmaxf(row >= 2 ? s1 : NI, row >= 3 ? s2 : NI));
}
__device__ __forceinline__ float wave_max(float v) {
    const float NI = -3.0e38f;
    v = fmaxf(v, dpp_shr<1>(v, NI)); v = fmaxf(v, dpp_shr<2>(v, NI)); v = fmaxf(v, dpp_shr<4>(v, NI)); v = fmaxf(v, dpp_shr<8>(v, NI));
    return fmaxf(fmaxf(rdlane(v, 15), rdlane(v, 31)), fmaxf(rdlane(v, 47), rdlane(v, 63)));
}

constexpr int SC_BUF = 32768;
__device__ __forceinline__ void scan_unit(const Params& p, int b, int h, int dir, char* lds) {
    const int tid = threadIdx.x, wid = tid >> 6, lane = tid & 63, r32 = lane & 31, hi = lane >> 5, db = wid & 1, vq = wid >> 1;
    const int sr = tid >> 3, sc8 = tid & 7;
    const int kst = v_st(sr, sc8 * 8), vst0 = v_st(sr, sc8 * 8), vst1 = v_st(sr, 64 + sc8 * 8);
    const int va0 = (int)(uintptr_t)lds + v_rd_base(lane) + db * 512, vb0 = (int)(uintptr_t)lds + 16384 + v_rd_base(lane) + vq * 512;
    bf16_t* CS = dir ? p.CB() : p.CF(); float* NS = dir ? p.NB_() : p.NF(); float* MS = dir ? p.MB() : p.MF();
    const size_t sbase = (size_t)(b * 8 + h) * 64;
    f32x16 acc = {}; float nacc = 0.f, m = 0.f, decay_prev = 1.f;
    const int nsteps = dir ? 64 : 65;
    bf16x8 sk, sv0, sv1; float gli, glf;
#define ML_LOAD(st) do { const int c_ = dir ? 63 - (st) : (st) - 1; \
        if (c_ < 0) { const float* z = p.ZM() + (size_t)(sr & 15) * DIN; const bool okr = sr < NMETA; \
            sk = f8_to_bf(z + OFF_K + h * 64 + sc8 * 8, okr); sv0 = f8_to_bf(z + OFF_V + h * 128 + sc8 * 8, okr); sv1 = f8_to_bf(z + OFF_V + h * 128 + 64 + sc8 * 8, okr); \
            const float* zl = p.ZM() + (size_t)(lane & 15) * DIN; gli = lane < NMETA ? zl[OFF_I + h] + p.m_b_i[h] : -1e30f; glf = lane < NMETA ? logsigmoidf_(zl[OFF_F + h] + p.m_b_f[h]) : 0.f; } \
        else { const size_t r_ = (size_t)b * SEQ + c_ * 64 + sr; sk = *reinterpret_cast<const bf16x8*>(p.Km() + r_ * 512 + h * 64 + sc8 * 8); \
            sv0 = *reinterpret_cast<const bf16x8*>(p.Vm() + r_ * 1024 + h * 128 + sc8 * 8); sv1 = *reinterpret_cast<const bf16x8*>(p.Vm() + r_ * 1024 + h * 128 + 64 + sc8 * 8); \
            const size_t rg = (size_t)b * SEQ + c_ * 64 + (dir ? 63 - lane : lane); gli = p.GI()[rg * 16 + dir * 8 + h]; glf = p.GF()[rg * 16 + dir * 8 + h]; } } while (0)
#define ML_GATES(decay_, mnew_, wk_) do { const float bc_ = wave_incl_sum(glf, lane); const float bl_ = rdlane(bc_, 63); const float g_ = bl_ - bc_ + gli; \
        mnew_ = fmaxf(bl_ + m, wave_max(g_)); decay_ = __expf(bl_ + m - mnew_); wk_ = __expf(g_ - mnew_); } while (0)
    ML_LOAD(0);
    float decay, mnew, wk;
    { asm volatile("s_waitcnt vmcnt(0)" ::: "memory"); ML_GATES(decay, mnew, wk);
      const float w = __shfl(wk, dir ? 63 - sr : sr);
      *(bf16x8*)(lds + kst) = sk; *(bf16x8*)(lds + 16384 + vst0) = scale8(sv0, w); *(bf16x8*)(lds + 16384 + vst1) = scale8(sv1, w); }
    __syncthreads();
#pragma unroll 1
    for (int st = 0; st < nsteps; ++st) {
        const int c = dir ? 63 - st : st - 1, buf = st & 1;
        if (wid == 0 && st > 0) { float s_ = 0.f; const float* np_ = (const float*)(lds + 65536) + ((st - 1) & 1) * 512;
#pragma unroll
            for (int w8 = 0; w8 < 8; ++w8) s_ += np_[w8 * 64 + lane];
            nacc = nacc * decay_prev + s_; }
        if (c >= 0) {
            const size_t sidx = sbase + c; bf16_t* cd = CS + sidx * 8192 + (size_t)(db * 32) * 128 + vq * 32 + r32;
#pragma unroll
            for (int r = 0; r < 16; ++r) cd[(size_t)crow(r, hi) * 128] = f2bf(acc[r]);
            if (wid == 0) NS[sidx * 64 + lane] = nacc;
            if (tid == 0) MS[sidx] = m;
        }
        if (st == nsteps - 1) break;
        if (st + 1 < nsteps - 1) ML_LOAD(st + 1);
#pragma unroll
        for (int r = 0; r < 16; ++r) acc[r] *= decay;
        tt_blk(acc, va0 + buf * SC_BUF, vb0 + buf * SC_BUF);
        {
            float s_ = 0.f;
#pragma unroll
            for (int q = 0; q < 8; ++q) { const int s = wid * 8 + q; const float w = __shfl(wk, dir ? 63 - s : s); s_ += w * bf2f(*(const bf16_t*)(lds + buf * SC_BUF + v_st(s, lane))); }
            ((float*)(lds + 65536))[(st & 1) * 512 + wid * 64 + lane] = s_;
        }
        decay_prev = decay;
        m = mnew;
        if (st + 1 < nsteps - 1) {
            asm volatile("s_waitcnt vmcnt(0)" ::: "memory"); ML_GATES(decay, mnew, wk);
            const float w = __shfl(wk, dir ? 63 - sr : sr); char* lb = lds + (buf ^ 1) * SC_BUF;
            *(bf16x8*)(lb + kst) = sk; *(bf16x8*)(lb + 16384 + vst0) = scale8(sv0, w); *(bf16x8*)(lb + 16384 + vst1) = scale8(sv1, w);
        }
        __syncthreads();
    }
    __syncthreads();
#undef ML_LOAD
#undef ML_GATES
}

constexpr int O_K = 0, O_V = 8192, O_CF = 24576, O_CB = 40960, O_T = 57344, O_ARR = 122880, O_WS = 125440, O_END = 127488;
struct OutPre { bf16x8 kk, v0, v1, f0, f1, b0, b1, q0, q1, q2, q3; float li, lf, mm, nn; };
__device__ __forceinline__ void out_load(const Params& p, int u, OutPre& R) {
    const int tid = threadIdx.x, wid = tid >> 6, lane = tid & 63, r32 = lane & 31, hi = lane >> 5, tb = wid & 1;
    const int b = u >> 9, h = u & 7, c = (u >> 3) & 63; const size_t r0 = (size_t)b * SEQ + c * 64, sidx = (size_t)(b * 8 + h) * 64 + c;
    const int sr = tid >> 3, sc8 = tid & 7;
    R.kk = *reinterpret_cast<const bf16x8*>(p.Km() + (r0 + sr) * 512 + h * 64 + sc8 * 8);
    const bf16_t* vp = p.Vm() + (r0 + sr) * 1024 + h * 128 + sc8 * 8; R.v0 = *reinterpret_cast<const bf16x8*>(vp); R.v1 = *reinterpret_cast<const bf16x8*>(vp + 64);
    const bf16_t* cf = p.CF() + sidx * 8192 + (size_t)sr * 128 + sc8 * 8; R.f0 = *reinterpret_cast<const bf16x8*>(cf); R.f1 = *reinterpret_cast<const bf16x8*>(cf + 64);
    const bf16_t* cb = p.CB() + sidx * 8192 + (size_t)sr * 128 + sc8 * 8; R.b0 = *reinterpret_cast<const bf16x8*>(cb); R.b1 = *reinterpret_cast<const bf16x8*>(cb + 64);
    const bf16_t* qp = p.Qm() + (r0 + tb * 32 + r32) * 512 + h * 64 + hi * 8;
    R.q0 = *reinterpret_cast<const bf16x8*>(qp); R.q1 = *reinterpret_cast<const bf16x8*>(qp + 16); R.q2 = *reinterpret_cast<const bf16x8*>(qp + 32); R.q3 = *reinterpret_cast<const bf16x8*>(qp + 48);
    R.li = 0.f; R.lf = 0.f; R.mm = 0.f; R.nn = 0.f;
    if (wid < 2) { const int dir = wid, t = dir ? 63 - lane : lane; R.li = p.GI()[(r0 + t) * 16 + dir * 8 + h]; R.lf = p.GF()[(r0 + t) * 16 + dir * 8 + h]; R.mm = (dir ? p.MB() : p.MF())[sidx]; }
    else if (wid < 4) { const int dir = wid - 2; R.nn = (dir ? p.NB_() : p.NF())[sidx * 64 + lane]; }
}
__device__ __forceinline__ void phase_mlstm_out_body(const Params& p, char* lds, int vcu, int G) {
    const int tid = threadIdx.x, wid = tid >> 6, lane = tid & 63, r32 = lane & 31, hi = lane >> 5, tb = wid & 1, vq = wid >> 1;
    const int sr = tid >> 3, sc8 = tid & 7;
    float* arr = (float*)(lds + O_ARR);
    float* nbuf = arr + 512;
    float* wsc = (float*)(lds + O_WS) + wid * 64;
    const int NU = NB * 8 * 64;
    OutPre R;
    if (vcu < NU) out_load(p, vcu, R);
#pragma unroll 1
    for (int u = vcu; u < NU; u += G) {
        const int b = u >> 9, h = u & 7, c = (u >> 3) & 63; const size_t r0 = (size_t)b * SEQ + c * 64;
        { *(bf16x8*)(lds + O_K + RSWZ(sr, sc8 * 16)) = R.kk;
          const int s0 = v_st(sr, sc8 * 8), s1 = v_st(sr, 64 + sc8 * 8);
          *(bf16x8*)(lds + O_V + s0) = R.v0; *(bf16x8*)(lds + O_V + s1) = R.v1; *(bf16x8*)(lds + O_CF + s0) = R.f0; *(bf16x8*)(lds + O_CF + s1) = R.f1; *(bf16x8*)(lds + O_CB + s0) = R.b0; *(bf16x8*)(lds + O_CB + s1) = R.b1; }
        if (wid < 2) {
            const int dir = wid, t = dir ? 63 - lane : lane; const float m = R.mm;
            const float bc = wave_incl_sum(R.lf, lane), a = R.li - bc, pm = wave_incl_max(a, lane), mx = fmaxf(m, pm);
            float* ar = arr + dir * 256;
            ar[t] = -mx * 1.4426950408889634f; ar[64 + t] = a * 1.4426950408889634f; ar[128 + t] = __expf(m - mx); ar[192 + t] = __expf(-(bc + mx));
        } else if (wid < 4) nbuf[(wid - 2) * 64 + lane] = R.nn;
        bf16x8 qr[4] = {R.q0, R.q1, R.q2, R.q3};
        __syncthreads();
        if (u + G < NU) out_load(p, u + G, R);
        const int ocol = h * 128 + sc8 * 16; const size_t oo = (r0 + sr) * 1024 + ocol;
        const u32x4 og0 = *(const u32x4*)(p.OG() + oo), og1 = *(const u32x4*)(p.OG() + oo + 8);
        const f32x4 n0 = *(const f32x4*)(p.m_norm + ocol), n1 = *(const f32x4*)(p.m_norm + ocol + 4), n2 = *(const f32x4*)(p.m_norm + ocol + 8), n3 = *(const f32x4*)(p.m_norm + ocol + 12);
        const int dir = (wid >> 1) & 1, vh = wid >> 2;
        float qn;
        { const float* nv = nbuf + dir * 64 + hi * 8; float s_ = 0.f;
#pragma unroll
          for (int d0 = 0; d0 < 4; ++d0) { const u32x4 w = *reinterpret_cast<const u32x4*>(&qr[d0]); const f32x4 n0 = *(const f32x4*)(nv + d0 * 16), n1 = *(const f32x4*)(nv + d0 * 16 + 4);
              s_ += __uint_as_float(w.x << 16) * n0[0] + __uint_as_float(w.x & 0xffff0000u) * n0[1] + __uint_as_float(w.y << 16) * n0[2] + __uint_as_float(w.y & 0xffff0000u) * n0[3]
                  + __uint_as_float(w.z << 16) * n1[0] + __uint_as_float(w.z & 0xffff0000u) * n1[1] + __uint_as_float(w.w << 16) * n1[2] + __uint_as_float(w.w & 0xffff0000u) * n1[3]; }
          qn = half_swap_add(s_); }
        f32x16 p0 = {}, p1 = {};
        const bool has0 = !(dir == 1 && tb == 1), has1 = !(dir == 0 && tb == 0);
#pragma unroll
        for (int d0 = 0; d0 < 4; ++d0) { const int cb = (d0 * 16 + hi * 8) * 2;
            if (has0) { const bf16x8 k0 = *reinterpret_cast<const bf16x8*>(lds + O_K + RSWZ(r32, cb)); p0 = __builtin_amdgcn_mfma_f32_32x32x16_bf16(k0, qr[d0], p0, 0, 0, 0); }
            if (has1) { const bf16x8 k1 = *reinterpret_cast<const bf16x8*>(lds + O_K + RSWZ(32 + r32, cb)); p1 = __builtin_amdgcn_mfma_f32_32x32x16_bf16(k1, qr[d0], p1, 0, 0, 0); } }
        const int t = tb * 32 + r32;
        const int vbase = (int)(uintptr_t)lds + v_rd_base(lane) + vh * 1024;
#define W_FULL(P, W, SB) _Pragma("unroll") for (int g = 0; g < 4; ++g) { const f32x4 ct = *(const f32x4*)(ar + 64 + (SB) + 8 * g + 4 * hi); \
            _Pragma("unroll") for (int q = 0; q < 4; ++q) { const float x = __builtin_amdgcn_exp2f(rt + ct[q]) * P[4 * g + q]; W[4 * g + q] = x; rs += x; } }
#define W_DIAG(P, W, SB) _Pragma("unroll") for (int g = 0; g < 4; ++g) { const f32x4 ct = *(const f32x4*)(ar + 64 + (SB) + 8 * g + 4 * hi); \
            _Pragma("unroll") for (int q = 0; q < 4; ++q) { const int sl = 8 * g + 4 * hi + q; const bool ok = dir ? (sl >= r32) : (sl <= r32); \
                const float x = ok ? __builtin_amdgcn_exp2f(rt + ct[q]) * P[4 * g + q] : 0.f; W[4 * g + q] = x; rs += x; } }
        {
            const float* ar = arr + dir * 256; const float rt = ar[t], sint = ar[128 + t], efl = ar[192 + t];
            f32x16 w0, w1; float rs = 0.f;
            if (tb == 0) { W_DIAG(p0, w0, 0) if (dir == 1) { W_FULL(p1, w1, 32) } }
            else         { W_DIAG(p1, w1, 32) if (dir == 0) { W_FULL(p0, w0, 0) } }
            rs = half_swap_add(rs);
            bf16x8 pa0, pa1, pa2, pa3;
            if (has0) { PK4(w0, 0, pa0); PK4(w0, 8, pa1); }
            if (has1) { PK4(w1, 0, pa2); PK4(w1, 8, pa3); }
            const float den = rs + sint * qn, inv = 1.f / fmaxf(fabsf(den), efl);
            if (hi == 0) { wsc[r32] = sint; wsc[32 + r32] = inv; }
            f32x16 o0 = {}, o1 = {};
            pv_blk(o0, vbase + (dir ? O_CB : O_CF), qr[0], qr[1], qr[2], qr[3]);
            pv_blk(o1, vbase + (dir ? O_CB : O_CF) + 512, qr[0], qr[1], qr[2], qr[3]);
            asm volatile("s_waitcnt lgkmcnt(0)" ::: "memory");
#pragma unroll
            for (int g = 0; g < 4; ++g) { const f32x4 sc = *(const f32x4*)(wsc + 8 * g + 4 * hi);
#pragma unroll
                for (int q = 0; q < 4; ++q) { o0[4 * g + q] *= sc[q]; o1[4 * g + q] *= sc[q]; } }
            if (has0) { pv_blk2<0>(o0, vbase + O_V, pa0, pa1); pv_blk2<0>(o1, vbase + O_V + 512, pa0, pa1); }
            if (has1) { pv_blk2<2>(o0, vbase + O_V, pa2, pa3); pv_blk2<2>(o1, vbase + O_V + 512, pa2, pa3); }
            float* T = (float*)(lds + O_T + dir * 32768) + (size_t)(tb * 32) * 128 + vh * 64 + r32;
#pragma unroll
            for (int g = 0; g < 4; ++g) { const f32x4 sc = *(const f32x4*)(wsc + 32 + 8 * g + 4 * hi);
#pragma unroll
                for (int q = 0; q < 4; ++q) { const int rw = 8 * g + 4 * hi + q; T[rw * 128] = o0[4 * g + q] * sc[q]; T[rw * 128 + 32] = o1[4 * g + q] * sc[q]; } }
        }
#undef W_FULL
#undef W_DIAG
        __syncthreads();
        { const float* T = (const float*)(lds + O_T) + sr * 128 + sc8 * 16; f32x4 v[4]; float ss = 0.f;
#pragma unroll
          for (int q = 0; q < 4; ++q) { v[q] = *(const f32x4*)(T + q * 4) + *(const f32x4*)(T + 8192 + q * 4); ss += v[q][0] * v[q][0] + v[q][1] * v[q][1] + v[q][2] * v[q][2] + v[q][3] * v[q][3]; }
          ss += __shfl_xor(ss, 1); ss += __shfl_xor(ss, 2); ss += __shfl_xor(ss, 4);
          const float rstd = rsqrtf(ss * (1.f / 128.f) + EPS);
          const f32x4 g0 = (f32x4){__uint_as_float(og0.x << 16), __uint_as_float(og0.x & 0xffff0000u), __uint_as_float(og0.y << 16), __uint_as_float(og0.y & 0xffff0000u)};
          const f32x4 g1 = (f32x4){__uint_as_float(og0.z << 16), __uint_as_float(og0.z & 0xffff0000u), __uint_as_float(og0.w << 16), __uint_as_float(og0.w & 0xffff0000u)};
          const f32x4 g2 = (f32x4){__uint_as_float(og1.x << 16), __uint_as_float(og1.x & 0xffff0000u), __uint_as_float(og1.y << 16), __uint_as_float(og1.y & 0xffff0000u)};
          const f32x4 g3 = (f32x4){__uint_as_float(og1.z << 16), __uint_as_float(og1.z & 0xffff0000u), __uint_as_float(og1.w << 16), __uint_as_float(og1.w & 0xffff0000u)};
          st8_bf16(p.HM() + oo, v[0] * rstd * n0 * g0, v[1] * rstd * n1 * g1); st8_bf16(p.HM() + oo + 8, v[2] * rstd * n2 * g2, v[3] * rstd * n3 * g3); }
    }
    __syncthreads();
}
#undef PK4
#undef RSWZ
#undef SBAR
}

__device__ __forceinline__ void phase_mlstm_scan(const Params& p, char* lds, int vcu, int G) {
    for (int u = vcu; u < NB * 8 * 2; u += G) ml::scan_unit(p, u >> 4, (u >> 1) & 7, u & 1, lds);
}
__device__ __forceinline__ void phase_mlstm_out(const Params& p, char* lds, int vcu, int G) {
    ml::phase_mlstm_out_body(p, lds, vcu, G);
}

#define RS_STEP(IN, OUT, N, BIT, MASK) _Pragma("unroll") for (int i_ = 0; i_ < (N); ++i_) { const float keep_ = (BIT) ? IN[(N) + i_] : IN[i_], send_ = (BIT) ? IN[i_] : IN[(N) + i_]; OUT[i_] = keep_ + __shfl_xor(send_, (MASK)); }
__device__ __forceinline__ float route_reduce(const float (&v)[32], int lane) {
    const int b5 = (lane >> 5) & 1, b4 = (lane >> 4) & 1, b3 = (lane >> 3) & 1, b2 = (lane >> 2) & 1, b1 = (lane >> 1) & 1;
    float a16[16], a8[8], a4[4], a2[2], a1[1];
    RS_STEP(v, a16, 16, b5, 32) RS_STEP(a16, a8, 8, b4, 16) RS_STEP(a8, a4, 4, b3, 8) RS_STEP(a4, a2, 2, b2, 4) RS_STEP(a2, a1, 1, b1, 2)
    return a1[0] + __shfl_xor(a1[0], 1);
}
__device__ __forceinline__ int route_rank(float val, int myexp) {
    int cnt = 0;
#pragma unroll
    for (int e = 0; e < 32; ++e) { const float ve = __int_as_float(__builtin_amdgcn_readlane(__float_as_int(val), 2 * e)); cnt += (ve > val || (ve == val && e < myexp)) ? 1 : 0; }
    return cnt;
}
__device__ __forceinline__ void phase_route(const Params& p, char* lds, int vcu, int G) {
    constexpr int XST = 1028;
    float* xs = (float*)lds;
    float* part = (float*)(lds + 65792);
    unsigned short* ent = (unsigned short*)(lds + 84224);
    int* lcount = (int*)(lds + 88320); int* lbase = lcount + 32;
    float* rec = (float*)(lds + 88576);
    const int tid = threadIdx.x, lane = tid & 63, w = tid >> 6, q4 = lane >> 4, l15 = lane & 15;
    __syncthreads();
    if (tid < 32) lcount[tid] = 0;
    float breg0[32], breg1[32];
#pragma unroll
    for (int i = 0; i < 32; ++i) { const float* wr = p.w_router + (size_t)(128 * w + 4 * i + q4) * NEXP + l15; breg0[i] = wr[0]; breg1[i] = wr[16]; }
    const int te = lane & 31, tsel = lane >> 5;
    const float mybias = p.b_router[te];
    int nloc = 0;
    float4 pa_[4], pb_[4];
    if (vcu * 16 < NT) {
#pragma unroll
        for (int j = 0; j < 4; ++j) { pa_[j] = ntld4(p.out + (size_t)(vcu * 16 + w * 2) * DM + (j * 64 + lane) * 4); pb_[j] = ntld4(p.out + (size_t)(vcu * 16 + w * 2 + 1) * DM + (j * 64 + lane) * 4); } }
#pragma unroll 1
    for (int base = vcu * 16; base < NT; base += G * 16, nloc += 16) {
        const int row0 = base + w * 2;
        float4 xa[4], xb[4]; float sa = 0.f, sb = 0.f;
#pragma unroll
        for (int j = 0; j < 4; ++j) { xa[j] = pa_[j]; xb[j] = pb_[j]; }
        { const int nb_ = base + G * 16; if (nb_ < NT) {
#pragma unroll
            for (int j = 0; j < 4; ++j) { pa_[j] = ntld4(p.out + (size_t)(nb_ + w * 2) * DM + (j * 64 + lane) * 4); pb_[j] = ntld4(p.out + (size_t)(nb_ + w * 2 + 1) * DM + (j * 64 + lane) * 4); } } }
#pragma unroll
        for (int j = 0; j < 4; ++j) { sa += xa[j].x * xa[j].x + xa[j].y * xa[j].y + xa[j].z * xa[j].z + xa[j].w * xa[j].w; sb += xb[j].x * xb[j].x + xb[j].y * xb[j].y + xb[j].z * xb[j].z + xb[j].w * xb[j].w; }
        const float ra = rsqrtf(wave_sum(sa) * (1.f / DM) + EPS), rb = rsqrtf(wave_sum(sb) * (1.f / DM) + EPS);
#pragma unroll
        for (int j = 0; j < 4; ++j) { const int c = (j * 64 + lane) * 4; const float4 g = *(const float4*)(p.norm_ffn + c);
            xa[j] = make_float4(xa[j].x * ra * g.x, xa[j].y * ra * g.y, xa[j].z * ra * g.z, xa[j].w * ra * g.w);
            xb[j] = make_float4(xb[j].x * rb * g.x, xb[j].y * rb * g.y, xb[j].z * rb * g.z, xb[j].w * rb * g.w);
            *(float4*)&xs[(w * 2) * XST + c] = xa[j]; *(float4*)&xs[(w * 2 + 1) * XST + c] = xb[j];
            *(unsigned*)((unsigned char*)p.XN2() + (size_t)row0 * DM + c) = pk4_fp8(xa[j].x, xa[j].y, xa[j].z, xa[j].w);
            *(unsigned*)((unsigned char*)p.XN2() + (size_t)(row0 + 1) * DM + c) = pk4_fp8(xb[j].x, xb[j].y, xb[j].z, xb[j].w); }
        __syncthreads();
        f32x4 acc0 = {0.f, 0.f, 0.f, 0.f}, acc1 = {0.f, 0.f, 0.f, 0.f};
        const float* xp = xs + l15 * XST + 128 * w + q4;
#pragma unroll
        for (int i = 0; i < 32; ++i) { const float a = xp[4 * i];
            acc0 = __builtin_amdgcn_mfma_f32_16x16x4f32(a, breg0[i], acc0, 0, 0, 0); acc1 = __builtin_amdgcn_mfma_f32_16x16x4f32(a, breg1[i], acc1, 0, 0, 0); }
#pragma unroll
        for (int r = 0; r < 4; ++r) { part[(w * 16 + 4 * q4 + r) * 32 + l15] = acc0[r]; part[(w * 16 + 4 * q4 + r) * 32 + 16 + l15] = acc1[r]; }
        __syncthreads();
        float val = mybias;
#pragma unroll
        for (int w8 = 0; w8 < 8; ++w8) val += part[(w8 * 16 + 2 * w + tsel) * 32 + te];
        int cnt = 0;
#pragma unroll
        for (int e = 0; e < 32; ++e) { const float v0 = __int_as_float(__builtin_amdgcn_readlane(__float_as_int(val), e)), v1 = __int_as_float(__builtin_amdgcn_readlane(__float_as_int(val), 32 + e));
            const float ve = tsel ? v1 : v0; cnt += (ve > val || (ve == val && e < te)) ? 1 : 0; }
        float* rc = rec + w * 16 + tsel * 8;
        if (cnt < 4) { rc[cnt * 2] = __int_as_float(te); rc[cnt * 2 + 1] = val; }
        asm volatile("s_waitcnt lgkmcnt(0)" ::: "memory");
        if (te == 0) {
            const int row = row0 + tsel, tl = nloc + w * 2 + tsel; float ex[4], sum = 0.f; int tx[4];
#pragma unroll
            for (int kk = 0; kk < 4; ++kk) { tx[kk] = __float_as_int(rc[kk * 2]); ex[kk] = __expf(rc[kk * 2 + 1] - rc[1]); sum += ex[kk]; }
            const float inv = 1.f / sum;
#pragma unroll
            for (int kk = 0; kk < 4; ++kk) { const int e = tx[kk]; p.TOPI()[row * 4 + kk] = e; p.TOPW()[row * 4 + kk] = ex[kk] * inv;
                const int lr = atomicAdd(&lcount[e], 1); ent[tl * 4 + kk] = (unsigned short)(e | (lr << 5)); }
        }
        asm volatile("s_waitcnt lgkmcnt(0)" ::: "memory");
    }
    __syncthreads();
    if (tid < 32) lbase[tid] = atomicAdd(&p.CNT()[tid * CNT_STRIDE], lcount[tid]);
    __syncthreads();
    for (int idx = tid; idx < nloc * 4; idx += MK_THREADS) { const int tl = idx >> 2, row = vcu * 16 + (tl >> 4) * G * 16 + (tl & 15); const unsigned en = ent[idx];
        p.RANK()[row * 4 + (idx & 3)] = lbase[en & 31] + (int)(en >> 5); }
    __syncthreads();
}
#undef RS_STEP
__device__ __forceinline__ void phase_scatter(const Params& p, char* lds, int vcu, int G) {
    int* ps = (int*)lds;
    __syncthreads();
    if (threadIdx.x == 0) { int s = 0; for (int e = 0; e < NEXP; ++e) { ps[e] = s; s += (p.CNT()[e * CNT_STRIDE] + 255) / 256 * 256; } }
    __syncthreads();
    for (int gid = vcu * MK_THREADS + threadIdx.x; gid < NT * 4; gid += G * MK_THREADS) { const int slot = ps[p.TOPI()[gid]] + p.RANK()[gid]; p.SLOTS()[gid] = slot; p.SLOT_TOK()[slot] = gid >> 2; }
    __syncthreads();
}
__device__ __forceinline__ void phase_combine(const Params& p, int vcu, int G, float* dst) {
    const int lane = threadIdx.x & 63, gw = vcu * 8 + (threadIdx.x >> 6), NGW = G * 8;
    for (int r = gw * 2; r < NT; r += NGW * 2) {
        int sl[8]; float tw[8];
#pragma unroll
        for (int q = 0; q < 8; ++q) { sl[q] = p.SLOTS()[r * 4 + q]; tw[q] = p.TOPW()[r * 4 + q]; }
        float4 v[8];
#pragma unroll
        for (int j = 0; j < 4; ++j) { v[j] = ntld4(p.out + (size_t)r * DM + (j * 64 + lane) * 4); v[4 + j] = ntld4(p.out + (size_t)(r + 1) * DM + (j * 64 + lane) * 4); }
        uint2 y[8][4];
#pragma unroll
        for (int q = 0; q < 8; ++q)
#pragma unroll
            for (int j = 0; j < 4; ++j) y[q][j] = ntld2u(p.YB() + (size_t)sl[q] * DM + (j * 64 + lane) * 4);
#pragma unroll
        for (int q = 0; q < 8; ++q) { const float w = tw[q]; const int o = (q >> 2) * 4;
#pragma unroll
            for (int j = 0; j < 4; ++j) { const uint2 t = y[q][j];
                v[o + j].x += w * __uint_as_float(t.x << 16); v[o + j].y += w * __uint_as_float(t.x & 0xffff0000u); v[o + j].z += w * __uint_as_float(t.y << 16); v[o + j].w += w * __uint_as_float(t.y & 0xffff0000u); } }
        float sa = 0.f, sb = 0.f;
#pragma unroll
        for (int j = 0; j < 4; ++j) { sa += v[j].x * v[j].x + v[j].y * v[j].y + v[j].z * v[j].z + v[j].w * v[j].w; sb += v[4 + j].x * v[4 + j].x + v[4 + j].y * v[4 + j].y + v[4 + j].z * v[4 + j].z + v[4 + j].w * v[4 + j].w; }
        const float ra = rsqrtf(wave_sum(sa) * (1.f / DM) + EPS), rb = rsqrtf(wave_sum(sb) * (1.f / DM) + EPS);
#pragma unroll
        for (int j = 0; j < 4; ++j) { const int c = (j * 64 + lane) * 4; const float4 g = *(const float4*)(p.norm_final + c);
            *(float4*)(dst + (size_t)r * DM + c) = make_float4(v[j].x * ra * g.x, v[j].y * ra * g.y, v[j].z * ra * g.z, v[j].w * ra * g.w);
            *(float4*)(dst + (size_t)(r + 1) * DM + c) = make_float4(v[4 + j].x * rb * g.x, v[4 + j].y * rb * g.y, v[4 + j].z * rb * g.z, v[4 + j].w * rb * g.w); }
    }
}
__device__ __forceinline__ void phase_init_ctl(const Params& p, int vcu, int G) {
    if (vcu == 0) for (int i = threadIdx.x; i < NEXP * CNT_STRIDE; i += MK_THREADS) p.CNT()[i] = 0;
    for (int i = vcu * MK_THREADS + threadIdx.x; i < NSLOT; i += G * MK_THREADS) p.SLOT_TOK()[i] = -1;
}

#define XB_TMO      128
#define XB_XCNT(j)  (256  + 64 * (j))
#define XB_XSUB(j)  (1280 + 64 * (j))
#define XB_XGEN(j)  (2304 + 64 * (j))
#define XB_TOP      3328
#define XB_TOPGEN   3392
#define XCD_BAR_WORDS 3456
#define XB_SPIN_CAP (1u << 20)
__device__ __forceinline__ unsigned xb_ld(unsigned* p)              { return __hip_atomic_load(p, __ATOMIC_RELAXED, __HIP_MEMORY_SCOPE_AGENT); }
__device__ __forceinline__ unsigned xb_add(unsigned* p, unsigned v) { return __hip_atomic_fetch_add(p, v, __ATOMIC_RELAXED, __HIP_MEMORY_SCOPE_AGENT); }
__device__ __forceinline__ unsigned xb_xcc_id() { return (unsigned)__builtin_amdgcn_s_getreg((3 << 11) | 20) & 0xFu; }
#define XB_SPIN(cond, bar) do { unsigned _sp = 0; while (cond) { __builtin_amdgcn_s_sleep(1); \
    if ((++_sp & 255u) == 0u) { if (xb_ld(&(bar)[XB_TMO])) break; if (_sp > XB_SPIN_CAP) { atomicAdd(&(bar)[XB_TMO], 1u); break; } } } } while (0)
struct XcdBarrier { unsigned* bar; unsigned x; volatile LAS unsigned* st; };
__device__ __forceinline__ XcdBarrier xcd_barrier_post(unsigned* bar, volatile LAS unsigned* st) {
    XcdBarrier b; b.bar = bar; b.x = xb_xcc_id(); b.st = st;
    if (threadIdx.x == 0) (void)xb_add(&bar[XB_XCNT(b.x)], 1u);
    return b;
}
__device__ __forceinline__ void xcd_barrier_complete(unsigned* bar, unsigned x, unsigned& nloc, unsigned& nx) {
    const unsigned G = gridDim.x * gridDim.y * gridDim.z;
    unsigned sum, cnt, mine, sp = 0u;
    for (;;) {
        sum = 0u; cnt = 0u; mine = 0u;
#pragma unroll
        for (unsigned j = 0; j < 16; ++j) { const unsigned c = xb_ld(&bar[XB_XCNT(j)]); sum += c; cnt += (c > 0u) ? 1u : 0u; mine = (j == x) ? c : mine; }
        if (sum == G) break;
        __builtin_amdgcn_s_sleep(1);
        if ((++sp & 255u) == 0u) { if (xb_ld(&bar[XB_TMO])) break; if (sp > XB_SPIN_CAP) { atomicAdd(&bar[XB_TMO], 1u); break; } }
    }
    nloc = mine > 0u ? mine : 1u; nx = cnt > 0u ? cnt : 1u;
}
__device__ __forceinline__ void xcd_barrier(const XcdBarrier& b) {
    asm volatile("s_waitcnt vmcnt(0)" ::: "memory");
    __syncthreads();
    if (threadIdx.x == 0) {
        unsigned* bar = b.bar;
        __builtin_amdgcn_s_waitcnt(0);
        unsigned nloc = b.st[0], nx = b.st[1];
        if (nloc == 0u) { xcd_barrier_complete(bar, b.x, nloc, nx); b.st[0] = nloc; b.st[1] = nx; }
        const unsigned old = xb_add(&bar[XB_XSUB(b.x)], 1u);
        const unsigned gen = old / nloc;
        if (old + 1u == (gen + 1u) * nloc) {
            __builtin_amdgcn_fence(__ATOMIC_RELEASE, "agent");
            asm volatile("s_waitcnt vmcnt(0)" ::: "memory");
            const unsigned og = xb_add(&bar[XB_TOP], 1u);
            const unsigned tg = og / nx;
            if (og + 1u == (tg + 1u) * nx) xb_add(&bar[XB_TOPGEN], 1u);
            else XB_SPIN(xb_ld(&bar[XB_TOPGEN]) == tg, bar);
            __builtin_amdgcn_fence(__ATOMIC_ACQUIRE, "agent");
            xb_add(&bar[XB_XGEN(b.x)], 1u);
            asm volatile("s_waitcnt vmcnt(0)" ::: "memory");
        } else {
            XB_SPIN(xb_ld(&bar[XB_XGEN(b.x)]) == gen, bar);
            __builtin_amdgcn_fence(__ATOMIC_ACQUIRE, "agent");
            asm volatile("s_waitcnt vmcnt(0)" ::: "memory");
        }
    }
    __syncthreads();
}

struct MkArgs { Params p; int ph_lo, ph_hi, sub, pad; };
enum { PH_PRO = 0, PH_INPROJ = 1, PH_MSCAN = 2, PH_QPROJ = 3, PH_MOUT = 4, PH_ATTN = 5, PH_YM = 6, PH_YA = 7, PH_OUT = 8, PH_ROUTE = 9, PH_SCATTER = 10, PH_M1 = 11, PH_M2 = 12, PH_COMBINE = 13, PH_END = 14 };

__global__ void __launch_bounds__(MK_THREADS, 2) mk_fwd(MkArgs a) {
    extern __shared__ __attribute__((aligned(16))) unsigned char lds_raw[];
    LAS unsigned char* lds = (LAS unsigned char*)lds_raw;
    const Params& p = *(const Params*)__builtin_amdgcn_kernarg_segment_ptr();
    const int G = gridDim.x, bx = blockIdx.x;
    const int vcu = (G % 8 == 0) ? (bx % 8) * (G / 8) + bx / 8 : bx;
    cooperative_groups::grid_group grid = cooperative_groups::this_grid();
    const int lo = a.ph_lo, hi = a.ph_hi;
    volatile LAS unsigned* bst = (volatile LAS unsigned*)(lds + MK_LDS - 16);
    if (threadIdx.x < 4) bst[threadIdx.x] = 0u;
    __syncthreads();
    XcdBarrier xbar; xbar.bar = p.BAR(); xbar.x = 0; xbar.st = bst;
    if (hi - lo > 1) xbar = xcd_barrier_post(p.BAR(), bst);
#ifndef PHASE_MASK
#define PHASE_MASK 0xffffffffu
#endif
#define IN(k) (((PHASE_MASK >> (k)) & 1u) && lo <= (k) && (k) < hi)
#define SEAM(k) do { if (IN(k) && IN((k) + 1)) { if (a.sub == 0x7fffffff) grid.sync(); else xcd_barrier(xbar); } } while (0)
#ifndef PROBE_PHASE
#define PROBE_PHASE -1
#endif
#ifndef PROBE_REPS
#define PROBE_REPS 2
#endif
#define REPS(k) ((k) == PROBE_PHASE ? PROBE_REPS : 1)
    if (IN(PH_PRO)) for (int rep_ = 0; rep_ < REPS(PH_PRO); ++rep_) { if (rep_) xcd_barrier(xbar); phase_init_ctl(p, vcu, G); phase_prologue(p, lds, vcu, G, a.sub); } SEAM(PH_PRO);
    if (IN(PH_INPROJ)) for (int rep_ = 0; rep_ < REPS(PH_INPROJ); ++rep_) { if (rep_) xcd_barrier(xbar); { pg8::StaticOrder S; S.init(NT, 2560, DM, G, bx, p.U(), p.WinT()); EpiInP<0> E{p}; pg8::gemm_phase<EpiInP<0>, pg8::StaticOrder>(lds, DM, DM, S, E); }
        { pg8::StaticOrder S; S.init(NT, 3072, DM / 2, G, bx, p.U8(), p.WinT8()); EpiInP<1> E{p}; pg8::gemm_phase<EpiInP<1>, pg8::StaticOrder, true>(lds, DM / 2, DM / 2, S, E); } } SEAM(PH_INPROJ);
    if (IN(PH_MSCAN)) for (int rep_ = 0; rep_ < REPS(PH_MSCAN); ++rep_) { if (rep_) xcd_barrier(xbar);
        { const int half = (bx >> 3) & 1, idx = (bx & 7) * 16 + (bx >> 4);
            if (half == 0) { if (a.sub != 2) phase_mlstm_scan(p, (char*)lds_raw, idx, 128); }
            else if (a.sub != 1) { phase_kprep(p, idx, 128);
                asm volatile("s_waitcnt vmcnt(0)" ::: "memory"); __syncthreads();
                if (threadIdx.x == 0) { unsigned* cw = p.BAR() + 3584; __builtin_amdgcn_fence(__ATOMIC_RELEASE, "agent"); asm volatile("s_waitcnt vmcnt(0)" ::: "memory");
                    xb_add(cw, 1u); unsigned sp = 0; while (xb_ld(cw) < 128u * (unsigned)(rep_ + 1)) { __builtin_amdgcn_s_sleep(2); if (++sp > (1u << 22)) break; }
                    __builtin_amdgcn_fence(__ATOMIC_ACQUIRE, "agent"); asm volatile("s_waitcnt vmcnt(0)" ::: "memory"); }
                __syncthreads();
                pg8::StaticOrder S; S.init(NT, 1536, 256, 128, idx, p.CQb(), p.WqT()); EpiQ E{p}; pg8::gemm_phase<EpiQ, pg8::StaticOrder>(lds, 256, 256, S, E); } }
        } SEAM(PH_MSCAN);
    if (IN(PH_MOUT)) for (int rep_ = 0; rep_ < REPS(PH_MOUT); ++rep_) { if (rep_) xcd_barrier(xbar); phase_mlstm_out(p, (char*)lds_raw, vcu, G); }
    if (IN(PH_ATTN)) for (int rep_ = 0; rep_ < REPS(PH_ATTN); ++rep_) { if (rep_) xcd_barrier(xbar); phase_attn(p, (char*)lds_raw, vcu, G); } SEAM(PH_ATTN);
    if (IN(PH_YM)) for (int rep_ = 0; rep_ < REPS(PH_YM); ++rep_) { if (rep_) xcd_barrier(xbar); pg8::StaticOrder S; S.init(NT, DM, DM, G, bx, p.HM(), p.WmT()); EpiMix<0> E{p}; pg8::gemm_phase<EpiMix<0>, pg8::StaticOrder>(lds, DM, DM, S, E); }
    if (IN(PH_YA)) for (int rep_ = 0; rep_ < REPS(PH_YA); ++rep_) { if (rep_) xcd_barrier(xbar); pg8::StaticOrder S; S.init(NT, DM, DM, G, bx, p.OA(), p.WoT()); EpiMix<1> E{p}; pg8::gemm_phase<EpiMix<1>, pg8::StaticOrder>(lds, DM, DM, S, E); } SEAM(PH_YA);
    if (IN(PH_OUT)) for (int rep_ = 0; rep_ < REPS(PH_OUT); ++rep_) { if (rep_) xcd_barrier(xbar); pg8::StaticOrder S; S.init(NT, DM, DM, G, bx, p.MIX(), p.WoutT()); EpiOut E{p}; pg8::gemm_phase<EpiOut, pg8::StaticOrder>(lds, DM, DM, S, E); } SEAM(PH_OUT);
    if (IN(PH_ROUTE)) for (int rep_ = 0; rep_ < REPS(PH_ROUTE); ++rep_) { if (rep_) xcd_barrier(xbar); phase_route(p, (char*)lds_raw, vcu, G); } SEAM(PH_ROUTE);
    if (IN(PH_SCATTER)) for (int rep_ = 0; rep_ < REPS(PH_SCATTER); ++rep_) { if (rep_) xcd_barrier(xbar); phase_scatter(p, (char*)lds_raw, vcu, G); } SEAM(PH_SCATTER);
    if (IN(PH_M1)) for (int rep_ = 0; rep_ < REPS(PH_M1); ++rep_) { if (rep_) xcd_barrier(xbar); volatile LAS int* tst = (volatile LAS int*)(lds + MISC_OFF); moe_tile_table(p, tst);
        pg8::MoeOrder S; S.tstart = tst; S.npn = 8; S.G = G; S.c = bx; S.A = (const char*)p.XN2(); S.W = (const char*)p.W1T(); S.wexp = (size_t)2048 * DM; S.btile = (size_t)256 * DM;     S.rowidx = p.SLOT_TOK(); S.bias = p.b1; S.bsplit = 1;
        EpiM1 E{p}; pg8::gemm_phase<EpiM1, pg8::MoeOrder, true>(lds, DM / 2, DM / 2, S, E); } SEAM(PH_M1);
    if (IN(PH_M2)) for (int rep_ = 0; rep_ < REPS(PH_M2); ++rep_) { if (rep_) xcd_barrier(xbar); volatile LAS int* tst = (volatile LAS int*)(lds + MISC_OFF); moe_tile_table(p, tst);
        pg8::MoeOrder S; S.tstart = tst; S.npn = 4; S.G = G; S.c = bx; S.A = (const char*)p.ACT(); S.W = (const char*)p.W2T(); S.wexp = (size_t)DM * DFF; S.btile = (size_t)256 * DFF; S.rowidx = nullptr; S.bias = p.b2; S.bsplit = 0;
        EpiM2 E{p}; pg8::gemm_phase<EpiM2, pg8::MoeOrder, true>(lds, DFF / 2, DFF / 2, S, E); } SEAM(PH_M2);
    if (IN(PH_COMBINE)) for (int rep_ = 0; rep_ < REPS(PH_COMBINE); ++rep_) { if (rep_) xcd_barrier(xbar); phase_combine(p, vcu, G, a.sub ? (float*)p.ACT() : p.out); }
#undef IN
#undef SEAM
}

#ifndef ONE_LAUNCH
#define ONE_LAUNCH 1
#endif
#ifndef PROBE_DUP
#define PROBE_DUP -1
#endif
#ifndef PROBE_SUB
#define PROBE_SUB 0
#endif
#ifndef PROBE_DUP_N
#define PROBE_DUP_N 1
#endif
#ifndef FAST_INPROJ
#define FAST_INPROJ 1
#endif
#ifndef FAST_QPROJ
#define FAST_QPROJ 1
#endif
#ifndef FAST_MIX
#define FAST_MIX 1
#endif
#ifndef FAST_MOE
#define FAST_MOE 1
#endif
#ifndef FAST_ATTN
#define FAST_ATTN 1
#endif
#ifndef FAST_MLSTM
#define FAST_MLSTM 1
#endif
static void launch_mk(const Params& p, int lo, int hi, int grid, hipStream_t stream, int sub = 0) {
    MkArgs a{}; a.p = p; a.ph_lo = lo; a.ph_hi = hi; a.sub = sub;
    hipLaunchKernelGGL(mk_fwd, dim3(grid), dim3(MK_THREADS), MK_LDS, stream, a);
}
extern "C" void kernel_launch(void* const* d_in, const int* in_sizes, int n_in, void* d_out, int out_size, void* d_ws, size_t ws_size, hipStream_t stream) {
    static int ok = 0, grid = 0;
    if (!ok) {
        if (n_in != 22 || in_sizes[0] != NT * DM || out_size != NT * DM) { fprintf(stderr, "kernel_launch: unexpected shapes (n_in %d, x %d, out %d)\n", n_in, n_in > 0 ? in_sizes[0] : -1, out_size); return; }
        (void)hipFuncSetAttribute((const void*)k_mlstm_out, hipFuncAttributeMaxDynamicSharedMemorySize, MO_LDS);
        (void)hipFuncSetAttribute((const void*)mk_fwd, hipFuncAttributeMaxDynamicSharedMemorySize, MK_LDS);
        int dev = 0, cus = 0, per_cu = 0; (void)hipGetDevice(&dev); (void)hipDeviceGetAttribute(&cus, hipDeviceAttributeMultiprocessorCount, dev);
        (void)hipOccupancyMaxActiveBlocksPerMultiprocessor(&per_cu, (const void*)mk_fwd, MK_THREADS, MK_LDS);
        if (per_cu < 1) { fprintf(stderr, "kernel_launch: occupancy query says %d blocks/CU\n", per_cu); per_cu = 1; }
        if (cus != 256) { fprintf(stderr, "kernel_launch: built for a 256-CU device (got %d CUs)\n", cus); return; }
        grid = 256;
        ok = 1;
    }
    Params p{};
    const float** ins = (const float**)&p.x;
    for (int i = 0; i < 22; ++i) ins[i] = (const float*)d_in[i];
    p.out = (float*)d_out;
    p.ws = (char*)d_ws;
    if (WS_TOTAL > ws_size) { fprintf(stderr, "kernel_launch: workspace too small (%zu > %zu)\n", (size_t)WS_TOTAL, ws_size); return; }
    (void)hipMemsetAsync(p.BAR(), 0, 16384, stream);
#if ONE_LAUNCH
    { MkArgs a{}; a.p = p; a.ph_lo = 0; a.ph_hi = PH_END; void* args[] = {&a};
      hipError_t e = hipLaunchCooperativeKernel((const void*)mk_fwd, dim3(grid), dim3(MK_THREADS), args, MK_LDS, stream);
      if (e != hipSuccess) fprintf(stderr, "kernel_launch: cooperative launch failed: %s (grid %d)\n", hipGetErrorString(e), grid); }
#else
    for (int ph = 0; ph < PH_END; ++ph) { if (ph == PH_COMBINE && PROBE_DUP == PH_COMBINE) { launch_mk(p, ph, ph + 1, grid, stream, 1); launch_mk(p, ph, ph + 1, grid, stream, 0); continue; }
        launch_mk(p, ph, ph + 1, grid, stream);
        for (int d = 0; d < ((ph == PROBE_DUP) ? PROBE_DUP_N : 0); ++d) { if (ph == PH_ROUTE) (void)hipMemsetAsync(p.CNT(), 0, 4096, stream); launch_mk(p, ph, ph + 1, grid, stream, PROBE_SUB); } }
#endif
}
```

```cpp
#include <hip/hip_runtime.h>
#include <hip/hip_cooperative_groups.h>
#include <cstdio>
#include <cstdint>

typedef unsigned short bf16_t;
__device__ __forceinline__ float bf2f(bf16_t v) { return __uint_as_float(((unsigned)v) << 16); }
__device__ __forceinline__ bf16_t f2bf(float f) { unsigned u = __float_as_uint(f); return (bf16_t)((u + 0x7fffu + ((u >> 16) & 1u)) >> 16); }

constexpr int NB = 8, SEQ = 4096, NT = NB * SEQ, DM = 1024, NMETA = 16, LTOT = SEQ + NMETA;
constexpr int DIN = 5600;
constexpr int OFF_Q = 0, OFF_K = 512, OFF_V = 1024, OFF_O = 2048, OFF_I = 3072, OFF_F = 3088, OFF_CQ = 3104, OFF_CKV = 3360, OFF_KR = 3488, OFF_G = 3552;
constexpr int KVROWS = 4160;
constexpr int NEXP = 32, DFF = 1024;
constexpr int NSLOT = NT * 4 + NEXP * 256;
constexpr float EPS = 1e-6f;
constexpr int CNT_STRIDE = 16;
constexpr float QSCALE = 0.07216878364870322f * 1.4426950408889634f;

constexpr size_t ws_al(size_t x) { return (x + 255) & ~(size_t)255; }
constexpr size_t WS_BAR = 0;
constexpr size_t WS_CNT = WS_BAR + 16384;
constexpr size_t WS_SLOT_TOK = WS_CNT + ws_al(4096);
constexpr size_t WS_TOPI = WS_SLOT_TOK + ws_al((size_t)NSLOT*4);
constexpr size_t WS_TOPW = WS_TOPI + ws_al((size_t)NT*16);
constexpr size_t WS_RANK = WS_TOPW + ws_al((size_t)NT*16);
constexpr size_t WS_SLOTS = WS_RANK + ws_al((size_t)NT*16);
constexpr size_t WS_UM = WS_SLOTS + ws_al((size_t)NT*16);
constexpr size_t WS_ZM = WS_UM + ws_al((size_t)NMETA*DM*4);
constexpr size_t WS_ROPE = WS_ZM + ws_al((size_t)NMETA*DIN*4);
constexpr size_t WS_RSQ = WS_ROPE + ws_al((size_t)LTOT*64*4);
constexpr size_t WS_GI = WS_RSQ + ws_al((size_t)NT*4);
constexpr size_t WS_GF = WS_GI + ws_al((size_t)NT*64);
constexpr size_t WS_NF = WS_GF + ws_al((size_t)NT*64);
constexpr size_t WS_NB_ = WS_NF + ws_al((size_t)4096*256);
constexpr size_t WS_MF = WS_NB_ + ws_al((size_t)4096*256);
constexpr size_t WS_MB = WS_MF + ws_al((size_t)4096*4);
constexpr size_t WS_Kc = WS_MB + ws_al((size_t)4096*4);
constexpr size_t WS_WinT = WS_Kc + ws_al((size_t)NB*KVROWS*192*2);
constexpr size_t WS_WinT8 = WS_WinT + ws_al((size_t)5632*DM*2);
constexpr size_t WS_W1T = WS_WinT8 + ws_al((size_t)3072*DM);
constexpr size_t WS_W2T = WS_W1T + ws_al((size_t)NEXP*2048*DM*2);
constexpr size_t WS_WmT = WS_W2T + ws_al((size_t)NEXP*DM*DFF*2);
constexpr size_t WS_WoutT = WS_WmT + ws_al((size_t)DM*DM*2);
constexpr size_t WS_WoT = WS_WoutT + ws_al((size_t)DM*DM*2);
constexpr size_t WS_WqT = WS_WoT + ws_al((size_t)DM*DM*2);
constexpr size_t WS_CKV = WS_WqT + ws_al((size_t)1536*256*2);
constexpr size_t WS_KR = WS_CKV + ws_al((size_t)NT*128*4);
constexpr size_t WS_CQb = WS_KR + ws_al((size_t)NT*64*4);
constexpr size_t WS_GATE = WS_CQb + ws_al((size_t)NT*256*2);
constexpr size_t WS_WQF = WS_GATE + ws_al((size_t)NT*2048*2);
constexpr size_t WS_WOF = WS_WQF + ws_al((size_t)256*1536*4);
constexpr size_t WS_U = WS_WOF + ws_al((size_t)1024*1024*4);
constexpr size_t WS_Qm = WS_U + ws_al((size_t)NT*DM*2);
constexpr size_t WS_Km = WS_Qm + ws_al((size_t)NT*512*2);
constexpr size_t WS_Vm = WS_Km + ws_al((size_t)NT*512*2);
constexpr size_t WS_OG = WS_Vm + ws_al((size_t)NT*1024*2);
constexpr size_t WS_QP = WS_OG + ws_al((size_t)NT*1024*2);
constexpr size_t WS_CB = WS_QP + ws_al((size_t)NT*1536*2);
constexpr size_t WS_HM = WS_CB + ws_al((size_t)4096*8192*2);
constexpr size_t WS_OA = WS_HM + ws_al((size_t)NT*DM*2);
constexpr size_t WS_TOTAL = WS_OA + ws_al((size_t)NT*DM*2);
constexpr size_t WS_ACT = WS_U, WS_YB = WS_ACT + ws_al((size_t)NSLOT * DFF * 2), WS_MOE_END = WS_YB + ws_al((size_t)NSLOT * DM * 2);
constexpr size_t WS_U8 = WS_CB;
constexpr size_t WS_CF = WS_U, WS_MIX = WS_Qm, WS_XN2 = WS_HM, WS_CQ = WS_HM;
static_assert(WS_MOE_END <= WS_TOTAL && WS_XN2 >= WS_YB, "MoE overlay layout");
struct Params {
    const float *x, *meta, *norm_mix, *w_in, *m_b_i, *m_b_f, *m_norm, *w_m_proj, *a_w_uq, *a_w_ukv, *a_norm_q, *a_norm_kv, *w_a_proj, *w_out,
        *norm_ffn, *w_router, *b_router, *w1, *b1, *w2, *b2, *norm_final;
    float* out; char* ws;
    __host__ __device__ __forceinline__ int* CNT() const { return (int*)(ws + WS_CNT); }
    __host__ __device__ __forceinline__ unsigned* BAR() const { return (unsigned*)(ws + WS_BAR); }
    __host__ __device__ __forceinline__ unsigned char* WinT8() const { return (unsigned char*)(ws + WS_WinT8); }
    __host__ __device__ __forceinline__ unsigned char* U8() const { return (unsigned char*)(ws + WS_U8); }
    __host__ __device__ __forceinline__ int* SLOT_TOK() const { return (int*)(ws + WS_SLOT_TOK); }
    __host__ __device__ __forceinline__ int* TOPI() const { return (int*)(ws + WS_TOPI); }
    __host__ __device__ __forceinline__ float* TOPW() const { return (float*)(ws + WS_TOPW); }
    __host__ __device__ __forceinline__ int* RANK() const { return (int*)(ws + WS_RANK); }
    __host__ __device__ __forceinline__ int* SLOTS() const { return (int*)(ws + WS_SLOTS); }
    __host__ __device__ __forceinline__ float* UM() const { return (float*)(ws + WS_UM); }
    __host__ __device__ __forceinline__ float* ZM() const { return (float*)(ws + WS_ZM); }
    __host__ __device__ __forceinline__ float* ROPE() const { return (float*)(ws + WS_ROPE); }
    __host__ __device__ __forceinline__ float* RSQ() const { return (float*)(ws + WS_RSQ); }
    __host__ __device__ __forceinline__ float* GI() const { return (float*)(ws + WS_GI); }
    __host__ __device__ __forceinline__ float* GF() const { return (float*)(ws + WS_GF); }
    __host__ __device__ __forceinline__ float* NF() const { return (float*)(ws + WS_NF); }
    __host__ __device__ __forceinline__ float* NB_() const { return (float*)(ws + WS_NB_); }
    __host__ __device__ __forceinline__ float* MF() const { return (float*)(ws + WS_MF); }
    __host__ __device__ __forceinline__ float* MB() const { return (float*)(ws + WS_MB); }
    __host__ __device__ __forceinline__ bf16_t* Kc() const { return (bf16_t*)(ws + WS_Kc); }
    __host__ __device__ __forceinline__ bf16_t* WinT() const { return (bf16_t*)(ws + WS_WinT); }
    __host__ __device__ __forceinline__ bf16_t* W1T() const { return (bf16_t*)(ws + WS_W1T); }
    __host__ __device__ __forceinline__ bf16_t* W2T() const { return (bf16_t*)(ws + WS_W2T); }
    __host__ __device__ __forceinline__ bf16_t* WmT() const { return (bf16_t*)(ws + WS_WmT); }
    __host__ __device__ __forceinline__ bf16_t* WoutT() const { return (bf16_t*)(ws + WS_WoutT); }
    __host__ __device__ __forceinline__ bf16_t* WoT() const { return (bf16_t*)(ws + WS_WoT); }
    __host__ __device__ __forceinline__ bf16_t* WqT() const { return (bf16_t*)(ws + WS_WqT); }
    __host__ __device__ __forceinline__ float* CKV() const { return (float*)(ws + WS_CKV); }
    __host__ __device__ __forceinline__ float* KR() const { return (float*)(ws + WS_KR); }
    __host__ __device__ __forceinline__ bf16_t* CQb() const { return (bf16_t*)(ws + WS_CQb); }
    __host__ __device__ __forceinline__ bf16_t* GATE() const { return (bf16_t*)(ws + WS_GATE); }
    __host__ __device__ __forceinline__ float* WQF() const { return (float*)(ws + WS_WQF); }
    __host__ __device__ __forceinline__ float* WOF() const { return (float*)(ws + WS_WOF); }
    __host__ __device__ __forceinline__ bf16_t* U() const { return (bf16_t*)(ws + WS_U); }
    __host__ __device__ __forceinline__ bf16_t* Qm() const { return (bf16_t*)(ws + WS_Qm); }
    __host__ __device__ __forceinline__ bf16_t* Km() const { return (bf16_t*)(ws + WS_Km); }
    __host__ __device__ __forceinline__ bf16_t* Vm() const { return (bf16_t*)(ws + WS_Vm); }
    __host__ __device__ __forceinline__ bf16_t* OG() const { return (bf16_t*)(ws + WS_OG); }
    __host__ __device__ __forceinline__ bf16_t* QP() const { return (bf16_t*)(ws + WS_QP); }
    __host__ __device__ __forceinline__ bf16_t* CB() const { return (bf16_t*)(ws + WS_CB); }
    __host__ __device__ __forceinline__ bf16_t* HM() const { return (bf16_t*)(ws + WS_HM); }
    __host__ __device__ __forceinline__ bf16_t* OA() const { return (bf16_t*)(ws + WS_OA); }
    __host__ __device__ __forceinline__ bf16_t* ACT() const { return (bf16_t*)(ws + WS_ACT); }
    __host__ __device__ __forceinline__ bf16_t* YB() const { return (bf16_t*)(ws + WS_YB); }
    __host__ __device__ __forceinline__ bf16_t* CF() const { return (bf16_t*)(ws + WS_CF); }
    __host__ __device__ __forceinline__ bf16_t* MIX() const { return (bf16_t*)(ws + WS_MIX); }
    __host__ __device__ __forceinline__ bf16_t* XN2() const { return (bf16_t*)(ws + WS_XN2); }
    __host__ __device__ __forceinline__ float* CQ() const { return (float*)(ws + WS_CQ); }
};

__device__ __forceinline__ float wave_sum(float v) {
#pragma unroll
    for (int o = 1; o < 64; o <<= 1) v += __shfl_xor(v, o);
    return v;
}
__device__ __forceinline__ float sigmoidf_(float v) { return __builtin_amdgcn_rcpf(1.f + __expf(-v)); }
__device__ __forceinline__ float logsigmoidf_(float v) { return fminf(v, 0.f) - __logf(1.f + __expf(-fabsf(v))); }

__global__ void __launch_bounds__(256) k_prep_rows(Params p) {
    const int lane = threadIdx.x & 63, gw = (blockIdx.x * 256 + threadIdx.x) >> 6, ngw = (gridDim.x * 256) >> 6;
    for (int r = gw; r < NT + NMETA; r += ngw) {
        const float* src = r < NT ? p.x + (size_t)r * DM : p.meta + (size_t)(r - NT) * DM;
        float4 v[4]; float ss = 0.f;
#pragma unroll
        for (int j = 0; j < 4; ++j) { v[j] = *(const float4*)(src + (j * 64 + lane) * 4); ss += v[j].x * v[j].x + v[j].y * v[j].y + v[j].z * v[j].z + v[j].w * v[j].w; }
        const float rstd = rsqrtf(wave_sum(ss) * (1.f / DM) + EPS);
#pragma unroll
        for (int j = 0; j < 4; ++j) {
            const int c = (j * 64 + lane) * 4; const float4 g = *(const float4*)(p.norm_mix + c);
            const float a0 = v[j].x * rstd * g.x, a1 = v[j].y * rstd * g.y, a2 = v[j].z * rstd * g.z, a3 = v[j].w * rstd * g.w;
            if (r < NT) { bf16_t* d = p.U() + (size_t)r * DM + c; d[0] = f2bf(a0); d[1] = f2bf(a1); d[2] = f2bf(a2); d[3] = f2bf(a3); }
            else { float* d = p.UM() + (size_t)(r - NT) * DM + c; d[0] = a0; d[1] = a1; d[2] = a2; d[3] = a3; }
        }
    }
}

__global__ void __launch_bounds__(256) k_fold(Params p) {
    const long gid = (long)blockIdx.x * 256 + threadIdx.x, gn = (long)gridDim.x * 256;
    for (long i = gid; i < 256L * 1536; i += gn) {
        const int r = (int)(i / 1536), hc = (int)(i % 1536), h = hc / 192, c = hc % 192;
        const float* uq = p.a_w_uq + ((size_t)r * 8 + h) * 192; float acc;
        if (c >= 128) acc = uq[c];
        else { const float* kv = p.a_w_ukv + ((size_t)c * 8 + h) * 256; acc = 0.f; for (int d = 0; d < 128; ++d) acc += uq[d] * kv[d]; }
        p.WQF()[i] = acc;
    }
    for (long i = gid; i < 1024L * 1024; i += gn) {
        const int hc = (int)(i >> 10), n = (int)(i & 1023), h = hc >> 7, c = hc & 127;
        const float* kv = p.a_w_ukv + ((size_t)c * 8 + h) * 256 + 128; const float* ap = p.w_a_proj + (size_t)(h * 128) * DM + n;
        float acc = 0.f; for (int d = 0; d < 128; ++d) acc += kv[d] * ap[(size_t)d * DM];
        p.WOF()[i] = acc;
    }
    for (long i = gid; i < (long)LTOT * 32; i += gn) {
        const int pos = (int)(i >> 5), f = (int)(i & 31);
        const float freq = powf(10000.f, -(float)f / 32.f), ang = (float)pos * freq; float s, c; sincosf(ang, &s, &c);
        p.ROPE()[i * 2] = c; p.ROPE()[i * 2 + 1] = s;
    }
}

__global__ void __launch_bounds__(256) k_meta_proj(Params p) {
    const int gid = blockIdx.x * 256 + threadIdx.x;
    if (gid >= NMETA * DIN) return;
    const int j = gid / DIN, n = gid % DIN; const float* u = p.UM() + (size_t)j * DM; float acc = 0.f;
    for (int k = 0; k < DM; ++k) acc += u[k] * p.w_in[(size_t)k * DIN + n];
    p.ZM()[gid] = acc;
}

template <class P> __global__ void __launch_bounds__(256) k_sgemm(P q) {
    __shared__ float As[16][68]; __shared__ float Bs[16][68];
    const int ntn = (q.N + 63) / 64, ntm = q.M / 64, tid = threadIdx.x, tx = tid & 15, ty = tid >> 4;
    for (int tile = blockIdx.x; tile < ntm * ntn; tile += gridDim.x) {
        const int tm = tile / ntn, tn = tile % ntn; int ctx = 0;
        if (!q.setup(tm, ctx)) continue;
        float acc[4][4];
#pragma unroll
        for (int i = 0; i < 4; ++i)
#pragma unroll
            for (int j = 0; j < 4; ++j) acc[i][j] = 0.f;
        const int arow = tm * 64 + (tid >> 2), ak = (tid & 3) * 4, bk = tid >> 4, bcol = tn * 64 + (tid & 15) * 4;
        for (int k0 = 0; k0 < q.K; k0 += 16) {
            const float4 av = q.a4(ctx, arow, k0 + ak);
            const float4 bv = bcol < q.N ? q.b4(ctx, k0 + bk, bcol) : make_float4(0.f, 0.f, 0.f, 0.f);
            __syncthreads();
            As[ak + 0][tid >> 2] = av.x; As[ak + 1][tid >> 2] = av.y; As[ak + 2][tid >> 2] = av.z; As[ak + 3][tid >> 2] = av.w;
            *(float4*)&Bs[bk][(tid & 15) * 4] = bv;
            __syncthreads();
#pragma unroll
            for (int kk = 0; kk < 16; ++kk) {
                const float4 a = *(const float4*)&As[kk][ty * 4]; const float4 b = *(const float4*)&Bs[kk][tx * 4];
                const float aa[4] = {a.x, a.y, a.z, a.w}, bb[4] = {b.x, b.y, b.z, b.w};
#pragma unroll
                for (int i = 0; i < 4; ++i)
#pragma unroll
                    for (int j = 0; j < 4; ++j) acc[i][j] += aa[i] * bb[j];
            }
        }
        const int col = tn * 64 + tx * 4;
        if (col < q.N) {
#pragma unroll
            for (int i = 0; i < 4; ++i) q.epi(ctx, tm * 64 + ty * 4 + i, col, acc[i]);
        }
    }
}
__device__ __forceinline__ float4 ld_bf4(const bf16_t* p) { const uint2 w = *(const uint2*)p; return make_float4(__uint_as_float(w.x << 16), __uint_as_float(w.x & 0xffff0000u), __uint_as_float(w.y << 16), __uint_as_float(w.y & 0xffff0000u)); }

struct ProbIn {
    Params p; int M, N, K, pad;
    __device__ bool setup(int, int&) const { return true; }
    __device__ float4 a4(int, int row, int k) const { return ld_bf4(p.U() + (size_t)row * DM + k); }
    __device__ float4 b4(int, int k, int col) const { return *(const float4*)(p.w_in + (size_t)k * DIN + col); }
    __device__ void epi(int, int row, int col, const float (&v)[4]) const {
#pragma unroll
        for (int j = 0; j < 4; ++j) {
            const int c = col + j; const float z = v[j];
            if (c < OFF_K) p.Qm()[(size_t)row * 512 + c] = f2bf(z * 0.125f);
            else if (c < OFF_V) p.Km()[(size_t)row * 512 + (c - OFF_K)] = f2bf(z);
            else if (c < OFF_O) p.Vm()[(size_t)row * 1024 + (c - OFF_V)] = f2bf(z);
            else if (c < OFF_I) p.OG()[(size_t)row * 1024 + (c - OFF_O)] = f2bf(sigmoidf_(z));
            else if (c < OFF_F) p.GI()[(size_t)row * 16 + (c - OFF_I)] = z + p.m_b_i[c - OFF_I];
            else if (c < OFF_CQ) p.GF()[(size_t)row * 16 + (c - OFF_F)] = logsigmoidf_(z + p.m_b_f[c - OFF_F]);
            else if (c < OFF_CKV) p.CQ()[(size_t)row * 256 + (c - OFF_CQ)] = z;
            else if (c < OFF_KR) p.CKV()[(size_t)row * 128 + (c - OFF_CKV)] = z;
            else if (c < OFF_G) p.KR()[(size_t)row * 64 + (c - OFF_KR)] = z;
            else p.GATE()[(size_t)row * 2048 + (c - OFF_G)] = f2bf(sigmoidf_(z));
        }
    }
};

__global__ void __launch_bounds__(256) k_kprep(Params p) {
    const int lane = threadIdx.x & 63, gw = (blockIdx.x * 256 + threadIdx.x) >> 6, ngw = (gridDim.x * 256) >> 6;
    for (int i = gw; i < NB * KVROWS; i += ngw) {
        const int b = i / KVROWS, key = i % KVROWS; bf16_t* dst = p.Kc() + (size_t)i * 192;
        if (key >= LTOT) { dst[lane] = 0; dst[64 + lane] = 0; dst[128 + lane] = 0; continue; }
        const float *ckv, *kr; int pos;
        if (key < SEQ) { const size_t r = (size_t)b * SEQ + key; ckv = p.CKV() + r * 128; kr = p.KR() + r * 64; pos = NMETA + key; }
        else { const int j = key - SEQ; ckv = p.ZM() + (size_t)j * DIN + OFF_CKV; kr = p.ZM() + (size_t)j * DIN + OFF_KR; pos = j; }
        const float c0 = ckv[lane], c1 = ckv[64 + lane];
        const float rstd = rsqrtf(wave_sum(c0 * c0 + c1 * c1) * (1.f / 128.f) + EPS);
        dst[lane] = f2bf(c0 * rstd * p.a_norm_kv[lane]); dst[64 + lane] = f2bf(c1 * rstd * p.a_norm_kv[64 + lane]);
        if (lane < 32) {
            const float x1 = kr[lane], x2 = kr[32 + lane], cs = p.ROPE()[((size_t)pos * 32 + lane) * 2], sn = p.ROPE()[((size_t)pos * 32 + lane) * 2 + 1];
            dst[128 + lane] = f2bf(x1 * cs - x2 * sn); dst[160 + lane] = f2bf(x1 * sn + x2 * cs);
        }
    }
    for (int r = gw; r < NT; r += ngw) {
        float* cq = p.CQ() + (size_t)r * 256; float v[4]; float ss = 0.f;
#pragma unroll
        for (int j = 0; j < 4; ++j) { v[j] = cq[j * 64 + lane]; ss += v[j] * v[j]; }
        const float rstd = rsqrtf(wave_sum(ss) * (1.f / 256.f) + EPS);
#pragma unroll
        for (int j = 0; j < 4; ++j) cq[j * 64 + lane] = v[j] * rstd * p.a_norm_q[j * 64 + lane];
    }
}

struct ProbQ {
    Params p; int M, N, K, pad;
    __device__ bool setup(int, int&) const { return true; }
    __device__ float4 a4(int, int row, int k) const { return *(const float4*)(p.CQ() + (size_t)row * 256 + k); }
    __device__ float4 b4(int, int k, int col) const { return *(const float4*)(p.WQF() + (size_t)k * 1536 + col); }
    __device__ void epi(int, int row, int col, const float (&v)[4]) const {
        const int h = col / 192, c = col % 192;
        if (c < 128) {
#pragma unroll
            for (int j = 0; j < 4; ++j) p.QP()[(size_t)row * 1536 + col + j] = f2bf(v[j] * QSCALE);
        } else {
#pragma unroll
            for (int j = 0; j < 4; ++j) p.QP()[(size_t)row * 1536 + col + j] = f2bf(v[j] * QSCALE);
        }
        (void)h;
    }
};
__global__ void __launch_bounds__(256) k_rope_q(Params p) {
    const long gid = (long)blockIdx.x * 256 + threadIdx.x;
    if (gid >= (long)NT * 8 * 32) return;
    const int i = (int)(gid & 31), h = (int)((gid >> 5) & 7); const long r = gid >> 8; const int pos = NMETA + (int)(r % SEQ);
    bf16_t* q = p.QP() + (size_t)r * 1536 + h * 192 + 128;
    const float x1 = bf2f(q[i]), x2 = bf2f(q[32 + i]), cs = p.ROPE()[((size_t)pos * 32 + i) * 2], sn = p.ROPE()[((size_t)pos * 32 + i) * 2 + 1];
    q[i] = f2bf(x1 * cs - x2 * sn); q[32 + i] = f2bf(x1 * sn + x2 * cs);
}

__global__ void __launch_bounds__(256) k_mlstm_scan(Params p) {
    __shared__ float ks[64][65]; __shared__ float vs[64][128]; __shared__ float wk[64]; __shared__ float li[64], lf[64]; __shared__ float sc[2];
    const int tid = threadIdx.x, b = blockIdx.x >> 4, h = (blockIdx.x >> 1) & 7, dir = blockIdx.x & 1;
    const int d = tid >> 2, vq = tid & 3;
    float C[32]; float n = 0.f, m = 0.f;
#pragma unroll
    for (int i = 0; i < 32; ++i) C[i] = 0.f;
    bf16_t* CS = dir ? p.CB() : p.CF(); float* NS = dir ? p.NB_() : p.NF(); float* MS = dir ? p.MB() : p.MF();
    const int nsteps = dir ? 64 : 65;
    for (int st = 0; st < nsteps; ++st) {
        const int c = dir ? 63 - st : st - 1;
        if (c >= 0) {
            const size_t sidx = ((size_t)(b * 8 + h) * 64 + c);
            bf16_t* cd = CS + sidx * 8192 + d * 128 + vq * 32;
#pragma unroll
            for (int i = 0; i < 32; ++i) cd[i] = f2bf(C[i]);
            if (vq == 0) NS[sidx * 64 + d] = n;
            if (tid == 0) MS[sidx] = m;
            if ((dir == 0 && c == 63) || (dir == 1 && c == 0)) break;
        }
        const int npos = c < 0 ? NMETA : 64;
        __syncthreads();
        for (int e = tid; e < 64 * 64; e += 256) { const int j = e >> 6, dd = e & 63; float v = 0.f;
            if (j < npos) { if (c < 0) v = p.ZM()[(size_t)j * DIN + OFF_K + h * 64 + dd]; else { const int t = dir ? 63 - j : j; v = bf2f(p.Km()[((size_t)b * SEQ + c * 64 + t) * 512 + h * 64 + dd]); } }
            ks[j][dd] = v; }
        for (int e = tid; e < 64 * 128; e += 256) { const int j = e >> 7, dd = e & 127; float v = 0.f;
            if (j < npos) { if (c < 0) v = p.ZM()[(size_t)j * DIN + OFF_V + h * 128 + dd]; else { const int t = dir ? 63 - j : j; v = bf2f(p.Vm()[((size_t)b * SEQ + c * 64 + t) * 1024 + h * 128 + dd]); } }
            vs[j][dd] = v; }
        if (tid < 64) { float a = -1e30f, f = 0.f; const int j = tid;
            if (j < npos) { if (c < 0) { a = p.ZM()[(size_t)j * DIN + OFF_I + h] + p.m_b_i[h]; f = logsigmoidf_(p.ZM()[(size_t)j * DIN + OFF_F + h] + p.m_b_f[h]); }
                            else { const int t = dir ? 63 - j : j; const size_t r = (size_t)b * SEQ + c * 64 + t; a = p.GI()[r * 16 + dir * 8 + h]; f = p.GF()[r * 16 + dir * 8 + h]; } }
            li[j] = a; lf[j] = f; }
        __syncthreads();
        if (tid == 0) {
            float bl = 0.f; for (int j = 0; j < npos; ++j) bl += lf[j];
            float bc = 0.f, gmax = -1e30f;
            for (int j = 0; j < npos; ++j) { bc += lf[j]; const float g = bl - bc + li[j]; wk[j] = g; gmax = fmaxf(gmax, g); }
            const float mnew = fmaxf(bl + m, gmax);
            for (int j = 0; j < 64; ++j) wk[j] = j < npos ? __expf(wk[j] - mnew) : 0.f;
            sc[0] = __expf(bl + m - mnew); sc[1] = mnew;
        }
        __syncthreads();
        const float decay = sc[0]; m = sc[1];
#pragma unroll
        for (int i = 0; i < 32; ++i) C[i] *= decay;
        n *= decay;
        for (int j = 0; j < npos; ++j) { const float kw = wk[j] * ks[j][d]; n += kw;
#pragma unroll
            for (int i = 0; i < 32; ++i) C[i] += kw * vs[j][vq * 32 + i]; }
    }
}

constexpr int MO_LDS = (64 * 65 * 3 + 64 * 128 * 2 + 64 * 8) * 4;
__global__ void __launch_bounds__(256) k_mlstm_out(Params p) {
    extern __shared__ __attribute__((aligned(16))) float sm[];
    float (*qs)[65] = (float (*)[65])sm; float (*ks)[65] = (float (*)[65])(sm + 64 * 65); float (*Ws)[65] = (float (*)[65])(sm + 2 * 64 * 65);
    float (*vs)[128] = (float (*)[128])(sm + 3 * 64 * 65); float (*Cs)[128] = (float (*)[128])(sm + 3 * 64 * 65 + 64 * 128);
    float* sx = sm + 3 * 64 * 65 + 2 * 64 * 128; float *li = sx, *lf = sx + 64, *bt = sx + 128, *mt = sx + 192, *as = sx + 256, *ns = sx + 320, *msc = sx + 384;
    const int tid = threadIdx.x, c = blockIdx.x & 63, h = (blockIdx.x >> 6) & 7, b = blockIdx.x >> 9;
    const int t = tid >> 2, vq = tid & 3; const size_t r0 = (size_t)b * SEQ + c * 64;
    for (int e = tid; e < 64 * 64; e += 256) { const int j = e >> 6, dd = e & 63; qs[j][dd] = bf2f(p.Qm()[(r0 + j) * 512 + h * 64 + dd]); ks[j][dd] = bf2f(p.Km()[(r0 + j) * 512 + h * 64 + dd]); }
    for (int e = tid; e < 64 * 128; e += 256) { const int j = e >> 7, dd = e & 127; vs[j][dd] = bf2f(p.Vm()[(r0 + j) * 1024 + h * 128 + dd]); }
    __syncthreads();
    float S[16];
#pragma unroll
    for (int i = 0; i < 16; ++i) { const int s = vq * 16 + i; float a = 0.f;
#pragma unroll 4
        for (int dd = 0; dd < 64; ++dd) a += qs[t][dd] * ks[s][dd]; S[i] = a; }
    float hacc[32];
#pragma unroll
    for (int i = 0; i < 32; ++i) hacc[i] = 0.f;
#pragma unroll 1
    for (int dir = 0; dir < 2; ++dir) {
        const size_t sidx = ((size_t)(b * 8 + h) * 64 + c);
        const bf16_t* CS = (dir ? p.CB() : p.CF()) + sidx * 8192; const float* NS = (dir ? p.NB_() : p.NF()) + sidx * 64; const float* MS = (dir ? p.MB() : p.MF()) + sidx;
        __syncthreads();
        for (int e = tid; e < 64 * 128; e += 256) Cs[e >> 7][e & 127] = bf2f(CS[e]);
        if (tid < 64) { ns[tid] = NS[tid]; li[tid] = p.GI()[(r0 + tid) * 16 + dir * 8 + h]; lf[tid] = p.GF()[(r0 + tid) * 16 + dir * 8 + h]; }
        if (tid == 0) msc[0] = MS[0];
        __syncthreads();
        if (tid == 0) {
            const float m = msc[0]; float bc = 0.f, pm = -1e30f;
            if (dir == 0) { for (int j = 0; j < 64; ++j) { bc += lf[j]; const float a = li[j] - bc; as[j] = a; pm = fmaxf(pm, a); bt[j] = bc; mt[j] = fmaxf(bc + m, bc + pm); } }
            else { for (int j = 63; j >= 0; --j) { bc += lf[j]; const float a = li[j] - bc; as[j] = a; pm = fmaxf(pm, a); bt[j] = bc; mt[j] = fmaxf(bc + m, bc + pm); } }
        }
        __syncthreads();
        const float m = msc[0], b_t = bt[t], m_t = mt[t];
#pragma unroll
        for (int i = 0; i < 16; ++i) { const int s = vq * 16 + i; const bool valid = dir ? (s >= t) : (s <= t); Ws[t][s] = valid ? __expf(b_t + as[s] - m_t) * S[i] : 0.f; }
        __syncthreads();
        const float s_inter = __expf(b_t + m - m_t);
        float num[32]; float den = 0.f, qn = 0.f;
#pragma unroll
        for (int i = 0; i < 32; ++i) num[i] = 0.f;
#pragma unroll 2
        for (int dd = 0; dd < 64; ++dd) { const float qv = qs[t][dd]; qn += qv * ns[dd];
#pragma unroll
            for (int i = 0; i < 32; ++i) num[i] += qv * Cs[dd][vq * 32 + i]; }
#pragma unroll
        for (int i = 0; i < 32; ++i) num[i] *= s_inter;
        den = s_inter * qn;
#pragma unroll 2
        for (int s = 0; s < 64; ++s) { const float w = Ws[t][s]; den += w;
#pragma unroll
            for (int i = 0; i < 32; ++i) num[i] += w * vs[s][vq * 32 + i]; }
        const float inv = 1.f / fmaxf(fabsf(den), __expf(-m_t));
#pragma unroll
        for (int i = 0; i < 32; ++i) hacc[i] += num[i] * inv;
    }
    float ss = 0.f;
#pragma unroll
    for (int i = 0; i < 32; ++i) ss += hacc[i] * hacc[i];
    ss += __shfl_xor(ss, 1); ss += __shfl_xor(ss, 2);
    const float rstd = rsqrtf(ss * (1.f / 128.f) + EPS);
#pragma unroll
    for (int i = 0; i < 32; ++i) { const int col = h * 128 + vq * 32 + i; const size_t o = (r0 + t) * 1024 + col;
        p.HM()[o] = f2bf(hacc[i] * rstd * p.m_norm[col] * bf2f(p.OG()[o])); }
}

__global__ void __launch_bounds__(256) k_attn(Params p) {
    __shared__ float kt[32][192];
    const int tid = threadIdx.x, qi = tid >> 2, sl = tid & 3, qb = blockIdx.x & 63, h = (blockIdx.x >> 6) & 7, b = blockIdx.x >> 9;
    const size_t r = (size_t)b * SEQ + qb * 64 + qi;
    float q[48], o[32]; float m = -1e30f, l = 0.f;
#pragma unroll
    for (int i = 0; i < 48; ++i) q[i] = bf2f(p.QP()[r * 1536 + h * 192 + i * 4 + sl]);
#pragma unroll
    for (int i = 0; i < 32; ++i) o[i] = 0.f;
    const bf16_t* Kb = p.Kc() + (size_t)b * KVROWS * 192;
#pragma unroll 1
    for (int tile = 0; tile < KVROWS / 32; ++tile) {
        __syncthreads();
        for (int e = tid; e < 32 * 192; e += 256) kt[e / 192][e % 192] = bf2f(Kb[(size_t)tile * 32 * 192 + e]);
        __syncthreads();
#pragma unroll 1
        for (int g = 0; g < 4; ++g) {
            float s[8]; float tmax = -1e30f;
#pragma unroll
            for (int j = 0; j < 8; ++j) { float a = 0.f; const float* kr = &kt[g * 8 + j][sl];
#pragma unroll
                for (int i = 0; i < 48; ++i) a += q[i] * kr[i * 4];
                a += __shfl_xor(a, 1); a += __shfl_xor(a, 2);
                if (tile * 32 + g * 8 + j >= LTOT) a = -1e30f;
                s[j] = a; tmax = fmaxf(tmax, a); }
            const float mn = fmaxf(m, tmax), alpha = exp2f(m - mn); m = mn; l *= alpha;
#pragma unroll
            for (int i = 0; i < 32; ++i) o[i] *= alpha;
#pragma unroll
            for (int j = 0; j < 8; ++j) { const float pj = (tile * 32 + g * 8 + j >= LTOT) ? 0.f : exp2f(s[j] - mn); l += pj; const float* kr = &kt[g * 8 + j][sl];
#pragma unroll
                for (int i = 0; i < 32; ++i) o[i] += pj * kr[i * 4]; }
        }
    }
    const float inv = 1.f / l;
#pragma unroll
    for (int i = 0; i < 32; ++i) p.OA()[r * 1024 + h * 128 + i * 4 + sl] = f2bf(o[i] * inv);
}

struct ProbYm {
    Params p; int M, N, K, pad;
    __device__ bool setup(int, int&) const { return true; }
    __device__ float4 a4(int, int row, int k) const { return ld_bf4(p.HM() + (size_t)row * DM + k); }
    __device__ float4 b4(int, int k, int col) const { return *(const float4*)(p.w_m_proj + (size_t)k * DM + col); }
    __device__ void epi(int, int row, int col, const float (&v)[4]) const {
#pragma unroll
        for (int j = 0; j < 4; ++j) p.MIX()[(size_t)row * DM + col + j] = f2bf(v[j] * bf2f(p.GATE()[(size_t)row * 2048 + col + j]));
    }
};
struct ProbYa {
    Params p; int M, N, K, pad;
    __device__ bool setup(int, int&) const { return true; }
    __device__ float4 a4(int, int row, int k) const { return ld_bf4(p.OA() + (size_t)row * DM + k); }
    __device__ float4 b4(int, int k, int col) const { return *(const float4*)(p.WOF() + (size_t)k * DM + col); }
    __device__ void epi(int, int row, int col, const float (&v)[4]) const {
#pragma unroll
        for (int j = 0; j < 4; ++j) { const size_t o = (size_t)row * DM + col + j; p.MIX()[o] = f2bf(bf2f(p.MIX()[o]) + v[j] * bf2f(p.GATE()[(size_t)row * 2048 + 1024 + col + j])); }
    }
};
struct ProbOut {
    Params p; int M, N, K, pad;
    __device__ bool setup(int, int&) const { return true; }
    __device__ float4 a4(int, int row, int k) const { return ld_bf4(p.MIX() + (size_t)row * DM + k); }
    __device__ float4 b4(int, int k, int col) const { return *(const float4*)(p.w_out + (size_t)k * DM + col); }
    __device__ void epi(int, int row, int col, const float (&v)[4]) const {
        const float4 xv = *(const float4*)(p.x + (size_t)row * DM + col);
        *(float4*)(p.out + (size_t)row * DM + col) = make_float4(xv.x + v[0], xv.y + v[1], xv.z + v[2], xv.w + v[3]);
    }
};

__global__ void __launch_bounds__(256) k_route(Params p) {
    __shared__ float xn[8][1024];
    const int tid = threadIdx.x, lane = tid & 63, w = tid >> 6;
    for (int base = blockIdx.x * 8; base < NT; base += gridDim.x * 8) {
        __syncthreads();
        for (int rr = 0; rr < 2; ++rr) {
            const int row = base + w * 2 + rr; const float* src = p.out + (size_t)row * DM;
            float4 v[4]; float ss = 0.f;
#pragma unroll
            for (int j = 0; j < 4; ++j) { v[j] = *(const float4*)(src + (j * 64 + lane) * 4); ss += v[j].x * v[j].x + v[j].y * v[j].y + v[j].z * v[j].z + v[j].w * v[j].w; }
            const float rstd = rsqrtf(wave_sum(ss) * (1.f / DM) + EPS);
#pragma unroll
            for (int j = 0; j < 4; ++j) { const int c = (j * 64 + lane) * 4; const float4 g = *(const float4*)(p.norm_ffn + c);
                const float a0 = v[j].x * rstd * g.x, a1 = v[j].y * rstd * g.y, a2 = v[j].z * rstd * g.z, a3 = v[j].w * rstd * g.w;
                float* d = &xn[w * 2 + rr][c]; d[0] = a0; d[1] = a1; d[2] = a2; d[3] = a3;
                bf16_t* o = p.XN2() + (size_t)row * DM + c; o[0] = f2bf(a0); o[1] = f2bf(a1); o[2] = f2bf(a2); o[3] = f2bf(a3); }
        }
        __syncthreads();
        const int rloc = w * 2 + (lane >> 5), e = lane & 31, row = base + rloc;
        float acc = p.b_router[e];
        for (int k = 0; k < DM; ++k) acc += xn[rloc][k] * p.w_router[(size_t)k * NEXP + e];
        float val = acc; int ti[4]; float tv[4];
#pragma unroll
        for (int kk = 0; kk < 4; ++kk) {
            float best = val; int bi = e;
#pragma unroll
            for (int o = 1; o < 32; o <<= 1) { const float ov = __shfl_xor(best, o); const int oi = __shfl_xor(bi, o); if (ov > best || (ov == best && oi < bi)) { best = ov; bi = oi; } }
            ti[kk] = bi; tv[kk] = best; if (e == bi) val = -3.0e38f;
        }
        if (e == 0) {
            const float mx = tv[0]; float ex[4], sum = 0.f;
#pragma unroll
            for (int kk = 0; kk < 4; ++kk) { ex[kk] = __expf(tv[kk] - mx); sum += ex[kk]; }
#pragma unroll
            for (int kk = 0; kk < 4; ++kk) { p.TOPI()[row * 4 + kk] = ti[kk]; p.TOPW()[row * 4 + kk] = ex[kk] / sum; p.RANK()[row * 4 + kk] = atomicAdd(&p.CNT()[ti[kk] * CNT_STRIDE], 1); }
        }
    }
}
__device__ __forceinline__ int expert_pstart(const int* cnt, int e) { int s = 0; for (int i = 0; i < e; ++i) s += (cnt[i * CNT_STRIDE] + 255) / 256 * 256; return s; }
__global__ void __launch_bounds__(256) k_scatter(Params p) {
    __shared__ int ps[NEXP];
    if (threadIdx.x < NEXP) ps[threadIdx.x] = expert_pstart(p.CNT(), threadIdx.x);
    __syncthreads();
    const int gid = blockIdx.x * 256 + threadIdx.x; if (gid >= NT * 4) return;
    const int slot = ps[p.TOPI()[gid]] + p.RANK()[gid]; p.SLOTS()[gid] = slot; p.SLOT_TOK()[slot] = gid >> 2;
}

struct ProbM1 {
    Params p; int M, N, K, pad;
    __device__ bool setup(int tm, int& e) const {
        int s = 0; e = -1;
        for (int i = 0; i < NEXP; ++i) { const int pc = (p.CNT()[i * CNT_STRIDE] + 255) / 256 * 256; if (tm * 64 < s + pc) { e = i; break; } s += pc; }
        return e >= 0;
    }
    __device__ float4 a4(int, int row, int k) const { const int tok = p.SLOT_TOK()[row]; return tok < 0 ? make_float4(0.f, 0.f, 0.f, 0.f) : ld_bf4(p.XN2() + (size_t)tok * DM + k); }
    __device__ float4 b4(int e, int k, int col) const { const float* w = p.w1 + ((size_t)e * DM + k) * 2048 + (col >> 1); const float2 g = *(const float2*)w, l = *(const float2*)(w + 1024); return make_float4(g.x, l.x, g.y, l.y); }
    __device__ void epi(int e, int row, int col, const float (&v)[4]) const {
#pragma unroll
        for (int j = 0; j < 2; ++j) { const int c = (col >> 1) + j; const float g0 = v[2 * j] + p.b1[(size_t)e * 2048 + c], l0 = v[2 * j + 1] + p.b1[(size_t)e * 2048 + 1024 + c];
            const float glu = fminf(g0, 7.f), lin = fminf(fmaxf(l0, -7.f), 7.f);
            p.ACT()[(size_t)row * DFF + c] = f2bf(glu * sigmoidf_(1.702f * glu) * (lin + 1.f)); }
    }
};
struct ProbM2 {
    Params p; int M, N, K, pad;
    __device__ bool setup(int tm, int& e) const {
        int s = 0; e = -1;
        for (int i = 0; i < NEXP; ++i) { const int pc = (p.CNT()[i * CNT_STRIDE] + 255) / 256 * 256; if (tm * 64 < s + pc) { e = i; break; } s += pc; }
        return e >= 0;
    }
    __device__ float4 a4(int, int row, int k) const { return ld_bf4(p.ACT() + (size_t)row * DFF + k); }
    __device__ float4 b4(int e, int k, int col) const { return *(const float4*)(p.w2 + ((size_t)e * DFF + k) * DM + col); }
    __device__ void epi(int e, int row, int col, const float (&v)[4]) const {
#pragma unroll
        for (int j = 0; j < 4; ++j) p.YB()[(size_t)row * DM + col + j] = f2bf(v[j] + p.b2[(size_t)e * DM + col + j]);
    }
};

__global__ void __launch_bounds__(256) k_combine(Params p) {
    const int lane = threadIdx.x & 63, gw = (blockIdx.x * 256 + threadIdx.x) >> 6, ngw = (gridDim.x * 256) >> 6;
    for (int r = gw; r < NT; r += ngw) {
        float4 v[4];
#pragma unroll
        for (int j = 0; j < 4; ++j) v[j] = *(const float4*)(p.out + (size_t)r * DM + (j * 64 + lane) * 4);
#pragma unroll
        for (int kk = 0; kk < 4; ++kk) { const float w = p.TOPW()[r * 4 + kk]; const bf16_t* y = p.YB() + (size_t)p.SLOTS()[r * 4 + kk] * DM;
#pragma unroll
            for (int j = 0; j < 4; ++j) { const float4 t = ld_bf4(y + (j * 64 + lane) * 4); v[j].x += w * t.x; v[j].y += w * t.y; v[j].z += w * t.z; v[j].w += w * t.w; } }
        float ss = 0.f;
#pragma unroll
        for (int j = 0; j < 4; ++j) ss += v[j].x * v[j].x + v[j].y * v[j].y + v[j].z * v[j].z + v[j].w * v[j].w;
        const float rstd = rsqrtf(wave_sum(ss) * (1.f / DM) + EPS);
#pragma unroll
        for (int j = 0; j < 4; ++j) { const int c = (j * 64 + lane) * 4; const float4 g = *(const float4*)(p.norm_final + c);
            *(float4*)(p.out + (size_t)r * DM + c) = make_float4(v[j].x * rstd * g.x, v[j].y * rstd * g.y, v[j].z * rstd * g.z, v[j].w * rstd * g.w); }
    }
}

#define LAS __attribute__((address_space(3)))
typedef short bf16x8 __attribute__((ext_vector_type(8)));
typedef float f32x4 __attribute__((ext_vector_type(4)));
typedef float f32x2 __attribute__((ext_vector_type(2)));
typedef unsigned u32x4 __attribute__((ext_vector_type(4)));
typedef unsigned u32x2 __attribute__((ext_vector_type(2)));
typedef int v4i __attribute__((ext_vector_type(4)));
typedef int v8i __attribute__((ext_vector_type(8)));

constexpr int MK_THREADS = 512;
constexpr int RING_BYTES = 131072, MISC_OFF = RING_BYTES, MK_LDS = 147456;
constexpr int NIN_PAD = 5632;

namespace pg8 {
constexpr int BM = 256, BK = 64, HALF = 128, HTB = HALF * BK * 2, NXCD = 8, WGM = 8;
__host__ __device__ __forceinline__ int lds_byte(int r, int c) { const int st = (r >> 4) * 2 + (c >> 5), rr = r & 15, cc = c & 31, ob = rr * 64 + cc * 2; return st * 1024 + (ob ^ (((ob >> 9) & 1) << 5)); }
__host__ __device__ __forceinline__ void stage_rc(int b, int& R, int& C) { const int st = b / 1024, sb = b % 1024, swz = sb ^ (((sb >> 9) & 1) << 5); R = (st >> 1) * 16 + swz / 64; C = (st & 1) * 32 + (swz % 64) / 2; }
__host__ __device__ __forceinline__ int perm32(int rho) { const int n = rho >> 4, i = rho & 15; return 8 * (i >> 2) + 4 * n + (i & 3); }
__device__ __forceinline__ unsigned cvt_pk_bf16(float lo, float hi) { unsigned r; asm volatile("v_cvt_pk_bf16_f32 %0, %1, %2" : "=v"(r) : "v"(lo), "v"(hi)); return r; }

struct Unit { int pm, pn, e; const char* A; const char* B; };

struct StaticOrder {
    int nM, nN, nwg, G, c; const char* A; const char* Bt; size_t btile;
    __device__ void init(int M, int N, int K, int G_, int c_, const void* A_, const void* Bt_) { nM = M / BM; nN = N / BM; nwg = nM * nN; G = G_; c = c_; A = (const char*)A_; Bt = (const char*)Bt_; btile = (size_t)BM * K * 2; }
    __device__ bool next(int i, Unit& u) const {
        const long L = (long)i * G + c; if (L >= nwg) return false;
        int wgid = (int)L; { const int q = nwg / NXCD, r = nwg % NXCD, xcd = wgid % NXCD, off = wgid / NXCD; wgid = (xcd < r ? xcd * (q + 1) : r * (q + 1) + (xcd - r) * q) + off; }
        const int nig = WGM * nN, gid = wgid / nig, fm = gid * WGM, gsz = (nM - fm) < WGM ? (nM - fm) : WGM;
        u.pm = fm + ((wgid % nig) % gsz); u.pn = (wgid % nig) / gsz; u.e = 0; u.A = A; u.B = Bt + (size_t)u.pn * btile; return true;
    }
    __device__ __forceinline__ int arow(int r) const { return r; }
    static constexpr bool HAS_BIAS = false;
    __device__ __forceinline__ const float* bias_src(const Unit&, int) const { return nullptr; }
};
struct MoeOrder {
    const volatile LAS int* tstart;
    int npn, G, c; const char* A; const char* W; size_t wexp, btile; const int* rowidx;
    const float* bias; int bsplit;
    __device__ bool next(int i, Unit& u) const {
        const long L = (long)i * G + c; const int ntile = tstart[NEXP]; if (L >= (long)ntile * npn) return false;
        const int mt = (int)(L / npn), pn = (int)(L % npn);
        const int k = (int)(threadIdx.x & 31u); const int tv = tstart[k];
        const int e = __builtin_popcount((unsigned)__ballot(k >= 1 && tv <= mt));
        u.pm = mt; u.pn = pn; u.e = e; u.A = A; u.B = W + (size_t)e * wexp + (size_t)pn * btile; return true;
    }
    __device__ __forceinline__ int arow(int r) const { if (!rowidx) return r; const int t = rowidx[r]; return t < 0 ? 0 : t; }
    static constexpr bool HAS_BIAS = true;
    __device__ __forceinline__ const float* bias_src(const Unit& u, int lane) const {
        return bsplit ? bias + (size_t)u.e * 2048 + (lane >> 5) * 1024 + u.pn * 128 + (lane & 31) * 4 : bias + (size_t)u.e * 1024 + u.pn * 256 + lane * 4; }
};

template <class Epi, class Sched, bool F8 = false>
__device__ __forceinline__ void gemm_phase(LAS unsigned char* lds, const int K, const int lda, const Sched& S, const Epi& E) {
    const int tid = threadIdx.x, wid = __builtin_amdgcn_readfirstlane(tid >> 6), lane = tid & 63, wr = wid >> 2, wc = wid & 3, fr = lane & 15, fq = lane >> 4;
    const int nt = K / BK;
    unsigned voffB[2];
#pragma unroll
    for (int i = 0; i < 2; ++i) { int R, C; stage_rc(tid * 16 + i * 8192, R, C); const int Rb = Epi::PERM ? ((R & ~31) + perm32(R & 31)) : R; voffB[i] = (unsigned)(Rb * K + C) * 2u; }
    const size_t kstep = (size_t)(BK * 2);
    const size_t hstepB = (size_t)HALF * K * 2;
    const unsigned ldsw = (unsigned)wid * 1024u;
    const int aoff = lds_byte(wr * 64 + fr, fq * 8), boff = lds_byte(wc * 32 + fr, fq * 8);
#define PG8_SA(b, h) (((b) * 2 + (h)) * HTB)
#define PG8_SB(b, h) ((4 + (b) * 2 + (h)) * HTB)
#define PG8_STAGE(bufoff, gbase, voff) do { _Pragma("unroll") for (int _i = 0; _i < 2; ++_i) \
        __builtin_amdgcn_global_load_lds((const unsigned*)((const char*)(gbase) + (voff)[_i]), (LAS unsigned*)(lds + (bufoff) + ldsw + _i * 8192), 16, 0, 0); } while (0)
#define PG8_STAGE_B(bufoff, gbase) do { if constexpr (F8) { const u32x2 vo_ = *(const LAS u32x2*)vslot; const unsigned vv_[2] = {vo_[0], vo_[1]}; PG8_STAGE(bufoff, gbase, vv_); } else PG8_STAGE(bufoff, gbase, voffB); } while (0)
#define PG8_STAGE_A(bufoff, gbase, h) do { if constexpr (F8) { const u32x2 vo_ = *(const LAS u32x2*)(vslot + 2 + 2 * (h)); const unsigned vv_[2] = {vo_[0], vo_[1]}; PG8_STAGE(bufoff, gbase, vv_); } else PG8_STAGE(bufoff, gbase, vc[h]); } while (0)
#define PG8_LDA(dst, b, h) do { _Pragma("unroll") for (int m = 0; m < 4; ++m) _Pragma("unroll") for (int k = 0; k < 2; ++k) dst[m][k] = *(const LAS bf16x8*)(lds + PG8_SA(b, h) + aoff + m * 2048 + k * 1024); } while (0)
#define PG8_LDB(dst, b, h) do { _Pragma("unroll") for (int n = 0; n < 2; ++n) _Pragma("unroll") for (int k = 0; k < 2; ++k) dst[n][k] = *(const LAS bf16x8*)(lds + PG8_SB(b, h) + boff + n * 2048 + k * 1024); } while (0)
#define PG8_MMA(ai, bj, At, Bt) do { __builtin_amdgcn_s_setprio(1); _Pragma("unroll") for (int m = 0; m < 4; ++m) _Pragma("unroll") for (int n = 0; n < 2; ++n) _Pragma("unroll") for (int k = 0; k < 2; ++k) \
        acc[ai][bj][m][n] = __builtin_amdgcn_mfma_f32_16x16x32_bf16(Bt[n][k], At[m][k], acc[ai][bj][m][n], 0, 0, 0); __builtin_amdgcn_s_setprio(0); } while (0)
#define PG8_LDA8(dst, b, h) do { _Pragma("unroll") for (int m = 0; m < 4; ++m) dst[m] = __builtin_shufflevector(*(const LAS v4i*)(lds + PG8_SA(b, h) + aoff + m * 2048), *(const LAS v4i*)(lds + PG8_SA(b, h) + aoff + m * 2048 + 1024), 0, 1, 2, 3, 4, 5, 6, 7); } while (0)
#define PG8_LDB8(dst, b, h) do { _Pragma("unroll") for (int n = 0; n < 2; ++n) dst[n] = __builtin_shufflevector(*(const LAS v4i*)(lds + PG8_SB(b, h) + boff + n * 2048), *(const LAS v4i*)(lds + PG8_SB(b, h) + boff + n * 2048 + 1024), 0, 1, 2, 3, 4, 5, 6, 7); } while (0)
#define PG8_MMA8(ai, bj, At, Bt) do { __builtin_amdgcn_s_setprio(1); _Pragma("unroll") for (int m = 0; m < 4; ++m) _Pragma("unroll") for (int n = 0; n < 2; ++n) \
        acc[ai][bj][m][n] = __builtin_amdgcn_mfma_scale_f32_16x16x128_f8f6f4(Bt[n], At[m], acc[ai][bj][m][n], 0, 0, 0, 122, 0, 127); __builtin_amdgcn_s_setprio(0); } while (0)
#define PG8_XLDA(b, h) do { if constexpr (F8) PG8_LDA8(At8, b, h); else PG8_LDA(At, b, h); } while (0)
#define PG8_XLDB0(b, h) do { if constexpr (F8) PG8_LDB8(B08, b, h); else PG8_LDB(B0, b, h); } while (0)
#define PG8_XLDB1(b, h) do { if constexpr (F8) PG8_LDB8(B18, b, h); else PG8_LDB(B1, b, h); } while (0)
#define PG8_XMM0(ai, bj) do { if constexpr (F8) PG8_MMA8(ai, bj, At8, B08); else PG8_MMA(ai, bj, At, B0); } while (0)
#define PG8_XMM1(ai, bj) do { if constexpr (F8) PG8_MMA8(ai, bj, At8, B18); else PG8_MMA(ai, bj, At, B1); } while (0)
#define PG8_WAIT_V(n) asm volatile("s_waitcnt vmcnt(" #n ")" ::: "memory")
#define PG8_WAIT_L(n) asm volatile("s_waitcnt lgkmcnt(" #n ")" ::: "memory")
#define PG8_BAR __builtin_amdgcn_s_barrier()
#define PG8_SCHED __builtin_amdgcn_sched_barrier(0)
#define PG8_VOFF(dst, u) do { int _tt = tid; asm volatile("" : "+v"(_tt)); _Pragma("unroll") for (int _i = 0; _i < 2; ++_i) { int _R, _C; stage_rc(_tt * 16 + _i * 8192, _R, _C); \
        _Pragma("unroll") for (int _h = 0; _h < 2; ++_h) dst[_h][_i] = (unsigned)(S.arow((u).pm * BM + _h * HALF + _R) * lda + _C) * 2u; } } while (0)
    constexpr bool HB = Sched::HAS_BIAS;
    LAS float* bias_l = (LAS float*)(lds + MISC_OFF + 13312);
#define PG8_BIAS(u) do { if constexpr (HB) { if (wid == 0) __builtin_amdgcn_global_load_lds((const unsigned*)S.bias_src(u, lane), (LAS unsigned*)bias_l, 16, 0, 0); } } while (0)
#define PG8_ACC_INIT() do { f32x4 bv_[2][2]; _Pragma("unroll") for (int b = 0; b < 2; ++b) _Pragma("unroll") for (int n = 0; n < 2; ++n) { \
        if constexpr (HB) bv_[b][n] = *(const LAS f32x4*)(bias_l + b * 128 + wc * 32 + 8 * fq + 4 * n); else bv_[b][n] = (f32x4){0.f, 0.f, 0.f, 0.f}; } \
        _Pragma("unroll") for (int a = 0; a < 2; ++a) _Pragma("unroll") for (int b = 0; b < 2; ++b) _Pragma("unroll") for (int m = 0; m < 4; ++m) _Pragma("unroll") for (int n = 0; n < 2; ++n) acc[a][b][m][n] = bv_[b][n]; } while (0)
    Unit cur, nxt; int ui = 0;
    if (!S.next(0, cur)) return;
    f32x4 acc[2][2][4][2];
    bf16x8 At[4][2], B0[2][2], B1[2][2]; v8i At8[4], B08[2], B18[2];
    unsigned vc[2][2], vn[2][2];
    LAS unsigned* vslot = (LAS unsigned*)(lds + MISC_OFF + 1024) + tid * 6;
    PG8_VOFF(vc, cur);
    if constexpr (F8) { vslot[0] = voffB[0]; vslot[1] = voffB[1]; vslot[2] = vc[0][0]; vslot[3] = vc[0][1]; vslot[4] = vc[1][0]; vslot[5] = vc[1][1]; }
    const char* cA = cur.A; const char* cB = cur.B;
    PG8_BIAS(cur);
    PG8_STAGE_B(PG8_SB(0, 0), cB); PG8_STAGE_B(PG8_SB(0, 1), cB + hstepB); PG8_STAGE_A(PG8_SA(0, 0), cA, 0); PG8_STAGE_A(PG8_SA(0, 1), cA, 1);
    if (wr == 1) PG8_BAR;
    PG8_WAIT_V(2); PG8_BAR;
    PG8_STAGE_B(PG8_SB(1, 0), cB + kstep); PG8_STAGE_A(PG8_SA(1, 0), cA + kstep, 0); PG8_STAGE_B(PG8_SB(1, 1), cB + hstepB + kstep);
    PG8_WAIT_V(6); PG8_BAR;
    PG8_ACC_INIT();
    for (;;) {
        const bool has_next = S.next(ui + 1, nxt);
        const char* nA = has_next ? nxt.A : cA; const char* nB = has_next ? nxt.B : cB;
#pragma unroll 1
        for (int t = 0; t < nt; t += 2) {
            const bool last = (t == nt - 2);
            const char* a1 = cA + (size_t)(t + 1) * kstep;
            const char* a2 = last ? nA : cA + (size_t)(t + 2) * kstep; const char* b2 = last ? nB : cB + (size_t)(t + 2) * kstep;
            const char* a3 = a2 + kstep; const char* b3 = b2 + kstep;
            if (last && has_next) { PG8_VOFF(vn, nxt); PG8_BIAS(nxt); }
            PG8_XLDB0(0, 0); PG8_XLDB1(0, 1); PG8_SCHED; PG8_XLDA(0, 0); PG8_STAGE_A(PG8_SA(1, 1), a1, 1);
            PG8_WAIT_V(8); PG8_WAIT_L(0); PG8_BAR; PG8_XMM0(0, 0); PG8_XMM1(0, 1); PG8_BAR; PG8_SCHED;
            if (last && has_next) {
                if constexpr (F8) { vslot[2] = vn[0][0]; vslot[3] = vn[0][1]; vslot[4] = vn[1][0]; vslot[5] = vn[1][1]; }
                else {
#pragma unroll
                for (int h = 0; h < 2; ++h)
#pragma unroll
                    for (int i = 0; i < 2; ++i) vc[h][i] = vn[h][i];
                }
            }
            PG8_XLDA(0, 1); PG8_STAGE_B(PG8_SB(0, 0), b2); PG8_STAGE_B(PG8_SB(0, 1), b2 + hstepB); PG8_STAGE_A(PG8_SA(0, 0), a2, 0);
            PG8_WAIT_V(8); PG8_WAIT_L(0); PG8_BAR; PG8_XMM0(1, 0); PG8_XMM1(1, 1); PG8_BAR; PG8_SCHED;
            PG8_XLDB0(1, 0); PG8_XLDB1(1, 1); PG8_SCHED; PG8_XLDA(1, 0); PG8_STAGE_A(PG8_SA(0, 1), a2, 1);
            PG8_WAIT_V(8); PG8_WAIT_L(0); PG8_BAR; PG8_XMM0(0, 0); PG8_XMM1(0, 1); PG8_BAR; PG8_SCHED;
            PG8_XLDA(1, 1); PG8_STAGE_B(PG8_SB(1, 0), b3); PG8_STAGE_B(PG8_SB(1, 1), b3 + hstepB); PG8_STAGE_A(PG8_SA(1, 0), a3, 0);
            PG8_WAIT_V(8); PG8_WAIT_L(0); PG8_BAR; PG8_XMM0(1, 0); PG8_XMM1(1, 1); PG8_BAR; PG8_SCHED;
        }
        if (wr == 0) PG8_BAR;
        E(acc, cur, wr, wc, fr, fq);
        if (!has_next) break;
        PG8_ACC_INIT();
        cur = nxt; cA = nA; cB = nB; ++ui;
        if (wr == 1) PG8_BAR;
    }
    PG8_WAIT_V(0);
    PG8_BAR;
#undef PG8_SA
#undef PG8_SB
#undef PG8_STAGE
#undef PG8_STAGE_A
#undef PG8_STAGE_B
#undef PG8_LDA
#undef PG8_LDB
#undef PG8_MMA
#undef PG8_MMA8
#undef PG8_LDA8
#undef PG8_LDB8
#undef PG8_XLDA
#undef PG8_XLDB0
#undef PG8_XLDB1
#undef PG8_XMM0
#undef PG8_XMM1
#undef PG8_WAIT_V
#undef PG8_WAIT_L
#undef PG8_BAR
#undef PG8_SCHED
#undef PG8_VOFF
#undef PG8_BIAS
#undef PG8_ACC_INIT
}
}

__device__ __forceinline__ unsigned pk4_fp8(float a, float b, float c, float d) { int p = 0; p = __builtin_amdgcn_cvt_pk_fp8_f32(a, b, p, false); p = __builtin_amdgcn_cvt_pk_fp8_f32(c, d, p, true); return (unsigned)p; }
constexpr float W8_SCALE = 32.f;
__device__ __forceinline__ void st8_bf16(bf16_t* dst, const f32x4 v0, const f32x4 v1) {
    u32x4 w; w.x = pg8::cvt_pk_bf16(v0[0], v0[1]); w.y = pg8::cvt_pk_bf16(v0[2], v0[3]); w.z = pg8::cvt_pk_bf16(v1[0], v1[1]); w.w = pg8::cvt_pk_bf16(v1[2], v1[3]);
    *(u32x4*)dst = w;
}
__device__ __forceinline__ void ld8_bf16(const bf16_t* src, f32x4& v0, f32x4& v1) {
    const u32x4 w = *(const u32x4*)src;
    v0 = (f32x4){__uint_as_float(w.x << 16), __uint_as_float(w.x & 0xffff0000u), __uint_as_float(w.y << 16), __uint_as_float(w.y & 0xffff0000u)};
    v1 = (f32x4){__uint_as_float(w.z << 16), __uint_as_float(w.z & 0xffff0000u), __uint_as_float(w.w << 16), __uint_as_float(w.w & 0xffff0000u)};
}
__device__ __forceinline__ f32x4 sig4(f32x4 v) {
    f32x4 e = v * -1.4426950408889634f;
#pragma unroll
    for (int j = 0; j < 4; ++j) e[j] = __builtin_amdgcn_exp2f(e[j]);
    e = e + 1.f;
#pragma unroll
    for (int j = 0; j < 4; ++j) e[j] = __builtin_amdgcn_rcpf(e[j]);
    return e;
}

template <int PART> struct EpiIn {
    static constexpr bool PERM = true;
    Params p;
    __device__ __forceinline__ void operator()(const f32x4 (&acc)[2][2][4][2], const pg8::Unit& u, int wr, int wc, int fr, int fq) const {
        const int pn = u.pn; const size_t row0 = (size_t)u.pm * 256 + wr * 64 + fr; const int cl0 = wc * 32 + 8 * fq;
        if (PART == 1 || pn < 21) {
            bf16_t* base; int ld, c0; int mode;
            if (PART != 1 && pn < 2) { base = p.Qm(); ld = 512; c0 = pn * 256; mode = 1; }
            else if (PART != 1 && pn < 4) { base = p.Km(); ld = 512; c0 = (pn - 2) * 256; mode = 0; }
            else if (PART != 1 && pn < 8) { base = p.Vm(); ld = 1024; c0 = (pn - 4) * 256; mode = 0; }
            else if (PART != 0 && pn < 12) { base = p.OG(); ld = 1024; c0 = (pn - 8) * 256; mode = 2; }
            else if (PART != 0 && pn < 20) { base = p.GATE(); ld = 2048; c0 = (pn - 12) * 256; mode = 2; }
            else { base = nullptr; ld = 256; c0 = 0; mode = 3; }
#pragma unroll
            for (int ai = 0; ai < 2; ++ai)
#pragma unroll
                for (int m = 0; m < 4; ++m) { const size_t r = row0 + ai * 128 + m * 16;
#pragma unroll
                    for (int bj = 0; bj < 2; ++bj) { f32x4 v0 = acc[ai][bj][m][0], v1 = acc[ai][bj][m][1]; const int c = c0 + bj * 128 + cl0;
                        if (PART != 1 && mode == 3) { float* d = p.CQ() + r * 256 + c; *(f32x4*)d = v0; *(f32x4*)(d + 4) = v1; }
                        else { if (PART != 1 && mode == 1) { v0 = v0 * 0.125f; v1 = v1 * 0.125f; } else if (PART != 0 && mode == 2) { v0 = sig4(v0); v1 = sig4(v1); }
                               st8_bf16(base + r * ld + c, v0, v1); } } }
        } else if (PART != 1) {
#pragma unroll
            for (int ai = 0; ai < 2; ++ai)
#pragma unroll
                for (int m = 0; m < 4; ++m) { const size_t r = row0 + ai * 128 + m * 16;
                    { float* d = p.CKV() + r * 128 + cl0; *(f32x4*)d = acc[ai][0][m][0]; *(f32x4*)(d + 4) = acc[ai][0][m][1]; }
                    const f32x4 v0 = acc[ai][1][m][0], v1 = acc[ai][1][m][1];
                    if (wc < 2) { float* d = p.KR() + r * 64 + cl0; *(f32x4*)d = v0; *(f32x4*)(d + 4) = v1; }
                    else if (wc == 2) { const int g = 8 * (fq & 1);
                        if (fq < 2) { float* d = p.GI() + r * 16 + g; const f32x4 b0 = *(const f32x4*)(p.m_b_i + g), b1 = *(const f32x4*)(p.m_b_i + g + 4); *(f32x4*)d = v0 + b0; *(f32x4*)(d + 4) = v1 + b1; }
                        else { float* d = p.GF() + r * 16 + g; const f32x4 b0 = *(const f32x4*)(p.m_b_f + g), b1 = *(const f32x4*)(p.m_b_f + g + 4);
                            *(f32x4*)d = (f32x4){logsigmoidf_(v0[0] + b0[0]), logsigmoidf_(v0[1] + b0[1]), logsigmoidf_(v0[2] + b0[2]), logsigmoidf_(v0[3] + b0[3])};
                            *(f32x4*)(d + 4) = (f32x4){logsigmoidf_(v1[0] + b1[0]), logsigmoidf_(v1[1] + b1[1]), logsigmoidf_(v1[2] + b1[2]), logsigmoidf_(v1[3] + b1[3])}; } } }
        }
    }
};
template <int PART> struct EpiInP {
    static constexpr bool PERM = true;
    Params p;
    __device__ __forceinline__ void operator()(const f32x4 (&acc)[2][2][4][2], const pg8::Unit& u, int wr, int wc, int fr, int fq) const {
        pg8::Unit v = u; v.pn = PART == 0 ? (u.pn < 8 ? u.pn : u.pn + 12) : u.pn + 8;
        EpiIn<PART> E{p}; E(acc, v, wr, wc, fr, fq);
    }
};
struct EpiQ {
    static constexpr bool PERM = true;
    Params p;
    __device__ __forceinline__ void operator()(const f32x4 (&acc)[2][2][4][2], const pg8::Unit& u, int wr, int wc, int fr, int fq) const {
        const size_t row0 = (size_t)u.pm * 256 + wr * 64 + fr;
#pragma unroll
        for (int ai = 0; ai < 2; ++ai)
#pragma unroll
            for (int m = 0; m < 4; ++m) { const size_t r = row0 + ai * 128 + m * 16; const float rs = p.RSQ()[r] * QSCALE; const int pos = NMETA + (int)(r & (SEQ - 1));
#pragma unroll
                for (int bj = 0; bj < 2; ++bj) { const int c = u.pn * 256 + bj * 128 + wc * 32 + 8 * fq; const int local = c % 192;
                    f32x4 v0 = acc[ai][bj][m][0] * rs, v1 = acc[ai][bj][m][1] * rs;
                    if (local >= 128) { const int i0 = (local - 128) >> 1; const float* rp = p.ROPE() + ((size_t)pos * 32 + i0) * 2;
                        const f32x4 cs0 = *(const f32x4*)rp, cs1 = *(const f32x4*)(rp + 4);
                        const f32x4 o0 = (f32x4){v0[0] * cs0[0] - v0[1] * cs0[1], v0[0] * cs0[1] + v0[1] * cs0[0], v0[2] * cs0[2] - v0[3] * cs0[3], v0[2] * cs0[3] + v0[3] * cs0[2]};
                        const f32x4 o1 = (f32x4){v1[0] * cs1[0] - v1[1] * cs1[1], v1[0] * cs1[1] + v1[1] * cs1[0], v1[2] * cs1[2] - v1[3] * cs1[3], v1[2] * cs1[3] + v1[3] * cs1[2]};
                        v0 = o0; v1 = o1; }
                    st8_bf16(p.QP() + r * 1536 + c, v0, v1); }
                asm volatile("" ::: "memory"); }
    }
};
template <int PASS> struct EpiMix {
    static constexpr bool PERM = true;
    Params p;
    __device__ __forceinline__ void operator()(const f32x4 (&acc)[2][2][4][2], const pg8::Unit& u, int wr, int wc, int fr, int fq) const {
        const size_t row0 = (size_t)u.pm * 256 + wr * 64 + fr;
#pragma unroll
        for (int ai = 0; ai < 2; ++ai)
#pragma unroll
            for (int m = 0; m < 4; ++m) { const size_t r = row0 + ai * 128 + m * 16;
#pragma unroll
                for (int bj = 0; bj < 2; ++bj) { const int c = u.pn * 256 + bj * 128 + wc * 32 + 8 * fq;
                    f32x4 g0, g1; ld8_bf16(p.GATE() + r * 2048 + PASS * 1024 + c, g0, g1);
                    f32x4 v0 = acc[ai][bj][m][0] * g0, v1 = acc[ai][bj][m][1] * g1;
                    if (PASS == 1) { f32x4 m0, m1; ld8_bf16(p.MIX() + r * 1024 + c, m0, m1); v0 = v0 + m0; v1 = v1 + m1; }
                    st8_bf16(p.MIX() + r * 1024 + c, v0, v1); } }
    }
};
struct EpiOut {
    static constexpr bool PERM = false;
    Params p;
    __device__ __forceinline__ void operator()(const f32x4 (&acc)[2][2][4][2], const pg8::Unit& u, int wr, int wc, int fr, int fq) const {
        const size_t row0 = (size_t)u.pm * 256 + wr * 64 + fr; const int col0 = u.pn * 256 + wc * 32 + 4 * fq;
#pragma unroll
        for (int ai = 0; ai < 2; ++ai)
#pragma unroll
            for (int m = 0; m < 4; ++m) { const size_t off = (row0 + ai * 128 + m * 16) * DM + col0;
#pragma unroll
                for (int bj = 0; bj < 2; ++bj)
#pragma unroll
                    for (int n = 0; n < 2; ++n) { const f32x4 xv = *(const f32x4*)(p.x + off + bj * 128 + n * 16); *(f32x4*)(p.out + off + bj * 128 + n * 16) = xv + acc[ai][bj][m][n]; } }
    }
};
__device__ __forceinline__ f32x4 swiglu4(f32x4 g, f32x4 l) {
    f32x4 gg, ll, e;
#pragma unroll
    for (int j = 0; j < 4; ++j) { gg[j] = __builtin_amdgcn_fmed3f(g[j], -3.0e38f, 7.f); ll[j] = __builtin_amdgcn_fmed3f(l[j], -7.f, 7.f); }
    e = gg * (-1.702f * 1.4426950408889634f);
#pragma unroll
    for (int j = 0; j < 4; ++j) e[j] = __builtin_amdgcn_exp2f(e[j]);
    e = e + 1.f;
#pragma unroll
    for (int j = 0; j < 4; ++j) e[j] = __builtin_amdgcn_rcpf(e[j]);
    const f32x4 t = gg * e;
    return t * ll + t;
}
struct EpiM1 {
    static constexpr bool PERM = true;
    Params p;
    __device__ __forceinline__ void operator()(const f32x4 (&acc)[2][2][4][2], const pg8::Unit& u, int wr, int wc, int fr, int fq) const {
        const size_t row0 = (size_t)u.pm * 256 + wr * 64 + fr; const int c = u.pn * 128 + wc * 32 + 8 * fq;
#pragma unroll
        for (int ai = 0; ai < 2; ++ai)
#pragma unroll
            for (int m = 0; m < 4; ++m) { const size_t r = row0 + ai * 128 + m * 16;
                const f32x4 a0 = swiglu4(acc[ai][0][m][0], acc[ai][1][m][0]), a1 = swiglu4(acc[ai][0][m][1], acc[ai][1][m][1]);
                u32x2 o8; o8.x = pk4_fp8(a0[0], a0[1], a0[2], a0[3]); o8.y = pk4_fp8(a1[0], a1[1], a1[2], a1[3]); *(u32x2*)((unsigned char*)p.ACT() + r * DFF + c) = o8; }
    }
};
struct EpiM2 {
    static constexpr bool PERM = true;
    Params p;
    __device__ __forceinline__ void operator()(const f32x4 (&acc)[2][2][4][2], const pg8::Unit& u, int wr, int wc, int fr, int fq) const {
        const size_t row0 = (size_t)u.pm * 256 + wr * 64 + fr;
#pragma unroll
        for (int bj = 0; bj < 2; ++bj) { const int c = u.pn * 256 + bj * 128 + wc * 32 + 8 * fq;
#pragma unroll
            for (int ai = 0; ai < 2; ++ai)
#pragma unroll
                for (int m = 0; m < 4; ++m) { const size_t r = row0 + ai * 128 + m * 16; st8_bf16(p.YB() + r * DM + c, acc[ai][bj][m][0], acc[ai][bj][m][1]); } }
    }
};

__device__ __forceinline__ float4 ntld4(const float* p) { const f32x4 v = __builtin_nontemporal_load((const f32x4*)p); return make_float4(v[0], v[1], v[2], v[3]); }
__device__ __forceinline__ uint2 ntld2u(const bf16_t* p) { const u32x2 v = __builtin_nontemporal_load((const u32x2*)p); return make_uint2(v[0], v[1]); }
__device__ __forceinline__ unsigned pk2(float lo, float hi) { return (unsigned)f2bf(lo) | ((unsigned)f2bf(hi) << 16); }
struct TrDesc { const float* W; bf16_t* WT; int ldw, K, dr0, sc0, nvalid, k0, f8; };
__device__ __forceinline__ void tr_load(const TrDesc& d, float4 (&v)[16], int lane) {
    const int lr = lane >> 4, lc = (lane & 15) * 4;
#pragma unroll
    for (int i = 0; i < 16; ++i) v[i] = (lc < d.nvalid) ? ntld4(d.W + (size_t)(d.k0 + i * 4 + lr) * d.ldw + d.sc0 + lc) : make_float4(0.f, 0.f, 0.f, 0.f);
}
__device__ __forceinline__ void tr_finish(const TrDesc& d, const float4 (&v)[16], LAS float* scr, int lane) {
    const int lr = lane >> 4, lc = (lane & 15) * 4;
#pragma unroll
    for (int i = 0; i < 16; ++i) { LAS float* q = scr + (i * 4 + lr) * 65 + lc; q[0] = v[i].x; q[1] = v[i].y; q[2] = v[i].z; q[3] = v[i].w; }
    asm volatile("s_waitcnt lgkmcnt(0)" ::: "memory");
    const int c = lane & 7;
    if (d.f8) {
#pragma unroll
        for (int j = 0; j < 8; ++j) { const int n = (lane >> 3) + 8 * j; const LAS float* s = scr + (8 * c) * 65 + n;
            u32x2 o; o.x = pk4_fp8(s[0 * 65] * W8_SCALE, s[1 * 65] * W8_SCALE, s[2 * 65] * W8_SCALE, s[3 * 65] * W8_SCALE); o.y = pk4_fp8(s[4 * 65] * W8_SCALE, s[5 * 65] * W8_SCALE, s[6 * 65] * W8_SCALE, s[7 * 65] * W8_SCALE);
            *(u32x2*)((unsigned char*)d.WT + (size_t)(d.dr0 + n) * d.K + d.k0 + 8 * c) = o; }
    } else {
#pragma unroll
    for (int j = 0; j < 8; ++j) { const int n = (lane >> 3) + 8 * j; const LAS float* s = scr + (8 * c) * 65 + n;
        u32x4 o; o.x = pk2(s[0 * 65], s[1 * 65]); o.y = pk2(s[2 * 65], s[3 * 65]); o.z = pk2(s[4 * 65], s[5 * 65]); o.w = pk2(s[6 * 65], s[7 * 65]);
        *(u32x4*)(d.WT + (size_t)(d.dr0 + n) * d.K + d.k0 + 8 * c) = o; }
    }
    asm volatile("s_waitcnt lgkmcnt(0)" ::: "memory");
}
__device__ __forceinline__ int win_src_col(int np, int& nvalid) {
    nvalid = 64;
    if (np < 3072) return np;
    if (np < 5120) return OFF_G + (np - 3072);
    if (np < 5376) return OFF_CQ + (np - 5120);
    if (np < 5504) return OFF_CKV + (np - 5376);
    if (np < 5568) return OFF_KR + (np - 5504);
    nvalid = 32; return OFF_I;
}

__device__ __forceinline__ void phase_prologue(const Params& p, LAS unsigned char* lds, int vcu, int G, int sub) {
#define SUBP(x) (sub == 0 || sub == (x))
    const int tid = threadIdx.x, lane = tid & 63, wave = tid >> 6;
    const int gw = vcu * 8 + wave, NGW = G * 8;
    LAS float* scr = (LAS float*)(lds + wave * 16640);
    if (SUBP(1)) for (int it = vcu; it < 88; it += G) {
        LAS float* um = (LAS float*)lds;
        LAS float* red = (LAS float*)(lds + 65536);
        __syncthreads();
        for (int j = wave * 2; j < wave * 2 + 2; ++j) {
            const float* src = p.meta + (size_t)j * DM; float4 v[4]; float ss = 0.f;
#pragma unroll
            for (int q = 0; q < 4; ++q) { v[q] = *(const float4*)(src + (q * 64 + lane) * 4); ss += v[q].x * v[q].x + v[q].y * v[q].y + v[q].z * v[q].z + v[q].w * v[q].w; }
            const float rstd = rsqrtf(wave_sum(ss) * (1.f / DM) + EPS);
#pragma unroll
            for (int q = 0; q < 4; ++q) { const int c = (q * 64 + lane) * 4; const float4 g = *(const float4*)(p.norm_mix + c);
                um[j * 1024 + c] = v[q].x * rstd * g.x; um[j * 1024 + c + 1] = v[q].y * rstd * g.y; um[j * 1024 + c + 2] = v[q].z * rstd * g.z; um[j * 1024 + c + 3] = v[q].w * rstd * g.w; }
        }
        __syncthreads();
        const int n = it * 64 + lane; const bool okn = n < DIN;
        float a[16];
#pragma unroll
        for (int j = 0; j < 16; ++j) a[j] = 0.f;
#pragma unroll 8
        for (int kk = 0; kk < 128; ++kk) { const int kq = wave * 128 + kk; const float w = okn ? p.w_in[(size_t)kq * DIN + n] : 0.f;
#pragma unroll
            for (int j = 0; j < 16; ++j) a[j] += um[j * 1024 + kq] * w; }
#pragma unroll
        for (int j = 0; j < 16; ++j) red[(wave * 16 + j) * 64 + lane] = a[j];
        __syncthreads();
        for (int o = tid; o < 1024; o += MK_THREADS) { const int j = o >> 6, nl = o & 63; float s = 0.f;
#pragma unroll
            for (int w8 = 0; w8 < 8; ++w8) s += red[(w8 * 16 + j) * 64 + nl];
            if (it * 64 + nl < DIN) p.ZM()[(size_t)j * DIN + it * 64 + nl] = s; }
        __syncthreads();
    }
    constexpr int I_INA = 16 * 40, I_INB = 16 * 48, I_IN = I_INA + I_INB, I_W1 = NEXP * 16 * 32, I_W2 = NEXP * 16 * 16, I_SQ = 16 * 16;
    constexpr int NITEMS = I_IN + I_W1 + I_W2 + 2 * I_SQ;
    auto decode = [&](int it, TrDesc& d) {
        int r = it;
        if (r < I_INA) { const int kb = r / 40, nb = r % 40, np = nb * 64, nl = np < 2048 ? np : np + 3072; int nv; const int sc = win_src_col(nl, nv); d = TrDesc{p.w_in, p.WinT(), DIN, DM, np, sc, nv, kb * 64, 0}; return; } r -= I_INA;
        if (r < I_INB) { const int kb = r / 48, nb = r % 48, np = nb * 64; int nv; const int sc = win_src_col(2048 + np, nv); d = TrDesc{p.w_in, (bf16_t*)p.WinT8(), DIN, DM, np, sc, nv, kb * 64, 1}; return; } r -= I_INB;
        if (r < I_W1) { const int e = r / 512, q = r % 512, kb = q / 32, nb = q % 32, np = nb * 64, pn = np >> 8, bj = (np >> 7) & 1, j = np & 127;
            d = TrDesc{p.w1 + (size_t)e * DM * 2048, (bf16_t*)((unsigned char*)p.W1T() + (size_t)e * 2048 * DM), 2048, DM, np, 1024 * bj + 128 * pn + j, 64, kb * 64, 1}; return; } r -= I_W1;
        if (r < I_W2) { const int e = r / 256, q = r % 256, kb = q / 16, nb = q % 16; d = TrDesc{p.w2 + (size_t)e * DFF * DM, (bf16_t*)((unsigned char*)p.W2T() + (size_t)e * DM * DFF), DM, DFF, nb * 64, nb * 64, 64, kb * 64, 1}; return; } r -= I_W2;
        if (r < I_SQ) { const int kb = r / 16, nb = r % 16; d = TrDesc{p.w_m_proj, p.WmT(), DM, DM, nb * 64, nb * 64, 64, kb * 64, 0}; return; } r -= I_SQ;
        { const int kb = r / 16, nb = r % 16; d = TrDesc{p.w_out, p.WoutT(), DM, DM, nb * 64, nb * 64, 64, kb * 64, 0}; }
    };
    if (SUBP(2)) {
        float4 va[16], vb[16]; TrDesc da, db; int it = gw;
        if (it < NITEMS) { decode(it, da); tr_load(da, va, lane); }
#pragma unroll 1
        while (it < NITEMS) {
            const int it1 = it + NGW; if (it1 < NITEMS) { decode(it1, db); tr_load(db, vb, lane); }
            tr_finish(da, va, scr, lane);
            if (it1 >= NITEMS) break;
            const int it2 = it1 + NGW; if (it2 < NITEMS) { decode(it2, da); tr_load(da, va, lane); }
            tr_finish(db, vb, scr, lane);
            it = it2;
        }
    }
    if (SUBP(3)) for (int r = gw * 4; r < NT; r += NGW * 4) {
        const float* s0 = p.x + (size_t)r * DM; float4 v[16];
#pragma unroll
        for (int q = 0; q < 4; ++q)
#pragma unroll
            for (int j = 0; j < 4; ++j) v[q * 4 + j] = ntld4(s0 + (size_t)q * DM + (j * 64 + lane) * 4);
        float rs[4];
#pragma unroll
        for (int q = 0; q < 4; ++q) { float s = 0.f;
#pragma unroll
            for (int j = 0; j < 4; ++j) { const float4 t = v[q * 4 + j]; s += t.x * t.x + t.y * t.y + t.z * t.z + t.w * t.w; }
            rs[q] = rsqrtf(wave_sum(s) * (1.f / DM) + EPS); }
#pragma unroll
        for (int j = 0; j < 4; ++j) { const int c = (j * 64 + lane) * 4; const float4 g = *(const float4*)(p.norm_mix + c);
#pragma unroll
            for (int q = 0; q < 4; ++q) { const float4 t = v[q * 4 + j]; const float rr = rs[q];
                const float u0 = t.x * rr * g.x, u1 = t.y * rr * g.y, u2 = t.z * rr * g.z, u3 = t.w * rr * g.w;
                u32x2 o; o.x = pk2(u0, u1); o.y = pk2(u2, u3); *(u32x2*)(p.U() + (size_t)(r + q) * DM + c) = o;
                *(unsigned*)(p.U8() + (size_t)(r + q) * DM + c) = pk4_fp8(u0, u1, u2, u3); } }
    }
    const long gid = (long)vcu * MK_THREADS + tid, gn = (long)G * MK_THREADS;
    if (SUBP(4)) for (long i = gid; i < (long)LTOT * 32; i += gn) {
        const int pos = (int)(i >> 5), f = (int)(i & 31);
        const float freq = powf(10000.f, -(float)f / 32.f), ang = (float)pos * freq; float s, c; sincosf(ang, &s, &c);
        p.ROPE()[i * 2] = c; p.ROPE()[i * 2 + 1] = s;
    }
    const int rot_wo = (vcu + 40) & 255;
    if (SUBP(5)) for (long i = (long)rot_wo * MK_THREADS + tid; i < 8L * 8 * 1024; i += gn) {
        const int n = (int)(i & 1023), hcg = __builtin_amdgcn_readfirstlane((int)(i >> 10)), h = hcg >> 3, c0 = (hcg & 7) * 16;
        const float* ap = p.w_a_proj + (size_t)(h * 128) * DM + n; const float* kv = p.a_w_ukv + ((size_t)c0 * 8 + h) * 256 + 128;
        float acc[16];
#pragma unroll
        for (int q = 0; q < 16; ++q) acc[q] = 0.f;
#pragma unroll 4
        for (int d = 0; d < 128; ++d) { const float b = ap[(size_t)d * DM];
#pragma unroll
            for (int q = 0; q < 16; ++q) acc[q] += kv[(size_t)q * 2048 + d] * b; }
        u32x4 o0, o1; o0.x = pk2(acc[0], acc[1]); o0.y = pk2(acc[2], acc[3]); o0.z = pk2(acc[4], acc[5]); o0.w = pk2(acc[6], acc[7]);
        o1.x = pk2(acc[8], acc[9]); o1.y = pk2(acc[10], acc[11]); o1.z = pk2(acc[12], acc[13]); o1.w = pk2(acc[14], acc[15]);
        bf16_t* dst = p.WoT() + (size_t)n * 1024 + h * 128 + c0; *(u32x4*)dst = o0; *(u32x4*)(dst + 8) = o1;
    }
    if (SUBP(6)) for (int t = ((vcu + 168) & 255) * 8 + wave; t < 8 * 128; t += NGW) {
        const int h = t >> 7, c = t & 127; const float2 kvv = *(const float2*)(p.a_w_ukv + ((size_t)c * 8 + h) * 256 + 2 * lane);
#pragma unroll 1
        for (int r0 = 0; r0 < 256; r0 += 64) { float keep = 0.f;
#pragma unroll 8
            for (int rr = 0; rr < 64; ++rr) { const float2 u = *(const float2*)(p.a_w_uq + ((size_t)(r0 + rr) * 8 + h) * 192 + 2 * lane);
                const float s = wave_sum(u.x * kvv.x + u.y * kvv.y); if (lane == rr) keep = s; }
            p.WqT()[(size_t)(h * 192 + c) * 256 + r0 + lane] = f2bf(keep * p.a_norm_q[r0 + lane]); }
    }
    if (SUBP(6)) for (long i = gid; i < 8L * 64 * 256; i += gn) {
        const int r = (int)(i & 255), hq = (int)(i >> 8), h = hq >> 6, q = hq & 63;
        p.WqT()[(size_t)(h * 192 + 128 + q) * 256 + r] = f2bf(p.a_w_uq[((size_t)r * 8 + h) * 192 + 128 + (q >> 1) + 32 * (q & 1)] * p.a_norm_q[r]);
    }
}

#undef SUBP
__device__ __forceinline__ void phase_kprep(const Params& p, int vcu, int G) {
    const int lane = threadIdx.x & 63, gw = vcu * 8 + (threadIdx.x >> 6), NGW = G * 8;
    const float gk0 = p.a_norm_kv[lane], gk1 = p.a_norm_kv[64 + lane];
    for (int r0 = gw * 4; r0 < NT; r0 += NGW * 4) {
        float c0[4], c1[4], x1[4], x2[4], cs[4], sn[4];
#pragma unroll
        for (int q = 0; q < 4; ++q) { const size_t r = (size_t)r0 + q; const int pos = NMETA + (int)(r & (SEQ - 1));
            c0[q] = p.CKV()[r * 128 + lane]; c1[q] = p.CKV()[r * 128 + 64 + lane];
            const int l32 = lane & 31; x1[q] = p.KR()[r * 64 + l32]; x2[q] = p.KR()[r * 64 + 32 + l32];
            const float2 t = *(const float2*)(p.ROPE() + ((size_t)pos * 32 + l32) * 2); cs[q] = t.x; sn[q] = t.y; }
#pragma unroll
        for (int q = 0; q < 4; ++q) { const size_t r = (size_t)r0 + q; const int b = (int)(r >> 12), key = (int)(r & (SEQ - 1));
            bf16_t* dst = p.Kc() + ((size_t)b * KVROWS + key) * 192;
            const float rstd = rsqrtf(wave_sum(c0[q] * c0[q] + c1[q] * c1[q]) * (1.f / 128.f) + EPS);
            dst[lane] = f2bf(c0[q] * rstd * gk0); dst[64 + lane] = f2bf(c1[q] * rstd * gk1);
            if (lane < 32) *(unsigned*)(dst + 128 + 2 * lane) = pk2(x1[q] * cs[q] - x2[q] * sn[q], x1[q] * sn[q] + x2[q] * cs[q]); }
    }
    for (int i = gw; i < NB * 64; i += NGW) {
        const int b = i >> 6, j = i & 63; bf16_t* dst = p.Kc() + ((size_t)b * KVROWS + SEQ + j) * 192;
        if (j >= NMETA) { dst[lane] = 0; dst[64 + lane] = 0; dst[128 + lane] = 0; continue; }
        const float* ckv = p.ZM() + (size_t)j * DIN + OFF_CKV; const float* kr = p.ZM() + (size_t)j * DIN + OFF_KR;
        const float c0 = ckv[lane], c1 = ckv[64 + lane];
        const float rstd = rsqrtf(wave_sum(c0 * c0 + c1 * c1) * (1.f / 128.f) + EPS);
        dst[lane] = f2bf(c0 * rstd * gk0); dst[64 + lane] = f2bf(c1 * rstd * gk1);
        if (lane < 32) { const float x1 = kr[lane], x2 = kr[32 + lane], cs = p.ROPE()[((size_t)j * 32 + lane) * 2], sn = p.ROPE()[((size_t)j * 32 + lane) * 2 + 1];
            *(unsigned*)(dst + 128 + 2 * lane) = pk2(x1 * cs - x2 * sn, x1 * sn + x2 * cs); }
    }
    for (int r0 = gw * 4; r0 < NT; r0 += NGW * 4) {
        float4 v[4];
#pragma unroll
        for (int q = 0; q < 4; ++q) v[q] = ntld4(p.CQ() + (size_t)(r0 + q) * 256 + lane * 4);
#pragma unroll
        for (int q = 0; q < 4; ++q) { u32x2 o; o.x = pk2(v[q].x, v[q].y); o.y = pk2(v[q].z, v[q].w);
            const float a = __uint_as_float(o.x << 16), b = __uint_as_float(o.x & 0xffff0000u), c = __uint_as_float(o.y << 16), d = __uint_as_float(o.y & 0xffff0000u);
            const float ss = wave_sum(a * a + b * b + c * c + d * d);
            *(u32x2*)(p.CQb() + (size_t)(r0 + q) * 256 + lane * 4) = o;
            if (lane == 0) p.RSQ()[r0 + q] = rsqrtf(ss * (1.f / 256.f) + EPS); }
    }
}

__device__ __forceinline__ void moe_tile_table(const Params& p, volatile LAS int* tst) {
    __syncthreads();
    if (threadIdx.x == 0) { int s = 0; for (int e = 0; e < NEXP; ++e) { tst[e] = s; s += (p.CNT()[e * CNT_STRIDE] + 255) / 256; } tst[NEXP] = s; }
    __syncthreads();
}

namespace att {
using s16x4 = __attribute__((ext_vector_type(4))) short;
using f32x16 = __attribute__((ext_vector_type(16))) float;
constexpr int KN_B = 16384, KR_B = 8192, V_B = 16384;
constexpr int L_KN = 0, L_KR = 2 * KN_B, L_WS = L_KR + 2 * KR_B, L_QR = L_WS + 8 * 256, L_END = L_QR + 8 * 4096;
constexpr float THR = 8.f;
#define KSWZ(row, colB) ((row) * 256 + ((colB) ^ (((((row) & 3) << 2) | (((row) >> 2) & 3)) << 4)))
#define RSWZ(row, colB) ((row) * 128 + ((colB) ^ ((((row) >> 1) & 7) << 4)))
#define SBAR() __builtin_amdgcn_sched_barrier(0)
__device__ __forceinline__ int crow(int r, int hi) { return (r & 3) + 8 * (r >> 2) + 4 * hi; }
__device__ __forceinline__ unsigned cvtpk(float lo, float hi) { unsigned r; asm volatile("v_cvt_pk_bf16_f32 %0, %1, %2" : "=v"(r) : "v"(lo), "v"(hi)); return r; }

__device__ __forceinline__ void partialSM(f32x16& p0, f32x16& p1, float& m_reg, float& alpha) {
    float pmax = p0[0];
#pragma unroll
    for (int r = 1; r < 16; ++r) pmax = fmaxf(pmax, p0[r]);
#pragma unroll
    for (int r = 0; r < 16; ++r) pmax = fmaxf(pmax, p1[r]);
    { auto rr = __builtin_amdgcn_permlane32_swap(__float_as_uint(pmax), __float_as_uint(pmax), false, false);
      pmax = fmaxf(__uint_as_float(rr[0]), __uint_as_float(rr[1])); }
    float mn;
    if (__builtin_expect(__all(pmax - m_reg <= THR), 1)) { mn = m_reg; alpha = 1.f; }
    else { mn = fmaxf(m_reg, pmax); alpha = __builtin_amdgcn_exp2f(m_reg - mn); m_reg = mn; }
#pragma unroll
    for (int r = 0; r < 16; ++r) p0[r] = p0[r] - mn;
#pragma unroll
    for (int r = 0; r < 16; ++r) p1[r] = p1[r] - mn;
#pragma unroll
    for (int r = 0; r < 16; ++r) p0[r] = __builtin_amdgcn_exp2f(p0[r]);
}
__device__ __forceinline__ void finishSM(f32x16& p0, f32x16& p1, float alpha, float& l_reg, bf16x8& pa0, bf16x8& pa1, bf16x8& pa2, bf16x8& pa3) {
#pragma unroll
    for (int r = 0; r < 16; ++r) p1[r] = __builtin_amdgcn_exp2f(p1[r]);
    float ps = 0;
#pragma unroll
    for (int r = 0; r < 16; ++r) ps += p0[r];
#pragma unroll
    for (int r = 0; r < 16; ++r) ps += p1[r];
    { auto rr = __builtin_amdgcn_permlane32_swap(__float_as_uint(ps), __float_as_uint(ps), false, false);
      ps = __uint_as_float(rr[0]) + __uint_as_float(rr[1]); }
    l_reg = l_reg * alpha + ps;
#define PK4(P, BASE, OUT) do { unsigned a0 = cvtpk(P[BASE + 0], P[BASE + 1]), a1 = cvtpk(P[BASE + 2], P[BASE + 3]);   \
    unsigned b0 = cvtpk(P[BASE + 4], P[BASE + 5]), b1 = cvtpk(P[BASE + 6], P[BASE + 7]);                              \
    auto r0 = __builtin_amdgcn_permlane32_swap(a0, b0, false, false); auto r1 = __builtin_amdgcn_permlane32_swap(a1, b1, false, false); \
    u32x4 w = {r0[0], r1[0], r0[1], r1[1]}; OUT = *reinterpret_cast<bf16x8*>(&w); } while (0)
    PK4(p0, 0, pa0); PK4(p0, 8, pa1); PK4(p1, 0, pa2); PK4(p1, 8, pa3);
#undef PK4
}
__device__ __forceinline__ void qkt(f32x16& p0, f32x16& p1, const char* Kn, const char* Kr, const bf16x8* qr, const char* qrl, int r32, int hi) {
    p0 = f32x16{}; p1 = f32x16{};
#pragma unroll
    for (int d0 = 0; d0 < 8; ++d0) { const int cb = (d0 * 16 + hi * 8) * 2;
        const bf16x8 b0 = *reinterpret_cast<const bf16x8*>(Kn + KSWZ(r32, cb));
        const bf16x8 b1 = *reinterpret_cast<const bf16x8*>(Kn + KSWZ(32 + r32, cb));
        p0 = __builtin_amdgcn_mfma_f32_32x32x16_bf16(b0, qr[d0], p0, 0, 0, 0);
        p1 = __builtin_amdgcn_mfma_f32_32x32x16_bf16(b1, qr[d0], p1, 0, 0, 0); }
#pragma unroll
    for (int d0 = 0; d0 < 4; ++d0) { const int cb = (d0 * 16 + hi * 8) * 2;
        const bf16x8 b0 = *reinterpret_cast<const bf16x8*>(Kr + RSWZ(r32, cb));
        const bf16x8 b1 = *reinterpret_cast<const bf16x8*>(Kr + RSWZ(32 + r32, cb));
        const bf16x8 qf = *reinterpret_cast<const bf16x8*>(qrl + d0 * 1024);
        p0 = __builtin_amdgcn_mfma_f32_32x32x16_bf16(b0, qf, p0, 0, 0, 0);
        p1 = __builtin_amdgcn_mfma_f32_32x32x16_bf16(b1, qf, p1, 0, 0, 0); }
}
__device__ __forceinline__ int v_st(int k, int c) { const int kk = (k & ~0xC) | ((k & 4) << 1) | ((k & 8) >> 1); return ((kk >> 3) * 4 + (c >> 5)) * 512 + ((kk & 7) * 32 + (c & 31)) * 2; }
__device__ __forceinline__ int v_rd_base(int lane) { return ((lane & 3) << 3) | (((lane >> 2) & 3) << 6) | (((lane >> 4) & 1) << 5) | (((lane >> 5) & 1) << 8); }
constexpr int v_rd_off(int d0, int ks, int half) { return d0 * 512 + ks * 4096 + half * 2048; }
template <int OFF> __device__ __forceinline__ s16x4 tr_read(int vb) { s16x4 r; asm volatile("ds_read_b64_tr_b16 %0, %1 offset:%2" : "=&v"(r) : "v"(vb), "i"(OFF) : "memory"); return r; }
template <int C> __device__ __forceinline__ void pv_one(f32x16& od, int bt0, int bt1, bf16x8 pa0, bf16x8 pa1, bf16x8 pa2, bf16x8 pa3) {
    const int a0 = bt0 ^ (C << 6), a1 = bt1 ^ (C << 6);
    const s16x4 l0 = tr_read<0>(a0), h0 = tr_read<0>(a1), l1 = tr_read<4096>(a0), h1 = tr_read<4096>(a1);
    const s16x4 l2 = tr_read<8192>(a0), h2 = tr_read<8192>(a1), l3 = tr_read<12288>(a0), h3 = tr_read<12288>(a1);
    asm volatile("s_waitcnt lgkmcnt(0)" ::: "memory"); SBAR();
#define PK(L, H) (bf16x8){L[0], L[1], L[2], L[3], H[0], H[1], H[2], H[3]}
    od = __builtin_amdgcn_mfma_f32_32x32x16_bf16(pa0, PK(l0, h0), od, 0, 0, 0);
    od = __builtin_amdgcn_mfma_f32_32x32x16_bf16(pa1, PK(l1, h1), od, 0, 0, 0);
    od = __builtin_amdgcn_mfma_f32_32x32x16_bf16(pa2, PK(l2, h2), od, 0, 0, 0);
    od = __builtin_amdgcn_mfma_f32_32x32x16_bf16(pa3, PK(l3, h3), od, 0, 0, 0);
#undef PK
}
__device__ __forceinline__ void pv_d0(f32x16* o, int bt0, int bt1, bf16x8 pa0, bf16x8 pa1, bf16x8 pa2, bf16x8 pa3) {
    pv_one<0>(o[0], bt0, bt1, pa0, pa1, pa2, pa3); pv_one<1>(o[1], bt0, bt1, pa0, pa1, pa2, pa3); pv_one<2>(o[2], bt0, bt1, pa0, pa1, pa2, pa3); pv_one<3>(o[3], bt0, bt1, pa0, pa1, pa2, pa3);
}
__device__ __forceinline__ int tr_base(int lane, int t) {
    const int h = lane >> 5, blk = (lane >> 4) & 1, q = (lane & 15) >> 2, p = lane & 3, row = 8 * h + 4 * t + q, ch = 2 * blk + (p >> 1);
    return KSWZ(row, ch * 16) + 8 * (p & 1);
}

__device__ __forceinline__ void attn_unit(const bf16_t* __restrict__ Qb, const bf16_t* __restrict__ Kb, bf16_t* __restrict__ Ob, char* lds) {
    const int tid = threadIdx.x, wid = tid >> 6, lane = tid & 63, r32 = lane & 31, hi = lane >> 5;
    char* Kn_l = lds + L_KN; char* Kr_l = lds + L_KR;
    float* ws = (float*)(lds + L_WS) + wid * 64; float* li_l = ws; float* al_l = ws + 32;
    float m_reg = -1e30f, l_reg = 0; f32x16 o[4] = {}; bf16x8 qr[8];
    const bf16_t* Qw = Qb + (size_t)(wid * 32 + r32) * 1536 + hi * 8;
    char* qrl = lds + L_QR + wid * 4096 + lane * 16;
#pragma unroll
    for (int d0 = 0; d0 < 8; ++d0) qr[d0] = *reinterpret_cast<const bf16x8*>(Qw + d0 * 16);
#pragma unroll
    for (int d0 = 0; d0 < 4; ++d0) *reinterpret_cast<bf16x8*>(qrl + d0 * 1024) = *reinterpret_cast<const bf16x8*>(Qw + (8 + d0) * 16);
    const int sr = tid >> 3, sc8 = tid & 7;
    const int kst0 = KSWZ(sr, sc8 * 16), kst1 = KSWZ(sr, 128 + sc8 * 16), rst = RSWZ(sr, sc8 * 16);
    const int bt0 = (int)(uintptr_t)Kn_l + tr_base(lane, 0), bt1 = (int)(uintptr_t)Kn_l + tr_base(lane, 1);
    bf16x8 s0, s1, s2;
#define SLOAD(mt) do { const bf16_t* kp = Kb + (size_t)((mt) * 64 + sr) * 192 + sc8 * 8; s0 = *reinterpret_cast<const bf16x8*>(kp); s1 = *reinterpret_cast<const bf16x8*>(kp + 64); s2 = *reinterpret_cast<const bf16x8*>(kp + 128); } while (0)
#define SWRITE(b) do { *(bf16x8*)(Kn_l + (b) * KN_B + kst0) = s0; *(bf16x8*)(Kn_l + (b) * KN_B + kst1) = s1; *(bf16x8*)(Kr_l + (b) * KR_B + rst) = s2; } while (0)
#define RESC(a) do { if (__any((a) < 1.f)) { if (hi == 0) al_l[r32] = (a); asm volatile("s_waitcnt lgkmcnt(0)" ::: "memory"); \
        _Pragma("unroll") for (int d = 0; d < 4; ++d) _Pragma("unroll") for (int r = 0; r < 16; ++r) o[d][r] *= al_l[crow(r, hi)]; } } while (0)
    f32x16 pA0, pA1, pB0, pB1; float alA, alB; bf16x8 pa0, pa1, pa2, pa3;
    constexpr int NTL = 65;
    SLOAD(64); asm volatile("s_waitcnt vmcnt(0)" ::: "memory"); SWRITE(0); __syncthreads();
    qkt(pA0, pA1, Kn_l, Kr_l, qr, qrl, r32, hi);
#pragma unroll
    for (int r = 8; r < 16; ++r) pA0[r] = -1e30f;
#pragma unroll
    for (int r = 0; r < 16; ++r) pA1[r] = -1e30f;
    partialSM(pA0, pA1, m_reg, alA);
    SLOAD(0); asm volatile("s_waitcnt vmcnt(0)" ::: "memory"); SWRITE(1); __syncthreads();
#pragma unroll 1
    for (int j = 1; j + 1 < NTL; j += 2) {
        SBAR(); qkt(pB0, pB1, Kn_l + KN_B, Kr_l + KR_B, qr, qrl, r32, hi);
        finishSM(pA0, pA1, alA, l_reg, pa0, pa1, pa2, pa3); SBAR();
        SLOAD(j); SBAR();
        pv_d0(o, bt0, bt1, pa0, pa1, pa2, pa3); partialSM(pB0, pB1, m_reg, alB);
        __syncthreads(); asm volatile("s_waitcnt vmcnt(0)" ::: "memory"); SWRITE(0);
        RESC(alB); __syncthreads();
        SBAR(); qkt(pA0, pA1, Kn_l, Kr_l, qr, qrl, r32, hi);
        finishSM(pB0, pB1, alB, l_reg, pa0, pa1, pa2, pa3); SBAR();
        if (j + 2 < NTL) SLOAD(j + 1); SBAR();
        pv_d0(o, bt0 + KN_B, bt1 + KN_B, pa0, pa1, pa2, pa3); partialSM(pA0, pA1, m_reg, alA);
        __syncthreads(); asm volatile("s_waitcnt vmcnt(0)" ::: "memory"); if (j + 2 < NTL) SWRITE(1);
        RESC(alA); __syncthreads();
    }
    finishSM(pA0, pA1, alA, l_reg, pa0, pa1, pa2, pa3); SBAR();
    pv_d0(o, bt0, bt1, pa0, pa1, pa2, pa3);
    if (hi == 0) li_l[r32] = l_reg; asm volatile("s_waitcnt lgkmcnt(0)" ::: "memory");
    float rli[16];
#pragma unroll
    for (int r = 0; r < 16; ++r) rli[r] = __builtin_amdgcn_rcpf(li_l[crow(r, hi)]);
    bf16_t* Ow = Ob + (size_t)(wid * 32) * 1024;
#pragma unroll
    for (int r = 0; r < 16; ++r) { const int orow = crow(r, hi);
#pragma unroll
        for (int d0 = 0; d0 < 4; ++d0) Ow[(size_t)orow * 1024 + d0 * 32 + r32] = f2bf(o[d0][r] * rli[r]); }
    __syncthreads();
#undef SLOAD
#undef SWRITE
#undef RESC
}
#undef KSWZ
#undef RSWZ
#undef SBAR
}

__device__ __forceinline__ void phase_attn(const Params& p, char* lds, int vcu, int G) {
    for (int u = vcu; u < NB * 8 * 16; u += G) {
        const int b = u >> 7, h = (u >> 4) & 7, qb = u & 15;
        const size_t r0 = (size_t)b * SEQ + qb * 256;
        att::attn_unit(p.QP() + r0 * 1536 + h * 192, p.Kc() + (size_t)b * KVROWS * 192, p.OA() + r0 * 1024 + h * 128, lds);
    }
}

namespace ml {
using att::s16x4; using att::f32x16; using att::crow; using att::cvtpk; using att::v_st; using att::v_rd_base; using att::tr_read; using att::v_rd_off;
#define RSWZ(row, colB) ((row) * 128 + ((colB) ^ ((((row) >> 1) & 7) << 4)))
#define SBAR() __builtin_amdgcn_sched_barrier(0)
__device__ __forceinline__ void pv_blk(f32x16& od, int vb, bf16x8 pa0, bf16x8 pa1, bf16x8 pa2, bf16x8 pa3) {
    const s16x4 l0 = tr_read<v_rd_off(0, 0, 0)>(vb), h0 = tr_read<v_rd_off(0, 0, 1)>(vb), l1 = tr_read<v_rd_off(0, 1, 0)>(vb), h1 = tr_read<v_rd_off(0, 1, 1)>(vb);
    const s16x4 l2 = tr_read<v_rd_off(0, 2, 0)>(vb), h2 = tr_read<v_rd_off(0, 2, 1)>(vb), l3 = tr_read<v_rd_off(0, 3, 0)>(vb), h3 = tr_read<v_rd_off(0, 3, 1)>(vb);
    asm volatile("s_waitcnt lgkmcnt(0)" ::: "memory"); SBAR();
#define PK(L, H) (bf16x8){L[0], L[1], L[2], L[3], H[0], H[1], H[2], H[3]}
    od = __builtin_amdgcn_mfma_f32_32x32x16_bf16(pa0, PK(l0, h0), od, 0, 0, 0);
    od = __builtin_amdgcn_mfma_f32_32x32x16_bf16(pa1, PK(l1, h1), od, 0, 0, 0);
    od = __builtin_amdgcn_mfma_f32_32x32x16_bf16(pa2, PK(l2, h2), od, 0, 0, 0);
    od = __builtin_amdgcn_mfma_f32_32x32x16_bf16(pa3, PK(l3, h3), od, 0, 0, 0);
}
template <int KS0> __device__ __forceinline__ void pv_blk2(f32x16& od, int vb, bf16x8 pa, bf16x8 pb) {
    const s16x4 l0 = tr_read<v_rd_off(0, KS0, 0)>(vb), h0 = tr_read<v_rd_off(0, KS0, 1)>(vb), l1 = tr_read<v_rd_off(0, KS0 + 1, 0)>(vb), h1 = tr_read<v_rd_off(0, KS0 + 1, 1)>(vb);
    asm volatile("s_waitcnt lgkmcnt(0)" ::: "memory"); SBAR();
    od = __builtin_amdgcn_mfma_f32_32x32x16_bf16(pa, PK(l0, h0), od, 0, 0, 0);
    od = __builtin_amdgcn_mfma_f32_32x32x16_bf16(pb, PK(l1, h1), od, 0, 0, 0);
}
__device__ __forceinline__ void tt_blk(f32x16& od, int va, int vb) {
    const s16x4 al0 = tr_read<v_rd_off(0, 0, 0)>(va), ah0 = tr_read<v_rd_off(0, 0, 1)>(va), al1 = tr_read<v_rd_off(0, 1, 0)>(va), ah1 = tr_read<v_rd_off(0, 1, 1)>(va);
    const s16x4 al2 = tr_read<v_rd_off(0, 2, 0)>(va), ah2 = tr_read<v_rd_off(0, 2, 1)>(va), al3 = tr_read<v_rd_off(0, 3, 0)>(va), ah3 = tr_read<v_rd_off(0, 3, 1)>(va);
    const s16x4 l0 = tr_read<v_rd_off(0, 0, 0)>(vb), h0 = tr_read<v_rd_off(0, 0, 1)>(vb), l1 = tr_read<v_rd_off(0, 1, 0)>(vb), h1 = tr_read<v_rd_off(0, 1, 1)>(vb);
    const s16x4 l2 = tr_read<v_rd_off(0, 2, 0)>(vb), h2 = tr_read<v_rd_off(0, 2, 1)>(vb), l3 = tr_read<v_rd_off(0, 3, 0)>(vb), h3 = tr_read<v_rd_off(0, 3, 1)>(vb);
    asm volatile("s_waitcnt lgkmcnt(0)" ::: "memory"); SBAR();
    od = __builtin_amdgcn_mfma_f32_32x32x16_bf16(PK(al0, ah0), PK(l0, h0), od, 0, 0, 0);
    od = __builtin_amdgcn_mfma_f32_32x32x16_bf16(PK(al1, ah1), PK(l1, h1), od, 0, 0, 0);
    od = __builtin_amdgcn_mfma_f32_32x32x16_bf16(PK(al2, ah2), PK(l2, h2), od, 0, 0, 0);
    od = __builtin_amdgcn_mfma_f32_32x32x16_bf16(PK(al3, ah3), PK(l3, h3), od, 0, 0, 0);
#undef PK
}
#define PK4(P, BASE, OUT) do { unsigned a0 = cvtpk(P[BASE + 0], P[BASE + 1]), a1 = cvtpk(P[BASE + 2], P[BASE + 3]);   \
    unsigned b0 = cvtpk(P[BASE + 4], P[BASE + 5]), b1 = cvtpk(P[BASE + 6], P[BASE + 7]);                              \
    auto r0 = __builtin_amdgcn_permlane32_swap(a0, b0, false, false); auto r1 = __builtin_amdgcn_permlane32_swap(a1, b1, false, false); \
    u32x4 w = {r0[0], r1[0], r0[1], r1[1]}; OUT = *reinterpret_cast<bf16x8*>(&w); } while (0)
__device__ __forceinline__ float half_swap_add(float v) { auto rr = __builtin_amdgcn_permlane32_swap(__float_as_uint(v), __float_as_uint(v), false, false); return __uint_as_float(rr[0]) + __uint_as_float(rr[1]); }
__device__ __forceinline__ bf16x8 scale8(bf16x8 v, float s) {
    const u32x4 w = *reinterpret_cast<const u32x4*>(&v); u32x4 o;
    o.x = cvtpk(__uint_as_float(w.x << 16) * s, __uint_as_float(w.x & 0xffff0000u) * s); o.y = cvtpk(__uint_as_float(w.y << 16) * s, __uint_as_float(w.y & 0xffff0000u) * s);
    o.z = cvtpk(__uint_as_float(w.z << 16) * s, __uint_as_float(w.z & 0xffff0000u) * s); o.w = cvtpk(__uint_as_float(w.w << 16) * s, __uint_as_float(w.w & 0xffff0000u) * s);
    return *reinterpret_cast<bf16x8*>(&o);
}
__device__ __forceinline__ bf16x8 f8_to_bf(const float* p, bool ok) {
    if (!ok) return (bf16x8){0, 0, 0, 0, 0, 0, 0, 0};
    const f32x4 a = *(const f32x4*)p, b = *(const f32x4*)(p + 4); u32x4 o = {cvtpk(a[0], a[1]), cvtpk(a[2], a[3]), cvtpk(b[0], b[1]), cvtpk(b[2], b[3])};
    return *reinterpret_cast<bf16x8*>(&o);
}
template <int K> __device__ __forceinline__ float dpp_shr(float v, float ident) {
    return __int_as_float(__builtin_amdgcn_update_dpp(__float_as_int(ident), __float_as_int(v), 0x110 | K, 0xf, 0xf, false));
}
__device__ __forceinline__ float rdlane(float v, int l) { return __int_as_float(__builtin_amdgcn_readlane(__float_as_int(v), l)); }
__device__ __forceinline__ float wave_incl_sum(float v, int lane) {
    v += dpp_shr<1>(v, 0.f); v += dpp_shr<2>(v, 0.f); v += dpp_shr<4>(v, 0.f); v += dpp_shr<8>(v, 0.f);
    const float s0 = rdlane(v, 15), s1 = rdlane(v, 31), s2 = rdlane(v, 47); const int row = lane >> 4;
    return v + (row >= 1 ? s0 : 0.f) + (row >= 2 ? s1 : 0.f) + (row >= 3 ? s2 : 0.f);
}
__device__ __forceinline__ float wave_incl_max(float v, int lane) {
    const float NI = -3.0e38f;
    v = fmaxf(v, dpp_shr<1>(v, NI)); v = fmaxf(v, dpp_shr<2>(v, NI)); v = fmaxf(v, dpp_shr<4>(v, NI)); v = fmaxf(v, dpp_shr<8>(v, NI));
    const float s0 = rdlane(v, 15), s1 = rdlane(v, 31), s2 = rdlane(v, 47); const int row = lane >> 4;
    return fmaxf(fmaxf(v, row >= 1 ? s0 : NI), fmaxf(row >= 2 ? s1 : NI, row >= 3 ? s2 : NI));
}
__device__ __forceinline__ float wave_max(float v) {
    const float NI = -3.0e38f;
    v = fmaxf(v, dpp_shr<1>(v, NI)); v = fmaxf(v, dpp_shr<2>(v, NI)); v = fmaxf(v, dpp_shr<4>(v, NI)); v = fmaxf(v, dpp_shr<8>(v, NI));
    return fmaxf(fmaxf(rdlane(v, 15), rdlane(v, 31)), fmaxf(rdlane(v, 47), rdlane(v, 63)));
}

constexpr int SC_BUF = 32768;
__device__ __forceinline__ void scan_unit(const Params& p, int b, int h, int dir, char* lds) {
    const int tid = threadIdx.x, wid = tid >> 6, lane = tid & 63, r32 = lane & 31, hi = lane >> 5, db = wid & 1, vq = wid >> 1;
    const int sr = tid >> 3, sc8 = tid & 7;
    const int kst = v_st(sr, sc8 * 8), vst0 = v_st(sr, sc8 * 8), vst1 = v_st(sr, 64 + sc8 * 8);
    const int va0 = (int)(uintptr_t)lds + v_rd_base(lane) + db * 512, vb0 = (int)(uintptr_t)lds + 16384 + v_rd_base(lane) + vq * 512;
    bf16_t* CS = dir ? p.CB() : p.CF(); float* NS = dir ? p.NB_() : p.NF(); float* MS = dir ? p.MB() : p.MF();
    const size_t sbase = (size_t)(b * 8 + h) * 64;
    f32x16 acc = {}; float nacc = 0.f, m = 0.f, decay_prev = 1.f;
    const int nsteps = dir ? 64 : 65;
    bf16x8 sk, sv0, sv1; float gli, glf;
#define ML_LOAD(st) do { const int c_ = dir ? 63 - (st) : (st) - 1; \
        if (c_ < 0) { const float* z = p.ZM() + (size_t)(sr & 15) * DIN; const bool okr = sr < NMETA; \
            sk = f8_to_bf(z + OFF_K + h * 64 + sc8 * 8, okr); sv0 = f8_to_bf(z + OFF_V + h * 128 + sc8 * 8, okr); sv1 = f8_to_bf(z + OFF_V + h * 128 + 64 + sc8 * 8, okr); \
            const float* zl = p.ZM() + (size_t)(lane & 15) * DIN; gli = lane < NMETA ? zl[OFF_I + h] + p.m_b_i[h] : -1e30f; glf = lane < NMETA ? logsigmoidf_(zl[OFF_F + h] + p.m_b_f[h]) : 0.f; } \
        else { const size_t r_ = (size_t)b * SEQ + c_ * 64 + sr; sk = *reinterpret_cast<const bf16x8*>(p.Km() + r_ * 512 + h * 64 + sc8 * 8); \
            sv0 = *reinterpret_cast<const bf16x8*>(p.Vm() + r_ * 1024 + h * 128 + sc8 * 8); sv1 = *reinterpret_cast<const bf16x8*>(p.Vm() + r_ * 1024 + h * 128 + 64 + sc8 * 8); \
            const size_t rg = (size_t)b * SEQ + c_ * 64 + (dir ? 63 - lane : lane); gli = p.GI()[rg * 16 + dir * 8 + h]; glf = p.GF()[rg * 16 + dir * 8 + h]; } } while (0)
#define ML_GATES(decay_, mnew_, wk_) do { const float bc_ = wave_incl_sum(glf, lane); const float bl_ = rdlane(bc_, 63); const float g_ = bl_ - bc_ + gli; \
        mnew_ = fmaxf(bl_ + m, wave_max(g_)); decay_ = __expf(bl_ + m - mnew_); wk_ = __expf(g_ - mnew_); } while (0)
    ML_LOAD(0);
    float decay, mnew, wk;
    { asm volatile("s_waitcnt vmcnt(0)" ::: "memory"); ML_GATES(decay, mnew, wk);
      const float w = __shfl(wk, dir ? 63 - sr : sr);
      *(bf16x8*)(lds + kst) = sk; *(bf16x8*)(lds + 16384 + vst0) = scale8(sv0, w); *(bf16x8*)(lds + 16384 + vst1) = scale8(sv1, w); }
    __syncthreads();
#pragma unroll 1
    for (int st = 0; st < nsteps; ++st) {
        const int c = dir ? 63 - st : st - 1, buf = st & 1;
        if (wid == 0 && st > 0) { float s_ = 0.f; const float* np_ = (const float*)(lds + 65536) + ((st - 1) & 1) * 512;
#pragma unroll
            for (int w8 = 0; w8 < 8; ++w8) s_ += np_[w8 * 64 + lane];
            nacc = nacc * decay_prev + s_; }
        if (c >= 0) {
            const size_t sidx = sbase + c; bf16_t* cd = CS + sidx * 8192 + (size_t)(db * 32) * 128 + vq * 32 + r32;
#pragma unroll
            for (int r = 0; r < 16; ++r) cd[(size_t)crow(r, hi) * 128] = f2bf(acc[r]);
            if (wid == 0) NS[sidx * 64 + lane] = nacc;
            if (tid == 0) MS[sidx] = m;
        }
        if (st == nsteps - 1) break;
        if (st + 1 < nsteps - 1) ML_LOAD(st + 1);
#pragma unroll
        for (int r = 0; r < 16; ++r) acc[r] *= decay;
        tt_blk(acc, va0 + buf * SC_BUF, vb0 + buf * SC_BUF);
        {
            float s_ = 0.f;
#pragma unroll
            for (int q = 0; q < 8; ++q) { const int s = wid * 8 + q; const float w = __shfl(wk, dir ? 63 - s : s); s_ += w * bf2f(*(const bf16_t*)(lds + buf * SC_BUF + v_st(s, lane))); }
            ((float*)(lds + 65536))[(st & 1) * 512 + wid * 64 + lane] = s_;
        }
        decay_prev = decay;
        m = mnew;
        if (st + 1 < nsteps - 1) {
            asm volatile("s_waitcnt vmcnt(0)" ::: "memory"); ML_GATES(decay, mnew, wk);
            const float w = __shfl(wk, dir ? 63 - sr : sr); char* lb = lds + (buf ^ 1) * SC_BUF;
            *(bf16x8*)(lb + kst) = sk; *(bf16x8*)(lb + 16384 + vst0) = scale8(sv0, w); *(bf16x8*)(lb + 16384 + vst1) = scale8(sv1, w);
        }
        __syncthreads();
    }
    __syncthreads();
#undef ML_LOAD
#undef ML_GATES
}

constexpr int O_K = 0, O_V = 8192, O_CF = 24576, O_CB = 40960, O_T = 57344, O_ARR = 122880, O_WS = 125440, O_END = 127488;
struct OutPre { bf16x8 kk, v0, v1, f0, f1, b0, b1, q0, q1, q2, q3; float li, lf, mm, nn; };
__device__ __forceinline__ void out_load(const Params& p, int u, OutPre& R) {
    const int tid = threadIdx.x, wid = tid >> 6, lane = tid & 63, r32 = lane & 31, hi = lane >> 5, tb = wid & 1;
    const int b = u >> 9, h = u & 7, c = (u >> 3) & 63; const size_t r0 = (size_t)b * SEQ + c * 64, sidx = (size_t)(b * 8 + h) * 64 + c;
    const int sr = tid >> 3, sc8 = tid & 7;
    R.kk = *reinterpret_cast<const bf16x8*>(p.Km() + (r0 + sr) * 512 + h * 64 + sc8 * 8);
    const bf16_t* vp = p.Vm() + (r0 + sr) * 1024 + h * 128 + sc8 * 8; R.v0 = *reinterpret_cast<const bf16x8*>(vp); R.v1 = *reinterpret_cast<const bf16x8*>(vp + 64);
    const bf16_t* cf = p.CF() + sidx * 8192 + (size_t)sr * 128 + sc8 * 8; R.f0 = *reinterpret_cast<const bf16x8*>(cf); R.f1 = *reinterpret_cast<const bf16x8*>(cf + 64);
    const bf16_t* cb = p.CB() + sidx * 8192 + (size_t)sr * 128 + sc8 * 8; R.b0 = *reinterpret_cast<const bf16x8*>(cb); R.b1 = *reinterpret_cast<const bf16x8*>(cb + 64);
    const bf16_t* qp = p.Qm() + (r0 + tb * 32 + r32) * 512 + h * 64 + hi * 8;
    R.q0 = *reinterpret_cast<const bf16x8*>(qp); R.q1 = *reinterpret_cast<const bf16x8*>(qp + 16); R.q2 = *reinterpret_cast<const bf16x8*>(qp + 32); R.q3 = *reinterpret_cast<const bf16x8*>(qp + 48);
    R.li = 0.f; R.lf = 0.f; R.mm = 0.f; R.nn = 0.f;
    if (wid < 2) { const int dir = wid, t = dir ? 63 - lane : lane; R.li = p.GI()[(r0 + t) * 16 + dir * 8 + h]; R.lf = p.GF()[(r0 + t) * 16 + dir * 8 + h]; R.mm = (dir ? p.MB() : p.MF())[sidx]; }
    else if (wid < 4) { const int dir = wid - 2; R.nn = (dir ? p.NB_() : p.NF())[sidx * 64 + lane]; }
}
__device__ __forceinline__ void phase_mlstm_out_body(const Params& p, char* lds, int vcu, int G) {
    const int tid = threadIdx.x, wid = tid >> 6, lane = tid & 63, r32 = lane & 31, hi = lane >> 5, tb = wid & 1, vq = wid >> 1;
    const int sr = tid >> 3, sc8 = tid & 7;
    float* arr = (float*)(lds + O_ARR);
    float* nbuf = arr + 512;
    float* wsc = (float*)(lds + O_WS) + wid * 64;
    const int NU = NB * 8 * 64;
    OutPre R;
    if (vcu < NU) out_load(p, vcu, R);
#pragma unroll 1
    for (int u = vcu; u < NU; u += G) {
        const int b = u >> 9, h = u & 7, c = (u >> 3) & 63; const size_t r0 = (size_t)b * SEQ + c * 64;
        { *(bf16x8*)(lds + O_K + RSWZ(sr, sc8 * 16)) = R.kk;
          const int s0 = v_st(sr, sc8 * 8), s1 = v_st(sr, 64 + sc8 * 8);
          *(bf16x8*)(lds + O_V + s0) = R.v0; *(bf16x8*)(lds + O_V + s1) = R.v1; *(bf16x8*)(lds + O_CF + s0) = R.f0; *(bf16x8*)(lds + O_CF + s1) = R.f1; *(bf16x8*)(lds + O_CB + s0) = R.b0; *(bf16x8*)(lds + O_CB + s1) = R.b1; }
        if (wid < 2) {
            const int dir = wid, t = dir ? 63 - lane : lane; const float m = R.mm;
            const float bc = wave_incl_sum(R.lf, lane), a = R.li - bc, pm = wave_incl_max(a, lane), mx = fmaxf(m, pm);
            float* ar = arr + dir * 256;
            ar[t] = -mx * 1.4426950408889634f; ar[64 + t] = a * 1.4426950408889634f; ar[128 + t] = __expf(m - mx); ar[192 + t] = __expf(-(bc + mx));
        } else if (wid < 4) nbuf[(wid - 2) * 64 + lane] = R.nn;
        bf16x8 qr[4] = {R.q0, R.q1, R.q2, R.q3};
        __syncthreads();
        if (u + G < NU) out_load(p, u + G, R);
        const int ocol = h * 128 + sc8 * 16; const size_t oo = (r0 + sr) * 1024 + ocol;
        const u32x4 og0 = *(const u32x4*)(p.OG() + oo), og1 = *(const u32x4*)(p.OG() + oo + 8);
        const f32x4 n0 = *(const f32x4*)(p.m_norm + ocol), n1 = *(const f32x4*)(p.m_norm + ocol + 4), n2 = *(const f32x4*)(p.m_norm + ocol + 8), n3 = *(const f32x4*)(p.m_norm + ocol + 12);
        const int dir = (wid >> 1) & 1, vh = wid >> 2;
        float qn;
        { const float* nv = nbuf + dir * 64 + hi * 8; float s_ = 0.f;
#pragma unroll
          for (int d0 = 0; d0 < 4; ++d0) { const u32x4 w = *reinterpret_cast<const u32x4*>(&qr[d0]); const f32x4 n0 = *(const f32x4*)(nv + d0 * 16), n1 = *(const f32x4*)(nv + d0 * 16 + 4);
              s_ += __uint_as_float(w.x << 16) * n0[0] + __uint_as_float(w.x & 0xffff0000u) * n0[1] + __uint_as_float(w.y << 16) * n0[2] + __uint_as_float(w.y & 0xffff0000u) * n0[3]
                  + __uint_as_float(w.z << 16) * n1[0] + __uint_as_float(w.z & 0xffff0000u) * n1[1] + __uint_as_float(w.w << 16) * n1[2] + __uint_as_float(w.w & 0xffff0000u) * n1[3]; }
          qn = half_swap_add(s_); }
        f32x16 p0 = {}, p1 = {};
        const bool has0 = !(dir == 1 && tb == 1), has1 = !(dir == 0 && tb == 0);
#pragma unroll
        for (int d0 = 0; d0 < 4; ++d0) { const int cb = (d0 * 16 + hi * 8) * 2;
            if (has0) { const bf16x8 k0 = *reinterpret_cast<const bf16x8*>(lds + O_K + RSWZ(r32, cb)); p0 = __builtin_amdgcn_mfma_f32_32x32x16_bf16(k0, qr[d0], p0, 0, 0, 0); }
            if (has1) { const bf16x8 k1 = *reinterpret_cast<const bf16x8*>(lds + O_K + RSWZ(32 + r32, cb)); p1 = __builtin_amdgcn_mfma_f32_32x32x16_bf16(k1, qr[d0], p1, 0, 0, 0); } }
        const int t = tb * 32 + r32;
        const int vbase = (int)(uintptr_t)lds + v_rd_base(lane) + vh * 1024;
#define W_FULL(P, W, SB) _Pragma("unroll") for (int g = 0; g < 4; ++g) { const f32x4 ct = *(const f32x4*)(ar + 64 + (SB) + 8 * g + 4 * hi); \
            _Pragma("unroll") for (int q = 0; q < 4; ++q) { const float x = __builtin_amdgcn_exp2f(rt + ct[q]) * P[4 * g + q]; W[4 * g + q] = x; rs += x; } }
#define W_DIAG(P, W, SB) _Pragma("unroll") for (int g = 0; g < 4; ++g) { const f32x4 ct = *(const f32x4*)(ar + 64 + (SB) + 8 * g + 4 * hi); \
            _Pragma("unroll") for (int q = 0; q < 4; ++q) { const int sl = 8 * g + 4 * hi + q; const bool ok = dir ? (sl >= r32) : (sl <= r32); \
                const float x = ok ? __builtin_amdgcn_exp2f(rt + ct[q]) * P[4 * g + q] : 0.f; W[4 * g + q] = x; rs += x; } }
        {
            const float* ar = arr + dir * 256; const float rt = ar[t], sint = ar[128 + t], efl = ar[192 + t];
            f32x16 w0, w1; float rs = 0.f;
            if (tb == 0) { W_DIAG(p0, w0, 0) if (dir == 1) { W_FULL(p1, w1, 32) } }
            else         { W_DIAG(p1, w1, 32) if (dir == 0) { W_FULL(p0, w0, 0) } }
            rs = half_swap_add(rs);
            bf16x8 pa0, pa1, pa2, pa3;
            if (has0) { PK4(w0, 0, pa0); PK4(w0, 8, pa1); }
            if (has1) { PK4(w1, 0, pa2); PK4(w1, 8, pa3); }
            const float den = rs + sint * qn, inv = 1.f / fmaxf(fabsf(den), efl);
            if (hi == 0) { wsc[r32] = sint; wsc[32 + r32] = inv; }
            f32x16 o0 = {}, o1 = {};
            pv_blk(o0, vbase + (dir ? O_CB : O_CF), qr[0], qr[1], qr[2], qr[3]);
            pv_blk(o1, vbase + (dir ? O_CB : O_CF) + 512, qr[0], qr[1], qr[2], qr[3]);
            asm volatile("s_waitcnt lgkmcnt(0)" ::: "memory");
#pragma unroll
            for (int g = 0; g < 4; ++g) { const f32x4 sc = *(const f32x4*)(wsc + 8 * g + 4 * hi);
#pragma unroll
                for (int q = 0; q < 4; ++q) { o0[4 * g + q] *= sc[q]; o1[4 * g + q] *= sc[q]; } }
            if (has0) { pv_blk2<0>(o0, vbase + O_V, pa0, pa1); pv_blk2<0>(o1, vbase + O_V + 512, pa0, pa1); }
            if (has1) { pv_blk2<2>(o0, vbase + O_V, pa2, pa3); pv_blk2<2>(o1, vbase + O_V + 512, pa2, pa3); }
            float* T = (float*)(lds + O_T + dir * 32768) + (size_t)(tb * 32) * 128 + vh * 64 + r32;
#pragma unroll
            for (int g = 0; g < 4; ++g) { const f32x4 sc = *(const f32x4*)(wsc + 32 + 8 * g + 4 * hi);
#pragma unroll
                for (int q = 0; q < 4; ++q) { const int rw = 8 * g + 4 * hi + q; T[rw * 128] = o0[4 * g + q] * sc[q]; T[rw * 128 + 32] = o1[4 * g + q] * sc[q]; } }
        }
#undef W_FULL
#undef W_DIAG
        __syncthreads();
        { const float* T = (const float*)(lds + O_T) + sr * 128 + sc8 * 16; f32x4 v[4]; float ss = 0.f;
#pragma unroll
          for (int q = 0; q < 4; ++q) { v[q] = *(const f32x4*)(T + q * 4) + *(const f32x4*)(T + 8192 + q * 4); ss += v[q][0] * v[q][0] + v[q][1] * v[q][1] + v[q][2] * v[q][2] + v[q][3] * v[q][3]; }
          ss += __shfl_xor(ss, 1); ss += __shfl_xor(ss, 2); ss += __shfl_xor(ss, 4);
          const float rstd = rsqrtf(ss * (1.f / 128.f) + EPS);
          const f32x4 g0 = (f32x4){__uint_as_float(og0.x << 16), __uint_as_float(og0.x & 0xffff0000u), __uint_as_float(og0.y << 16), __uint_as_float(og0.y & 0xffff0000u)};
          const f32x4 g1 = (f32x4){__uint_as_float(og0.z << 16), __uint_as_float(og0.z & 0xffff0000u), __uint_as_float(og0.w << 16), __uint_as_float(og0.w & 0xffff0000u)};
          const f32x4 g2 = (f32x4){__uint_as_float(og1.x << 16), __uint_as_float(og1.x & 0xffff0000u), __uint_as_float(og1.y << 16), __uint_as_float(og1.y & 0xffff0000u)};
          const f32x4 g3 = (f32x4){__uint_as_float(og1.z << 16), __uint_as_float(og1.z & 0xffff0000u), __uint_as_float(og1.w << 16), __uint_as_float(og1.w & 0xffff0000u)};
          st8_bf16(p.HM() + oo, v[0] * rstd * n0 * g0, v[1] * rstd * n1 * g1); st8_bf16(p.HM() + oo + 8, v[2] * rstd * n2 * g2, v[3] * rstd * n3 * g3); }
    }
    __syncthreads();
}
#undef PK4
#undef RSWZ
#undef SBAR
}

__device__ __forceinline__ void phase_mlstm_scan(const Params& p, char* lds, int vcu, int G) {
    for (int u = vcu; u < NB * 8 * 2; u += G) ml::scan_unit(p, u >> 4, (u >> 1) & 7, u & 1, lds);
}
__device__ __forceinline__ void phase_mlstm_out(const Params& p, char* lds, int vcu, int G) {
    ml::phase_mlstm_out_body(p, lds, vcu, G);
}

#define RS_STEP(IN, OUT, N, BIT, MASK) _Pragma("unroll") for (int i_ = 0; i_ < (N); ++i_) { const float keep_ = (BIT) ? IN[(N) + i_] : IN[i_], send_ = (BIT) ? IN[i_] : IN[(N) + i_]; OUT[i_] = keep_ + __shfl_xor(send_, (MASK)); }
__device__ __forceinline__ float route_reduce(const float (&v)[32], int lane) {
    const int b5 = (lane >> 5) & 1, b4 = (lane >> 4) & 1, b3 = (lane >> 3) & 1, b2 = (lane >> 2) & 1, b1 = (lane >> 1) & 1;
    float a16[16], a8[8], a4[4], a2[2], a1[1];
    RS_STEP(v, a16, 16, b5, 32) RS_STEP(a16, a8, 8, b4, 16) RS_STEP(a8, a4, 4, b3, 8) RS_STEP(a4, a2, 2, b2, 4) RS_STEP(a2, a1, 1, b1, 2)
    return a1[0] + __shfl_xor(a1[0], 1);
}
__device__ __forceinline__ int route_rank(float val, int myexp) {
    int cnt = 0;
#pragma unroll
    for (int e = 0; e < 32; ++e) { const float ve = __int_as_float(__builtin_amdgcn_readlane(__float_as_int(val), 2 * e)); cnt += (ve > val || (ve == val && e < myexp)) ? 1 : 0; }
    return cnt;
}
__device__ __forceinline__ void phase_route(const Params& p, char* lds, int vcu, int G) {
    constexpr int XST = 1028;
    float* xs = (float*)lds;
    float* part = (float*)(lds + 65792);
    unsigned short* ent = (unsigned short*)(lds + 84224);
    int* lcount = (int*)(lds + 88320); int* lbase = lcount + 32;
    float* rec = (float*)(lds + 88576);
    const int tid = threadIdx.x, lane = tid & 63, w = tid >> 6, q4 = lane >> 4, l15 = lane & 15;
    __syncthreads();
    if (tid < 32) lcount[tid] = 0;
    float breg0[32], breg1[32];
#pragma unroll
    for (int i = 0; i < 32; ++i) { const float* wr = p.w_router + (size_t)(128 * w + 4 * i + q4) * NEXP + l15; breg0[i] = wr[0]; breg1[i] = wr[16]; }
    const int te = lane & 31, tsel = lane >> 5;
    const float mybias = p.b_router[te];
    int nloc = 0;
    float4 pa_[4], pb_[4];
    if (vcu * 16 < NT) {
#pragma unroll
        for (int j = 0; j < 4; ++j) { pa_[j] = ntld4(p.out + (size_t)(vcu * 16 + w * 2) * DM + (j * 64 + lane) * 4); pb_[j] = ntld4(p.out + (size_t)(vcu * 16 + w * 2 + 1) * DM + (j * 64 + lane) * 4); } }
#pragma unroll 1
    for (int base = vcu * 16; base < NT; base += G * 16, nloc += 16) {
        const int row0 = base + w * 2;
        float4 xa[4], xb[4]; float sa = 0.f, sb = 0.f;
#pragma unroll
        for (int j = 0; j < 4; ++j) { xa[j] = pa_[j]; xb[j] = pb_[j]; }
        { const int nb_ = base + G * 16; if (nb_ < NT) {
#pragma unroll
            for (int j = 0; j < 4; ++j) { pa_[j] = ntld4(p.out + (size_t)(nb_ + w * 2) * DM + (j * 64 + lane) * 4); pb_[j] = ntld4(p.out + (size_t)(nb_ + w * 2 + 1) * DM + (j * 64 + lane) * 4); } } }
#pragma unroll
        for (int j = 0; j < 4; ++j) { sa += xa[j].x * xa[j].x + xa[j].y * xa[j].y + xa[j].z * xa[j].z + xa[j].w * xa[j].w; sb += xb[j].x * xb[j].x + xb[j].y * xb[j].y + xb[j].z * xb[j].z + xb[j].w * xb[j].w; }
        const float ra = rsqrtf(wave_sum(sa) * (1.f / DM) + EPS), rb = rsqrtf(wave_sum(sb) * (1.f / DM) + EPS);
#pragma unroll
        for (int j = 0; j < 4; ++j) { const int c = (j * 64 + lane) * 4; const float4 g = *(const float4*)(p.norm_ffn + c);
            xa[j] = make_float4(xa[j].x * ra * g.x, xa[j].y * ra * g.y, xa[j].z * ra * g.z, xa[j].w * ra * g.w);
            xb[j] = make_float4(xb[j].x * rb * g.x, xb[j].y * rb * g.y, xb[j].z * rb * g.z, xb[j].w * rb * g.w);
            *(float4*)&xs[(w * 2) * XST + c] = xa[j]; *(float4*)&xs[(w * 2 + 1) * XST + c] = xb[j];
            *(unsigned*)((unsigned char*)p.XN2() + (size_t)row0 * DM + c) = pk4_fp8(xa[j].x, xa[j].y, xa[j].z, xa[j].w);
            *(unsigned*)((unsigned char*)p.XN2() + (size_t)(row0 + 1) * DM + c) = pk4_fp8(xb[j].x, xb[j].y, xb[j].z, xb[j].w); }
        __syncthreads();
        f32x4 acc0 = {0.f, 0.f, 0.f, 0.f}, acc1 = {0.f, 0.f, 0.f, 0.f};
        const float* xp = xs + l15 * XST + 128 * w + q4;
#pragma unroll
        for (int i = 0; i < 32; ++i) { const float a = xp[4 * i];
            acc0 = __builtin_amdgcn_mfma_f32_16x16x4f32(a, breg0[i], acc0, 0, 0, 0); acc1 = __builtin_amdgcn_mfma_f32_16x16x4f32(a, breg1[i], acc1, 0, 0, 0); }
#pragma unroll
        for (int r = 0; r < 4; ++r) { part[(w * 16 + 4 * q4 + r) * 32 + l15] = acc0[r]; part[(w * 16 + 4 * q4 + r) * 32 + 16 + l15] = acc1[r]; }
        __syncthreads();
        float val = mybias;
#pragma unroll
        for (int w8 = 0; w8 < 8; ++w8) val += part[(w8 * 16 + 2 * w + tsel) * 32 + te];
        int cnt = 0;
#pragma unroll
        for (int e = 0; e < 32; ++e) { const float v0 = __int_as_float(__builtin_amdgcn_readlane(__float_as_int(val), e)), v1 = __int_as_float(__builtin_amdgcn_readlane(__float_as_int(val), 32 + e));
            const float ve = tsel ? v1 : v0; cnt += (ve > val || (ve == val && e < te)) ? 1 : 0; }
        float* rc = rec + w * 16 + tsel * 8;
        if (cnt < 4) { rc[cnt * 2] = __int_as_float(te); rc[cnt * 2 + 1] = val; }
        asm volatile("s_waitcnt lgkmcnt(0)" ::: "memory");
        if (te == 0) {
            const int row = row0 + tsel, tl = nloc + w * 2 + tsel; float ex[4], sum = 0.f; int tx[4];
#pragma unroll
            for (int kk = 0; kk < 4; ++kk) { tx[kk] = __float_as_int(rc[kk * 2]); ex[kk] = __expf(rc[kk * 2 + 1] - rc[1]); sum += ex[kk]; }
            const float inv = 1.f / sum;
#pragma unroll
            for (int kk = 0; kk < 4; ++kk) { const int e = tx[kk]; p.TOPI()[row * 4 + kk] = e; p.TOPW()[row * 4 + kk] = ex[kk] * inv;
                const int lr = atomicAdd(&lcount[e], 1); ent[tl * 4 + kk] = (unsigned short)(e | (lr << 5)); }
        }
        asm volatile("s_waitcnt lgkmcnt(0)" ::: "memory");
    }
    __syncthreads();
    if (tid < 32) lbase[tid] = atomicAdd(&p.CNT()[tid * CNT_STRIDE], lcount[tid]);
    __syncthreads();
    for (int idx = tid; idx < nloc * 4; idx += MK_THREADS) { const int tl = idx >> 2, row = vcu * 16 + (tl >> 4) * G * 16 + (tl & 15); const unsigned en = ent[idx];
        p.RANK()[row * 4 + (idx & 3)] = lbase[en & 31] + (int)(en >> 5); }
    __syncthreads();
}
#undef RS_STEP
__device__ __forceinline__ void phase_scatter(const Params& p, char* lds, int vcu, int G) {
    int* ps = (int*)lds;
    __syncthreads();
    if (threadIdx.x == 0) { int s = 0; for (int e = 0; e < NEXP; ++e) { ps[e] = s; s += (p.CNT()[e * CNT_STRIDE] + 255) / 256 * 256; } }
    __syncthreads();
    for (int gid = vcu * MK_THREADS + threadIdx.x; gid < NT * 4; gid += G * MK_THREADS) { const int slot = ps[p.TOPI()[gid]] + p.RANK()[gid]; p.SLOTS()[gid] = slot; p.SLOT_TOK()[slot] = gid >> 2; }
    __syncthreads();
}
__device__ __forceinline__ void phase_combine(const Params& p, int vcu, int G, float* dst) {
    const int lane = threadIdx.x & 63, gw = vcu * 8 + (threadIdx.x >> 6), NGW = G * 8;
    for (int r = gw * 2; r < NT; r += NGW * 2) {
        int sl[8]; float tw[8];
#pragma unroll
        for (int q = 0; q < 8; ++q) { sl[q] = p.SLOTS()[r * 4 + q]; tw[q] = p.TOPW()[r * 4 + q]; }
        float4 v[8];
#pragma unroll
        for (int j = 0; j < 4; ++j) { v[j] = ntld4(p.out + (size_t)r * DM + (j * 64 + lane) * 4); v[4 + j] = ntld4(p.out + (size_t)(r + 1) * DM + (j * 64 + lane) * 4); }
        uint2 y[8][4];
#pragma unroll
        for (int q = 0; q < 8; ++q)
#pragma unroll
            for (int j = 0; j < 4; ++j) y[q][j] = ntld2u(p.YB() + (size_t)sl[q] * DM + (j * 64 + lane) * 4);
#pragma unroll
        for (int q = 0; q < 8; ++q) { const float w = tw[q]; const int o = (q >> 2) * 4;
#pragma unroll
            for (int j = 0; j < 4; ++j) { const uint2 t = y[q][j];
                v[o + j].x += w * __uint_as_float(t.x << 16); v[o + j].y += w * __uint_as_float(t.x & 0xffff0000u); v[o + j].z += w * __uint_as_float(t.y << 16); v[o + j].w += w * __uint_as_float(t.y & 0xffff0000u); } }
        float sa = 0.f, sb = 0.f;
#pragma unroll
        for (int j = 0; j < 4; ++j) { sa += v[j].x * v[j].x + v[j].y * v[j].y + v[j].z * v[j].z + v[j].w * v[j].w; sb += v[4 + j].x * v[4 + j].x + v[4 + j].y * v[4 + j].y + v[4 + j].z * v[4 + j].z + v[4 + j].w * v[4 + j].w; }
        const float ra = rsqrtf(wave_sum(sa) * (1.f / DM) + EPS), rb = rsqrtf(wave_sum(sb) * (1.f / DM) + EPS);
#pragma unroll
        for (int j = 0; j < 4; ++j) { const int c = (j * 64 + lane) * 4; const float4 g = *(const float4*)(p.norm_final + c);
            *(float4*)(dst + (size_t)r * DM + c) = make_float4(v[j].x * ra * g.x, v[j].y * ra * g.y, v[j].z * ra * g.z, v[j].w * ra * g.w);
            *(float4*)(dst + (size_t)(r + 1) * DM + c) = make_float4(v[4 + j].x * rb * g.x, v[4 + j].y * rb * g.y, v[4 + j].z * rb * g.z, v[4 + j].w * rb * g.w); }
    }
}
__device__ __forceinline__ void phase_init_ctl(const Params& p, int vcu, int G) {
    if (vcu == 0) for (int i = threadIdx.x; i < NEXP * CNT_STRIDE; i += MK_THREADS) p.CNT()[i] = 0;
    for (int i = vcu * MK_THREADS + threadIdx.x; i < NSLOT; i += G * MK_THREADS) p.SLOT_TOK()[i] = -1;
}

#define XB_TMO      128
#define XB_XCNT(j)  (256  + 64 * (j))
#define XB_XSUB(j)  (1280 + 64 * (j))
#define XB_XGEN(j)  (2304 + 64 * (j))
#define XB_TOP      3328
#define XB_TOPGEN   3392
#define XCD_BAR_WORDS 3456
#define XB_SPIN_CAP (1u << 20)
__device__ __forceinline__ unsigned xb_ld(unsigned* p)              { return __hip_atomic_load(p, __ATOMIC_RELAXED, __HIP_MEMORY_SCOPE_AGENT); }
__device__ __forceinline__ unsigned xb_add(unsigned* p, unsigned v) { return __hip_atomic_fetch_add(p, v, __ATOMIC_RELAXED, __HIP_MEMORY_SCOPE_AGENT); }
__device__ __forceinline__ unsigned xb_xcc_id() { return (unsigned)__builtin_amdgcn_s_getreg((3 << 11) | 20) & 0xFu; }
#define XB_SPIN(cond, bar) do { unsigned _sp = 0; while (cond) { __builtin_amdgcn_s_sleep(1); \
    if ((++_sp & 255u) == 0u) { if (xb_ld(&(bar)[XB_TMO])) break; if (_sp > XB_SPIN_CAP) { atomicAdd(&(bar)[XB_TMO], 1u); break; } } } } while (0)
struct XcdBarrier { unsigned* bar; unsigned x; volatile LAS unsigned* st; };
__device__ __forceinline__ XcdBarrier xcd_barrier_post(unsigned* bar, volatile LAS unsigned* st) {
    XcdBarrier b; b.bar = bar; b.x = xb_xcc_id(); b.st = st;
    if (threadIdx.x == 0) (void)xb_add(&bar[XB_XCNT(b.x)], 1u);
    return b;
}
__device__ __forceinline__ void xcd_barrier_complete(unsigned* bar, unsigned x, unsigned& nloc, unsigned& nx) {
    const unsigned G = gridDim.x * gridDim.y * gridDim.z;
    unsigned sum, cnt, mine, sp = 0u;
    for (;;) {
        sum = 0u; cnt = 0u; mine = 0u;
#pragma unroll
        for (unsigned j = 0; j < 16; ++j) { const unsigned c = xb_ld(&bar[XB_XCNT(j)]); sum += c; cnt += (c > 0u) ? 1u : 0u; mine = (j == x) ? c : mine; }
        if (sum == G) break;
        __builtin_amdgcn_s_sleep(1);
        if ((++sp & 255u) == 0u) { if (xb_ld(&bar[XB_TMO])) break; if (sp > XB_SPIN_CAP) { atomicAdd(&bar[XB_TMO], 1u); break; } }
    }
    nloc = mine > 0u ? mine : 1u; nx = cnt > 0u ? cnt : 1u;
}
__device__ __forceinline__ void xcd_barrier(const XcdBarrier& b) {
    asm volatile("s_waitcnt vmcnt(0)" ::: "memory");
    __syncthreads();
    if (threadIdx.x == 0) {
        unsigned* bar = b.bar;
        __builtin_amdgcn_s_waitcnt(0);
        unsigned nloc = b.st[0], nx = b.st[1];
        if (nloc == 0u) { xcd_barrier_complete(bar, b.x, nloc, nx); b.st[0] = nloc; b.st[1] = nx; }
        const unsigned old = xb_add(&bar[XB_XSUB(b.x)], 1u);
        const unsigned gen = old / nloc;
        if (old + 1u == (gen + 1u) * nloc) {
            __builtin_amdgcn_fence(__ATOMIC_RELEASE, "agent");
            asm volatile("s_waitcnt vmcnt(0)" ::: "memory");
            const unsigned og = xb_add(&bar[XB_TOP], 1u);
            const unsigned tg = og / nx;
            if (og + 1u == (tg + 1u) * nx) xb_add(&bar[XB_TOPGEN], 1u);
            else XB_SPIN(xb_ld(&bar[XB_TOPGEN]) == tg, bar);
            __builtin_amdgcn_fence(__ATOMIC_ACQUIRE, "agent");
            xb_add(&bar[XB_XGEN(b.x)], 1u);
            asm volatile("s_waitcnt vmcnt(0)" ::: "memory");
        } else {
            XB_SPIN(xb_ld(&bar[XB_XGEN(b.x)]) == gen, bar);
            __builtin_amdgcn_fence(__ATOMIC_ACQUIRE, "agent");
            asm volatile("s_waitcnt vmcnt(0)" ::: "memory");
        }
    }
    __syncthreads();
}

struct MkArgs { Params p; int ph_lo, ph_hi, sub, pad; };
enum { PH_PRO = 0, PH_INPROJ = 1, PH_MSCAN = 2, PH_QPROJ = 3, PH_MOUT = 4, PH_ATTN = 5, PH_YM = 6, PH_YA = 7, PH_OUT = 8, PH_ROUTE = 9, PH_SCATTER = 10, PH_M1 = 11, PH_M2 = 12, PH_COMBINE = 13, PH_END = 14 };

__global__ void __launch_bounds__(MK_THREADS, 2) mk_fwd(MkArgs a) {
    extern __shared__ __attribute__((aligned(16))) unsigned char lds_raw[];
    LAS unsigned char* lds = (LAS unsigned char*)lds_raw;
    const Params& p = *(const Params*)__builtin_amdgcn_kernarg_segment_ptr();
    const int G = gridDim.x, bx = blockIdx.x;
    const int vcu = (G % 8 == 0) ? (bx % 8) * (G / 8) + bx / 8 : bx;
    cooperative_groups::grid_group grid = cooperative_groups::this_grid();
    const int lo = a.ph_lo, hi = a.ph_hi;
    volatile LAS unsigned* bst = (volatile LAS unsigned*)(lds + MK_LDS - 16);
    if (threadIdx.x < 4) bst[threadIdx.x] = 0u;
    __syncthreads();
    XcdBarrier xbar; xbar.bar = p.BAR(); xbar.x = 0; xbar.st = bst;
    if (hi - lo > 1) xbar = xcd_barrier_post(p.BAR(), bst);
#ifndef PHASE_MASK
#define PHASE_MASK 0xffffffffu
#endif
#define IN(k) (((PHASE_MASK >> (k)) & 1u) && lo <= (k) && (k) < hi)
#define SEAM(k) do { if (IN(k) && IN((k) + 1)) { if (a.sub == 0x7fffffff) grid.sync(); else xcd_barrier(xbar); } } while (0)
#ifndef PROBE_PHASE
#define PROBE_PHASE -1
#endif
#ifndef PROBE_REPS
#define PROBE_REPS 2
#endif
#define REPS(k) ((k) == PROBE_PHASE ? PROBE_REPS : 1)
    if (IN(PH_PRO)) for (int rep_ = 0; rep_ < REPS(PH_PRO); ++rep_) { if (rep_) xcd_barrier(xbar); phase_init_ctl(p, vcu, G); phase_prologue(p, lds, vcu, G, a.sub); } SEAM(PH_PRO);
    if (IN(PH_INPROJ)) for (int rep_ = 0; rep_ < REPS(PH_INPROJ); ++rep_) { if (rep_) xcd_barrier(xbar); { pg8::StaticOrder S; S.init(NT, 2560, DM, G, bx, p.U(), p.WinT()); EpiInP<0> E{p}; pg8::gemm_phase<EpiInP<0>, pg8::StaticOrder>(lds, DM, DM, S, E); }
        { pg8::StaticOrder S; S.init(NT, 3072, DM / 2, G, bx, p.U8(), p.WinT8()); EpiInP<1> E{p}; pg8::gemm_phase<EpiInP<1>, pg8::StaticOrder, true>(lds, DM / 2, DM / 2, S, E); } } SEAM(PH_INPROJ);
    if (IN(PH_MSCAN)) for (int rep_ = 0; rep_ < REPS(PH_MSCAN); ++rep_) { if (rep_) xcd_barrier(xbar);
        { const int half = (bx >> 3) & 1, idx = (bx & 7) * 16 + (bx >> 4);
            if (half == 0) { if (a.sub != 2) phase_mlstm_scan(p, (char*)lds_raw, idx, 128); }
            else if (a.sub != 1) { phase_kprep(p, idx, 128);
                asm volatile("s_waitcnt vmcnt(0)" ::: "memory"); __syncthreads();
                if (threadIdx.x == 0) { unsigned* cw = p.BAR() + 3584; __builtin_amdgcn_fence(__ATOMIC_RELEASE, "agent"); asm volatile("s_waitcnt vmcnt(0)" ::: "memory");
                    xb_add(cw, 1u); unsigned sp = 0; while (xb_ld(cw) < 128u * (unsigned)(rep_ + 1)) { __builtin_amdgcn_s_sleep(2); if (++sp > (1u << 22)) break; }
                    __builtin_amdgcn_fence(__ATOMIC_ACQUIRE, "agent"); asm volatile("s_waitcnt vmcnt(0)" ::: "memory"); }
                __syncthreads();
                pg8::StaticOrder S; S.init(NT, 1536, 256, 128, idx, p.CQb(), p.WqT()); EpiQ E{p}; pg8::gemm_phase<EpiQ, pg8::StaticOrder>(lds, 256, 256, S, E); } }
        } SEAM(PH_MSCAN);
    if (IN(PH_MOUT)) for (int rep_ = 0; rep_ < REPS(PH_MOUT); ++rep_) { if (rep_) xcd_barrier(xbar); phase_mlstm_out(p, (char*)lds_raw, vcu, G); }
    if (IN(PH_ATTN)) for (int rep_ = 0; rep_ < REPS(PH_ATTN); ++rep_) { if (rep_) xcd_barrier(xbar); phase_attn(p, (char*)lds_raw, vcu, G); } SEAM(PH_ATTN);
    if (IN(PH_YM)) for (int rep_ = 0; rep_ < REPS(PH_YM); ++rep_) { if (rep_) xcd_barrier(xbar); pg8::StaticOrder S; S.init(NT, DM, DM, G, bx, p.HM(), p.WmT()); EpiMix<0> E{p}; pg8::gemm_phase<EpiMix<0>, pg8::StaticOrder>(lds, DM, DM, S, E); }
    if (IN(PH_YA)) for (int rep_ = 0; rep_ < REPS(PH_YA); ++rep_) { if (rep_) xcd_barrier(xbar); pg8::StaticOrder S; S.init(NT, DM, DM, G, bx, p.OA(), p.WoT()); EpiMix<1> E{p}; pg8::gemm_phase<EpiMix<1>, pg8::StaticOrder>(lds, DM, DM, S, E); } SEAM(PH_YA);
    if (IN(PH_OUT)) for (int rep_ = 0; rep_ < REPS(PH_OUT); ++rep_) { if (rep_) xcd_barrier(xbar); pg8::StaticOrder S; S.init(NT, DM, DM, G, bx, p.MIX(), p.WoutT()); EpiOut E{p}; pg8::gemm_phase<EpiOut, pg8::StaticOrder>(lds, DM, DM, S, E); } SEAM(PH_OUT);
    if (IN(PH_ROUTE)) for (int rep_ = 0; rep_ < REPS(PH_ROUTE); ++rep_) { if (rep_) xcd_barrier(xbar); phase_route(p, (char*)lds_raw, vcu, G); } SEAM(PH_ROUTE);
    if (IN(PH_SCATTER)) for (int rep_ = 0; rep_ < REPS(PH_SCATTER); ++rep_) { if (rep_) xcd_barrier(xbar); phase_scatter(p, (char*)lds_raw, vcu, G); } SEAM(PH_SCATTER);
    if (IN(PH_M1)) for (int rep_ = 0; rep_ < REPS(PH_M1); ++rep_) { if (rep_) xcd_barrier(xbar); volatile LAS int* tst = (volatile LAS int*)(lds + MISC_OFF); moe_tile_table(p, tst);
        pg8::MoeOrder S; S.tstart = tst; S.npn = 8; S.G = G; S.c = bx; S.A = (const char*)p.XN2(); S.W = (const char*)p.W1T(); S.wexp = (size_t)2048 * DM; S.btile = (size_t)256 * DM;     S.rowidx = p.SLOT_TOK(); S.bias = p.b1; S.bsplit = 1;
        EpiM1 E{p}; pg8::gemm_phase<EpiM1, pg8::MoeOrder, true>(lds, DM / 2, DM / 2, S, E); } SEAM(PH_M1);
    if (IN(PH_M2)) for (int rep_ = 0; rep_ < REPS(PH_M2); ++rep_) { if (rep_) xcd_barrier(xbar); volatile LAS int* tst = (volatile LAS int*)(lds + MISC_OFF); moe_tile_table(p, tst);
        pg8::MoeOrder S; S.tstart = tst; S.npn = 4; S.G = G; S.c = bx; S.A = (const char*)p.ACT(); S.W = (const char*)p.W2T(); S.wexp = (size_t)DM * DFF; S.btile = (size_t)256 * DFF; S.rowidx = nullptr; S.bias = p.b2; S.bsplit = 0;
        EpiM2 E{p}; pg8::gemm_phase<EpiM2, pg8::MoeOrder, true>(lds, DFF / 2, DFF / 2, S, E); } SEAM(PH_M2);
    if (IN(PH_COMBINE)) for (int rep_ = 0; rep_ < REPS(PH_COMBINE); ++rep_) { if (rep_) xcd_barrier(xbar); phase_combine(p, vcu, G, a.sub ? (float*)p.ACT() : p.out); }
#undef IN
#undef SEAM
}

#ifndef ONE_LAUNCH
#define ONE_LAUNCH 1
#endif
#ifndef PROBE_DUP
#define PROBE_DUP -1
#endif
#ifndef PROBE_SUB
#define PROBE_SUB 0
#endif
#ifndef PROBE_DUP_N
#define PROBE_DUP_N 1
#endif
#ifndef FAST_INPROJ
#define FAST_INPROJ 1
#endif
#ifndef FAST_QPROJ
#define FAST_QPROJ 1
#endif
#ifndef FAST_MIX
#define FAST_MIX 1
#endif
#ifndef FAST_MOE
#define FAST_MOE 1
#endif
#ifndef FAST_ATTN
#define FAST_ATTN 1
#endif
#ifndef FAST_MLSTM
#define FAST_MLSTM 1
#endif
static void launch_mk(const Params& p, int lo, int hi, int grid, hipStream_t stream, int sub = 0) {
    MkArgs a{}; a.p = p; a.ph_lo = lo; a.ph_hi = hi; a.sub = sub;
    hipLaunchKernelGGL(mk_fwd, dim3(grid), dim3(MK_THREADS), MK_LDS, stream, a);
}
extern "C" void kernel_launch(void* const* d_in, const int* in_sizes, int n_in, void* d_out, int out_size, void* d_ws, size_t ws_size, hipStream_t stream) {
    static int ok = 0, grid = 0;
    if (!ok) {
        if (n_in != 22 || in_sizes[0] != NT * DM || out_size != NT * DM) { fprintf(stderr, "kernel_launch: unexpected shapes (n_in %d, x %d, out %d)\n", n_in, n_in > 0 ? in_sizes[0] : -1, out_size); return; }
        (void)hipFuncSetAttribute((const void*)k_mlstm_out, hipFuncAttributeMaxDynamicSharedMemorySize, MO_LDS);
        (void)hipFuncSetAttribute((const void*)mk_fwd, hipFuncAttributeMaxDynamicSharedMemorySize, MK_LDS);
        int dev = 0, cus = 0, per_cu = 0; (void)hipGetDevice(&dev); (void)hipDeviceGetAttribute(&cus, hipDeviceAttributeMultiprocessorCount, dev);
        (void)hipOccupancyMaxActiveBlocksPerMultiprocessor(&per_cu, (const void*)mk_fwd, MK_THREADS, MK_LDS);
        if (per_cu < 1) { fprintf(stderr, "kernel_launch: occupancy query says %d blocks/CU\n", per_cu); per_cu = 1; }
        if (cus != 256) { fprintf(stderr, "kernel_launch: built for a 256-CU device (got %d CUs)\n", cus); return; }
        grid = 256;
        ok = 1;
    }
    Params p{};
    const float** ins = (const float**)&p.x;
    for (int i = 0; i < 22; ++i) ins[i] = (const float*)d_in[i];
    p.out = (float*)d_out;
    p.ws = (char*)d_ws;
    if (WS_TOTAL > ws_size) { fprintf(stderr, "kernel_launch: workspace too small (%zu > %zu)\n", (size_t)WS_TOTAL, ws_size); return; }
    (void)hipMemsetAsync(p.BAR(), 0, 16384, stream);
#if ONE_LAUNCH
    { MkArgs a{}; a.p = p; a.ph_lo = 0; a.ph_hi = PH_END; void* args[] = {&a};
      hipError_t e = hipLaunchCooperativeKernel((const void*)mk_fwd, dim3(grid), dim3(MK_THREADS), args, MK_LDS, stream);
      if (e != hipSuccess) fprintf(stderr, "kernel_launch: cooperative launch failed: %s (grid %d)\n", hipGetErrorString(e), grid); }
#else
    for (int ph = 0; ph < PH_END; ++ph) { if (ph == PH_COMBINE && PROBE_DUP == PH_COMBINE) { launch_mk(p, ph, ph + 1, grid, stream, 1); launch_mk(p, ph, ph + 1, grid, stream, 0); continue; }
        launch_mk(p, ph, ph + 1, grid, stream);
        for (int d = 0; d < ((ph == PROBE_DUP) ? PROBE_DUP_N : 0); ++d) { if (ph == PH_ROUTE) (void)hipMemsetAsync(p.CNT(), 0, 4096, stream); launch_mk(p, ph, ph + 1, grid, stream, PROBE_SUB); } }
#endif
}
```

```cpp
#include <hip/hip_runtime.h>
#include <hip/hip_cooperative_groups.h>
#include <cstdio>
#include <cstdint>

typedef unsigned short bf16_t;
__device__ __forceinline__ float bf2f(bf16_t v) { return __uint_as_float(((unsigned)v) << 16); }
__device__ __forceinline__ bf16_t f2bf(float f) { unsigned u = __float_as_uint(f); return (bf16_t)((u + 0x7fffu + ((u >> 16) & 1u)) >> 16); }

constexpr int NB = 8, SEQ = 4096, NT = NB * SEQ, DM = 1024, NMETA = 16, LTOT = SEQ + NMETA;
constexpr int DIN = 5600;
constexpr int OFF_Q = 0, OFF_K = 512, OFF_V = 1024, OFF_O = 2048, OFF_I = 3072, OFF_F = 3088, OFF_CQ = 3104, OFF_CKV = 3360, OFF_KR = 3488, OFF_G = 3552;
constexpr int KVROWS = 4160;
constexpr int NEXP = 32, DFF = 1024;
constexpr int NSLOT = NT * 4 + NEXP * 256;
constexpr float EPS = 1e-6f;
constexpr int CNT_STRIDE = 16;
constexpr float QSCALE = 0.07216878364870322f * 1.4426950408889634f;

constexpr size_t ws_al(size_t x) { return (x + 255) & ~(size_t)255; }
constexpr size_t WS_BAR = 0;
constexpr size_t WS_CNT = WS_BAR + 16384;
constexpr size_t WS_SLOT_TOK = WS_CNT + ws_al(4096);
constexpr size_t WS_TOPI = WS_SLOT_TOK + ws_al((size_t)NSLOT*4);
constexpr size_t WS_TOPW = WS_TOPI + ws_al((size_t)NT*16);
constexpr size_t WS_RANK = WS_TOPW + ws_al((size_t)NT*16);
constexpr size_t WS_SLOTS = WS_RANK + ws_al((size_t)NT*16);
constexpr size_t WS_UM = WS_SLOTS + ws_al((size_t)NT*16);
constexpr size_t WS_ZM = WS_UM + ws_al((size_t)NMETA*DM*4);
constexpr size_t WS_ROPE = WS_ZM + ws_al((size_t)NMETA*DIN*4);
constexpr size_t WS_RSQ = WS_ROPE + ws_al((size_t)LTOT*64*4);
constexpr size_t WS_GI = WS_RSQ + ws_al((size_t)NT*4);
constexpr size_t WS_GF = WS_GI + ws_al((size_t)NT*64);
constexpr size_t WS_NF = WS_GF + ws_al((size_t)NT*64);
constexpr size_t WS_NB_ = WS_NF + ws_al((size_t)4096*256);
constexpr size_t WS_MF = WS_NB_ + ws_al((size_t)4096*256);
constexpr size_t WS_MB = WS_MF + ws_al((size_t)4096*4);
constexpr size_t WS_Kc = WS_MB + ws_al((size_t)4096*4);
constexpr size_t WS_WinT = WS_Kc + ws_al((size_t)NB*KVROWS*192*2);
constexpr size_t WS_WinT8 = WS_WinT + ws_al((size_t)5632*DM*2);
constexpr size_t WS_W1T = WS_WinT8 + ws_al((size_t)3072*DM);
constexpr size_t WS_W2T = WS_W1T + ws_al((size_t)NEXP*2048*DM*2);
constexpr size_t WS_WmT = WS_W2T + ws_al((size_t)NEXP*DM*DFF*2);
constexpr size_t WS_WoutT = WS_WmT + ws_al((size_t)DM*DM*2);
constexpr size_t WS_WoT = WS_WoutT + ws_al((size_t)DM*DM*2);
constexpr size_t WS_WqT = WS_WoT + ws_al((size_t)DM*DM*2);
constexpr size_t WS_CKV = WS_WqT + ws_al((size_t)1536*256*2);
constexpr size_t WS_KR = WS_CKV + ws_al((size_t)NT*128*4);
constexpr size_t WS_CQb = WS_KR + ws_al((size_t)NT*64*4);
constexpr size_t WS_GATE = WS_CQb + ws_al((size_t)NT*256*2);
constexpr size_t WS_WQF = WS_GATE + ws_al((size_t)NT*2048*2);
constexpr size_t WS_WOF = WS_WQF + ws_al((size_t)256*1536*4);
constexpr size_t WS_U = WS_WOF + ws_al((size_t)1024*1024*4);
constexpr size_t WS_Qm = WS_U + ws_al((size_t)NT*DM*2);
constexpr size_t WS_Km = WS_Qm + ws_al((size_t)NT*512*2);
constexpr size_t WS_Vm = WS_Km + ws_al((size_t)NT*512*2);
constexpr size_t WS_OG = WS_Vm + ws_al((size_t)NT*1024*2);
constexpr size_t WS_QP = WS_OG + ws_al((size_t)NT*1024*2);
constexpr size_t WS_CB = WS_QP + ws_al((size_t)NT*1536*2);
constexpr size_t WS_HM = WS_CB + ws_al((size_t)4096*8192*2);
constexpr size_t WS_OA = WS_HM + ws_al((size_t)NT*DM*2);
constexpr size_t WS_TOTAL = WS_OA + ws_al((size_t)NT*DM*2);
constexpr size_t WS_ACT = WS_U, WS_YB = WS_ACT + ws_al((size_t)NSLOT * DFF * 2), WS_MOE_END = WS_YB + ws_al((size_t)NSLOT * DM * 2);
constexpr size_t WS_U8 = WS_CB;
constexpr size_t WS_CF = WS_U, WS_MIX = WS_Qm, WS_XN2 = WS_HM, WS_CQ = WS_HM;
static_assert(WS_MOE_END <= WS_TOTAL && WS_XN2 >= WS_YB, "MoE overlay layout");
struct Params {
    const float *x, *meta, *norm_mix, *w_in, *m_b_i, *m_b_f, *m_norm, *w_m_proj, *a_w_uq, *a_w_ukv, *a_norm_q, *a_norm_kv, *w_a_proj, *w_out,
        *norm_ffn, *w_router, *b_router, *w1, *b1, *w2, *b2, *norm_final;
    float* out; char* ws;
    __host__ __device__ __forceinline__ int* CNT() const { return (int*)(ws + WS_CNT); }
    __host__ __device__ __forceinline__ unsigned* BAR() const { return (unsigned*)(ws + WS_BAR); }
    __host__ __device__ __forceinline__ unsigned char* WinT8() const { return (unsigned char*)(ws + WS_WinT8); }
    __host__ __device__ __forceinline__ unsigned char* U8() const { return (unsigned char*)(ws + WS_U8); }
    __host__ __device__ __forceinline__ int* SLOT_TOK() const { return (int*)(ws + WS_SLOT_TOK); }
    __host__ __device__ __forceinline__ int* TOPI() const { return (int*)(ws + WS_TOPI); }
    __host__ __device__ __forceinline__ float* TOPW() const { return (float*)(ws + WS_TOPW); }
    __host__ __device__ __forceinline__ int* RANK() const { return (int*)(ws + WS_RANK); }
    __host__ __device__ __forceinline__ int* SLOTS() const { return (int*)(ws + WS_SLOTS); }
    __host__ __device__ __forceinline__ float* UM() const { return (float*)(ws + WS_UM); }
    __host__ __device__ __forceinline__ float* ZM() const { return (float*)(ws + WS_ZM); }
    __host__ __device__ __forceinline__ float* ROPE() const { return (float*)(ws + WS_ROPE); }
    __host__ __device__ __forceinline__ float* RSQ() const { return (float*)(ws + WS_RSQ); }
    __host__ __device__ __forceinline__ float* GI() const { return (float*)(ws + WS_GI); }
    __host__ __device__ __forceinline__ float* GF() const { return (float*)(ws + WS_GF); }
    __host__ __device__ __forceinline__ float* NF() const { return (float*)(ws + WS_NF); }
    __host__ __device__ __forceinline__ float* NB_() const { return (float*)(ws + WS_NB_); }
    __host__ __device__ __forceinline__ float* MF() const { return (float*)(ws + WS_MF); }
    __host__ __device__ __forceinline__ float* MB() const { return (float*)(ws + WS_MB); }
    __host__ __device__ __forceinline__ bf16_t* Kc() const { return (bf16_t*)(ws + WS_Kc); }
    __host__ __device__ __forceinline__ bf16_t* WinT() const { return (bf16_t*)(ws + WS_WinT); }
    __host__ __device__ __forceinline__ bf16_t* W1T() const { return (bf16_t*)(ws + WS_W1T); }
    __host__ __device__ __forceinline__ bf16_t* W2T() const { return (bf16_t*)(ws + WS_W2T); }
    __host__ __device__ __forceinline__ bf16_t* WmT() const { return (bf16_t*)(ws + WS_WmT); }
    __host__ __device__ __forceinline__ bf16_t* WoutT() const { return (bf16_t*)(ws + WS_WoutT); }
    __host__ __device__ __forceinline__ bf16_t* WoT() const { return (bf16_t*)(ws + WS_WoT); }
    __host__ __device__ __forceinline__ bf16_t* WqT() const { return (bf16_t*)(ws + WS_WqT); }
    __host__ __device__ __forceinline__ float* CKV() const { return (float*)(ws + WS_CKV); }
    __host__ __device__ __forceinline__ float* KR() const { return (float*)(ws + WS_KR); }
    __host__ __device__ __forceinline__ bf16_t* CQb() const { return (bf16_t*)(ws + WS_CQb); }
    __host__ __device__ __forceinline__ bf16_t* GATE() const { return (bf16_t*)(ws + WS_GATE); }
    __host__ __device__ __forceinline__ float* WQF() const { return (float*)(ws + WS_WQF); }
    __host__ __device__ __forceinline__ float* WOF() const { return (float*)(ws + WS_WOF); }
    __host__ __device__ __forceinline__ bf16_t* U() const { return (bf16_t*)(ws + WS_U); }
    __host__ __device__ __forceinline__ bf16_t* Qm() const { return (bf16_t*)(ws + WS_Qm); }
    __host__ __device__ __forceinline__ bf16_t* Km() const { return (bf16_t*)(ws + WS_Km); }
    __host__ __device__ __forceinline__ bf16_t* Vm() const { return (bf16_t*)(ws + WS_Vm); }
    __host__ __device__ __forceinline__ bf16_t* OG() const { return (bf16_t*)(ws + WS_OG); }
    __host__ __device__ __forceinline__ bf16_t* QP() const { return (bf16_t*)(ws + WS_QP); }
    __host__ __device__ __forceinline__ bf16_t* CB() const { return (bf16_t*)(ws + WS_CB); }
    __host__ __device__ __forceinline__ bf16_t* HM() const { return (bf16_t*)(ws + WS_HM); }
    __host__ __device__ __forceinline__ bf16_t* OA() const { return (bf16_t*)(ws + WS_OA); }
    __host__ __device__ __forceinline__ bf16_t* ACT() const { return (bf16_t*)(ws + WS_ACT); }
    __host__ __device__ __forceinline__ bf16_t* YB() const { return (bf16_t*)(ws + WS_YB); }
    __host__ __device__ __forceinline__ bf16_t* CF() const { return (bf16_t*)(ws + WS_CF); }
    __host__ __device__ __forceinline__ bf16_t* MIX() const { return (bf16_t*)(ws + WS_MIX); }
    __host__ __device__ __forceinline__ bf16_t* XN2() const { return (bf16_t*)(ws + WS_XN2); }
    __host__ __device__ __forceinline__ float* CQ() const { return (float*)(ws + WS_CQ); }
};

__device__ __forceinline__ float wave_sum(float v) {
#pragma unroll
    for (int o = 1; o < 64; o <<= 1) v += __shfl_xor(v, o);
    return v;
}
__device__ __forceinline__ float sigmoidf_(float v) { return __builtin_amdgcn_rcpf(1.f + __expf(-v)); }
__device__ __forceinline__ float logsigmoidf_(float v) { return fminf(v, 0.f) - __logf(1.f + __expf(-fabsf(v))); }

__global__ void __launch_bounds__(256) k_prep_rows(Params p) {
    const int lane = threadIdx.x & 63, gw = (blockIdx.x * 256 + threadIdx.x) >> 6, ngw = (gridDim.x * 256) >> 6;
    for (int r = gw; r < NT + NMETA; r += ngw) {
        const float* src = r < NT ? p.x + (size_t)r * DM : p.meta + (size_t)(r - NT) * DM;
        float4 v[4]; float ss = 0.f;
#pragma unroll
        for (int j = 0; j < 4; ++j) { v[j] = *(const float4*)(src + (j * 64 + lane) * 4); ss += v[j].x * v[j].x + v[j].y * v[j].y + v[j].z * v[j].z + v[j].w * v[j].w; }
        const float rstd = rsqrtf(wave_sum(ss) * (1.f / DM) + EPS);
#pragma unroll
        for (int j = 0; j < 4; ++j) {
            const int c = (j * 64 + lane) * 4; const float4 g = *(const float4*)(p.norm_mix + c);
            const float a0 = v[j].x * rstd * g.x, a1 = v[j].y * rstd * g.y, a2 = v[j].z * rstd * g.z, a3 = v[j].w * rstd * g.w;
            if (r < NT) { bf16_t* d = p.U() + (size_t)r * DM + c; d[0] = f2bf(a0); d[1] = f2bf(a1); d[2] = f2bf(a2); d[3] = f2bf(a3); }
            else { float* d = p.UM() + (size_t)(r - NT) * DM + c; d[0] = a0; d[1] = a1; d[2] = a2; d[3] = a3; }
        }
    }
}

__global__ void __launch_bounds__(256) k_fold(Params p) {
    const long gid = (long)blockIdx.x * 256 + threadIdx.x, gn = (long)gridDim.x * 256;
    for (long i = gid; i < 256L * 1536; i += gn) {
        const int r = (int)(i / 1536), hc = (int)(i % 1536), h = hc / 192, c = hc % 192;
        const float* uq = p.a_w_uq + ((size_t)r * 8 + h) * 192; float acc;
        if (c >= 128) acc = uq[c];
        else { const float* kv = p.a_w_ukv + ((size_t)c * 8 + h) * 256; acc = 0.f; for (int d = 0; d < 128; ++d) acc += uq[d] * kv[d]; }
        p.WQF()[i] = acc;
    }
    for (long i = gid; i < 1024L * 1024; i += gn) {
        const int hc = (int)(i >> 10), n = (int)(i & 1023), h = hc >> 7, c = hc & 127;
        const float* kv = p.a_w_ukv + ((size_t)c * 8 + h) * 256 + 128; const float* ap = p.w_a_proj + (size_t)(h * 128) * DM + n;
        float acc = 0.f; for (int d = 0; d < 128; ++d) acc += kv[d] * ap[(size_t)d * DM];
        p.WOF()[i] = acc;
    }
    for (long i = gid; i < (long)LTOT * 32; i += gn) {
        const int pos = (int)(i >> 5), f = (int)(i & 31);
        const float freq = powf(10000.f, -(float)f / 32.f), ang = (float)pos * freq; float s, c; sincosf(ang, &s, &c);
        p.ROPE()[i * 2] = c; p.ROPE()[i * 2 + 1] = s;
    }
}

__global__ void __launch_bounds__(256) k_meta_proj(Params p) {
    const int gid = blockIdx.x * 256 + threadIdx.x;
    if (gid >= NMETA * DIN) return;
    const int j = gid / DIN, n = gid % DIN; const float* u = p.UM() + (size_t)j * DM; float acc = 0.f;
    for (int k = 0; k < DM; ++k) acc += u[k] * p.w_in[(size_t)k * DIN + n];
    p.ZM()[gid] = acc;
}

template <class P> __global__ void __launch_bounds__(256) k_sgemm(P q) {
    __shared__ float As[16][68]; __shared__ float Bs[16][68];
    const int ntn = (q.N + 63) / 64, ntm = q.M / 64, tid = threadIdx.x, tx = tid & 15, ty = tid >> 4;
    for (int tile = blockIdx.x; tile < ntm * ntn; tile += gridDim.x) {
        const int tm = tile / ntn, tn = tile % ntn; int ctx = 0;
        if (!q.setup(tm, ctx)) continue;
        float acc[4][4];
#pragma unroll
        for (int i = 0; i < 4; ++i)
#pragma unroll
            for (int j = 0; j < 4; ++j) acc[i][j] = 0.f;
        const int arow = tm * 64 + (tid >> 2), ak = (tid & 3) * 4, bk = tid >> 4, bcol = tn * 64 + (tid & 15) * 4;
        for (int k0 = 0; k0 < q.K; k0 += 16) {
            const float4 av = q.a4(ctx, arow, k0 + ak);
            const float4 bv = bcol < q.N ? q.b4(ctx, k0 + bk, bcol) : make_float4(0.f, 0.f, 0.f, 0.f);
            __syncthreads();
            As[ak + 0][tid >> 2] = av.x; As[ak + 1][tid >> 2] = av.y; As[ak + 2][tid >> 2] = av.z; As[ak + 3][tid >> 2] = av.w;
            *(float4*)&Bs[bk][(tid & 15) * 4] = bv;
            __syncthreads();
#pragma unroll
            for (int kk = 0; kk < 16; ++kk) {
                const float4 a = *(const float4*)&As[kk][ty * 4]; const float4 b = *(const float4*)&Bs[kk][tx * 4];
                const float aa[4] = {a.x, a.y, a.z, a.w}, bb[4] = {b.x, b.y, b.z, b.w};
#pragma unroll
                for (int i = 0; i < 4; ++i)
#pragma unroll
                    for (int j = 0; j < 4; ++j) acc[i][j] += aa[i] * bb[j];
            }
        }
        const int col = tn * 64 + tx * 4;
        if (col < q.N) {
#pragma unroll
            for (int i = 0; i < 4; ++i) q.epi(ctx, tm * 64 + ty * 4 + i, col, acc[i]);
        }
    }
}
__device__ __forceinline__ float4 ld_bf4(const bf16_t* p) { const uint2 w = *(const uint2*)p; return make_float4(__uint_as_float(w.x << 16), __uint_as_float(w.x & 0xffff0000u), __uint_as_float(w.y << 16), __uint_as_float(w.y & 0xffff0000u)); }

struct ProbIn {
    Params p; int M, N, K, pad;
    __device__ bool setup(int, int&) const { return true; }
    __device__ float4 a4(int, int row, int k) const { return ld_bf4(p.U() + (size_t)row * DM + k); }
    __device__ float4 b4(int, int k, int col) const { return *(const float4*)(p.w_in + (size_t)k * DIN + col); }
    __device__ void epi(int, int row, int col, const float (&v)[4]) const {
#pragma unroll
        for (int j = 0; j < 4; ++j) {
            const int c = col + j; const float z = v[j];
            if (c < OFF_K) p.Qm()[(size_t)row * 512 + c] = f2bf(z * 0.125f);
            else if (c < OFF_V) p.Km()[(size_t)row * 512 + (c - OFF_K)] = f2bf(z);
            else if (c < OFF_O) p.Vm()[(size_t)row * 1024 + (c - OFF_V)] = f2bf(z);
            else if (c < OFF_I) p.OG()[(size_t)row * 1024 + (c - OFF_O)] = f2bf(sigmoidf_(z));
            else if (c < OFF_F) p.GI()[(size_t)row * 16 + (c - OFF_I)] = z + p.m_b_i[c - OFF_I];
            else if (c < OFF_CQ) p.GF()[(size_t)row * 16 + (c - OFF_F)] = logsigmoidf_(z + p.m_b_f[c - OFF_F]);
            else if (c < OFF_CKV) p.CQ()[(size_t)row * 256 + (c - OFF_CQ)] = z;
            else if (c < OFF_KR) p.CKV()[(size_t)row * 128 + (c - OFF_CKV)] = z;
            else if (c < OFF_G) p.KR()[(size_t)row * 64 + (c - OFF_KR)] = z;
            else p.GATE()[(size_t)row * 2048 + (c - OFF_G)] = f2bf(sigmoidf_(z));
        }
    }
};

__global__ void __launch_bounds__(256) k_kprep(Params p) {
    const int lane = threadIdx.x & 63, gw = (blockIdx.x * 256 + threadIdx.x) >> 6, ngw = (gridDim.x * 256) >> 6;
    for (int i = gw; i < NB * KVROWS; i += ngw) {
        const int b = i / KVROWS, key = i % KVROWS; bf16_t* dst = p.Kc() + (size_t)i * 192;
        if (key >= LTOT) { dst[lane] = 0; dst[64 + lane] = 0; dst[128 + lane] = 0; continue; }
        const float *ckv, *kr; int pos;
        if (key < SEQ) { const size_t r = (size_t)b * SEQ + key; ckv = p.CKV() + r * 128; kr = p.KR() + r * 64; pos = NMETA + key; }
        else { const int j = key - SEQ; ckv = p.ZM() + (size_t)j * DIN + OFF_CKV; kr = p.ZM() + (size_t)j * DIN + OFF_KR; pos = j; }
        const float c0 = ckv[lane], c1 = ckv[64 + lane];
        const float rstd = rsqrtf(wave_sum(c0 * c0 + c1 * c1) * (1.f / 128.f) + EPS);
        dst[lane] = f2bf(c0 * rstd * p.a_norm_kv[lane]); dst[64 + lane] = f2bf(c1 * rstd * p.a_norm_kv[64 + lane]);
        if (lane < 32) {
            const float x1 = kr[lane], x2 = kr[32 + lane], cs = p.ROPE()[((size_t)pos * 32 + lane) * 2], sn = p.ROPE()[((size_t)pos * 32 + lane) * 2 + 1];
            dst[128 + lane] = f2bf(x1 * cs - x2 * sn); dst[160 + lane] = f2bf(x1 * sn + x2 * cs);
        }
    }
    for (int r = gw; r < NT; r += ngw) {
        float* cq = p.CQ() + (size_t)r * 256; float v[4]; float ss = 0.f;
#pragma unroll
        for (int j = 0; j < 4; ++j) { v[j] = cq[j * 64 + lane]; ss += v[j] * v[j]; }
        const float rstd = rsqrtf(wave_sum(ss) * (1.f / 256.f) + EPS);
#pragma unroll
        for (int j = 0; j < 4; ++j) cq[j * 64 + lane] = v[j] * rstd * p.a_norm_q[j * 64 + lane];
    }
}

struct ProbQ {
    Params p; int M, N, K, pad;
    __device__ bool setup(int, int&) const { return true; }
    __device__ float4 a4(int, int row, int k) const { return *(const float4*)(p.CQ() + (size_t)row * 256 + k); }
    __device__ float4 b4(int, int k, int col) const { return *(const float4*)(p.WQF() + (size_t)k * 1536 + col); }
    __device__ void epi(int, int row, int col, const float (&v)[4]) const {
        const int h = col / 192, c = col % 192;
        if (c < 128) {
#pragma unroll
            for (int j = 0; j < 4; ++j) p.QP()[(size_t)row * 1536 + col + j] = f2bf(v[j] * QSCALE);
        } else {
#pragma unroll
            for (int j = 0; j < 4; ++j) p.QP()[(size_t)row * 1536 + col + j] = f2bf(v[j] * QSCALE);
        }
        (void)h;
    }
};
__global__ void __launch_bounds__(256) k_rope_q(Params p) {
    const long gid = (long)blockIdx.x * 256 + threadIdx.x;
    if (gid >= (long)NT * 8 * 32) return;
    const int i = (int)(gid & 31), h = (int)((gid >> 5) & 7); const long r = gid >> 8; const int pos = NMETA + (int)(r % SEQ);
    bf16_t* q = p.QP() + (size_t)r * 1536 + h * 192 + 128;
    const float x1 = bf2f(q[i]), x2 = bf2f(q[32 + i]), cs = p.ROPE()[((size_t)pos * 32 + i) * 2], sn = p.ROPE()[((size_t)pos * 32 + i) * 2 + 1];
    q[i] = f2bf(x1 * cs - x2 * sn); q[32 + i] = f2bf(x1 * sn + x2 * cs);
}

__global__ void __launch_bounds__(256) k_mlstm_scan(Params p) {
    __shared__ float ks[64][65]; __shared__ float vs[64][128]; __shared__ float wk[64]; __shared__ float li[64], lf[64]; __shared__ float sc[2];
    const int tid = threadIdx.x, b = blockIdx.x >> 4, h = (blockIdx.x >> 1) & 7, dir = blockIdx.x & 1;
    const int d = tid >> 2, vq = tid & 3;
    float C[32]; float n = 0.f, m = 0.f;
#pragma unroll
    for (int i = 0; i < 32; ++i) C[i] = 0.f;
    bf16_t* CS = dir ? p.CB() : p.CF(); float* NS = dir ? p.NB_() : p.NF(); float* MS = dir ? p.MB() : p.MF();
    const int nsteps = dir ? 64 : 65;
    for (int st = 0; st < nsteps; ++st) {
        const int c = dir ? 63 - st : st - 1;
        if (c >= 0) {
            const size_t sidx = ((size_t)(b * 8 + h) * 64 + c);
            bf16_t* cd = CS + sidx * 8192 + d * 128 + vq * 32;
#pragma unroll
            for (int i = 0; i < 32; ++i) cd[i] = f2bf(C[i]);
            if (vq == 0) NS[sidx * 64 + d] = n;
            if (tid == 0) MS[sidx] = m;
            if ((dir == 0 && c == 63) || (dir == 1 && c == 0)) break;
        }
        const int npos = c < 0 ? NMETA : 64;
        __syncthreads();
        for (int e = tid; e < 64 * 64; e += 256) { const int j = e >> 6, dd = e & 63; float v = 0.f;
            if (j < npos) { if (c < 0) v = p.ZM()[(size_t)j * DIN + OFF_K + h * 64 + dd]; else { const int t = dir ? 63 - j : j; v = bf2f(p.Km()[((size_t)b * SEQ + c * 64 + t) * 512 + h * 64 + dd]); } }
            ks[j][dd] = v; }
        for (int e = tid; e < 64 * 128; e += 256) { const int j = e >> 7, dd = e & 127; float v = 0.f;
            if (j < npos) { if (c < 0) v = p.ZM()[(size_t)j * DIN + OFF_V + h * 128 + dd]; else { const int t = dir ? 63 - j : j; v = bf2f(p.Vm()[((size_t)b * SEQ + c * 64 + t) * 1024 + h * 128 + dd]); } }
            vs[j][dd] = v; }
        if (tid < 64) { float a = -1e30f, f = 0.f; const int j = tid;
            if (j < npos) { if (c < 0) { a = p.ZM()[(size_t)j * DIN + OFF_I + h] + p.m_b_i[h]; f = logsigmoidf_(p.ZM()[(size_t)j * DIN + OFF_F + h] + p.m_b_f[h]); }
                            else { const int t = dir ? 63 - j : j; const size_t r = (size_t)b * SEQ + c * 64 + t; a = p.GI()[r * 16 + dir * 8 + h]; f = p.GF()[r * 16 + dir * 8 + h]; } }
            li[j] = a; lf[j] = f; }
        __syncthreads();
        if (tid == 0) {
            float bl = 0.f; for (int j = 0; j < npos; ++j) bl += lf[j];
            float bc = 0.f, gmax = -1e30f;
            for (int j = 0; j < npos; ++j) { bc += lf[j]; const float g = bl - bc + li[j]; wk[j] = g; gmax = fmaxf(gmax, g); }
            const float mnew = fmaxf(bl + m, gmax);
            for (int j = 0; j < 64; ++j) wk[j] = j < npos ? __expf(wk[j] - mnew) : 0.f;
            sc[0] = __expf(bl + m - mnew); sc[1] = mnew;
        }
        __syncthreads();
        const float decay = sc[0]; m = sc[1];
#pragma unroll
        for (int i = 0; i < 32; ++i) C[i] *= decay;
        n *= decay;
        for (int j = 0; j < npos; ++j) { const float kw = wk[j] * ks[j][d]; n += kw;
#pragma unroll
            for (int i = 0; i < 32; ++i) C[i] += kw * vs[j][vq * 32 + i]; }
    }
}

constexpr int MO_LDS = (64 * 65 * 3 + 64 * 128 * 2 + 64 * 8) * 4;
__global__ void __launch_bounds__(256) k_mlstm_out(Params p) {
    extern __shared__ __attribute__((aligned(16))) float sm[];
    float (*qs)[65] = (float (*)[65])sm; float (*ks)[65] = (float (*)[65])(sm + 64 * 65); float (*Ws)[65] = (float (*)[65])(sm + 2 * 64 * 65);
    float (*vs)[128] = (float (*)[128])(sm + 3 * 64 * 65); float (*Cs)[128] = (float (*)[128])(sm + 3 * 64 * 65 + 64 * 128);
    float* sx = sm + 3 * 64 * 65 + 2 * 64 * 128; float *li = sx, *lf = sx + 64, *bt = sx + 128, *mt = sx + 192, *as = sx + 256, *ns = sx + 320, *msc = sx + 384;
    const int tid = threadIdx.x, c = blockIdx.x & 63, h = (blockIdx.x >> 6) & 7, b = blockIdx.x >> 9;
    const int t = tid >> 2, vq = tid & 3; const size_t r0 = (size_t)b * SEQ + c * 64;
    for (int e = tid; e < 64 * 64; e += 256) { const int j = e >> 6, dd = e & 63; qs[j][dd] = bf2f(p.Qm()[(r0 + j) * 512 + h * 64 + dd]); ks[j][dd] = bf2f(p.Km()[(r0 + j) * 512 + h * 64 + dd]); }
    for (int e = tid; e < 64 * 128; e += 256) { const int j = e >> 7, dd = e & 127; vs[j][dd] = bf2f(p.Vm()[(r0 + j) * 1024 + h * 128 + dd]); }
    __syncthreads();
    float S[16];
#pragma unroll
    for (int i = 0; i < 16; ++i) { const int s = vq * 16 + i; float a = 0.f;
#pragma unroll 4
        for (int dd = 0; dd < 64; ++dd) a += qs[t][dd] * ks[s][dd]; S[i] = a; }
    float hacc[32];
#pragma unroll
    for (int i = 0; i < 32; ++i) hacc[i] = 0.f;
#pragma unroll 1
    for (int dir = 0; dir < 2; ++dir) {
        const size_t sidx = ((size_t)(b * 8 + h) * 64 + c);
        const bf16_t* CS = (dir ? p.CB() : p.CF()) + sidx * 8192; const float* NS = (dir ? p.NB_() : p.NF()) + sidx * 64; const float* MS = (dir ? p.MB() : p.MF()) + sidx;
        __syncthreads();
        for (int e = tid; e < 64 * 128; e += 256) Cs[e >> 7][e & 127] = bf2f(CS[e]);
        if (tid < 64) { ns[tid] = NS[tid]; li[tid] = p.GI()[(r0 + tid) * 16 + dir * 8 + h]; lf[tid] = p.GF()[(r0 + tid) * 16 + dir * 8 + h]; }
        if (tid == 0) msc[0] = MS[0];
        __syncthreads();
        if (tid == 0) {
            const float m = msc[0]; float bc = 0.f, pm = -1e30f;
            if (dir == 0) { for (int j = 0; j < 64; ++j) { bc += lf[j]; const float a = li[j] - bc; as[j] = a; pm = fmaxf(pm, a); bt[j] = bc; mt[j] = fmaxf(bc + m, bc + pm); } }
            else { for (int j = 63; j >= 0; --j) { bc += lf[j]; const float a = li[j] - bc; as[j] = a; pm = fmaxf(pm, a); bt[j] = bc; mt[j] = fmaxf(bc + m, bc + pm); } }
        }
        __syncthreads();
        const float m = msc[0], b_t = bt[t], m_t = mt[t];
#pragma unroll
        for (int i = 0; i < 16; ++i) { const int s = vq * 16 + i; const bool valid = dir ? (s >= t) : (s <= t); Ws[t][s] = valid ? __expf(b_t + as[s] - m_t) * S[i] : 0.f; }
        __syncthreads();
        const float s_inter = __expf(b_t + m - m_t);
        float num[32]; float den = 0.f, qn = 0.f;
#pragma unroll
        for (int i = 0; i < 32; ++i) num[i] = 0.f;
#pragma unroll 2
        for (int dd = 0; dd < 64; ++dd) { const float qv = qs[t][dd]; qn += qv * ns[dd];
#pragma unroll
            for (int i = 0; i < 32; ++i) num[i] += qv * Cs[dd][vq * 32 + i]; }
#pragma unroll
        for (int i = 0; i < 32; ++i) num[i] *= s_inter;
        den = s_inter * qn;
#pragma unroll 2
        for (int s = 0; s < 64; ++s) { const float w = Ws[t][s]; den += w;
#pragma unroll
            for (int i = 0; i < 32; ++i) num[i] += w * vs[s][vq * 32 + i]; }
        const float inv = 1.f / fmaxf(fabsf(den), __expf(-m_t));
#pragma unroll
        for (int i = 0; i < 32; ++i) hacc[i] += num[i] * inv;
    }
    float ss = 0.f;
#pragma unroll
    for (int i = 0; i < 32; ++i) ss += hacc[i] * hacc[i];
    ss += __shfl_xor(ss, 1); ss += __shfl_xor(ss, 2);
    const float rstd = rsqrtf(ss * (1.f / 128.f) + EPS);
#pragma unroll
    for (int i = 0; i < 32; ++i) { const int col = h * 128 + vq * 32 + i; const size_t o = (r0 + t) * 1024 + col;
        p.HM()[o] = f2bf(hacc[i] * rstd * p.m_norm[col] * bf2f(p.OG()[o])); }
}

__global__ void __launch_bounds__(256) k_attn(Params p) {
    __shared__ float kt[32][192];
    const int tid = threadIdx.x, qi = tid >> 2, sl = tid & 3, qb = blockIdx.x & 63, h = (blockIdx.x >> 6) & 7, b = blockIdx.x >> 9;
    const size_t r = (size_t)b * SEQ + qb * 64 + qi;
    float q[48], o[32]; float m = -1e30f, l = 0.f;
#pragma unroll
    for (int i = 0; i < 48; ++i) q[i] = bf2f(p.QP()[r * 1536 + h * 192 + i * 4 + sl]);
#pragma unroll
    for (int i = 0; i < 32; ++i) o[i] = 0.f;
    const bf16_t* Kb = p.Kc() + (size_t)b * KVROWS * 192;
#pragma unroll 1
    for (int tile = 0; tile < KVROWS / 32; ++tile) {
        __syncthreads();
        for (int e = tid; e < 32 * 192; e += 256) kt[e / 192][e % 192] = bf2f(Kb[(size_t)tile * 32 * 192 + e]);
        __syncthreads();
#pragma unroll 1
        for (int g = 0; g < 4; ++g) {
            float s[8]; float tmax = -1e30f;
#pragma unroll
            for (int j = 0; j < 8; ++j) { float a = 0.f; const float* kr = &kt[g * 8 + j][sl];
#pragma unroll
                for (int i = 0; i < 48; ++i) a += q[i] * kr[i * 4];
                a += __shfl_xor(a, 1); a += __shfl_xor(a, 2);
                if (tile * 32 + g * 8 + j >= LTOT) a = -1e30f;
                s[j] = a; tmax = fmaxf(tmax, a); }
            const float mn = fmaxf(m, tmax), alpha = exp2f(m - mn); m = mn; l *= alpha;
#pragma unroll
            for (int i = 0; i < 32; ++i) o[i] *= alpha;
#pragma unroll
            for (int j = 0; j < 8; ++j) { const float pj = (tile * 32 + g * 8 + j >= LTOT) ? 0.f : exp2f(s[j] - mn); l += pj; const float* kr = &kt[g * 8 + j][sl];
#pragma unroll
                for (int i = 0; i < 32; ++i) o[i] += pj * kr[i * 4]; }
        }
    }
    const float inv = 1.f / l;
#pragma unroll
    for (int i = 0; i < 32; ++i) p.OA()[r * 1024 + h * 128 + i * 4 + sl] = f2bf(o[i] * inv);
}

struct ProbYm {
    Params p; int M, N, K, pad;
    __device__ bool setup(int, int&) const { return true; }
    __device__ float4 a4(int, int row, int k) const { return ld_bf4(p.HM() + (size_t)row * DM + k); }
    __device__ float4 b4(int, int k, int col) const { return *(const float4*)(p.w_m_proj + (size_t)k * DM + col); }
    __device__ void epi(int, int row, int col, const float (&v)[4]) const {
#pragma unroll
        for (int j = 0; j < 4; ++j) p.MIX()[(size_t)row * DM + col + j] = f2bf(v[j] * bf2f(p.GATE()[(size_t)row * 2048 + col + j]));
    }
};
struct ProbYa {
    Params p; int M, N, K, pad;
    __device__ bool setup(int, int&) const { return true; }
    __device__ float4 a4(int, int row, int k) const { return ld_bf4(p.OA() + (size_t)row * DM + k); }
    __device__ float4 b4(int, int k, int col) const { return *(const float4*)(p.WOF() + (size_t)k * DM + col); }
    __device__ void epi(int, int row, int col, const float (&v)[4]) const {
#pragma unroll
        for (int j = 0; j < 4; ++j) { const size_t o = (size_t)row * DM + col + j; p.MIX()[o] = f2bf(bf2f(p.MIX()[o]) + v[j] * bf2f(p.GATE()[(size_t)row * 2048 + 1024 + col + j])); }
    }
};
struct ProbOut {
    Params p; int M, N, K, pad;
    __device__ bool setup(int, int&) const { return true; }
    __device__ float4 a4(int, int row, int k) const { return ld_bf4(p.MIX() + (size_t)row * DM + k); }
    __device__ float4 b4(int, int k, int col) const { return *(const float4*)(p.w_out + (size_t)k * DM + col); }
    __device__ void epi(int, int row, int col, const float (&v)[4]) const {
        const float4 xv = *(const float4*)(p.x + (size_t)row * DM + col);
        *(float4*)(p.out + (size_t)row * DM + col) = make_float4(xv.x + v[0], xv.y + v[1], xv.z + v[2], xv.w + v[3]);
    }
};

__global__ void __launch_bounds__(256) k_route(Params p) {
    __shared__ float xn[8][1024];
    const int tid = threadIdx.x, lane = tid & 63, w = tid >> 6;
    for (int base = blockIdx.x * 8; base < NT; base += gridDim.x * 8) {
        __syncthreads();
        for (int rr = 0; rr < 2; ++rr) {
            const int row = base + w * 2 + rr; const float* src = p.out + (size_t)row * DM;
            float4 v[4]; float ss = 0.f;
#pragma unroll
            for (int j = 0; j < 4; ++j) { v[j] = *(const float4*)(src + (j * 64 + lane) * 4); ss += v[j].x * v[j].x + v[j].y * v[j].y + v[j].z * v[j].z + v[j].w * v[j].w; }
            const float rstd = rsqrtf(wave_sum(ss) * (1.f / DM) + EPS);
#pragma unroll
            for (int j = 0; j < 4; ++j) { const int c = (j * 64 + lane) * 4; const float4 g = *(const float4*)(p.norm_ffn + c);
                const float a0 = v[j].x * rstd * g.x, a1 = v[j].y * rstd * g.y, a2 = v[j].z * rstd * g.z, a3 = v[j].w * rstd * g.w;
                float* d = &xn[w * 2 + rr][c]; d[0] = a0; d[1] = a1; d[2] = a2; d[3] = a3;
                bf16_t* o = p.XN2() + (size_t)row * DM + c; o[0] = f2bf(a0); o[1] = f2bf(a1); o[2] = f2bf(a2); o[3] = f2bf(a3); }
        }
        __syncthreads();
        const int rloc = w * 2 + (lane >> 5), e = lane & 31, row = base + rloc;
        float acc = p.b_router[e];
        for (int k = 0; k < DM; ++k) acc += xn[rloc][k] * p.w_router[(size_t)k * NEXP + e];
        float val = acc; int ti[4]; float tv[4];
#pragma unroll
        for (int kk = 0; kk < 4; ++kk) {
            float best = val; int bi = e;
#pragma unroll
            for (int o = 1; o < 32; o <<= 1) { const float ov = __shfl_xor(best, o); const int oi = __shfl_xor(bi, o); if (ov > best || (ov == best && oi < bi)) { best = ov; bi = oi; } }
            ti[kk] = bi; tv[kk] = best; if (e == bi) val = -3.0e38f;
        }
        if (e == 0) {
            const float mx = tv[0]; float ex[4], sum = 0.f;
#pragma unroll
            for (int kk = 0; kk < 4; ++kk) { ex[kk] = __expf(tv[kk] - mx); sum += ex[kk]; }
#pragma unroll
            for (int kk = 0; kk < 4; ++kk) { p.TOPI()[row * 4 + kk] = ti[kk]; p.TOPW()[row * 4 + kk] = ex[kk] / sum; p.RANK()[row * 4 + kk] = atomicAdd(&p.CNT()[ti[kk] * CNT_STRIDE], 1); }
        }
    }
}
__device__ __forceinline__ int expert_pstart(const int* cnt, int e) { int s = 0; for (int i = 0; i < e; ++i) s += (cnt[i * CNT_STRIDE] + 255) / 256 * 256; return s; }
__global__ void __launch_bounds__(256) k_scatter(Params p) {
    __shared__ int ps[NEXP];
    if (threadIdx.x < NEXP) ps[threadIdx.x] = expert_pstart(p.CNT(), threadIdx.x);
    __syncthreads();
    const int gid = blockIdx.x * 256 + threadIdx.x; if (gid >= NT * 4) return;
    const int slot = ps[p.TOPI()[gid]] + p.RANK()[gid]; p.SLOTS()[gid] = slot; p.SLOT_TOK()[slot] = gid >> 2;
}

struct ProbM1 {
    Params p; int M, N, K, pad;
    __device__ bool setup(int tm, int& e) const {
        int s = 0; e = -1;
        for (int i = 0; i < NEXP; ++i) { const int pc = (p.CNT()[i * CNT_STRIDE] + 255) / 256 * 256; if (tm * 64 < s + pc) { e = i; break; } s += pc; }
        return e >= 0;
    }
    __device__ float4 a4(int, int row, int k) const { const int tok = p.SLOT_TOK()[row]; return tok < 0 ? make_float4(0.f, 0.f, 0.f, 0.f) : ld_bf4(p.XN2() + (size_t)tok * DM + k); }
    __device__ float4 b4(int e, int k, int col) const { const float* w = p.w1 + ((size_t)e * DM + k) * 2048 + (col >> 1); const float2 g = *(const float2*)w, l = *(const float2*)(w + 1024); return make_float4(g.x, l.x, g.y, l.y); }
    __device__ void epi(int e, int row, int col, const float (&v)[4]) const {
#pragma unroll
        for (int j = 0; j < 2; ++j) { const int c = (col >> 1) + j; const float g0 = v[2 * j] + p.b1[(size_t)e * 2048 + c], l0 = v[2 * j + 1] + p.b1[(size_t)e * 2048 + 1024 + c];
            const float glu = fminf(g0, 7.f), lin = fminf(fmaxf(l0, -7.f), 7.f);
            p.ACT()[(size_t)row * DFF + c] = f2bf(glu * sigmoidf_(1.702f * glu) * (lin + 1.f)); }
    }
};
struct ProbM2 {
    Params p; int M, N, K, pad;
    __device__ bool setup(int tm, int& e) const {
        int s = 0; e = -1;
        for (int i = 0; i < NEXP; ++i) { const int pc = (p.CNT()[i * CNT_STRIDE] + 255) / 256 * 256; if (tm * 64 < s + pc) { e = i; break; } s += pc; }
        return e >= 0;
    }
    __device__ float4 a4(int, int row, int k) const { return ld_bf4(p.ACT() + (size_t)row * DFF + k); }
    __device__ float4 b4(int e, int k, int col) const { return *(const float4*)(p.w2 + ((size_t)e * DFF + k) * DM + col); }
    __device__ void epi(int e, int row, int col, const float (&v)[4]) const {
#pragma unroll
        for (int j = 0; j < 4; ++j) p.YB()[(size_t)row * DM + col + j] = f2bf(v[j] + p.b2[(size_t)e * DM + col + j]);
    }
};

__global__ void __launch_bounds__(256) k_combine(Params p) {
    const int lane = threadIdx.x & 63, gw = (blockIdx.x * 256 + threadIdx.x) >> 6, ngw = (gridDim.x * 256) >> 6;
    for (int r = gw; r < NT; r += ngw) {
        float4 v[4];
#pragma unroll
        for (int j = 0; j < 4; ++j) v[j] = *(const float4*)(p.out + (size_t)r * DM + (j * 64 + lane) * 4);
#pragma unroll
        for (int kk = 0; kk < 4; ++kk) { const float w = p.TOPW()[r * 4 + kk]; const bf16_t* y = p.YB() + (size_t)p.SLOTS()[r * 4 + kk] * DM;
#pragma unroll
            for (int j = 0; j < 4; ++j) { const float4 t = ld_bf4(y + (j * 64 + lane) * 4); v[j].x += w * t.x; v[j].y += w * t.y; v[j].z += w * t.z; v[j].w += w * t.w; } }
        float ss = 0.f;
#pragma unroll
        for (int j = 0; j < 4; ++j) ss += v[j].x * v[j].x + v[j].y * v[j].y + v[j].z * v[j].z + v[j].w * v[j].w;
        const float rstd = rsqrtf(wave_sum(ss) * (1.f / DM) + EPS);
#pragma unroll
        for (int j = 0; j < 4; ++j) { const int c = (j * 64 + lane) * 4; const float4 g = *(const float4*)(p.norm_final + c);
            *(float4*)(p.out + (size_t)r * DM + c) = make_float4(v[j].x * rstd * g.x, v[j].y * rstd * g.y, v[j].z * rstd * g.z, v[j].w * rstd * g.w); }
    }
}

#define LAS __attribute__((address_space(3)))
typedef short bf16x8 __attribute__((ext_vector_type(8)));
typedef float f32x4 __attribute__((ext_vector_type(4)));
typedef float f32x2 __attribute__((ext_vector_type(2)));
typedef unsigned u32x4 __attribute__((ext_vector_type(4)));
typedef unsigned u32x2 __attribute__((ext_vector_type(2)));
typedef int v4i __attribute__((ext_vector_type(4)));
typedef int v8i __attribute__((ext_vector_type(8)));

constexpr int MK_THREADS = 512;
constexpr int RING_BYTES = 131072, MISC_OFF = RING_BYTES, MK_LDS = 147456;
constexpr int NIN_PAD = 5632;

namespace pg8 {
constexpr int BM = 256, BK = 64, HALF = 128, HTB = HALF * BK * 2, NXCD = 8, WGM = 8;
__host__ __device__ __forceinline__ int lds_byte(int r, int c) { const int st = (r >> 4) * 2 + (c >> 5), rr = r & 15, cc = c & 31, ob = rr * 64 + cc * 2; return st * 1024 + (ob ^ (((ob >> 9) & 1) << 5)); }
__host__ __device__ __forceinline__ void stage_rc(int b, int& R, int& C) { const int st = b / 1024, sb = b % 1024, swz = sb ^ (((sb >> 9) & 1) << 5); R = (st >> 1) * 16 + swz / 64; C = (st & 1) * 32 + (swz % 64) / 2; }
__host__ __device__ __forceinline__ int perm32(int rho) { const int n = rho >> 4, i = rho & 15; return 8 * (i >> 2) + 4 * n + (i & 3); }
__device__ __forceinline__ unsigned cvt_pk_bf16(float lo, float hi) { unsigned r; asm volatile("v_cvt_pk_bf16_f32 %0, %1, %2" : "=v"(r) : "v"(lo), "v"(hi)); return r; }

struct Unit { int pm, pn, e; const char* A; const char* B; };

struct StaticOrder {
    int nM, nN, nwg, G, c; const char* A; const char* Bt; size_t btile;
    __device__ void init(int M, int N, int K, int G_, int c_, const void* A_, const void* Bt_) { nM = M / BM; nN = N / BM; nwg = nM * nN; G = G_; c = c_; A = (const char*)A_; Bt = (const char*)Bt_; btile = (size_t)BM * K * 2; }
    __device__ bool next(int i, Unit& u) const {
        const long L = (long)i * G + c; if (L >= nwg) return false;
        int wgid = (int)L; { const int q = nwg / NXCD, r = nwg % NXCD, xcd = wgid % NXCD, off = wgid / NXCD; wgid = (xcd < r ? xcd * (q + 1) : r * (q + 1) + (xcd - r) * q) + off; }
        const int nig = WGM * nN, gid = wgid / nig, fm = gid * WGM, gsz = (nM - fm) < WGM ? (nM - fm) : WGM;
        u.pm = fm + ((wgid % nig) % gsz); u.pn = (wgid % nig) / gsz; u.e = 0; u.A = A; u.B = Bt + (size_t)u.pn * btile; return true;
    }
    __device__ __forceinline__ int arow(int r) const { return r; }
    __device__ __forceinline__ int arow_l(const volatile LAS int*, int r, int) const { return r; }
    __device__ __forceinline__ const int* rows_src(const Unit&, int) const { return nullptr; }
    static constexpr bool HAS_BIAS = false;
    __device__ __forceinline__ const float* bias_src(const Unit&, int) const { return nullptr; }
};
template <int NN> struct StaticOrderN {
    static constexpr int nM = NT / BM, nwg = nM * NN, nig = WGM * NN;
    static_assert(nM % WGM == 0, "row groups are full");
    int G, c; const char* A; const char* Bt; size_t btile;
    __device__ void init(int K, int G_, int c_, const void* A_, const void* Bt_) { G = G_; c = c_; A = (const char*)A_; Bt = (const char*)Bt_; btile = (size_t)BM * K * 2; }
    __device__ bool next(int i, Unit& u) const {
        const int L = i * G + c; if (L >= nwg) return false;
        constexpr int q = nwg / NXCD, r = nwg % NXCD; const int xcd = L & (NXCD - 1), off = L >> 3;
        const int wgid = (xcd < r ? xcd * (q + 1) : r * (q + 1) + (xcd - r) * q) + off;
        const int gid = wgid / nig, rem = wgid - gid * nig;
        u.pm = gid * WGM + (rem & (WGM - 1)); u.pn = rem >> 3; u.e = 0; u.A = A; u.B = Bt + (size_t)u.pn * btile; return true;
    }
    __device__ __forceinline__ int arow(int r) const { return r; }
    __device__ __forceinline__ int arow_l(const volatile LAS int*, int r, int) const { return r; }
    __device__ __forceinline__ const int* rows_src(const Unit&, int) const { return nullptr; }
    static constexpr bool HAS_BIAS = false;
    __device__ __forceinline__ const float* bias_src(const Unit&, int) const { return nullptr; }
};
struct MoeOrder {
    const volatile LAS int* tstart;
    int npn, G, c; const char* A; const char* W; size_t wexp, btile; const int* rowidx;
    const float* bias; int bsplit;
    __device__ bool next(int i, Unit& u) const {
        const long L = (long)i * G + c; const int ntile = tstart[NEXP]; if (L >= (long)ntile * npn) return false;
        const int mt = (int)(L / npn), pn = (int)(L % npn);
        const int k = (int)(threadIdx.x & 31u); const int tv = tstart[k];
        const int e = __builtin_popcount((unsigned)__ballot(k >= 1 && tv <= mt));
        u.pm = mt; u.pn = pn; u.e = e; u.A = A; u.B = W + (size_t)e * wexp + (size_t)pn * btile; return true;
    }
    __device__ __forceinline__ int arow(int r) const { if (!rowidx) return r; const int t = rowidx[r]; return t < 0 ? 0 : t; }
    __device__ __forceinline__ int arow_l(const volatile LAS int* tab, int r, int rl) const { if (!rowidx) return r; const int t = tab[rl]; return t < 0 ? 0 : t; }
    __device__ __forceinline__ const int* rows_src(const Unit& u, int lane) const { return rowidx ? rowidx + (size_t)u.pm * BM + lane * 4 : nullptr; }
    static constexpr bool HAS_BIAS = true;
    __device__ __forceinline__ const float* bias_src(const Unit& u, int lane) const {
        return bsplit ? bias + (size_t)u.e * 2048 + (lane >> 5) * 1024 + u.pn * 128 + (lane & 31) * 4 : bias + (size_t)u.e * 1024 + u.pn * 256 + lane * 4; }
};

template <class Epi, class Sched, bool F8 = false>
__device__ __forceinline__ void gemm_phase(LAS unsigned char* lds, const int K, const int lda, const Sched& S, const Epi& E) {
    const int tid = threadIdx.x, wid = __builtin_amdgcn_readfirstlane(tid >> 6), lane = tid & 63, wr = wid >> 2, wc = wid & 3, fr = lane & 15, fq = lane >> 4;
    const int nt = K / BK;
    unsigned voffB[2];
#pragma unroll
    for (int i = 0; i < 2; ++i) { int R, C; stage_rc(tid * 16 + i * 8192, R, C); const int Rb = Epi::PERM ? ((R & ~31) + perm32(R & 31)) : R; voffB[i] = (unsigned)(Rb * K + C) * 2u; }
    const size_t kstep = (size_t)(BK * 2);
    const size_t hstepB = (size_t)HALF * K * 2;
    const unsigned ldsw = (unsigned)wid * 1024u;
    const int aoff = lds_byte(wr * 64 + fr, fq * 8), boff = lds_byte(wc * 32 + fr, fq * 8);
#define PG8_SA(b, h) (((b) * 2 + (h)) * HTB)
#define PG8_SB(b, h) ((4 + (b) * 2 + (h)) * HTB)
#define PG8_STAGE(bufoff, gbase, voff) do { _Pragma("unroll") for (int _i = 0; _i < 2; ++_i) \
        __builtin_amdgcn_global_load_lds((const unsigned*)((const char*)(gbase) + (voff)[_i]), (LAS unsigned*)(lds + (bufoff) + ldsw + _i * 8192), 16, 0, 0); } while (0)
#define PG8_STAGE_B(bufoff, gbase) do { if constexpr (F8) { const u32x2 vo_ = *(const LAS u32x2*)vslot; const unsigned vv_[2] = {vo_[0], vo_[1]}; PG8_STAGE(bufoff, gbase, vv_); } else PG8_STAGE(bufoff, gbase, voffB); } while (0)
#define PG8_STAGE_A(bufoff, gbase, h) do { if constexpr (F8) { const u32x2 vo_ = *(const LAS u32x2*)(vslot + 2 + 2 * (h)); const unsigned vv_[2] = {vo_[0], vo_[1]}; PG8_STAGE(bufoff, gbase, vv_); } else PG8_STAGE(bufoff, gbase, vc[h]); } while (0)
#define PG8_LDA(dst, b, h) do { _Pragma("unroll") for (int m = 0; m < 4; ++m) _Pragma("unroll") for (int k = 0; k < 2; ++k) dst[m][k] = *(const LAS bf16x8*)(lds + PG8_SA(b, h) + aoff + m * 2048 + k * 1024); } while (0)
#define PG8_LDB(dst, b, h) do { _Pragma("unroll") for (int n = 0; n < 2; ++n) _Pragma("unroll") for (int k = 0; k < 2; ++k) dst[n][k] = *(const LAS bf16x8*)(lds + PG8_SB(b, h) + boff + n * 2048 + k * 1024); } while (0)
#define PG8_MMA(ai, bj, At, Bt) do { __builtin_amdgcn_s_setprio(1); _Pragma("unroll") for (int m = 0; m < 4; ++m) _Pragma("unroll") for (int n = 0; n < 2; ++n) _Pragma("unroll") for (int k = 0; k < 2; ++k) \
        acc[ai][bj][m][n] = __builtin_amdgcn_mfma_f32_16x16x32_bf16(Bt[n][k], At[m][k], acc[ai][bj][m][n], 0, 0, 0); __builtin_amdgcn_s_setprio(0); } while (0)
#define PG8_LDA8(dst, b, h) do { _Pragma("unroll") for (int m = 0; m < 4; ++m) dst[m] = __builtin_shufflevector(*(const LAS v4i*)(lds + PG8_SA(b, h) + aoff + m * 2048), *(const LAS v4i*)(lds + PG8_SA(b, h) + aoff + m * 2048 + 1024), 0, 1, 2, 3, 4, 5, 6, 7); } while (0)
#define PG8_LDB8(dst, b, h) do { _Pragma("unroll") for (int n = 0; n < 2; ++n) dst[n] = __builtin_shufflevector(*(const LAS v4i*)(lds + PG8_SB(b, h) + boff + n * 2048), *(const LAS v4i*)(lds + PG8_SB(b, h) + boff + n * 2048 + 1024), 0, 1, 2, 3, 4, 5, 6, 7); } while (0)
#define PG8_MMA8(ai, bj, At, Bt) do { __builtin_amdgcn_s_setprio(1); _Pragma("unroll") for (int m = 0; m < 4; ++m) _Pragma("unroll") for (int n = 0; n < 2; ++n) \
        acc[ai][bj][m][n] = __builtin_amdgcn_mfma_scale_f32_16x16x128_f8f6f4(Bt[n], At[m], acc[ai][bj][m][n], 0, 0, 0, 122, 0, 127); __builtin_amdgcn_s_setprio(0); } while (0)
#define PG8_XLDA(b, h) do { if constexpr (F8) PG8_LDA8(At8, b, h); else PG8_LDA(At, b, h); } while (0)
#define PG8_XLDB0(b, h) do { if constexpr (F8) PG8_LDB8(B08, b, h); else PG8_LDB(B0, b, h); } while (0)
#define PG8_XLDB1(b, h) do { if constexpr (F8) PG8_LDB8(B18, b, h); else PG8_LDB(B1, b, h); } while (0)
#define PG8_XMM0(ai, bj) do { if constexpr (F8) PG8_MMA8(ai, bj, At8, B08); else PG8_MMA(ai, bj, At, B0); } while (0)
#define PG8_XMM1(ai, bj) do { if constexpr (F8) PG8_MMA8(ai, bj, At8, B18); else PG8_MMA(ai, bj, At, B1); } while (0)
#define PG8_WAIT_V(n) asm volatile("s_waitcnt vmcnt(" #n ")" ::: "memory")
#define PG8_WAIT_L(n) asm volatile("s_waitcnt lgkmcnt(" #n ")" ::: "memory")
#define PG8_BAR __builtin_amdgcn_s_barrier()
#define PG8_SCHED __builtin_amdgcn_sched_barrier(0)
#define PG8_VOFFL(dst, u) do { int _tt = tid; asm volatile("" : "+v"(_tt)); _Pragma("unroll") for (int _i = 0; _i < 2; ++_i) { int _R, _C; stage_rc(_tt * 16 + _i * 8192, _R, _C); \
        _Pragma("unroll") for (int _h = 0; _h < 2; ++_h) dst[_h][_i] = (unsigned)(S.arow_l(rowtab, (u).pm * BM + _h * HALF + _R, _h * HALF + _R) * lda + _C) * 2u; } } while (0)
#define PG8_VOFF(dst, u) do { int _tt = tid; asm volatile("" : "+v"(_tt)); _Pragma("unroll") for (int _i = 0; _i < 2; ++_i) { int _R, _C; stage_rc(_tt * 16 + _i * 8192, _R, _C); \
        _Pragma("unroll") for (int _h = 0; _h < 2; ++_h) dst[_h][_i] = (unsigned)(S.arow((u).pm * BM + _h * HALF + _R) * lda + _C) * 2u; } } while (0)
    constexpr bool HB = Sched::HAS_BIAS;
    LAS float* bias_l = (LAS float*)(lds + MISC_OFF + 13312);
    volatile LAS int* rowtab = (volatile LAS int*)(lds + MISC_OFF + 14336);
#define PG8_ROWS(u) do { if constexpr (HB) { const int* rs_ = S.rows_src(u, lane); if (wid == 0 && rs_) __builtin_amdgcn_global_load_lds((const unsigned*)rs_, (LAS unsigned*)(lds + MISC_OFF + 14336), 16, 0, 0); } } while (0)
#define PG8_BIAS(u) do { if constexpr (HB) { if (wid == 0) __builtin_amdgcn_global_load_lds((const unsigned*)S.bias_src(u, lane), (LAS unsigned*)bias_l, 16, 0, 0); } } while (0)
#define PG8_ACC_INIT() do { f32x4 bv_[2][2]; _Pragma("unroll") for (int b = 0; b < 2; ++b) _Pragma("unroll") for (int n = 0; n < 2; ++n) { \
        if constexpr (HB) bv_[b][n] = *(const LAS f32x4*)(bias_l + b * 128 + wc * 32 + 8 * fq + 4 * n); else bv_[b][n] = (f32x4){0.f, 0.f, 0.f, 0.f}; } \
        _Pragma("unroll") for (int a = 0; a < 2; ++a) _Pragma("unroll") for (int b = 0; b < 2; ++b) _Pragma("unroll") for (int m = 0; m < 4; ++m) _Pragma("unroll") for (int n = 0; n < 2; ++n) acc[a][b][m][n] = bv_[b][n]; } while (0)
    Unit cur, nxt; int ui = 0;
    if (!S.next(0, cur)) return;
    f32x4 acc[2][2][4][2];
    bf16x8 At[4][2], B0[2][2], B1[2][2]; v8i At8[4], B08[2], B18[2];
    unsigned vc[2][2], vn[2][2];
    LAS unsigned* vslot = (LAS unsigned*)(lds + MISC_OFF + 1024) + tid * 6;
    PG8_VOFF(vc, cur);
    if constexpr (F8) { vslot[0] = voffB[0]; vslot[1] = voffB[1]; vslot[2] = vc[0][0]; vslot[3] = vc[0][1]; vslot[4] = vc[1][0]; vslot[5] = vc[1][1]; }
    const char* cA = cur.A; const char* cB = cur.B;
    PG8_BIAS(cur);
    PG8_STAGE_B(PG8_SB(0, 0), cB); PG8_STAGE_B(PG8_SB(0, 1), cB + hstepB); PG8_STAGE_A(PG8_SA(0, 0), cA, 0); PG8_STAGE_A(PG8_SA(0, 1), cA, 1);
    if (wr == 1) PG8_BAR;
    PG8_WAIT_V(2); PG8_BAR;
    PG8_STAGE_B(PG8_SB(1, 0), cB + kstep); PG8_STAGE_A(PG8_SA(1, 0), cA + kstep, 0); PG8_STAGE_B(PG8_SB(1, 1), cB + hstepB + kstep);
    PG8_WAIT_V(6); PG8_BAR;
    PG8_ACC_INIT();
    for (;;) {
        const bool has_next = S.next(ui + 1, nxt);
        const char* nA = has_next ? nxt.A : cA; const char* nB = has_next ? nxt.B : cB;
#pragma unroll 1
        for (int t = 0; t < nt; t += 2) {
            const bool last = (t == nt - 2);
            const char* a1 = cA + (size_t)(t + 1) * kstep;
            const char* a2 = last ? nA : cA + (size_t)(t + 2) * kstep; const char* b2 = last ? nB : cB + (size_t)(t + 2) * kstep;
            const char* a3 = a2 + kstep; const char* b3 = b2 + kstep;
            if constexpr (HB) { if (t == nt - 4 && has_next) PG8_ROWS(nxt); }
            if (last && has_next) { if constexpr (HB) { PG8_VOFFL(vn, nxt); } else { PG8_VOFF(vn, nxt); } PG8_BIAS(nxt); }
            PG8_XLDB0(0, 0); PG8_XLDB1(0, 1); PG8_SCHED; PG8_XLDA(0, 0); PG8_STAGE_A(PG8_SA(1, 1), a1, 1);
            PG8_WAIT_V(8); PG8_WAIT_L(0); PG8_BAR; PG8_XMM0(0, 0); PG8_XMM1(0, 1); PG8_BAR; PG8_SCHED;
            if (last && has_next) {
                if constexpr (F8) { vslot[2] = vn[0][0]; vslot[3] = vn[0][1]; vslot[4] = vn[1][0]; vslot[5] = vn[1][1]; }
                else {
#pragma unroll
                for (int h = 0; h < 2; ++h)
#pragma unroll
                    for (int i = 0; i < 2; ++i) vc[h][i] = vn[h][i];
                }
            }
            PG8_XLDA(0, 1); PG8_STAGE_B(PG8_SB(0, 0), b2); PG8_STAGE_B(PG8_SB(0, 1), b2 + hstepB); PG8_STAGE_A(PG8_SA(0, 0), a2, 0);
            PG8_WAIT_V(8); PG8_WAIT_L(0); PG8_BAR; PG8_XMM0(1, 0); PG8_XMM1(1, 1); PG8_BAR; PG8_SCHED;
            PG8_XLDB0(1, 0); PG8_XLDB1(1, 1); PG8_SCHED; PG8_XLDA(1, 0); PG8_STAGE_A(PG8_SA(0, 1), a2, 1);
            PG8_WAIT_V(8); PG8_WAIT_L(0); PG8_BAR; PG8_XMM0(0, 0); PG8_XMM1(0, 1); PG8_BAR; PG8_SCHED;
            PG8_XLDA(1, 1); PG8_STAGE_B(PG8_SB(1, 0), b3); PG8_STAGE_B(PG8_SB(1, 1), b3 + hstepB); PG8_STAGE_A(PG8_SA(1, 0), a3, 0);
            PG8_WAIT_V(8); PG8_WAIT_L(0); PG8_BAR; PG8_XMM0(1, 0); PG8_XMM1(1, 1); PG8_BAR; PG8_SCHED;
        }
        if (wr == 0) PG8_BAR;
        E(acc, cur, wr, wc, fr, fq);
        if (!has_next) break;
        PG8_ACC_INIT();
        cur = nxt; cA = nA; cB = nB; ++ui;
        if (wr == 1) PG8_BAR;
    }
    PG8_WAIT_V(0);
    PG8_BAR;
#undef PG8_SA
#undef PG8_SB
#undef PG8_STAGE
#undef PG8_STAGE_A
#undef PG8_STAGE_B
#undef PG8_LDA
#undef PG8_LDB
#undef PG8_MMA
#undef PG8_MMA8
#undef PG8_LDA8
#undef PG8_LDB8
#undef PG8_XLDA
#undef PG8_XLDB0
#undef PG8_XLDB1
#undef PG8_XMM0
#undef PG8_XMM1
#undef PG8_WAIT_V
#undef PG8_WAIT_L
#undef PG8_BAR
#undef PG8_SCHED
#undef PG8_VOFF
#undef PG8_VOFFL
#undef PG8_ROWS
#undef PG8_BIAS
#undef PG8_ACC_INIT
}
}

__device__ __forceinline__ unsigned pk4_fp8(float a, float b, float c, float d) { int p = 0; p = __builtin_amdgcn_cvt_pk_fp8_f32(a, b, p, false); p = __builtin_amdgcn_cvt_pk_fp8_f32(c, d, p, true); return (unsigned)p; }
constexpr float W8_SCALE = 32.f;
__device__ __forceinline__ void st8_bf16(bf16_t* dst, const f32x4 v0, const f32x4 v1) {
    u32x4 w; w.x = pg8::cvt_pk_bf16(v0[0], v0[1]); w.y = pg8::cvt_pk_bf16(v0[2], v0[3]); w.z = pg8::cvt_pk_bf16(v1[0], v1[1]); w.w = pg8::cvt_pk_bf16(v1[2], v1[3]);
    *(u32x4*)dst = w;
}
__device__ __forceinline__ void ld8_bf16(const bf16_t* src, f32x4& v0, f32x4& v1) {
    const u32x4 w = *(const u32x4*)src;
    v0 = (f32x4){__uint_as_float(w.x << 16), __uint_as_float(w.x & 0xffff0000u), __uint_as_float(w.y << 16), __uint_as_float(w.y & 0xffff0000u)};
    v1 = (f32x4){__uint_as_float(w.z << 16), __uint_as_float(w.z & 0xffff0000u), __uint_as_float(w.w << 16), __uint_as_float(w.w & 0xffff0000u)};
}
__device__ __forceinline__ f32x4 sig4(f32x4 v) {
    f32x4 e = v * -1.4426950408889634f;
#pragma unroll
    for (int j = 0; j < 4; ++j) e[j] = __builtin_amdgcn_exp2f(e[j]);
    e = e + 1.f;
#pragma unroll
    for (int j = 0; j < 4; ++j) e[j] = __builtin_amdgcn_rcpf(e[j]);
    return e;
}

template <int PART> struct EpiIn {
    static constexpr bool PERM = true;
    Params p;
    __device__ __forceinline__ void operator()(const f32x4 (&acc)[2][2][4][2], const pg8::Unit& u, int wr, int wc, int fr, int fq) const {
        const int pn = u.pn; const size_t row0 = (size_t)u.pm * 256 + wr * 64 + fr; const int cl0 = wc * 32 + 8 * fq;
        if (PART == 1 || pn < 21) {
            bf16_t* base; int ld, c0; int mode;
            if (PART != 1 && pn < 2) { base = p.Qm(); ld = 512; c0 = pn * 256; mode = 1; }
            else if (PART != 1 && pn < 4) { base = p.Km(); ld = 512; c0 = (pn - 2) * 256; mode = 0; }
            else if (PART != 1 && pn < 8) { base = p.Vm(); ld = 1024; c0 = (pn - 4) * 256; mode = 0; }
            else if (PART != 0 && pn < 12) { base = p.OG(); ld = 1024; c0 = (pn - 8) * 256; mode = 2; }
            else if (PART != 0 && pn < 20) { base = p.GATE(); ld = 2048; c0 = (pn - 12) * 256; mode = 2; }
            else { base = nullptr; ld = 256; c0 = 0; mode = 3; }
#pragma unroll
            for (int ai = 0; ai < 2; ++ai)
#pragma unroll
                for (int m = 0; m < 4; ++m) { const size_t r = row0 + ai * 128 + m * 16;
#pragma unroll
                    for (int bj = 0; bj < 2; ++bj) { f32x4 v0 = acc[ai][bj][m][0], v1 = acc[ai][bj][m][1]; const int c = c0 + bj * 128 + cl0;
                        if (PART != 1 && mode == 3) { float* d = p.CQ() + r * 256 + c; *(f32x4*)d = v0; *(f32x4*)(d + 4) = v1; }
                        else { if (PART != 1 && mode == 1) { v0 = v0 * 0.125f; v1 = v1 * 0.125f; } else if (PART != 0 && mode == 2) { v0 = sig4(v0); v1 = sig4(v1); }
                               st8_bf16(base + r * ld + c, v0, v1); } } }
        } else if (PART != 1) {
#pragma unroll
            for (int ai = 0; ai < 2; ++ai)
#pragma unroll
                for (int m = 0; m < 4; ++m) { const size_t r = row0 + ai * 128 + m * 16;
                    { float* d = p.CKV() + r * 128 + cl0; *(f32x4*)d = acc[ai][0][m][0]; *(f32x4*)(d + 4) = acc[ai][0][m][1]; }
                    const f32x4 v0 = acc[ai][1][m][0], v1 = acc[ai][1][m][1];
                    if (wc < 2) { float* d = p.KR() + r * 64 + cl0; *(f32x4*)d = v0; *(f32x4*)(d + 4) = v1; }
                    else if (wc == 2) { const int g = 8 * (fq & 1);
                        if (fq < 2) { float* d = p.GI() + r * 16 + g; const f32x4 b0 = *(const f32x4*)(p.m_b_i + g), b1 = *(const f32x4*)(p.m_b_i + g + 4); *(f32x4*)d = v0 + b0; *(f32x4*)(d + 4) = v1 + b1; }
                        else { float* d = p.GF() + r * 16 + g; const f32x4 b0 = *(const f32x4*)(p.m_b_f + g), b1 = *(const f32x4*)(p.m_b_f + g + 4);
                            *(f32x4*)d = (f32x4){logsigmoidf_(v0[0] + b0[0]), logsigmoidf_(v0[1] + b0[1]), logsigmoidf_(v0[2] + b0[2]), logsigmoidf_(v0[3] + b0[3])};
                            *(f32x4*)(d + 4) = (f32x4){logsigmoidf_(v1[0] + b1[0]), logsigmoidf_(v1[1] + b1[1]), logsigmoidf_(v1[2] + b1[2]), logsigmoidf_(v1[3] + b1[3])}; } } }
        }
    }
};
template <int PART> struct EpiInP {
    static constexpr bool PERM = true;
    Params p;
    __device__ __forceinline__ void operator()(const f32x4 (&acc)[2][2][4][2], const pg8::Unit& u, int wr, int wc, int fr, int fq) const {
        pg8::Unit v = u; v.pn = PART == 0 ? (u.pn < 8 ? u.pn : u.pn + 12) : u.pn + 8;
        EpiIn<PART> E{p}; E(acc, v, wr, wc, fr, fq);
    }
};
struct EpiQ {
    static constexpr bool PERM = true;
    Params p;
    __device__ __forceinline__ void operator()(const f32x4 (&acc)[2][2][4][2], const pg8::Unit& u, int wr, int wc, int fr, int fq) const {
        const size_t row0 = (size_t)u.pm * 256 + wr * 64 + fr;
#pragma unroll
        for (int ai = 0; ai < 2; ++ai)
#pragma unroll
            for (int m = 0; m < 4; ++m) { const size_t r = row0 + ai * 128 + m * 16; const float rs = p.RSQ()[r] * QSCALE; const int pos = NMETA + (int)(r & (SEQ - 1));
#pragma unroll
                for (int bj = 0; bj < 2; ++bj) { const int c = u.pn * 256 + bj * 128 + wc * 32 + 8 * fq; const int local = c % 192;
                    f32x4 v0 = acc[ai][bj][m][0] * rs, v1 = acc[ai][bj][m][1] * rs;
                    if (local >= 128) { const int i0 = (local - 128) >> 1; const float* rp = p.ROPE() + ((size_t)pos * 32 + i0) * 2;
                        const f32x4 cs0 = *(const f32x4*)rp, cs1 = *(const f32x4*)(rp + 4);
                        const f32x4 o0 = (f32x4){v0[0] * cs0[0] - v0[1] * cs0[1], v0[0] * cs0[1] + v0[1] * cs0[0], v0[2] * cs0[2] - v0[3] * cs0[3], v0[2] * cs0[3] + v0[3] * cs0[2]};
                        const f32x4 o1 = (f32x4){v1[0] * cs1[0] - v1[1] * cs1[1], v1[0] * cs1[1] + v1[1] * cs1[0], v1[2] * cs1[2] - v1[3] * cs1[3], v1[2] * cs1[3] + v1[3] * cs1[2]};
                        v0 = o0; v1 = o1; }
                    st8_bf16(p.QP() + r * 1536 + c, v0, v1); }
                asm volatile("" ::: "memory"); }
    }
};
template <int PASS> struct EpiMix {
    static constexpr bool PERM = true;
    Params p;
    __device__ __forceinline__ void operator()(const f32x4 (&acc)[2][2][4][2], const pg8::Unit& u, int wr, int wc, int fr, int fq) const {
        const size_t row0 = (size_t)u.pm * 256 + wr * 64 + fr;
#pragma unroll
        for (int ai = 0; ai < 2; ++ai)
#pragma unroll
            for (int m = 0; m < 4; ++m) { const size_t r = row0 + ai * 128 + m * 16;
#pragma unroll
                for (int bj = 0; bj < 2; ++bj) { const int c = u.pn * 256 + bj * 128 + wc * 32 + 8 * fq;
                    f32x4 g0, g1; ld8_bf16(p.GATE() + r * 2048 + PASS * 1024 + c, g0, g1);
                    f32x4 v0 = acc[ai][bj][m][0] * g0, v1 = acc[ai][bj][m][1] * g1;
                    if (PASS == 1) { f32x4 m0, m1; ld8_bf16(p.MIX() + r * 1024 + c, m0, m1); v0 = v0 + m0; v1 = v1 + m1; }
                    st8_bf16(p.MIX() + r * 1024 + c, v0, v1); } }
    }
};
struct EpiOut {
    static constexpr bool PERM = false;
    Params p;
    __device__ __forceinline__ void operator()(const f32x4 (&acc)[2][2][4][2], const pg8::Unit& u, int wr, int wc, int fr, int fq) const {
        const size_t row0 = (size_t)u.pm * 256 + wr * 64 + fr; const int col0 = u.pn * 256 + wc * 32 + 4 * fq;
#pragma unroll
        for (int ai = 0; ai < 2; ++ai)
#pragma unroll
            for (int m = 0; m < 4; ++m) { const size_t off = (row0 + ai * 128 + m * 16) * DM + col0;
#pragma unroll
                for (int bj = 0; bj < 2; ++bj)
#pragma unroll
                    for (int n = 0; n < 2; ++n) { const f32x4 xv = *(const f32x4*)(p.x + off + bj * 128 + n * 16); *(f32x4*)(p.out + off + bj * 128 + n * 16) = xv + acc[ai][bj][m][n]; } }
    }
};
__device__ __forceinline__ f32x4 swiglu4(f32x4 g, f32x4 l) {
    f32x4 gg, ll, e;
#pragma unroll
    for (int j = 0; j < 4; ++j) { gg[j] = __builtin_amdgcn_fmed3f(g[j], -3.0e38f, 7.f); ll[j] = __builtin_amdgcn_fmed3f(l[j], -7.f, 7.f); }
    e = gg * (-1.702f * 1.4426950408889634f);
#pragma unroll
    for (int j = 0; j < 4; ++j) e[j] = __builtin_amdgcn_exp2f(e[j]);
    e = e + 1.f;
#pragma unroll
    for (int j = 0; j < 4; ++j) e[j] = __builtin_amdgcn_rcpf(e[j]);
    const f32x4 t = gg * e;
    return t * ll + t;
}
struct EpiM1 {
    static constexpr bool PERM = true;
    Params p;
    __device__ __forceinline__ void operator()(const f32x4 (&acc)[2][2][4][2], const pg8::Unit& u, int wr, int wc, int fr, int fq) const {
        const size_t row0 = (size_t)u.pm * 256 + wr * 64 + fr; const int c = u.pn * 128 + wc * 32 + 8 * fq;
#pragma unroll
        for (int ai = 0; ai < 2; ++ai)
#pragma unroll
            for (int m = 0; m < 4; ++m) { const size_t r = row0 + ai * 128 + m * 16;
                const f32x4 a0 = swiglu4(acc[ai][0][m][0], acc[ai][1][m][0]), a1 = swiglu4(acc[ai][0][m][1], acc[ai][1][m][1]);
                u32x2 o8; o8.x = pk4_fp8(a0[0], a0[1], a0[2], a0[3]); o8.y = pk4_fp8(a1[0], a1[1], a1[2], a1[3]); *(u32x2*)((unsigned char*)p.ACT() + r * DFF + c) = o8; }
    }
};
struct EpiM2 {
    static constexpr bool PERM = true;
    Params p;
    __device__ __forceinline__ void operator()(const f32x4 (&acc)[2][2][4][2], const pg8::Unit& u, int wr, int wc, int fr, int fq) const {
        const size_t row0 = (size_t)u.pm * 256 + wr * 64 + fr;
#pragma unroll
        for (int bj = 0; bj < 2; ++bj) { const int c = u.pn * 256 + bj * 128 + wc * 32 + 8 * fq;
#pragma unroll
            for (int ai = 0; ai < 2; ++ai)
#pragma unroll
                for (int m = 0; m < 4; ++m) { const size_t r = row0 + ai * 128 + m * 16; st8_bf16(p.YB() + r * DM + c, acc[ai][bj][m][0], acc[ai][bj][m][1]); } }
    }
};

__device__ __forceinline__ float4 ntld4(const float* p) { const f32x4 v = __builtin_nontemporal_load((const f32x4*)p); return make_float4(v[0], v[1], v[2], v[3]); }
__device__ __forceinline__ uint2 ntld2u(const bf16_t* p) { const u32x2 v = __builtin_nontemporal_load((const u32x2*)p); return make_uint2(v[0], v[1]); }
__device__ __forceinline__ unsigned pk2(float lo, float hi) { return (unsigned)f2bf(lo) | ((unsigned)f2bf(hi) << 16); }
struct TrDesc { const float* W; bf16_t* WT; int ldw, K, dr0, sc0, nvalid, k0, f8; };
__device__ __forceinline__ void tr_load(const TrDesc& d, float4 (&v)[16], int lane) {
    const int lr = lane >> 4, lc = (lane & 15) * 4;
#pragma unroll
    for (int i = 0; i < 16; ++i) v[i] = (lc < d.nvalid) ? ntld4(d.W + (size_t)(d.k0 + i * 4 + lr) * d.ldw + d.sc0 + lc) : make_float4(0.f, 0.f, 0.f, 0.f);
}
__device__ __forceinline__ void tr_finish(const TrDesc& d, const float4 (&v)[16], LAS float* scr, int lane) {
    const int lr = lane >> 4, lc = (lane & 15) * 4;
#pragma unroll
    for (int i = 0; i < 16; ++i) { LAS float* q = scr + (i * 4 + lr) * 65 + lc; q[0] = v[i].x; q[1] = v[i].y; q[2] = v[i].z; q[3] = v[i].w; }
    asm volatile("s_waitcnt lgkmcnt(0)" ::: "memory");
    const int c = lane & 7;
    if (d.f8) {
#pragma unroll
        for (int j = 0; j < 8; ++j) { const int n = (lane >> 3) + 8 * j; const LAS float* s = scr + (8 * c) * 65 + n;
            u32x2 o; o.x = pk4_fp8(s[0 * 65] * W8_SCALE, s[1 * 65] * W8_SCALE, s[2 * 65] * W8_SCALE, s[3 * 65] * W8_SCALE); o.y = pk4_fp8(s[4 * 65] * W8_SCALE, s[5 * 65] * W8_SCALE, s[6 * 65] * W8_SCALE, s[7 * 65] * W8_SCALE);
            *(u32x2*)((unsigned char*)d.WT + (size_t)(d.dr0 + n) * d.K + d.k0 + 8 * c) = o; }
    } else {
#pragma unroll
    for (int j = 0; j < 8; ++j) { const int n = (lane >> 3) + 8 * j; const LAS float* s = scr + (8 * c) * 65 + n;
        u32x4 o; o.x = pk2(s[0 * 65], s[1 * 65]); o.y = pk2(s[2 * 65], s[3 * 65]); o.z = pk2(s[4 * 65], s[5 * 65]); o.w = pk2(s[6 * 65], s[7 * 65]);
        *(u32x4*)(d.WT + (size_t)(d.dr0 + n) * d.K + d.k0 + 8 * c) = o; }
    }
    asm volatile("s_waitcnt lgkmcnt(0)" ::: "memory");
}
__device__ __forceinline__ int win_src_col(int np, int& nvalid) {
    nvalid = 64;
    if (np < 3072) return np;
    if (np < 5120) return OFF_G + (np - 3072);
    if (np < 5376) return OFF_CQ + (np - 5120);
    if (np < 5504) return OFF_CKV + (np - 5376);
    if (np < 5568) return OFF_KR + (np - 5504);
    nvalid = 32; return OFF_I;
}

__device__ __forceinline__ void phase_prologue(const Params& p, LAS unsigned char* lds, int vcu, int G, int sub) {
#define SUBP(x) (sub == 0 || sub == (x))
    const int tid = threadIdx.x, lane = tid & 63, wave = tid >> 6;
    const int gw = vcu * 8 + wave, NGW = G * 8;
    LAS float* scr = (LAS float*)(lds + wave * 16640);
    if (SUBP(1)) for (int it = vcu; it < 88; it += G) {
        LAS float* um = (LAS float*)lds;
        LAS float* red = (LAS float*)(lds + 65536);
        __syncthreads();
        for (int j = wave * 2; j < wave * 2 + 2; ++j) {
            const float* src = p.meta + (size_t)j * DM; float4 v[4]; float ss = 0.f;
#pragma unroll
            for (int q = 0; q < 4; ++q) { v[q] = *(const float4*)(src + (q * 64 + lane) * 4); ss += v[q].x * v[q].x + v[q].y * v[q].y + v[q].z * v[q].z + v[q].w * v[q].w; }
            const float rstd = rsqrtf(wave_sum(ss) * (1.f / DM) + EPS);
#pragma unroll
            for (int q = 0; q < 4; ++q) { const int c = (q * 64 + lane) * 4; const float4 g = *(const float4*)(p.norm_mix + c);
                um[j * 1024 + c] = v[q].x * rstd * g.x; um[j * 1024 + c + 1] = v[q].y * rstd * g.y; um[j * 1024 + c + 2] = v[q].z * rstd * g.z; um[j * 1024 + c + 3] = v[q].w * rstd * g.w; }
        }
        __syncthreads();
        const int n = it * 64 + lane; const bool okn = n < DIN;
        float a[16];
#pragma unroll
        for (int j = 0; j < 16; ++j) a[j] = 0.f;
#pragma unroll 8
        for (int kk = 0; kk < 128; ++kk) { const int kq = wave * 128 + kk; const float w = okn ? p.w_in[(size_t)kq * DIN + n] : 0.f;
#pragma unroll
            for (int j = 0; j < 16; ++j) a[j] += um[j * 1024 + kq] * w; }
#pragma unroll
        for (int j = 0; j < 16; ++j) red[(wave * 16 + j) * 64 + lane] = a[j];
        __syncthreads();
        for (int o = tid; o < 1024; o += MK_THREADS) { const int j = o >> 6, nl = o & 63; float s = 0.f;
#pragma unroll
            for (int w8 = 0; w8 < 8; ++w8) s += red[(w8 * 16 + j) * 64 + nl];
            if (it * 64 + nl < DIN) p.ZM()[(size_t)j * DIN + it * 64 + nl] = s; }
        __syncthreads();
    }
    constexpr int I_INA = 16 * 40, I_INB = 16 * 48, I_IN = I_INA + I_INB, I_W1 = NEXP * 16 * 32, I_W2 = NEXP * 16 * 16, I_SQ = 16 * 16;
    constexpr int NITEMS = I_IN + I_W1 + I_W2 + 2 * I_SQ;
    auto decode = [&](int it, TrDesc& d) {
        int r = it;
        if (r < I_INA) { const int kb = r / 40, nb = r % 40, np = nb * 64, nl = np < 2048 ? np : np + 3072; int nv; const int sc = win_src_col(nl, nv); d = TrDesc{p.w_in, p.WinT(), DIN, DM, np, sc, nv, kb * 64, 0}; return; } r -= I_INA;
        if (r < I_INB) { const int kb = r / 48, nb = r % 48, np = nb * 64; int nv; const int sc = win_src_col(2048 + np, nv); d = TrDesc{p.w_in, (bf16_t*)p.WinT8(), DIN, DM, np, sc, nv, kb * 64, 1}; return; } r -= I_INB;
        if (r < I_W1) { const int e = r / 512, q = r % 512, kb = q / 32, nb = q % 32, np = nb * 64, pn = np >> 8, bj = (np >> 7) & 1, j = np & 127;
            d = TrDesc{p.w1 + (size_t)e * DM * 2048, (bf16_t*)((unsigned char*)p.W1T() + (size_t)e * 2048 * DM), 2048, DM, np, 1024 * bj + 128 * pn + j, 64, kb * 64, 1}; return; } r -= I_W1;
        if (r < I_W2) { const int e = r / 256, q = r % 256, kb = q / 16, nb = q % 16; d = TrDesc{p.w2 + (size_t)e * DFF * DM, (bf16_t*)((unsigned char*)p.W2T() + (size_t)e * DM * DFF), DM, DFF, nb * 64, nb * 64, 64, kb * 64, 1}; return; } r -= I_W2;
        if (r < I_SQ) { const int kb = r / 16, nb = r % 16; d = TrDesc{p.w_m_proj, p.WmT(), DM, DM, nb * 64, nb * 64, 64, kb * 64, 0}; return; } r -= I_SQ;
        { const int kb = r / 16, nb = r % 16; d = TrDesc{p.w_out, p.WoutT(), DM, DM, nb * 64, nb * 64, 64, kb * 64, 0}; }
    };
    if (SUBP(2)) {
        float4 va[16], vb[16]; TrDesc da, db; int it = gw;
        if (it < NITEMS) { decode(it, da); tr_load(da, va, lane); }
#pragma unroll 1
        while (it < NITEMS) {
            const int it1 = it + NGW; if (it1 < NITEMS) { decode(it1, db); tr_load(db, vb, lane); }
            tr_finish(da, va, scr, lane);
            if (it1 >= NITEMS) break;
            const int it2 = it1 + NGW; if (it2 < NITEMS) { decode(it2, da); tr_load(da, va, lane); }
            tr_finish(db, vb, scr, lane);
            it = it2;
        }
    }
    if (SUBP(3)) for (int r = gw * 4; r < NT; r += NGW * 4) {
        const float* s0 = p.x + (size_t)r * DM; float4 v[16];
#pragma unroll
        for (int q = 0; q < 4; ++q)
#pragma unroll
            for (int j = 0; j < 4; ++j) v[q * 4 + j] = ntld4(s0 + (size_t)q * DM + (j * 64 + lane) * 4);
        float rs[4];
#pragma unroll
        for (int q = 0; q < 4; ++q) { float s = 0.f;
#pragma unroll
            for (int j = 0; j < 4; ++j) { const float4 t = v[q * 4 + j]; s += t.x * t.x + t.y * t.y + t.z * t.z + t.w * t.w; }
            rs[q] = rsqrtf(wave_sum(s) * (1.f / DM) + EPS); }
#pragma unroll
        for (int j = 0; j < 4; ++j) { const int c = (j * 64 + lane) * 4; const float4 g = *(const float4*)(p.norm_mix + c);
#pragma unroll
            for (int q = 0; q < 4; ++q) { const float4 t = v[q * 4 + j]; const float rr = rs[q];
                const float u0 = t.x * rr * g.x, u1 = t.y * rr * g.y, u2 = t.z * rr * g.z, u3 = t.w * rr * g.w;
                u32x2 o; o.x = pk2(u0, u1); o.y = pk2(u2, u3); *(u32x2*)(p.U() + (size_t)(r + q) * DM + c) = o;
                *(unsigned*)(p.U8() + (size_t)(r + q) * DM + c) = pk4_fp8(u0, u1, u2, u3); } }
    }
    const long gid = (long)vcu * MK_THREADS + tid, gn = (long)G * MK_THREADS;
    if (SUBP(4)) for (long i = gid; i < (long)LTOT * 32; i += gn) {
        const int pos = (int)(i >> 5), f = (int)(i & 31);
        const float freq = powf(10000.f, -(float)f / 32.f), ang = (float)pos * freq; float s, c; sincosf(ang, &s, &c);
        p.ROPE()[i * 2] = c; p.ROPE()[i * 2 + 1] = s;
    }
    const int rot_wo = (vcu + 40) & 255;
    if (SUBP(5)) for (long i = (long)rot_wo * MK_THREADS + tid; i < 8L * 8 * 1024; i += gn) {
        const int n = (int)(i & 1023), hcg = __builtin_amdgcn_readfirstlane((int)(i >> 10)), h = hcg >> 3, c0 = (hcg & 7) * 16;
        const float* ap = p.w_a_proj + (size_t)(h * 128) * DM + n; const float* kv = p.a_w_ukv + ((size_t)c0 * 8 + h) * 256 + 128;
        float acc[16];
#pragma unroll
        for (int q = 0; q < 16; ++q) acc[q] = 0.f;
#pragma unroll 4
        for (int d = 0; d < 128; ++d) { const float b = ap[(size_t)d * DM];
#pragma unroll
            for (int q = 0; q < 16; ++q) acc[q] += kv[(size_t)q * 2048 + d] * b; }
        u32x4 o0, o1; o0.x = pk2(acc[0], acc[1]); o0.y = pk2(acc[2], acc[3]); o0.z = pk2(acc[4], acc[5]); o0.w = pk2(acc[6], acc[7]);
        o1.x = pk2(acc[8], acc[9]); o1.y = pk2(acc[10], acc[11]); o1.z = pk2(acc[12], acc[13]); o1.w = pk2(acc[14], acc[15]);
        bf16_t* dst = p.WoT() + (size_t)n * 1024 + h * 128 + c0; *(u32x4*)dst = o0; *(u32x4*)(dst + 8) = o1;
    }
    if (SUBP(6)) for (int t = ((vcu + 168) & 255) * 8 + wave; t < 8 * 128; t += NGW) {
        const int h = t >> 7, c = t & 127; const float2 kvv = *(const float2*)(p.a_w_ukv + ((size_t)c * 8 + h) * 256 + 2 * lane);
#pragma unroll 1
        for (int r0 = 0; r0 < 256; r0 += 64) { float keep = 0.f;
#pragma unroll 8
            for (int rr = 0; rr < 64; ++rr) { const float2 u = *(const float2*)(p.a_w_uq + ((size_t)(r0 + rr) * 8 + h) * 192 + 2 * lane);
                const float s = wave_sum(u.x * kvv.x + u.y * kvv.y); if (lane == rr) keep = s; }
            p.WqT()[(size_t)(h * 192 + c) * 256 + r0 + lane] = f2bf(keep * p.a_norm_q[r0 + lane]); }
    }
    if (SUBP(6)) for (long i = gid; i < 8L * 64 * 256; i += gn) {
        const int r = (int)(i & 255), hq = (int)(i >> 8), h = hq >> 6, q = hq & 63;
        p.WqT()[(size_t)(h * 192 + 128 + q) * 256 + r] = f2bf(p.a_w_uq[((size_t)r * 8 + h) * 192 + 128 + (q >> 1) + 32 * (q & 1)] * p.a_norm_q[r]);
    }
}

#undef SUBP
__device__ __forceinline__ void phase_kprep(const Params& p, int vcu, int G) {
    const int lane = threadIdx.x & 63, gw = vcu * 8 + (threadIdx.x >> 6), NGW = G * 8;
    const float gk0 = p.a_norm_kv[lane], gk1 = p.a_norm_kv[64 + lane];
    for (int r0 = gw * 4; r0 < NT; r0 += NGW * 4) {
        float c0[4], c1[4], x1[4], x2[4], cs[4], sn[4];
#pragma unroll
        for (int q = 0; q < 4; ++q) { const size_t r = (size_t)r0 + q; const int pos = NMETA + (int)(r & (SEQ - 1));
            c0[q] = p.CKV()[r * 128 + lane]; c1[q] = p.CKV()[r * 128 + 64 + lane];
            const int l32 = lane & 31; x1[q] = p.KR()[r * 64 + l32]; x2[q] = p.KR()[r * 64 + 32 + l32];
            const float2 t = *(const float2*)(p.ROPE() + ((size_t)pos * 32 + l32) * 2); cs[q] = t.x; sn[q] = t.y; }
#pragma unroll
        for (int q = 0; q < 4; ++q) { const size_t r = (size_t)r0 + q; const int b = (int)(r >> 12), key = (int)(r & (SEQ - 1));
            bf16_t* dst = p.Kc() + ((size_t)b * KVROWS + key) * 192;
            const float rstd = rsqrtf(wave_sum(c0[q] * c0[q] + c1[q] * c1[q]) * (1.f / 128.f) + EPS);
            dst[lane] = f2bf(c0[q] * rstd * gk0); dst[64 + lane] = f2bf(c1[q] * rstd * gk1);
            if (lane < 32) *(unsigned*)(dst + 128 + 2 * lane) = pk2(x1[q] * cs[q] - x2[q] * sn[q], x1[q] * sn[q] + x2[q] * cs[q]); }
    }
    for (int i = gw; i < NB * 64; i += NGW) {
        const int b = i >> 6, j = i & 63; bf16_t* dst = p.Kc() + ((size_t)b * KVROWS + SEQ + j) * 192;
        if (j >= NMETA) { dst[lane] = 0; dst[64 + lane] = 0; dst[128 + lane] = 0; continue; }
        const float* ckv = p.ZM() + (size_t)j * DIN + OFF_CKV; const float* kr = p.ZM() + (size_t)j * DIN + OFF_KR;
        const float c0 = ckv[lane], c1 = ckv[64 + lane];
        const float rstd = rsqrtf(wave_sum(c0 * c0 + c1 * c1) * (1.f / 128.f) + EPS);
        dst[lane] = f2bf(c0 * rstd * gk0); dst[64 + lane] = f2bf(c1 * rstd * gk1);
        if (lane < 32) { const float x1 = kr[lane], x2 = kr[32 + lane], cs = p.ROPE()[((size_t)j * 32 + lane) * 2], sn = p.ROPE()[((size_t)j * 32 + lane) * 2 + 1];
            *(unsigned*)(dst + 128 + 2 * lane) = pk2(x1 * cs - x2 * sn, x1 * sn + x2 * cs); }
    }
    for (int r0 = gw * 4; r0 < NT; r0 += NGW * 4) {
        float4 v[4];
#pragma unroll
        for (int q = 0; q < 4; ++q) v[q] = ntld4(p.CQ() + (size_t)(r0 + q) * 256 + lane * 4);
#pragma unroll
        for (int q = 0; q < 4; ++q) { u32x2 o; o.x = pk2(v[q].x, v[q].y); o.y = pk2(v[q].z, v[q].w);
            const float a = __uint_as_float(o.x << 16), b = __uint_as_float(o.x & 0xffff0000u), c = __uint_as_float(o.y << 16), d = __uint_as_float(o.y & 0xffff0000u);
            const float ss = wave_sum(a * a + b * b + c * c + d * d);
            *(u32x2*)(p.CQb() + (size_t)(r0 + q) * 256 + lane * 4) = o;
            if (lane == 0) p.RSQ()[r0 + q] = rsqrtf(ss * (1.f / 256.f) + EPS); }
    }
}

__device__ __forceinline__ void moe_tile_table(const Params& p, volatile LAS int* tst) {
    __syncthreads();
    if (threadIdx.x == 0) { int s = 0; for (int e = 0; e < NEXP; ++e) { tst[e] = s; s += (p.CNT()[e * CNT_STRIDE] + 255) / 256; } tst[NEXP] = s; }
    __syncthreads();
}

namespace att {
using s16x4 = __attribute__((ext_vector_type(4))) short;
using f32x16 = __attribute__((ext_vector_type(16))) float;
constexpr int KN_B = 16384, KR_B = 8192, V_B = 16384;
constexpr int L_KN = 0, L_KR = 2 * KN_B, L_WS = L_KR + 2 * KR_B, L_QR = L_WS + 8 * 256, L_END = L_QR + 8 * 4096;
constexpr float THR = 8.f;
#define KSWZ(row, colB) ((row) * 256 + ((colB) ^ (((((row) & 3) << 2) | (((row) >> 2) & 3)) << 4)))
#define RSWZ(row, colB) ((row) * 128 + ((colB) ^ ((((row) >> 1) & 7) << 4)))
#define SBAR() __builtin_amdgcn_sched_barrier(0)
__device__ __forceinline__ int crow(int r, int hi) { return (r & 3) + 8 * (r >> 2) + 4 * hi; }
__device__ __forceinline__ unsigned cvtpk(float lo, float hi) { unsigned r; asm volatile("v_cvt_pk_bf16_f32 %0, %1, %2" : "=v"(r) : "v"(lo), "v"(hi)); return r; }

__device__ __forceinline__ void partialSM(f32x16& p0, f32x16& p1, float& m_reg, float& alpha) {
    float pmax = p0[0];
#pragma unroll
    for (int r = 1; r < 16; ++r) pmax = fmaxf(pmax, p0[r]);
#pragma unroll
    for (int r = 0; r < 16; ++r) pmax = fmaxf(pmax, p1[r]);
    { auto rr = __builtin_amdgcn_permlane32_swap(__float_as_uint(pmax), __float_as_uint(pmax), false, false);
      pmax = fmaxf(__uint_as_float(rr[0]), __uint_as_float(rr[1])); }
    float mn;
    if (__builtin_expect(__all(pmax - m_reg <= THR), 1)) { mn = m_reg; alpha = 1.f; }
    else { mn = fmaxf(m_reg, pmax); alpha = __builtin_amdgcn_exp2f(m_reg - mn); m_reg = mn; }
#pragma unroll
    for (int r = 0; r < 16; ++r) p0[r] = p0[r] - mn;
#pragma unroll
    for (int r = 0; r < 16; ++r) p1[r] = p1[r] - mn;
#pragma unroll
    for (int r = 0; r < 16; ++r) p0[r] = __builtin_amdgcn_exp2f(p0[r]);
}
__device__ __forceinline__ void finishSM(f32x16& p0, f32x16& p1, float alpha, float& l_reg, bf16x8& pa0, bf16x8& pa1, bf16x8& pa2, bf16x8& pa3) {
#pragma unroll
    for (int r = 0; r < 16; ++r) p1[r] = __builtin_amdgcn_exp2f(p1[r]);
    float ps = 0;
#pragma unroll
    for (int r = 0; r < 16; ++r) ps += p0[r];
#pragma unroll
    for (int r = 0; r < 16; ++r) ps += p1[r];
    { auto rr = __builtin_amdgcn_permlane32_swap(__float_as_uint(ps), __float_as_uint(ps), false, false);
      ps = __uint_as_float(rr[0]) + __uint_as_float(rr[1]); }
    l_reg = l_reg * alpha + ps;
#define PK4(P, BASE, OUT) do { unsigned a0 = cvtpk(P[BASE + 0], P[BASE + 1]), a1 = cvtpk(P[BASE + 2], P[BASE + 3]);   \
    unsigned b0 = cvtpk(P[BASE + 4], P[BASE + 5]), b1 = cvtpk(P[BASE + 6], P[BASE + 7]);                              \
    auto r0 = __builtin_amdgcn_permlane32_swap(a0, b0, false, false); auto r1 = __builtin_amdgcn_permlane32_swap(a1, b1, false, false); \
    u32x4 w = {r0[0], r1[0], r0[1], r1[1]}; OUT = *reinterpret_cast<bf16x8*>(&w); } while (0)
    PK4(p0, 0, pa0); PK4(p0, 8, pa1); PK4(p1, 0, pa2); PK4(p1, 8, pa3);
#undef PK4
}
__device__ __forceinline__ void qkt(f32x16& p0, f32x16& p1, const char* Kn, const char* Kr, const bf16x8* qr, const char* qrl, int r32, int hi) {
    p0 = f32x16{}; p1 = f32x16{};
#pragma unroll
    for (int d0 = 0; d0 < 8; ++d0) { const int cb = (d0 * 16 + hi * 8) * 2;
        const bf16x8 b0 = *reinterpret_cast<const bf16x8*>(Kn + KSWZ(r32, cb));
        const bf16x8 b1 = *reinterpret_cast<const bf16x8*>(Kn + KSWZ(32 + r32, cb));
        p0 = __builtin_amdgcn_mfma_f32_32x32x16_bf16(b0, qr[d0], p0, 0, 0, 0);
        p1 = __builtin_amdgcn_mfma_f32_32x32x16_bf16(b1, qr[d0], p1, 0, 0, 0); }
#pragma unroll
    for (int d0 = 0; d0 < 4; ++d0) { const int cb = (d0 * 16 + hi * 8) * 2;
        const bf16x8 b0 = *reinterpret_cast<const bf16x8*>(Kr + RSWZ(r32, cb));
        const bf16x8 b1 = *reinterpret_cast<const bf16x8*>(Kr + RSWZ(32 + r32, cb));
        const bf16x8 qf = *reinterpret_cast<const bf16x8*>(qrl + d0 * 1024);
        p0 = __builtin_amdgcn_mfma_f32_32x32x16_bf16(b0, qf, p0, 0, 0, 0);
        p1 = __builtin_amdgcn_mfma_f32_32x32x16_bf16(b1, qf, p1, 0, 0, 0); }
}
__device__ __forceinline__ int v_st(int k, int c) { const int kk = (k & ~0xC) | ((k & 4) << 1) | ((k & 8) >> 1); return ((kk >> 3) * 4 + (c >> 5)) * 512 + ((kk & 7) * 32 + (c & 31)) * 2; }
__device__ __forceinline__ int v_rd_base(int lane) { return ((lane & 3) << 3) | (((lane >> 2) & 3) << 6) | (((lane >> 4) & 1) << 5) | (((lane >> 5) & 1) << 8); }
constexpr int v_rd_off(int d0, int ks, int half) { return d0 * 512 + ks * 4096 + half * 2048; }
template <int OFF> __device__ __forceinline__ s16x4 tr_read(int vb) { s16x4 r; asm volatile("ds_read_b64_tr_b16 %0, %1 offset:%2" : "=&v"(r) : "v"(vb), "i"(OFF) : "memory"); return r; }
template <int C> __device__ __forceinline__ void pv_one(f32x16& od, int bt0, int bt1, bf16x8 pa0, bf16x8 pa1, bf16x8 pa2, bf16x8 pa3) {
    const int a0 = bt0 ^ (C << 6), a1 = bt1 ^ (C << 6);
    const s16x4 l0 = tr_read<0>(a0), h0 = tr_read<0>(a1), l1 = tr_read<4096>(a0), h1 = tr_read<4096>(a1);
    const s16x4 l2 = tr_read<8192>(a0), h2 = tr_read<8192>(a1), l3 = tr_read<12288>(a0), h3 = tr_read<12288>(a1);
    asm volatile("s_waitcnt lgkmcnt(0)" ::: "memory"); SBAR();
#define PK(L, H) (bf16x8){L[0], L[1], L[2], L[3], H[0], H[1], H[2], H[3]}
    od = __builtin_amdgcn_mfma_f32_32x32x16_bf16(pa0, PK(l0, h0), od, 0, 0, 0);
    od = __builtin_amdgcn_mfma_f32_32x32x16_bf16(pa1, PK(l1, h1), od, 0, 0, 0);
    od = __builtin_amdgcn_mfma_f32_32x32x16_bf16(pa2, PK(l2, h2), od, 0, 0, 0);
    od = __builtin_amdgcn_mfma_f32_32x32x16_bf16(pa3, PK(l3, h3), od, 0, 0, 0);
#undef PK
}
__device__ __forceinline__ void pv_d0(f32x16* o, int bt0, int bt1, bf16x8 pa0, bf16x8 pa1, bf16x8 pa2, bf16x8 pa3) {
    pv_one<0>(o[0], bt0, bt1, pa0, pa1, pa2, pa3); pv_one<1>(o[1], bt0, bt1, pa0, pa1, pa2, pa3); pv_one<2>(o[2], bt0, bt1, pa0, pa1, pa2, pa3); pv_one<3>(o[3], bt0, bt1, pa0, pa1, pa2, pa3);
}
__device__ __forceinline__ int tr_base(int lane, int t) {
    const int h = lane >> 5, blk = (lane >> 4) & 1, q = (lane & 15) >> 2, p = lane & 3, row = 8 * h + 4 * t + q, ch = 2 * blk + (p >> 1);
    return KSWZ(row, ch * 16) + 8 * (p & 1);
}

__device__ __forceinline__ void attn_unit(const bf16_t* __restrict__ Qb, const bf16_t* __restrict__ Kb, bf16_t* __restrict__ Ob, char* lds) {
    const int tid = threadIdx.x, wid = tid >> 6, lane = tid & 63, r32 = lane & 31, hi = lane >> 5;
    char* Kn_l = lds + L_KN; char* Kr_l = lds + L_KR;
    float* ws = (float*)(lds + L_WS) + wid * 64; float* li_l = ws; float* al_l = ws + 32;
    float m_reg = -1e30f, l_reg = 0; f32x16 o[4] = {}; bf16x8 qr[8];
    const bf16_t* Qw = Qb + (size_t)(wid * 32 + r32) * 1536 + hi * 8;
    char* qrl = lds + L_QR + wid * 4096 + lane * 16;
#pragma unroll
    for (int d0 = 0; d0 < 8; ++d0) qr[d0] = *reinterpret_cast<const bf16x8*>(Qw + d0 * 16);
#pragma unroll
    for (int d0 = 0; d0 < 4; ++d0) *reinterpret_cast<bf16x8*>(qrl + d0 * 1024) = *reinterpret_cast<const bf16x8*>(Qw + (8 + d0) * 16);
    const int sr = tid >> 3, sc8 = tid & 7;
    const int kst0 = KSWZ(sr, sc8 * 16), kst1 = KSWZ(sr, 128 + sc8 * 16), rst = RSWZ(sr, sc8 * 16);
    const int bt0 = (int)(uintptr_t)Kn_l + tr_base(lane, 0), bt1 = (int)(uintptr_t)Kn_l + tr_base(lane, 1);
    bf16x8 s0, s1, s2;
#define SLOAD(mt) do { const bf16_t* kp = Kb + (size_t)((mt) * 64 + sr) * 192 + sc8 * 8; s0 = *reinterpret_cast<const bf16x8*>(kp); s1 = *reinterpret_cast<const bf16x8*>(kp + 64); s2 = *reinterpret_cast<const bf16x8*>(kp + 128); } while (0)
#define SWRITE(b) do { *(bf16x8*)(Kn_l + (b) * KN_B + kst0) = s0; *(bf16x8*)(Kn_l + (b) * KN_B + kst1) = s1; *(bf16x8*)(Kr_l + (b) * KR_B + rst) = s2; } while (0)
#define RESC(a) do { if (__any((a) < 1.f)) { if (hi == 0) al_l[r32] = (a); asm volatile("s_waitcnt lgkmcnt(0)" ::: "memory"); \
        _Pragma("unroll") for (int d = 0; d < 4; ++d) _Pragma("unroll") for (int r = 0; r < 16; ++r) o[d][r] *= al_l[crow(r, hi)]; } } while (0)
    f32x16 pA0, pA1, pB0, pB1; float alA, alB; bf16x8 pa0, pa1, pa2, pa3;
    constexpr int NTL = 65;
    SLOAD(64); asm volatile("s_waitcnt vmcnt(0)" ::: "memory"); SWRITE(0); __syncthreads();
    qkt(pA0, pA1, Kn_l, Kr_l, qr, qrl, r32, hi);
#pragma unroll
    for (int r = 8; r < 16; ++r) pA0[r] = -1e30f;
#pragma unroll
    for (int r = 0; r < 16; ++r) pA1[r] = -1e30f;
    partialSM(pA0, pA1, m_reg, alA);
    SLOAD(0); asm volatile("s_waitcnt vmcnt(0)" ::: "memory"); SWRITE(1); __syncthreads();
#pragma unroll 1
    for (int j = 1; j + 1 < NTL; j += 2) {
        SBAR(); qkt(pB0, pB1, Kn_l + KN_B, Kr_l + KR_B, qr, qrl, r32, hi);
        finishSM(pA0, pA1, alA, l_reg, pa0, pa1, pa2, pa3); SBAR();
        SLOAD(j); SBAR();
        pv_d0(o, bt0, bt1, pa0, pa1, pa2, pa3); partialSM(pB0, pB1, m_reg, alB);
        __syncthreads(); asm volatile("s_waitcnt vmcnt(0)" ::: "memory"); SWRITE(0);
        RESC(alB); __syncthreads();
        SBAR(); qkt(pA0, pA1, Kn_l, Kr_l, qr, qrl, r32, hi);
        finishSM(pB0, pB1, alB, l_reg, pa0, pa1, pa2, pa3); SBAR();
        if (j + 2 < NTL) SLOAD(j + 1); SBAR();
        pv_d0(o, bt0 + KN_B, bt1 + KN_B, pa0, pa1, pa2, pa3); partialSM(pA0, pA1, m_reg, alA);
        __syncthreads(); asm volatile("s_waitcnt vmcnt(0)" ::: "memory"); if (j + 2 < NTL) SWRITE(1);
        RESC(alA); __syncthreads();
    }
    finishSM(pA0, pA1, alA, l_reg, pa0, pa1, pa2, pa3); SBAR();
    pv_d0(o, bt0, bt1, pa0, pa1, pa2, pa3);
    if (hi == 0) li_l[r32] = l_reg; asm volatile("s_waitcnt lgkmcnt(0)" ::: "memory");
    float rli[16];
#pragma unroll
    for (int r = 0; r < 16; ++r) rli[r] = __builtin_amdgcn_rcpf(li_l[crow(r, hi)]);
    bf16_t* Ow = Ob + (size_t)(wid * 32) * 1024;
#pragma unroll
    for (int r = 0; r < 16; ++r) { const int orow = crow(r, hi);
#pragma unroll
        for (int d0 = 0; d0 < 4; ++d0) Ow[(size_t)orow * 1024 + d0 * 32 + r32] = f2bf(o[d0][r] * rli[r]); }
    __syncthreads();
#undef SLOAD
#undef SWRITE
#undef RESC
}
#undef KSWZ
#undef RSWZ
#undef SBAR
}

__device__ __forceinline__ void phase_attn(const Params& p, char* lds, int vcu, int G) {
    for (int u = vcu; u < NB * 8 * 16; u += G) {
        const int b = u >> 7, h = (u >> 4) & 7, qb = u & 15;
        const size_t r0 = (size_t)b * SEQ + qb * 256;
        att::attn_unit(p.QP() + r0 * 1536 + h * 192, p.Kc() + (size_t)b * KVROWS * 192, p.OA() + r0 * 1024 + h * 128, lds);
    }
}

namespace ml {
using att::s16x4; using att::f32x16; using att::crow; using att::cvtpk; using att::v_st; using att::v_rd_base; using att::tr_read; using att::v_rd_off;
#define RSWZ(row, colB) ((row) * 128 + ((colB) ^ ((((row) >> 1) & 7) << 4)))
#define SBAR() __builtin_amdgcn_sched_barrier(0)
__device__ __forceinline__ void pv_blk(f32x16& od, int vb, bf16x8 pa0, bf16x8 pa1, bf16x8 pa2, bf16x8 pa3) {
    const s16x4 l0 = tr_read<v_rd_off(0, 0, 0)>(vb), h0 = tr_read<v_rd_off(0, 0, 1)>(vb), l1 = tr_read<v_rd_off(0, 1, 0)>(vb), h1 = tr_read<v_rd_off(0, 1, 1)>(vb);
    const s16x4 l2 = tr_read<v_rd_off(0, 2, 0)>(vb), h2 = tr_read<v_rd_off(0, 2, 1)>(vb), l3 = tr_read<v_rd_off(0, 3, 0)>(vb), h3 = tr_read<v_rd_off(0, 3, 1)>(vb);
    asm volatile("s_waitcnt lgkmcnt(0)" ::: "memory"); SBAR();
#define PK(L, H) (bf16x8){L[0], L[1], L[2], L[3], H[0], H[1], H[2], H[3]}
    od = __builtin_amdgcn_mfma_f32_32x32x16_bf16(pa0, PK(l0, h0), od, 0, 0, 0);
    od = __builtin_amdgcn_mfma_f32_32x32x16_bf16(pa1, PK(l1, h1), od, 0, 0, 0);
    od = __builtin_amdgcn_mfma_f32_32x32x16_bf16(pa2, PK(l2, h2), od, 0, 0, 0);
    od = __builtin_amdgcn_mfma_f32_32x32x16_bf16(pa3, PK(l3, h3), od, 0, 0, 0);
}
template <int KS0> __device__ __forceinline__ void pv_blk2(f32x16& od, int vb, bf16x8 pa, bf16x8 pb) {
    const s16x4 l0 = tr_read<v_rd_off(0, KS0, 0)>(vb), h0 = tr_read<v_rd_off(0, KS0, 1)>(vb), l1 = tr_read<v_rd_off(0, KS0 + 1, 0)>(vb), h1 = tr_read<v_rd_off(0, KS0 + 1, 1)>(vb);
    asm volatile("s_waitcnt lgkmcnt(0)" ::: "memory"); SBAR();
    od = __builtin_amdgcn_mfma_f32_32x32x16_bf16(pa, PK(l0, h0), od, 0, 0, 0);
    od = __builtin_amdgcn_mfma_f32_32x32x16_bf16(pb, PK(l1, h1), od, 0, 0, 0);
}
__device__ __forceinline__ void tt_blk(f32x16& od, int va, int vb) {
    const s16x4 al0 = tr_read<v_rd_off(0, 0, 0)>(va), ah0 = tr_read<v_rd_off(0, 0, 1)>(va), al1 = tr_read<v_rd_off(0, 1, 0)>(va), ah1 = tr_read<v_rd_off(0, 1, 1)>(va);
    const s16x4 al2 = tr_read<v_rd_off(0, 2, 0)>(va), ah2 = tr_read<v_rd_off(0, 2, 1)>(va), al3 = tr_read<v_rd_off(0, 3, 0)>(va), ah3 = tr_read<v_rd_off(0, 3, 1)>(va);
    const s16x4 l0 = tr_read<v_rd_off(0, 0, 0)>(vb), h0 = tr_read<v_rd_off(0, 0, 1)>(vb), l1 = tr_read<v_rd_off(0, 1, 0)>(vb), h1 = tr_read<v_rd_off(0, 1, 1)>(vb);
    const s16x4 l2 = tr_read<v_rd_off(0, 2, 0)>(vb), h2 = tr_read<v_rd_off(0, 2, 1)>(vb), l3 = tr_read<v_rd_off(0, 3, 0)>(vb), h3 = tr_read<v_rd_off(0, 3, 1)>(vb);
    asm volatile("s_waitcnt lgkmcnt(0)" ::: "memory"); SBAR();
    od = __builtin_amdgcn_mfma_f32_32x32x16_bf16(PK(al0, ah0), PK(l0, h0), od, 0, 0, 0);
    od = __builtin_amdgcn_mfma_f32_32x32x16_bf16(PK(al1, ah1), PK(l1, h1), od, 0, 0, 0);
    od = __builtin_amdgcn_mfma_f32_32x32x16_bf16(PK(al2, ah2), PK(l2, h2), od, 0, 0, 0);
    od = __builtin_amdgcn_mfma_f32_32x32x16_bf16(PK(al3, ah3), PK(l3, h3), od, 0, 0, 0);
#undef PK
}
#define PK4(P, BASE, OUT) do { unsigned a0 = cvtpk(P[BASE + 0], P[BASE + 1]), a1 = cvtpk(P[BASE + 2], P[BASE + 3]);   \
    unsigned b0 = cvtpk(P[BASE + 4], P[BASE + 5]), b1 = cvtpk(P[BASE + 6], P[BASE + 7]);                              \
    auto r0 = __builtin_amdgcn_permlane32_swap(a0, b0, false, false); auto r1 = __builtin_amdgcn_permlane32_swap(a1, b1, false, false); \
    u32x4 w = {r0[0], r1[0], r0[1], r1[1]}; OUT = *reinterpret_cast<bf16x8*>(&w); } while (0)
__device__ __forceinline__ float half_swap_add(float v) { auto rr = __builtin_amdgcn_permlane32_swap(__float_as_uint(v), __float_as_uint(v), false, false); return __uint_as_float(rr[0]) + __uint_as_float(rr[1]); }
__device__ __forceinline__ bf16x8 scale8(bf16x8 v, float s) {
    const u32x4 w = *reinterpret_cast<const u32x4*>(&v); u32x4 o;
    o.x = cvtpk(__uint_as_float(w.x << 16) * s, __uint_as_float(w.x & 0xffff0000u) * s); o.y = cvtpk(__uint_as_float(w.y << 16) * s, __uint_as_float(w.y & 0xffff0000u) * s);
    o.z = cvtpk(__uint_as_float(w.z << 16) * s, __uint_as_float(w.z & 0xffff0000u) * s); o.w = cvtpk(__uint_as_float(w.w << 16) * s, __uint_as_float(w.w & 0xffff0000u) * s);
    return *reinterpret_cast<bf16x8*>(&o);
}
__device__ __forceinline__ bf16x8 f8_to_bf(const float* p, bool ok) {
    if (!ok) return (bf16x8){0, 0, 0, 0, 0, 0, 0, 0};
    const f32x4 a = *(const f32x4*)p, b = *(const f32x4*)(p + 4); u32x4 o = {cvtpk(a[0], a[1]), cvtpk(a[2], a[3]), cvtpk(b[0], b[1]), cvtpk(b[2], b[3])};
    return *reinterpret_cast<bf16x8*>(&o);
}
template <int K> __device__ __forceinline__ float dpp_shr(float v, float ident) {
    return __int_as_float(__builtin_amdgcn_update_dpp(__float_as_int(ident), __float_as_int(v), 0x110 | K, 0xf, 0xf, false));
}
__device__ __forceinline__ float rdlane(float v, int l) { return __int_as_float(__builtin_amdgcn_readlane(__float_as_int(v), l)); }
__device__ __forceinline__ float wave_incl_sum(float v, int lane) {
    v += dpp_shr<1>(v, 0.f); v += dpp_shr<2>(v, 0.f); v += dpp_shr<4>(v, 0.f); v += dpp_shr<8>(v, 0.f);
    const float s0 = rdlane(v, 15), s1 = rdlane(v, 31), s2 = rdlane(v, 47); const int row = lane >> 4;
    return v + (row >= 1 ? s0 : 0.f) + (row >= 2 ? s1 : 0.f) + (row >= 3 ? s2 : 0.f);
}
__device__ __forceinline__ float wave_incl_max(float v, int lane) {
    const float NI = -3.0e38f;
    v = fmaxf(v, dpp_shr<1>(v, NI)); v = fmaxf(v, dpp_shr<2>(v, NI)); v = fmaxf(v, dpp_shr<4>(v, NI)); v = fmaxf(v, dpp_shr<8>(v, NI));
    const float s0 = rdlane(v, 15), s1 = rdlane(v, 31), s2 = rdlane(v, 47); const int row = lane >> 4;
    return fmaxf(fmaxf(v, row >= 1 ? s0 : NI), fmaxf(row >= 2 ? s1 : NI, row >= 3 ? s2 : NI));
}
__device__ __forceinline__ float wave_max(float v) {
    const float NI = -3.0e38f;
    v = fmaxf(v, dpp_shr<1>(v, NI)); v = fmaxf(v, dpp_shr<2>(v, NI)); v = fmaxf(v, dpp_shr<4>(v, NI)); v = fmaxf(v, dpp_shr<8>(v, NI));
    return fmaxf(fmaxf(rdlane(v, 15), rdlane(v, 31)), fmaxf(rdlane(v, 47), rdlane(v, 63)));
}

constexpr int SC_BUF = 32768;
__device__ __forceinline__ void scan_unit(const Params& p, int b, int h, int dir, char* lds) {
    const int tid = threadIdx.x, wid = tid >> 6, lane = tid & 63, r32 = lane & 31, hi = lane >> 5, db = wid & 1, vq = wid >> 1;
    const int sr = tid >> 3, sc8 = tid & 7;
    const int kst = v_st(sr, sc8 * 8), vst0 = v_st(sr, sc8 * 8), vst1 = v_st(sr, 64 + sc8 * 8);
    const int va0 = (int)(uintptr_t)lds + v_rd_base(lane) + db * 512, vb0 = (int)(uintptr_t)lds + 16384 + v_rd_base(lane) + vq * 512;
    bf16_t* CS = dir ? p.CB() : p.CF(); float* NS = dir ? p.NB_() : p.NF(); float* MS = dir ? p.MB() : p.MF();
    const size_t sbase = (size_t)(b * 8 + h) * 64;
    f32x16 acc = {}; float nacc = 0.f, m = 0.f, decay_prev = 1.f;
    const int nsteps = dir ? 64 : 65;
    bf16x8 sk, sv0, sv1; float gli, glf;
#define ML_LOAD(st) do { const int c_ = dir ? 63 - (st) : (st) - 1; \
        if (c_ < 0) { const float* z = p.ZM() + (size_t)(sr & 15) * DIN; const bool okr = sr < NMETA; \
            sk = f8_to_bf(z + OFF_K + h * 64 + sc8 * 8, okr); sv0 = f8_to_bf(z + OFF_V + h * 128 + sc8 * 8, okr); sv1 = f8_to_bf(z + OFF_V + h * 128 + 64 + sc8 * 8, okr); \
            const float* zl = p.ZM() + (size_t)(lane & 15) * DIN; gli = lane < NMETA ? zl[OFF_I + h] + p.m_b_i[h] : -1e30f; glf = lane < NMETA ? logsigmoidf_(zl[OFF_F + h] + p.m_b_f[h]) : 0.f; } \
        else { const size_t r_ = (size_t)b * SEQ + c_ * 64 + sr; sk = *reinterpret_cast<const bf16x8*>(p.Km() + r_ * 512 + h * 64 + sc8 * 8); \
            sv0 = *reinterpret_cast<const bf16x8*>(p.Vm() + r_ * 1024 + h * 128 + sc8 * 8); sv1 = *reinterpret_cast<const bf16x8*>(p.Vm() + r_ * 1024 + h * 128 + 64 + sc8 * 8); \
            const size_t rg = (size_t)b * SEQ + c_ * 64 + (dir ? 63 - lane : lane); gli = p.GI()[rg * 16 + dir * 8 + h]; glf = p.GF()[rg * 16 + dir * 8 + h]; } } while (0)
#define ML_GATES(decay_, mnew_, wk_) do { const float bc_ = wave_incl_sum(glf, lane); const float bl_ = rdlane(bc_, 63); const float g_ = bl_ - bc_ + gli; \
        mnew_ = fmaxf(bl_ + m, wave_max(g_)); decay_ = __expf(bl_ + m - mnew_); wk_ = __expf(g_ - mnew_); } while (0)
    ML_LOAD(0);
    float decay, mnew, wk;
    { asm volatile("s_waitcnt vmcnt(0)" ::: "memory"); ML_GATES(decay, mnew, wk);
      const float w = __shfl(wk, dir ? 63 - sr : sr);
      *(bf16x8*)(lds + kst) = sk; *(bf16x8*)(lds + 16384 + vst0) = scale8(sv0, w); *(bf16x8*)(lds + 16384 + vst1) = scale8(sv1, w); }
    __syncthreads();
#pragma unroll 1
    for (int st = 0; st < nsteps; ++st) {
        const int c = dir ? 63 - st : st - 1, buf = st & 1;
        if (wid == 0 && st > 0) { float s_ = 0.f; const float* np_ = (const float*)(lds + 65536) + ((st - 1) & 1) * 512;
#pragma unroll
            for (int w8 = 0; w8 < 8; ++w8) s_ += np_[w8 * 64 + lane];
            nacc = nacc * decay_prev + s_; }
        if (c >= 0) {
            const size_t sidx = sbase + c; bf16_t* cd = CS + sidx * 8192 + (size_t)(db * 32) * 128 + vq * 32 + r32;
#pragma unroll
            for (int r = 0; r < 16; ++r) cd[(size_t)crow(r, hi) * 128] = f2bf(acc[r]);
            if (wid == 0) NS[sidx * 64 + lane] = nacc;
            if (tid == 0) MS[sidx] = m;
        }
        if (st == nsteps - 1) break;
        if (st + 1 < nsteps - 1) ML_LOAD(st + 1);
#pragma unroll
        for (int r = 0; r < 16; ++r) acc[r] *= decay;
        tt_blk(acc, va0 + buf * SC_BUF, vb0 + buf * SC_BUF);
        {
            float s_ = 0.f;
#pragma unroll
            for (int q = 0; q < 8; ++q) { const int s = wid * 8 + q; const float w = __shfl(wk, dir ? 63 - s : s); s_ += w * bf2f(*(const bf16_t*)(lds + buf * SC_BUF + v_st(s, lane))); }
            ((float*)(lds + 65536))[(st & 1) * 512 + wid * 64 + lane] = s_;
        }
        decay_prev = decay;
        m = mnew;
        if (st + 1 < nsteps - 1) {
            asm volatile("s_waitcnt vmcnt(0)" ::: "memory"); ML_GATES(decay, mnew, wk);
            const float w = __shfl(wk, dir ? 63 - sr : sr); char* lb = lds + (buf ^ 1) * SC_BUF;
            *(bf16x8*)(lb + kst) = sk; *(bf16x8*)(lb + 16384 + vst0) = scale8(sv0, w); *(bf16x8*)(lb + 16384 + vst1) = scale8(sv1, w);
        }
        __syncthreads();
    }
    __syncthreads();
#undef ML_LOAD
#undef ML_GATES
}

constexpr int O_K = 0, O_V = 8192, O_CF = 24576, O_CB = 40960, O_T = 57344, O_ARR = 122880, O_WS = 125440, O_END = 127488;
struct OutPre { bf16x8 kk, v0, v1, f0, f1, b0, b1, q0, q1, q2, q3; float li, lf, mm, nn; };
__device__ __forceinline__ void out_load(const Params& p, int u, OutPre& R) {
    const int tid = threadIdx.x, wid = tid >> 6, lane = tid & 63, r32 = lane & 31, hi = lane >> 5, tb = wid & 1;
    const int b = u >> 9, h = u & 7, c = (u >> 3) & 63; const size_t r0 = (size_t)b * SEQ + c * 64, sidx = (size_t)(b * 8 + h) * 64 + c;
    const int sr = tid >> 3, sc8 = tid & 7;
    R.kk = *reinterpret_cast<const bf16x8*>(p.Km() + (r0 + sr) * 512 + h * 64 + sc8 * 8);
    const bf16_t* vp = p.Vm() + (r0 + sr) * 1024 + h * 128 + sc8 * 8; R.v0 = *reinterpret_cast<const bf16x8*>(vp); R.v1 = *reinterpret_cast<const bf16x8*>(vp + 64);
    const bf16_t* cf = p.CF() + sidx * 8192 + (size_t)sr * 128 + sc8 * 8; R.f0 = *reinterpret_cast<const bf16x8*>(cf); R.f1 = *reinterpret_cast<const bf16x8*>(cf + 64);
    const bf16_t* cb = p.CB() + sidx * 8192 + (size_t)sr * 128 + sc8 * 8; R.b0 = *reinterpret_cast<const bf16x8*>(cb); R.b1 = *reinterpret_cast<const bf16x8*>(cb + 64);
    const bf16_t* qp = p.Qm() + (r0 + tb * 32 + r32) * 512 + h * 64 + hi * 8;
    R.q0 = *reinterpret_cast<const bf16x8*>(qp); R.q1 = *reinterpret_cast<const bf16x8*>(qp + 16); R.q2 = *reinterpret_cast<const bf16x8*>(qp + 32); R.q3 = *reinterpret_cast<const bf16x8*>(qp + 48);
    R.li = 0.f; R.lf = 0.f; R.mm = 0.f; R.nn = 0.f;
    if (wid < 2) { const int dir = wid, t = dir ? 63 - lane : lane; R.li = p.GI()[(r0 + t) * 16 + dir * 8 + h]; R.lf = p.GF()[(r0 + t) * 16 + dir * 8 + h]; R.mm = (dir ? p.MB() : p.MF())[sidx]; }
    else if (wid < 4) { const int dir = wid - 2; R.nn = (dir ? p.NB_() : p.NF())[sidx * 64 + lane]; }
}
__device__ __forceinline__ void phase_mlstm_out_body(const Params& p, char* lds, int vcu, int G) {
    const int tid = threadIdx.x, wid = tid >> 6, lane = tid & 63, r32 = lane & 31, hi = lane >> 5, tb = wid & 1, vq = wid >> 1;
    const int sr = tid >> 3, sc8 = tid & 7;
    float* arr = (float*)(lds + O_ARR);
    float* nbuf = arr + 512;
    float* wsc = (float*)(lds + O_WS) + wid * 64;
    const int NU = NB * 8 * 64;
    OutPre R;
    if (vcu < NU) out_load(p, vcu, R);
#pragma unroll 1
    for (int u = vcu; u < NU; u += G) {
        const int b = u >> 9, h = u & 7, c = (u >> 3) & 63; const size_t r0 = (size_t)b * SEQ + c * 64;
        { *(bf16x8*)(lds + O_K + RSWZ(sr, sc8 * 16)) = R.kk;
          const int s0 = v_st(sr, sc8 * 8), s1 = v_st(sr, 64 + sc8 * 8);
          *(bf16x8*)(lds + O_V + s0) = R.v0; *(bf16x8*)(lds + O_V + s1) = R.v1; *(bf16x8*)(lds + O_CF + s0) = R.f0; *(bf16x8*)(lds + O_CF + s1) = R.f1; *(bf16x8*)(lds + O_CB + s0) = R.b0; *(bf16x8*)(lds + O_CB + s1) = R.b1; }
        if (wid < 2) {
            const int dir = wid, t = dir ? 63 - lane : lane; const float m = R.mm;
            const float bc = wave_incl_sum(R.lf, lane), a = R.li - bc, pm = wave_incl_max(a, lane), mx = fmaxf(m, pm);
            float* ar = arr + dir * 256;
            ar[t] = -mx * 1.4426950408889634f; ar[64 + t] = a * 1.4426950408889634f; ar[128 + t] = __expf(m - mx); ar[192 + t] = __expf(-(bc + mx));
        } else if (wid < 4) nbuf[(wid - 2) * 64 + lane] = R.nn;
        bf16x8 qr[4] = {R.q0, R.q1, R.q2, R.q3};
        __syncthreads();
        if (u + G < NU) out_load(p, u + G, R);
        const int ocol = h * 128 + sc8 * 16; const size_t oo = (r0 + sr) * 1024 + ocol;
        const u32x4 og0 = *(const u32x4*)(p.OG() + oo), og1 = *(const u32x4*)(p.OG() + oo + 8);
        const f32x4 n0 = *(const f32x4*)(p.m_norm + ocol), n1 = *(const f32x4*)(p.m_norm + ocol + 4), n2 = *(const f32x4*)(p.m_norm + ocol + 8), n3 = *(const f32x4*)(p.m_norm + ocol + 12);
        const int dir = (wid >> 1) & 1, vh = wid >> 2;
        float qn;
        { const float* nv = nbuf + dir * 64 + hi * 8; float s_ = 0.f;
#pragma unroll
          for (int d0 = 0; d0 < 4; ++d0) { const u32x4 w = *reinterpret_cast<const u32x4*>(&qr[d0]); const f32x4 n0 = *(const f32x4*)(nv + d0 * 16), n1 = *(const f32x4*)(nv + d0 * 16 + 4);
              s_ += __uint_as_float(w.x << 16) * n0[0] + __uint_as_float(w.x & 0xffff0000u) * n0[1] + __uint_as_float(w.y << 16) * n0[2] + __uint_as_float(w.y & 0xffff0000u) * n0[3]
                  + __uint_as_float(w.z << 16) * n1[0] + __uint_as_float(w.z & 0xffff0000u) * n1[1] + __uint_as_float(w.w << 16) * n1[2] + __uint_as_float(w.w & 0xffff0000u) * n1[3]; }
          qn = half_swap_add(s_); }
        f32x16 p0 = {}, p1 = {};
        const bool has0 = !(dir == 1 && tb == 1), has1 = !(dir == 0 && tb == 0);
#pragma unroll
        for (int d0 = 0; d0 < 4; ++d0) { const int cb = (d0 * 16 + hi * 8) * 2;
            if (has0) { const bf16x8 k0 = *reinterpret_cast<const bf16x8*>(lds + O_K + RSWZ(r32, cb)); p0 = __builtin_amdgcn_mfma_f32_32x32x16_bf16(k0, qr[d0], p0, 0, 0, 0); }
            if (has1) { const bf16x8 k1 = *reinterpret_cast<const bf16x8*>(lds + O_K + RSWZ(32 + r32, cb)); p1 = __builtin_amdgcn_mfma_f32_32x32x16_bf16(k1, qr[d0], p1, 0, 0, 0); } }
        const int t = tb * 32 + r32;
        const int vbase = (int)(uintptr_t)lds + v_rd_base(lane) + vh * 1024;
#define W_FULL(P, W, SB) _Pragma("unroll") for (int g = 0; g < 4; ++g) { const f32x4 ct = *(const f32x4*)(ar + 64 + (SB) + 8 * g + 4 * hi); \
            _Pragma("unroll") for (int q = 0; q < 4; ++q) { const float x = __builtin_amdgcn_exp2f(rt + ct[q]) * P[4 * g + q]; W[4 * g + q] = x; rs += x; } }
#define W_DIAG(P, W, SB) _Pragma("unroll") for (int g = 0; g < 4; ++g) { const f32x4 ct = *(const f32x4*)(ar + 64 + (SB) + 8 * g + 4 * hi); \
            _Pragma("unroll") for (int q = 0; q < 4; ++q) { const int sl = 8 * g + 4 * hi + q; const bool ok = dir ? (sl >= r32) : (sl <= r32); \
                const float x = ok ? __builtin_amdgcn_exp2f(rt + ct[q]) * P[4 * g + q] : 0.f; W[4 * g + q] = x; rs += x; } }
        {
            const float* ar = arr + dir * 256; const float rt = ar[t], sint = ar[128 + t], efl = ar[192 + t];
            f32x16 w0, w1; float rs = 0.f;
            if (tb == 0) { W_DIAG(p0, w0, 0) if (dir == 1) { W_FULL(p1, w1, 32) } }
            else         { W_DIAG(p1, w1, 32) if (dir == 0) { W_FULL(p0, w0, 0) } }
            rs = half_swap_add(rs);
            bf16x8 pa0, pa1, pa2, pa3;
            if (has0) { PK4(w0, 0, pa0); PK4(w0, 8, pa1); }
            if (has1) { PK4(w1, 0, pa2); PK4(w1, 8, pa3); }
            const float den = rs + sint * qn, inv = 1.f / fmaxf(fabsf(den), efl);
            if (hi == 0) { wsc[r32] = sint; wsc[32 + r32] = inv; }
            f32x16 o0 = {}, o1 = {};
            pv_blk(o0, vbase + (dir ? O_CB : O_CF), qr[0], qr[1], qr[2], qr[3]);
            pv_blk(o1, vbase + (dir ? O_CB : O_CF) + 512, qr[0], qr[1], qr[2], qr[3]);
            asm volatile("s_waitcnt lgkmcnt(0)" ::: "memory");
#pragma unroll
            for (int g = 0; g < 4; ++g) { const f32x4 sc = *(const f32x4*)(wsc + 8 * g + 4 * hi);
#pragma unroll
                for (int q = 0; q < 4; ++q) { o0[4 * g + q] *= sc[q]; o1[4 * g + q] *= sc[q]; } }
            if (has0) { pv_blk2<0>(o0, vbase + O_V, pa0, pa1); pv_blk2<0>(o1, vbase + O_V + 512, pa0, pa1); }
            if (has1) { pv_blk2<2>(o0, vbase + O_V, pa2, pa3); pv_blk2<2>(o1, vbase + O_V + 512, pa2, pa3); }
            float* T = (float*)(lds + O_T + dir * 32768) + (size_t)(tb * 32) * 128 + vh * 64 + r32;
#pragma unroll
            for (int g = 0; g < 4; ++g) { const f32x4 sc = *(const f32x4*)(wsc + 32 + 8 * g + 4 * hi);
#pragma unroll
                for (int q = 0; q < 4; ++q) { const int rw = 8 * g + 4 * hi + q; T[rw * 128] = o0[4 * g + q] * sc[q]; T[rw * 128 + 32] = o1[4 * g + q] * sc[q]; } }
        }
#undef W_FULL
#undef W_DIAG
        __syncthreads();
        { const float* T = (const float*)(lds + O_T) + sr * 128 + sc8 * 16; f32x4 v[4]; float ss = 0.f;
#pragma unroll
          for (int q = 0; q < 4; ++q) { v[q] = *(const f32x4*)(T + q * 4) + *(const f32x4*)(T + 8192 + q * 4); ss += v[q][0] * v[q][0] + v[q][1] * v[q][1] + v[q][2] * v[q][2] + v[q][3] * v[q][3]; }
          ss += __shfl_xor(ss, 1); ss += __shfl_xor(ss, 2); ss += __shfl_xor(ss, 4);
          const float rstd = rsqrtf(ss * (1.f / 128.f) + EPS);
          const f32x4 g0 = (f32x4){__uint_as_float(og0.x << 16), __uint_as_float(og0.x & 0xffff0000u), __uint_as_float(og0.y << 16), __uint_as_float(og0.y & 0xffff0000u)};
          const f32x4 g1 = (f32x4){__uint_as_float(og0.z << 16), __uint_as_float(og0.z & 0xffff0000u), __uint_as_float(og0.w << 16), __uint_as_float(og0.w & 0xffff0000u)};
          const f32x4 g2 = (f32x4){__uint_as_float(og1.x << 16), __uint_as_float(og1.x & 0xffff0000u), __uint_as_float(og1.y << 16), __uint_as_float(og1.y & 0xffff0000u)};
          const f32x4 g3 = (f32x4){__uint_as_float(og1.z << 16), __uint_as_float(og1.z & 0xffff0000u), __uint_as_float(og1.w << 16), __uint_as_float(og1.w & 0xffff0000u)};
          st8_bf16(p.HM() + oo, v[0] * rstd * n0 * g0, v[1] * rstd * n1 * g1); st8_bf16(p.HM() + oo + 8, v[2] * rstd * n2 * g2, v[3] * rstd * n3 * g3); }
    }
    __syncthreads();
}
#undef PK4
#undef RSWZ
#undef SBAR
}

__device__ __forceinline__ void phase_mlstm_scan(const Params& p, char* lds, int vcu, int G) {
    for (int u = vcu; u < NB * 8 * 2; u += G) ml::scan_unit(p, u >> 4, (u >> 1) & 7, u & 1, lds);
}
__device__ __forceinline__ void phase_mlstm_out(const Params& p, char* lds, int vcu, int G) {
    ml::phase_mlstm_out_body(p, lds, vcu, G);
}

#define RS_STEP(IN, OUT, N, BIT, MASK) _Pragma("unroll") for (int i_ = 0; i_ < (N); ++i_) { const float keep_ = (BIT) ? IN[(N) + i_] : IN[i_], send_ = (BIT) ? IN[i_] : IN[(N) + i_]; OUT[i_] = keep_ + __shfl_xor(send_, (MASK)); }
__device__ __forceinline__ float route_reduce(const float (&v)[32], int lane) {
    const int b5 = (lane >> 5) & 1, b4 = (lane >> 4) & 1, b3 = (lane >> 3) & 1, b2 = (lane >> 2) & 1, b1 = (lane >> 1) & 1;
    float a16[16], a8[8], a4[4], a2[2], a1[1];
    RS_STEP(v, a16, 16, b5, 32) RS_STEP(a16, a8, 8, b4, 16) RS_STEP(a8, a4, 4, b3, 8) RS_STEP(a4, a2, 2, b2, 4) RS_STEP(a2, a1, 1, b1, 2)
    return a1[0] + __shfl_xor(a1[0], 1);
}
__device__ __forceinline__ int route_rank(float val, int myexp) {
    int cnt = 0;
#pragma unroll
    for (int e = 0; e < 32; ++e) { const float ve = __int_as_float(__builtin_amdgcn_readlane(__float_as_int(val), 2 * e)); cnt += (ve > val || (ve == val && e < myexp)) ? 1 : 0; }
    return cnt;
}
__device__ __forceinline__ void phase_route(const Params& p, char* lds, int vcu, int G) {
    constexpr int XST = 1028;
    float* xs = (float*)lds;
    float* part = (float*)(lds + 65792);
    unsigned short* ent = (unsigned short*)(lds + 84224);
    int* lcount = (int*)(lds + 88320); int* lbase = lcount + 32;
    float* rec = (float*)(lds + 88576);
    const int tid = threadIdx.x, lane = tid & 63, w = tid >> 6, q4 = lane >> 4, l15 = lane & 15;
    __syncthreads();
    if (tid < 32) lcount[tid] = 0;
    float breg0[32], breg1[32];
#pragma unroll
    for (int i = 0; i < 32; ++i) { const float* wr = p.w_router + (size_t)(128 * w + 4 * i + q4) * NEXP + l15; breg0[i] = wr[0]; breg1[i] = wr[16]; }
    const int te = lane & 31, tsel = lane >> 5;
    const float mybias = p.b_router[te];
    int nloc = 0;
    float4 pa_[4], pb_[4];
    if (vcu * 16 < NT) {
#pragma unroll
        for (int j = 0; j < 4; ++j) { pa_[j] = ntld4(p.out + (size_t)(vcu * 16 + w * 2) * DM + (j * 64 + lane) * 4); pb_[j] = ntld4(p.out + (size_t)(vcu * 16 + w * 2 + 1) * DM + (j * 64 + lane) * 4); } }
#pragma unroll 1
    for (int base = vcu * 16; base < NT; base += G * 16, nloc += 16) {
        const int row0 = base + w * 2;
        float4 xa[4], xb[4]; float sa = 0.f, sb = 0.f;
#pragma unroll
        for (int j = 0; j < 4; ++j) { xa[j] = pa_[j]; xb[j] = pb_[j]; }
        { const int nb_ = base + G * 16; if (nb_ < NT) {
#pragma unroll
            for (int j = 0; j < 4; ++j) { pa_[j] = ntld4(p.out + (size_t)(nb_ + w * 2) * DM + (j * 64 + lane) * 4); pb_[j] = ntld4(p.out + (size_t)(nb_ + w * 2 + 1) * DM + (j * 64 + lane) * 4); } } }
#pragma unroll
        for (int j = 0; j < 4; ++j) { sa += xa[j].x * xa[j].x + xa[j].y * xa[j].y + xa[j].z * xa[j].z + xa[j].w * xa[j].w; sb += xb[j].x * xb[j].x + xb[j].y * xb[j].y + xb[j].z * xb[j].z + xb[j].w * xb[j].w; }
        const float ra = rsqrtf(wave_sum(sa) * (1.f / DM) + EPS), rb = rsqrtf(wave_sum(sb) * (1.f / DM) + EPS);
#pragma unroll
        for (int j = 0; j < 4; ++j) { const int c = (j * 64 + lane) * 4; const float4 g = *(const float4*)(p.norm_ffn + c);
            xa[j] = make_float4(xa[j].x * ra * g.x, xa[j].y * ra * g.y, xa[j].z * ra * g.z, xa[j].w * ra * g.w);
            xb[j] = make_float4(xb[j].x * rb * g.x, xb[j].y * rb * g.y, xb[j].z * rb * g.z, xb[j].w * rb * g.w);
            *(float4*)&xs[(w * 2) * XST + c] = xa[j]; *(float4*)&xs[(w * 2 + 1) * XST + c] = xb[j];
            *(unsigned*)((unsigned char*)p.XN2() + (size_t)row0 * DM + c) = pk4_fp8(xa[j].x, xa[j].y, xa[j].z, xa[j].w);
            *(unsigned*)((unsigned char*)p.XN2() + (size_t)(row0 + 1) * DM + c) = pk4_fp8(xb[j].x, xb[j].y, xb[j].z, xb[j].w); }
        __syncthreads();
        f32x4 acc0 = {0.f, 0.f, 0.f, 0.f}, acc1 = {0.f, 0.f, 0.f, 0.f};
        const float* xp = xs + l15 * XST + 128 * w + q4;
#pragma unroll
        for (int i = 0; i < 32; ++i) { const float a = xp[4 * i];
            acc0 = __builtin_amdgcn_mfma_f32_16x16x4f32(a, breg0[i], acc0, 0, 0, 0); acc1 = __builtin_amdgcn_mfma_f32_16x16x4f32(a, breg1[i], acc1, 0, 0, 0); }
#pragma unroll
        for (int r = 0; r < 4; ++r) { part[(w * 16 + 4 * q4 + r) * 32 + l15] = acc0[r]; part[(w * 16 + 4 * q4 + r) * 32 + 16 + l15] = acc1[r]; }
        __syncthreads();
        float val = mybias;
#pragma unroll
        for (int w8 = 0; w8 < 8; ++w8) val += part[(w8 * 16 + 2 * w + tsel) * 32 + te];
        int cnt = 0;
#pragma unroll
        for (int e = 0; e < 32; ++e) { const float v0 = __int_as_float(__builtin_amdgcn_readlane(__float_as_int(val), e)), v1 = __int_as_float(__builtin_amdgcn_readlane(__float_as_int(val), 32 + e));
            const float ve = tsel ? v1 : v0; cnt += (ve > val || (ve == val && e < te)) ? 1 : 0; }
        float* rc = rec + w * 16 + tsel * 8;
        if (cnt < 4) { rc[cnt * 2] = __int_as_float(te); rc[cnt * 2 + 1] = val; }
        asm volatile("s_waitcnt lgkmcnt(0)" ::: "memory");
        if (te == 0) {
            const int row = row0 + tsel, tl = nloc + w * 2 + tsel; float ex[4], sum = 0.f; int tx[4];
#pragma unroll
            for (int kk = 0; kk < 4; ++kk) { tx[kk] = __float_as_int(rc[kk * 2]); ex[kk] = __expf(rc[kk * 2 + 1] - rc[1]); sum += ex[kk]; }
            const float inv = 1.f / sum;
#pragma unroll
            for (int kk = 0; kk < 4; ++kk) { const int e = tx[kk]; p.TOPI()[row * 4 + kk] = e; p.TOPW()[row * 4 + kk] = ex[kk] * inv;
                const int lr = atomicAdd(&lcount[e], 1); ent[tl * 4 + kk] = (unsigned short)(e | (lr << 5)); }
        }
        asm volatile("s_waitcnt lgkmcnt(0)" ::: "memory");
    }
    __syncthreads();
    if (tid < 32) lbase[tid] = atomicAdd(&p.CNT()[tid * CNT_STRIDE], lcount[tid]);
    __syncthreads();
    for (int idx = tid; idx < nloc * 4; idx += MK_THREADS) { const int tl = idx >> 2, row = vcu * 16 + (tl >> 4) * G * 16 + (tl & 15); const unsigned en = ent[idx];
        p.RANK()[row * 4 + (idx & 3)] = lbase[en & 31] + (int)(en >> 5); }
    __syncthreads();
}
#undef RS_STEP
__device__ __forceinline__ void phase_scatter(const Params& p, char* lds, int vcu, int G) {
    int* ps = (int*)lds;
    __syncthreads();
    if (threadIdx.x == 0) { int s = 0; for (int e = 0; e < NEXP; ++e) { ps[e] = s; s += (p.CNT()[e * CNT_STRIDE] + 255) / 256 * 256; } }
    __syncthreads();
    for (int gid = vcu * MK_THREADS + threadIdx.x; gid < NT * 4; gid += G * MK_THREADS) { const int slot = ps[p.TOPI()[gid]] + p.RANK()[gid]; p.SLOTS()[gid] = slot; p.SLOT_TOK()[slot] = gid >> 2; }
    __syncthreads();
}
__device__ __forceinline__ void phase_combine(const Params& p, int vcu, int G, float* dst) {
    const int lane = threadIdx.x & 63, gw = vcu * 8 + (threadIdx.x >> 6), NGW = G * 8;
    for (int r = gw * 2; r < NT; r += NGW * 2) {
        int sl[8]; float tw[8];
#pragma unroll
        for (int q = 0; q < 8; ++q) { sl[q] = p.SLOTS()[r * 4 + q]; tw[q] = p.TOPW()[r * 4 + q]; }
        float4 v[8];
#pragma unroll
        for (int j = 0; j < 4; ++j) { v[j] = ntld4(p.out + (size_t)r * DM + (j * 64 + lane) * 4); v[4 + j] = ntld4(p.out + (size_t)(r + 1) * DM + (j * 64 + lane) * 4); }
        uint2 y[8][4];
#pragma unroll
        for (int q = 0; q < 8; ++q)
#pragma unroll
            for (int j = 0; j < 4; ++j) y[q][j] = ntld2u(p.YB() + (size_t)sl[q] * DM + (j * 64 + lane) * 4);
#pragma unroll
        for (int q = 0; q < 8; ++q) { const float w = tw[q]; const int o = (q >> 2) * 4;
#pragma unroll
            for (int j = 0; j < 4; ++j) { const uint2 t = y[q][j];
                v[o + j].x += w * __uint_as_float(t.x << 16); v[o + j].y += w * __uint_as_float(t.x & 0xffff0000u); v[o + j].z += w * __uint_as_float(t.y << 16); v[o + j].w += w * __uint_as_float(t.y & 0xffff0000u); } }
        float sa = 0.f, sb = 0.f;
#pragma unroll
        for (int j = 0; j < 4; ++j) { sa += v[j].x * v[j].x + v[j].y * v[j].y + v[j].z * v[j].z + v[j].w * v[j].w; sb += v[4 + j].x * v[4 + j].x + v[4 + j].y * v[4 + j].y + v[4 + j].z * v[4 + j].z + v[4 + j].w * v[4 + j].w; }
        const float ra = rsqrtf(wave_sum(sa) * (1.f / DM) + EPS), rb = rsqrtf(wave_sum(sb) * (1.f / DM) + EPS);
#pragma unroll
        for (int j = 0; j < 4; ++j) { const int c = (j * 64 + lane) * 4; const float4 g = *(const float4*)(p.norm_final + c);
            *(float4*)(dst + (size_t)r * DM + c) = make_float4(v[j].x * ra * g.x, v[j].y * ra * g.y, v[j].z * ra * g.z, v[j].w * ra * g.w);
            *(float4*)(dst + (size_t)(r + 1) * DM + c) = make_float4(v[4 + j].x * rb * g.x, v[4 + j].y * rb * g.y, v[4 + j].z * rb * g.z, v[4 + j].w * rb * g.w); }
    }
}
__device__ __forceinline__ void phase_init_ctl(const Params& p, int vcu, int G) {
    if (vcu == 0) for (int i = threadIdx.x; i < NEXP * CNT_STRIDE; i += MK_THREADS) p.CNT()[i] = 0;
    for (int i = vcu * MK_THREADS + threadIdx.x; i < NSLOT; i += G * MK_THREADS) p.SLOT_TOK()[i] = -1;
}

#define XB_TMO      128
#define XB_XCNT(j)  (256  + 64 * (j))
#define XB_XSUB(j)  (1280 + 64 * (j))
#define XB_XGEN(j)  (2304 + 64 * (j))
#define XB_TOP      3328
#define XB_TOPGEN   3392
#define XCD_BAR_WORDS 3456
#define XB_SPIN_CAP (1u << 20)
__device__ __forceinline__ unsigned xb_ld(unsigned* p)              { return __hip_atomic_load(p, __ATOMIC_RELAXED, __HIP_MEMORY_SCOPE_AGENT); }
__device__ __forceinline__ unsigned xb_add(unsigned* p, unsigned v) { return __hip_atomic_fetch_add(p, v, __ATOMIC_RELAXED, __HIP_MEMORY_SCOPE_AGENT); }
__device__ __forceinline__ unsigned xb_xcc_id() { return (unsigned)__builtin_amdgcn_s_getreg((3 << 11) | 20) & 0xFu; }
#define XB_SPIN(cond, bar) do { unsigned _sp = 0; while (cond) { __builtin_amdgcn_s_sleep(1); \
    if ((++_sp & 255u) == 0u) { if (xb_ld(&(bar)[XB_TMO])) break; if (_sp > XB_SPIN_CAP) { atomicAdd(&(bar)[XB_TMO], 1u); break; } } } } while (0)
struct XcdBarrier { unsigned* bar; unsigned x; volatile LAS unsigned* st; };
__device__ __forceinline__ XcdBarrier xcd_barrier_post(unsigned* bar, volatile LAS unsigned* st) {
    XcdBarrier b; b.bar = bar; b.x = xb_xcc_id(); b.st = st;
    if (threadIdx.x == 0) (void)xb_add(&bar[XB_XCNT(b.x)], 1u);
    return b;
}
__device__ __forceinline__ void xcd_barrier_complete(unsigned* bar, unsigned x, unsigned& nloc, unsigned& nx) {
    const unsigned G = gridDim.x * gridDim.y * gridDim.z;
    unsigned sum, cnt, mine, sp = 0u;
    for (;;) {
        sum = 0u; cnt = 0u; mine = 0u;
#pragma unroll
        for (unsigned j = 0; j < 16; ++j) { const unsigned c = xb_ld(&bar[XB_XCNT(j)]); sum += c; cnt += (c > 0u) ? 1u : 0u; mine = (j == x) ? c : mine; }
        if (sum == G) break;
        __builtin_amdgcn_s_sleep(1);
        if ((++sp & 255u) == 0u) { if (xb_ld(&bar[XB_TMO])) break; if (sp > XB_SPIN_CAP) { atomicAdd(&bar[XB_TMO], 1u); break; } }
    }
    nloc = mine > 0u ? mine : 1u; nx = cnt > 0u ? cnt : 1u;
}
__device__ __forceinline__ void xcd_barrier(const XcdBarrier& b) {
    asm volatile("s_waitcnt vmcnt(0)" ::: "memory");
    __syncthreads();
    if (threadIdx.x == 0) {
        unsigned* bar = b.bar;
        __builtin_amdgcn_s_waitcnt(0);
        unsigned nloc = b.st[0], nx = b.st[1];
        if (nloc == 0u) { xcd_barrier_complete(bar, b.x, nloc, nx); b.st[0] = nloc; b.st[1] = nx; }
        const unsigned old = xb_add(&bar[XB_XSUB(b.x)], 1u);
        const unsigned gen = old / nloc;
        if (old + 1u == (gen + 1u) * nloc) {
            __builtin_amdgcn_fence(__ATOMIC_RELEASE, "agent");
            asm volatile("s_waitcnt vmcnt(0)" ::: "memory");
            const unsigned og = xb_add(&bar[XB_TOP], 1u);
            const unsigned tg = og / nx;
            if (og + 1u == (tg + 1u) * nx) xb_add(&bar[XB_TOPGEN], 1u);
            else XB_SPIN(xb_ld(&bar[XB_TOPGEN]) == tg, bar);
            __builtin_amdgcn_fence(__ATOMIC_ACQUIRE, "agent");
            xb_add(&bar[XB_XGEN(b.x)], 1u);
            asm volatile("s_waitcnt vmcnt(0)" ::: "memory");
        } else {
            XB_SPIN(xb_ld(&bar[XB_XGEN(b.x)]) == gen, bar);
            __builtin_amdgcn_fence(__ATOMIC_ACQUIRE, "agent");
            asm volatile("s_waitcnt vmcnt(0)" ::: "memory");
        }
    }
    __syncthreads();
}

struct MkArgs { Params p; int ph_lo, ph_hi, sub, pad; };
enum { PH_PRO = 0, PH_INPROJ = 1, PH_MSCAN = 2, PH_QPROJ = 3, PH_MOUT = 4, PH_ATTN = 5, PH_YM = 6, PH_YA = 7, PH_OUT = 8, PH_ROUTE = 9, PH_SCATTER = 10, PH_M1 = 11, PH_M2 = 12, PH_COMBINE = 13, PH_END = 14 };

__global__ void __launch_bounds__(MK_THREADS, 2) mk_fwd(MkArgs a) {
    extern __shared__ __attribute__((aligned(16))) unsigned char lds_raw[];
    LAS unsigned char* lds = (LAS unsigned char*)lds_raw;
    const Params& p = *(const Params*)__builtin_amdgcn_kernarg_segment_ptr();
    const int G = gridDim.x, bx = blockIdx.x;
    const int vcu = (G % 8 == 0) ? (bx % 8) * (G / 8) + bx / 8 : bx;
    cooperative_groups::grid_group grid = cooperative_groups::this_grid();
    const int lo = a.ph_lo, hi = a.ph_hi;
    volatile LAS unsigned* bst = (volatile LAS unsigned*)(lds + MK_LDS - 16);
    if (threadIdx.x < 4) bst[threadIdx.x] = 0u;
    __syncthreads();
    XcdBarrier xbar; xbar.bar = p.BAR(); xbar.x = 0; xbar.st = bst;
    if (hi - lo > 1) xbar = xcd_barrier_post(p.BAR(), bst);
#ifndef PHASE_MASK
#define PHASE_MASK 0xffffffffu
#endif
#define IN(k) (((PHASE_MASK >> (k)) & 1u) && lo <= (k) && (k) < hi)
#define SEAM(k) do { if (IN(k) && IN((k) + 1)) { if (a.sub == 0x7fffffff) grid.sync(); else xcd_barrier(xbar); } } while (0)
#ifndef PROBE_PHASE
#define PROBE_PHASE -1
#endif
#ifndef PROBE_REPS
#define PROBE_REPS 2
#endif
#define REPS(k) ((k) == PROBE_PHASE ? PROBE_REPS : 1)
    if (IN(PH_PRO)) for (int rep_ = 0; rep_ < REPS(PH_PRO); ++rep_) { if (rep_) xcd_barrier(xbar); phase_init_ctl(p, vcu, G); phase_prologue(p, lds, vcu, G, a.sub); } SEAM(PH_PRO);
    if (IN(PH_INPROJ)) for (int rep_ = 0; rep_ < REPS(PH_INPROJ); ++rep_) { if (rep_) xcd_barrier(xbar); { pg8::StaticOrderN<10> S; S.init(DM, G, bx, p.U(), p.WinT()); EpiInP<0> E{p}; pg8::gemm_phase<EpiInP<0>, pg8::StaticOrderN<10>>(lds, DM, DM, S, E); }
        { pg8::StaticOrderN<12> S; S.init(DM / 2, G, bx, p.U8(), p.WinT8()); EpiInP<1> E{p}; pg8::gemm_phase<EpiInP<1>, pg8::StaticOrderN<12>, true>(lds, DM / 2, DM / 2, S, E); } } SEAM(PH_INPROJ);
    if (IN(PH_MSCAN)) for (int rep_ = 0; rep_ < REPS(PH_MSCAN); ++rep_) { if (rep_) xcd_barrier(xbar);
        { const int half = (bx >> 3) & 1, idx = (bx & 7) * 16 + (bx >> 4);
            if (half == 0) { if (a.sub != 2) phase_mlstm_scan(p, (char*)lds_raw, idx, 128); }
            else if (a.sub != 1) { phase_kprep(p, idx, 128);
                asm volatile("s_waitcnt vmcnt(0)" ::: "memory"); __syncthreads();
                if (threadIdx.x == 0) { unsigned* cw = p.BAR() + 3584; __builtin_amdgcn_fence(__ATOMIC_RELEASE, "agent"); asm volatile("s_waitcnt vmcnt(0)" ::: "memory");
                    xb_add(cw, 1u); unsigned sp = 0; while (xb_ld(cw) < 128u * (unsigned)(rep_ + 1)) { __builtin_amdgcn_s_sleep(2); if (++sp > (1u << 22)) break; }
                    __builtin_amdgcn_fence(__ATOMIC_ACQUIRE, "agent"); asm volatile("s_waitcnt vmcnt(0)" ::: "memory"); }
                __syncthreads();
                pg8::StaticOrderN<6> S; S.init(256, 128, idx, p.CQb(), p.WqT()); EpiQ E{p}; pg8::gemm_phase<EpiQ, pg8::StaticOrderN<6>>(lds, 256, 256, S, E); } }
        } SEAM(PH_MSCAN);
    if (IN(PH_MOUT)) for (int rep_ = 0; rep_ < REPS(PH_MOUT); ++rep_) { if (rep_) xcd_barrier(xbar); phase_mlstm_out(p, (char*)lds_raw, vcu, G); }
    if (IN(PH_ATTN)) for (int rep_ = 0; rep_ < REPS(PH_ATTN); ++rep_) { if (rep_) xcd_barrier(xbar); phase_attn(p, (char*)lds_raw, vcu, G); } SEAM(PH_ATTN);
    if (IN(PH_YM)) for (int rep_ = 0; rep_ < REPS(PH_YM); ++rep_) { if (rep_) xcd_barrier(xbar); pg8::StaticOrderN<4> S; S.init(DM, G, bx, p.HM(), p.WmT()); EpiMix<0> E{p}; pg8::gemm_phase<EpiMix<0>, pg8::StaticOrderN<4>>(lds, DM, DM, S, E); }
    if (IN(PH_YA)) for (int rep_ = 0; rep_ < REPS(PH_YA); ++rep_) { if (rep_) xcd_barrier(xbar); pg8::StaticOrderN<4> S; S.init(DM, G, bx, p.OA(), p.WoT()); EpiMix<1> E{p}; pg8::gemm_phase<EpiMix<1>, pg8::StaticOrderN<4>>(lds, DM, DM, S, E); } SEAM(PH_YA);
    if (IN(PH_OUT)) for (int rep_ = 0; rep_ < REPS(PH_OUT); ++rep_) { if (rep_) xcd_barrier(xbar); pg8::StaticOrderN<4> S; S.init(DM, G, bx, p.MIX(), p.WoutT()); EpiOut E{p}; pg8::gemm_phase<EpiOut, pg8::StaticOrderN<4>>(lds, DM, DM, S, E); } SEAM(PH_OUT);
    if (IN(PH_ROUTE)) for (int rep_ = 0; rep_ < REPS(PH_ROUTE); ++rep_) { if (rep_) xcd_barrier(xbar); phase_route(p, (char*)lds_raw, vcu, G); } SEAM(PH_ROUTE);
    if (IN(PH_SCATTER)) for (int rep_ = 0; rep_ < REPS(PH_SCATTER); ++rep_) { if (rep_) xcd_barrier(xbar); phase_scatter(p, (char*)lds_raw, vcu, G); } SEAM(PH_SCATTER);
    if (IN(PH_M1)) for (int rep_ = 0; rep_ < REPS(PH_M1); ++rep_) { if (rep_) xcd_barrier(xbar); volatile LAS int* tst = (volatile LAS int*)(lds + MISC_OFF); moe_tile_table(p, tst);
        pg8::MoeOrder S; S.tstart = tst; S.npn = 8; S.G = G; S.c = bx; S.A = (const char*)p.XN2(); S.W = (const char*)p.W1T(); S.wexp = (size_t)2048 * DM; S.btile = (size_t)256 * DM;     S.rowidx = p.SLOT_TOK(); S.bias = p.b1; S.bsplit = 1;
        EpiM1 E{p}; pg8::gemm_phase<EpiM1, pg8::MoeOrder, true>(lds, DM / 2, DM / 2, S, E); } SEAM(PH_M1);
    if (IN(PH_M2)) for (int rep_ = 0; rep_ < REPS(PH_M2); ++rep_) { if (rep_) xcd_barrier(xbar); volatile LAS int* tst = (volatile LAS int*)(lds + MISC_OFF); moe_tile_table(p, tst);
        pg8::MoeOrder S; S.tstart = tst; S.npn = 4; S.G = G; S.c = bx; S.A = (const char*)p.ACT(); S.W = (const char*)p.W2T(); S.wexp = (size_t)DM * DFF; S.btile = (size_t)256 * DFF; S.rowidx = nullptr; S.bias = p.b2; S.bsplit = 0;
        EpiM2 E{p}; pg8::gemm_phase<EpiM2, pg8::MoeOrder, true>(lds, DFF / 2, DFF / 2, S, E); } SEAM(PH_M2);
    if (IN(PH_COMBINE)) for (int rep_ = 0; rep_ < REPS(PH_COMBINE); ++rep_) { if (rep_) xcd_barrier(xbar); phase_combine(p, vcu, G, a.sub ? (float*)p.ACT() : p.out); }
#undef IN
#undef SEAM
}

#ifndef ONE_LAUNCH
#define ONE_LAUNCH 1
#endif
#ifndef PROBE_DUP
#define PROBE_DUP -1
#endif
#ifndef PROBE_SUB
#define PROBE_SUB 0
#endif
#ifndef PROBE_DUP_N
#define PROBE_DUP_N 1
#endif
#ifndef FAST_INPROJ
#define FAST_INPROJ 1
#endif
#ifndef FAST_QPROJ
#define FAST_QPROJ 1
#endif
#ifndef FAST_MIX
#define FAST_MIX 1
#endif
#ifndef FAST_MOE
#define FAST_MOE 1
#endif
#ifndef FAST_ATTN
#define FAST_ATTN 1
#endif
#ifndef FAST_MLSTM
#define FAST_MLSTM 1
#endif
static void launch_mk(const Params& p, int lo, int hi, int grid, hipStream_t stream, int sub = 0) {
    MkArgs a{}; a.p = p; a.ph_lo = lo; a.ph_hi = hi; a.sub = sub;
    hipLaunchKernelGGL(mk_fwd, dim3(grid), dim3(MK_THREADS), MK_LDS, stream, a);
}
extern "C" void kernel_launch(void* const* d_in, const int* in_sizes, int n_in, void* d_out, int out_size, void* d_ws, size_t ws_size, hipStream_t stream) {
    static int ok = 0, grid = 0;
    if (!ok) {
        if (n_in != 22 || in_sizes[0] != NT * DM || out_size != NT * DM) { fprintf(stderr, "kernel_launch: unexpected shapes (n_in %d, x %d, out %d)\n", n_in, n_in > 0 ? in_sizes[0] : -1, out_size); return; }
        (void)hipFuncSetAttribute((const void*)k_mlstm_out, hipFuncAttributeMaxDynamicSharedMemorySize, MO_LDS);
        (void)hipFuncSetAttribute((const void*)mk_fwd, hipFuncAttributeMaxDynamicSharedMemorySize, MK_LDS);
        int dev = 0, cus = 0, per_cu = 0; (void)hipGetDevice(&dev); (void)hipDeviceGetAttribute(&cus, hipDeviceAttributeMultiprocessorCount, dev);
        (void)hipOccupancyMaxActiveBlocksPerMultiprocessor(&per_cu, (const void*)mk_fwd, MK_THREADS, MK_LDS);
        if (per_cu < 1) { fprintf(stderr, "kernel_launch: occupancy query says %d blocks/CU\n", per_cu); per_cu = 1; }
        if (cus != 256) { fprintf(stderr, "kernel_launch: built for a 256-CU device (got %d CUs)\n", cus); return; }
        grid = 256;
        ok = 1;
    }
    Params p{};
    const float** ins = (const float**)&p.x;
    for (int i = 0; i < 22; ++i) ins[i] = (const float*)d_in[i];
    p.out = (float*)d_out;
    p.ws = (char*)d_ws;
    if (WS_TOTAL > ws_size) { fprintf(stderr, "kernel_launch: workspace too small (%zu > %zu)\n", (size_t)WS_TOTAL, ws_size); return; }
    (void)hipMemsetAsync(p.BAR(), 0, 16384, stream);
#if ONE_LAUNCH
    { MkArgs a{}; a.p = p; a.ph_lo = 0; a.ph_hi = PH_END; void* args[] = {&a};
      hipError_t e = hipLaunchCooperativeKernel((const void*)mk_fwd, dim3(grid), dim3(MK_THREADS), args, MK_LDS, stream);
      if (e != hipSuccess) fprintf(stderr, "kernel_launch: cooperative launch failed: %s (grid %d)\n", hipGetErrorString(e), grid); }
#else
    for (int ph = 0; ph < PH_END; ++ph) { if (ph == PH_COMBINE && PROBE_DUP == PH_COMBINE) { launch_mk(p, ph, ph + 1, grid, stream, 1); launch_mk(p, ph, ph + 1, grid, stream, 0); continue; }
        launch_mk(p, ph, ph + 1, grid, stream);
        for (int d = 0; d < ((ph == PROBE_DUP) ? PROBE_DUP_N : 0); ++d) { if (ph == PH_ROUTE) (void)hipMemsetAsync(p.CNT(), 0, 4096, stream); launch_mk(p, ph, ph + 1, grid, stream, PROBE_SUB); } }
#endif
}
```

```cpp
#include <hip/hip_runtime.h>
#include <hip/hip_cooperative_groups.h>
#include <cstdio>
#include <cstdint>

typedef unsigned short bf16_t;
__device__ __forceinline__ float bf2f(bf16_t v) { return __uint_as_float(((unsigned)v) << 16); }
__device__ __forceinline__ bf16_t f2bf(float f) { unsigned u = __float_as_uint(f); return (bf16_t)((u + 0x7fffu + ((u >> 16) & 1u)) >> 16); }

constexpr int NB = 8, SEQ = 4096, NT = NB * SEQ, DM = 1024, NMETA = 16, LTOT = SEQ + NMETA;
constexpr int DIN = 5600;
constexpr int OFF_Q = 0, OFF_K = 512, OFF_V = 1024, OFF_O = 2048, OFF_I = 3072, OFF_F = 3088, OFF_CQ = 3104, OFF_CKV = 3360, OFF_KR = 3488, OFF_G = 3552;
constexpr int KVROWS = 4160;
constexpr int NEXP = 32, DFF = 1024;
constexpr int NSLOT = NT * 4 + NEXP * 256;
constexpr float EPS = 1e-6f;
constexpr int CNT_STRIDE = 16;
constexpr float QSCALE = 0.07216878364870322f * 1.4426950408889634f;

constexpr size_t ws_al(size_t x) { return (x + 255) & ~(size_t)255; }
constexpr size_t WS_BAR = 0;
constexpr size_t WS_CNT = WS_BAR + 16384;
constexpr size_t WS_SLOT_TOK = WS_CNT + ws_al(4096);
constexpr size_t WS_TOPI = WS_SLOT_TOK + ws_al((size_t)NSLOT*4);
constexpr size_t WS_TOPW = WS_TOPI + ws_al((size_t)NT*16);
constexpr size_t WS_RANK = WS_TOPW + ws_al((size_t)NT*16);
constexpr size_t WS_SLOTS = WS_RANK + ws_al((size_t)NT*16);
constexpr size_t WS_UM = WS_SLOTS + ws_al((size_t)NT*16);
constexpr size_t WS_ZM = WS_UM + ws_al((size_t)NMETA*DM*4);
constexpr size_t WS_ROPE = WS_ZM + ws_al((size_t)NMETA*DIN*4);
constexpr size_t WS_RSQ = WS_ROPE + ws_al((size_t)LTOT*64*4);
constexpr size_t WS_GI = WS_RSQ + ws_al((size_t)NT*4);
constexpr size_t WS_GF = WS_GI + ws_al((size_t)NT*64);
constexpr size_t WS_NF = WS_GF + ws_al((size_t)NT*64);
constexpr size_t WS_NB_ = WS_NF + ws_al((size_t)4096*256);
constexpr size_t WS_MF = WS_NB_ + ws_al((size_t)4096*256);
constexpr size_t WS_MB = WS_MF + ws_al((size_t)4096*4);
constexpr size_t WS_Kc = WS_MB + ws_al((size_t)4096*4);
constexpr size_t WS_WinT = WS_Kc + ws_al((size_t)NB*KVROWS*192*2);
constexpr size_t WS_WinT8 = WS_WinT + ws_al((size_t)5632*DM*2);
constexpr size_t WS_W1T = WS_WinT8 + ws_al((size_t)3072*DM);
constexpr size_t WS_W2T = WS_W1T + ws_al((size_t)NEXP*2048*DM*2);
constexpr size_t WS_WmT = WS_W2T + ws_al((size_t)NEXP*DM*DFF*2);
constexpr size_t WS_WoutT = WS_WmT + ws_al((size_t)DM*DM*2);
constexpr size_t WS_WoT = WS_WoutT + ws_al((size_t)DM*DM*2);
constexpr size_t WS_WqT = WS_WoT + ws_al((size_t)DM*DM*2);
constexpr size_t WS_CKV = WS_WqT + ws_al((size_t)1536*256*2);
constexpr size_t WS_KR = WS_CKV + ws_al((size_t)NT*128*4);
constexpr size_t WS_CQb = WS_KR + ws_al((size_t)NT*64*4);
constexpr size_t WS_GATE = WS_CQb + ws_al((size_t)NT*256*2);
constexpr size_t WS_WQF = WS_GATE + ws_al((size_t)NT*2048*2);
constexpr size_t WS_WOF = WS_WQF + ws_al((size_t)256*1536*4);
constexpr size_t WS_U = WS_WOF + ws_al((size_t)1024*1024*4);
constexpr size_t WS_Qm = WS_U + ws_al((size_t)NT*DM*2);
constexpr size_t WS_Km = WS_Qm + ws_al((size_t)NT*512*2);
constexpr size_t WS_Vm = WS_Km + ws_al((size_t)NT*512*2);
constexpr size_t WS_OG = WS_Vm + ws_al((size_t)NT*1024*2);
constexpr size_t WS_QP = WS_OG + ws_al((size_t)NT*1024*2);
constexpr size_t WS_CB = WS_QP + ws_al((size_t)NT*1536*2);
constexpr size_t WS_HM = WS_CB + ws_al((size_t)4096*8192*2);
constexpr size_t WS_OA = WS_HM + ws_al((size_t)NT*DM*2);
constexpr size_t WS_TOTAL = WS_OA + ws_al((size_t)NT*DM*2);
constexpr size_t WS_ACT = WS_U, WS_YB = WS_ACT + ws_al((size_t)NSLOT * DFF * 2), WS_MOE_END = WS_YB + ws_al((size_t)NSLOT * DM * 2);
constexpr size_t WS_U8 = WS_CB;
constexpr size_t WS_CF = WS_U, WS_MIX = WS_Qm, WS_XN2 = WS_HM, WS_CQ = WS_HM;
static_assert(WS_MOE_END <= WS_TOTAL && WS_XN2 >= WS_YB, "MoE overlay layout");
struct Params {
    const float *x, *meta, *norm_mix, *w_in, *m_b_i, *m_b_f, *m_norm, *w_m_proj, *a_w_uq, *a_w_ukv, *a_norm_q, *a_norm_kv, *w_a_proj, *w_out,
        *norm_ffn, *w_router, *b_router, *w1, *b1, *w2, *b2, *norm_final;
    float* out; char* ws;
    __host__ __device__ __forceinline__ int* CNT() const { return (int*)(ws + WS_CNT); }
    __host__ __device__ __forceinline__ unsigned* BAR() const { return (unsigned*)(ws + WS_BAR); }
    __host__ __device__ __forceinline__ unsigned char* WinT8() const { return (unsigned char*)(ws + WS_WinT8); }
    __host__ __device__ __forceinline__ unsigned char* U8() const { return (unsigned char*)(ws + WS_U8); }
    __host__ __device__ __forceinline__ int* SLOT_TOK() const { return (int*)(ws + WS_SLOT_TOK); }
    __host__ __device__ __forceinline__ int* TOPI() const { return (int*)(ws + WS_TOPI); }
    __host__ __device__ __forceinline__ float* TOPW() const { return (float*)(ws + WS_TOPW); }
    __host__ __device__ __forceinline__ int* RANK() const { return (int*)(ws + WS_RANK); }
    __host__ __device__ __forceinline__ int* SLOTS() const { return (int*)(ws + WS_SLOTS); }
    __host__ __device__ __forceinline__ float* UM() const { return (float*)(ws + WS_UM); }
    __host__ __device__ __forceinline__ float* ZM() const { return (float*)(ws + WS_ZM); }
    __host__ __device__ __forceinline__ float* ROPE() const { return (float*)(ws + WS_ROPE); }
    __host__ __device__ __forceinline__ float* RSQ() const { return (float*)(ws + WS_RSQ); }
    __host__ __device__ __forceinline__ float* GI() const { return (float*)(ws + WS_GI); }
    __host__ __device__ __forceinline__ float* GF() const { return (float*)(ws + WS_GF); }
    __host__ __device__ __forceinline__ float* NF() const { return (float*)(ws + WS_NF); }
    __host__ __device__ __forceinline__ float* NB_() const { return (float*)(ws + WS_NB_); }
    __host__ __device__ __forceinline__ float* MF() const { return (float*)(ws + WS_MF); }
    __host__ __device__ __forceinline__ float* MB() const { return (float*)(ws + WS_MB); }
    __host__ __device__ __forceinline__ bf16_t* Kc() const { return (bf16_t*)(ws + WS_Kc); }
    __host__ __device__ __forceinline__ bf16_t* WinT() const { return (bf16_t*)(ws + WS_WinT); }
    __host__ __device__ __forceinline__ bf16_t* W1T() const { return (bf16_t*)(ws + WS_W1T); }
    __host__ __device__ __forceinline__ bf16_t* W2T() const { return (bf16_t*)(ws + WS_W2T); }
    __host__ __device__ __forceinline__ bf16_t* WmT() const { return (bf16_t*)(ws + WS_WmT); }
    __host__ __device__ __forceinline__ bf16_t* WoutT() const { return (bf16_t*)(ws + WS_WoutT); }
    __host__ __device__ __forceinline__ bf16_t* WoT() const { return (bf16_t*)(ws + WS_WoT); }
    __host__ __device__ __forceinline__ bf16_t* WqT() const { return (bf16_t*)(ws + WS_WqT); }
    __host__ __device__ __forceinline__ float* CKV() const { return (float*)(ws + WS_CKV); }
    __host__ __device__ __forceinline__ float* KR() const { return (float*)(ws + WS_KR); }
    __host__ __device__ __forceinline__ bf16_t* CQb() const { return (bf16_t*)(ws + WS_CQb); }
    __host__ __device__ __forceinline__ bf16_t* GATE() const { return (bf16_t*)(ws + WS_GATE); }
    __host__ __device__ __forceinline__ float* WQF() const { return (float*)(ws + WS_WQF); }
    __host__ __device__ __forceinline__ float* WOF() const { return (float*)(ws + WS_WOF); }
    __host__ __device__ __forceinline__ bf16_t* U() const { return (bf16_t*)(ws + WS_U); }
    __host__ __device__ __forceinline__ bf16_t* Qm() const { return (bf16_t*)(ws + WS_Qm); }
    __host__ __device__ __forceinline__ bf16_t* Km() const { return (bf16_t*)(ws + WS_Km); }
    __host__ __device__ __forceinline__ bf16_t* Vm() const { return (bf16_t*)(ws + WS_Vm); }
    __host__ __device__ __forceinline__ bf16_t* OG() const { return (bf16_t*)(ws + WS_OG); }
    __host__ __device__ __forceinline__ bf16_t* QP() const { return (bf16_t*)(ws + WS_QP); }
    __host__ __device__ __forceinline__ bf16_t* CB() const { return (bf16_t*)(ws + WS_CB); }
    __host__ __device__ __forceinline__ bf16_t* HM() const { return (bf16_t*)(ws + WS_HM); }
    __host__ __device__ __forceinline__ bf16_t* OA() const { return (bf16_t*)(ws + WS_OA); }
    __host__ __device__ __forceinline__ bf16_t* ACT() const { return (bf16_t*)(ws + WS_ACT); }
    __host__ __device__ __forceinline__ bf16_t* YB() const { return (bf16_t*)(ws + WS_YB); }
    __host__ __device__ __forceinline__ bf16_t* CF() const { return (bf16_t*)(ws + WS_CF); }
    __host__ __device__ __forceinline__ bf16_t* MIX() const { return (bf16_t*)(ws + WS_MIX); }
    __host__ __device__ __forceinline__ bf16_t* XN2() const { return (bf16_t*)(ws + WS_XN2); }
    __host__ __device__ __forceinline__ float* CQ() const { return (float*)(ws + WS_CQ); }
};

__device__ __forceinline__ float wave_sum(float v) {
#pragma unroll
    for (int o = 1; o < 64; o <<= 1) v += __shfl_xor(v, o);
    return v;
}
__device__ __forceinline__ float sigmoidf_(float v) { return __builtin_amdgcn_rcpf(1.f + __expf(-v)); }
__device__ __forceinline__ float logsigmoidf_(float v) { return fminf(v, 0.f) - __logf(1.f + __expf(-fabsf(v))); }

__global__ void __launch_bounds__(256) k_prep_rows(Params p) {
    const int lane = threadIdx.x & 63, gw = (blockIdx.x * 256 + threadIdx.x) >> 6, ngw = (gridDim.x * 256) >> 6;
    for (int r = gw; r < NT + NMETA; r += ngw) {
        const float* src = r < NT ? p.x + (size_t)r * DM : p.meta + (size_t)(r - NT) * DM;
        float4 v[4]; float ss = 0.f;
#pragma unroll
        for (int j = 0; j < 4; ++j) { v[j] = *(const float4*)(src + (j * 64 + lane) * 4); ss += v[j].x * v[j].x + v[j].y * v[j].y + v[j].z * v[j].z + v[j].w * v[j].w; }
        const float rstd = rsqrtf(wave_sum(ss) * (1.f / DM) + EPS);
#pragma unroll
        for (int j = 0; j < 4; ++j) {
            const int c = (j * 64 + lane) * 4; const float4 g = *(const float4*)(p.norm_mix + c);
            const float a0 = v[j].x * rstd * g.x, a1 = v[j].y * rstd * g.y, a2 = v[j].z * rstd * g.z, a3 = v[j].w * rstd * g.w;
            if (r < NT) { bf16_t* d = p.U() + (size_t)r * DM + c; d[0] = f2bf(a0); d[1] = f2bf(a1); d[2] = f2bf(a2); d[3] = f2bf(a3); }
            else { float* d = p.UM() + (size_t)(r - NT) * DM + c; d[0] = a0; d[1] = a1; d[2] = a2; d[3] = a3; }
        }
    }
}

__global__ void __launch_bounds__(256) k_fold(Params p) {
    const long gid = (long)blockIdx.x * 256 + threadIdx.x, gn = (long)gridDim.x * 256;
    for (long i = gid; i < 256L * 1536; i += gn) {
        const int r = (int)(i / 1536), hc = (int)(i % 1536), h = hc / 192, c = hc % 192;
        const float* uq = p.a_w_uq + ((size_t)r * 8 + h) * 192; float acc;
        if (c >= 128) acc = uq[c];
        else { const float* kv = p.a_w_ukv + ((size_t)c * 8 + h) * 256; acc = 0.f; for (int d = 0; d < 128; ++d) acc += uq[d] * kv[d]; }
        p.WQF()[i] = acc;
    }
    for (long i = gid; i < 1024L * 1024; i += gn) {
        const int hc = (int)(i >> 10), n = (int)(i & 1023), h = hc >> 7, c = hc & 127;
        const float* kv = p.a_w_ukv + ((size_t)c * 8 + h) * 256 + 128; const float* ap = p.w_a_proj + (size_t)(h * 128) * DM + n;
        float acc = 0.f; for (int d = 0; d < 128; ++d) acc += kv[d] * ap[(size_t)d * DM];
        p.WOF()[i] = acc;
    }
    for (long i = gid; i < (long)LTOT * 32; i += gn) {
        const int pos = (int)(i >> 5), f = (int)(i & 31);
        const float freq = powf(10000.f, -(float)f / 32.f), ang = (float)pos * freq; float s, c; sincosf(ang, &s, &c);
        p.ROPE()[i * 2] = c; p.ROPE()[i * 2 + 1] = s;
    }
}

__global__ void __launch_bounds__(256) k_meta_proj(Params p) {
    const int gid = blockIdx.x * 256 + threadIdx.x;
    if (gid >= NMETA * DIN) return;
    const int j = gid / DIN, n = gid % DIN; const float* u = p.UM() + (size_t)j * DM; float acc = 0.f;
    for (int k = 0; k < DM; ++k) acc += u[k] * p.w_in[(size_t)k * DIN + n];
    p.ZM()[gid] = acc;
}

template <class P> __global__ void __launch_bounds__(256) k_sgemm(P q) {
    __shared__ float As[16][68]; __shared__ float Bs[16][68];
    const int ntn = (q.N + 63) / 64, ntm = q.M / 64, tid = threadIdx.x, tx = tid & 15, ty = tid >> 4;
    for (int tile = blockIdx.x; tile < ntm * ntn; tile += gridDim.x) {
        const int tm = tile / ntn, tn = tile % ntn; int ctx = 0;
        if (!q.setup(tm, ctx)) continue;
        float acc[4][4];
#pragma unroll
        for (int i = 0; i < 4; ++i)
#pragma unroll
            for (int j = 0; j < 4; ++j) acc[i][j] = 0.f;
        const int arow = tm * 64 + (tid >> 2), ak = (tid & 3) * 4, bk = tid >> 4, bcol = tn * 64 + (tid & 15) * 4;
        for (int k0 = 0; k0 < q.K; k0 += 16) {
            const float4 av = q.a4(ctx, arow, k0 + ak);
            const float4 bv = bcol < q.N ? q.b4(ctx, k0 + bk, bcol) : make_float4(0.f, 0.f, 0.f, 0.f);
            __syncthreads();
            As[ak + 0][tid >> 2] = av.x; As[ak + 1][tid >> 2] = av.y; As[ak + 2][tid >> 2] = av.z; As[ak + 3][tid >> 2] = av.w;
            *(float4*)&Bs[bk][(tid & 15) * 4] = bv;
            __syncthreads();
#pragma unroll
            for (int kk = 0; kk < 16; ++kk) {
                const float4 a = *(const float4*)&As[kk][ty * 4]; const float4 b = *(const float4*)&Bs[kk][tx * 4];
                const float aa[4] = {a.x, a.y, a.z, a.w}, bb[4] = {b.x, b.y, b.z, b.w};
#pragma unroll
                for (int i = 0; i < 4; ++i)
#pragma unroll
                    for (int j = 0; j < 4; ++j) acc[i][j] += aa[i] * bb[j];
            }
        }
        const int col = tn * 64 + tx * 4;
        if (col < q.N) {
#pragma unroll
            for (int i = 0; i < 4; ++i) q.epi(ctx, tm * 64 + ty * 4 + i, col, acc[i]);
        }
    }
}
__device__ __forceinline__ float4 ld_bf4(const bf16_t* p) { const uint2 w = *(const uint2*)p; return make_float4(__uint_as_float(w.x << 16), __uint_as_float(w.x & 0xffff0000u), __uint_as_float(w.y << 16), __uint_as_float(w.y & 0xffff0000u)); }

struct ProbIn {
    Params p; int M, N, K, pad;
    __device__ bool setup(int, int&) const { return true; }
    __device__ float4 a4(int, int row, int k) const { return ld_bf4(p.U() + (size_t)row * DM + k); }
    __device__ float4 b4(int, int k, int col) const { return *(const float4*)(p.w_in + (size_t)k * DIN + col); }
    __device__ void epi(int, int row, int col, const float (&v)[4]) const {
#pragma unroll
        for (int j = 0; j < 4; ++j) {
            const int c = col + j; const float z = v[j];
            if (c < OFF_K) p.Qm()[(size_t)row * 512 + c] = f2bf(z * 0.125f);
            else if (c < OFF_V) p.Km()[(size_t)row * 512 + (c - OFF_K)] = f2bf(z);
            else if (c < OFF_O) p.Vm()[(size_t)row * 1024 + (c - OFF_V)] = f2bf(z);
            else if (c < OFF_I) p.OG()[(size_t)row * 1024 + (c - OFF_O)] = f2bf(sigmoidf_(z));
            else if (c < OFF_F) p.GI()[(size_t)row * 16 + (c - OFF_I)] = z + p.m_b_i[c - OFF_I];
            else if (c < OFF_CQ) p.GF()[(size_t)row * 16 + (c - OFF_F)] = logsigmoidf_(z + p.m_b_f[c - OFF_F]);
            else if (c < OFF_CKV) p.CQ()[(size_t)row * 256 + (c - OFF_CQ)] = z;
            else if (c < OFF_KR) p.CKV()[(size_t)row * 128 + (c - OFF_CKV)] = z;
            else if (c < OFF_G) p.KR()[(size_t)row * 64 + (c - OFF_KR)] = z;
            else p.GATE()[(size_t)row * 2048 + (c - OFF_G)] = f2bf(sigmoidf_(z));
        }
    }
};

__global__ void __launch_bounds__(256) k_kprep(Params p) {
    const int lane = threadIdx.x & 63, gw = (blockIdx.x * 256 + threadIdx.x) >> 6, ngw = (gridDim.x * 256) >> 6;
    for (int i = gw; i < NB * KVROWS; i += ngw) {
        const int b = i / KVROWS, key = i % KVROWS; bf16_t* dst = p.Kc() + (size_t)i * 192;
        if (key >= LTOT) { dst[lane] = 0; dst[64 + lane] = 0; dst[128 + lane] = 0; continue; }
        const float *ckv, *kr; int pos;
        if (key < SEQ) { const size_t r = (size_t)b * SEQ + key; ckv = p.CKV() + r * 128; kr = p.KR() + r * 64; pos = NMETA + key; }
        else { const int j = key - SEQ; ckv = p.ZM() + (size_t)j * DIN + OFF_CKV; kr = p.ZM() + (size_t)j * DIN + OFF_KR; pos = j; }
        const float c0 = ckv[lane], c1 = ckv[64 + lane];
        const float rstd = rsqrtf(wave_sum(c0 * c0 + c1 * c1) * (1.f / 128.f) + EPS);
        dst[lane] = f2bf(c0 * rstd * p.a_norm_kv[lane]); dst[64 + lane] = f2bf(c1 * rstd * p.a_norm_kv[64 + lane]);
        if (lane < 32) {
            const float x1 = kr[lane], x2 = kr[32 + lane], cs = p.ROPE()[((size_t)pos * 32 + lane) * 2], sn = p.ROPE()[((size_t)pos * 32 + lane) * 2 + 1];
            dst[128 + lane] = f2bf(x1 * cs - x2 * sn); dst[160 + lane] = f2bf(x1 * sn + x2 * cs);
        }
    }
    for (int r = gw; r < NT; r += ngw) {
        float* cq = p.CQ() + (size_t)r * 256; float v[4]; float ss = 0.f;
#pragma unroll
        for (int j = 0; j < 4; ++j) { v[j] = cq[j * 64 + lane]; ss += v[j] * v[j]; }
        const float rstd = rsqrtf(wave_sum(ss) * (1.f / 256.f) + EPS);
#pragma unroll
        for (int j = 0; j < 4; ++j) cq[j * 64 + lane] = v[j] * rstd * p.a_norm_q[j * 64 + lane];
    }
}

struct ProbQ {
    Params p; int M, N, K, pad;
    __device__ bool setup(int, int&) const { return true; }
    __device__ float4 a4(int, int row, int k) const { return *(const float4*)(p.CQ() + (size_t)row * 256 + k); }
    __device__ float4 b4(int, int k, int col) const { return *(const float4*)(p.WQF() + (size_t)k * 1536 + col); }
    __device__ void epi(int, int row, int col, const float (&v)[4]) const {
        const int h = col / 192, c = col % 192;
        if (c < 128) {
#pragma unroll
            for (int j = 0; j < 4; ++j) p.QP()[(size_t)row * 1536 + col + j] = f2bf(v[j] * QSCALE);
        } else {
#pragma unroll
            for (int j = 0; j < 4; ++j) p.QP()[(size_t)row * 1536 + col + j] = f2bf(v[j] * QSCALE);
        }
        (void)h;
    }
};
__global__ void __launch_bounds__(256) k_rope_q(Params p) {
    const long gid = (long)blockIdx.x * 256 + threadIdx.x;
    if (gid >= (long)NT * 8 * 32) return;
    const int i = (int)(gid & 31), h = (int)((gid >> 5) & 7); const long r = gid >> 8; const int pos = NMETA + (int)(r % SEQ);
    bf16_t* q = p.QP() + (size_t)r * 1536 + h * 192 + 128;
    const float x1 = bf2f(q[i]), x2 = bf2f(q[32 + i]), cs = p.ROPE()[((size_t)pos * 32 + i) * 2], sn = p.ROPE()[((size_t)pos * 32 + i) * 2 + 1];
    q[i] = f2bf(x1 * cs - x2 * sn); q[32 + i] = f2bf(x1 * sn + x2 * cs);
}

__global__ void __launch_bounds__(256) k_mlstm_scan(Params p) {
    __shared__ float ks[64][65]; __shared__ float vs[64][128]; __shared__ float wk[64]; __shared__ float li[64], lf[64]; __shared__ float sc[2];
    const int tid = threadIdx.x, b = blockIdx.x >> 4, h = (blockIdx.x >> 1) & 7, dir = blockIdx.x & 1;
    const int d = tid >> 2, vq = tid & 3;
    float C[32]; float n = 0.f, m = 0.f;
#pragma unroll
    for (int i = 0; i < 32; ++i) C[i] = 0.f;
    bf16_t* CS = dir ? p.CB() : p.CF(); float* NS = dir ? p.NB_() : p.NF(); float* MS = dir ? p.MB() : p.MF();
    const int nsteps = dir ? 64 : 65;
    for (int st = 0; st < nsteps; ++st) {
        const int c = dir ? 63 - st : st - 1;
        if (c >= 0) {
            const size_t sidx = ((size_t)(b * 8 + h) * 64 + c);
            bf16_t* cd = CS + sidx * 8192 + d * 128 + vq * 32;
#pragma unroll
            for (int i = 0; i < 32; ++i) cd[i] = f2bf(C[i]);
            if (vq == 0) NS[sidx * 64 + d] = n;
            if (tid == 0) MS[sidx] = m;
            if ((dir == 0 && c == 63) || (dir == 1 && c == 0)) break;
        }
        const int npos = c < 0 ? NMETA : 64;
        __syncthreads();
        for (int e = tid; e < 64 * 64; e += 256) { const int j = e >> 6, dd = e & 63; float v = 0.f;
            if (j < npos) { if (c < 0) v = p.ZM()[(size_t)j * DIN + OFF_K + h * 64 + dd]; else { const int t = dir ? 63 - j : j; v = bf2f(p.Km()[((size_t)b * SEQ + c * 64 + t) * 512 + h * 64 + dd]); } }
            ks[j][dd] = v; }
        for (int e = tid; e < 64 * 128; e += 256) { const int j = e >> 7, dd = e & 127; float v = 0.f;
            if (j < npos) { if (c < 0) v = p.ZM()[(size_t)j * DIN + OFF_V + h * 128 + dd]; else { const int t = dir ? 63 - j : j; v = bf2f(p.Vm()[((size_t)b * SEQ + c * 64 + t) * 1024 + h * 128 + dd]); } }
            vs[j][dd] = v; }
        if (tid < 64) { float a = -1e30f, f = 0.f; const int j = tid;
            if (j < npos) { if (c < 0) { a = p.ZM()[(size_t)j * DIN + OFF_I + h] + p.m_b_i[h]; f = logsigmoidf_(p.ZM()[(size_t)j * DIN + OFF_F + h] + p.m_b_f[h]); }
                            else { const int t = dir ? 63 - j : j; const size_t r = (size_t)b * SEQ + c * 64 + t; a = p.GI()[r * 16 + dir * 8 + h]; f = p.GF()[r * 16 + dir * 8 + h]; } }
            li[j] = a; lf[j] = f; }
        __syncthreads();
        if (tid == 0) {
            float bl = 0.f; for (int j = 0; j < npos; ++j) bl += lf[j];
            float bc = 0.f, gmax = -1e30f;
            for (int j = 0; j < npos; ++j) { bc += lf[j]; const float g = bl - bc + li[j]; wk[j] = g; gmax = fmaxf(gmax, g); }
            const float mnew = fmaxf(bl + m, gmax);
            for (int j = 0; j < 64; ++j) wk[j] = j < npos ? __expf(wk[j] - mnew) : 0.f;
            sc[0] = __expf(bl + m - mnew); sc[1] = mnew;
        }
        __syncthreads();
        const float decay = sc[0]; m = sc[1];
#pragma unroll
        for (int i = 0; i < 32; ++i) C[i] *= decay;
        n *= decay;
        for (int j = 0; j < npos; ++j) { const float kw = wk[j] * ks[j][d]; n += kw;
#pragma unroll
            for (int i = 0; i < 32; ++i) C[i] += kw * vs[j][vq * 32 + i]; }
    }
}

constexpr int MO_LDS = (64 * 65 * 3 + 64 * 128 * 2 + 64 * 8) * 4;
__global__ void __launch_bounds__(256) k_mlstm_out(Params p) {
    extern __shared__ __attribute__((aligned(16))) float sm[];
    float (*qs)[65] = (float (*)[65])sm; float (*ks)[65] = (float (*)[65])(sm + 64 * 65); float (*Ws)[65] = (float (*)[65])(sm + 2 * 64 * 65);
    float (*vs)[128] = (float (*)[128])(sm + 3 * 64 * 65); float (*Cs)[128] = (float (*)[128])(sm + 3 * 64 * 65 + 64 * 128);
    float* sx = sm + 3 * 64 * 65 + 2 * 64 * 128; float *li = sx, *lf = sx + 64, *bt = sx + 128, *mt = sx + 192, *as = sx + 256, *ns = sx + 320, *msc = sx + 384;
    const int tid = threadIdx.x, c = blockIdx.x & 63, h = (blockIdx.x >> 6) & 7, b = blockIdx.x >> 9;
    const int t = tid >> 2, vq = tid & 3; const size_t r0 = (size_t)b * SEQ + c * 64;
    for (int e = tid; e < 64 * 64; e += 256) { const int j = e >> 6, dd = e & 63; qs[j][dd] = bf2f(p.Qm()[(r0 + j) * 512 + h * 64 + dd]); ks[j][dd] = bf2f(p.Km()[(r0 + j) * 512 + h * 64 + dd]); }
    for (int e = tid; e < 64 * 128; e += 256) { const int j = e >> 7, dd = e & 127; vs[j][dd] = bf2f(p.Vm()[(r0 + j) * 1024 + h * 128 + dd]); }
    __syncthreads();
    float S[16];
#pragma unroll
    for (int i = 0; i < 16; ++i) { const int s = vq * 16 + i; float a = 0.f;
#pragma unroll 4
        for (int dd = 0; dd < 64; ++dd) a += qs[t][dd] * ks[s][dd]; S[i] = a; }
    float hacc[32];
#pragma unroll
    for (int i = 0; i < 32; ++i) hacc[i] = 0.f;
#pragma unroll 1
    for (int dir = 0; dir < 2; ++dir) {
        const size_t sidx = ((size_t)(b * 8 + h) * 64 + c);
        const bf16_t* CS = (dir ? p.CB() : p.CF()) + sidx * 8192; const float* NS = (dir ? p.NB_() : p.NF()) + sidx * 64; const float* MS = (dir ? p.MB() : p.MF()) + sidx;
        __syncthreads();
        for (int e = tid; e < 64 * 128; e += 256) Cs[e >> 7][e & 127] = bf2f(CS[e]);
        if (tid < 64) { ns[tid] = NS[tid]; li[tid] = p.GI()[(r0 + tid) * 16 + dir * 8 + h]; lf[tid] = p.GF()[(r0 + tid) * 16 + dir * 8 + h]; }
        if (tid == 0) msc[0] = MS[0];
        __syncthreads();
        if (tid == 0) {
            const float m = msc[0]; float bc = 0.f, pm = -1e30f;
            if (dir == 0) { for (int j = 0; j < 64; ++j) { bc += lf[j]; const float a = li[j] - bc; as[j] = a; pm = fmaxf(pm, a); bt[j] = bc; mt[j] = fmaxf(bc + m, bc + pm); } }
            else { for (int j = 63; j >= 0; --j) { bc += lf[j]; const float a = li[j] - bc; as[j] = a; pm = fmaxf(pm, a); bt[j] = bc; mt[j] = fmaxf(bc + m, bc + pm); } }
        }
        __syncthreads();
        const float m = msc[0], b_t = bt[t], m_t = mt[t];
#pragma unroll
        for (int i = 0; i < 16; ++i) { const int s = vq * 16 + i; const bool valid = dir ? (s >= t) : (s <= t); Ws[t][s] = valid ? __expf(b_t + as[s] - m_t) * S[i] : 0.f; }
        __syncthreads();
        const float s_inter = __expf(b_t + m - m_t);
        float num[32]; float den = 0.f, qn = 0.f;
#pragma unroll
        for (int i = 0; i < 32; ++i) num[i] = 0.f;
#pragma unroll 2
        for (int dd = 0; dd < 64; ++dd) { const float qv = qs[t][dd]; qn += qv * ns[dd];
#pragma unroll
            for (int i = 0; i < 32; ++i) num[i] += qv * Cs[dd][vq * 32 + i]; }
#pragma unroll
        for (int i = 0; i < 32; ++i) num[i] *= s_inter;
        den = s_inter * qn;
#pragma unroll 2
        for (int s = 0; s < 64; ++s) { const float w = Ws[t][s]; den += w;
#pragma unroll
            for (int i = 0; i < 32; ++i) num[i] += w * vs[s][vq * 32 + i]; }
        const float inv = 1.f / fmaxf(fabsf(den), __expf(-m_t));
#pragma unroll
        for (int i = 0; i < 32; ++i) hacc[i] += num[i] * inv;
    }
    float ss = 0.f;
#pragma unroll
    for (int i = 0; i < 32; ++i) ss += hacc[i] * hacc[i];
    ss += __shfl_xor(ss, 1); ss += __shfl_xor(ss, 2);
    const float rstd = rsqrtf(ss * (1.f / 128.f) + EPS);
#pragma unroll
    for (int i = 0; i < 32; ++i) { const int col = h * 128 + vq * 32 + i; const size_t o = (r0 + t) * 1024 + col;
        p.HM()[o] = f2bf(hacc[i] * rstd * p.m_norm[col] * bf2f(p.OG()[o])); }
}

__global__ void __launch_bounds__(256) k_attn(Params p) {
    __shared__ float kt[32][192];
    const int tid = threadIdx.x, qi = tid >> 2, sl = tid & 3, qb = blockIdx.x & 63, h = (blockIdx.x >> 6) & 7, b = blockIdx.x >> 9;
    const size_t r = (size_t)b * SEQ + qb * 64 + qi;
    float q[48], o[32]; float m = -1e30f, l = 0.f;
#pragma unroll
    for (int i = 0; i < 48; ++i) q[i] = bf2f(p.QP()[r * 1536 + h * 192 + i * 4 + sl]);
#pragma unroll
    for (int i = 0; i < 32; ++i) o[i] = 0.f;
    const bf16_t* Kb = p.Kc() + (size_t)b * KVROWS * 192;
#pragma unroll 1
    for (int tile = 0; tile < KVROWS / 32; ++tile) {
        __syncthreads();
        for (int e = tid; e < 32 * 192; e += 256) kt[e / 192][e % 192] = bf2f(Kb[(size_t)tile * 32 * 192 + e]);
        __syncthreads();
#pragma unroll 1
        for (int g = 0; g < 4; ++g) {
            float s[8]; float tmax = -1e30f;
#pragma unroll
            for (int j = 0; j < 8; ++j) { float a = 0.f; const float* kr = &kt[g * 8 + j][sl];
#pragma unroll
                for (int i = 0; i < 48; ++i) a += q[i] * kr[i * 4];
                a += __shfl_xor(a, 1); a += __shfl_xor(a, 2);
                if (tile * 32 + g * 8 + j >= LTOT) a = -1e30f;
                s[j] = a; tmax = fmaxf(tmax, a); }
            const float mn = fmaxf(m, tmax), alpha = exp2f(m - mn); m = mn; l *= alpha;
#pragma unroll
            for (int i = 0; i < 32; ++i) o[i] *= alpha;
#pragma unroll
            for (int j = 0; j < 8; ++j) { const float pj = (tile * 32 + g * 8 + j >= LTOT) ? 0.f : exp2f(s[j] - mn); l += pj; const float* kr = &kt[g * 8 + j][sl];
#pragma unroll
                for (int i = 0; i < 32; ++i) o[i] += pj * kr[i * 4]; }
        }
    }
    const float inv = 1.f / l;
#pragma unroll
    for (int i = 0; i < 32; ++i) p.OA()[r * 1024 + h * 128 + i * 4 + sl] = f2bf(o[i] * inv);
}

struct ProbYm {
    Params p; int M, N, K, pad;
    __device__ bool setup(int, int&) const { return true; }
    __device__ float4 a4(int, int row, int k) const { return ld_bf4(p.HM() + (size_t)row * DM + k); }
    __device__ float4 b4(int, int k, int col) const { return *(const float4*)(p.w_m_proj + (size_t)k * DM + col); }
    __device__ void epi(int, int row, int col, const float (&v)[4]) const {
#pragma unroll
        for (int j = 0; j < 4; ++j) p.MIX()[(size_t)row * DM + col + j] = f2bf(v[j] * bf2f(p.GATE()[(size_t)row * 2048 + col + j]));
    }
};
struct ProbYa {
    Params p; int M, N, K, pad;
    __device__ bool setup(int, int&) const { return true; }
    __device__ float4 a4(int, int row, int k) const { return ld_bf4(p.OA() + (size_t)row * DM + k); }
    __device__ float4 b4(int, int k, int col) const { return *(const float4*)(p.WOF() + (size_t)k * DM + col); }
    __device__ void epi(int, int row, int col, const float (&v)[4]) const {
#pragma unroll
        for (int j = 0; j < 4; ++j) { const size_t o = (size_t)row * DM + col + j; p.MIX()[o] = f2bf(bf2f(p.MIX()[o]) + v[j] * bf2f(p.GATE()[(size_t)row * 2048 + 1024 + col + j])); }
    }
};
struct ProbOut {
    Params p; int M, N, K, pad;
    __device__ bool setup(int, int&) const { return true; }
    __device__ float4 a4(int, int row, int k) const { return ld_bf4(p.MIX() + (size_t)row * DM + k); }
    __device__ float4 b4(int, int k, int col) const { return *(const float4*)(p.w_out + (size_t)k * DM + col); }
    __device__ void epi(int, int row, int col, const float (&v)[4]) const {
        const float4 xv = *(const float4*)(p.x + (size_t)row * DM + col);
        *(float4*)(p.out + (size_t)row * DM + col) = make_float4(xv.x + v[0], xv.y + v[1], xv.z + v[2], xv.w + v[3]);
    }
};

__global__ void __launch_bounds__(256) k_route(Params p) {
    __shared__ float xn[8][1024];
    const int tid = threadIdx.x, lane = tid & 63, w = tid >> 6;
    for (int base = blockIdx.x * 8; base < NT; base += gridDim.x * 8) {
        __syncthreads();
        for (int rr = 0; rr < 2; ++rr) {
            const int row = base + w * 2 + rr; const float* src = p.out + (size_t)row * DM;
            float4 v[4]; float ss = 0.f;
#pragma unroll
            for (int j = 0; j < 4; ++j) { v[j] = *(const float4*)(src + (j * 64 + lane) * 4); ss += v[j].x * v[j].x + v[j].y * v[j].y + v[j].z * v[j].z + v[j].w * v[j].w; }
            const float rstd = rsqrtf(wave_sum(ss) * (1.f / DM) + EPS);
#pragma unroll
            for (int j = 0; j < 4; ++j) { const int c = (j * 64 + lane) * 4; const float4 g = *(const float4*)(p.norm_ffn + c);
                const float a0 = v[j].x * rstd * g.x, a1 = v[j].y * rstd * g.y, a2 = v[j].z * rstd * g.z, a3 = v[j].w * rstd * g.w;
                float* d = &xn[w * 2 + rr][c]; d[0] = a0; d[1] = a1; d[2] = a2; d[3] = a3;
                bf16_t* o = p.XN2() + (size_t)row * DM + c; o[0] = f2bf(a0); o[1] = f2bf(a1); o[2] = f2bf(a2); o[3] = f2bf(a3); }
        }
        __syncthreads();
        const int rloc = w * 2 + (lane >> 5), e = lane & 31, row = base + rloc;
        float acc = p.b_router[e];
        for (int k = 0; k < DM; ++k) acc += xn[rloc][k] * p.w_router[(size_t)k * NEXP + e];
        float val = acc; int ti[4]; float tv[4];
#pragma unroll
        for (int kk = 0; kk < 4; ++kk) {
            float best = val; int bi = e;
#pragma unroll
            for (int o = 1; o < 32; o <<= 1) { const float ov = __shfl_xor(best, o); const int oi = __shfl_xor(bi, o); if (ov > best || (ov == best && oi < bi)) { best = ov; bi = oi; } }
            ti[kk] = bi; tv[kk] = best; if (e == bi) val = -3.0e38f;
        }
        if (e == 0) {
            const float mx = tv[0]; float ex[4], sum = 0.f;
#pragma unroll
            for (int kk = 0; kk < 4; ++kk) { ex[kk] = __expf(tv[kk] - mx); sum += ex[kk]; }
#pragma unroll
            for (int kk = 0; kk < 4; ++kk) { p.TOPI()[row * 4 + kk] = ti[kk]; p.TOPW()[row * 4 + kk] = ex[kk] / sum; p.RANK()[row * 4 + kk] = atomicAdd(&p.CNT()[ti[kk] * CNT_STRIDE], 1); }
        }
    }
}
__device__ __forceinline__ int expert_pstart(const int* cnt, int e) { int s = 0; for (int i = 0; i < e; ++i) s += (cnt[i * CNT_STRIDE] + 255) / 256 * 256; return s; }
__global__ void __launch_bounds__(256) k_scatter(Params p) {
    __shared__ int ps[NEXP];
    if (threadIdx.x < NEXP) ps[threadIdx.x] = expert_pstart(p.CNT(), threadIdx.x);
    __syncthreads();
    const int gid = blockIdx.x * 256 + threadIdx.x; if (gid >= NT * 4) return;
    const int slot = ps[p.TOPI()[gid]] + p.RANK()[gid]; p.SLOTS()[gid] = slot; p.SLOT_TOK()[slot] = gid >> 2;
}

struct ProbM1 {
    Params p; int M, N, K, pad;
    __device__ bool setup(int tm, int& e) const {
        int s = 0; e = -1;
        for (int i = 0; i < NEXP; ++i) { const int pc = (p.CNT()[i * CNT_STRIDE] + 255) / 256 * 256; if (tm * 64 < s + pc) { e = i; break; } s += pc; }
        return e >= 0;
    }
    __device__ float4 a4(int, int row, int k) const { const int tok = p.SLOT_TOK()[row]; return tok < 0 ? make_float4(0.f, 0.f, 0.f, 0.f) : ld_bf4(p.XN2() + (size_t)tok * DM + k); }
    __device__ float4 b4(int e, int k, int col) const { const float* w = p.w1 + ((size_t)e * DM + k) * 2048 + (col >> 1); const float2 g = *(const float2*)w, l = *(const float2*)(w + 1024); return make_float4(g.x, l.x, g.y, l.y); }
    __device__ void epi(int e, int row, int col, const float (&v)[4]) const {
#pragma unroll
        for (int j = 0; j < 2; ++j) { const int c = (col >> 1) + j; const float g0 = v[2 * j] + p.b1[(size_t)e * 2048 + c], l0 = v[2 * j + 1] + p.b1[(size_t)e * 2048 + 1024 + c];
            const float glu = fminf(g0, 7.f), lin = fminf(fmaxf(l0, -7.f), 7.f);
            p.ACT()[(size_t)row * DFF + c] = f2bf(glu * sigmoidf_(1.702f * glu) * (lin + 1.f)); }
    }
};
struct ProbM2 {
    Params p; int M, N, K, pad;
    __device__ bool setup(int tm, int& e) const {
        int s = 0; e = -1;
        for (int i = 0; i < NEXP; ++i) { const int pc = (p.CNT()[i * CNT_STRIDE] + 255) / 256 * 256; if (tm * 64 < s + pc) { e = i; break; } s += pc; }
        return e >= 0;
    }
    __device__ float4 a4(int, int row, int k) const { return ld_bf4(p.ACT() + (size_t)row * DFF + k); }
    __device__ float4 b4(int e, int k, int col) const { return *(const float4*)(p.w2 + ((size_t)e * DFF + k) * DM + col); }
    __device__ void epi(int e, int row, int col, const float (&v)[4]) const {
#pragma unroll
        for (int j = 0; j < 4; ++j) p.YB()[(size_t)row * DM + col + j] = f2bf(v[j] + p.b2[(size_t)e * DM + col + j]);
    }
};

__global__ void __launch_bounds__(256) k_combine(Params p) {
    const int lane = threadIdx.x & 63, gw = (blockIdx.x * 256 + threadIdx.x) >> 6, ngw = (gridDim.x * 256) >> 6;
    for (int r = gw; r < NT; r += ngw) {
        float4 v[4];
#pragma unroll
        for (int j = 0; j < 4; ++j) v[j] = *(const float4*)(p.out + (size_t)r * DM + (j * 64 + lane) * 4);
#pragma unroll
        for (int kk = 0; kk < 4; ++kk) { const float w = p.TOPW()[r * 4 + kk]; const bf16_t* y = p.YB() + (size_t)p.SLOTS()[r * 4 + kk] * DM;
#pragma unroll
            for (int j = 0; j < 4; ++j) { const float4 t = ld_bf4(y + (j * 64 + lane) * 4); v[j].x += w * t.x; v[j].y += w * t.y; v[j].z += w * t.z; v[j].w += w * t.w; } }
        float ss = 0.f;
#pragma unroll
        for (int j = 0; j < 4; ++j) ss += v[j].x * v[j].x + v[j].y * v[j].y + v[j].z * v[j].z + v[j].w * v[j].w;
        const float rstd = rsqrtf(wave_sum(ss) * (1.f / DM) + EPS);
#pragma unroll
        for (int j = 0; j < 4; ++j) { const int c = (j * 64 + lane) * 4; const float4 g = *(const float4*)(p.norm_final + c);
            *(float4*)(p.out + (size_t)r * DM + c) = make_float4(v[j].x * rstd * g.x, v[j].y * rstd * g.y, v[j].z * rstd * g.z, v[j].w * rstd * g.w); }
    }
}

#define LAS __attribute__((address_space(3)))
typedef short bf16x8 __attribute__((ext_vector_type(8)));
typedef float f32x4 __attribute__((ext_vector_type(4)));
typedef float f32x2 __attribute__((ext_vector_type(2)));
typedef unsigned u32x4 __attribute__((ext_vector_type(4)));
typedef unsigned u32x2 __attribute__((ext_vector_type(2)));
typedef int v4i __attribute__((ext_vector_type(4)));
typedef int v8i __attribute__((ext_vector_type(8)));

constexpr int MK_THREADS = 512;
constexpr int RING_BYTES = 131072, MISC_OFF = RING_BYTES, MK_LDS = 147456;
constexpr int NIN_PAD = 5632;

namespace pg8 {
constexpr int BM = 256, BK = 64, HALF = 128, HTB = HALF * BK * 2, NXCD = 8, WGM = 8;
__host__ __device__ __forceinline__ int lds_byte(int r, int c) { const int st = (r >> 4) * 2 + (c >> 5), rr = r & 15, cc = c & 31, ob = rr * 64 + cc * 2; return st * 1024 + (ob ^ (((ob >> 9) & 1) << 5)); }
__host__ __device__ __forceinline__ void stage_rc(int b, int& R, int& C) { const int st = b / 1024, sb = b % 1024, swz = sb ^ (((sb >> 9) & 1) << 5); R = (st >> 1) * 16 + swz / 64; C = (st & 1) * 32 + (swz % 64) / 2; }
__host__ __device__ __forceinline__ int perm32(int rho) { const int n = rho >> 4, i = rho & 15; return 8 * (i >> 2) + 4 * n + (i & 3); }
__device__ __forceinline__ unsigned cvt_pk_bf16(float lo, float hi) { unsigned r; asm volatile("v_cvt_pk_bf16_f32 %0, %1, %2" : "=v"(r) : "v"(lo), "v"(hi)); return r; }

struct Unit { int pm, pn, e; const char* A; const char* B; };

struct StaticOrder {
    int nM, nN, nwg, G, c; const char* A; const char* Bt; size_t btile;
    __device__ void init(int M, int N, int K, int G_, int c_, const void* A_, const void* Bt_) { nM = M / BM; nN = N / BM; nwg = nM * nN; G = G_; c = c_; A = (const char*)A_; Bt = (const char*)Bt_; btile = (size_t)BM * K * 2; }
    __device__ bool next(int i, Unit& u) const {
        const long L = (long)i * G + c; if (L >= nwg) return false;
        int wgid = (int)L; { const int q = nwg / NXCD, r = nwg % NXCD, xcd = wgid % NXCD, off = wgid / NXCD; wgid = (xcd < r ? xcd * (q + 1) : r * (q + 1) + (xcd - r) * q) + off; }
        const int nig = WGM * nN, gid = wgid / nig, fm = gid * WGM, gsz = (nM - fm) < WGM ? (nM - fm) : WGM;
        u.pm = fm + ((wgid % nig) % gsz); u.pn = (wgid % nig) / gsz; u.e = 0; u.A = A; u.B = Bt + (size_t)u.pn * btile; return true;
    }
    __device__ __forceinline__ int arow(int r) const { return r; }
    __device__ __forceinline__ int arow_l(const volatile LAS int*, int r, int) const { return r; }
    __device__ __forceinline__ const int* rows_src(const Unit&, int) const { return nullptr; }
    static constexpr bool HAS_BIAS = false;
    __device__ __forceinline__ const float* bias_src(const Unit&, int) const { return nullptr; }
};
template <int NN> struct StaticOrderN {
    static constexpr int nM = NT / BM, nwg = nM * NN, nig = WGM * NN;
    static_assert(nM % WGM == 0, "row groups are full");
    int G, c; const char* A; const char* Bt; size_t btile;
    __device__ void init(int K, int G_, int c_, const void* A_, const void* Bt_) { G = G_; c = c_; A = (const char*)A_; Bt = (const char*)Bt_; btile = (size_t)BM * K * 2; }
    __device__ bool next(int i, Unit& u) const {
        const int L = i * G + c; if (L >= nwg) return false;
        constexpr int q = nwg / NXCD, r = nwg % NXCD; const int xcd = L & (NXCD - 1), off = L >> 3;
        const int wgid = (xcd < r ? xcd * (q + 1) : r * (q + 1) + (xcd - r) * q) + off;
        const int gid = wgid / nig, rem = wgid - gid * nig;
        u.pm = gid * WGM + (rem & (WGM - 1)); u.pn = rem >> 3; u.e = 0; u.A = A; u.B = Bt + (size_t)u.pn * btile; return true;
    }
    __device__ __forceinline__ int arow(int r) const { return r; }
    __device__ __forceinline__ int arow_l(const volatile LAS int*, int r, int) const { return r; }
    __device__ __forceinline__ const int* rows_src(const Unit&, int) const { return nullptr; }
    static constexpr bool HAS_BIAS = false;
    __device__ __forceinline__ const float* bias_src(const Unit&, int) const { return nullptr; }
};
struct MoeOrder {
    const volatile LAS int* tstart;
    int npn, G, c; const char* A; const char* W; size_t wexp, btile; const int* rowidx;
    const float* bias; int bsplit;
    __device__ bool next(int i, Unit& u) const {
        const long L = (long)i * G + c; const int ntile = tstart[NEXP]; if (L >= (long)ntile * npn) return false;
        const int mt = (int)(L / npn), pn = (int)(L % npn);
        const int k = (int)(threadIdx.x & 31u); const int tv = tstart[k];
        const int e = __builtin_popcount((unsigned)__ballot(k >= 1 && tv <= mt));
        u.pm = mt; u.pn = pn; u.e = e; u.A = A; u.B = W + (size_t)e * wexp + (size_t)pn * btile; return true;
    }
    __device__ __forceinline__ int arow(int r) const { if (!rowidx) return r; const int t = rowidx[r]; return t < 0 ? 0 : t; }
    __device__ __forceinline__ int arow_l(const volatile LAS int* tab, int r, int rl) const { if (!rowidx) return r; const int t = tab[rl]; return t < 0 ? 0 : t; }
    __device__ __forceinline__ const int* rows_src(const Unit& u, int lane) const { return rowidx ? rowidx + (size_t)u.pm * BM + lane * 4 : nullptr; }
    static constexpr bool HAS_BIAS = true;
    __device__ __forceinline__ const float* bias_src(const Unit& u, int lane) const {
        return bsplit ? bias + (size_t)u.e * 2048 + (lane >> 5) * 1024 + u.pn * 128 + (lane & 31) * 4 : bias + (size_t)u.e * 1024 + u.pn * 256 + lane * 4; }
};

template <class Epi, class Sched, bool F8 = false>
__device__ __forceinline__ void gemm_phase(LAS unsigned char* lds, const int K, const int lda, const Sched& S, const Epi& E) {
    const int tid = threadIdx.x, wid = __builtin_amdgcn_readfirstlane(tid >> 6), lane = tid & 63, wr = wid >> 2, wc = wid & 3, fr = lane & 15, fq = lane >> 4;
    const int nt = K / BK;
    unsigned voffB[2];
#pragma unroll
    for (int i = 0; i < 2; ++i) { int R, C; stage_rc(tid * 16 + i * 8192, R, C); const int Rb = Epi::PERM ? ((R & ~31) + perm32(R & 31)) : R; voffB[i] = (unsigned)(Rb * K + C) * 2u; }
    const size_t kstep = (size_t)(BK * 2);
    const size_t hstepB = (size_t)HALF * K * 2;
    const unsigned ldsw = (unsigned)wid * 1024u;
    const int aoff = lds_byte(wr * 64 + fr, fq * 8), boff = lds_byte(wc * 32 + fr, fq * 8);
#define PG8_SA(b, h) (((b) * 2 + (h)) * HTB)
#define PG8_SB(b, h) ((4 + (b) * 2 + (h)) * HTB)
#define PG8_STAGE(bufoff, gbase, voff) do { _Pragma("unroll") for (int _i = 0; _i < 2; ++_i) \
        __builtin_amdgcn_global_load_lds((const unsigned*)((const char*)(gbase) + (voff)[_i]), (LAS unsigned*)(lds + (bufoff) + ldsw + _i * 8192), 16, 0, 0); } while (0)
#define PG8_STAGE_B(bufoff, gbase) do { if constexpr (F8) { const u32x2 vo_ = *(const LAS u32x2*)vslot; const unsigned vv_[2] = {vo_[0], vo_[1]}; PG8_STAGE(bufoff, gbase, vv_); } else PG8_STAGE(bufoff, gbase, voffB); } while (0)
#define PG8_STAGE_A(bufoff, gbase, h) do { if constexpr (F8) { const u32x2 vo_ = *(const LAS u32x2*)(vslot + 2 + 2 * (h)); const unsigned vv_[2] = {vo_[0], vo_[1]}; PG8_STAGE(bufoff, gbase, vv_); } else PG8_STAGE(bufoff, gbase, vc[h]); } while (0)
#define PG8_LDA(dst, b, h) do { _Pragma("unroll") for (int m = 0; m < 4; ++m) _Pragma("unroll") for (int k = 0; k < 2; ++k) dst[m][k] = *(const LAS bf16x8*)(lds + PG8_SA(b, h) + aoff + m * 2048 + k * 1024); } while (0)
#define PG8_LDB(dst, b, h) do { _Pragma("unroll") for (int n = 0; n < 2; ++n) _Pragma("unroll") for (int k = 0; k < 2; ++k) dst[n][k] = *(const LAS bf16x8*)(lds + PG8_SB(b, h) + boff + n * 2048 + k * 1024); } while (0)
#define PG8_MMA(ai, bj, At, Bt) do { __builtin_amdgcn_s_setprio(1); _Pragma("unroll") for (int m = 0; m < 4; ++m) _Pragma("unroll") for (int n = 0; n < 2; ++n) _Pragma("unroll") for (int k = 0; k < 2; ++k) \
        acc[ai][bj][m][n] = __builtin_amdgcn_mfma_f32_16x16x32_bf16(Bt[n][k], At[m][k], acc[ai][bj][m][n], 0, 0, 0); __builtin_amdgcn_s_setprio(0); } while (0)
#define PG8_LDA8(dst, b, h) do { _Pragma("unroll") for (int m = 0; m < 4; ++m) dst[m] = __builtin_shufflevector(*(const LAS v4i*)(lds + PG8_SA(b, h) + aoff + m * 2048), *(const LAS v4i*)(lds + PG8_SA(b, h) + aoff + m * 2048 + 1024), 0, 1, 2, 3, 4, 5, 6, 7); } while (0)
#define PG8_LDB8(dst, b, h) do { _Pragma("unroll") for (int n = 0; n < 2; ++n) dst[n] = __builtin_shufflevector(*(const LAS v4i*)(lds + PG8_SB(b, h) + boff + n * 2048), *(const LAS v4i*)(lds + PG8_SB(b, h) + boff + n * 2048 + 1024), 0, 1, 2, 3, 4, 5, 6, 7); } while (0)
#define PG8_MMA8(ai, bj, At, Bt) do { __builtin_amdgcn_s_setprio(1); _Pragma("unroll") for (int m = 0; m < 4; ++m) _Pragma("unroll") for (int n = 0; n < 2; ++n) \
        acc[ai][bj][m][n] = __builtin_amdgcn_mfma_scale_f32_16x16x128_f8f6f4(Bt[n], At[m], acc[ai][bj][m][n], 0, 0, 0, 122, 0, 127); __builtin_amdgcn_s_setprio(0); } while (0)
#define PG8_XLDA(b, h) do { if constexpr (F8) PG8_LDA8(At8, b, h); else PG8_LDA(At, b, h); } while (0)
#define PG8_XLDB0(b, h) do { if constexpr (F8) PG8_LDB8(B08, b, h); else PG8_LDB(B0, b, h); } while (0)
#define PG8_XLDB1(b, h) do { if constexpr (F8) PG8_LDB8(B18, b, h); else PG8_LDB(B1, b, h); } while (0)
#define PG8_XMM0(ai, bj) do { if constexpr (F8) PG8_MMA8(ai, bj, At8, B08); else PG8_MMA(ai, bj, At, B0); } while (0)
#define PG8_XMM1(ai, bj) do { if constexpr (F8) PG8_MMA8(ai, bj, At8, B18); else PG8_MMA(ai, bj, At, B1); } while (0)
#define PG8_WAIT_V(n) asm volatile("s_waitcnt vmcnt(" #n ")" ::: "memory")
#define PG8_WAIT_L(n) asm volatile("s_waitcnt lgkmcnt(" #n ")" ::: "memory")
#define PG8_BAR __builtin_amdgcn_s_barrier()
#define PG8_SCHED __builtin_amdgcn_sched_barrier(0)
#define PG8_VOFFL(dst, u) do { int _tt = tid; asm volatile("" : "+v"(_tt)); _Pragma("unroll") for (int _i = 0; _i < 2; ++_i) { int _R, _C; stage_rc(_tt * 16 + _i * 8192, _R, _C); \
        _Pragma("unroll") for (int _h = 0; _h < 2; ++_h) dst[_h][_i] = (unsigned)(S.arow_l(rowtab, (u).pm * BM + _h * HALF + _R, _h * HALF + _R) * lda + _C) * 2u; } } while (0)
#define PG8_VOFF(dst, u) do { int _tt = tid; asm volatile("" : "+v"(_tt)); _Pragma("unroll") for (int _i = 0; _i < 2; ++_i) { int _R, _C; stage_rc(_tt * 16 + _i * 8192, _R, _C); \
        _Pragma("unroll") for (int _h = 0; _h < 2; ++_h) dst[_h][_i] = (unsigned)(S.arow((u).pm * BM + _h * HALF + _R) * lda + _C) * 2u; } } while (0)
    constexpr bool HB = Sched::HAS_BIAS;
    LAS float* bias_l = (LAS float*)(lds + MISC_OFF + 13312);
    volatile LAS int* rowtab = (volatile LAS int*)(lds + MISC_OFF + 14336);
#define PG8_ROWS(u) do { if constexpr (HB) { const int* rs_ = S.rows_src(u, lane); if (wid == 0 && rs_) __builtin_amdgcn_global_load_lds((const unsigned*)rs_, (LAS unsigned*)(lds + MISC_OFF + 14336), 16, 0, 0); } } while (0)
#define PG8_BIAS(u) do { if constexpr (HB) { if (wid == 0) __builtin_amdgcn_global_load_lds((const unsigned*)S.bias_src(u, lane), (LAS unsigned*)bias_l, 16, 0, 0); } } while (0)
#define PG8_ACC_INIT() do { f32x4 bv_[2][2]; _Pragma("unroll") for (int b = 0; b < 2; ++b) _Pragma("unroll") for (int n = 0; n < 2; ++n) { \
        if constexpr (HB) bv_[b][n] = *(const LAS f32x4*)(bias_l + b * 128 + wc * 32 + 8 * fq + 4 * n); else bv_[b][n] = (f32x4){0.f, 0.f, 0.f, 0.f}; } \
        _Pragma("unroll") for (int a = 0; a < 2; ++a) _Pragma("unroll") for (int b = 0; b < 2; ++b) _Pragma("unroll") for (int m = 0; m < 4; ++m) _Pragma("unroll") for (int n = 0; n < 2; ++n) acc[a][b][m][n] = bv_[b][n]; } while (0)
    Unit cur, nxt; int ui = 0;
    if (!S.next(0, cur)) return;
    f32x4 acc[2][2][4][2];
    bf16x8 At[4][2], B0[2][2], B1[2][2]; v8i At8[4], B08[2], B18[2];
    unsigned vc[2][2], vn[2][2];
    LAS unsigned* vslot = (LAS unsigned*)(lds + MISC_OFF + 1024) + tid * 6;
    PG8_VOFF(vc, cur);
    if constexpr (F8) { vslot[0] = voffB[0]; vslot[1] = voffB[1]; vslot[2] = vc[0][0]; vslot[3] = vc[0][1]; vslot[4] = vc[1][0]; vslot[5] = vc[1][1]; }
    const char* cA = cur.A; const char* cB = cur.B;
    PG8_BIAS(cur);
    PG8_STAGE_B(PG8_SB(0, 0), cB); PG8_STAGE_B(PG8_SB(0, 1), cB + hstepB); PG8_STAGE_A(PG8_SA(0, 0), cA, 0); PG8_STAGE_A(PG8_SA(0, 1), cA, 1);
    if (wr == 1) PG8_BAR;
    PG8_WAIT_V(2); PG8_BAR;
    PG8_STAGE_B(PG8_SB(1, 0), cB + kstep); PG8_STAGE_A(PG8_SA(1, 0), cA + kstep, 0); PG8_STAGE_B(PG8_SB(1, 1), cB + hstepB + kstep);
    PG8_WAIT_V(6); PG8_BAR;
    PG8_ACC_INIT();
    for (;;) {
        const bool has_next = S.next(ui + 1, nxt);
        const char* nA = has_next ? nxt.A : cA; const char* nB = has_next ? nxt.B : cB;
#pragma unroll 1
        for (int t = 0; t < nt; t += 2) {
            const bool last = (t == nt - 2);
            const char* a1 = cA + (size_t)(t + 1) * kstep;
            const char* a2 = last ? nA : cA + (size_t)(t + 2) * kstep; const char* b2 = last ? nB : cB + (size_t)(t + 2) * kstep;
            const char* a3 = a2 + kstep; const char* b3 = b2 + kstep;
            if constexpr (HB) { if (t == nt - 4 && has_next) PG8_ROWS(nxt); }
            if (last && has_next) { if constexpr (HB) { PG8_VOFFL(vn, nxt); } else { PG8_VOFF(vn, nxt); } PG8_BIAS(nxt); }
            PG8_XLDB0(0, 0); PG8_XLDB1(0, 1); PG8_SCHED; PG8_XLDA(0, 0); PG8_STAGE_A(PG8_SA(1, 1), a1, 1);
            PG8_WAIT_V(8); PG8_WAIT_L(0); PG8_BAR; PG8_XMM0(0, 0); PG8_XMM1(0, 1); PG8_BAR; PG8_SCHED;
            if (last && has_next) {
                if constexpr (F8) { vslot[2] = vn[0][0]; vslot[3] = vn[0][1]; vslot[4] = vn[1][0]; vslot[5] = vn[1][1]; }
                else {
#pragma unroll
                for (int h = 0; h < 2; ++h)
#pragma unroll
                    for (int i = 0; i < 2; ++i) vc[h][i] = vn[h][i];
                }
            }
            PG8_XLDA(0, 1); PG8_STAGE_B(PG8_SB(0, 0), b2); PG8_STAGE_B(PG8_SB(0, 1), b2 + hstepB); PG8_STAGE_A(PG8_SA(0, 0), a2, 0);
            PG8_WAIT_V(8); PG8_WAIT_L(0); PG8_BAR; PG8_XMM0(1, 0); PG8_XMM1(1, 1); PG8_BAR; PG8_SCHED;
            PG8_XLDB0(1, 0); PG8_XLDB1(1, 1); PG8_SCHED; PG8_XLDA(1, 0); PG8_STAGE_A(PG8_SA(0, 1), a2, 1);
            PG8_WAIT_V(8); PG8_WAIT_L(0); PG8_BAR; PG8_XMM0(0, 0); PG8_XMM1(0, 1); PG8_BAR; PG8_SCHED;
            PG8_XLDA(1, 1); PG8_STAGE_B(PG8_SB(1, 0), b3); PG8_STAGE_B(PG8_SB(1, 1), b3 + hstepB); PG8_STAGE_A(PG8_SA(1, 0), a3, 0);
            PG8_WAIT_V(8); PG8_WAIT_L(0); PG8_BAR; PG8_XMM0(1, 0); PG8_XMM1(1, 1); PG8_BAR; PG8_SCHED;
        }
        if (wr == 0) PG8_BAR;
        E(acc, cur, wr, wc, fr, fq);
        if (!has_next) break;
        PG8_ACC_INIT();
        cur = nxt; cA = nA; cB = nB; ++ui;
        if (wr == 1) PG8_BAR;
    }
    PG8_WAIT_V(0);
    PG8_BAR;
#undef PG8_SA
#undef PG8_SB
#undef PG8_STAGE
#undef PG8_STAGE_A
#undef PG8_STAGE_B
#undef PG8_LDA
#undef PG8_LDB
#undef PG8_MMA
#undef PG8_MMA8
#undef PG8_LDA8
#undef PG8_LDB8
#undef PG8_XLDA
#undef PG8_XLDB0
#undef PG8_XLDB1
#undef PG8_XMM0
#undef PG8_XMM1
#undef PG8_WAIT_V
#undef PG8_WAIT_L
#undef PG8_BAR
#undef PG8_SCHED
#undef PG8_VOFF
#undef PG8_VOFFL
#undef PG8_ROWS
#undef PG8_BIAS
#undef PG8_ACC_INIT
}
}

__device__ __forceinline__ unsigned pk4_fp8(float a, float b, float c, float d) { int p = 0; p = __builtin_amdgcn_cvt_pk_fp8_f32(a, b, p, false); p = __builtin_amdgcn_cvt_pk_fp8_f32(c, d, p, true); return (unsigned)p; }
constexpr float YB_SCALE = 8.f;
constexpr float W8_SCALE = 32.f;
__device__ __forceinline__ void st8_bf16(bf16_t* dst, const f32x4 v0, const f32x4 v1) {
    u32x4 w; w.x = pg8::cvt_pk_bf16(v0[0], v0[1]); w.y = pg8::cvt_pk_bf16(v0[2], v0[3]); w.z = pg8::cvt_pk_bf16(v1[0], v1[1]); w.w = pg8::cvt_pk_bf16(v1[2], v1[3]);
    *(u32x4*)dst = w;
}
__device__ __forceinline__ void ld8_bf16(const bf16_t* src, f32x4& v0, f32x4& v1) {
    const u32x4 w = *(const u32x4*)src;
    v0 = (f32x4){__uint_as_float(w.x << 16), __uint_as_float(w.x & 0xffff0000u), __uint_as_float(w.y << 16), __uint_as_float(w.y & 0xffff0000u)};
    v1 = (f32x4){__uint_as_float(w.z << 16), __uint_as_float(w.z & 0xffff0000u), __uint_as_float(w.w << 16), __uint_as_float(w.w & 0xffff0000u)};
}
__device__ __forceinline__ f32x4 sig4(f32x4 v) {
    f32x4 e = v * -1.4426950408889634f;
#pragma unroll
    for (int j = 0; j < 4; ++j) e[j] = __builtin_amdgcn_exp2f(e[j]);
    e = e + 1.f;
#pragma unroll
    for (int j = 0; j < 4; ++j) e[j] = __builtin_amdgcn_rcpf(e[j]);
    return e;
}

template <int PART> struct EpiIn {
    static constexpr bool PERM = true;
    Params p;
    __device__ __forceinline__ void operator()(const f32x4 (&acc)[2][2][4][2], const pg8::Unit& u, int wr, int wc, int fr, int fq) const {
        const int pn = u.pn; const size_t row0 = (size_t)u.pm * 256 + wr * 64 + fr; const int cl0 = wc * 32 + 8 * fq;
        if (PART == 1 || pn < 21) {
            bf16_t* base; int ld, c0; int mode;
            if (PART != 1 && pn < 2) { base = p.Qm(); ld = 512; c0 = pn * 256; mode = 1; }
            else if (PART != 1 && pn < 4) { base = p.Km(); ld = 512; c0 = (pn - 2) * 256; mode = 0; }
            else if (PART != 1 && pn < 8) { base = p.Vm(); ld = 1024; c0 = (pn - 4) * 256; mode = 0; }
            else if (PART != 0 && pn < 12) { base = p.OG(); ld = 1024; c0 = (pn - 8) * 256; mode = 2; }
            else if (PART != 0 && pn < 20) { base = p.GATE(); ld = 2048; c0 = (pn - 12) * 256; mode = 2; }
            else { base = nullptr; ld = 256; c0 = 0; mode = 3; }
#pragma unroll
            for (int ai = 0; ai < 2; ++ai)
#pragma unroll
                for (int m = 0; m < 4; ++m) { const size_t r = row0 + ai * 128 + m * 16;
#pragma unroll
                    for (int bj = 0; bj < 2; ++bj) { f32x4 v0 = acc[ai][bj][m][0], v1 = acc[ai][bj][m][1]; const int c = c0 + bj * 128 + cl0;
                        if (PART != 1 && mode == 3) { float* d = p.CQ() + r * 256 + c; *(f32x4*)d = v0; *(f32x4*)(d + 4) = v1; }
                        else { if (PART != 1 && mode == 1) { v0 = v0 * 0.125f; v1 = v1 * 0.125f; } else if (PART != 0 && mode == 2) { v0 = sig4(v0); v1 = sig4(v1); }
                               st8_bf16(base + r * ld + c, v0, v1); } } }
        } else if (PART != 1) {
#pragma unroll
            for (int ai = 0; ai < 2; ++ai)
#pragma unroll
                for (int m = 0; m < 4; ++m) { const size_t r = row0 + ai * 128 + m * 16;
                    { float* d = p.CKV() + r * 128 + cl0; *(f32x4*)d = acc[ai][0][m][0]; *(f32x4*)(d + 4) = acc[ai][0][m][1]; }
                    const f32x4 v0 = acc[ai][1][m][0], v1 = acc[ai][1][m][1];
                    if (wc < 2) { float* d = p.KR() + r * 64 + cl0; *(f32x4*)d = v0; *(f32x4*)(d + 4) = v1; }
                    else if (wc == 2) { const int g = 8 * (fq & 1);
                        if (fq < 2) { float* d = p.GI() + r * 16 + g; const f32x4 b0 = *(const f32x4*)(p.m_b_i + g), b1 = *(const f32x4*)(p.m_b_i + g + 4); *(f32x4*)d = v0 + b0; *(f32x4*)(d + 4) = v1 + b1; }
                        else { float* d = p.GF() + r * 16 + g; const f32x4 b0 = *(const f32x4*)(p.m_b_f + g), b1 = *(const f32x4*)(p.m_b_f + g + 4);
                            *(f32x4*)d = (f32x4){logsigmoidf_(v0[0] + b0[0]), logsigmoidf_(v0[1] + b0[1]), logsigmoidf_(v0[2] + b0[2]), logsigmoidf_(v0[3] + b0[3])};
                            *(f32x4*)(d + 4) = (f32x4){logsigmoidf_(v1[0] + b1[0]), logsigmoidf_(v1[1] + b1[1]), logsigmoidf_(v1[2] + b1[2]), logsigmoidf_(v1[3] + b1[3])}; } } }
        }
    }
};
template <int PART> struct EpiInP {
    static constexpr bool PERM = true;
    Params p;
    __device__ __forceinline__ void operator()(const f32x4 (&acc)[2][2][4][2], const pg8::Unit& u, int wr, int wc, int fr, int fq) const {
        pg8::Unit v = u; v.pn = PART == 0 ? (u.pn < 8 ? u.pn : u.pn + 12) : u.pn + 8;
        EpiIn<PART> E{p}; E(acc, v, wr, wc, fr, fq);
    }
};
struct EpiQ {
    static constexpr bool PERM = true;
    Params p;
    __device__ __forceinline__ void operator()(const f32x4 (&acc)[2][2][4][2], const pg8::Unit& u, int wr, int wc, int fr, int fq) const {
        const size_t row0 = (size_t)u.pm * 256 + wr * 64 + fr;
#pragma unroll
        for (int ai = 0; ai < 2; ++ai)
#pragma unroll
            for (int m = 0; m < 4; ++m) { const size_t r = row0 + ai * 128 + m * 16; const float rs = p.RSQ()[r] * QSCALE; const int pos = NMETA + (int)(r & (SEQ - 1));
#pragma unroll
                for (int bj = 0; bj < 2; ++bj) { const int c = u.pn * 256 + bj * 128 + wc * 32 + 8 * fq; const int local = c % 192;
                    f32x4 v0 = acc[ai][bj][m][0] * rs, v1 = acc[ai][bj][m][1] * rs;
                    if (local >= 128) { const int i0 = (local - 128) >> 1; const float* rp = p.ROPE() + ((size_t)pos * 32 + i0) * 2;
                        const f32x4 cs0 = *(const f32x4*)rp, cs1 = *(const f32x4*)(rp + 4);
                        const f32x4 o0 = (f32x4){v0[0] * cs0[0] - v0[1] * cs0[1], v0[0] * cs0[1] + v0[1] * cs0[0], v0[2] * cs0[2] - v0[3] * cs0[3], v0[2] * cs0[3] + v0[3] * cs0[2]};
                        const f32x4 o1 = (f32x4){v1[0] * cs1[0] - v1[1] * cs1[1], v1[0] * cs1[1] + v1[1] * cs1[0], v1[2] * cs1[2] - v1[3] * cs1[3], v1[2] * cs1[3] + v1[3] * cs1[2]};
                        v0 = o0; v1 = o1; }
                    st8_bf16(p.QP() + r * 1536 + c, v0, v1); }
                asm volatile("" ::: "memory"); }
    }
};
template <int PASS> struct EpiMix {
    static constexpr bool PERM = true;
    Params p;
    __device__ __forceinline__ void operator()(const f32x4 (&acc)[2][2][4][2], const pg8::Unit& u, int wr, int wc, int fr, int fq) const {
        const size_t row0 = (size_t)u.pm * 256 + wr * 64 + fr;
#pragma unroll
        for (int ai = 0; ai < 2; ++ai)
#pragma unroll
            for (int m = 0; m < 4; ++m) { const size_t r = row0 + ai * 128 + m * 16;
#pragma unroll
                for (int bj = 0; bj < 2; ++bj) { const int c = u.pn * 256 + bj * 128 + wc * 32 + 8 * fq;
                    f32x4 g0, g1; ld8_bf16(p.GATE() + r * 2048 + PASS * 1024 + c, g0, g1);
                    f32x4 v0 = acc[ai][bj][m][0] * g0, v1 = acc[ai][bj][m][1] * g1;
                    if (PASS == 1) { f32x4 m0, m1; ld8_bf16(p.MIX() + r * 1024 + c, m0, m1); v0 = v0 + m0; v1 = v1 + m1; }
                    st8_bf16(p.MIX() + r * 1024 + c, v0, v1); } }
    }
};
struct EpiOut {
    static constexpr bool PERM = false;
    Params p;
    __device__ __forceinline__ void operator()(const f32x4 (&acc)[2][2][4][2], const pg8::Unit& u, int wr, int wc, int fr, int fq) const {
        const size_t row0 = (size_t)u.pm * 256 + wr * 64 + fr; const int col0 = u.pn * 256 + wc * 32 + 4 * fq;
#pragma unroll
        for (int ai = 0; ai < 2; ++ai)
#pragma unroll
            for (int m = 0; m < 4; ++m) { const size_t off = (row0 + ai * 128 + m * 16) * DM + col0;
#pragma unroll
                for (int bj = 0; bj < 2; ++bj)
#pragma unroll
                    for (int n = 0; n < 2; ++n) { const f32x4 xv = *(const f32x4*)(p.x + off + bj * 128 + n * 16); *(f32x4*)(p.out + off + bj * 128 + n * 16) = xv + acc[ai][bj][m][n]; } }
    }
};
__device__ __forceinline__ f32x4 swiglu4(f32x4 g, f32x4 l) {
    f32x4 gg, ll, e;
#pragma unroll
    for (int j = 0; j < 4; ++j) { gg[j] = __builtin_amdgcn_fmed3f(g[j], -3.0e38f, 7.f); ll[j] = __builtin_amdgcn_fmed3f(l[j], -7.f, 7.f); }
    e = gg * (-1.702f * 1.4426950408889634f);
#pragma unroll
    for (int j = 0; j < 4; ++j) e[j] = __builtin_amdgcn_exp2f(e[j]);
    e = e + 1.f;
#pragma unroll
    for (int j = 0; j < 4; ++j) e[j] = __builtin_amdgcn_rcpf(e[j]);
    const f32x4 t = gg * e;
    return t * ll + t;
}
struct EpiM1 {
    static constexpr bool PERM = true;
    Params p;
    __device__ __forceinline__ void operator()(const f32x4 (&acc)[2][2][4][2], const pg8::Unit& u, int wr, int wc, int fr, int fq) const {
        const size_t row0 = (size_t)u.pm * 256 + wr * 64 + fr; const int c = u.pn * 128 + wc * 32 + 8 * fq;
#pragma unroll
        for (int ai = 0; ai < 2; ++ai)
#pragma unroll
            for (int m = 0; m < 4; ++m) { const size_t r = row0 + ai * 128 + m * 16;
                const f32x4 a0 = swiglu4(acc[ai][0][m][0], acc[ai][1][m][0]), a1 = swiglu4(acc[ai][0][m][1], acc[ai][1][m][1]);
                u32x2 o8; o8.x = pk4_fp8(a0[0], a0[1], a0[2], a0[3]); o8.y = pk4_fp8(a1[0], a1[1], a1[2], a1[3]); *(u32x2*)((unsigned char*)p.ACT() + r * DFF + c) = o8; }
    }
};
struct EpiM2 {
    static constexpr bool PERM = true;
    Params p;
    __device__ __forceinline__ void operator()(const f32x4 (&acc)[2][2][4][2], const pg8::Unit& u, int wr, int wc, int fr, int fq) const {
        const size_t row0 = (size_t)u.pm * 256 + wr * 64 + fr;
#pragma unroll
        for (int bj = 0; bj < 2; ++bj) { const int c = u.pn * 256 + bj * 128 + wc * 32 + 8 * fq;
#pragma unroll
            for (int ai = 0; ai < 2; ++ai)
#pragma unroll
                for (int m = 0; m < 4; ++m) { const size_t r = row0 + ai * 128 + m * 16; const f32x4 v0 = acc[ai][bj][m][0] * YB_SCALE, v1 = acc[ai][bj][m][1] * YB_SCALE;
                    u32x2 o8; o8.x = pk4_fp8(v0[0], v0[1], v0[2], v0[3]); o8.y = pk4_fp8(v1[0], v1[1], v1[2], v1[3]); *(u32x2*)((unsigned char*)p.YB() + r * DM + c) = o8; } }
    }
};

__device__ __forceinline__ float4 ntld4(const float* p) { const f32x4 v = __builtin_nontemporal_load((const f32x4*)p); return make_float4(v[0], v[1], v[2], v[3]); }
__device__ __forceinline__ uint2 ntld2u(const bf16_t* p) { const u32x2 v = __builtin_nontemporal_load((const u32x2*)p); return make_uint2(v[0], v[1]); }
__device__ __forceinline__ unsigned pk2(float lo, float hi) { return (unsigned)f2bf(lo) | ((unsigned)f2bf(hi) << 16); }
struct TrDesc { const float* W; bf16_t* WT; int ldw, K, dr0, sc0, nvalid, k0, f8; };
__device__ __forceinline__ void tr_load(const TrDesc& d, float4 (&v)[16], int lane) {
    const int lr = lane >> 4, lc = (lane & 15) * 4;
#pragma unroll
    for (int i = 0; i < 16; ++i) v[i] = (lc < d.nvalid) ? ntld4(d.W + (size_t)(d.k0 + i * 4 + lr) * d.ldw + d.sc0 + lc) : make_float4(0.f, 0.f, 0.f, 0.f);
}
__device__ __forceinline__ void tr_finish(const TrDesc& d, const float4 (&v)[16], LAS float* scr, int lane) {
    const int lr = lane >> 4, lc = (lane & 15) * 4;
#pragma unroll
    for (int i = 0; i < 16; ++i) { LAS float* q = scr + (i * 4 + lr) * 65 + lc; q[0] = v[i].x; q[1] = v[i].y; q[2] = v[i].z; q[3] = v[i].w; }
    asm volatile("s_waitcnt lgkmcnt(0)" ::: "memory");
    const int c = lane & 7;
    if (d.f8) {
#pragma unroll
        for (int j = 0; j < 8; ++j) { const int n = (lane >> 3) + 8 * j; const LAS float* s = scr + (8 * c) * 65 + n;
            u32x2 o; o.x = pk4_fp8(s[0 * 65] * W8_SCALE, s[1 * 65] * W8_SCALE, s[2 * 65] * W8_SCALE, s[3 * 65] * W8_SCALE); o.y = pk4_fp8(s[4 * 65] * W8_SCALE, s[5 * 65] * W8_SCALE, s[6 * 65] * W8_SCALE, s[7 * 65] * W8_SCALE);
            *(u32x2*)((unsigned char*)d.WT + (size_t)(d.dr0 + n) * d.K + d.k0 + 8 * c) = o; }
    } else {
#pragma unroll
    for (int j = 0; j < 8; ++j) { const int n = (lane >> 3) + 8 * j; const LAS float* s = scr + (8 * c) * 65 + n;
        u32x4 o; o.x = pk2(s[0 * 65], s[1 * 65]); o.y = pk2(s[2 * 65], s[3 * 65]); o.z = pk2(s[4 * 65], s[5 * 65]); o.w = pk2(s[6 * 65], s[7 * 65]);
        *(u32x4*)(d.WT + (size_t)(d.dr0 + n) * d.K + d.k0 + 8 * c) = o; }
    }
    asm volatile("s_waitcnt lgkmcnt(0)" ::: "memory");
}
__device__ __forceinline__ int win_src_col(int np, int& nvalid) {
    nvalid = 64;
    if (np < 3072) return np;
    if (np < 5120) return OFF_G + (np - 3072);
    if (np < 5376) return OFF_CQ + (np - 5120);
    if (np < 5504) return OFF_CKV + (np - 5376);
    if (np < 5568) return OFF_KR + (np - 5504);
    nvalid = 32; return OFF_I;
}

__device__ __forceinline__ void phase_prologue(const Params& p, LAS unsigned char* lds, int vcu, int G, int sub) {
#define SUBP(x) (sub == 0 || sub == (x))
    const int tid = threadIdx.x, lane = tid & 63, wave = tid >> 6;
    const int gw = vcu * 8 + wave, NGW = G * 8;
    LAS float* scr = (LAS float*)(lds + wave * 16640);
    if (SUBP(1)) for (int it = vcu; it < 88; it += G) {
        LAS float* um = (LAS float*)lds;
        LAS float* red = (LAS float*)(lds + 65536);
        __syncthreads();
        for (int j = wave * 2; j < wave * 2 + 2; ++j) {
            const float* src = p.meta + (size_t)j * DM; float4 v[4]; float ss = 0.f;
#pragma unroll
            for (int q = 0; q < 4; ++q) { v[q] = *(const float4*)(src + (q * 64 + lane) * 4); ss += v[q].x * v[q].x + v[q].y * v[q].y + v[q].z * v[q].z + v[q].w * v[q].w; }
            const float rstd = rsqrtf(wave_sum(ss) * (1.f / DM) + EPS);
#pragma unroll
            for (int q = 0; q < 4; ++q) { const int c = (q * 64 + lane) * 4; const float4 g = *(const float4*)(p.norm_mix + c);
                um[j * 1024 + c] = v[q].x * rstd * g.x; um[j * 1024 + c + 1] = v[q].y * rstd * g.y; um[j * 1024 + c + 2] = v[q].z * rstd * g.z; um[j * 1024 + c + 3] = v[q].w * rstd * g.w; }
        }
        __syncthreads();
        const int n = it * 64 + lane; const bool okn = n < DIN;
        float a[16];
#pragma unroll
        for (int j = 0; j < 16; ++j) a[j] = 0.f;
#pragma unroll 8
        for (int kk = 0; kk < 128; ++kk) { const int kq = wave * 128 + kk; const float w = okn ? p.w_in[(size_t)kq * DIN + n] : 0.f;
#pragma unroll
            for (int j = 0; j < 16; ++j) a[j] += um[j * 1024 + kq] * w; }
#pragma unroll
        for (int j = 0; j < 16; ++j) red[(wave * 16 + j) * 64 + lane] = a[j];
        __syncthreads();
        for (int o = tid; o < 1024; o += MK_THREADS) { const int j = o >> 6, nl = o & 63; float s = 0.f;
#pragma unroll
            for (int w8 = 0; w8 < 8; ++w8) s += red[(w8 * 16 + j) * 64 + nl];
            if (it * 64 + nl < DIN) p.ZM()[(size_t)j * DIN + it * 64 + nl] = s; }
        __syncthreads();
    }
    constexpr int I_INA = 16 * 40, I_INB = 16 * 48, I_IN = I_INA + I_INB, I_W1 = NEXP * 16 * 32, I_W2 = NEXP * 16 * 16, I_SQ = 16 * 16;
    constexpr int NITEMS = I_IN + I_W1 + I_W2 + 2 * I_SQ;
    auto decode = [&](int it, TrDesc& d) {
        int r = it;
        if (r < I_INA) { const int kb = r / 40, nb = r % 40, np = nb * 64, nl = np < 2048 ? np : np + 3072; int nv; const int sc = win_src_col(nl, nv); d = TrDesc{p.w_in, p.WinT(), DIN, DM, np, sc, nv, kb * 64, 0}; return; } r -= I_INA;
        if (r < I_INB) { const int kb = r / 48, nb = r % 48, np = nb * 64; int nv; const int sc = win_src_col(2048 + np, nv); d = TrDesc{p.w_in, (bf16_t*)p.WinT8(), DIN, DM, np, sc, nv, kb * 64, 1}; return; } r -= I_INB;
        if (r < I_W1) { const int e = r / 512, q = r % 512, kb = q / 32, nb = q % 32, np = nb * 64, pn = np >> 8, bj = (np >> 7) & 1, j = np & 127;
            d = TrDesc{p.w1 + (size_t)e * DM * 2048, (bf16_t*)((unsigned char*)p.W1T() + (size_t)e * 2048 * DM), 2048, DM, np, 1024 * bj + 128 * pn + j, 64, kb * 64, 1}; return; } r -= I_W1;
        if (r < I_W2) { const int e = r / 256, q = r % 256, kb = q / 16, nb = q % 16; d = TrDesc{p.w2 + (size_t)e * DFF * DM, (bf16_t*)((unsigned char*)p.W2T() + (size_t)e * DM * DFF), DM, DFF, nb * 64, nb * 64, 64, kb * 64, 1}; return; } r -= I_W2;
        if (r < I_SQ) { const int kb = r / 16, nb = r % 16; d = TrDesc{p.w_m_proj, p.WmT(), DM, DM, nb * 64, nb * 64, 64, kb * 64, 0}; return; } r -= I_SQ;
        { const int kb = r / 16, nb = r % 16; d = TrDesc{p.w_out, p.WoutT(), DM, DM, nb * 64, nb * 64, 64, kb * 64, 0}; }
    };
    if (SUBP(2)) {
        float4 va[16], vb[16]; TrDesc da, db; int it = gw;
        if (it < NITEMS) { decode(it, da); tr_load(da, va, lane); }
#pragma unroll 1
        while (it < NITEMS) {
            const int it1 = it + NGW; if (it1 < NITEMS) { decode(it1, db); tr_load(db, vb, lane); }
            tr_finish(da, va, scr, lane);
            if (it1 >= NITEMS) break;
            const int it2 = it1 + NGW; if (it2 < NITEMS) { decode(it2, da); tr_load(da, va, lane); }
            tr_finish(db, vb, scr, lane);
            it = it2;
        }
    }
    if (SUBP(3)) for (int r = gw * 4; r < NT; r += NGW * 4) {
        const float* s0 = p.x + (size_t)r * DM; float4 v[16];
#pragma unroll
        for (int q = 0; q < 4; ++q)
#pragma unroll
            for (int j = 0; j < 4; ++j) v[q * 4 + j] = ntld4(s0 + (size_t)q * DM + (j * 64 + lane) * 4);
        float rs[4];
#pragma unroll
        for (int q = 0; q < 4; ++q) { float s = 0.f;
#pragma unroll
            for (int j = 0; j < 4; ++j) { const float4 t = v[q * 4 + j]; s += t.x * t.x + t.y * t.y + t.z * t.z + t.w * t.w; }
            rs[q] = rsqrtf(wave_sum(s) * (1.f / DM) + EPS); }
#pragma unroll
        for (int j = 0; j < 4; ++j) { const int c = (j * 64 + lane) * 4; const float4 g = *(const float4*)(p.norm_mix + c);
#pragma unroll
            for (int q = 0; q < 4; ++q) { const float4 t = v[q * 4 + j]; const float rr = rs[q];
                const float u0 = t.x * rr * g.x, u1 = t.y * rr * g.y, u2 = t.z * rr * g.z, u3 = t.w * rr * g.w;
                u32x2 o; o.x = pk2(u0, u1); o.y = pk2(u2, u3); *(u32x2*)(p.U() + (size_t)(r + q) * DM + c) = o;
                *(unsigned*)(p.U8() + (size_t)(r + q) * DM + c) = pk4_fp8(u0, u1, u2, u3); } }
    }
    const long gid = (long)vcu * MK_THREADS + tid, gn = (long)G * MK_THREADS;
    if (SUBP(4)) for (long i = gid; i < (long)LTOT * 32; i += gn) {
        const int pos = (int)(i >> 5), f = (int)(i & 31);
        const float freq = powf(10000.f, -(float)f / 32.f), ang = (float)pos * freq; float s, c; sincosf(ang, &s, &c);
        p.ROPE()[i * 2] = c; p.ROPE()[i * 2 + 1] = s;
    }
    const int rot_wo = (vcu + 40) & 255;
    if (SUBP(5)) for (long i = (long)rot_wo * MK_THREADS + tid; i < 8L * 8 * 1024; i += gn) {
        const int n = (int)(i & 1023), hcg = __builtin_amdgcn_readfirstlane((int)(i >> 10)), h = hcg >> 3, c0 = (hcg & 7) * 16;
        const float* ap = p.w_a_proj + (size_t)(h * 128) * DM + n; const float* kv = p.a_w_ukv + ((size_t)c0 * 8 + h) * 256 + 128;
        float acc[16];
#pragma unroll
        for (int q = 0; q < 16; ++q) acc[q] = 0.f;
#pragma unroll 4
        for (int d = 0; d < 128; ++d) { const float b = ap[(size_t)d * DM];
#pragma unroll
            for (int q = 0; q < 16; ++q) acc[q] += kv[(size_t)q * 2048 + d] * b; }
        u32x4 o0, o1; o0.x = pk2(acc[0], acc[1]); o0.y = pk2(acc[2], acc[3]); o0.z = pk2(acc[4], acc[5]); o0.w = pk2(acc[6], acc[7]);
        o1.x = pk2(acc[8], acc[9]); o1.y = pk2(acc[10], acc[11]); o1.z = pk2(acc[12], acc[13]); o1.w = pk2(acc[14], acc[15]);
        bf16_t* dst = p.WoT() + (size_t)n * 1024 + h * 128 + c0; *(u32x4*)dst = o0; *(u32x4*)(dst + 8) = o1;
    }
    if (SUBP(6)) for (int t = ((vcu + 168) & 255) * 8 + wave; t < 8 * 128; t += NGW) {
        const int h = t >> 7, c = t & 127; const float2 kvv = *(const float2*)(p.a_w_ukv + ((size_t)c * 8 + h) * 256 + 2 * lane);
#pragma unroll 1
        for (int r0 = 0; r0 < 256; r0 += 64) { float keep = 0.f;
#pragma unroll 8
            for (int rr = 0; rr < 64; ++rr) { const float2 u = *(const float2*)(p.a_w_uq + ((size_t)(r0 + rr) * 8 + h) * 192 + 2 * lane);
                const float s = wave_sum(u.x * kvv.x + u.y * kvv.y); if (lane == rr) keep = s; }
            p.WqT()[(size_t)(h * 192 + c) * 256 + r0 + lane] = f2bf(keep * p.a_norm_q[r0 + lane]); }
    }
    if (SUBP(6)) for (long i = gid; i < 8L * 64 * 256; i += gn) {
        const int r = (int)(i & 255), hq = (int)(i >> 8), h = hq >> 6, q = hq & 63;
        p.WqT()[(size_t)(h * 192 + 128 + q) * 256 + r] = f2bf(p.a_w_uq[((size_t)r * 8 + h) * 192 + 128 + (q >> 1) + 32 * (q & 1)] * p.a_norm_q[r]);
    }
}

#undef SUBP
__device__ __forceinline__ void phase_kprep(const Params& p, int vcu, int G) {
    const int lane = threadIdx.x & 63, gw = vcu * 8 + (threadIdx.x >> 6), NGW = G * 8;
    const float gk0 = p.a_norm_kv[lane], gk1 = p.a_norm_kv[64 + lane];
    for (int r0 = gw * 4; r0 < NT; r0 += NGW * 4) {
        float c0[4], c1[4], x1[4], x2[4], cs[4], sn[4];
#pragma unroll
        for (int q = 0; q < 4; ++q) { const size_t r = (size_t)r0 + q; const int pos = NMETA + (int)(r & (SEQ - 1));
            c0[q] = p.CKV()[r * 128 + lane]; c1[q] = p.CKV()[r * 128 + 64 + lane];
            const int l32 = lane & 31; x1[q] = p.KR()[r * 64 + l32]; x2[q] = p.KR()[r * 64 + 32 + l32];
            const float2 t = *(const float2*)(p.ROPE() + ((size_t)pos * 32 + l32) * 2); cs[q] = t.x; sn[q] = t.y; }
#pragma unroll
        for (int q = 0; q < 4; ++q) { const size_t r = (size_t)r0 + q; const int b = (int)(r >> 12), key = (int)(r & (SEQ - 1));
            bf16_t* dst = p.Kc() + ((size_t)b * KVROWS + key) * 192;
            const float rstd = rsqrtf(wave_sum(c0[q] * c0[q] + c1[q] * c1[q]) * (1.f / 128.f) + EPS);
            dst[lane] = f2bf(c0[q] * rstd * gk0); dst[64 + lane] = f2bf(c1[q] * rstd * gk1);
            if (lane < 32) *(unsigned*)(dst + 128 + 2 * lane) = pk2(x1[q] * cs[q] - x2[q] * sn[q], x1[q] * sn[q] + x2[q] * cs[q]); }
    }
    for (int i = gw; i < NB * 64; i += NGW) {
        const int b = i >> 6, j = i & 63; bf16_t* dst = p.Kc() + ((size_t)b * KVROWS + SEQ + j) * 192;
        if (j >= NMETA) { dst[lane] = 0; dst[64 + lane] = 0; dst[128 + lane] = 0; continue; }
        const float* ckv = p.ZM() + (size_t)j * DIN + OFF_CKV; const float* kr = p.ZM() + (size_t)j * DIN + OFF_KR;
        const float c0 = ckv[lane], c1 = ckv[64 + lane];
        const float rstd = rsqrtf(wave_sum(c0 * c0 + c1 * c1) * (1.f / 128.f) + EPS);
        dst[lane] = f2bf(c0 * rstd * gk0); dst[64 + lane] = f2bf(c1 * rstd * gk1);
        if (lane < 32) { const float x1 = kr[lane], x2 = kr[32 + lane], cs = p.ROPE()[((size_t)j * 32 + lane) * 2], sn = p.ROPE()[((size_t)j * 32 + lane) * 2 + 1];
            *(unsigned*)(dst + 128 + 2 * lane) = pk2(x1 * cs - x2 * sn, x1 * sn + x2 * cs); }
    }
    for (int r0 = gw * 4; r0 < NT; r0 += NGW * 4) {
        float4 v[4];
#pragma unroll
        for (int q = 0; q < 4; ++q) v[q] = ntld4(p.CQ() + (size_t)(r0 + q) * 256 + lane * 4);
#pragma unroll
        for (int q = 0; q < 4; ++q) { u32x2 o; o.x = pk2(v[q].x, v[q].y); o.y = pk2(v[q].z, v[q].w);
            const float a = __uint_as_float(o.x << 16), b = __uint_as_float(o.x & 0xffff0000u), c = __uint_as_float(o.y << 16), d = __uint_as_float(o.y & 0xffff0000u);
            const float ss = wave_sum(a * a + b * b + c * c + d * d);
            *(u32x2*)(p.CQb() + (size_t)(r0 + q) * 256 + lane * 4) = o;
            if (lane == 0) p.RSQ()[r0 + q] = rsqrtf(ss * (1.f / 256.f) + EPS); }
    }
}

__device__ __forceinline__ void moe_tile_table(const Params& p, volatile LAS int* tst) {
    __syncthreads();
    if (threadIdx.x == 0) { int s = 0; for (int e = 0; e < NEXP; ++e) { tst[e] = s; s += (p.CNT()[e * CNT_STRIDE] + 255) / 256; } tst[NEXP] = s; }
    __syncthreads();
}

namespace att {
using s16x4 = __attribute__((ext_vector_type(4))) short;
using f32x16 = __attribute__((ext_vector_type(16))) float;
constexpr int KN_B = 16384, KR_B = 8192, V_B = 16384;
constexpr int L_KN = 0, L_KR = 2 * KN_B, L_WS = L_KR + 2 * KR_B, L_QR = L_WS + 8 * 256, L_END = L_QR + 8 * 4096;
constexpr float THR = 8.f;
#define KSWZ(row, colB) ((row) * 256 + ((colB) ^ (((((row) & 3) << 2) | (((row) >> 2) & 3)) << 4)))
#define RSWZ(row, colB) ((row) * 128 + ((colB) ^ ((((row) >> 1) & 7) << 4)))
#define SBAR() __builtin_amdgcn_sched_barrier(0)
__device__ __forceinline__ int crow(int r, int hi) { return (r & 3) + 8 * (r >> 2) + 4 * hi; }
__device__ __forceinline__ unsigned cvtpk(float lo, float hi) { unsigned r; asm volatile("v_cvt_pk_bf16_f32 %0, %1, %2" : "=v"(r) : "v"(lo), "v"(hi)); return r; }

__device__ __forceinline__ void partialSM(f32x16& p0, f32x16& p1, float& m_reg, float& alpha) {
    float pmax = p0[0];
#pragma unroll
    for (int r = 1; r < 16; ++r) pmax = fmaxf(pmax, p0[r]);
#pragma unroll
    for (int r = 0; r < 16; ++r) pmax = fmaxf(pmax, p1[r]);
    { auto rr = __builtin_amdgcn_permlane32_swap(__float_as_uint(pmax), __float_as_uint(pmax), false, false);
      pmax = fmaxf(__uint_as_float(rr[0]), __uint_as_float(rr[1])); }
    float mn;
    if (__builtin_expect(__all(pmax - m_reg <= THR), 1)) { mn = m_reg; alpha = 1.f; }
    else { mn = fmaxf(m_reg, pmax); alpha = __builtin_amdgcn_exp2f(m_reg - mn); m_reg = mn; }
#pragma unroll
    for (int r = 0; r < 16; ++r) p0[r] = p0[r] - mn;
#pragma unroll
    for (int r = 0; r < 16; ++r) p1[r] = p1[r] - mn;
#pragma unroll
    for (int r = 0; r < 16; ++r) p0[r] = __builtin_amdgcn_exp2f(p0[r]);
}
__device__ __forceinline__ void finishSM(f32x16& p0, f32x16& p1, float alpha, float& l_reg, bf16x8& pa0, bf16x8& pa1, bf16x8& pa2, bf16x8& pa3) {
#pragma unroll
    for (int r = 0; r < 16; ++r) p1[r] = __builtin_amdgcn_exp2f(p1[r]);
    float ps = 0;
#pragma unroll
    for (int r = 0; r < 16; ++r) ps += p0[r];
#pragma unroll
    for (int r = 0; r < 16; ++r) ps += p1[r];
    { auto rr = __builtin_amdgcn_permlane32_swap(__float_as_uint(ps), __float_as_uint(ps), false, false);
      ps = __uint_as_float(rr[0]) + __uint_as_float(rr[1]); }
    l_reg = l_reg * alpha + ps;
#define PK4(P, BASE, OUT) do { unsigned a0 = cvtpk(P[BASE + 0], P[BASE + 1]), a1 = cvtpk(P[BASE + 2], P[BASE + 3]);   \
    unsigned b0 = cvtpk(P[BASE + 4], P[BASE + 5]), b1 = cvtpk(P[BASE + 6], P[BASE + 7]);                              \
    auto r0 = __builtin_amdgcn_permlane32_swap(a0, b0, false, false); auto r1 = __builtin_amdgcn_permlane32_swap(a1, b1, false, false); \
    u32x4 w = {r0[0], r1[0], r0[1], r1[1]}; OUT = *reinterpret_cast<bf16x8*>(&w); } while (0)
    PK4(p0, 0, pa0); PK4(p0, 8, pa1); PK4(p1, 0, pa2); PK4(p1, 8, pa3);
#undef PK4
}
__device__ __forceinline__ void qkt(f32x16& p0, f32x16& p1, const char* Kn, const char* Kr, const bf16x8* qr, const char* qrl, int r32, int hi) {
    p0 = f32x16{}; p1 = f32x16{};
#pragma unroll
    for (int d0 = 0; d0 < 8; ++d0) { const int cb = (d0 * 16 + hi * 8) * 2;
        const bf16x8 b0 = *reinterpret_cast<const bf16x8*>(Kn + KSWZ(r32, cb));
        const bf16x8 b1 = *reinterpret_cast<const bf16x8*>(Kn + KSWZ(32 + r32, cb));
        p0 = __builtin_amdgcn_mfma_f32_32x32x16_bf16(b0, qr[d0], p0, 0, 0, 0);
        p1 = __builtin_amdgcn_mfma_f32_32x32x16_bf16(b1, qr[d0], p1, 0, 0, 0); }
#pragma unroll
    for (int d0 = 0; d0 < 4; ++d0) { const int cb = (d0 * 16 + hi * 8) * 2;
        const bf16x8 b0 = *reinterpret_cast<const bf16x8*>(Kr + RSWZ(r32, cb));
        const bf16x8 b1 = *reinterpret_cast<const bf16x8*>(Kr + RSWZ(32 + r32, cb));
        const bf16x8 qf = *reinterpret_cast<const bf16x8*>(qrl + d0 * 1024);
        p0 = __builtin_amdgcn_mfma_f32_32x32x16_bf16(b0, qf, p0, 0, 0, 0);
        p1 = __builtin_amdgcn_mfma_f32_32x32x16_bf16(b1, qf, p1, 0, 0, 0); }
}
__device__ __forceinline__ int v_st(int k, int c) { const int kk = (k & ~0xC) | ((k & 4) << 1) | ((k & 8) >> 1); return ((kk >> 3) * 4 + (c >> 5)) * 512 + ((kk & 7) * 32 + (c & 31)) * 2; }
__device__ __forceinline__ int v_rd_base(int lane) { return ((lane & 3) << 3) | (((lane >> 2) & 3) << 6) | (((lane >> 4) & 1) << 5) | (((lane >> 5) & 1) << 8); }
constexpr int v_rd_off(int d0, int ks, int half) { return d0 * 512 + ks * 4096 + half * 2048; }
template <int OFF> __device__ __forceinline__ s16x4 tr_read(int vb) { s16x4 r; asm volatile("ds_read_b64_tr_b16 %0, %1 offset:%2" : "=&v"(r) : "v"(vb), "i"(OFF) : "memory"); return r; }
template <int C> __device__ __forceinline__ void pv_one(f32x16& od, int bt0, int bt1, bf16x8 pa0, bf16x8 pa1, bf16x8 pa2, bf16x8 pa3) {
    const int a0 = bt0 ^ (C << 6), a1 = bt1 ^ (C << 6);
    const s16x4 l0 = tr_read<0>(a0), h0 = tr_read<0>(a1), l1 = tr_read<4096>(a0), h1 = tr_read<4096>(a1);
    const s16x4 l2 = tr_read<8192>(a0), h2 = tr_read<8192>(a1), l3 = tr_read<12288>(a0), h3 = tr_read<12288>(a1);
    asm volatile("s_waitcnt lgkmcnt(0)" ::: "memory"); SBAR();
#define PK(L, H) (bf16x8){L[0], L[1], L[2], L[3], H[0], H[1], H[2], H[3]}
    od = __builtin_amdgcn_mfma_f32_32x32x16_bf16(pa0, PK(l0, h0), od, 0, 0, 0);
    od = __builtin_amdgcn_mfma_f32_32x32x16_bf16(pa1, PK(l1, h1), od, 0, 0, 0);
    od = __builtin_amdgcn_mfma_f32_32x32x16_bf16(pa2, PK(l2, h2), od, 0, 0, 0);
    od = __builtin_amdgcn_mfma_f32_32x32x16_bf16(pa3, PK(l3, h3), od, 0, 0, 0);
#undef PK
}
__device__ __forceinline__ void pv_d0(f32x16* o, int bt0, int bt1, bf16x8 pa0, bf16x8 pa1, bf16x8 pa2, bf16x8 pa3) {
    pv_one<0>(o[0], bt0, bt1, pa0, pa1, pa2, pa3); pv_one<1>(o[1], bt0, bt1, pa0, pa1, pa2, pa3); pv_one<2>(o[2], bt0, bt1, pa0, pa1, pa2, pa3); pv_one<3>(o[3], bt0, bt1, pa0, pa1, pa2, pa3);
}
__device__ __forceinline__ int tr_base(int lane, int t) {
    const int h = lane >> 5, blk = (lane >> 4) & 1, q = (lane & 15) >> 2, p = lane & 3, row = 8 * h + 4 * t + q, ch = 2 * blk + (p >> 1);
    return KSWZ(row, ch * 16) + 8 * (p & 1);
}

__device__ __forceinline__ void attn_unit(const bf16_t* __restrict__ Qb, const bf16_t* __restrict__ Kb, bf16_t* __restrict__ Ob, char* lds) {
    const int tid = threadIdx.x, wid = tid >> 6, lane = tid & 63, r32 = lane & 31, hi = lane >> 5;
    char* Kn_l = lds + L_KN; char* Kr_l = lds + L_KR;
    float* ws = (float*)(lds + L_WS) + wid * 64; float* li_l = ws; float* al_l = ws + 32;
    float m_reg = -1e30f, l_reg = 0; f32x16 o[4] = {}; bf16x8 qr[8];
    const bf16_t* Qw = Qb + (size_t)(wid * 32 + r32) * 1536 + hi * 8;
    char* qrl = lds + L_QR + wid * 4096 + lane * 16;
#pragma unroll
    for (int d0 = 0; d0 < 8; ++d0) qr[d0] = *reinterpret_cast<const bf16x8*>(Qw + d0 * 16);
#pragma unroll
    for (int d0 = 0; d0 < 4; ++d0) *reinterpret_cast<bf16x8*>(qrl + d0 * 1024) = *reinterpret_cast<const bf16x8*>(Qw + (8 + d0) * 16);
    const int sr = tid >> 3, sc8 = tid & 7;
    const int kst0 = KSWZ(sr, sc8 * 16), kst1 = KSWZ(sr, 128 + sc8 * 16), rst = RSWZ(sr, sc8 * 16);
    const int bt0 = (int)(uintptr_t)Kn_l + tr_base(lane, 0), bt1 = (int)(uintptr_t)Kn_l + tr_base(lane, 1);
    bf16x8 s0, s1, s2;
#define SLOAD(mt) do { const bf16_t* kp = Kb + (size_t)((mt) * 64 + sr) * 192 + sc8 * 8; s0 = *reinterpret_cast<const bf16x8*>(kp); s1 = *reinterpret_cast<const bf16x8*>(kp + 64); s2 = *reinterpret_cast<const bf16x8*>(kp + 128); } while (0)
#define SWRITE(b) do { *(bf16x8*)(Kn_l + (b) * KN_B + kst0) = s0; *(bf16x8*)(Kn_l + (b) * KN_B + kst1) = s1; *(bf16x8*)(Kr_l + (b) * KR_B + rst) = s2; } while (0)
#define RESC(a) do { if (__any((a) < 1.f)) { if (hi == 0) al_l[r32] = (a); asm volatile("s_waitcnt lgkmcnt(0)" ::: "memory"); \
        _Pragma("unroll") for (int d = 0; d < 4; ++d) _Pragma("unroll") for (int r = 0; r < 16; ++r) o[d][r] *= al_l[crow(r, hi)]; } } while (0)
    f32x16 pA0, pA1, pB0, pB1; float alA, alB; bf16x8 pa0, pa1, pa2, pa3;
    constexpr int NTL = 65;
    SLOAD(64); asm volatile("s_waitcnt vmcnt(0)" ::: "memory"); SWRITE(0); __syncthreads();
    qkt(pA0, pA1, Kn_l, Kr_l, qr, qrl, r32, hi);
#pragma unroll
    for (int r = 8; r < 16; ++r) pA0[r] = -1e30f;
#pragma unroll
    for (int r = 0; r < 16; ++r) pA1[r] = -1e30f;
    partialSM(pA0, pA1, m_reg, alA);
    SLOAD(0); asm volatile("s_waitcnt vmcnt(0)" ::: "memory"); SWRITE(1); __syncthreads();
#pragma unroll 1
    for (int j = 1; j + 1 < NTL; j += 2) {
        SBAR(); qkt(pB0, pB1, Kn_l + KN_B, Kr_l + KR_B, qr, qrl, r32, hi);
        finishSM(pA0, pA1, alA, l_reg, pa0, pa1, pa2, pa3); SBAR();
        SLOAD(j); SBAR();
        pv_d0(o, bt0, bt1, pa0, pa1, pa2, pa3); partialSM(pB0, pB1, m_reg, alB);
        __syncthreads(); asm volatile("s_waitcnt vmcnt(0)" ::: "memory"); SWRITE(0);
        RESC(alB); __syncthreads();
        SBAR(); qkt(pA0, pA1, Kn_l, Kr_l, qr, qrl, r32, hi);
        finishSM(pB0, pB1, alB, l_reg, pa0, pa1, pa2, pa3); SBAR();
        if (j + 2 < NTL) SLOAD(j + 1); SBAR();
        pv_d0(o, bt0 + KN_B, bt1 + KN_B, pa0, pa1, pa2, pa3); partialSM(pA0, pA1, m_reg, alA);
        __syncthreads(); asm volatile("s_waitcnt vmcnt(0)" ::: "memory"); if (j + 2 < NTL) SWRITE(1);
        RESC(alA); __syncthreads();
    }
    finishSM(pA0, pA1, alA, l_reg, pa0, pa1, pa2, pa3); SBAR();
    pv_d0(o, bt0, bt1, pa0, pa1, pa2, pa3);
    if (hi == 0) li_l[r32] = l_reg; asm volatile("s_waitcnt lgkmcnt(0)" ::: "memory");
    float rli[16];
#pragma unroll
    for (int r = 0; r < 16; ++r) rli[r] = __builtin_amdgcn_rcpf(li_l[crow(r, hi)]);
    bf16_t* Ow = Ob + (size_t)(wid * 32) * 1024;
#pragma unroll
    for (int r = 0; r < 16; ++r) { const int orow = crow(r, hi);
#pragma unroll
        for (int d0 = 0; d0 < 4; ++d0) Ow[(size_t)orow * 1024 + d0 * 32 + r32] = f2bf(o[d0][r] * rli[r]); }
    __syncthreads();
#undef SLOAD
#undef SWRITE
#undef RESC
}
#undef KSWZ
#undef RSWZ
#undef SBAR
}

__device__ __forceinline__ void phase_attn(const Params& p, char* lds, int vcu, int G) {
    for (int u = vcu; u < NB * 8 * 16; u += G) {
        const int b = u >> 7, h = (u >> 4) & 7, qb = u & 15;
        const size_t r0 = (size_t)b * SEQ + qb * 256;
        att::attn_unit(p.QP() + r0 * 1536 + h * 192, p.Kc() + (size_t)b * KVROWS * 192, p.OA() + r0 * 1024 + h * 128, lds);
    }
}

namespace ml {
using att::s16x4; using att::f32x16; using att::crow; using att::cvtpk; using att::v_st; using att::v_rd_base; using att::tr_read; using att::v_rd_off;
#define RSWZ(row, colB) ((row) * 128 + ((colB) ^ ((((row) >> 1) & 7) << 4)))
#define SBAR() __builtin_amdgcn_sched_barrier(0)
__device__ __forceinline__ void pv_blk(f32x16& od, int vb, bf16x8 pa0, bf16x8 pa1, bf16x8 pa2, bf16x8 pa3) {
    const s16x4 l0 = tr_read<v_rd_off(0, 0, 0)>(vb), h0 = tr_read<v_rd_off(0, 0, 1)>(vb), l1 = tr_read<v_rd_off(0, 1, 0)>(vb), h1 = tr_read<v_rd_off(0, 1, 1)>(vb);
    const s16x4 l2 = tr_read<v_rd_off(0, 2, 0)>(vb), h2 = tr_read<v_rd_off(0, 2, 1)>(vb), l3 = tr_read<v_rd_off(0, 3, 0)>(vb), h3 = tr_read<v_rd_off(0, 3, 1)>(vb);
    asm volatile("s_waitcnt lgkmcnt(0)" ::: "memory"); SBAR();
#define PK(L, H) (bf16x8){L[0], L[1], L[2], L[3], H[0], H[1], H[2], H[3]}
    od = __builtin_amdgcn_mfma_f32_32x32x16_bf16(pa0, PK(l0, h0), od, 0, 0, 0);
    od = __builtin_amdgcn_mfma_f32_32x32x16_bf16(pa1, PK(l1, h1), od, 0, 0, 0);
    od = __builtin_amdgcn_mfma_f32_32x32x16_bf16(pa2, PK(l2, h2), od, 0, 0, 0);
    od = __builtin_amdgcn_mfma_f32_32x32x16_bf16(pa3, PK(l3, h3), od, 0, 0, 0);
}
template <int KS0> __device__ __forceinline__ void pv_blk2(f32x16& od, int vb, bf16x8 pa, bf16x8 pb) {
    const s16x4 l0 = tr_read<v_rd_off(0, KS0, 0)>(vb), h0 = tr_read<v_rd_off(0, KS0, 1)>(vb), l1 = tr_read<v_rd_off(0, KS0 + 1, 0)>(vb), h1 = tr_read<v_rd_off(0, KS0 + 1, 1)>(vb);
    asm volatile("s_waitcnt lgkmcnt(0)" ::: "memory"); SBAR();
    od = __builtin_amdgcn_mfma_f32_32x32x16_bf16(pa, PK(l0, h0), od, 0, 0, 0);
    od = __builtin_amdgcn_mfma_f32_32x32x16_bf16(pb, PK(l1, h1), od, 0, 0, 0);
}
__device__ __forceinline__ void tt_blk(f32x16& od, int va, int vb) {
    const s16x4 al0 = tr_read<v_rd_off(0, 0, 0)>(va), ah0 = tr_read<v_rd_off(0, 0, 1)>(va), al1 = tr_read<v_rd_off(0, 1, 0)>(va), ah1 = tr_read<v_rd_off(0, 1, 1)>(va);
    const s16x4 al2 = tr_read<v_rd_off(0, 2, 0)>(va), ah2 = tr_read<v_rd_off(0, 2, 1)>(va), al3 = tr_read<v_rd_off(0, 3, 0)>(va), ah3 = tr_read<v_rd_off(0, 3, 1)>(va);
    const s16x4 l0 = tr_read<v_rd_off(0, 0, 0)>(vb), h0 = tr_read<v_rd_off(0, 0, 1)>(vb), l1 = tr_read<v_rd_off(0, 1, 0)>(vb), h1 = tr_read<v_rd_off(0, 1, 1)>(vb);
    const s16x4 l2 = tr_read<v_rd_off(0, 2, 0)>(vb), h2 = tr_read<v_rd_off(0, 2, 1)>(vb), l3 = tr_read<v_rd_off(0, 3, 0)>(vb), h3 = tr_read<v_rd_off(0, 3, 1)>(vb);
    asm volatile("s_waitcnt lgkmcnt(0)" ::: "memory"); SBAR();
    od = __builtin_amdgcn_mfma_f32_32x32x16_bf16(PK(al0, ah0), PK(l0, h0), od, 0, 0, 0);
    od = __builtin_amdgcn_mfma_f32_32x32x16_bf16(PK(al1, ah1), PK(l1, h1), od, 0, 0, 0);
    od = __builtin_amdgcn_mfma_f32_32x32x16_bf16(PK(al2, ah2), PK(l2, h2), od, 0, 0, 0);
    od = __builtin_amdgcn_mfma_f32_32x32x16_bf16(PK(al3, ah3), PK(l3, h3), od, 0, 0, 0);
#undef PK
}
#define PK4(P, BASE, OUT) do { unsigned a0 = cvtpk(P[BASE + 0], P[BASE + 1]), a1 = cvtpk(P[BASE + 2], P[BASE + 3]);   \
    unsigned b0 = cvtpk(P[BASE + 4], P[BASE + 5]), b1 = cvtpk(P[BASE + 6], P[BASE + 7]);                              \
    auto r0 = __builtin_amdgcn_permlane32_swap(a0, b0, false, false); auto r1 = __builtin_amdgcn_permlane32_swap(a1, b1, false, false); \
    u32x4 w = {r0[0], r1[0], r0[1], r1[1]}; OUT = *reinterpret_cast<bf16x8*>(&w); } while (0)
__device__ __forceinline__ float half_swap_add(float v) { auto rr = __builtin_amdgcn_permlane32_swap(__float_as_uint(v), __float_as_uint(v), false, false); return __uint_as_float(rr[0]) + __uint_as_float(rr[1]); }
__device__ __forceinline__ bf16x8 scale8(bf16x8 v, float s) {
    const u32x4 w = *reinterpret_cast<const u32x4*>(&v); u32x4 o;
    o.x = cvtpk(__uint_as_float(w.x << 16) * s, __uint_as_float(w.x & 0xffff0000u) * s); o.y = cvtpk(__uint_as_float(w.y << 16) * s, __uint_as_float(w.y & 0xffff0000u) * s);
    o.z = cvtpk(__uint_as_float(w.z << 16) * s, __uint_as_float(w.z & 0xffff0000u) * s); o.w = cvtpk(__uint_as_float(w.w << 16) * s, __uint_as_float(w.w & 0xffff0000u) * s);
    return *reinterpret_cast<bf16x8*>(&o);
}
__device__ __forceinline__ bf16x8 f8_to_bf(const float* p, bool ok) {
    if (!ok) return (bf16x8){0, 0, 0, 0, 0, 0, 0, 0};
    const f32x4 a = *(const f32x4*)p, b = *(const f32x4*)(p + 4); u32x4 o = {cvtpk(a[0], a[1]), cvtpk(a[2], a[3]), cvtpk(b[0], b[1]), cvtpk(b[2], b[3])};
    return *reinterpret_cast<bf16x8*>(&o);
}
template <int K> __device__ __forceinline__ float dpp_shr(float v, float ident) {
    return __int_as_float(__builtin_amdgcn_update_dpp(__float_as_int(ident), __float_as_int(v), 0x110 | K, 0xf, 0xf, false));
}
__device__ __forceinline__ float rdlane(float v, int l) { return __int_as_float(__builtin_amdgcn_readlane(__float_as_int(v), l)); }
__device__ __forceinline__ float wave_incl_sum(float v, int lane) {
    v += dpp_shr<1>(v, 0.f); v += dpp_shr<2>(v, 0.f); v += dpp_shr<4>(v, 0.f); v += dpp_shr<8>(v, 0.f);
    const float s0 = rdlane(v, 15), s1 = rdlane(v, 31), s2 = rdlane(v, 47); const int row = lane >> 4;
    return v + (row >= 1 ? s0 : 0.f) + (row >= 2 ? s1 : 0.f) + (row >= 3 ? s2 : 0.f);
}
__device__ __forceinline__ float wave_incl_max(float v, int lane) {
    const float NI = -3.0e38f;
    v = fmaxf(v, dpp_shr<1>(v, NI)); v = fmaxf(v, dpp_shr<2>(v, NI)); v = fmaxf(v, dpp_shr<4>(v, NI)); v = fmaxf(v, dpp_shr<8>(v, NI));
    const float s0 = rdlane(v, 15), s1 = rdlane(v, 31), s2 = rdlane(v, 47); const int row = lane >> 4;
    return fmaxf(fmaxf(v, row >= 1 ? s0 : NI), fmaxf(row >= 2 ? s1 : NI, row >= 3 ? s2 : NI));
}
__device__ __forceinline__ float wave_max(float v) {
    const float NI = -3.0e38f;
    v = fmaxf(v, dpp_shr<1>(v, NI)); v = fmaxf(v, dpp_shr<2>(v, NI)); v = fmaxf(v, dpp_shr<4>(v, NI)); v = fmaxf(v, dpp_shr<8>(v, NI));
    return fmaxf(fmaxf(rdlane(v, 15), rdlane(v, 31)), fmaxf(rdlane(v, 47), rdlane(v, 63)));
}

constexpr int SC_BUF = 32768;
__device__ __forceinline__ void scan_unit(const Params& p, int b, int h, int dir, char* lds) {
    const int tid = threadIdx.x, wid = tid >> 6, lane = tid & 63, r32 = lane & 31, hi = lane >> 5, db = wid & 1, vq = wid >> 1;
    const int sr = tid >> 3, sc8 = tid & 7;
    const int kst = v_st(sr, sc8 * 8), vst0 = v_st(sr, sc8 * 8), vst1 = v_st(sr, 64 + sc8 * 8);
    const int va0 = (int)(uintptr_t)lds + v_rd_base(lane) + db * 512, vb0 = (int)(uintptr_t)lds + 16384 + v_rd_base(lane) + vq * 512;
    bf16_t* CS = dir ? p.CB() : p.CF(); float* NS = dir ? p.NB_() : p.NF(); float* MS = dir ? p.MB() : p.MF();
    const size_t sbase = (size_t)(b * 8 + h) * 64;
    f32x16 acc = {}; float nacc = 0.f, m = 0.f, decay_prev = 1.f;
    const int nsteps = dir ? 64 : 65;
    bf16x8 sk, sv0, sv1; float gli, glf;
#define ML_LOAD(st) do { const int c_ = dir ? 63 - (st) : (st) - 1; \
        if (c_ < 0) { const float* z = p.ZM() + (size_t)(sr & 15) * DIN; const bool okr = sr < NMETA; \
            sk = f8_to_bf(z + OFF_K + h * 64 + sc8 * 8, okr); sv0 = f8_to_bf(z + OFF_V + h * 128 + sc8 * 8, okr); sv1 = f8_to_bf(z + OFF_V + h * 128 + 64 + sc8 * 8, okr); \
            const float* zl = p.ZM() + (size_t)(lane & 15) * DIN; gli = lane < NMETA ? zl[OFF_I + h] + p.m_b_i[h] : -1e30f; glf = lane < NMETA ? logsigmoidf_(zl[OFF_F + h] + p.m_b_f[h]) : 0.f; } \
        else { const size_t r_ = (size_t)b * SEQ + c_ * 64 + sr; sk = *reinterpret_cast<const bf16x8*>(p.Km() + r_ * 512 + h * 64 + sc8 * 8); \
            sv0 = *reinterpret_cast<const bf16x8*>(p.Vm() + r_ * 1024 + h * 128 + sc8 * 8); sv1 = *reinterpret_cast<const bf16x8*>(p.Vm() + r_ * 1024 + h * 128 + 64 + sc8 * 8); \
            const size_t rg = (size_t)b * SEQ + c_ * 64 + (dir ? 63 - lane : lane); gli = p.GI()[rg * 16 + dir * 8 + h]; glf = p.GF()[rg * 16 + dir * 8 + h]; } } while (0)
#define ML_GATES(decay_, mnew_, wk_) do { const float bc_ = wave_incl_sum(glf, lane); const float bl_ = rdlane(bc_, 63); const float g_ = bl_ - bc_ + gli; \
        mnew_ = fmaxf(bl_ + m, wave_max(g_)); decay_ = __expf(bl_ + m - mnew_); wk_ = __expf(g_ - mnew_); } while (0)
    ML_LOAD(0);
    float decay, mnew, wk;
    { asm volatile("s_waitcnt vmcnt(0)" ::: "memory"); ML_GATES(decay, mnew, wk);
      const float w = __shfl(wk, dir ? 63 - sr : sr);
      *(bf16x8*)(lds + kst) = sk; *(bf16x8*)(lds + 16384 + vst0) = scale8(sv0, w); *(bf16x8*)(lds + 16384 + vst1) = scale8(sv1, w); }
    __syncthreads();
#pragma unroll 1
    for (int st = 0; st < nsteps; ++st) {
        const int c = dir ? 63 - st : st - 1, buf = st & 1;
        if (wid == 0 && st > 0) { float s_ = 0.f; const float* np_ = (const float*)(lds + 65536) + ((st - 1) & 1) * 512;
#pragma unroll
            for (int w8 = 0; w8 < 8; ++w8) s_ += np_[w8 * 64 + lane];
            nacc = nacc * decay_prev + s_; }
        if (c >= 0) {
            const size_t sidx = sbase + c; bf16_t* cd = CS + sidx * 8192 + (size_t)(db * 32) * 128 + vq * 32 + r32;
#pragma unroll
            for (int r = 0; r < 16; ++r) cd[(size_t)crow(r, hi) * 128] = f2bf(acc[r]);
            if (wid == 0) NS[sidx * 64 + lane] = nacc;
            if (tid == 0) MS[sidx] = m;
        }
        if (st == nsteps - 1) break;
        if (st + 1 < nsteps - 1) ML_LOAD(st + 1);
#pragma unroll
        for (int r = 0; r < 16; ++r) acc[r] *= decay;
        tt_blk(acc, va0 + buf * SC_BUF, vb0 + buf * SC_BUF);
        {
            float s_ = 0.f;
#pragma unroll
            for (int q = 0; q < 8; ++q) { const int s = wid * 8 + q; const float w = __shfl(wk, dir ? 63 - s : s); s_ += w * bf2f(*(const bf16_t*)(lds + buf * SC_BUF + v_st(s, lane))); }
            ((float*)(lds + 65536))[(st & 1) * 512 + wid * 64 + lane] = s_;
        }
        decay_prev = decay;
        m = mnew;
        if (st + 1 < nsteps - 1) {
            asm volatile("s_waitcnt vmcnt(0)" ::: "memory"); ML_GATES(decay, mnew, wk);
            const float w = __shfl(wk, dir ? 63 - sr : sr); char* lb = lds + (buf ^ 1) * SC_BUF;
            *(bf16x8*)(lb + kst) = sk; *(bf16x8*)(lb + 16384 + vst0) = scale8(sv0, w); *(bf16x8*)(lb + 16384 + vst1) = scale8(sv1, w);
        }
        __syncthreads();
    }
    __syncthreads();
#undef ML_LOAD
#undef ML_GATES
}

constexpr int O_K = 0, O_V = 8192, O_CF = 24576, O_CB = 40960, O_T = 57344, O_ARR = 122880, O_WS = 125440, O_END = 127488;
struct OutPre { bf16x8 kk, v0, v1, f0, f1, b0, b1, q0, q1, q2, q3; float li, lf, mm, nn; };
__device__ __forceinline__ void out_load(const Params& p, int u, OutPre& R) {
    const int tid = threadIdx.x, wid = tid >> 6, lane = tid & 63, r32 = lane & 31, hi = lane >> 5, tb = wid & 1;
    const int b = u >> 9, h = u & 7, c = (u >> 3) & 63; const size_t r0 = (size_t)b * SEQ + c * 64, sidx = (size_t)(b * 8 + h) * 64 + c;
    const int sr = tid >> 3, sc8 = tid & 7;
    R.kk = *reinterpret_cast<const bf16x8*>(p.Km() + (r0 + sr) * 512 + h * 64 + sc8 * 8);
    const bf16_t* vp = p.Vm() + (r0 + sr) * 1024 + h * 128 + sc8 * 8; R.v0 = *reinterpret_cast<const bf16x8*>(vp); R.v1 = *reinterpret_cast<const bf16x8*>(vp + 64);
    const bf16_t* cf = p.CF() + sidx * 8192 + (size_t)sr * 128 + sc8 * 8; R.f0 = *reinterpret_cast<const bf16x8*>(cf); R.f1 = *reinterpret_cast<const bf16x8*>(cf + 64);
    const bf16_t* cb = p.CB() + sidx * 8192 + (size_t)sr * 128 + sc8 * 8; R.b0 = *reinterpret_cast<const bf16x8*>(cb); R.b1 = *reinterpret_cast<const bf16x8*>(cb + 64);
    const bf16_t* qp = p.Qm() + (r0 + tb * 32 + r32) * 512 + h * 64 + hi * 8;
    R.q0 = *reinterpret_cast<const bf16x8*>(qp); R.q1 = *reinterpret_cast<const bf16x8*>(qp + 16); R.q2 = *reinterpret_cast<const bf16x8*>(qp + 32); R.q3 = *reinterpret_cast<const bf16x8*>(qp + 48);
    R.li = 0.f; R.lf = 0.f; R.mm = 0.f; R.nn = 0.f;
    if (wid < 2) { const int dir = wid, t = dir ? 63 - lane : lane; R.li = p.GI()[(r0 + t) * 16 + dir * 8 + h]; R.lf = p.GF()[(r0 + t) * 16 + dir * 8 + h]; R.mm = (dir ? p.MB() : p.MF())[sidx]; }
    else if (wid < 4) { const int dir = wid - 2; R.nn = (dir ? p.NB_() : p.NF())[sidx * 64 + lane]; }
}
__device__ __forceinline__ void phase_mlstm_out_body(const Params& p, char* lds, int vcu, int G) {
    const int tid = threadIdx.x, wid = tid >> 6, lane = tid & 63, r32 = lane & 31, hi = lane >> 5, tb = wid & 1, vq = wid >> 1;
    const int sr = tid >> 3, sc8 = tid & 7;
    float* arr = (float*)(lds + O_ARR);
    float* nbuf = arr + 512;
    float* wsc = (float*)(lds + O_WS) + wid * 64;
    const int NU = NB * 8 * 64;
    OutPre R;
    if (vcu < NU) out_load(p, vcu, R);
#pragma unroll 1
    for (int u = vcu; u < NU; u += G) {
        const int b = u >> 9, h = u & 7, c = (u >> 3) & 63; const size_t r0 = (size_t)b * SEQ + c * 64;
        { *(bf16x8*)(lds + O_K + RSWZ(sr, sc8 * 16)) = R.kk;
          const int s0 = v_st(sr, sc8 * 8), s1 = v_st(sr, 64 + sc8 * 8);
          *(bf16x8*)(lds + O_V + s0) = R.v0; *(bf16x8*)(lds + O_V + s1) = R.v1; *(bf16x8*)(lds + O_CF + s0) = R.f0; *(bf16x8*)(lds + O_CF + s1) = R.f1; *(bf16x8*)(lds + O_CB + s0) = R.b0; *(bf16x8*)(lds + O_CB + s1) = R.b1; }
        if (wid < 2) {
            const int dir = wid, t = dir ? 63 - lane : lane; const float m = R.mm;
            const float bc = wave_incl_sum(R.lf, lane), a = R.li - bc, pm = wave_incl_max(a, lane), mx = fmaxf(m, pm);
            float* ar = arr + dir * 256;
            ar[t] = -mx * 1.4426950408889634f; ar[64 + t] = a * 1.4426950408889634f; ar[128 + t] = __expf(m - mx); ar[192 + t] = __expf(-(bc + mx));
        } else if (wid < 4) nbuf[(wid - 2) * 64 + lane] = R.nn;
        bf16x8 qr[4] = {R.q0, R.q1, R.q2, R.q3};
        __syncthreads();
        if (u + G < NU) out_load(p, u + G, R);
        const int ocol = h * 128 + sc8 * 16; const size_t oo = (r0 + sr) * 1024 + ocol;
        const u32x4 og0 = *(const u32x4*)(p.OG() + oo), og1 = *(const u32x4*)(p.OG() + oo + 8);
        const f32x4 n0 = *(const f32x4*)(p.m_norm + ocol), n1 = *(const f32x4*)(p.m_norm + ocol + 4), n2 = *(const f32x4*)(p.m_norm + ocol + 8), n3 = *(const f32x4*)(p.m_norm + ocol + 12);
        const int dir = (wid >> 1) & 1, vh = wid >> 2;
        float qn;
        { const float* nv = nbuf + dir * 64 + hi * 8; float s_ = 0.f;
#pragma unroll
          for (int d0 = 0; d0 < 4; ++d0) { const u32x4 w = *reinterpret_cast<const u32x4*>(&qr[d0]); const f32x4 n0 = *(const f32x4*)(nv + d0 * 16), n1 = *(const f32x4*)(nv + d0 * 16 + 4);
              s_ += __uint_as_float(w.x << 16) * n0[0] + __uint_as_float(w.x & 0xffff0000u) * n0[1] + __uint_as_float(w.y << 16) * n0[2] + __uint_as_float(w.y & 0xffff0000u) * n0[3]
                  + __uint_as_float(w.z << 16) * n1[0] + __uint_as_float(w.z & 0xffff0000u) * n1[1] + __uint_as_float(w.w << 16) * n1[2] + __uint_as_float(w.w & 0xffff0000u) * n1[3]; }
          qn = half_swap_add(s_); }
        f32x16 p0 = {}, p1 = {};
        const bool has0 = !(dir == 1 && tb == 1), has1 = !(dir == 0 && tb == 0);
#pragma unroll
        for (int d0 = 0; d0 < 4; ++d0) { const int cb = (d0 * 16 + hi * 8) * 2;
            if (has0) { const bf16x8 k0 = *reinterpret_cast<const bf16x8*>(lds + O_K + RSWZ(r32, cb)); p0 = __builtin_amdgcn_mfma_f32_32x32x16_bf16(k0, qr[d0], p0, 0, 0, 0); }
            if (has1) { const bf16x8 k1 = *reinterpret_cast<const bf16x8*>(lds + O_K + RSWZ(32 + r32, cb)); p1 = __builtin_amdgcn_mfma_f32_32x32x16_bf16(k1, qr[d0], p1, 0, 0, 0); } }
        const int t = tb * 32 + r32;
        const int vbase = (int)(uintptr_t)lds + v_rd_base(lane) + vh * 1024;
#define W_FULL(P, W, SB) _Pragma("unroll") for (int g = 0; g < 4; ++g) { const f32x4 ct = *(const f32x4*)(ar + 64 + (SB) + 8 * g + 4 * hi); \
            _Pragma("unroll") for (int q = 0; q < 4; ++q) { const float x = __builtin_amdgcn_exp2f(rt + ct[q]) * P[4 * g + q]; W[4 * g + q] = x; rs += x; } }
#define W_DIAG(P, W, SB) _Pragma("unroll") for (int g = 0; g < 4; ++g) { const f32x4 ct = *(const f32x4*)(ar + 64 + (SB) + 8 * g + 4 * hi); \
            _Pragma("unroll") for (int q = 0; q < 4; ++q) { const int sl = 8 * g + 4 * hi + q; const bool ok = dir ? (sl >= r32) : (sl <= r32); \
                const float x = ok ? __builtin_amdgcn_exp2f(rt + ct[q]) * P[4 * g + q] : 0.f; W[4 * g + q] = x; rs += x; } }
        {
            const float* ar = arr + dir * 256; const float rt = ar[t], sint = ar[128 + t], efl = ar[192 + t];
            f32x16 w0, w1; float rs = 0.f;
            if (tb == 0) { W_DIAG(p0, w0, 0) if (dir == 1) { W_FULL(p1, w1, 32) } }
            else         { W_DIAG(p1, w1, 32) if (dir == 0) { W_FULL(p0, w0, 0) } }
            rs = half_swap_add(rs);
            bf16x8 pa0, pa1, pa2, pa3;
            if (has0) { PK4(w0, 0, pa0); PK4(w0, 8, pa1); }
            if (has1) { PK4(w1, 0, pa2); PK4(w1, 8, pa3); }
            const float den = rs + sint * qn, inv = 1.f / fmaxf(fabsf(den), efl);
            if (hi == 0) { wsc[r32] = sint; wsc[32 + r32] = inv; }
            f32x16 o0 = {}, o1 = {};
            pv_blk(o0, vbase + (dir ? O_CB : O_CF), qr[0], qr[1], qr[2], qr[3]);
            pv_blk(o1, vbase + (dir ? O_CB : O_CF) + 512, qr[0], qr[1], qr[2], qr[3]);
            asm volatile("s_waitcnt lgkmcnt(0)" ::: "memory");
#pragma unroll
            for (int g = 0; g < 4; ++g) { const f32x4 sc = *(const f32x4*)(wsc + 8 * g + 4 * hi);
#pragma unroll
                for (int q = 0; q < 4; ++q) { o0[4 * g + q] *= sc[q]; o1[4 * g + q] *= sc[q]; } }
            if (has0) { pv_blk2<0>(o0, vbase + O_V, pa0, pa1); pv_blk2<0>(o1, vbase + O_V + 512, pa0, pa1); }
            if (has1) { pv_blk2<2>(o0, vbase + O_V, pa2, pa3); pv_blk2<2>(o1, vbase + O_V + 512, pa2, pa3); }
            float* T = (float*)(lds + O_T + dir * 32768) + (size_t)(tb * 32) * 128 + vh * 64 + r32;
#pragma unroll
            for (int g = 0; g < 4; ++g) { const f32x4 sc = *(const f32x4*)(wsc + 32 + 8 * g + 4 * hi);
#pragma unroll
                for (int q = 0; q < 4; ++q) { const int rw = 8 * g + 4 * hi + q; T[rw * 128] = o0[4 * g + q] * sc[q]; T[rw * 128 + 32] = o1[4 * g + q] * sc[q]; } }
        }
#undef W_FULL
#undef W_DIAG
        __syncthreads();
        { const float* T = (const float*)(lds + O_T) + sr * 128 + sc8 * 16; f32x4 v[4]; float ss = 0.f;
#pragma unroll
          for (int q = 0; q < 4; ++q) { v[q] = *(const f32x4*)(T + q * 4) + *(const f32x4*)(T + 8192 + q * 4); ss += v[q][0] * v[q][0] + v[q][1] * v[q][1] + v[q][2] * v[q][2] + v[q][3] * v[q][3]; }
          ss += __shfl_xor(ss, 1); ss += __shfl_xor(ss, 2); ss += __shfl_xor(ss, 4);
          const float rstd = rsqrtf(ss * (1.f / 128.f) + EPS);
          const f32x4 g0 = (f32x4){__uint_as_float(og0.x << 16), __uint_as_float(og0.x & 0xffff0000u), __uint_as_float(og0.y << 16), __uint_as_float(og0.y & 0xffff0000u)};
          const f32x4 g1 = (f32x4){__uint_as_float(og0.z << 16), __uint_as_float(og0.z & 0xffff0000u), __uint_as_float(og0.w << 16), __uint_as_float(og0.w & 0xffff0000u)};
          const f32x4 g2 = (f32x4){__uint_as_float(og1.x << 16), __uint_as_float(og1.x & 0xffff0000u), __uint_as_float(og1.y << 16), __uint_as_float(og1.y & 0xffff0000u)};
          const f32x4 g3 = (f32x4){__uint_as_float(og1.z << 16), __uint_as_float(og1.z & 0xffff0000u), __uint_as_float(og1.w << 16), __uint_as_float(og1.w & 0xffff0000u)};
          st8_bf16(p.HM() + oo, v[0] * rstd * n0 * g0, v[1] * rstd * n1 * g1); st8_bf16(p.HM() + oo + 8, v[2] * rstd * n2 * g2, v[3] * rstd * n3 * g3); }
    }
    __syncthreads();
}
#undef PK4
#undef RSWZ
#undef SBAR
}

__device__ __forceinline__ void phase_mlstm_scan(const Params& p, char* lds, int vcu, int G) {
    for (int u = vcu; u < NB * 8 * 2; u += G) ml::scan_unit(p, u >> 4, (u >> 1) & 7, u & 1, lds);
}
__device__ __forceinline__ void phase_mlstm_out(const Params& p, char* lds, int vcu, int G) {
    ml::phase_mlstm_out_body(p, lds, vcu, G);
}

#define RS_STEP(IN, OUT, N, BIT, MASK) _Pragma("unroll") for (int i_ = 0; i_ < (N); ++i_) { const float keep_ = (BIT) ? IN[(N) + i_] : IN[i_], send_ = (BIT) ? IN[i_] : IN[(N) + i_]; OUT[i_] = keep_ + __shfl_xor(send_, (MASK)); }
__device__ __forceinline__ float route_reduce(const float (&v)[32], int lane) {
    const int b5 = (lane >> 5) & 1, b4 = (lane >> 4) & 1, b3 = (lane >> 3) & 1, b2 = (lane >> 2) & 1, b1 = (lane >> 1) & 1;
    float a16[16], a8[8], a4[4], a2[2], a1[1];
    RS_STEP(v, a16, 16, b5, 32) RS_STEP(a16, a8, 8, b4, 16) RS_STEP(a8, a4, 4, b3, 8) RS_STEP(a4, a2, 2, b2, 4) RS_STEP(a2, a1, 1, b1, 2)
    return a1[0] + __shfl_xor(a1[0], 1);
}
__device__ __forceinline__ int route_rank(float val, int myexp) {
    int cnt = 0;
#pragma unroll
    for (int e = 0; e < 32; ++e) { const float ve = __int_as_float(__builtin_amdgcn_readlane(__float_as_int(val), 2 * e)); cnt += (ve > val || (ve == val && e < myexp)) ? 1 : 0; }
    return cnt;
}
__device__ __forceinline__ void phase_route(const Params& p, char* lds, int vcu, int G) {
    constexpr int XST = 1028;
    float* xs = (float*)lds;
    float* part = (float*)(lds + 65792);
    unsigned short* ent = (unsigned short*)(lds + 84224);
    int* lcount = (int*)(lds + 88320); int* lbase = lcount + 32;
    float* rec = (float*)(lds + 88576);
    const int tid = threadIdx.x, lane = tid & 63, w = tid >> 6, q4 = lane >> 4, l15 = lane & 15;
    __syncthreads();
    if (tid < 32) lcount[tid] = 0;
    float breg0[32], breg1[32];
#pragma unroll
    for (int i = 0; i < 32; ++i) { const float* wr = p.w_router + (size_t)(128 * w + 4 * i + q4) * NEXP + l15; breg0[i] = wr[0]; breg1[i] = wr[16]; }
    const int te = lane & 31, tsel = lane >> 5;
    const float mybias = p.b_router[te];
    int nloc = 0;
    float4 pa_[4], pb_[4];
    if (vcu * 16 < NT) {
#pragma unroll
        for (int j = 0; j < 4; ++j) { pa_[j] = ntld4(p.out + (size_t)(vcu * 16 + w * 2) * DM + (j * 64 + lane) * 4); pb_[j] = ntld4(p.out + (size_t)(vcu * 16 + w * 2 + 1) * DM + (j * 64 + lane) * 4); } }
#pragma unroll 1
    for (int base = vcu * 16; base < NT; base += G * 16, nloc += 16) {
        const int row0 = base + w * 2;
        float4 xa[4], xb[4]; float sa = 0.f, sb = 0.f;
#pragma unroll
        for (int j = 0; j < 4; ++j) { xa[j] = pa_[j]; xb[j] = pb_[j]; }
        { const int nb_ = base + G * 16; if (nb_ < NT) {
#pragma unroll
            for (int j = 0; j < 4; ++j) { pa_[j] = ntld4(p.out + (size_t)(nb_ + w * 2) * DM + (j * 64 + lane) * 4); pb_[j] = ntld4(p.out + (size_t)(nb_ + w * 2 + 1) * DM + (j * 64 + lane) * 4); } } }
#pragma unroll
        for (int j = 0; j < 4; ++j) { sa += xa[j].x * xa[j].x + xa[j].y * xa[j].y + xa[j].z * xa[j].z + xa[j].w * xa[j].w; sb += xb[j].x * xb[j].x + xb[j].y * xb[j].y + xb[j].z * xb[j].z + xb[j].w * xb[j].w; }
        const float ra = rsqrtf(wave_sum(sa) * (1.f / DM) + EPS), rb = rsqrtf(wave_sum(sb) * (1.f / DM) + EPS);
#pragma unroll
        for (int j = 0; j < 4; ++j) { const int c = (j * 64 + lane) * 4; const float4 g = *(const float4*)(p.norm_ffn + c);
            xa[j] = make_float4(xa[j].x * ra * g.x, xa[j].y * ra * g.y, xa[j].z * ra * g.z, xa[j].w * ra * g.w);
            xb[j] = make_float4(xb[j].x * rb * g.x, xb[j].y * rb * g.y, xb[j].z * rb * g.z, xb[j].w * rb * g.w);
            *(float4*)&xs[(w * 2) * XST + c] = xa[j]; *(float4*)&xs[(w * 2 + 1) * XST + c] = xb[j];
            *(unsigned*)((unsigned char*)p.XN2() + (size_t)row0 * DM + c) = pk4_fp8(xa[j].x, xa[j].y, xa[j].z, xa[j].w);
            *(unsigned*)((unsigned char*)p.XN2() + (size_t)(row0 + 1) * DM + c) = pk4_fp8(xb[j].x, xb[j].y, xb[j].z, xb[j].w); }
        __syncthreads();
        f32x4 acc0 = {0.f, 0.f, 0.f, 0.f}, acc1 = {0.f, 0.f, 0.f, 0.f};
        const float* xp = xs + l15 * XST + 128 * w + q4;
#pragma unroll
        for (int i = 0; i < 32; ++i) { const float a = xp[4 * i];
            acc0 = __builtin_amdgcn_mfma_f32_16x16x4f32(a, breg0[i], acc0, 0, 0, 0); acc1 = __builtin_amdgcn_mfma_f32_16x16x4f32(a, breg1[i], acc1, 0, 0, 0); }
#pragma unroll
        for (int r = 0; r < 4; ++r) { part[(w * 16 + 4 * q4 + r) * 32 + l15] = acc0[r]; part[(w * 16 + 4 * q4 + r) * 32 + 16 + l15] = acc1[r]; }
        __syncthreads();
        float val = mybias;
#pragma unroll
        for (int w8 = 0; w8 < 8; ++w8) val += part[(w8 * 16 + 2 * w + tsel) * 32 + te];
        int cnt = 0;
#pragma unroll
        for (int e = 0; e < 32; ++e) { const float v0 = __int_as_float(__builtin_amdgcn_readlane(__float_as_int(val), e)), v1 = __int_as_float(__builtin_amdgcn_readlane(__float_as_int(val), 32 + e));
            const float ve = tsel ? v1 : v0; cnt += (ve > val || (ve == val && e < te)) ? 1 : 0; }
        float* rc = rec + w * 16 + tsel * 8;
        if (cnt < 4) { rc[cnt * 2] = __int_as_float(te); rc[cnt * 2 + 1] = val; }
        asm volatile("s_waitcnt lgkmcnt(0)" ::: "memory");
        if (te == 0) {
            const int row = row0 + tsel, tl = nloc + w * 2 + tsel; float ex[4], sum = 0.f; int tx[4];
#pragma unroll
            for (int kk = 0; kk < 4; ++kk) { tx[kk] = __float_as_int(rc[kk * 2]); ex[kk] = __expf(rc[kk * 2 + 1] - rc[1]); sum += ex[kk]; }
            const float inv = 1.f / sum;
#pragma unroll
            for (int kk = 0; kk < 4; ++kk) { const int e = tx[kk]; p.TOPI()[row * 4 + kk] = e; p.TOPW()[row * 4 + kk] = ex[kk] * inv;
                const int lr = atomicAdd(&lcount[e], 1); ent[tl * 4 + kk] = (unsigned short)(e | (lr << 5)); }
        }
        asm volatile("s_waitcnt lgkmcnt(0)" ::: "memory");
    }
    __syncthreads();
    if (tid < 32) lbase[tid] = atomicAdd(&p.CNT()[tid * CNT_STRIDE], lcount[tid]);
    __syncthreads();
    for (int idx = tid; idx < nloc * 4; idx += MK_THREADS) { const int tl = idx >> 2, row = vcu * 16 + (tl >> 4) * G * 16 + (tl & 15); const unsigned en = ent[idx];
        p.RANK()[row * 4 + (idx & 3)] = lbase[en & 31] + (int)(en >> 5); }
    __syncthreads();
}
#undef RS_STEP
__device__ __forceinline__ void phase_scatter(const Params& p, char* lds, int vcu, int G) {
    int* ps = (int*)lds;
    __syncthreads();
    if (threadIdx.x == 0) { int s = 0; for (int e = 0; e < NEXP; ++e) { ps[e] = s; s += (p.CNT()[e * CNT_STRIDE] + 255) / 256 * 256; } }
    __syncthreads();
    for (int gid = vcu * MK_THREADS + threadIdx.x; gid < NT * 4; gid += G * MK_THREADS) { const int slot = ps[p.TOPI()[gid]] + p.RANK()[gid]; p.SLOTS()[gid] = slot; p.SLOT_TOK()[slot] = gid >> 2; }
    __syncthreads();
}
__device__ __forceinline__ void phase_combine(const Params& p, int vcu, int G, float* dst) {
    const int lane = threadIdx.x & 63, gw = vcu * 8 + (threadIdx.x >> 6), NGW = G * 8;
    for (int r = gw * 2; r < NT; r += NGW * 2) {
        int sl[8]; float tw[8];
#pragma unroll
        for (int q = 0; q < 8; ++q) { sl[q] = p.SLOTS()[r * 4 + q]; tw[q] = p.TOPW()[r * 4 + q]; }
        float4 v[8];
#pragma unroll
        for (int j = 0; j < 4; ++j) { v[j] = ntld4(p.out + (size_t)r * DM + (j * 64 + lane) * 4); v[4 + j] = ntld4(p.out + (size_t)(r + 1) * DM + (j * 64 + lane) * 4); }
        unsigned y[8][4];
#pragma unroll
        for (int q = 0; q < 8; ++q)
#pragma unroll
            for (int j = 0; j < 4; ++j) y[q][j] = __builtin_nontemporal_load((const unsigned*)((const unsigned char*)p.YB() + (size_t)sl[q] * DM + (j * 64 + lane) * 4));
#pragma unroll
        for (int q = 0; q < 8; ++q) { const float w = tw[q] * (1.f / YB_SCALE); const int o = (q >> 2) * 4;
#pragma unroll
            for (int j = 0; j < 4; ++j) { const f32x2 lo = __builtin_amdgcn_cvt_pk_f32_fp8((int)y[q][j], false), hi = __builtin_amdgcn_cvt_pk_f32_fp8((int)y[q][j], true);
                v[o + j].x += w * lo[0]; v[o + j].y += w * lo[1]; v[o + j].z += w * hi[0]; v[o + j].w += w * hi[1]; } }
        float sa = 0.f, sb = 0.f;
#pragma unroll
        for (int j = 0; j < 4; ++j) { sa += v[j].x * v[j].x + v[j].y * v[j].y + v[j].z * v[j].z + v[j].w * v[j].w; sb += v[4 + j].x * v[4 + j].x + v[4 + j].y * v[4 + j].y + v[4 + j].z * v[4 + j].z + v[4 + j].w * v[4 + j].w; }
        const float ra = rsqrtf(wave_sum(sa) * (1.f / DM) + EPS), rb = rsqrtf(wave_sum(sb) * (1.f / DM) + EPS);
#pragma unroll
        for (int j = 0; j < 4; ++j) { const int c = (j * 64 + lane) * 4; const float4 g = *(const float4*)(p.norm_final + c);
            *(float4*)(dst + (size_t)r * DM + c) = make_float4(v[j].x * ra * g.x, v[j].y * ra * g.y, v[j].z * ra * g.z, v[j].w * ra * g.w);
            *(float4*)(dst + (size_t)(r + 1) * DM + c) = make_float4(v[4 + j].x * rb * g.x, v[4 + j].y * rb * g.y, v[4 + j].z * rb * g.z, v[4 + j].w * rb * g.w); }
    }
}
__device__ __forceinline__ void phase_init_ctl(const Params& p, int vcu, int G) {
    if (vcu == 0) for (int i = threadIdx.x; i < NEXP * CNT_STRIDE; i += MK_THREADS) p.CNT()[i] = 0;
    for (int i = vcu * MK_THREADS + threadIdx.x; i < NSLOT; i += G * MK_THREADS) p.SLOT_TOK()[i] = -1;
}

#define XB_TMO      128
#define XB_XCNT(j)  (256  + 64 * (j))
#define XB_XSUB(j)  (1280 + 64 * (j))
#define XB_XGEN(j)  (2304 + 64 * (j))
#define XB_TOP      3328
#define XB_TOPGEN   3392
#define XCD_BAR_WORDS 3456
#define XB_SPIN_CAP (1u << 20)
__device__ __forceinline__ unsigned xb_ld(unsigned* p)              { return __hip_atomic_load(p, __ATOMIC_RELAXED, __HIP_MEMORY_SCOPE_AGENT); }
__device__ __forceinline__ unsigned xb_add(unsigned* p, unsigned v) { return __hip_atomic_fetch_add(p, v, __ATOMIC_RELAXED, __HIP_MEMORY_SCOPE_AGENT); }
__device__ __forceinline__ unsigned xb_xcc_id() { return (unsigned)__builtin_amdgcn_s_getreg((3 << 11) | 20) & 0xFu; }
#define XB_SPIN(cond, bar) do { unsigned _sp = 0; while (cond) { __builtin_amdgcn_s_sleep(1); \
    if ((++_sp & 255u) == 0u) { if (xb_ld(&(bar)[XB_TMO])) break; if (_sp > XB_SPIN_CAP) { atomicAdd(&(bar)[XB_TMO], 1u); break; } } } } while (0)
struct XcdBarrier { unsigned* bar; unsigned x; volatile LAS unsigned* st; };
__device__ __forceinline__ XcdBarrier xcd_barrier_post(unsigned* bar, volatile LAS unsigned* st) {
    XcdBarrier b; b.bar = bar; b.x = xb_xcc_id(); b.st = st;
    if (threadIdx.x == 0) (void)xb_add(&bar[XB_XCNT(b.x)], 1u);
    return b;
}
__device__ __forceinline__ void xcd_barrier_complete(unsigned* bar, unsigned x, unsigned& nloc, unsigned& nx) {
    const unsigned G = gridDim.x * gridDim.y * gridDim.z;
    unsigned sum, cnt, mine, sp = 0u;
    for (;;) {
        sum = 0u; cnt = 0u; mine = 0u;
#pragma unroll
        for (unsigned j = 0; j < 16; ++j) { const unsigned c = xb_ld(&bar[XB_XCNT(j)]); sum += c; cnt += (c > 0u) ? 1u : 0u; mine = (j == x) ? c : mine; }
        if (sum == G) break;
        __builtin_amdgcn_s_sleep(1);
        if ((++sp & 255u) == 0u) { if (xb_ld(&bar[XB_TMO])) break; if (sp > XB_SPIN_CAP) { atomicAdd(&bar[XB_TMO], 1u); break; } }
    }
    nloc = mine > 0u ? mine : 1u; nx = cnt > 0u ? cnt : 1u;
}
__device__ __forceinline__ void xcd_barrier(const XcdBarrier& b) {
    asm volatile("s_waitcnt vmcnt(0)" ::: "memory");
    __syncthreads();
    if (threadIdx.x == 0) {
        unsigned* bar = b.bar;
        __builtin_amdgcn_s_waitcnt(0);
        unsigned nloc = b.st[0], nx = b.st[1];
        if (nloc == 0u) { xcd_barrier_complete(bar, b.x, nloc, nx); b.st[0] = nloc; b.st[1] = nx; }
        const unsigned old = xb_add(&bar[XB_XSUB(b.x)], 1u);
        const unsigned gen = old / nloc;
        if (old + 1u == (gen + 1u) * nloc) {
            __builtin_amdgcn_fence(__ATOMIC_RELEASE, "agent");
            asm volatile("s_waitcnt vmcnt(0)" ::: "memory");
            const unsigned og = xb_add(&bar[XB_TOP], 1u);
            const unsigned tg = og / nx;
            if (og + 1u == (tg + 1u) * nx) xb_add(&bar[XB_TOPGEN], 1u);
            else XB_SPIN(xb_ld(&bar[XB_TOPGEN]) == tg, bar);
            __builtin_amdgcn_fence(__ATOMIC_ACQUIRE, "agent");
            xb_add(&bar[XB_XGEN(b.x)], 1u);
            asm volatile("s_waitcnt vmcnt(0)" ::: "memory");
        } else {
            XB_SPIN(xb_ld(&bar[XB_XGEN(b.x)]) == gen, bar);
            __builtin_amdgcn_fence(__ATOMIC_ACQUIRE, "agent");
            asm volatile("s_waitcnt vmcnt(0)" ::: "memory");
        }
    }
    __syncthreads();
}

struct MkArgs { Params p; int ph_lo, ph_hi, sub, pad; };
enum { PH_PRO = 0, PH_INPROJ = 1, PH_MSCAN = 2, PH_QPROJ = 3, PH_MOUT = 4, PH_ATTN = 5, PH_YM = 6, PH_YA = 7, PH_OUT = 8, PH_ROUTE = 9, PH_SCATTER = 10, PH_M1 = 11, PH_M2 = 12, PH_COMBINE = 13, PH_END = 14 };

__global__ void __launch_bounds__(MK_THREADS, 2) mk_fwd(MkArgs a) {
    extern __shared__ __attribute__((aligned(16))) unsigned char lds_raw[];
    LAS unsigned char* lds = (LAS unsigned char*)lds_raw;
    const Params& p = *(const Params*)__builtin_amdgcn_kernarg_segment_ptr();
    const int G = gridDim.x, bx = blockIdx.x;
    const int vcu = (G % 8 == 0) ? (bx % 8) * (G / 8) + bx / 8 : bx;
    cooperative_groups::grid_group grid = cooperative_groups::this_grid();
    const int lo = a.ph_lo, hi = a.ph_hi;
    volatile LAS unsigned* bst = (volatile LAS unsigned*)(lds + MK_LDS - 16);
    if (threadIdx.x < 4) bst[threadIdx.x] = 0u;
    __syncthreads();
    XcdBarrier xbar; xbar.bar = p.BAR(); xbar.x = 0; xbar.st = bst;
    if (hi - lo > 1) xbar = xcd_barrier_post(p.BAR(), bst);
#ifndef PHASE_MASK
#define PHASE_MASK 0xffffffffu
#endif
#define IN(k) (((PHASE_MASK >> (k)) & 1u) && lo <= (k) && (k) < hi)
#define SEAM(k) do { if (IN(k) && IN((k) + 1)) { if (a.sub == 0x7fffffff) grid.sync(); else xcd_barrier(xbar); } } while (0)
#ifndef PROBE_PHASE
#define PROBE_PHASE -1
#endif
#ifndef PROBE_REPS
#define PROBE_REPS 2
#endif
#define REPS(k) ((k) == PROBE_PHASE ? PROBE_REPS : 1)
    if (IN(PH_PRO)) for (int rep_ = 0; rep_ < REPS(PH_PRO); ++rep_) { if (rep_) xcd_barrier(xbar); phase_init_ctl(p, vcu, G); phase_prologue(p, lds, vcu, G, a.sub); } SEAM(PH_PRO);
    if (IN(PH_INPROJ)) for (int rep_ = 0; rep_ < REPS(PH_INPROJ); ++rep_) { if (rep_) xcd_barrier(xbar); { pg8::StaticOrderN<10> S; S.init(DM, G, bx, p.U(), p.WinT()); EpiInP<0> E{p}; pg8::gemm_phase<EpiInP<0>, pg8::StaticOrderN<10>>(lds, DM, DM, S, E); }
        { pg8::StaticOrderN<12> S; S.init(DM / 2, G, bx, p.U8(), p.WinT8()); EpiInP<1> E{p}; pg8::gemm_phase<EpiInP<1>, pg8::StaticOrderN<12>, true>(lds, DM / 2, DM / 2, S, E); } } SEAM(PH_INPROJ);
    if (IN(PH_MSCAN)) for (int rep_ = 0; rep_ < REPS(PH_MSCAN); ++rep_) { if (rep_) xcd_barrier(xbar);
        { const int half = (bx >> 3) & 1, idx = (bx & 7) * 16 + (bx >> 4);
            if (half == 0) { if (a.sub != 2) phase_mlstm_scan(p, (char*)lds_raw, idx, 128); }
            else if (a.sub != 1) { phase_kprep(p, idx, 128);
                asm volatile("s_waitcnt vmcnt(0)" ::: "memory"); __syncthreads();
                if (threadIdx.x == 0) { unsigned* cw = p.BAR() + 3584; __builtin_amdgcn_fence(__ATOMIC_RELEASE, "agent"); asm volatile("s_waitcnt vmcnt(0)" ::: "memory");
                    xb_add(cw, 1u); unsigned sp = 0; while (xb_ld(cw) < 128u * (unsigned)(rep_ + 1)) { __builtin_amdgcn_s_sleep(2); if (++sp > (1u << 22)) break; }
                    __builtin_amdgcn_fence(__ATOMIC_ACQUIRE, "agent"); asm volatile("s_waitcnt vmcnt(0)" ::: "memory"); }
                __syncthreads();
                pg8::StaticOrderN<6> S; S.init(256, 128, idx, p.CQb(), p.WqT()); EpiQ E{p}; pg8::gemm_phase<EpiQ, pg8::StaticOrderN<6>>(lds, 256, 256, S, E); } }
        } SEAM(PH_MSCAN);
    if (IN(PH_MOUT)) for (int rep_ = 0; rep_ < REPS(PH_MOUT); ++rep_) { if (rep_) xcd_barrier(xbar); phase_mlstm_out(p, (char*)lds_raw, vcu, G); }
    if (IN(PH_ATTN)) for (int rep_ = 0; rep_ < REPS(PH_ATTN); ++rep_) { if (rep_) xcd_barrier(xbar); phase_attn(p, (char*)lds_raw, vcu, G); } SEAM(PH_ATTN);
    if (IN(PH_YM)) for (int rep_ = 0; rep_ < REPS(PH_YM); ++rep_) { if (rep_) xcd_barrier(xbar); pg8::StaticOrderN<4> S; S.init(DM, G, bx, p.HM(), p.WmT()); EpiMix<0> E{p}; pg8::gemm_phase<EpiMix<0>, pg8::StaticOrderN<4>>(lds, DM, DM, S, E); }
    if (IN(PH_YA)) for (int rep_ = 0; rep_ < REPS(PH_YA); ++rep_) { if (rep_) xcd_barrier(xbar); pg8::StaticOrderN<4> S; S.init(DM, G, bx, p.OA(), p.WoT()); EpiMix<1> E{p}; pg8::gemm_phase<EpiMix<1>, pg8::StaticOrderN<4>>(lds, DM, DM, S, E); } SEAM(PH_YA);
    if (IN(PH_OUT)) for (int rep_ = 0; rep_ < REPS(PH_OUT); ++rep_) { if (rep_) xcd_barrier(xbar); pg8::StaticOrderN<4> S; S.init(DM, G, bx, p.MIX(), p.WoutT()); EpiOut E{p}; pg8::gemm_phase<EpiOut, pg8::StaticOrderN<4>>(lds, DM, DM, S, E); } SEAM(PH_OUT);
    if (IN(PH_ROUTE)) for (int rep_ = 0; rep_ < REPS(PH_ROUTE); ++rep_) { if (rep_) xcd_barrier(xbar); phase_route(p, (char*)lds_raw, vcu, G); } SEAM(PH_ROUTE);
    if (IN(PH_SCATTER)) for (int rep_ = 0; rep_ < REPS(PH_SCATTER); ++rep_) { if (rep_) xcd_barrier(xbar); phase_scatter(p, (char*)lds_raw, vcu, G); } SEAM(PH_SCATTER);
    if (IN(PH_M1)) for (int rep_ = 0; rep_ < REPS(PH_M1); ++rep_) { if (rep_) xcd_barrier(xbar); volatile LAS int* tst = (volatile LAS int*)(lds + MISC_OFF); moe_tile_table(p, tst);
        pg8::MoeOrder S; S.tstart = tst; S.npn = 8; S.G = G; S.c = bx; S.A = (const char*)p.XN2(); S.W = (const char*)p.W1T(); S.wexp = (size_t)2048 * DM; S.btile = (size_t)256 * DM;     S.rowidx = p.SLOT_TOK(); S.bias = p.b1; S.bsplit = 1;
        EpiM1 E{p}; pg8::gemm_phase<EpiM1, pg8::MoeOrder, true>(lds, DM / 2, DM / 2, S, E); } SEAM(PH_M1);
    if (IN(PH_M2)) for (int rep_ = 0; rep_ < REPS(PH_M2); ++rep_) { if (rep_) xcd_barrier(xbar); volatile LAS int* tst = (volatile LAS int*)(lds + MISC_OFF); moe_tile_table(p, tst);
        pg8::MoeOrder S; S.tstart = tst; S.npn = 4; S.G = G; S.c = bx; S.A = (const char*)p.ACT(); S.W = (const char*)p.W2T(); S.wexp = (size_t)DM * DFF; S.btile = (size_t)256 * DFF; S.rowidx = nullptr; S.bias = p.b2; S.bsplit = 0;
        EpiM2 E{p}; pg8::gemm_phase<EpiM2, pg8::MoeOrder, true>(lds, DFF / 2, DFF / 2, S, E); } SEAM(PH_M2);
    if (IN(PH_COMBINE)) for (int rep_ = 0; rep_ < REPS(PH_COMBINE); ++rep_) { if (rep_) xcd_barrier(xbar); phase_combine(p, vcu, G, a.sub ? (float*)p.ACT() : p.out); }
#undef IN
#undef SEAM
}

#ifndef ONE_LAUNCH
#define ONE_LAUNCH 1
#endif
#ifndef PROBE_DUP
#define PROBE_DUP -1
#endif
#ifndef PROBE_SUB
#define PROBE_SUB 0
#endif
#ifndef PROBE_DUP_N
#define PROBE_DUP_N 1
#endif
#ifndef FAST_INPROJ
#define FAST_INPROJ 1
#endif
#ifndef FAST_QPROJ
#define FAST_QPROJ 1
#endif
#ifndef FAST_MIX
#define FAST_MIX 1
#endif
#ifndef FAST_MOE
#define FAST_MOE 1
#endif
#ifndef FAST_ATTN
#define FAST_ATTN 1
#endif
#ifndef FAST_MLSTM
#define FAST_MLSTM 1
#endif
static void launch_mk(const Params& p, int lo, int hi, int grid, hipStream_t stream, int sub = 0) {
    MkArgs a{}; a.p = p; a.ph_lo = lo; a.ph_hi = hi; a.sub = sub;
    hipLaunchKernelGGL(mk_fwd, dim3(grid), dim3(MK_THREADS), MK_LDS, stream, a);
}
extern "C" void kernel_launch(void* const* d_in, const int* in_sizes, int n_in, void* d_out, int out_size, void* d_ws, size_t ws_size, hipStream_t stream) {
    static int ok = 0, grid = 0;
    if (!ok) {
        if (n_in != 22 || in_sizes[0] != NT * DM || out_size != NT * DM) { fprintf(stderr, "kernel_launch: unexpected shapes (n_in %d, x %d, out %d)\n", n_in, n_in > 0 ? in_sizes[0] : -1, out_size); return; }
        (void)hipFuncSetAttribute((const void*)k_mlstm_out, hipFuncAttributeMaxDynamicSharedMemorySize, MO_LDS);
        (void)hipFuncSetAttribute((const void*)mk_fwd, hipFuncAttributeMaxDynamicSharedMemorySize, MK_LDS);
        int dev = 0, cus = 0, per_cu = 0; (void)hipGetDevice(&dev); (void)hipDeviceGetAttribute(&cus, hipDeviceAttributeMultiprocessorCount, dev);
        (void)hipOccupancyMaxActiveBlocksPerMultiprocessor(&per_cu, (const void*)mk_fwd, MK_THREADS, MK_LDS);
        if (per_cu < 1) { fprintf(stderr, "kernel_launch: occupancy query says %d blocks/CU\n", per_cu); per_cu = 1; }
        if (cus != 256) { fprintf(stderr, "kernel_launch: built for a 256-CU device (got %d CUs)\n", cus); return; }
        grid = 256;
        ok = 1;
    }
    Params p{};
    const float** ins = (const float**)&p.x;
    for (int i = 0; i < 22; ++i) ins[i] = (const float*)d_in[i];
    p.out = (float*)d_out;
    p.ws = (char*)d_ws;
    if (WS_TOTAL > ws_size) { fprintf(stderr, "kernel_launch: workspace too small (%zu > %zu)\n", (size_t)WS_TOTAL, ws_size); return; }
    (void)hipMemsetAsync(p.BAR(), 0, 16384, stream);
#if ONE_LAUNCH
    { MkArgs a{}; a.p = p; a.ph_lo = 0; a.ph_hi = PH_END; void* args[] = {&a};
      hipError_t e = hipLaunchCooperativeKernel((const void*)mk_fwd, dim3(grid), dim3(MK_THREADS), args, MK_LDS, stream);
      if (e != hipSuccess) fprintf(stderr, "kernel_launch: cooperative launch failed: %s (grid %d)\n", hipGetErrorString(e), grid); }
#else
    for (int ph = 0; ph < PH_END; ++ph) { if (ph == PH_COMBINE && PROBE_DUP == PH_COMBINE) { launch_mk(p, ph, ph + 1, grid, stream, 1); launch_mk(p, ph, ph + 1, grid, stream, 0); continue; }
        launch_mk(p, ph, ph + 1, grid, stream);
        for (int d = 0; d < ((ph == PROBE_DUP) ? PROBE_DUP_N : 0); ++d) { if (ph == PH_ROUTE) (void)hipMemsetAsync(p.CNT(), 0, 4096, stream); launch_mk(p, ph, ph + 1, grid, stream, PROBE_SUB); } }
#endif
}
```

```cpp
#include <hip/hip_runtime.h>
#include <hip/hip_cooperative_groups.h>
#include <cstdio>
#include <cstdint>

typedef unsigned short bf16_t;
__device__ __forceinline__ float bf2f(bf16_t v) { return __uint_as_float(((unsigned)v) << 16); }
__device__ __forceinline__ bf16_t f2bf(float f) { unsigned u = __float_as_uint(f); return (bf16_t)((u + 0x7fffu + ((u >> 16) & 1u)) >> 16); }

constexpr int NB = 8, SEQ = 4096, NT = NB * SEQ, DM = 1024, NMETA = 16, LTOT = SEQ + NMETA;
constexpr int DIN = 5600;
constexpr int OFF_Q = 0, OFF_K = 512, OFF_V = 1024, OFF_O = 2048, OFF_I = 3072, OFF_F = 3088, OFF_CQ = 3104, OFF_CKV = 3360, OFF_KR = 3488, OFF_G = 3552;
constexpr int KVROWS = 4160;
constexpr int NEXP = 32, DFF = 1024;
constexpr int NSLOT = NT * 4 + NEXP * 256;
constexpr float EPS = 1e-6f;
constexpr int CNT_STRIDE = 16;
constexpr float QSCALE = 0.07216878364870322f * 1.4426950408889634f;

constexpr size_t ws_al(size_t x) { return (x + 255) & ~(size_t)255; }
constexpr size_t WS_BAR = 0;
constexpr size_t WS_CNT = WS_BAR + 16384;
constexpr size_t WS_SLOT_TOK = WS_CNT + ws_al(4096);
constexpr size_t WS_TOPI = WS_SLOT_TOK + ws_al((size_t)NSLOT*4);
constexpr size_t WS_TOPW = WS_TOPI + ws_al((size_t)NT*16);
constexpr size_t WS_RANK = WS_TOPW + ws_al((size_t)NT*16);
constexpr size_t WS_SLOTS = WS_RANK + ws_al((size_t)NT*16);
constexpr size_t WS_UM = WS_SLOTS + ws_al((size_t)NT*16);
constexpr size_t WS_ZM = WS_UM + ws_al((size_t)NMETA*DM*4);
constexpr size_t WS_ROPE = WS_ZM + ws_al((size_t)NMETA*DIN*4);
constexpr size_t WS_RSQ = WS_ROPE + ws_al((size_t)LTOT*64*4);
constexpr size_t WS_GI = WS_RSQ + ws_al((size_t)NT*4);
constexpr size_t WS_GF = WS_GI + ws_al((size_t)NT*64);
constexpr size_t WS_NF = WS_GF + ws_al((size_t)NT*64);
constexpr size_t WS_NB_ = WS_NF + ws_al((size_t)4096*256);
constexpr size_t WS_MF = WS_NB_ + ws_al((size_t)4096*256);
constexpr size_t WS_MB = WS_MF + ws_al((size_t)4096*4);
constexpr size_t WS_Kc = WS_MB + ws_al((size_t)4096*4);
constexpr size_t WS_WinT = WS_Kc + ws_al((size_t)NB*KVROWS*192*2);
constexpr size_t WS_WinT8 = WS_WinT + ws_al((size_t)5632*DM*2);
constexpr size_t WS_W1T = WS_WinT8 + ws_al((size_t)3072*DM);
constexpr size_t WS_W2T = WS_W1T + ws_al((size_t)NEXP*2048*DM*2);
constexpr size_t WS_WmT = WS_W2T + ws_al((size_t)NEXP*DM*DFF*2);
constexpr size_t WS_WoutT = WS_WmT + ws_al((size_t)DM*DM*2);
constexpr size_t WS_WoT = WS_WoutT + ws_al((size_t)DM*DM*2);
constexpr size_t WS_WqT = WS_WoT + ws_al((size_t)DM*DM*2);
constexpr size_t WS_CKV = WS_WqT + ws_al((size_t)1536*256*2);
constexpr size_t WS_KR = WS_CKV + ws_al((size_t)NT*128*4);
constexpr size_t WS_CQb = WS_KR + ws_al((size_t)NT*64*4);
constexpr size_t WS_GATE = WS_CQb + ws_al((size_t)NT*256*2);
constexpr size_t WS_WQF = WS_GATE + ws_al((size_t)NT*2048*2);
constexpr size_t WS_WOF = WS_WQF + ws_al((size_t)256*1536*4);
constexpr size_t WS_U = WS_WOF + ws_al((size_t)1024*1024*4);
constexpr size_t WS_Qm = WS_U + ws_al((size_t)NT*DM*2);
constexpr size_t WS_Km = WS_Qm + ws_al((size_t)NT*512*2);
constexpr size_t WS_Vm = WS_Km + ws_al((size_t)NT*512*2);
constexpr size_t WS_OG = WS_Vm + ws_al((size_t)NT*1024*2);
constexpr size_t WS_QP = WS_OG + ws_al((size_t)NT*1024*2);
constexpr size_t WS_CB = WS_QP + ws_al((size_t)NT*1536*2);
constexpr size_t WS_HM = WS_CB + ws_al((size_t)4096*8192*2);
constexpr size_t WS_OA = WS_HM + ws_al((size_t)NT*DM*2);
constexpr size_t WS_TOTAL = WS_OA + ws_al((size_t)NT*DM*2);
constexpr size_t WS_ACT = WS_U, WS_YB = WS_ACT + ws_al((size_t)NSLOT * DFF * 2), WS_MOE_END = WS_YB + ws_al((size_t)NSLOT * DM);
constexpr size_t WS_H1 = WS_OA;
constexpr size_t WS_U8 = WS_CB;
constexpr size_t WS_CF = WS_U, WS_MIX = WS_Qm, WS_XN2 = WS_HM, WS_CQ = WS_HM;
static_assert(WS_MOE_END <= WS_HM && WS_XN2 >= WS_MOE_END && WS_XN2 + (size_t)NT * DM <= WS_H1, "MoE overlay layout");
struct Params {
    const float *x, *meta, *norm_mix, *w_in, *m_b_i, *m_b_f, *m_norm, *w_m_proj, *a_w_uq, *a_w_ukv, *a_norm_q, *a_norm_kv, *w_a_proj, *w_out,
        *norm_ffn, *w_router, *b_router, *w1, *b1, *w2, *b2, *norm_final;
    float* out; char* ws;
    __host__ __device__ __forceinline__ int* CNT() const { return (int*)(ws + WS_CNT); }
    __host__ __device__ __forceinline__ unsigned* BAR() const { return (unsigned*)(ws + WS_BAR); }
    __host__ __device__ __forceinline__ unsigned char* WinT8() const { return (unsigned char*)(ws + WS_WinT8); }
    __host__ __device__ __forceinline__ unsigned char* U8() const { return (unsigned char*)(ws + WS_U8); }
    __host__ __device__ __forceinline__ int* SLOT_TOK() const { return (int*)(ws + WS_SLOT_TOK); }
    __host__ __device__ __forceinline__ int* TOPI() const { return (int*)(ws + WS_TOPI); }
    __host__ __device__ __forceinline__ float* TOPW() const { return (float*)(ws + WS_TOPW); }
    __host__ __device__ __forceinline__ int* RANK() const { return (int*)(ws + WS_RANK); }
    __host__ __device__ __forceinline__ int* SLOTS() const { return (int*)(ws + WS_SLOTS); }
    __host__ __device__ __forceinline__ float* UM() const { return (float*)(ws + WS_UM); }
    __host__ __device__ __forceinline__ float* ZM() const { return (float*)(ws + WS_ZM); }
    __host__ __device__ __forceinline__ float* ROPE() const { return (float*)(ws + WS_ROPE); }
    __host__ __device__ __forceinline__ float* RSQ() const { return (float*)(ws + WS_RSQ); }
    __host__ __device__ __forceinline__ float* GI() const { return (float*)(ws + WS_GI); }
    __host__ __device__ __forceinline__ float* GF() const { return (float*)(ws + WS_GF); }
    __host__ __device__ __forceinline__ float* NF() const { return (float*)(ws + WS_NF); }
    __host__ __device__ __forceinline__ float* NB_() const { return (float*)(ws + WS_NB_); }
    __host__ __device__ __forceinline__ float* MF() const { return (float*)(ws + WS_MF); }
    __host__ __device__ __forceinline__ float* MB() const { return (float*)(ws + WS_MB); }
    __host__ __device__ __forceinline__ bf16_t* Kc() const { return (bf16_t*)(ws + WS_Kc); }
    __host__ __device__ __forceinline__ bf16_t* WinT() const { return (bf16_t*)(ws + WS_WinT); }
    __host__ __device__ __forceinline__ bf16_t* W1T() const { return (bf16_t*)(ws + WS_W1T); }
    __host__ __device__ __forceinline__ bf16_t* W2T() const { return (bf16_t*)(ws + WS_W2T); }
    __host__ __device__ __forceinline__ bf16_t* WmT() const { return (bf16_t*)(ws + WS_WmT); }
    __host__ __device__ __forceinline__ bf16_t* WoutT() const { return (bf16_t*)(ws + WS_WoutT); }
    __host__ __device__ __forceinline__ bf16_t* WoT() const { return (bf16_t*)(ws + WS_WoT); }
    __host__ __device__ __forceinline__ bf16_t* WqT() const { return (bf16_t*)(ws + WS_WqT); }
    __host__ __device__ __forceinline__ float* CKV() const { return (float*)(ws + WS_CKV); }
    __host__ __device__ __forceinline__ float* KR() const { return (float*)(ws + WS_KR); }
    __host__ __device__ __forceinline__ bf16_t* CQb() const { return (bf16_t*)(ws + WS_CQb); }
    __host__ __device__ __forceinline__ bf16_t* GATE() const { return (bf16_t*)(ws + WS_GATE); }
    __host__ __device__ __forceinline__ float* WQF() const { return (float*)(ws + WS_WQF); }
    __host__ __device__ __forceinline__ float* WOF() const { return (float*)(ws + WS_WOF); }
    __host__ __device__ __forceinline__ bf16_t* U() const { return (bf16_t*)(ws + WS_U); }
    __host__ __device__ __forceinline__ bf16_t* Qm() const { return (bf16_t*)(ws + WS_Qm); }
    __host__ __device__ __forceinline__ bf16_t* Km() const { return (bf16_t*)(ws + WS_Km); }
    __host__ __device__ __forceinline__ bf16_t* Vm() const { return (bf16_t*)(ws + WS_Vm); }
    __host__ __device__ __forceinline__ bf16_t* OG() const { return (bf16_t*)(ws + WS_OG); }
    __host__ __device__ __forceinline__ bf16_t* QP() const { return (bf16_t*)(ws + WS_QP); }
    __host__ __device__ __forceinline__ bf16_t* CB() const { return (bf16_t*)(ws + WS_CB); }
    __host__ __device__ __forceinline__ bf16_t* HM() const { return (bf16_t*)(ws + WS_HM); }
    __host__ __device__ __forceinline__ bf16_t* OA() const { return (bf16_t*)(ws + WS_OA); }
    __host__ __device__ __forceinline__ bf16_t* H1() const { return (bf16_t*)(ws + WS_H1); }
    __host__ __device__ __forceinline__ bf16_t* ACT() const { return (bf16_t*)(ws + WS_ACT); }
    __host__ __device__ __forceinline__ bf16_t* YB() const { return (bf16_t*)(ws + WS_YB); }
    __host__ __device__ __forceinline__ bf16_t* CF() const { return (bf16_t*)(ws + WS_CF); }
    __host__ __device__ __forceinline__ bf16_t* MIX() const { return (bf16_t*)(ws + WS_MIX); }
    __host__ __device__ __forceinline__ bf16_t* XN2() const { return (bf16_t*)(ws + WS_XN2); }
    __host__ __device__ __forceinline__ float* CQ() const { return (float*)(ws + WS_CQ); }
};

__device__ __forceinline__ float wave_sum(float v) {
#pragma unroll
    for (int o = 1; o < 64; o <<= 1) v += __shfl_xor(v, o);
    return v;
}
__device__ __forceinline__ float sigmoidf_(float v) { return __builtin_amdgcn_rcpf(1.f + __expf(-v)); }
__device__ __forceinline__ float logsigmoidf_(float v) { return fminf(v, 0.f) - __logf(1.f + __expf(-fabsf(v))); }

__global__ void __launch_bounds__(256) k_prep_rows(Params p) {
    const int lane = threadIdx.x & 63, gw = (blockIdx.x * 256 + threadIdx.x) >> 6, ngw = (gridDim.x * 256) >> 6;
    for (int r = gw; r < NT + NMETA; r += ngw) {
        const float* src = r < NT ? p.x + (size_t)r * DM : p.meta + (size_t)(r - NT) * DM;
        float4 v[4]; float ss = 0.f;
#pragma unroll
        for (int j = 0; j < 4; ++j) { v[j] = *(const float4*)(src + (j * 64 + lane) * 4); ss += v[j].x * v[j].x + v[j].y * v[j].y + v[j].z * v[j].z + v[j].w * v[j].w; }
        const float rstd = rsqrtf(wave_sum(ss) * (1.f / DM) + EPS);
#pragma unroll
        for (int j = 0; j < 4; ++j) {
            const int c = (j * 64 + lane) * 4; const float4 g = *(const float4*)(p.norm_mix + c);
            const float a0 = v[j].x * rstd * g.x, a1 = v[j].y * rstd * g.y, a2 = v[j].z * rstd * g.z, a3 = v[j].w * rstd * g.w;
            if (r < NT) { bf16_t* d = p.U() + (size_t)r * DM + c; d[0] = f2bf(a0); d[1] = f2bf(a1); d[2] = f2bf(a2); d[3] = f2bf(a3); }
            else { float* d = p.UM() + (size_t)(r - NT) * DM + c; d[0] = a0; d[1] = a1; d[2] = a2; d[3] = a3; }
        }
    }
}

__global__ void __launch_bounds__(256) k_fold(Params p) {
    const long gid = (long)blockIdx.x * 256 + threadIdx.x, gn = (long)gridDim.x * 256;
    for (long i = gid; i < 256L * 1536; i += gn) {
        const int r = (int)(i / 1536), hc = (int)(i % 1536), h = hc / 192, c = hc % 192;
        const float* uq = p.a_w_uq + ((size_t)r * 8 + h) * 192; float acc;
        if (c >= 128) acc = uq[c];
        else { const float* kv = p.a_w_ukv + ((size_t)c * 8 + h) * 256; acc = 0.f; for (int d = 0; d < 128; ++d) acc += uq[d] * kv[d]; }
        p.WQF()[i] = acc;
    }
    for (long i = gid; i < 1024L * 1024; i += gn) {
        const int hc = (int)(i >> 10), n = (int)(i & 1023), h = hc >> 7, c = hc & 127;
        const float* kv = p.a_w_ukv + ((size_t)c * 8 + h) * 256 + 128; const float* ap = p.w_a_proj + (size_t)(h * 128) * DM + n;
        float acc = 0.f; for (int d = 0; d < 128; ++d) acc += kv[d] * ap[(size_t)d * DM];
        p.WOF()[i] = acc;
    }
    for (long i = gid; i < (long)LTOT * 32; i += gn) {
        const int pos = (int)(i >> 5), f = (int)(i & 31);
        const float freq = powf(10000.f, -(float)f / 32.f), ang = (float)pos * freq; float s, c; sincosf(ang, &s, &c);
        p.ROPE()[i * 2] = c; p.ROPE()[i * 2 + 1] = s;
    }
}

__global__ void __launch_bounds__(256) k_meta_proj(Params p) {
    const int gid = blockIdx.x * 256 + threadIdx.x;
    if (gid >= NMETA * DIN) return;
    const int j = gid / DIN, n = gid % DIN; const float* u = p.UM() + (size_t)j * DM; float acc = 0.f;
    for (int k = 0; k < DM; ++k) acc += u[k] * p.w_in[(size_t)k * DIN + n];
    p.ZM()[gid] = acc;
}

template <class P> __global__ void __launch_bounds__(256) k_sgemm(P q) {
    __shared__ float As[16][68]; __shared__ float Bs[16][68];
    const int ntn = (q.N + 63) / 64, ntm = q.M / 64, tid = threadIdx.x, tx = tid & 15, ty = tid >> 4;
    for (int tile = blockIdx.x; tile < ntm * ntn; tile += gridDim.x) {
        const int tm = tile / ntn, tn = tile % ntn; int ctx = 0;
        if (!q.setup(tm, ctx)) continue;
        float acc[4][4];
#pragma unroll
        for (int i = 0; i < 4; ++i)
#pragma unroll
            for (int j = 0; j < 4; ++j) acc[i][j] = 0.f;
        const int arow = tm * 64 + (tid >> 2), ak = (tid & 3) * 4, bk = tid >> 4, bcol = tn * 64 + (tid & 15) * 4;
        for (int k0 = 0; k0 < q.K; k0 += 16) {
            const float4 av = q.a4(ctx, arow, k0 + ak);
            const float4 bv = bcol < q.N ? q.b4(ctx, k0 + bk, bcol) : make_float4(0.f, 0.f, 0.f, 0.f);
            __syncthreads();
            As[ak + 0][tid >> 2] = av.x; As[ak + 1][tid >> 2] = av.y; As[ak + 2][tid >> 2] = av.z; As[ak + 3][tid >> 2] = av.w;
            *(float4*)&Bs[bk][(tid & 15) * 4] = bv;
            __syncthreads();
#pragma unroll
            for (int kk = 0; kk < 16; ++kk) {
                const float4 a = *(const float4*)&As[kk][ty * 4]; const float4 b = *(const float4*)&Bs[kk][tx * 4];
                const float aa[4] = {a.x, a.y, a.z, a.w}, bb[4] = {b.x, b.y, b.z, b.w};
#pragma unroll
                for (int i = 0; i < 4; ++i)
#pragma unroll
                    for (int j = 0; j < 4; ++j) acc[i][j] += aa[i] * bb[j];
            }
        }
        const int col = tn * 64 + tx * 4;
        if (col < q.N) {
#pragma unroll
            for (int i = 0; i < 4; ++i) q.epi(ctx, tm * 64 + ty * 4 + i, col, acc[i]);
        }
    }
}
__device__ __forceinline__ float4 ld_bf4(const bf16_t* p) { const uint2 w = *(const uint2*)p; return make_float4(__uint_as_float(w.x << 16), __uint_as_float(w.x & 0xffff0000u), __uint_as_float(w.y << 16), __uint_as_float(w.y & 0xffff0000u)); }

struct ProbIn {
    Params p; int M, N, K, pad;
    __device__ bool setup(int, int&) const { return true; }
    __device__ float4 a4(int, int row, int k) const { return ld_bf4(p.U() + (size_t)row * DM + k); }
    __device__ float4 b4(int, int k, int col) const { return *(const float4*)(p.w_in + (size_t)k * DIN + col); }
    __device__ void epi(int, int row, int col, const float (&v)[4]) const {
#pragma unroll
        for (int j = 0; j < 4; ++j) {
            const int c = col + j; const float z = v[j];
            if (c < OFF_K) p.Qm()[(size_t)row * 512 + c] = f2bf(z * 0.125f);
            else if (c < OFF_V) p.Km()[(size_t)row * 512 + (c - OFF_K)] = f2bf(z);
            else if (c < OFF_O) p.Vm()[(size_t)row * 1024 + (c - OFF_V)] = f2bf(z);
            else if (c < OFF_I) p.OG()[(size_t)row * 1024 + (c - OFF_O)] = f2bf(sigmoidf_(z));
            else if (c < OFF_F) p.GI()[(size_t)row * 16 + (c - OFF_I)] = z + p.m_b_i[c - OFF_I];
            else if (c < OFF_CQ) p.GF()[(size_t)row * 16 + (c - OFF_F)] = logsigmoidf_(z + p.m_b_f[c - OFF_F]);
            else if (c < OFF_CKV) p.CQ()[(size_t)row * 256 + (c - OFF_CQ)] = z;
            else if (c < OFF_KR) p.CKV()[(size_t)row * 128 + (c - OFF_CKV)] = z;
            else if (c < OFF_G) p.KR()[(size_t)row * 64 + (c - OFF_KR)] = z;
            else p.GATE()[(size_t)row * 2048 + (c - OFF_G)] = f2bf(sigmoidf_(z));
        }
    }
};

__global__ void __launch_bounds__(256) k_kprep(Params p) {
    const int lane = threadIdx.x & 63, gw = (blockIdx.x * 256 + threadIdx.x) >> 6, ngw = (gridDim.x * 256) >> 6;
    for (int i = gw; i < NB * KVROWS; i += ngw) {
        const int b = i / KVROWS, key = i % KVROWS; bf16_t* dst = p.Kc() + (size_t)i * 192;
        if (key >= LTOT) { dst[lane] = 0; dst[64 + lane] = 0; dst[128 + lane] = 0; continue; }
        const float *ckv, *kr; int pos;
        if (key < SEQ) { const size_t r = (size_t)b * SEQ + key; ckv = p.CKV() + r * 128; kr = p.KR() + r * 64; pos = NMETA + key; }
        else { const int j = key - SEQ; ckv = p.ZM() + (size_t)j * DIN + OFF_CKV; kr = p.ZM() + (size_t)j * DIN + OFF_KR; pos = j; }
        const float c0 = ckv[lane], c1 = ckv[64 + lane];
        const float rstd = rsqrtf(wave_sum(c0 * c0 + c1 * c1) * (1.f / 128.f) + EPS);
        dst[lane] = f2bf(c0 * rstd * p.a_norm_kv[lane]); dst[64 + lane] = f2bf(c1 * rstd * p.a_norm_kv[64 + lane]);
        if (lane < 32) {
            const float x1 = kr[lane], x2 = kr[32 + lane], cs = p.ROPE()[((size_t)pos * 32 + lane) * 2], sn = p.ROPE()[((size_t)pos * 32 + lane) * 2 + 1];
            dst[128 + lane] = f2bf(x1 * cs - x2 * sn); dst[160 + lane] = f2bf(x1 * sn + x2 * cs);
        }
    }
    for (int r = gw; r < NT; r += ngw) {
        float* cq = p.CQ() + (size_t)r * 256; float v[4]; float ss = 0.f;
#pragma unroll
        for (int j = 0; j < 4; ++j) { v[j] = cq[j * 64 + lane]; ss += v[j] * v[j]; }
        const float rstd = rsqrtf(wave_sum(ss) * (1.f / 256.f) + EPS);
#pragma unroll
        for (int j = 0; j < 4; ++j) cq[j * 64 + lane] = v[j] * rstd * p.a_norm_q[j * 64 + lane];
    }
}

struct ProbQ {
    Params p; int M, N, K, pad;
    __device__ bool setup(int, int&) const { return true; }
    __device__ float4 a4(int, int row, int k) const { return *(const float4*)(p.CQ() + (size_t)row * 256 + k); }
    __device__ float4 b4(int, int k, int col) const { return *(const float4*)(p.WQF() + (size_t)k * 1536 + col); }
    __device__ void epi(int, int row, int col, const float (&v)[4]) const {
        const int h = col / 192, c = col % 192;
        if (c < 128) {
#pragma unroll
            for (int j = 0; j < 4; ++j) p.QP()[(size_t)row * 1536 + col + j] = f2bf(v[j] * QSCALE);
        } else {
#pragma unroll
            for (int j = 0; j < 4; ++j) p.QP()[(size_t)row * 1536 + col + j] = f2bf(v[j] * QSCALE);
        }
        (void)h;
    }
};
__global__ void __launch_bounds__(256) k_rope_q(Params p) {
    const long gid = (long)blockIdx.x * 256 + threadIdx.x;
    if (gid >= (long)NT * 8 * 32) return;
    const int i = (int)(gid & 31), h = (int)((gid >> 5) & 7); const long r = gid >> 8; const int pos = NMETA + (int)(r % SEQ);
    bf16_t* q = p.QP() + (size_t)r * 1536 + h * 192 + 128;
    const float x1 = bf2f(q[i]), x2 = bf2f(q[32 + i]), cs = p.ROPE()[((size_t)pos * 32 + i) * 2], sn = p.ROPE()[((size_t)pos * 32 + i) * 2 + 1];
    q[i] = f2bf(x1 * cs - x2 * sn); q[32 + i] = f2bf(x1 * sn + x2 * cs);
}

__global__ void __launch_bounds__(256) k_mlstm_scan(Params p) {
    __shared__ float ks[64][65]; __shared__ float vs[64][128]; __shared__ float wk[64]; __shared__ float li[64], lf[64]; __shared__ float sc[2];
    const int tid = threadIdx.x, b = blockIdx.x >> 4, h = (blockIdx.x >> 1) & 7, dir = blockIdx.x & 1;
    const int d = tid >> 2, vq = tid & 3;
    float C[32]; float n = 0.f, m = 0.f;
#pragma unroll
    for (int i = 0; i < 32; ++i) C[i] = 0.f;
    bf16_t* CS = dir ? p.CB() : p.CF(); float* NS = dir ? p.NB_() : p.NF(); float* MS = dir ? p.MB() : p.MF();
    const int nsteps = dir ? 64 : 65;
    for (int st = 0; st < nsteps; ++st) {
        const int c = dir ? 63 - st : st - 1;
        if (c >= 0) {
            const size_t sidx = ((size_t)(b * 8 + h) * 64 + c);
            bf16_t* cd = CS + sidx * 8192 + d * 128 + vq * 32;
#pragma unroll
            for (int i = 0; i < 32; ++i) cd[i] = f2bf(C[i]);
            if (vq == 0) NS[sidx * 64 + d] = n;
            if (tid == 0) MS[sidx] = m;
            if ((dir == 0 && c == 63) || (dir == 1 && c == 0)) break;
        }
        const int npos = c < 0 ? NMETA : 64;
        __syncthreads();
        for (int e = tid; e < 64 * 64; e += 256) { const int j = e >> 6, dd = e & 63; float v = 0.f;
            if (j < npos) { if (c < 0) v = p.ZM()[(size_t)j * DIN + OFF_K + h * 64 + dd]; else { const int t = dir ? 63 - j : j; v = bf2f(p.Km()[((size_t)b * SEQ + c * 64 + t) * 512 + h * 64 + dd]); } }
            ks[j][dd] = v; }
        for (int e = tid; e < 64 * 128; e += 256) { const int j = e >> 7, dd = e & 127; float v = 0.f;
            if (j < npos) { if (c < 0) v = p.ZM()[(size_t)j * DIN + OFF_V + h * 128 + dd]; else { const int t = dir ? 63 - j : j; v = bf2f(p.Vm()[((size_t)b * SEQ + c * 64 + t) * 1024 + h * 128 + dd]); } }
            vs[j][dd] = v; }
        if (tid < 64) { float a = -1e30f, f = 0.f; const int j = tid;
            if (j < npos) { if (c < 0) { a = p.ZM()[(size_t)j * DIN + OFF_I + h] + p.m_b_i[h]; f = logsigmoidf_(p.ZM()[(size_t)j * DIN + OFF_F + h] + p.m_b_f[h]); }
                            else { const int t = dir ? 63 - j : j; const size_t r = (size_t)b * SEQ + c * 64 + t; a = p.GI()[r * 16 + dir * 8 + h]; f = p.GF()[r * 16 + dir * 8 + h]; } }
            li[j] = a; lf[j] = f; }
        __syncthreads();
        if (tid == 0) {
            float bl = 0.f; for (int j = 0; j < npos; ++j) bl += lf[j];
            float bc = 0.f, gmax = -1e30f;
            for (int j = 0; j < npos; ++j) { bc += lf[j]; const float g = bl - bc + li[j]; wk[j] = g; gmax = fmaxf(gmax, g); }
            const float mnew = fmaxf(bl + m, gmax);
            for (int j = 0; j < 64; ++j) wk[j] = j < npos ? __expf(wk[j] - mnew) : 0.f;
            sc[0] = __expf(bl + m - mnew); sc[1] = mnew;
        }
        __syncthreads();
        const float decay = sc[0]; m = sc[1];
#pragma unroll
        for (int i = 0; i < 32; ++i) C[i] *= decay;
        n *= decay;
        for (int j = 0; j < npos; ++j) { const float kw = wk[j] * ks[j][d]; n += kw;
#pragma unroll
            for (int i = 0; i < 32; ++i) C[i] += kw * vs[j][vq * 32 + i]; }
    }
}

constexpr int MO_LDS = (64 * 65 * 3 + 64 * 128 * 2 + 64 * 8) * 4;
__global__ void __launch_bounds__(256) k_mlstm_out(Params p) {
    extern __shared__ __attribute__((aligned(16))) float sm[];
    float (*qs)[65] = (float (*)[65])sm; float (*ks)[65] = (float (*)[65])(sm + 64 * 65); float (*Ws)[65] = (float (*)[65])(sm + 2 * 64 * 65);
    float (*vs)[128] = (float (*)[128])(sm + 3 * 64 * 65); float (*Cs)[128] = (float (*)[128])(sm + 3 * 64 * 65 + 64 * 128);
    float* sx = sm + 3 * 64 * 65 + 2 * 64 * 128; float *li = sx, *lf = sx + 64, *bt = sx + 128, *mt = sx + 192, *as = sx + 256, *ns = sx + 320, *msc = sx + 384;
    const int tid = threadIdx.x, c = blockIdx.x & 63, h = (blockIdx.x >> 6) & 7, b = blockIdx.x >> 9;
    const int t = tid >> 2, vq = tid & 3; const size_t r0 = (size_t)b * SEQ + c * 64;
    for (int e = tid; e < 64 * 64; e += 256) { const int j = e >> 6, dd = e & 63; qs[j][dd] = bf2f(p.Qm()[(r0 + j) * 512 + h * 64 + dd]); ks[j][dd] = bf2f(p.Km()[(r0 + j) * 512 + h * 64 + dd]); }
    for (int e = tid; e < 64 * 128; e += 256) { const int j = e >> 7, dd = e & 127; vs[j][dd] = bf2f(p.Vm()[(r0 + j) * 1024 + h * 128 + dd]); }
    __syncthreads();
    float S[16];
#pragma unroll
    for (int i = 0; i < 16; ++i) { const int s = vq * 16 + i; float a = 0.f;
#pragma unroll 4
        for (int dd = 0; dd < 64; ++dd) a += qs[t][dd] * ks[s][dd]; S[i] = a; }
    float hacc[32];
#pragma unroll
    for (int i = 0; i < 32; ++i) hacc[i] = 0.f;
#pragma unroll 1
    for (int dir = 0; dir < 2; ++dir) {
        const size_t sidx = ((size_t)(b * 8 + h) * 64 + c);
        const bf16_t* CS = (dir ? p.CB() : p.CF()) + sidx * 8192; const float* NS = (dir ? p.NB_() : p.NF()) + sidx * 64; const float* MS = (dir ? p.MB() : p.MF()) + sidx;
        __syncthreads();
        for (int e = tid; e < 64 * 128; e += 256) Cs[e >> 7][e & 127] = bf2f(CS[e]);
        if (tid < 64) { ns[tid] = NS[tid]; li[tid] = p.GI()[(r0 + tid) * 16 + dir * 8 + h]; lf[tid] = p.GF()[(r0 + tid) * 16 + dir * 8 + h]; }
        if (tid == 0) msc[0] = MS[0];
        __syncthreads();
        if (tid == 0) {
            const float m = msc[0]; float bc = 0.f, pm = -1e30f;
            if (dir == 0) { for (int j = 0; j < 64; ++j) { bc += lf[j]; const float a = li[j] - bc; as[j] = a; pm = fmaxf(pm, a); bt[j] = bc; mt[j] = fmaxf(bc + m, bc + pm); } }
            else { for (int j = 63; j >= 0; --j) { bc += lf[j]; const float a = li[j] - bc; as[j] = a; pm = fmaxf(pm, a); bt[j] = bc; mt[j] = fmaxf(bc + m, bc + pm); } }
        }
        __syncthreads();
        const float m = msc[0], b_t = bt[t], m_t = mt[t];
#pragma unroll
        for (int i = 0; i < 16; ++i) { const int s = vq * 16 + i; const bool valid = dir ? (s >= t) : (s <= t); Ws[t][s] = valid ? __expf(b_t + as[s] - m_t) * S[i] : 0.f; }
        __syncthreads();
        const float s_inter = __expf(b_t + m - m_t);
        float num[32]; float den = 0.f, qn = 0.f;
#pragma unroll
        for (int i = 0; i < 32; ++i) num[i] = 0.f;
#pragma unroll 2
        for (int dd = 0; dd < 64; ++dd) { const float qv = qs[t][dd]; qn += qv * ns[dd];
#pragma unroll
            for (int i = 0; i < 32; ++i) num[i] += qv * Cs[dd][vq * 32 + i]; }
#pragma unroll
        for (int i = 0; i < 32; ++i) num[i] *= s_inter;
        den = s_inter * qn;
#pragma unroll 2
        for (int s = 0; s < 64; ++s) { const float w = Ws[t][s]; den += w;
#pragma unroll
            for (int i = 0; i < 32; ++i) num[i] += w * vs[s][vq * 32 + i]; }
        const float inv = 1.f / fmaxf(fabsf(den), __expf(-m_t));
#pragma unroll
        for (int i = 0; i < 32; ++i) hacc[i] += num[i] * inv;
    }
    float ss = 0.f;
#pragma unroll
    for (int i = 0; i < 32; ++i) ss += hacc[i] * hacc[i];
    ss += __shfl_xor(ss, 1); ss += __shfl_xor(ss, 2);
    const float rstd = rsqrtf(ss * (1.f / 128.f) + EPS);
#pragma unroll
    for (int i = 0; i < 32; ++i) { const int col = h * 128 + vq * 32 + i; const size_t o = (r0 + t) * 1024 + col;
        p.HM()[o] = f2bf(hacc[i] * rstd * p.m_norm[col] * bf2f(p.OG()[o])); }
}

__global__ void __launch_bounds__(256) k_attn(Params p) {
    __shared__ float kt[32][192];
    const int tid = threadIdx.x, qi = tid >> 2, sl = tid & 3, qb = blockIdx.x & 63, h = (blockIdx.x >> 6) & 7, b = blockIdx.x >> 9;
    const size_t r = (size_t)b * SEQ + qb * 64 + qi;
    float q[48], o[32]; float m = -1e30f, l = 0.f;
#pragma unroll
    for (int i = 0; i < 48; ++i) q[i] = bf2f(p.QP()[r * 1536 + h * 192 + i * 4 + sl]);
#pragma unroll
    for (int i = 0; i < 32; ++i) o[i] = 0.f;
    const bf16_t* Kb = p.Kc() + (size_t)b * KVROWS * 192;
#pragma unroll 1
    for (int tile = 0; tile < KVROWS / 32; ++tile) {
        __syncthreads();
        for (int e = tid; e < 32 * 192; e += 256) kt[e / 192][e % 192] = bf2f(Kb[(size_t)tile * 32 * 192 + e]);
        __syncthreads();
#pragma unroll 1
        for (int g = 0; g < 4; ++g) {
            float s[8]; float tmax = -1e30f;
#pragma unroll
            for (int j = 0; j < 8; ++j) { float a = 0.f; const float* kr = &kt[g * 8 + j][sl];
#pragma unroll
                for (int i = 0; i < 48; ++i) a += q[i] * kr[i * 4];
                a += __shfl_xor(a, 1); a += __shfl_xor(a, 2);
                if (tile * 32 + g * 8 + j >= LTOT) a = -1e30f;
                s[j] = a; tmax = fmaxf(tmax, a); }
            const float mn = fmaxf(m, tmax), alpha = exp2f(m - mn); m = mn; l *= alpha;
#pragma unroll
            for (int i = 0; i < 32; ++i) o[i] *= alpha;
#pragma unroll
            for (int j = 0; j < 8; ++j) { const float pj = (tile * 32 + g * 8 + j >= LTOT) ? 0.f : exp2f(s[j] - mn); l += pj; const float* kr = &kt[g * 8 + j][sl];
#pragma unroll
                for (int i = 0; i < 32; ++i) o[i] += pj * kr[i * 4]; }
        }
    }
    const float inv = 1.f / l;
#pragma unroll
    for (int i = 0; i < 32; ++i) p.OA()[r * 1024 + h * 128 + i * 4 + sl] = f2bf(o[i] * inv);
}

struct ProbYm {
    Params p; int M, N, K, pad;
    __device__ bool setup(int, int&) const { return true; }
    __device__ float4 a4(int, int row, int k) const { return ld_bf4(p.HM() + (size_t)row * DM + k); }
    __device__ float4 b4(int, int k, int col) const { return *(const float4*)(p.w_m_proj + (size_t)k * DM + col); }
    __device__ void epi(int, int row, int col, const float (&v)[4]) const {
#pragma unroll
        for (int j = 0; j < 4; ++j) p.MIX()[(size_t)row * DM + col + j] = f2bf(v[j] * bf2f(p.GATE()[(size_t)row * 2048 + col + j]));
    }
};
struct ProbYa {
    Params p; int M, N, K, pad;
    __device__ bool setup(int, int&) const { return true; }
    __device__ float4 a4(int, int row, int k) const { return ld_bf4(p.OA() + (size_t)row * DM + k); }
    __device__ float4 b4(int, int k, int col) const { return *(const float4*)(p.WOF() + (size_t)k * DM + col); }
    __device__ void epi(int, int row, int col, const float (&v)[4]) const {
#pragma unroll
        for (int j = 0; j < 4; ++j) { const size_t o = (size_t)row * DM + col + j; p.MIX()[o] = f2bf(bf2f(p.MIX()[o]) + v[j] * bf2f(p.GATE()[(size_t)row * 2048 + 1024 + col + j])); }
    }
};
struct ProbOut {
    Params p; int M, N, K, pad;
    __device__ bool setup(int, int&) const { return true; }
    __device__ float4 a4(int, int row, int k) const { return ld_bf4(p.MIX() + (size_t)row * DM + k); }
    __device__ float4 b4(int, int k, int col) const { return *(const float4*)(p.w_out + (size_t)k * DM + col); }
    __device__ void epi(int, int row, int col, const float (&v)[4]) const {
        const float4 xv = *(const float4*)(p.x + (size_t)row * DM + col);
        *(float4*)(p.out + (size_t)row * DM + col) = make_float4(xv.x + v[0], xv.y + v[1], xv.z + v[2], xv.w + v[3]);
    }
};

__global__ void __launch_bounds__(256) k_route(Params p) {
    __shared__ float xn[8][1024];
    const int tid = threadIdx.x, lane = tid & 63, w = tid >> 6;
    for (int base = blockIdx.x * 8; base < NT; base += gridDim.x * 8) {
        __syncthreads();
        for (int rr = 0; rr < 2; ++rr) {
            const int row = base + w * 2 + rr; const float* src = p.out + (size_t)row * DM;
            float4 v[4]; float ss = 0.f;
#pragma unroll
            for (int j = 0; j < 4; ++j) { v[j] = *(const float4*)(src + (j * 64 + lane) * 4); ss += v[j].x * v[j].x + v[j].y * v[j].y + v[j].z * v[j].z + v[j].w * v[j].w; }
            const float rstd = rsqrtf(wave_sum(ss) * (1.f / DM) + EPS);
#pragma unroll
            for (int j = 0; j < 4; ++j) { const int c = (j * 64 + lane) * 4; const float4 g = *(const float4*)(p.norm_ffn + c);
                const float a0 = v[j].x * rstd * g.x, a1 = v[j].y * rstd * g.y, a2 = v[j].z * rstd * g.z, a3 = v[j].w * rstd * g.w;
                float* d = &xn[w * 2 + rr][c]; d[0] = a0; d[1] = a1; d[2] = a2; d[3] = a3;
                bf16_t* o = p.XN2() + (size_t)row * DM + c; o[0] = f2bf(a0); o[1] = f2bf(a1); o[2] = f2bf(a2); o[3] = f2bf(a3); }
        }
        __syncthreads();
        const int rloc = w * 2 + (lane >> 5), e = lane & 31, row = base + rloc;
        float acc = p.b_router[e];
        for (int k = 0; k < DM; ++k) acc += xn[rloc][k] * p.w_router[(size_t)k * NEXP + e];
        float val = acc; int ti[4]; float tv[4];
#pragma unroll
        for (int kk = 0; kk < 4; ++kk) {
            float best = val; int bi = e;
#pragma unroll
            for (int o = 1; o < 32; o <<= 1) { const float ov = __shfl_xor(best, o); const int oi = __shfl_xor(bi, o); if (ov > best || (ov == best && oi < bi)) { best = ov; bi = oi; } }
            ti[kk] = bi; tv[kk] = best; if (e == bi) val = -3.0e38f;
        }
        if (e == 0) {
            const float mx = tv[0]; float ex[4], sum = 0.f;
#pragma unroll
            for (int kk = 0; kk < 4; ++kk) { ex[kk] = __expf(tv[kk] - mx); sum += ex[kk]; }
#pragma unroll
            for (int kk = 0; kk < 4; ++kk) { p.TOPI()[row * 4 + kk] = ti[kk]; p.TOPW()[row * 4 + kk] = ex[kk] / sum; p.RANK()[row * 4 + kk] = atomicAdd(&p.CNT()[ti[kk] * CNT_STRIDE], 1); }
        }
    }
}
__device__ __forceinline__ int expert_pstart(const int* cnt, int e) { int s = 0; for (int i = 0; i < e; ++i) s += (cnt[i * CNT_STRIDE] + 255) / 256 * 256; return s; }
__global__ void __launch_bounds__(256) k_scatter(Params p) {
    __shared__ int ps[NEXP];
    if (threadIdx.x < NEXP) ps[threadIdx.x] = expert_pstart(p.CNT(), threadIdx.x);
    __syncthreads();
    const int gid = blockIdx.x * 256 + threadIdx.x; if (gid >= NT * 4) return;
    const int slot = ps[p.TOPI()[gid]] + p.RANK()[gid]; p.SLOTS()[gid] = slot; p.SLOT_TOK()[slot] = gid >> 2;
}

struct ProbM1 {
    Params p; int M, N, K, pad;
    __device__ bool setup(int tm, int& e) const {
        int s = 0; e = -1;
        for (int i = 0; i < NEXP; ++i) { const int pc = (p.CNT()[i * CNT_STRIDE] + 255) / 256 * 256; if (tm * 64 < s + pc) { e = i; break; } s += pc; }
        return e >= 0;
    }
    __device__ float4 a4(int, int row, int k) const { const int tok = p.SLOT_TOK()[row]; return tok < 0 ? make_float4(0.f, 0.f, 0.f, 0.f) : ld_bf4(p.XN2() + (size_t)tok * DM + k); }
    __device__ float4 b4(int e, int k, int col) const { const float* w = p.w1 + ((size_t)e * DM + k) * 2048 + (col >> 1); const float2 g = *(const float2*)w, l = *(const float2*)(w + 1024); return make_float4(g.x, l.x, g.y, l.y); }
    __device__ void epi(int e, int row, int col, const float (&v)[4]) const {
#pragma unroll
        for (int j = 0; j < 2; ++j) { const int c = (col >> 1) + j; const float g0 = v[2 * j] + p.b1[(size_t)e * 2048 + c], l0 = v[2 * j + 1] + p.b1[(size_t)e * 2048 + 1024 + c];
            const float glu = fminf(g0, 7.f), lin = fminf(fmaxf(l0, -7.f), 7.f);
            p.ACT()[(size_t)row * DFF + c] = f2bf(glu * sigmoidf_(1.702f * glu) * (lin + 1.f)); }
    }
};
struct ProbM2 {
    Params p; int M, N, K, pad;
    __device__ bool setup(int tm, int& e) const {
        int s = 0; e = -1;
        for (int i = 0; i < NEXP; ++i) { const int pc = (p.CNT()[i * CNT_STRIDE] + 255) / 256 * 256; if (tm * 64 < s + pc) { e = i; break; } s += pc; }
        return e >= 0;
    }
    __device__ float4 a4(int, int row, int k) const { return ld_bf4(p.ACT() + (size_t)row * DFF + k); }
    __device__ float4 b4(int e, int k, int col) const { return *(const float4*)(p.w2 + ((size_t)e * DFF + k) * DM + col); }
    __device__ void epi(int e, int row, int col, const float (&v)[4]) const {
#pragma unroll
        for (int j = 0; j < 4; ++j) p.YB()[(size_t)row * DM + col + j] = f2bf(v[j] + p.b2[(size_t)e * DM + col + j]);
    }
};

__global__ void __launch_bounds__(256) k_combine(Params p) {
    const int lane = threadIdx.x & 63, gw = (blockIdx.x * 256 + threadIdx.x) >> 6, ngw = (gridDim.x * 256) >> 6;
    for (int r = gw; r < NT; r += ngw) {
        float4 v[4];
#pragma unroll
        for (int j = 0; j < 4; ++j) v[j] = *(const float4*)(p.out + (size_t)r * DM + (j * 64 + lane) * 4);
#pragma unroll
        for (int kk = 0; kk < 4; ++kk) { const float w = p.TOPW()[r * 4 + kk]; const bf16_t* y = p.YB() + (size_t)p.SLOTS()[r * 4 + kk] * DM;
#pragma unroll
            for (int j = 0; j < 4; ++j) { const float4 t = ld_bf4(y + (j * 64 + lane) * 4); v[j].x += w * t.x; v[j].y += w * t.y; v[j].z += w * t.z; v[j].w += w * t.w; } }
        float ss = 0.f;
#pragma unroll
        for (int j = 0; j < 4; ++j) ss += v[j].x * v[j].x + v[j].y * v[j].y + v[j].z * v[j].z + v[j].w * v[j].w;
        const float rstd = rsqrtf(wave_sum(ss) * (1.f / DM) + EPS);
#pragma unroll
        for (int j = 0; j < 4; ++j) { const int c = (j * 64 + lane) * 4; const float4 g = *(const float4*)(p.norm_final + c);
            *(float4*)(p.out + (size_t)r * DM + c) = make_float4(v[j].x * rstd * g.x, v[j].y * rstd * g.y, v[j].z * rstd * g.z, v[j].w * rstd * g.w); }
    }
}

#define LAS __attribute__((address_space(3)))
typedef short bf16x8 __attribute__((ext_vector_type(8)));
typedef float f32x4 __attribute__((ext_vector_type(4)));
typedef float f32x2 __attribute__((ext_vector_type(2)));
typedef unsigned u32x4 __attribute__((ext_vector_type(4)));
typedef unsigned u32x2 __attribute__((ext_vector_type(2)));
typedef int v4i __attribute__((ext_vector_type(4)));
typedef int v8i __attribute__((ext_vector_type(8)));

constexpr int MK_THREADS = 512;
constexpr int RING_BYTES = 131072, MISC_OFF = RING_BYTES, MK_LDS = 147456;
constexpr int NIN_PAD = 5632;

namespace pg8 {
constexpr int BM = 256, BK = 64, HALF = 128, HTB = HALF * BK * 2, NXCD = 8, WGM = 8;
__host__ __device__ __forceinline__ int lds_byte(int r, int c) { const int st = (r >> 4) * 2 + (c >> 5), rr = r & 15, cc = c & 31, ob = rr * 64 + cc * 2; return st * 1024 + (ob ^ (((ob >> 9) & 1) << 5)); }
__host__ __device__ __forceinline__ void stage_rc(int b, int& R, int& C) { const int st = b / 1024, sb = b % 1024, swz = sb ^ (((sb >> 9) & 1) << 5); R = (st >> 1) * 16 + swz / 64; C = (st & 1) * 32 + (swz % 64) / 2; }
__host__ __device__ __forceinline__ int perm32(int rho) { const int n = rho >> 4, i = rho & 15; return 8 * (i >> 2) + 4 * n + (i & 3); }
__device__ __forceinline__ unsigned cvt_pk_bf16(float lo, float hi) { unsigned r; asm volatile("v_cvt_pk_bf16_f32 %0, %1, %2" : "=v"(r) : "v"(lo), "v"(hi)); return r; }

struct Unit { int pm, pn, e; const char* A; const char* B; };

struct StaticOrder {
    int nM, nN, nwg, G, c; const char* A; const char* Bt; size_t btile;
    __device__ void init(int M, int N, int K, int G_, int c_, const void* A_, const void* Bt_) { nM = M / BM; nN = N / BM; nwg = nM * nN; G = G_; c = c_; A = (const char*)A_; Bt = (const char*)Bt_; btile = (size_t)BM * K * 2; }
    __device__ bool next(int i, Unit& u) const {
        const long L = (long)i * G + c; if (L >= nwg) return false;
        int wgid = (int)L; { const int q = nwg / NXCD, r = nwg % NXCD, xcd = wgid % NXCD, off = wgid / NXCD; wgid = (xcd < r ? xcd * (q + 1) : r * (q + 1) + (xcd - r) * q) + off; }
        const int nig = WGM * nN, gid = wgid / nig, fm = gid * WGM, gsz = (nM - fm) < WGM ? (nM - fm) : WGM;
        u.pm = fm + ((wgid % nig) % gsz); u.pn = (wgid % nig) / gsz; u.e = 0; u.A = A; u.B = Bt + (size_t)u.pn * btile; return true;
    }
    __device__ __forceinline__ int arow(int r) const { return r; }
    __device__ __forceinline__ int arow_l(const volatile LAS int*, int r, int) const { return r; }
    __device__ __forceinline__ const int* rows_src(const Unit&, int) const { return nullptr; }
    static constexpr bool HAS_BIAS = false;
    __device__ __forceinline__ const float* bias_src(const Unit&, int) const { return nullptr; }
};
template <int NN> struct StaticOrderN {
    static constexpr int nM = NT / BM, nwg = nM * NN, nig = WGM * NN;
    static_assert(nM % WGM == 0, "row groups are full");
    int G, c; const char* A; const char* Bt; size_t btile;
    __device__ void init(int K, int G_, int c_, const void* A_, const void* Bt_) { G = G_; c = c_; A = (const char*)A_; Bt = (const char*)Bt_; btile = (size_t)BM * K * 2; }
    __device__ bool next(int i, Unit& u) const {
        const int L = i * G + c; if (L >= nwg) return false;
        constexpr int q = nwg / NXCD, r = nwg % NXCD; const int xcd = L & (NXCD - 1), off = L >> 3;
        const int wgid = (xcd < r ? xcd * (q + 1) : r * (q + 1) + (xcd - r) * q) + off;
        const int gid = wgid / nig, rem = wgid - gid * nig;
        u.pm = gid * WGM + (rem & (WGM - 1)); u.pn = rem >> 3; u.e = 0; u.A = A; u.B = Bt + (size_t)u.pn * btile; return true;
    }
    __device__ __forceinline__ int arow(int r) const { return r; }
    __device__ __forceinline__ int arow_l(const volatile LAS int*, int r, int) const { return r; }
    __device__ __forceinline__ const int* rows_src(const Unit&, int) const { return nullptr; }
    static constexpr bool HAS_BIAS = false;
    __device__ __forceinline__ const float* bias_src(const Unit&, int) const { return nullptr; }
};
struct MoeOrder {
    const volatile LAS int* tstart;
    int npn, G, c; const char* A; const char* W; size_t wexp, btile; const int* rowidx;
    const float* bias; int bsplit;
    __device__ bool next(int i, Unit& u) const {
        const long L = (long)i * G + c; const int ntile = tstart[NEXP]; if (L >= (long)ntile * npn) return false;
        const int mt = (int)(L / npn), pn = (int)(L % npn);
        const int k = (int)(threadIdx.x & 31u); const int tv = tstart[k];
        const int e = __builtin_popcount((unsigned)__ballot(k >= 1 && tv <= mt));
        u.pm = mt; u.pn = pn; u.e = e; u.A = A; u.B = W + (size_t)e * wexp + (size_t)pn * btile; return true;
    }
    __device__ __forceinline__ int arow(int r) const { if (!rowidx) return r; const int t = rowidx[r]; return t < 0 ? 0 : t; }
    __device__ __forceinline__ int arow_l(const volatile LAS int* tab, int r, int rl) const { if (!rowidx) return r; const int t = tab[rl]; return t < 0 ? 0 : t; }
    __device__ __forceinline__ const int* rows_src(const Unit& u, int lane) const { return rowidx ? rowidx + (size_t)u.pm * BM + lane * 4 : nullptr; }
    static constexpr bool HAS_BIAS = true;
    __device__ __forceinline__ const float* bias_src(const Unit& u, int lane) const {
        return bsplit ? bias + (size_t)u.e * 2048 + (lane >> 5) * 1024 + u.pn * 128 + (lane & 31) * 4 : bias + (size_t)u.e * 1024 + u.pn * 256 + lane * 4; }
};

template <class Epi, class Sched, bool F8 = false>
__device__ __forceinline__ void gemm_phase(LAS unsigned char* lds, const int K, const int lda, const Sched& S, const Epi& E) {
    const int tid = threadIdx.x, wid = __builtin_amdgcn_readfirstlane(tid >> 6), lane = tid & 63, wr = wid >> 2, wc = wid & 3, fr = lane & 15, fq = lane >> 4;
    const int nt = K / BK;
    unsigned voffB[2];
#pragma unroll
    for (int i = 0; i < 2; ++i) { int R, C; stage_rc(tid * 16 + i * 8192, R, C); const int Rb = Epi::PERM ? ((R & ~31) + perm32(R & 31)) : R; voffB[i] = (unsigned)(Rb * K + C) * 2u; }
    const size_t kstep = (size_t)(BK * 2);
    const size_t hstepB = (size_t)HALF * K * 2;
    const unsigned ldsw = (unsigned)wid * 1024u;
    const int aoff = lds_byte(wr * 64 + fr, fq * 8), boff = lds_byte(wc * 32 + fr, fq * 8);
#define PG8_SA(b, h) (((b) * 2 + (h)) * HTB)
#define PG8_SB(b, h) ((4 + (b) * 2 + (h)) * HTB)
#define PG8_STAGE(bufoff, gbase, voff) do { _Pragma("unroll") for (int _i = 0; _i < 2; ++_i) \
        __builtin_amdgcn_global_load_lds((const unsigned*)((const char*)(gbase) + (voff)[_i]), (LAS unsigned*)(lds + (bufoff) + ldsw + _i * 8192), 16, 0, 0); } while (0)
#define PG8_STAGE_B(bufoff, gbase) do { if constexpr (F8) { const u32x2 vo_ = *(const LAS u32x2*)vslot; const unsigned vv_[2] = {vo_[0], vo_[1]}; PG8_STAGE(bufoff, gbase, vv_); } else PG8_STAGE(bufoff, gbase, voffB); } while (0)
#define PG8_STAGE_A(bufoff, gbase, h) do { if constexpr (F8) { const u32x2 vo_ = *(const LAS u32x2*)(vslot + 2 + 2 * (h)); const unsigned vv_[2] = {vo_[0], vo_[1]}; PG8_STAGE(bufoff, gbase, vv_); } else PG8_STAGE(bufoff, gbase, vc[h]); } while (0)
#define PG8_LDA(dst, b, h) do { _Pragma("unroll") for (int m = 0; m < 4; ++m) _Pragma("unroll") for (int k = 0; k < 2; ++k) dst[m][k] = *(const LAS bf16x8*)(lds + PG8_SA(b, h) + aoff + m * 2048 + k * 1024); } while (0)
#define PG8_LDB(dst, b, h) do { _Pragma("unroll") for (int n = 0; n < 2; ++n) _Pragma("unroll") for (int k = 0; k < 2; ++k) dst[n][k] = *(const LAS bf16x8*)(lds + PG8_SB(b, h) + boff + n * 2048 + k * 1024); } while (0)
#define PG8_MMA(ai, bj, At, Bt) do { __builtin_amdgcn_s_setprio(1); _Pragma("unroll") for (int m = 0; m < 4; ++m) _Pragma("unroll") for (int n = 0; n < 2; ++n) _Pragma("unroll") for (int k = 0; k < 2; ++k) \
        acc[ai][bj][m][n] = __builtin_amdgcn_mfma_f32_16x16x32_bf16(Bt[n][k], At[m][k], acc[ai][bj][m][n], 0, 0, 0); __builtin_amdgcn_s_setprio(0); } while (0)
#define PG8_LDA8(dst, b, h) do { _Pragma("unroll") for (int m = 0; m < 4; ++m) dst[m] = __builtin_shufflevector(*(const LAS v4i*)(lds + PG8_SA(b, h) + aoff + m * 2048), *(const LAS v4i*)(lds + PG8_SA(b, h) + aoff + m * 2048 + 1024), 0, 1, 2, 3, 4, 5, 6, 7); } while (0)
#define PG8_LDB8(dst, b, h) do { _Pragma("unroll") for (int n = 0; n < 2; ++n) dst[n] = __builtin_shufflevector(*(const LAS v4i*)(lds + PG8_SB(b, h) + boff + n * 2048), *(const LAS v4i*)(lds + PG8_SB(b, h) + boff + n * 2048 + 1024), 0, 1, 2, 3, 4, 5, 6, 7); } while (0)
#define PG8_MMA8(ai, bj, At, Bt) do { __builtin_amdgcn_s_setprio(1); _Pragma("unroll") for (int m = 0; m < 4; ++m) _Pragma("unroll") for (int n = 0; n < 2; ++n) \
        acc[ai][bj][m][n] = __builtin_amdgcn_mfma_scale_f32_16x16x128_f8f6f4(Bt[n], At[m], acc[ai][bj][m][n], 0, 0, 0, 122, 0, 127); __builtin_amdgcn_s_setprio(0); } while (0)
#define PG8_XLDA(b, h) do { if constexpr (F8) PG8_LDA8(At8, b, h); else PG8_LDA(At, b, h); } while (0)
#define PG8_XLDB0(b, h) do { if constexpr (F8) PG8_LDB8(B08, b, h); else PG8_LDB(B0, b, h); } while (0)
#define PG8_XLDB1(b, h) do { if constexpr (F8) PG8_LDB8(B18, b, h); else PG8_LDB(B1, b, h); } while (0)
#define PG8_XMM0(ai, bj) do { if constexpr (F8) PG8_MMA8(ai, bj, At8, B08); else PG8_MMA(ai, bj, At, B0); } while (0)
#define PG8_XMM1(ai, bj) do { if constexpr (F8) PG8_MMA8(ai, bj, At8, B18); else PG8_MMA(ai, bj, At, B1); } while (0)
#define PG8_WAIT_V(n) asm volatile("s_waitcnt vmcnt(" #n ")" ::: "memory")
#define PG8_WAIT_L(n) asm volatile("s_waitcnt lgkmcnt(" #n ")" ::: "memory")
#define PG8_BAR __builtin_amdgcn_s_barrier()
#define PG8_SCHED __builtin_amdgcn_sched_barrier(0)
#define PG8_VOFFL(dst, u) do { int _tt = tid; asm volatile("" : "+v"(_tt)); _Pragma("unroll") for (int _i = 0; _i < 2; ++_i) { int _R, _C; stage_rc(_tt * 16 + _i * 8192, _R, _C); \
        _Pragma("unroll") for (int _h = 0; _h < 2; ++_h) dst[_h][_i] = (unsigned)(S.arow_l(rowtab, (u).pm * BM + _h * HALF + _R, _h * HALF + _R) * lda + _C) * 2u; } } while (0)
#define PG8_VOFF(dst, u) do { int _tt = tid; asm volatile("" : "+v"(_tt)); _Pragma("unroll") for (int _i = 0; _i < 2; ++_i) { int _R, _C; stage_rc(_tt * 16 + _i * 8192, _R, _C); \
        _Pragma("unroll") for (int _h = 0; _h < 2; ++_h) dst[_h][_i] = (unsigned)(S.arow((u).pm * BM + _h * HALF + _R) * lda + _C) * 2u; } } while (0)
    constexpr bool HB = Sched::HAS_BIAS;
    LAS float* bias_l = (LAS float*)(lds + MISC_OFF + 13312);
    volatile LAS int* rowtab = (volatile LAS int*)(lds + MISC_OFF + 14336);
#define PG8_ROWS(u) do { if constexpr (HB) { const int* rs_ = S.rows_src(u, lane); if (wid == 0 && rs_) __builtin_amdgcn_global_load_lds((const unsigned*)rs_, (LAS unsigned*)(lds + MISC_OFF + 14336), 16, 0, 0); } } while (0)
#define PG8_BIAS(u) do { if constexpr (HB) { if (wid == 0) __builtin_amdgcn_global_load_lds((const unsigned*)S.bias_src(u, lane), (LAS unsigned*)bias_l, 16, 0, 0); } } while (0)
#define PG8_ACC_INIT() do { f32x4 bv_[2][2]; _Pragma("unroll") for (int b = 0; b < 2; ++b) _Pragma("unroll") for (int n = 0; n < 2; ++n) { \
        if constexpr (HB) bv_[b][n] = *(const LAS f32x4*)(bias_l + b * 128 + wc * 32 + 8 * fq + 4 * n); else bv_[b][n] = (f32x4){0.f, 0.f, 0.f, 0.f}; } \
        _Pragma("unroll") for (int a = 0; a < 2; ++a) _Pragma("unroll") for (int b = 0; b < 2; ++b) _Pragma("unroll") for (int m = 0; m < 4; ++m) _Pragma("unroll") for (int n = 0; n < 2; ++n) acc[a][b][m][n] = bv_[b][n]; } while (0)
    Unit cur, nxt; int ui = 0;
    if (!S.next(0, cur)) return;
    f32x4 acc[2][2][4][2];
    bf16x8 At[4][2], B0[2][2], B1[2][2]; v8i At8[4], B08[2], B18[2];
    unsigned vc[2][2], vn[2][2];
    LAS unsigned* vslot = (LAS unsigned*)(lds + MISC_OFF + 1024) + tid * 6;
    PG8_VOFF(vc, cur);
    if constexpr (F8) { vslot[0] = voffB[0]; vslot[1] = voffB[1]; vslot[2] = vc[0][0]; vslot[3] = vc[0][1]; vslot[4] = vc[1][0]; vslot[5] = vc[1][1]; }
    const char* cA = cur.A; const char* cB = cur.B;
    PG8_BIAS(cur);
    PG8_STAGE_B(PG8_SB(0, 0), cB); PG8_STAGE_B(PG8_SB(0, 1), cB + hstepB); PG8_STAGE_A(PG8_SA(0, 0), cA, 0); PG8_STAGE_A(PG8_SA(0, 1), cA, 1);
    if (wr == 1) PG8_BAR;
    PG8_WAIT_V(2); PG8_BAR;
    PG8_STAGE_B(PG8_SB(1, 0), cB + kstep); PG8_STAGE_A(PG8_SA(1, 0), cA + kstep, 0); PG8_STAGE_B(PG8_SB(1, 1), cB + hstepB + kstep);
    PG8_WAIT_V(6); PG8_BAR;
    PG8_ACC_INIT();
    for (;;) {
        const bool has_next = S.next(ui + 1, nxt);
        const char* nA = has_next ? nxt.A : cA; const char* nB = has_next ? nxt.B : cB;
#pragma unroll 1
        for (int t = 0; t < nt; t += 2) {
            const bool last = (t == nt - 2);
            const char* a1 = cA + (size_t)(t + 1) * kstep;
            const char* a2 = last ? nA : cA + (size_t)(t + 2) * kstep; const char* b2 = last ? nB : cB + (size_t)(t + 2) * kstep;
            const char* a3 = a2 + kstep; const char* b3 = b2 + kstep;
            if constexpr (HB) { if (t == nt - 4 && has_next) PG8_ROWS(nxt); }
            if (last && has_next) { if constexpr (HB) { PG8_VOFFL(vn, nxt); } else { PG8_VOFF(vn, nxt); } PG8_BIAS(nxt); }
            PG8_XLDB0(0, 0); PG8_XLDB1(0, 1); PG8_SCHED; PG8_XLDA(0, 0); PG8_STAGE_A(PG8_SA(1, 1), a1, 1);
            PG8_WAIT_V(8); PG8_WAIT_L(0); PG8_BAR; PG8_XMM0(0, 0); PG8_XMM1(0, 1); PG8_BAR; PG8_SCHED;
            if (last && has_next) {
                if constexpr (F8) { vslot[2] = vn[0][0]; vslot[3] = vn[0][1]; vslot[4] = vn[1][0]; vslot[5] = vn[1][1]; }
                else {
#pragma unroll
                for (int h = 0; h < 2; ++h)
#pragma unroll
                    for (int i = 0; i < 2; ++i) vc[h][i] = vn[h][i];
                }
            }
            PG8_XLDA(0, 1); PG8_STAGE_B(PG8_SB(0, 0), b2); PG8_STAGE_B(PG8_SB(0, 1), b2 + hstepB); PG8_STAGE_A(PG8_SA(0, 0), a2, 0);
            PG8_WAIT_V(8); PG8_WAIT_L(0); PG8_BAR; PG8_XMM0(1, 0); PG8_XMM1(1, 1); PG8_BAR; PG8_SCHED;
            PG8_XLDB0(1, 0); PG8_XLDB1(1, 1); PG8_SCHED; PG8_XLDA(1, 0); PG8_STAGE_A(PG8_SA(0, 1), a2, 1);
            PG8_WAIT_V(8); PG8_WAIT_L(0); PG8_BAR; PG8_XMM0(0, 0); PG8_XMM1(0, 1); PG8_BAR; PG8_SCHED;
            PG8_XLDA(1, 1); PG8_STAGE_B(PG8_SB(1, 0), b3); PG8_STAGE_B(PG8_SB(1, 1), b3 + hstepB); PG8_STAGE_A(PG8_SA(1, 0), a3, 0);
            PG8_WAIT_V(8); PG8_WAIT_L(0); PG8_BAR; PG8_XMM0(1, 0); PG8_XMM1(1, 1); PG8_BAR; PG8_SCHED;
        }
        if (wr == 0) PG8_BAR;
        E(acc, cur, wr, wc, fr, fq);
        if (!has_next) break;
        PG8_ACC_INIT();
        cur = nxt; cA = nA; cB = nB; ++ui;
        if (wr == 1) PG8_BAR;
    }
    PG8_WAIT_V(0);
    PG8_BAR;
#undef PG8_SA
#undef PG8_SB
#undef PG8_STAGE
#undef PG8_STAGE_A
#undef PG8_STAGE_B
#undef PG8_LDA
#undef PG8_LDB
#undef PG8_MMA
#undef PG8_MMA8
#undef PG8_LDA8
#undef PG8_LDB8
#undef PG8_XLDA
#undef PG8_XLDB0
#undef PG8_XLDB1
#undef PG8_XMM0
#undef PG8_XMM1
#undef PG8_WAIT_V
#undef PG8_WAIT_L
#undef PG8_BAR
#undef PG8_SCHED
#undef PG8_VOFF
#undef PG8_VOFFL
#undef PG8_ROWS
#undef PG8_BIAS
#undef PG8_ACC_INIT
}
}

__device__ __forceinline__ unsigned pk4_fp8(float a, float b, float c, float d) { int p = 0; p = __builtin_amdgcn_cvt_pk_fp8_f32(a, b, p, false); p = __builtin_amdgcn_cvt_pk_fp8_f32(c, d, p, true); return (unsigned)p; }
constexpr float YB_SCALE = 8.f;
constexpr float W8_SCALE = 32.f;
__device__ __forceinline__ void st8_bf16(bf16_t* dst, const f32x4 v0, const f32x4 v1) {
    u32x4 w; w.x = pg8::cvt_pk_bf16(v0[0], v0[1]); w.y = pg8::cvt_pk_bf16(v0[2], v0[3]); w.z = pg8::cvt_pk_bf16(v1[0], v1[1]); w.w = pg8::cvt_pk_bf16(v1[2], v1[3]);
    *(u32x4*)dst = w;
}
__device__ __forceinline__ void ld8_bf16(const bf16_t* src, f32x4& v0, f32x4& v1) {
    const u32x4 w = *(const u32x4*)src;
    v0 = (f32x4){__uint_as_float(w.x << 16), __uint_as_float(w.x & 0xffff0000u), __uint_as_float(w.y << 16), __uint_as_float(w.y & 0xffff0000u)};
    v1 = (f32x4){__uint_as_float(w.z << 16), __uint_as_float(w.z & 0xffff0000u), __uint_as_float(w.w << 16), __uint_as_float(w.w & 0xffff0000u)};
}
__device__ __forceinline__ f32x4 sig4(f32x4 v) {
    f32x4 e = v * -1.4426950408889634f;
#pragma unroll
    for (int j = 0; j < 4; ++j) e[j] = __builtin_amdgcn_exp2f(e[j]);
    e = e + 1.f;
#pragma unroll
    for (int j = 0; j < 4; ++j) e[j] = __builtin_amdgcn_rcpf(e[j]);
    return e;
}

template <int PART> struct EpiIn {
    static constexpr bool PERM = true;
    Params p;
    __device__ __forceinline__ void operator()(const f32x4 (&acc)[2][2][4][2], const pg8::Unit& u, int wr, int wc, int fr, int fq) const {
        const int pn = u.pn; const size_t row0 = (size_t)u.pm * 256 + wr * 64 + fr; const int cl0 = wc * 32 + 8 * fq;
        if (PART == 1 || pn < 21) {
            bf16_t* base; int ld, c0; int mode;
            if (PART != 1 && pn < 2) { base = p.Qm(); ld = 512; c0 = pn * 256; mode = 1; }
            else if (PART != 1 && pn < 4) { base = p.Km(); ld = 512; c0 = (pn - 2) * 256; mode = 0; }
            else if (PART != 1 && pn < 8) { base = p.Vm(); ld = 1024; c0 = (pn - 4) * 256; mode = 0; }
            else if (PART != 0 && pn < 12) { base = p.OG(); ld = 1024; c0 = (pn - 8) * 256; mode = 2; }
            else if (PART != 0 && pn < 20) { base = p.GATE(); ld = 2048; c0 = (pn - 12) * 256; mode = 2; }
            else { base = nullptr; ld = 256; c0 = 0; mode = 3; }
#pragma unroll
            for (int ai = 0; ai < 2; ++ai)
#pragma unroll
                for (int m = 0; m < 4; ++m) { const size_t r = row0 + ai * 128 + m * 16;
#pragma unroll
                    for (int bj = 0; bj < 2; ++bj) { f32x4 v0 = acc[ai][bj][m][0], v1 = acc[ai][bj][m][1]; const int c = c0 + bj * 128 + cl0;
                        if (PART != 1 && mode == 3) { float* d = p.CQ() + r * 256 + c; *(f32x4*)d = v0; *(f32x4*)(d + 4) = v1; }
                        else { if (PART != 1 && mode == 1) { v0 = v0 * 0.125f; v1 = v1 * 0.125f; } else if (PART != 0 && mode == 2) { v0 = sig4(v0); v1 = sig4(v1); }
                               st8_bf16(base + r * ld + c, v0, v1); } } }
        } else if (PART != 1) {
#pragma unroll
            for (int ai = 0; ai < 2; ++ai)
#pragma unroll
                for (int m = 0; m < 4; ++m) { const size_t r = row0 + ai * 128 + m * 16;
                    { float* d = p.CKV() + r * 128 + cl0; *(f32x4*)d = acc[ai][0][m][0]; *(f32x4*)(d + 4) = acc[ai][0][m][1]; }
                    const f32x4 v0 = acc[ai][1][m][0], v1 = acc[ai][1][m][1];
                    if (wc < 2) { float* d = p.KR() + r * 64 + cl0; *(f32x4*)d = v0; *(f32x4*)(d + 4) = v1; }
                    else if (wc == 2) { const int g = 8 * (fq & 1);
                        if (fq < 2) { float* d = p.GI() + r * 16 + g; const f32x4 b0 = *(const f32x4*)(p.m_b_i + g), b1 = *(const f32x4*)(p.m_b_i + g + 4); *(f32x4*)d = v0 + b0; *(f32x4*)(d + 4) = v1 + b1; }
                        else { float* d = p.GF() + r * 16 + g; const f32x4 b0 = *(const f32x4*)(p.m_b_f + g), b1 = *(const f32x4*)(p.m_b_f + g + 4);
                            *(f32x4*)d = (f32x4){logsigmoidf_(v0[0] + b0[0]), logsigmoidf_(v0[1] + b0[1]), logsigmoidf_(v0[2] + b0[2]), logsigmoidf_(v0[3] + b0[3])};
                            *(f32x4*)(d + 4) = (f32x4){logsigmoidf_(v1[0] + b1[0]), logsigmoidf_(v1[1] + b1[1]), logsigmoidf_(v1[2] + b1[2]), logsigmoidf_(v1[3] + b1[3])}; } } }
        }
    }
};
template <int PART> struct EpiInP {
    static constexpr bool PERM = true;
    Params p;
    __device__ __forceinline__ void operator()(const f32x4 (&acc)[2][2][4][2], const pg8::Unit& u, int wr, int wc, int fr, int fq) const {
        pg8::Unit v = u; v.pn = PART == 0 ? (u.pn < 8 ? u.pn : u.pn + 12) : u.pn + 8;
        EpiIn<PART> E{p}; E(acc, v, wr, wc, fr, fq);
    }
};
struct EpiQ {
    static constexpr bool PERM = true;
    Params p;
    __device__ __forceinline__ void operator()(const f32x4 (&acc)[2][2][4][2], const pg8::Unit& u, int wr, int wc, int fr, int fq) const {
        const size_t row0 = (size_t)u.pm * 256 + wr * 64 + fr;
#pragma unroll
        for (int ai = 0; ai < 2; ++ai)
#pragma unroll
            for (int m = 0; m < 4; ++m) { const size_t r = row0 + ai * 128 + m * 16; const float rs = p.RSQ()[r] * QSCALE; const int pos = NMETA + (int)(r & (SEQ - 1));
#pragma unroll
                for (int bj = 0; bj < 2; ++bj) { const int c = u.pn * 256 + bj * 128 + wc * 32 + 8 * fq; const int local = c % 192;
                    f32x4 v0 = acc[ai][bj][m][0] * rs, v1 = acc[ai][bj][m][1] * rs;
                    if (local >= 128) { const int i0 = (local - 128) >> 1; const float* rp = p.ROPE() + ((size_t)pos * 32 + i0) * 2;
                        const f32x4 cs0 = *(const f32x4*)rp, cs1 = *(const f32x4*)(rp + 4);
                        const f32x4 o0 = (f32x4){v0[0] * cs0[0] - v0[1] * cs0[1], v0[0] * cs0[1] + v0[1] * cs0[0], v0[2] * cs0[2] - v0[3] * cs0[3], v0[2] * cs0[3] + v0[3] * cs0[2]};
                        const f32x4 o1 = (f32x4){v1[0] * cs1[0] - v1[1] * cs1[1], v1[0] * cs1[1] + v1[1] * cs1[0], v1[2] * cs1[2] - v1[3] * cs1[3], v1[2] * cs1[3] + v1[3] * cs1[2]};
                        v0 = o0; v1 = o1; }
                    st8_bf16(p.QP() + r * 1536 + c, v0, v1); }
                asm volatile("" ::: "memory"); }
    }
};
template <int PASS> struct EpiMix {
    static constexpr bool PERM = true;
    Params p;
    __device__ __forceinline__ void operator()(const f32x4 (&acc)[2][2][4][2], const pg8::Unit& u, int wr, int wc, int fr, int fq) const {
        const size_t row0 = (size_t)u.pm * 256 + wr * 64 + fr;
#pragma unroll
        for (int ai = 0; ai < 2; ++ai)
#pragma unroll
            for (int m = 0; m < 4; ++m) { const size_t r = row0 + ai * 128 + m * 16;
#pragma unroll
                for (int bj = 0; bj < 2; ++bj) { const int c = u.pn * 256 + bj * 128 + wc * 32 + 8 * fq;
                    f32x4 g0, g1; ld8_bf16(p.GATE() + r * 2048 + PASS * 1024 + c, g0, g1);
                    f32x4 v0 = acc[ai][bj][m][0] * g0, v1 = acc[ai][bj][m][1] * g1;
                    if (PASS == 1) { f32x4 m0, m1; ld8_bf16(p.MIX() + r * 1024 + c, m0, m1); v0 = v0 + m0; v1 = v1 + m1; }
                    st8_bf16(p.MIX() + r * 1024 + c, v0, v1); } }
    }
};
struct EpiOut {
    static constexpr bool PERM = true;
    Params p;
    __device__ __forceinline__ void operator()(const f32x4 (&acc)[2][2][4][2], const pg8::Unit& u, int wr, int wc, int fr, int fq) const {
        const size_t row0 = (size_t)u.pm * 256 + wr * 64 + fr;
#pragma unroll
        for (int ai = 0; ai < 2; ++ai)
#pragma unroll
            for (int m = 0; m < 4; ++m) { const size_t r = row0 + ai * 128 + m * 16;
#pragma unroll
                for (int bj = 0; bj < 2; ++bj) { const int c = u.pn * 256 + bj * 128 + wc * 32 + 8 * fq; const float* xs = p.x + r * DM + c;
                    const f32x4 x0 = __builtin_nontemporal_load((const f32x4*)xs), x1 = __builtin_nontemporal_load((const f32x4*)(xs + 4));
                    st8_bf16(p.H1() + r * DM + c, acc[ai][bj][m][0] + x0, acc[ai][bj][m][1] + x1); } }
    }
};
__device__ __forceinline__ f32x4 swiglu4(f32x4 g, f32x4 l) {
    f32x4 gg, ll, e;
#pragma unroll
    for (int j = 0; j < 4; ++j) { gg[j] = __builtin_amdgcn_fmed3f(g[j], -3.0e38f, 7.f); ll[j] = __builtin_amdgcn_fmed3f(l[j], -7.f, 7.f); }
    e = gg * (-1.702f * 1.4426950408889634f);
#pragma unroll
    for (int j = 0; j < 4; ++j) e[j] = __builtin_amdgcn_exp2f(e[j]);
    e = e + 1.f;
#pragma unroll
    for (int j = 0; j < 4; ++j) e[j] = __builtin_amdgcn_rcpf(e[j]);
    const f32x4 t = gg * e;
    return t * ll + t;
}
struct EpiM1 {
    static constexpr bool PERM = true;
    Params p;
    __device__ __forceinline__ void operator()(const f32x4 (&acc)[2][2][4][2], const pg8::Unit& u, int wr, int wc, int fr, int fq) const {
        const size_t row0 = (size_t)u.pm * 256 + wr * 64 + fr; const int c = u.pn * 128 + wc * 32 + 8 * fq;
#pragma unroll
        for (int ai = 0; ai < 2; ++ai)
#pragma unroll
            for (int m = 0; m < 4; ++m) { const size_t r = row0 + ai * 128 + m * 16;
                const f32x4 a0 = swiglu4(acc[ai][0][m][0], acc[ai][1][m][0]), a1 = swiglu4(acc[ai][0][m][1], acc[ai][1][m][1]);
                u32x2 o8; o8.x = pk4_fp8(a0[0], a0[1], a0[2], a0[3]); o8.y = pk4_fp8(a1[0], a1[1], a1[2], a1[3]); *(u32x2*)((unsigned char*)p.ACT() + r * DFF + c) = o8; }
    }
};
struct EpiM2 {
    static constexpr bool PERM = true;
    Params p;
    __device__ __forceinline__ void operator()(const f32x4 (&acc)[2][2][4][2], const pg8::Unit& u, int wr, int wc, int fr, int fq) const {
        const size_t row0 = (size_t)u.pm * 256 + wr * 64 + fr;
#pragma unroll
        for (int bj = 0; bj < 2; ++bj) { const int c = u.pn * 256 + bj * 128 + wc * 32 + 8 * fq;
#pragma unroll
            for (int ai = 0; ai < 2; ++ai)
#pragma unroll
                for (int m = 0; m < 4; ++m) { const size_t r = row0 + ai * 128 + m * 16; const f32x4 v0 = acc[ai][bj][m][0] * YB_SCALE, v1 = acc[ai][bj][m][1] * YB_SCALE;
                    u32x2 o8; o8.x = pk4_fp8(v0[0], v0[1], v0[2], v0[3]); o8.y = pk4_fp8(v1[0], v1[1], v1[2], v1[3]); *(u32x2*)((unsigned char*)p.YB() + r * DM + c) = o8; } }
    }
};

__device__ __forceinline__ float4 ntld4(const float* p) { const f32x4 v = __builtin_nontemporal_load((const f32x4*)p); return make_float4(v[0], v[1], v[2], v[3]); }
__device__ __forceinline__ uint2 ntld2u(const bf16_t* p) { const u32x2 v = __builtin_nontemporal_load((const u32x2*)p); return make_uint2(v[0], v[1]); }
__device__ __forceinline__ float4 ntld_h1(const bf16_t* p) { const uint2 u = ntld2u(p); return make_float4(__uint_as_float(u.x << 16), __uint_as_float(u.x & 0xffff0000u), __uint_as_float(u.y << 16), __uint_as_float(u.y & 0xffff0000u)); }
__device__ __forceinline__ unsigned pk2(float lo, float hi) { return (unsigned)f2bf(lo) | ((unsigned)f2bf(hi) << 16); }
struct TrDesc { const float* W; bf16_t* WT; int ldw, K, dr0, sc0, nvalid, k0, f8; };
__device__ __forceinline__ void tr_load(const TrDesc& d, float4 (&v)[16], int lane) {
    const int lr = lane >> 4, lc = (lane & 15) * 4;
#pragma unroll
    for (int i = 0; i < 16; ++i) v[i] = (lc < d.nvalid) ? ntld4(d.W + (size_t)(d.k0 + i * 4 + lr) * d.ldw + d.sc0 + lc) : make_float4(0.f, 0.f, 0.f, 0.f);
}
__device__ __forceinline__ void tr_finish(const TrDesc& d, const float4 (&v)[16], LAS float* scr, int lane) {
    const int lr = lane >> 4, lc = (lane & 15) * 4;
#pragma unroll
    for (int i = 0; i < 16; ++i) { LAS float* q = scr + (i * 4 + lr) * 65 + lc; q[0] = v[i].x; q[1] = v[i].y; q[2] = v[i].z; q[3] = v[i].w; }
    asm volatile("s_waitcnt lgkmcnt(0)" ::: "memory");
    const int c = lane & 7;
    if (d.f8) {
#pragma unroll
        for (int j = 0; j < 8; ++j) { const int n = (lane >> 3) + 8 * j; const LAS float* s = scr + (8 * c) * 65 + n;
            u32x2 o; o.x = pk4_fp8(s[0 * 65] * W8_SCALE, s[1 * 65] * W8_SCALE, s[2 * 65] * W8_SCALE, s[3 * 65] * W8_SCALE); o.y = pk4_fp8(s[4 * 65] * W8_SCALE, s[5 * 65] * W8_SCALE, s[6 * 65] * W8_SCALE, s[7 * 65] * W8_SCALE);
            *(u32x2*)((unsigned char*)d.WT + (size_t)(d.dr0 + n) * d.K + d.k0 + 8 * c) = o; }
    } else {
#pragma unroll
    for (int j = 0; j < 8; ++j) { const int n = (lane >> 3) + 8 * j; const LAS float* s = scr + (8 * c) * 65 + n;
        u32x4 o; o.x = pk2(s[0 * 65], s[1 * 65]); o.y = pk2(s[2 * 65], s[3 * 65]); o.z = pk2(s[4 * 65], s[5 * 65]); o.w = pk2(s[6 * 65], s[7 * 65]);
        *(u32x4*)(d.WT + (size_t)(d.dr0 + n) * d.K + d.k0 + 8 * c) = o; }
    }
    asm volatile("s_waitcnt lgkmcnt(0)" ::: "memory");
}
__device__ __forceinline__ int win_src_col(int np, int& nvalid) {
    nvalid = 64;
    if (np < 3072) return np;
    if (np < 5120) return OFF_G + (np - 3072);
    if (np < 5376) return OFF_CQ + (np - 5120);
    if (np < 5504) return OFF_CKV + (np - 5376);
    if (np < 5568) return OFF_KR + (np - 5504);
    nvalid = 32; return OFF_I;
}

__device__ __forceinline__ void phase_prologue(const Params& p, LAS unsigned char* lds, int vcu, int G, int sub) {
#define SUBP(x) (sub == 0 || sub == (x))
    const int tid = threadIdx.x, lane = tid & 63, wave = tid >> 6;
    const int gw = vcu * 8 + wave, NGW = G * 8;
    LAS float* scr = (LAS float*)(lds + wave * 16640);
    if (SUBP(1)) for (int it = vcu; it < 88; it += G) {
        LAS float* um = (LAS float*)lds;
        LAS float* red = (LAS float*)(lds + 65536);
        __syncthreads();
        for (int j = wave * 2; j < wave * 2 + 2; ++j) {
            const float* src = p.meta + (size_t)j * DM; float4 v[4]; float ss = 0.f;
#pragma unroll
            for (int q = 0; q < 4; ++q) { v[q] = *(const float4*)(src + (q * 64 + lane) * 4); ss += v[q].x * v[q].x + v[q].y * v[q].y + v[q].z * v[q].z + v[q].w * v[q].w; }
            const float rstd = rsqrtf(wave_sum(ss) * (1.f / DM) + EPS);
#pragma unroll
            for (int q = 0; q < 4; ++q) { const int c = (q * 64 + lane) * 4; const float4 g = *(const float4*)(p.norm_mix + c);
                um[j * 1024 + c] = v[q].x * rstd * g.x; um[j * 1024 + c + 1] = v[q].y * rstd * g.y; um[j * 1024 + c + 2] = v[q].z * rstd * g.z; um[j * 1024 + c + 3] = v[q].w * rstd * g.w; }
        }
        __syncthreads();
        const int n = it * 64 + lane; const bool okn = n < DIN;
        float a[16];
#pragma unroll
        for (int j = 0; j < 16; ++j) a[j] = 0.f;
#pragma unroll 8
        for (int kk = 0; kk < 128; ++kk) { const int kq = wave * 128 + kk; const float w = okn ? p.w_in[(size_t)kq * DIN + n] : 0.f;
#pragma unroll
            for (int j = 0; j < 16; ++j) a[j] += um[j * 1024 + kq] * w; }
#pragma unroll
        for (int j = 0; j < 16; ++j) red[(wave * 16 + j) * 64 + lane] = a[j];
        __syncthreads();
        for (int o = tid; o < 1024; o += MK_THREADS) { const int j = o >> 6, nl = o & 63; float s = 0.f;
#pragma unroll
            for (int w8 = 0; w8 < 8; ++w8) s += red[(w8 * 16 + j) * 64 + nl];
            if (it * 64 + nl < DIN) p.ZM()[(size_t)j * DIN + it * 64 + nl] = s; }
        __syncthreads();
    }
    constexpr int I_INA = 16 * 40, I_INB = 16 * 48, I_IN = I_INA + I_INB, I_W1 = NEXP * 16 * 32, I_W2 = NEXP * 16 * 16, I_SQ = 16 * 16;
    constexpr int NITEMS = I_IN + I_W1 + I_W2 + 2 * I_SQ;
    auto decode = [&](int it, TrDesc& d) {
        int r = it;
        if (r < I_INA) { const int kb = r / 40, nb = r % 40, np = nb * 64, nl = np < 2048 ? np : np + 3072; int nv; const int sc = win_src_col(nl, nv); d = TrDesc{p.w_in, p.WinT(), DIN, DM, np, sc, nv, kb * 64, 0}; return; } r -= I_INA;
        if (r < I_INB) { const int kb = r / 48, nb = r % 48, np = nb * 64; int nv; const int sc = win_src_col(2048 + np, nv); d = TrDesc{p.w_in, (bf16_t*)p.WinT8(), DIN, DM, np, sc, nv, kb * 64, 1}; return; } r -= I_INB;
        if (r < I_W1) { const int e = r / 512, q = r % 512, kb = q / 32, nb = q % 32, np = nb * 64, pn = np >> 8, bj = (np >> 7) & 1, j = np & 127;
            d = TrDesc{p.w1 + (size_t)e * DM * 2048, (bf16_t*)((unsigned char*)p.W1T() + (size_t)e * 2048 * DM), 2048, DM, np, 1024 * bj + 128 * pn + j, 64, kb * 64, 1}; return; } r -= I_W1;
        if (r < I_W2) { const int e = r / 256, q = r % 256, kb = q / 16, nb = q % 16; d = TrDesc{p.w2 + (size_t)e * DFF * DM, (bf16_t*)((unsigned char*)p.W2T() + (size_t)e * DM * DFF), DM, DFF, nb * 64, nb * 64, 64, kb * 64, 1}; return; } r -= I_W2;
        if (r < I_SQ) { const int kb = r / 16, nb = r % 16; d = TrDesc{p.w_m_proj, p.WmT(), DM, DM, nb * 64, nb * 64, 64, kb * 64, 0}; return; } r -= I_SQ;
        { const int kb = r / 16, nb = r % 16; d = TrDesc{p.w_out, p.WoutT(), DM, DM, nb * 64, nb * 64, 64, kb * 64, 0}; }
    };
    if (SUBP(2)) {
        float4 va[16], vb[16]; TrDesc da, db; int it = gw;
        if (it < NITEMS) { decode(it, da); tr_load(da, va, lane); }
#pragma unroll 1
        while (it < NITEMS) {
            const int it1 = it + NGW; if (it1 < NITEMS) { decode(it1, db); tr_load(db, vb, lane); }
            tr_finish(da, va, scr, lane);
            if (it1 >= NITEMS) break;
            const int it2 = it1 + NGW; if (it2 < NITEMS) { decode(it2, da); tr_load(da, va, lane); }
            tr_finish(db, vb, scr, lane);
            it = it2;
        }
    }
    if (SUBP(3)) for (int r = gw * 4; r < NT; r += NGW * 4) {
        const float* s0 = p.x + (size_t)r * DM; float4 v[16];
#pragma unroll
        for (int q = 0; q < 4; ++q)
#pragma unroll
            for (int j = 0; j < 4; ++j) v[q * 4 + j] = ntld4(s0 + (size_t)q * DM + (j * 64 + lane) * 4);
        float rs[4];
#pragma unroll
        for (int q = 0; q < 4; ++q) { float s = 0.f;
#pragma unroll
            for (int j = 0; j < 4; ++j) { const float4 t = v[q * 4 + j]; s += t.x * t.x + t.y * t.y + t.z * t.z + t.w * t.w; }
            rs[q] = rsqrtf(wave_sum(s) * (1.f / DM) + EPS); }
#pragma unroll
        for (int j = 0; j < 4; ++j) { const int c = (j * 64 + lane) * 4; const float4 g = *(const float4*)(p.norm_mix + c);
#pragma unroll
            for (int q = 0; q < 4; ++q) { const float4 t = v[q * 4 + j]; const float rr = rs[q];
                const float u0 = t.x * rr * g.x, u1 = t.y * rr * g.y, u2 = t.z * rr * g.z, u3 = t.w * rr * g.w;
                u32x2 o; o.x = pk2(u0, u1); o.y = pk2(u2, u3); *(u32x2*)(p.U() + (size_t)(r + q) * DM + c) = o;
                *(unsigned*)(p.U8() + (size_t)(r + q) * DM + c) = pk4_fp8(u0, u1, u2, u3); } }
    }
    const long gid = (long)vcu * MK_THREADS + tid, gn = (long)G * MK_THREADS;
    if (SUBP(4)) for (long i = gid; i < (long)LTOT * 32; i += gn) {
        const int pos = (int)(i >> 5), f = (int)(i & 31);
        const float freq = powf(10000.f, -(float)f / 32.f), ang = (float)pos * freq; float s, c; sincosf(ang, &s, &c);
        p.ROPE()[i * 2] = c; p.ROPE()[i * 2 + 1] = s;
    }
    const int rot_wo = (vcu + 40) & 255;
    if (SUBP(5)) for (long i = (long)rot_wo * MK_THREADS + tid; i < 8L * 8 * 1024; i += gn) {
        const int n = (int)(i & 1023), hcg = __builtin_amdgcn_readfirstlane((int)(i >> 10)), h = hcg >> 3, c0 = (hcg & 7) * 16;
        const float* ap = p.w_a_proj + (size_t)(h * 128) * DM + n; const float* kv = p.a_w_ukv + ((size_t)c0 * 8 + h) * 256 + 128;
        float acc[16];
#pragma unroll
        for (int q = 0; q < 16; ++q) acc[q] = 0.f;
#pragma unroll 4
        for (int d = 0; d < 128; ++d) { const float b = ap[(size_t)d * DM];
#pragma unroll
            for (int q = 0; q < 16; ++q) acc[q] += kv[(size_t)q * 2048 + d] * b; }
        u32x4 o0, o1; o0.x = pk2(acc[0], acc[1]); o0.y = pk2(acc[2], acc[3]); o0.z = pk2(acc[4], acc[5]); o0.w = pk2(acc[6], acc[7]);
        o1.x = pk2(acc[8], acc[9]); o1.y = pk2(acc[10], acc[11]); o1.z = pk2(acc[12], acc[13]); o1.w = pk2(acc[14], acc[15]);
        bf16_t* dst = p.WoT() + (size_t)n * 1024 + h * 128 + c0; *(u32x4*)dst = o0; *(u32x4*)(dst + 8) = o1;
    }
    if (SUBP(6)) for (int t = ((vcu + 168) & 255) * 8 + wave; t < 8 * 128; t += NGW) {
        const int h = t >> 7, c = t & 127; const float2 kvv = *(const float2*)(p.a_w_ukv + ((size_t)c * 8 + h) * 256 + 2 * lane);
#pragma unroll 1
        for (int r0 = 0; r0 < 256; r0 += 64) { float keep = 0.f;
#pragma unroll 8
            for (int rr = 0; rr < 64; ++rr) { const float2 u = *(const float2*)(p.a_w_uq + ((size_t)(r0 + rr) * 8 + h) * 192 + 2 * lane);
                const float s = wave_sum(u.x * kvv.x + u.y * kvv.y); if (lane == rr) keep = s; }
            p.WqT()[(size_t)(h * 192 + c) * 256 + r0 + lane] = f2bf(keep * p.a_norm_q[r0 + lane]); }
    }
    if (SUBP(6)) for (long i = gid; i < 8L * 64 * 256; i += gn) {
        const int r = (int)(i & 255), hq = (int)(i >> 8), h = hq >> 6, q = hq & 63;
        p.WqT()[(size_t)(h * 192 + 128 + q) * 256 + r] = f2bf(p.a_w_uq[((size_t)r * 8 + h) * 192 + 128 + (q >> 1) + 32 * (q & 1)] * p.a_norm_q[r]);
    }
}

#undef SUBP
__device__ __forceinline__ void phase_kprep(const Params& p, int vcu, int G) {
    const int lane = threadIdx.x & 63, gw = vcu * 8 + (threadIdx.x >> 6), NGW = G * 8;
    const float gk0 = p.a_norm_kv[lane], gk1 = p.a_norm_kv[64 + lane];
    for (int r0 = gw * 4; r0 < NT; r0 += NGW * 4) {
        float c0[4], c1[4], x1[4], x2[4], cs[4], sn[4];
#pragma unroll
        for (int q = 0; q < 4; ++q) { const size_t r = (size_t)r0 + q; const int pos = NMETA + (int)(r & (SEQ - 1));
            c0[q] = p.CKV()[r * 128 + lane]; c1[q] = p.CKV()[r * 128 + 64 + lane];
            const int l32 = lane & 31; x1[q] = p.KR()[r * 64 + l32]; x2[q] = p.KR()[r * 64 + 32 + l32];
            const float2 t = *(const float2*)(p.ROPE() + ((size_t)pos * 32 + l32) * 2); cs[q] = t.x; sn[q] = t.y; }
#pragma unroll
        for (int q = 0; q < 4; ++q) { const size_t r = (size_t)r0 + q; const int b = (int)(r >> 12), key = (int)(r & (SEQ - 1));
            bf16_t* dst = p.Kc() + ((size_t)b * KVROWS + key) * 192;
            const float rstd = rsqrtf(wave_sum(c0[q] * c0[q] + c1[q] * c1[q]) * (1.f / 128.f) + EPS);
            dst[lane] = f2bf(c0[q] * rstd * gk0); dst[64 + lane] = f2bf(c1[q] * rstd * gk1);
            if (lane < 32) *(unsigned*)(dst + 128 + 2 * lane) = pk2(x1[q] * cs[q] - x2[q] * sn[q], x1[q] * sn[q] + x2[q] * cs[q]); }
    }
    for (int i = gw; i < NB * 64; i += NGW) {
        const int b = i >> 6, j = i & 63; bf16_t* dst = p.Kc() + ((size_t)b * KVROWS + SEQ + j) * 192;
        if (j >= NMETA) { dst[lane] = 0; dst[64 + lane] = 0; dst[128 + lane] = 0; continue; }
        const float* ckv = p.ZM() + (size_t)j * DIN + OFF_CKV; const float* kr = p.ZM() + (size_t)j * DIN + OFF_KR;
        const float c0 = ckv[lane], c1 = ckv[64 + lane];
        const float rstd = rsqrtf(wave_sum(c0 * c0 + c1 * c1) * (1.f / 128.f) + EPS);
        dst[lane] = f2bf(c0 * rstd * gk0); dst[64 + lane] = f2bf(c1 * rstd * gk1);
        if (lane < 32) { const float x1 = kr[lane], x2 = kr[32 + lane], cs = p.ROPE()[((size_t)j * 32 + lane) * 2], sn = p.ROPE()[((size_t)j * 32 + lane) * 2 + 1];
            *(unsigned*)(dst + 128 + 2 * lane) = pk2(x1 * cs - x2 * sn, x1 * sn + x2 * cs); }
    }
    for (int r0 = gw * 4; r0 < NT; r0 += NGW * 4) {
        float4 v[4];
#pragma unroll
        for (int q = 0; q < 4; ++q) v[q] = ntld4(p.CQ() + (size_t)(r0 + q) * 256 + lane * 4);
#pragma unroll
        for (int q = 0; q < 4; ++q) { u32x2 o; o.x = pk2(v[q].x, v[q].y); o.y = pk2(v[q].z, v[q].w);
            const float a = __uint_as_float(o.x << 16), b = __uint_as_float(o.x & 0xffff0000u), c = __uint_as_float(o.y << 16), d = __uint_as_float(o.y & 0xffff0000u);
            const float ss = wave_sum(a * a + b * b + c * c + d * d);
            *(u32x2*)(p.CQb() + (size_t)(r0 + q) * 256 + lane * 4) = o;
            if (lane == 0) p.RSQ()[r0 + q] = rsqrtf(ss * (1.f / 256.f) + EPS); }
    }
}

__device__ __forceinline__ void moe_tile_table(const Params& p, volatile LAS int* tst) {
    __syncthreads();
    if (threadIdx.x == 0) { int s = 0; for (int e = 0; e < NEXP; ++e) { tst[e] = s; s += (p.CNT()[e * CNT_STRIDE] + 255) / 256; } tst[NEXP] = s; }
    __syncthreads();
}

namespace att {
using s16x4 = __attribute__((ext_vector_type(4))) short;
using f32x16 = __attribute__((ext_vector_type(16))) float;
constexpr int KN_B = 16384, KR_B = 8192, V_B = 16384;
constexpr int L_KN = 0, L_KR = 2 * KN_B, L_WS = L_KR + 2 * KR_B, L_QR = L_WS + 8 * 256, L_END = L_QR + 8 * 4096;
constexpr float THR = 8.f;
#define KSWZ(row, colB) ((row) * 256 + ((colB) ^ (((((row) & 3) << 2) | (((row) >> 2) & 3)) << 4)))
#define RSWZ(row, colB) ((row) * 128 + ((colB) ^ ((((row) >> 1) & 7) << 4)))
#define SBAR() __builtin_amdgcn_sched_barrier(0)
__device__ __forceinline__ int crow(int r, int hi) { return (r & 3) + 8 * (r >> 2) + 4 * hi; }
__device__ __forceinline__ unsigned cvtpk(float lo, float hi) { unsigned r; asm volatile("v_cvt_pk_bf16_f32 %0, %1, %2" : "=v"(r) : "v"(lo), "v"(hi)); return r; }

__device__ __forceinline__ void partialSM(f32x16& p0, f32x16& p1, float& m_reg, float& alpha) {
    float pmax = p0[0];
#pragma unroll
    for (int r = 1; r < 16; ++r) pmax = fmaxf(pmax, p0[r]);
#pragma unroll
    for (int r = 0; r < 16; ++r) pmax = fmaxf(pmax, p1[r]);
    { auto rr = __builtin_amdgcn_permlane32_swap(__float_as_uint(pmax), __float_as_uint(pmax), false, false);
      pmax = fmaxf(__uint_as_float(rr[0]), __uint_as_float(rr[1])); }
    float mn;
    if (__builtin_expect(__all(pmax - m_reg <= THR), 1)) { mn = m_reg; alpha = 1.f; }
    else { mn = fmaxf(m_reg, pmax); alpha = __builtin_amdgcn_exp2f(m_reg - mn); m_reg = mn; }
#pragma unroll
    for (int r = 0; r < 16; ++r) p0[r] = p0[r] - mn;
#pragma unroll
    for (int r = 0; r < 16; ++r) p1[r] = p1[r] - mn;
#pragma unroll
    for (int r = 0; r < 16; ++r) p0[r] = __builtin_amdgcn_exp2f(p0[r]);
}
__device__ __forceinline__ void finishSM(f32x16& p0, f32x16& p1, float alpha, float& l_reg, bf16x8& pa0, bf16x8& pa1, bf16x8& pa2, bf16x8& pa3) {
#pragma unroll
    for (int r = 0; r < 16; ++r) p1[r] = __builtin_amdgcn_exp2f(p1[r]);
    float ps = 0;
#pragma unroll
    for (int r = 0; r < 16; ++r) ps += p0[r];
#pragma unroll
    for (int r = 0; r < 16; ++r) ps += p1[r];
    { auto rr = __builtin_amdgcn_permlane32_swap(__float_as_uint(ps), __float_as_uint(ps), false, false);
      ps = __uint_as_float(rr[0]) + __uint_as_float(rr[1]); }
    l_reg = l_reg * alpha + ps;
#define PK4(P, BASE, OUT) do { unsigned a0 = cvtpk(P[BASE + 0], P[BASE + 1]), a1 = cvtpk(P[BASE + 2], P[BASE + 3]);   \
    unsigned b0 = cvtpk(P[BASE + 4], P[BASE + 5]), b1 = cvtpk(P[BASE + 6], P[BASE + 7]);                              \
    auto r0 = __builtin_amdgcn_permlane32_swap(a0, b0, false, false); auto r1 = __builtin_amdgcn_permlane32_swap(a1, b1, false, false); \
    u32x4 w = {r0[0], r1[0], r0[1], r1[1]}; OUT = *reinterpret_cast<bf16x8*>(&w); } while (0)
    PK4(p0, 0, pa0); PK4(p0, 8, pa1); PK4(p1, 0, pa2); PK4(p1, 8, pa3);
#undef PK4
}
__device__ __forceinline__ void qkt(f32x16& p0, f32x16& p1, const char* Kn, const char* Kr, const bf16x8* qr, const char* qrl, int r32, int hi) {
    p0 = f32x16{}; p1 = f32x16{};
#pragma unroll
    for (int d0 = 0; d0 < 8; ++d0) { const int cb = (d0 * 16 + hi * 8) * 2;
        const bf16x8 b0 = *reinterpret_cast<const bf16x8*>(Kn + KSWZ(r32, cb));
        const bf16x8 b1 = *reinterpret_cast<const bf16x8*>(Kn + KSWZ(32 + r32, cb));
        p0 = __builtin_amdgcn_mfma_f32_32x32x16_bf16(b0, qr[d0], p0, 0, 0, 0);
        p1 = __builtin_amdgcn_mfma_f32_32x32x16_bf16(b1, qr[d0], p1, 0, 0, 0); }
#pragma unroll
    for (int d0 = 0; d0 < 4; ++d0) { const int cb = (d0 * 16 + hi * 8) * 2;
        const bf16x8 b0 = *reinterpret_cast<const bf16x8*>(Kr + RSWZ(r32, cb));
        const bf16x8 b1 = *reinterpret_cast<const bf16x8*>(Kr + RSWZ(32 + r32, cb));
        const bf16x8 qf = *reinterpret_cast<const bf16x8*>(qrl + d0 * 1024);
        p0 = __builtin_amdgcn_mfma_f32_32x32x16_bf16(b0, qf, p0, 0, 0, 0);
        p1 = __builtin_amdgcn_mfma_f32_32x32x16_bf16(b1, qf, p1, 0, 0, 0); }
}
__device__ __forceinline__ int v_st(int k, int c) { const int kk = (k & ~0xC) | ((k & 4) << 1) | ((k & 8) >> 1); return ((kk >> 3) * 4 + (c >> 5)) * 512 + ((kk & 7) * 32 + (c & 31)) * 2; }
__device__ __forceinline__ int v_rd_base(int lane) { return ((lane & 3) << 3) | (((lane >> 2) & 3) << 6) | (((lane >> 4) & 1) << 5) | (((lane >> 5) & 1) << 8); }
constexpr int v_rd_off(int d0, int ks, int half) { return d0 * 512 + ks * 4096 + half * 2048; }
template <int OFF> __device__ __forceinline__ s16x4 tr_read(int vb) { s16x4 r; asm volatile("ds_read_b64_tr_b16 %0, %1 offset:%2" : "=&v"(r) : "v"(vb), "i"(OFF) : "memory"); return r; }
template <int C> __device__ __forceinline__ void pv_one(f32x16& od, int bt0, int bt1, bf16x8 pa0, bf16x8 pa1, bf16x8 pa2, bf16x8 pa3) {
    const int a0 = bt0 ^ (C << 6), a1 = bt1 ^ (C << 6);
    const s16x4 l0 = tr_read<0>(a0), h0 = tr_read<0>(a1), l1 = tr_read<4096>(a0), h1 = tr_read<4096>(a1);
    const s16x4 l2 = tr_read<8192>(a0), h2 = tr_read<8192>(a1), l3 = tr_read<12288>(a0), h3 = tr_read<12288>(a1);
    asm volatile("s_waitcnt lgkmcnt(0)" ::: "memory"); SBAR();
#define PK(L, H) (bf16x8){L[0], L[1], L[2], L[3], H[0], H[1], H[2], H[3]}
    od = __builtin_amdgcn_mfma_f32_32x32x16_bf16(pa0, PK(l0, h0), od, 0, 0, 0);
    od = __builtin_amdgcn_mfma_f32_32x32x16_bf16(pa1, PK(l1, h1), od, 0, 0, 0);
    od = __builtin_amdgcn_mfma_f32_32x32x16_bf16(pa2, PK(l2, h2), od, 0, 0, 0);
    od = __builtin_amdgcn_mfma_f32_32x32x16_bf16(pa3, PK(l3, h3), od, 0, 0, 0);
#undef PK
}
__device__ __forceinline__ void pv_d0(f32x16* o, int bt0, int bt1, bf16x8 pa0, bf16x8 pa1, bf16x8 pa2, bf16x8 pa3) {
    pv_one<0>(o[0], bt0, bt1, pa0, pa1, pa2, pa3); pv_one<1>(o[1], bt0, bt1, pa0, pa1, pa2, pa3); pv_one<2>(o[2], bt0, bt1, pa0, pa1, pa2, pa3); pv_one<3>(o[3], bt0, bt1, pa0, pa1, pa2, pa3);
}
__device__ __forceinline__ int tr_base(int lane, int t) {
    const int h = lane >> 5, blk = (lane >> 4) & 1, q = (lane & 15) >> 2, p = lane & 3, row = 8 * h + 4 * t + q, ch = 2 * blk + (p >> 1);
    return KSWZ(row, ch * 16) + 8 * (p & 1);
}

__device__ __forceinline__ void attn_unit(const bf16_t* __restrict__ Qb, const bf16_t* __restrict__ Kb, bf16_t* __restrict__ Ob, char* lds) {
    const int tid = threadIdx.x, wid = tid >> 6, lane = tid & 63, r32 = lane & 31, hi = lane >> 5;
    char* Kn_l = lds + L_KN; char* Kr_l = lds + L_KR;
    float* ws = (float*)(lds + L_WS) + wid * 64; float* li_l = ws; float* al_l = ws + 32;
    float m_reg = -1e30f, l_reg = 0; f32x16 o[4] = {}; bf16x8 qr[8];
    const bf16_t* Qw = Qb + (size_t)(wid * 32 + r32) * 1536 + hi * 8;
    char* qrl = lds + L_QR + wid * 4096 + lane * 16;
#pragma unroll
    for (int d0 = 0; d0 < 8; ++d0) qr[d0] = *reinterpret_cast<const bf16x8*>(Qw + d0 * 16);
#pragma unroll
    for (int d0 = 0; d0 < 4; ++d0) *reinterpret_cast<bf16x8*>(qrl + d0 * 1024) = *reinterpret_cast<const bf16x8*>(Qw + (8 + d0) * 16);
    const int sr = tid >> 3, sc8 = tid & 7;
    const int kst0 = KSWZ(sr, sc8 * 16), kst1 = KSWZ(sr, 128 + sc8 * 16), rst = RSWZ(sr, sc8 * 16);
    const int bt0 = (int)(uintptr_t)Kn_l + tr_base(lane, 0), bt1 = (int)(uintptr_t)Kn_l + tr_base(lane, 1);
    bf16x8 s0, s1, s2;
#define SLOAD(mt) do { const bf16_t* kp = Kb + (size_t)((mt) * 64 + sr) * 192 + sc8 * 8; s0 = *reinterpret_cast<const bf16x8*>(kp); s1 = *reinterpret_cast<const bf16x8*>(kp + 64); s2 = *reinterpret_cast<const bf16x8*>(kp + 128); } while (0)
#define SWRITE(b) do { *(bf16x8*)(Kn_l + (b) * KN_B + kst0) = s0; *(bf16x8*)(Kn_l + (b) * KN_B + kst1) = s1; *(bf16x8*)(Kr_l + (b) * KR_B + rst) = s2; } while (0)
#define RESC(a) do { if (__any((a) < 1.f)) { if (hi == 0) al_l[r32] = (a); asm volatile("s_waitcnt lgkmcnt(0)" ::: "memory"); \
        _Pragma("unroll") for (int d = 0; d < 4; ++d) _Pragma("unroll") for (int r = 0; r < 16; ++r) o[d][r] *= al_l[crow(r, hi)]; } } while (0)
    f32x16 pA0, pA1, pB0, pB1; float alA, alB; bf16x8 pa0, pa1, pa2, pa3;
    constexpr int NTL = 65;
    SLOAD(64); asm volatile("s_waitcnt vmcnt(0)" ::: "memory"); SWRITE(0); __syncthreads();
    qkt(pA0, pA1, Kn_l, Kr_l, qr, qrl, r32, hi);
#pragma unroll
    for (int r = 8; r < 16; ++r) pA0[r] = -1e30f;
#pragma unroll
    for (int r = 0; r < 16; ++r) pA1[r] = -1e30f;
    partialSM(pA0, pA1, m_reg, alA);
    SLOAD(0); asm volatile("s_waitcnt vmcnt(0)" ::: "memory"); SWRITE(1); __syncthreads();
#pragma unroll 1
    for (int j = 1; j + 1 < NTL; j += 2) {
        SBAR(); qkt(pB0, pB1, Kn_l + KN_B, Kr_l + KR_B, qr, qrl, r32, hi);
        finishSM(pA0, pA1, alA, l_reg, pa0, pa1, pa2, pa3); SBAR();
        SLOAD(j); SBAR();
        pv_d0(o, bt0, bt1, pa0, pa1, pa2, pa3); partialSM(pB0, pB1, m_reg, alB);
        __syncthreads(); asm volatile("s_waitcnt vmcnt(0)" ::: "memory"); SWRITE(0);
        RESC(alB); __syncthreads();
        SBAR(); qkt(pA0, pA1, Kn_l, Kr_l, qr, qrl, r32, hi);
        finishSM(pB0, pB1, alB, l_reg, pa0, pa1, pa2, pa3); SBAR();
        if (j + 2 < NTL) SLOAD(j + 1); SBAR();
        pv_d0(o, bt0 + KN_B, bt1 + KN_B, pa0, pa1, pa2, pa3); partialSM(pA0, pA1, m_reg, alA);
        __syncthreads(); asm volatile("s_waitcnt vmcnt(0)" ::: "memory"); if (j + 2 < NTL) SWRITE(1);
        RESC(alA); __syncthreads();
    }
    finishSM(pA0, pA1, alA, l_reg, pa0, pa1, pa2, pa3); SBAR();
    pv_d0(o, bt0, bt1, pa0, pa1, pa2, pa3);
    if (hi == 0) li_l[r32] = l_reg; asm volatile("s_waitcnt lgkmcnt(0)" ::: "memory");
    float rli[16];
#pragma unroll
    for (int r = 0; r < 16; ++r) rli[r] = __builtin_amdgcn_rcpf(li_l[crow(r, hi)]);
    bf16_t* Ow = Ob + (size_t)(wid * 32) * 1024;
#pragma unroll
    for (int r = 0; r < 16; ++r) { const int orow = crow(r, hi);
#pragma unroll
        for (int d0 = 0; d0 < 4; ++d0) Ow[(size_t)orow * 1024 + d0 * 32 + r32] = f2bf(o[d0][r] * rli[r]); }
    __syncthreads();
#undef SLOAD
#undef SWRITE
#undef RESC
}
#undef KSWZ
#undef RSWZ
#undef SBAR
}

__device__ __forceinline__ void phase_attn(const Params& p, char* lds, int vcu, int G) {
    for (int u = vcu; u < NB * 8 * 16; u += G) {
        const int b = u >> 7, h = (u >> 4) & 7, qb = u & 15;
        const size_t r0 = (size_t)b * SEQ + qb * 256;
        att::attn_unit(p.QP() + r0 * 1536 + h * 192, p.Kc() + (size_t)b * KVROWS * 192, p.OA() + r0 * 1024 + h * 128, lds);
    }
}

namespace ml {
using att::s16x4; using att::f32x16; using att::crow; using att::cvtpk; using att::v_st; using att::v_rd_base; using att::tr_read; using att::v_rd_off;
#define RSWZ(row, colB) ((row) * 128 + ((colB) ^ ((((row) >> 1) & 7) << 4)))
#define SBAR() __builtin_amdgcn_sched_barrier(0)
__device__ __forceinline__ void pv_blk(f32x16& od, int vb, bf16x8 pa0, bf16x8 pa1, bf16x8 pa2, bf16x8 pa3) {
    const s16x4 l0 = tr_read<v_rd_off(0, 0, 0)>(vb), h0 = tr_read<v_rd_off(0, 0, 1)>(vb), l1 = tr_read<v_rd_off(0, 1, 0)>(vb), h1 = tr_read<v_rd_off(0, 1, 1)>(vb);
    const s16x4 l2 = tr_read<v_rd_off(0, 2, 0)>(vb), h2 = tr_read<v_rd_off(0, 2, 1)>(vb), l3 = tr_read<v_rd_off(0, 3, 0)>(vb), h3 = tr_read<v_rd_off(0, 3, 1)>(vb);
    asm volatile("s_waitcnt lgkmcnt(0)" ::: "memory"); SBAR();
#define PK(L, H) (bf16x8){L[0], L[1], L[2], L[3], H[0], H[1], H[2], H[3]}
    od = __builtin_amdgcn_mfma_f32_32x32x16_bf16(pa0, PK(l0, h0), od, 0, 0, 0);
    od = __builtin_amdgcn_mfma_f32_32x32x16_bf16(pa1, PK(l1, h1), od, 0, 0, 0);
    od = __builtin_amdgcn_mfma_f32_32x32x16_bf16(pa2, PK(l2, h2), od, 0, 0, 0);
    od = __builtin_amdgcn_mfma_f32_32x32x16_bf16(pa3, PK(l3, h3), od, 0, 0, 0);
}
template <int KS0> __device__ __forceinline__ void pv_blk2(f32x16& od, int vb, bf16x8 pa, bf16x8 pb) {
    const s16x4 l0 = tr_read<v_rd_off(0, KS0, 0)>(vb), h0 = tr_read<v_rd_off(0, KS0, 1)>(vb), l1 = tr_read<v_rd_off(0, KS0 + 1, 0)>(vb), h1 = tr_read<v_rd_off(0, KS0 + 1, 1)>(vb);
    asm volatile("s_waitcnt lgkmcnt(0)" ::: "memory"); SBAR();
    od = __builtin_amdgcn_mfma_f32_32x32x16_bf16(pa, PK(l0, h0), od, 0, 0, 0);
    od = __builtin_amdgcn_mfma_f32_32x32x16_bf16(pb, PK(l1, h1), od, 0, 0, 0);
}
__device__ __forceinline__ void tt_blk(f32x16& od, int va, int vb) {
    const s16x4 al0 = tr_read<v_rd_off(0, 0, 0)>(va), ah0 = tr_read<v_rd_off(0, 0, 1)>(va), al1 = tr_read<v_rd_off(0, 1, 0)>(va), ah1 = tr_read<v_rd_off(0, 1, 1)>(va);
    const s16x4 al2 = tr_read<v_rd_off(0, 2, 0)>(va), ah2 = tr_read<v_rd_off(0, 2, 1)>(va), al3 = tr_read<v_rd_off(0, 3, 0)>(va), ah3 = tr_read<v_rd_off(0, 3, 1)>(va);
    const s16x4 l0 = tr_read<v_rd_off(0, 0, 0)>(vb), h0 = tr_read<v_rd_off(0, 0, 1)>(vb), l1 = tr_read<v_rd_off(0, 1, 0)>(vb), h1 = tr_read<v_rd_off(0, 1, 1)>(vb);
    const s16x4 l2 = tr_read<v_rd_off(0, 2, 0)>(vb), h2 = tr_read<v_rd_off(0, 2, 1)>(vb), l3 = tr_read<v_rd_off(0, 3, 0)>(vb), h3 = tr_read<v_rd_off(0, 3, 1)>(vb);
    asm volatile("s_waitcnt lgkmcnt(0)" ::: "memory"); SBAR();
    od = __builtin_amdgcn_mfma_f32_32x32x16_bf16(PK(al0, ah0), PK(l0, h0), od, 0, 0, 0);
    od = __builtin_amdgcn_mfma_f32_32x32x16_bf16(PK(al1, ah1), PK(l1, h1), od, 0, 0, 0);
    od = __builtin_amdgcn_mfma_f32_32x32x16_bf16(PK(al2, ah2), PK(l2, h2), od, 0, 0, 0);
    od = __builtin_amdgcn_mfma_f32_32x32x16_bf16(PK(al3, ah3), PK(l3, h3), od, 0, 0, 0);
#undef PK
}
#define PK4(P, BASE, OUT) do { unsigned a0 = cvtpk(P[BASE + 0], P[BASE + 1]), a1 = cvtpk(P[BASE + 2], P[BASE + 3]);   \
    unsigned b0 = cvtpk(P[BASE + 4], P[BASE + 5]), b1 = cvtpk(P[BASE + 6], P[BASE + 7]);                              \
    auto r0 = __builtin_amdgcn_permlane32_swap(a0, b0, false, false); auto r1 = __builtin_amdgcn_permlane32_swap(a1, b1, false, false); \
    u32x4 w = {r0[0], r1[0], r0[1], r1[1]}; OUT = *reinterpret_cast<bf16x8*>(&w); } while (0)
__device__ __forceinline__ float half_swap_add(float v) { auto rr = __builtin_amdgcn_permlane32_swap(__float_as_uint(v), __float_as_uint(v), false, false); return __uint_as_float(rr[0]) + __uint_as_float(rr[1]); }
__device__ __forceinline__ bf16x8 scale8(bf16x8 v, float s) {
    const u32x4 w = *reinterpret_cast<const u32x4*>(&v); u32x4 o;
    o.x = cvtpk(__uint_as_float(w.x << 16) * s, __uint_as_float(w.x & 0xffff0000u) * s); o.y = cvtpk(__uint_as_float(w.y << 16) * s, __uint_as_float(w.y & 0xffff0000u) * s);
    o.z = cvtpk(__uint_as_float(w.z << 16) * s, __uint_as_float(w.z & 0xffff0000u) * s); o.w = cvtpk(__uint_as_float(w.w << 16) * s, __uint_as_float(w.w & 0xffff0000u) * s);
    return *reinterpret_cast<bf16x8*>(&o);
}
__device__ __forceinline__ bf16x8 f8_to_bf(const float* p, bool ok) {
    if (!ok) return (bf16x8){0, 0, 0, 0, 0, 0, 0, 0};
    const f32x4 a = *(const f32x4*)p, b = *(const f32x4*)(p + 4); u32x4 o = {cvtpk(a[0], a[1]), cvtpk(a[2], a[3]), cvtpk(b[0], b[1]), cvtpk(b[2], b[3])};
    return *reinterpret_cast<bf16x8*>(&o);
}
template <int K> __device__ __forceinline__ float dpp_shr(float v, float ident) {
    return __int_as_float(__builtin_amdgcn_update_dpp(__float_as_int(ident), __float_as_int(v), 0x110 | K, 0xf, 0xf, false));
}
__device__ __forceinline__ float rdlane(float v, int l) { return __int_as_float(__builtin_amdgcn_readlane(__float_as_int(v), l)); }
__device__ __forceinline__ float wave_incl_sum(float v, int lane) {
    v += dpp_shr<1>(v, 0.f); v += dpp_shr<2>(v, 0.f); v += dpp_shr<4>(v, 0.f); v += dpp_shr<8>(v, 0.f);
    const float s0 = rdlane(v, 15), s1 = rdlane(v, 31), s2 = rdlane(v, 47); const int row = lane >> 4;
    return v + (row >= 1 ? s0 : 0.f) + (row >= 2 ? s1 : 0.f) + (row >= 3 ? s2 : 0.f);
}
__device__ __forceinline__ float wave_incl_max(float v, int lane) {
    const float NI = -3.0e38f;
    v = fmaxf(v, dpp_shr<1>(v, NI)); v = fmaxf(v, dpp_shr<2>(v, NI)); v = fmaxf(v, dpp_shr<4>(v, NI)); v = fmaxf(v, dpp_shr<8>(v, NI));
    const float s0 = rdlane(v, 15), s1 = rdlane(v, 31), s2 = rdlane(v, 47); const int row = lane >> 4;
    return fmaxf(fmaxf(v, row >= 1 ? s0 : NI), fmaxf(row >= 2 ? s1 : NI, row >= 3 ? s2 : NI));
}
__device__ __forceinline__ float wave_max(float v) {
    const float NI = -3.0e38f;
    v = fmaxf(v, dpp_shr<1>(v, NI)); v = fmaxf(v, dpp_shr<2>(v, NI)); v = fmaxf(v, dpp_shr<4>(v, NI)); v = fmaxf(v, dpp_shr<8>(v, NI));
    return fmaxf(fmaxf(rdlane(v, 15), rdlane(v, 31)), fmaxf(rdlane(v, 47), rdlane(v, 63)));
}

constexpr int SC_BUF = 32768;
__device__ __forceinline__ void scan_unit(const Params& p, int b, int h, int dir, char* lds) {
    const int tid = threadIdx.x, wid = tid >> 6, lane = tid & 63, r32 = lane & 31, hi = lane >> 5, db = wid & 1, vq = wid >> 1;
    const int sr = tid >> 3, sc8 = tid & 7;
    const int kst = v_st(sr, sc8 * 8), vst0 = v_st(sr, sc8 * 8), vst1 = v_st(sr, 64 + sc8 * 8);
    const int va0 = (int)(uintptr_t)lds + v_rd_base(lane) + db * 512, vb0 = (int)(uintptr_t)lds + 16384 + v_rd_base(lane) + vq * 512;
    bf16_t* CS = dir ? p.CB() : p.CF(); float* NS = dir ? p.NB_() : p.NF(); float* MS = dir ? p.MB() : p.MF();
    const size_t sbase = (size_t)(b * 8 + h) * 64;
    f32x16 acc = {}; float nacc = 0.f, m = 0.f, decay_prev = 1.f;
    const int nsteps = dir ? 64 : 65;
    bf16x8 sk, sv0, sv1; float gli, glf;
#define ML_LOAD(st) do { const int c_ = dir ? 63 - (st) : (st) - 1; \
        if (c_ < 0) { const float* z = p.ZM() + (size_t)(sr & 15) * DIN; const bool okr = sr < NMETA; \
            sk = f8_to_bf(z + OFF_K + h * 64 + sc8 * 8, okr); sv0 = f8_to_bf(z + OFF_V + h * 128 + sc8 * 8, okr); sv1 = f8_to_bf(z + OFF_V + h * 128 + 64 + sc8 * 8, okr); \
            const float* zl = p.ZM() + (size_t)(lane & 15) * DIN; gli = lane < NMETA ? zl[OFF_I + h] + p.m_b_i[h] : -1e30f; glf = lane < NMETA ? logsigmoidf_(zl[OFF_F + h] + p.m_b_f[h]) : 0.f; } \
        else { const size_t r_ = (size_t)b * SEQ + c_ * 64 + sr; sk = *reinterpret_cast<const bf16x8*>(p.Km() + r_ * 512 + h * 64 + sc8 * 8); \
            sv0 = *reinterpret_cast<const bf16x8*>(p.Vm() + r_ * 1024 + h * 128 + sc8 * 8); sv1 = *reinterpret_cast<const bf16x8*>(p.Vm() + r_ * 1024 + h * 128 + 64 + sc8 * 8); \
            const size_t rg = (size_t)b * SEQ + c_ * 64 + (dir ? 63 - lane : lane); gli = p.GI()[rg * 16 + dir * 8 + h]; glf = p.GF()[rg * 16 + dir * 8 + h]; } } while (0)
#define ML_GATES(decay_, mnew_, wk_) do { const float bc_ = wave_incl_sum(glf, lane); const float bl_ = rdlane(bc_, 63); const float g_ = bl_ - bc_ + gli; \
        mnew_ = fmaxf(bl_ + m, wave_max(g_)); decay_ = __expf(bl_ + m - mnew_); wk_ = __expf(g_ - mnew_); } while (0)
    ML_LOAD(0);
    float decay, mnew, wk;
    { asm volatile("s_waitcnt vmcnt(0)" ::: "memory"); ML_GATES(decay, mnew, wk);
      const float w = __shfl(wk, dir ? 63 - sr : sr);
      *(bf16x8*)(lds + kst) = sk; *(bf16x8*)(lds + 16384 + vst0) = scale8(sv0, w); *(bf16x8*)(lds + 16384 + vst1) = scale8(sv1, w); }
    __syncthreads();
#pragma unroll 1
    for (int st = 0; st < nsteps; ++st) {
        const int c = dir ? 63 - st : st - 1, buf = st & 1;
        if (wid == 0 && st > 0) { float s_ = 0.f; const float* np_ = (const float*)(lds + 65536) + ((st - 1) & 1) * 512;
#pragma unroll
            for (int w8 = 0; w8 < 8; ++w8) s_ += np_[w8 * 64 + lane];
            nacc = nacc * decay_prev + s_; }
        if (c >= 0) {
            const size_t sidx = sbase + c; bf16_t* cd = CS + sidx * 8192 + (size_t)(db * 32) * 128 + vq * 32 + r32;
#pragma unroll
            for (int r = 0; r < 16; ++r) cd[(size_t)crow(r, hi) * 128] = f2bf(acc[r]);
            if (wid == 0) NS[sidx * 64 + lane] = nacc;
            if (tid == 0) MS[sidx] = m;
        }
        if (st == nsteps - 1) break;
        if (st + 1 < nsteps - 1) ML_LOAD(st + 1);
#pragma unroll
        for (int r = 0; r < 16; ++r) acc[r] *= decay;
        tt_blk(acc, va0 + buf * SC_BUF, vb0 + buf * SC_BUF);
        {
            float s_ = 0.f;
#pragma unroll
            for (int q = 0; q < 8; ++q) { const int s = wid * 8 + q; const float w = __shfl(wk, dir ? 63 - s : s); s_ += w * bf2f(*(const bf16_t*)(lds + buf * SC_BUF + v_st(s, lane))); }
            ((float*)(lds + 65536))[(st & 1) * 512 + wid * 64 + lane] = s_;
        }
        decay_prev = decay;
        m = mnew;
        if (st + 1 < nsteps - 1) {
            asm volatile("s_waitcnt vmcnt(0)" ::: "memory"); ML_GATES(decay, mnew, wk);
            const float w = __shfl(wk, dir ? 63 - sr : sr); char* lb = lds + (buf ^ 1) * SC_BUF;
            *(bf16x8*)(lb + kst) = sk; *(bf16x8*)(lb + 16384 + vst0) = scale8(sv0, w); *(bf16x8*)(lb + 16384 + vst1) = scale8(sv1, w);
        }
        __syncthreads();
    }
    __syncthreads();
#undef ML_LOAD
#undef ML_GATES
}

constexpr int O_K = 0, O_V = 8192, O_CF = 24576, O_CB = 40960, O_T = 57344, O_ARR = 122880, O_WS = 125440, O_END = 127488;
struct OutPre { bf16x8 kk, v0, v1, f0, f1, b0, b1, q0, q1, q2, q3; float li, lf, mm, nn; };
__device__ __forceinline__ void out_load(const Params& p, int u, OutPre& R) {
    const int tid = threadIdx.x, wid = tid >> 6, lane = tid & 63, r32 = lane & 31, hi = lane >> 5, tb = wid & 1;
    const int b = u >> 9, h = u & 7, c = (u >> 3) & 63; const size_t r0 = (size_t)b * SEQ + c * 64, sidx = (size_t)(b * 8 + h) * 64 + c;
    const int sr = tid >> 3, sc8 = tid & 7;
    R.kk = *reinterpret_cast<const bf16x8*>(p.Km() + (r0 + sr) * 512 + h * 64 + sc8 * 8);
    const bf16_t* vp = p.Vm() + (r0 + sr) * 1024 + h * 128 + sc8 * 8; R.v0 = *reinterpret_cast<const bf16x8*>(vp); R.v1 = *reinterpret_cast<const bf16x8*>(vp + 64);
    const bf16_t* cf = p.CF() + sidx * 8192 + (size_t)sr * 128 + sc8 * 8; R.f0 = *reinterpret_cast<const bf16x8*>(cf); R.f1 = *reinterpret_cast<const bf16x8*>(cf + 64);
    const bf16_t* cb = p.CB() + sidx * 8192 + (size_t)sr * 128 + sc8 * 8; R.b0 = *reinterpret_cast<const bf16x8*>(cb); R.b1 = *reinterpret_cast<const bf16x8*>(cb + 64);
    const bf16_t* qp = p.Qm() + (r0 + tb * 32 + r32) * 512 + h * 64 + hi * 8;
    R.q0 = *reinterpret_cast<const bf16x8*>(qp); R.q1 = *reinterpret_cast<const bf16x8*>(qp + 16); R.q2 = *reinterpret_cast<const bf16x8*>(qp + 32); R.q3 = *reinterpret_cast<const bf16x8*>(qp + 48);
    R.li = 0.f; R.lf = 0.f; R.mm = 0.f; R.nn = 0.f;
    if (wid < 2) { const int dir = wid, t = dir ? 63 - lane : lane; R.li = p.GI()[(r0 + t) * 16 + dir * 8 + h]; R.lf = p.GF()[(r0 + t) * 16 + dir * 8 + h]; R.mm = (dir ? p.MB() : p.MF())[sidx]; }
    else if (wid < 4) { const int dir = wid - 2; R.nn = (dir ? p.NB_() : p.NF())[sidx * 64 + lane]; }
}
__device__ __forceinline__ void phase_mlstm_out_body(const Params& p, char* lds, int vcu, int G) {
    const int tid = threadIdx.x, wid = tid >> 6, lane = tid & 63, r32 = lane & 31, hi = lane >> 5, tb = wid & 1, vq = wid >> 1;
    const int sr = tid >> 3, sc8 = tid & 7;
    float* arr = (float*)(lds + O_ARR);
    float* nbuf = arr + 512;
    float* wsc = (float*)(lds + O_WS) + wid * 64;
    const int NU = NB * 8 * 64;
    OutPre R;
    if (vcu < NU) out_load(p, vcu, R);
#pragma unroll 1
    for (int u = vcu; u < NU; u += G) {
        const int b = u >> 9, h = u & 7, c = (u >> 3) & 63; const size_t r0 = (size_t)b * SEQ + c * 64;
        { *(bf16x8*)(lds + O_K + RSWZ(sr, sc8 * 16)) = R.kk;
          const int s0 = v_st(sr, sc8 * 8), s1 = v_st(sr, 64 + sc8 * 8);
          *(bf16x8*)(lds + O_V + s0) = R.v0; *(bf16x8*)(lds + O_V + s1) = R.v1; *(bf16x8*)(lds + O_CF + s0) = R.f0; *(bf16x8*)(lds + O_CF + s1) = R.f1; *(bf16x8*)(lds + O_CB + s0) = R.b0; *(bf16x8*)(lds + O_CB + s1) = R.b1; }
        if (wid < 2) {
            const int dir = wid, t = dir ? 63 - lane : lane; const float m = R.mm;
            const float bc = wave_incl_sum(R.lf, lane), a = R.li - bc, pm = wave_incl_max(a, lane), mx = fmaxf(m, pm);
            float* ar = arr + dir * 256;
            ar[t] = -mx * 1.4426950408889634f; ar[64 + t] = a * 1.4426950408889634f; ar[128 + t] = __expf(m - mx); ar[192 + t] = __expf(-(bc + mx));
        } else if (wid < 4) nbuf[(wid - 2) * 64 + lane] = R.nn;
        bf16x8 qr[4] = {R.q0, R.q1, R.q2, R.q3};
        __syncthreads();
        if (u + G < NU) out_load(p, u + G, R);
        const int ocol = h * 128 + sc8 * 16; const size_t oo = (r0 + sr) * 1024 + ocol;
        const u32x4 og0 = *(const u32x4*)(p.OG() + oo), og1 = *(const u32x4*)(p.OG() + oo + 8);
        const f32x4 n0 = *(const f32x4*)(p.m_norm + ocol), n1 = *(const f32x4*)(p.m_norm + ocol + 4), n2 = *(const f32x4*)(p.m_norm + ocol + 8), n3 = *(const f32x4*)(p.m_norm + ocol + 12);
        const int dir = (wid >> 1) & 1, vh = wid >> 2;
        float qn;
        { const float* nv = nbuf + dir * 64 + hi * 8; float s_ = 0.f;
#pragma unroll
          for (int d0 = 0; d0 < 4; ++d0) { const u32x4 w = *reinterpret_cast<const u32x4*>(&qr[d0]); const f32x4 n0 = *(const f32x4*)(nv + d0 * 16), n1 = *(const f32x4*)(nv + d0 * 16 + 4);
              s_ += __uint_as_float(w.x << 16) * n0[0] + __uint_as_float(w.x & 0xffff0000u) * n0[1] + __uint_as_float(w.y << 16) * n0[2] + __uint_as_float(w.y & 0xffff0000u) * n0[3]
                  + __uint_as_float(w.z << 16) * n1[0] + __uint_as_float(w.z & 0xffff0000u) * n1[1] + __uint_as_float(w.w << 16) * n1[2] + __uint_as_float(w.w & 0xffff0000u) * n1[3]; }
          qn = half_swap_add(s_); }
        f32x16 p0 = {}, p1 = {};
        const bool has0 = !(dir == 1 && tb == 1), has1 = !(dir == 0 && tb == 0);
#pragma unroll
        for (int d0 = 0; d0 < 4; ++d0) { const int cb = (d0 * 16 + hi * 8) * 2;
            if (has0) { const bf16x8 k0 = *reinterpret_cast<const bf16x8*>(lds + O_K + RSWZ(r32, cb)); p0 = __builtin_amdgcn_mfma_f32_32x32x16_bf16(k0, qr[d0], p0, 0, 0, 0); }
            if (has1) { const bf16x8 k1 = *reinterpret_cast<const bf16x8*>(lds + O_K + RSWZ(32 + r32, cb)); p1 = __builtin_amdgcn_mfma_f32_32x32x16_bf16(k1, qr[d0], p1, 0, 0, 0); } }
        const int t = tb * 32 + r32;
        const int vbase = (int)(uintptr_t)lds + v_rd_base(lane) + vh * 1024;
#define W_FULL(P, W, SB) _Pragma("unroll") for (int g = 0; g < 4; ++g) { const f32x4 ct = *(const f32x4*)(ar + 64 + (SB) + 8 * g + 4 * hi); \
            _Pragma("unroll") for (int q = 0; q < 4; ++q) { const float x = __builtin_amdgcn_exp2f(rt + ct[q]) * P[4 * g + q]; W[4 * g + q] = x; rs += x; } }
#define W_DIAG(P, W, SB) _Pragma("unroll") for (int g = 0; g < 4; ++g) { const f32x4 ct = *(const f32x4*)(ar + 64 + (SB) + 8 * g + 4 * hi); \
            _Pragma("unroll") for (int q = 0; q < 4; ++q) { const int sl = 8 * g + 4 * hi + q; const bool ok = dir ? (sl >= r32) : (sl <= r32); \
                const float x = ok ? __builtin_amdgcn_exp2f(rt + ct[q]) * P[4 * g + q] : 0.f; W[4 * g + q] = x; rs += x; } }
        {
            const float* ar = arr + dir * 256; const float rt = ar[t], sint = ar[128 + t], efl = ar[192 + t];
            f32x16 w0, w1; float rs = 0.f;
            if (tb == 0) { W_DIAG(p0, w0, 0) if (dir == 1) { W_FULL(p1, w1, 32) } }
            else         { W_DIAG(p1, w1, 32) if (dir == 0) { W_FULL(p0, w0, 0) } }
            rs = half_swap_add(rs);
            bf16x8 pa0, pa1, pa2, pa3;
            if (has0) { PK4(w0, 0, pa0); PK4(w0, 8, pa1); }
            if (has1) { PK4(w1, 0, pa2); PK4(w1, 8, pa3); }
            const float den = rs + sint * qn, inv = 1.f / fmaxf(fabsf(den), efl);
            if (hi == 0) { wsc[r32] = sint; wsc[32 + r32] = inv; }
            f32x16 o0 = {}, o1 = {};
            pv_blk(o0, vbase + (dir ? O_CB : O_CF), qr[0], qr[1], qr[2], qr[3]);
            pv_blk(o1, vbase + (dir ? O_CB : O_CF) + 512, qr[0], qr[1], qr[2], qr[3]);
            asm volatile("s_waitcnt lgkmcnt(0)" ::: "memory");
#pragma unroll
            for (int g = 0; g < 4; ++g) { const f32x4 sc = *(const f32x4*)(wsc + 8 * g + 4 * hi);
#pragma unroll
                for (int q = 0; q < 4; ++q) { o0[4 * g + q] *= sc[q]; o1[4 * g + q] *= sc[q]; } }
            if (has0) { pv_blk2<0>(o0, vbase + O_V, pa0, pa1); pv_blk2<0>(o1, vbase + O_V + 512, pa0, pa1); }
            if (has1) { pv_blk2<2>(o0, vbase + O_V, pa2, pa3); pv_blk2<2>(o1, vbase + O_V + 512, pa2, pa3); }
            float* T = (float*)(lds + O_T + dir * 32768) + (size_t)(tb * 32) * 128 + vh * 64 + r32;
#pragma unroll
            for (int g = 0; g < 4; ++g) { const f32x4 sc = *(const f32x4*)(wsc + 32 + 8 * g + 4 * hi);
#pragma unroll
                for (int q = 0; q < 4; ++q) { const int rw = 8 * g + 4 * hi + q; T[rw * 128] = o0[4 * g + q] * sc[q]; T[rw * 128 + 32] = o1[4 * g + q] * sc[q]; } }
        }
#undef W_FULL
#undef W_DIAG
        __syncthreads();
        { const float* T = (const float*)(lds + O_T) + sr * 128 + sc8 * 16; f32x4 v[4]; float ss = 0.f;
#pragma unroll
          for (int q = 0; q < 4; ++q) { v[q] = *(const f32x4*)(T + q * 4) + *(const f32x4*)(T + 8192 + q * 4); ss += v[q][0] * v[q][0] + v[q][1] * v[q][1] + v[q][2] * v[q][2] + v[q][3] * v[q][3]; }
          ss += __shfl_xor(ss, 1); ss += __shfl_xor(ss, 2); ss += __shfl_xor(ss, 4);
          const float rstd = rsqrtf(ss * (1.f / 128.f) + EPS);
          const f32x4 g0 = (f32x4){__uint_as_float(og0.x << 16), __uint_as_float(og0.x & 0xffff0000u), __uint_as_float(og0.y << 16), __uint_as_float(og0.y & 0xffff0000u)};
          const f32x4 g1 = (f32x4){__uint_as_float(og0.z << 16), __uint_as_float(og0.z & 0xffff0000u), __uint_as_float(og0.w << 16), __uint_as_float(og0.w & 0xffff0000u)};
          const f32x4 g2 = (f32x4){__uint_as_float(og1.x << 16), __uint_as_float(og1.x & 0xffff0000u), __uint_as_float(og1.y << 16), __uint_as_float(og1.y & 0xffff0000u)};
          const f32x4 g3 = (f32x4){__uint_as_float(og1.z << 16), __uint_as_float(og1.z & 0xffff0000u), __uint_as_float(og1.w << 16), __uint_as_float(og1.w & 0xffff0000u)};
          st8_bf16(p.HM() + oo, v[0] * rstd * n0 * g0, v[1] * rstd * n1 * g1); st8_bf16(p.HM() + oo + 8, v[2] * rstd * n2 * g2, v[3] * rstd * n3 * g3); }
    }
    __syncthreads();
}
#undef PK4
#undef RSWZ
#undef SBAR
}

__device__ __forceinline__ void phase_mlstm_scan(const Params& p, char* lds, int vcu, int G) {
    for (int u = vcu; u < NB * 8 * 2; u += G) ml::scan_unit(p, u >> 4, (u >> 1) & 7, u & 1, lds);
}
__device__ __forceinline__ void phase_mlstm_out(const Params& p, char* lds, int vcu, int G) {
    ml::phase_mlstm_out_body(p, lds, vcu, G);
}

#define RS_STEP(IN, OUT, N, BIT, MASK) _Pragma("unroll") for (int i_ = 0; i_ < (N); ++i_) { const float keep_ = (BIT) ? IN[(N) + i_] : IN[i_], send_ = (BIT) ? IN[i_] : IN[(N) + i_]; OUT[i_] = keep_ + __shfl_xor(send_, (MASK)); }
__device__ __forceinline__ float route_reduce(const float (&v)[32], int lane) {
    const int b5 = (lane >> 5) & 1, b4 = (lane >> 4) & 1, b3 = (lane >> 3) & 1, b2 = (lane >> 2) & 1, b1 = (lane >> 1) & 1;
    float a16[16], a8[8], a4[4], a2[2], a1[1];
    RS_STEP(v, a16, 16, b5, 32) RS_STEP(a16, a8, 8, b4, 16) RS_STEP(a8, a4, 4, b3, 8) RS_STEP(a4, a2, 2, b2, 4) RS_STEP(a2, a1, 1, b1, 2)
    return a1[0] + __shfl_xor(a1[0], 1);
}
__device__ __forceinline__ int route_rank(float val, int myexp) {
    int cnt = 0;
#pragma unroll
    for (int e = 0; e < 32; ++e) { const float ve = __int_as_float(__builtin_amdgcn_readlane(__float_as_int(val), 2 * e)); cnt += (ve > val || (ve == val && e < myexp)) ? 1 : 0; }
    return cnt;
}
__device__ __forceinline__ void phase_route(const Params& p, char* lds, int vcu, int G) {
    constexpr int XST = 1028;
    float* xs = (float*)lds;
    float* part = (float*)(lds + 65792);
    unsigned short* ent = (unsigned short*)(lds + 84224);
    int* lcount = (int*)(lds + 88320); int* lbase = lcount + 32;
    float* rec = (float*)(lds + 88576);
    const int tid = threadIdx.x, lane = tid & 63, w = tid >> 6, q4 = lane >> 4, l15 = lane & 15;
    __syncthreads();
    if (tid < 32) lcount[tid] = 0;
    float breg0[32], breg1[32];
#pragma unroll
    for (int i = 0; i < 32; ++i) { const float* wr = p.w_router + (size_t)(128 * w + 4 * i + q4) * NEXP + l15; breg0[i] = wr[0]; breg1[i] = wr[16]; }
    const int te = lane & 31, tsel = lane >> 5;
    const float mybias = p.b_router[te];
    int nloc = 0;
    float4 pa_[4], pb_[4];
    if (vcu * 16 < NT) {
#pragma unroll
        for (int j = 0; j < 4; ++j) { pa_[j] = ntld_h1(p.H1() + (size_t)(vcu * 16 + w * 2) * DM + (j * 64 + lane) * 4); pb_[j] = ntld_h1(p.H1() + (size_t)(vcu * 16 + w * 2 + 1) * DM + (j * 64 + lane) * 4); } }
#pragma unroll 1
    for (int base = vcu * 16; base < NT; base += G * 16, nloc += 16) {
        const int row0 = base + w * 2;
        float4 xa[4], xb[4]; float sa = 0.f, sb = 0.f;
#pragma unroll
        for (int j = 0; j < 4; ++j) { xa[j] = pa_[j]; xb[j] = pb_[j]; }
        { const int nb_ = base + G * 16; if (nb_ < NT) {
#pragma unroll
            for (int j = 0; j < 4; ++j) { pa_[j] = ntld_h1(p.H1() + (size_t)(nb_ + w * 2) * DM + (j * 64 + lane) * 4); pb_[j] = ntld_h1(p.H1() + (size_t)(nb_ + w * 2 + 1) * DM + (j * 64 + lane) * 4); } } }
#pragma unroll
        for (int j = 0; j < 4; ++j) { sa += xa[j].x * xa[j].x + xa[j].y * xa[j].y + xa[j].z * xa[j].z + xa[j].w * xa[j].w; sb += xb[j].x * xb[j].x + xb[j].y * xb[j].y + xb[j].z * xb[j].z + xb[j].w * xb[j].w; }
        const float ra = rsqrtf(wave_sum(sa) * (1.f / DM) + EPS), rb = rsqrtf(wave_sum(sb) * (1.f / DM) + EPS);
#pragma unroll
        for (int j = 0; j < 4; ++j) { const int c = (j * 64 + lane) * 4; const float4 g = *(const float4*)(p.norm_ffn + c);
            xa[j] = make_float4(xa[j].x * ra * g.x, xa[j].y * ra * g.y, xa[j].z * ra * g.z, xa[j].w * ra * g.w);
            xb[j] = make_float4(xb[j].x * rb * g.x, xb[j].y * rb * g.y, xb[j].z * rb * g.z, xb[j].w * rb * g.w);
            *(float4*)&xs[(w * 2) * XST + c] = xa[j]; *(float4*)&xs[(w * 2 + 1) * XST + c] = xb[j];
            *(unsigned*)((unsigned char*)p.XN2() + (size_t)row0 * DM + c) = pk4_fp8(xa[j].x, xa[j].y, xa[j].z, xa[j].w);
            *(unsigned*)((unsigned char*)p.XN2() + (size_t)(row0 + 1) * DM + c) = pk4_fp8(xb[j].x, xb[j].y, xb[j].z, xb[j].w); }
        __syncthreads();
        f32x4 acc0 = {0.f, 0.f, 0.f, 0.f}, acc1 = {0.f, 0.f, 0.f, 0.f};
        const float* xp = xs + l15 * XST + 128 * w + q4;
#pragma unroll
        for (int i = 0; i < 32; ++i) { const float a = xp[4 * i];
            acc0 = __builtin_amdgcn_mfma_f32_16x16x4f32(a, breg0[i], acc0, 0, 0, 0); acc1 = __builtin_amdgcn_mfma_f32_16x16x4f32(a, breg1[i], acc1, 0, 0, 0); }
#pragma unroll
        for (int r = 0; r < 4; ++r) { part[(w * 16 + 4 * q4 + r) * 32 + l15] = acc0[r]; part[(w * 16 + 4 * q4 + r) * 32 + 16 + l15] = acc1[r]; }
        __syncthreads();
        float val = mybias;
#pragma unroll
        for (int w8 = 0; w8 < 8; ++w8) val += part[(w8 * 16 + 2 * w + tsel) * 32 + te];
        int cnt = 0;
#pragma unroll
        for (int e = 0; e < 32; ++e) { const float v0 = __int_as_float(__builtin_amdgcn_readlane(__float_as_int(val), e)), v1 = __int_as_float(__builtin_amdgcn_readlane(__float_as_int(val), 32 + e));
            const float ve = tsel ? v1 : v0; cnt += (ve > val || (ve == val && e < te)) ? 1 : 0; }
        float* rc = rec + w * 16 + tsel * 8;
        if (cnt < 4) { rc[cnt * 2] = __int_as_float(te); rc[cnt * 2 + 1] = val; }
        asm volatile("s_waitcnt lgkmcnt(0)" ::: "memory");
        if (te == 0) {
            const int row = row0 + tsel, tl = nloc + w * 2 + tsel; float ex[4], sum = 0.f; int tx[4];
#pragma unroll
            for (int kk = 0; kk < 4; ++kk) { tx[kk] = __float_as_int(rc[kk * 2]); ex[kk] = __expf(rc[kk * 2 + 1] - rc[1]); sum += ex[kk]; }
            const float inv = 1.f / sum;
#pragma unroll
            for (int kk = 0; kk < 4; ++kk) { const int e = tx[kk]; p.TOPI()[row * 4 + kk] = e; p.TOPW()[row * 4 + kk] = ex[kk] * inv;
                const int lr = atomicAdd(&lcount[e], 1); ent[tl * 4 + kk] = (unsigned short)(e | (lr << 5)); }
        }
        asm volatile("s_waitcnt lgkmcnt(0)" ::: "memory");
    }
    __syncthreads();
    if (tid < 32) lbase[tid] = atomicAdd(&p.CNT()[tid * CNT_STRIDE], lcount[tid]);
    __syncthreads();
    for (int idx = tid; idx < nloc * 4; idx += MK_THREADS) { const int tl = idx >> 2, row = vcu * 16 + (tl >> 4) * G * 16 + (tl & 15); const unsigned en = ent[idx];
        p.RANK()[row * 4 + (idx & 3)] = lbase[en & 31] + (int)(en >> 5); }
    __syncthreads();
}
#undef RS_STEP
__device__ __forceinline__ void phase_scatter(const Params& p, char* lds, int vcu, int G) {
    int* ps = (int*)lds;
    __syncthreads();
    if (threadIdx.x == 0) { int s = 0; for (int e = 0; e < NEXP; ++e) { ps[e] = s; s += (p.CNT()[e * CNT_STRIDE] + 255) / 256 * 256; } }
    __syncthreads();
    for (int gid = vcu * MK_THREADS + threadIdx.x; gid < NT * 4; gid += G * MK_THREADS) { const int slot = ps[p.TOPI()[gid]] + p.RANK()[gid]; p.SLOTS()[gid] = slot; p.SLOT_TOK()[slot] = gid >> 2; }
    __syncthreads();
}
__device__ __forceinline__ void phase_combine(const Params& p, int vcu, int G, float* dst) {
    const int lane = threadIdx.x & 63, gw = vcu * 8 + (threadIdx.x >> 6), NGW = G * 8;
    for (int r = gw * 2; r < NT; r += NGW * 2) {
        int sl[8]; float tw[8];
#pragma unroll
        for (int q = 0; q < 8; ++q) { sl[q] = p.SLOTS()[r * 4 + q]; tw[q] = p.TOPW()[r * 4 + q]; }
        float4 v[8];
#pragma unroll
        for (int j = 0; j < 4; ++j) { v[j] = ntld_h1(p.H1() + (size_t)r * DM + (j * 64 + lane) * 4); v[4 + j] = ntld_h1(p.H1() + (size_t)(r + 1) * DM + (j * 64 + lane) * 4); }
        unsigned y[8][4];
#pragma unroll
        for (int q = 0; q < 8; ++q)
#pragma unroll
            for (int j = 0; j < 4; ++j) y[q][j] = __builtin_nontemporal_load((const unsigned*)((const unsigned char*)p.YB() + (size_t)sl[q] * DM + (j * 64 + lane) * 4));
#pragma unroll
        for (int q = 0; q < 8; ++q) { const float w = tw[q] * (1.f / YB_SCALE); const int o = (q >> 2) * 4;
#pragma unroll
            for (int j = 0; j < 4; ++j) { const f32x2 lo = __builtin_amdgcn_cvt_pk_f32_fp8((int)y[q][j], false), hi = __builtin_amdgcn_cvt_pk_f32_fp8((int)y[q][j], true);
                v[o + j].x += w * lo[0]; v[o + j].y += w * lo[1]; v[o + j].z += w * hi[0]; v[o + j].w += w * hi[1]; } }
        float sa = 0.f, sb = 0.f;
#pragma unroll
        for (int j = 0; j < 4; ++j) { sa += v[j].x * v[j].x + v[j].y * v[j].y + v[j].z * v[j].z + v[j].w * v[j].w; sb += v[4 + j].x * v[4 + j].x + v[4 + j].y * v[4 + j].y + v[4 + j].z * v[4 + j].z + v[4 + j].w * v[4 + j].w; }
        const float ra = rsqrtf(wave_sum(sa) * (1.f / DM) + EPS), rb = rsqrtf(wave_sum(sb) * (1.f / DM) + EPS);
#pragma unroll
        for (int j = 0; j < 4; ++j) { const int c = (j * 64 + lane) * 4; const float4 g = *(const float4*)(p.norm_final + c);
            *(float4*)(dst + (size_t)r * DM + c) = make_float4(v[j].x * ra * g.x, v[j].y * ra * g.y, v[j].z * ra * g.z, v[j].w * ra * g.w);
            *(float4*)(dst + (size_t)(r + 1) * DM + c) = make_float4(v[4 + j].x * rb * g.x, v[4 + j].y * rb * g.y, v[4 + j].z * rb * g.z, v[4 + j].w * rb * g.w); }
    }
}
__device__ __forceinline__ void phase_init_ctl(const Params& p, int vcu, int G) {
    if (vcu == 0) for (int i = threadIdx.x; i < NEXP * CNT_STRIDE; i += MK_THREADS) p.CNT()[i] = 0;
    for (int i = vcu * MK_THREADS + threadIdx.x; i < NSLOT; i += G * MK_THREADS) p.SLOT_TOK()[i] = -1;
}

#define XB_TMO      128
#define XB_XCNT(j)  (256  + 64 * (j))
#define XB_XSUB(j)  (1280 + 64 * (j))
#define XB_XGEN(j)  (2304 + 64 * (j))
#define XB_TOP      3328
#define XB_TOPGEN   3392
#define XCD_BAR_WORDS 3456
#define XB_SPIN_CAP (1u << 20)
__device__ __forceinline__ unsigned xb_ld(unsigned* p)              { return __hip_atomic_load(p, __ATOMIC_RELAXED, __HIP_MEMORY_SCOPE_AGENT); }
__device__ __forceinline__ unsigned xb_add(unsigned* p, unsigned v) { return __hip_atomic_fetch_add(p, v, __ATOMIC_RELAXED, __HIP_MEMORY_SCOPE_AGENT); }
__device__ __forceinline__ unsigned xb_xcc_id() { return (unsigned)__builtin_amdgcn_s_getreg((3 << 11) | 20) & 0xFu; }
#define XB_SPIN(cond, bar) do { unsigned _sp = 0; while (cond) { __builtin_amdgcn_s_sleep(1); \
    if ((++_sp & 255u) == 0u) { if (xb_ld(&(bar)[XB_TMO])) break; if (_sp > XB_SPIN_CAP) { atomicAdd(&(bar)[XB_TMO], 1u); break; } } } } while (0)
struct XcdBarrier { unsigned* bar; unsigned x; volatile LAS unsigned* st; };
__device__ __forceinline__ XcdBarrier xcd_barrier_post(unsigned* bar, volatile LAS unsigned* st) {
    XcdBarrier b; b.bar = bar; b.x = xb_xcc_id(); b.st = st;
    if (threadIdx.x == 0) (void)xb_add(&bar[XB_XCNT(b.x)], 1u);
    return b;
}
__device__ __forceinline__ void xcd_barrier_complete(unsigned* bar, unsigned x, unsigned& nloc, unsigned& nx) {
    const unsigned G = gridDim.x * gridDim.y * gridDim.z;
    unsigned sum, cnt, mine, sp = 0u;
    for (;;) {
        sum = 0u; cnt = 0u; mine = 0u;
#pragma unroll
        for (unsigned j = 0; j < 16; ++j) { const unsigned c = xb_ld(&bar[XB_XCNT(j)]); sum += c; cnt += (c > 0u) ? 1u : 0u; mine = (j == x) ? c : mine; }
        if (sum == G) break;
        __builtin_amdgcn_s_sleep(1);
        if ((++sp & 255u) == 0u) { if (xb_ld(&bar[XB_TMO])) break; if (sp > XB_SPIN_CAP) { atomicAdd(&bar[XB_TMO], 1u); break; } }
    }
    nloc = mine > 0u ? mine : 1u; nx = cnt > 0u ? cnt : 1u;
}
__device__ __forceinline__ void xcd_barrier(const XcdBarrier& b) {
    asm volatile("s_waitcnt vmcnt(0)" ::: "memory");
    __syncthreads();
    if (threadIdx.x == 0) {
        unsigned* bar = b.bar;
        __builtin_amdgcn_s_waitcnt(0);
        unsigned nloc = b.st[0], nx = b.st[1];
        if (nloc == 0u) { xcd_barrier_complete(bar, b.x, nloc, nx); b.st[0] = nloc; b.st[1] = nx; }
        const unsigned old = xb_add(&bar[XB_XSUB(b.x)], 1u);
        const unsigned gen = old / nloc;
        if (old + 1u == (gen + 1u) * nloc) {
            __builtin_amdgcn_fence(__ATOMIC_RELEASE, "agent");
            asm volatile("s_waitcnt vmcnt(0)" ::: "memory");
            const unsigned og = xb_add(&bar[XB_TOP], 1u);
            const unsigned tg = og / nx;
            if (og + 1u == (tg + 1u) * nx) xb_add(&bar[XB_TOPGEN], 1u);
            else XB_SPIN(xb_ld(&bar[XB_TOPGEN]) == tg, bar);
            __builtin_amdgcn_fence(__ATOMIC_ACQUIRE, "agent");
            xb_add(&bar[XB_XGEN(b.x)], 1u);
            asm volatile("s_waitcnt vmcnt(0)" ::: "memory");
        } else {
            XB_SPIN(xb_ld(&bar[XB_XGEN(b.x)]) == gen, bar);
            __builtin_amdgcn_fence(__ATOMIC_ACQUIRE, "agent");
            asm volatile("s_waitcnt vmcnt(0)" ::: "memory");
        }
    }
    __syncthreads();
}

struct MkArgs { Params p; int ph_lo, ph_hi, sub, pad; };
enum { PH_PRO = 0, PH_INPROJ = 1, PH_MSCAN = 2, PH_QPROJ = 3, PH_MOUT = 4, PH_ATTN = 5, PH_YM = 6, PH_YA = 7, PH_OUT = 8, PH_ROUTE = 9, PH_SCATTER = 10, PH_M1 = 11, PH_M2 = 12, PH_COMBINE = 13, PH_END = 14 };

__global__ void __launch_bounds__(MK_THREADS, 2) mk_fwd(MkArgs a) {
    extern __shared__ __attribute__((aligned(16))) unsigned char lds_raw[];
    LAS unsigned char* lds = (LAS unsigned char*)lds_raw;
    const Params& p = *(const Params*)__builtin_amdgcn_kernarg_segment_ptr();
    const int G = gridDim.x, bx = blockIdx.x;
    const int vcu = (G % 8 == 0) ? (bx % 8) * (G / 8) + bx / 8 : bx;
    cooperative_groups::grid_group grid = cooperative_groups::this_grid();
    const int lo = a.ph_lo, hi = a.ph_hi;
    volatile LAS unsigned* bst = (volatile LAS unsigned*)(lds + MK_LDS - 16);
    if (threadIdx.x < 4) bst[threadIdx.x] = 0u;
    __syncthreads();
    XcdBarrier xbar; xbar.bar = p.BAR(); xbar.x = 0; xbar.st = bst;
    if (hi - lo > 1) xbar = xcd_barrier_post(p.BAR(), bst);
#ifndef PHASE_MASK
#define PHASE_MASK 0xffffffffu
#endif
#define IN(k) (((PHASE_MASK >> (k)) & 1u) && lo <= (k) && (k) < hi)
#define SEAM(k) do { if (IN(k) && IN((k) + 1)) { if (a.sub == 0x7fffffff) grid.sync(); else xcd_barrier(xbar); } } while (0)
#ifndef PROBE_PHASE
#define PROBE_PHASE -1
#endif
#ifndef PROBE_REPS
#define PROBE_REPS 2
#endif
#define REPS(k) ((k) == PROBE_PHASE ? PROBE_REPS : 1)
    if (IN(PH_PRO)) for (int rep_ = 0; rep_ < REPS(PH_PRO); ++rep_) { if (rep_) xcd_barrier(xbar); phase_init_ctl(p, vcu, G); phase_prologue(p, lds, vcu, G, a.sub); } SEAM(PH_PRO);
    if (IN(PH_INPROJ)) for (int rep_ = 0; rep_ < REPS(PH_INPROJ); ++rep_) { if (rep_) xcd_barrier(xbar); { pg8::StaticOrderN<10> S; S.init(DM, G, bx, p.U(), p.WinT()); EpiInP<0> E{p}; pg8::gemm_phase<EpiInP<0>, pg8::StaticOrderN<10>>(lds, DM, DM, S, E); }
        { pg8::StaticOrderN<12> S; S.init(DM / 2, G, bx, p.U8(), p.WinT8()); EpiInP<1> E{p}; pg8::gemm_phase<EpiInP<1>, pg8::StaticOrderN<12>, true>(lds, DM / 2, DM / 2, S, E); } } SEAM(PH_INPROJ);
    if (IN(PH_MSCAN)) for (int rep_ = 0; rep_ < REPS(PH_MSCAN); ++rep_) { if (rep_) xcd_barrier(xbar);
        { const int half = (bx >> 3) & 1, idx = (bx & 7) * 16 + (bx >> 4);
            if (half == 0) { if (a.sub != 2) phase_mlstm_scan(p, (char*)lds_raw, idx, 128); }
            else if (a.sub != 1) { phase_kprep(p, idx, 128);
                asm volatile("s_waitcnt vmcnt(0)" ::: "memory"); __syncthreads();
                if (threadIdx.x == 0) { unsigned* cw = p.BAR() + 3584; __builtin_amdgcn_fence(__ATOMIC_RELEASE, "agent"); asm volatile("s_waitcnt vmcnt(0)" ::: "memory");
                    xb_add(cw, 1u); unsigned sp = 0; while (xb_ld(cw) < 128u * (unsigned)(rep_ + 1)) { __builtin_amdgcn_s_sleep(2); if (++sp > (1u << 22)) break; }
                    __builtin_amdgcn_fence(__ATOMIC_ACQUIRE, "agent"); asm volatile("s_waitcnt vmcnt(0)" ::: "memory"); }
                __syncthreads();
                pg8::StaticOrderN<6> S; S.init(256, 128, idx, p.CQb(), p.WqT()); EpiQ E{p}; pg8::gemm_phase<EpiQ, pg8::StaticOrderN<6>>(lds, 256, 256, S, E); } }
        } SEAM(PH_MSCAN);
    if (IN(PH_MOUT)) for (int rep_ = 0; rep_ < REPS(PH_MOUT); ++rep_) { if (rep_) xcd_barrier(xbar); phase_mlstm_out(p, (char*)lds_raw, vcu, G); }
    if (IN(PH_ATTN)) for (int rep_ = 0; rep_ < REPS(PH_ATTN); ++rep_) { if (rep_) xcd_barrier(xbar); phase_attn(p, (char*)lds_raw, vcu, G); } SEAM(PH_ATTN);
    if (IN(PH_YM)) for (int rep_ = 0; rep_ < REPS(PH_YM); ++rep_) { if (rep_) xcd_barrier(xbar); pg8::StaticOrderN<4> S; S.init(DM, G, bx, p.HM(), p.WmT()); EpiMix<0> E{p}; pg8::gemm_phase<EpiMix<0>, pg8::StaticOrderN<4>>(lds, DM, DM, S, E); }
    if (IN(PH_YA)) for (int rep_ = 0; rep_ < REPS(PH_YA); ++rep_) { if (rep_) xcd_barrier(xbar); pg8::StaticOrderN<4> S; S.init(DM, G, bx, p.OA(), p.WoT()); EpiMix<1> E{p}; pg8::gemm_phase<EpiMix<1>, pg8::StaticOrderN<4>>(lds, DM, DM, S, E); } SEAM(PH_YA);
    if (IN(PH_OUT)) for (int rep_ = 0; rep_ < REPS(PH_OUT); ++rep_) { if (rep_) xcd_barrier(xbar); pg8::StaticOrderN<4> S; S.init(DM, G, bx, p.MIX(), p.WoutT()); EpiOut E{p}; pg8::gemm_phase<EpiOut, pg8::StaticOrderN<4>>(lds, DM, DM, S, E); } SEAM(PH_OUT);
    if (IN(PH_ROUTE)) for (int rep_ = 0; rep_ < REPS(PH_ROUTE); ++rep_) { if (rep_) xcd_barrier(xbar); phase_route(p, (char*)lds_raw, vcu, G); } SEAM(PH_ROUTE);
    if (IN(PH_SCATTER)) for (int rep_ = 0; rep_ < REPS(PH_SCATTER); ++rep_) { if (rep_) xcd_barrier(xbar); phase_scatter(p, (char*)lds_raw, vcu, G); } SEAM(PH_SCATTER);
    if (IN(PH_M1)) for (int rep_ = 0; rep_ < REPS(PH_M1); ++rep_) { if (rep_) xcd_barrier(xbar); volatile LAS int* tst = (volatile LAS int*)(lds + MISC_OFF); moe_tile_table(p, tst);
        pg8::MoeOrder S; S.tstart = tst; S.npn = 8; S.G = G; S.c = bx; S.A = (const char*)p.XN2(); S.W = (const char*)p.W1T(); S.wexp = (size_t)2048 * DM; S.btile = (size_t)256 * DM;     S.rowidx = p.SLOT_TOK(); S.bias = p.b1; S.bsplit = 1;
        EpiM1 E{p}; pg8::gemm_phase<EpiM1, pg8::MoeOrder, true>(lds, DM / 2, DM / 2, S, E); } SEAM(PH_M1);
    if (IN(PH_M2)) for (int rep_ = 0; rep_ < REPS(PH_M2); ++rep_) { if (rep_) xcd_barrier(xbar); volatile LAS int* tst = (volatile LAS int*)(lds + MISC_OFF); moe_tile_table(p, tst);
        pg8::MoeOrder S; S.tstart = tst; S.npn = 4; S.G = G; S.c = bx; S.A = (const char*)p.ACT(); S.W = (const char*)p.W2T(); S.wexp = (size_t)DM * DFF; S.btile = (size_t)256 * DFF; S.rowidx = nullptr; S.bias = p.b2; S.bsplit = 0;
        EpiM2 E{p}; pg8::gemm_phase<EpiM2, pg8::MoeOrder, true>(lds, DFF / 2, DFF / 2, S, E); } SEAM(PH_M2);
    if (IN(PH_COMBINE)) for (int rep_ = 0; rep_ < REPS(PH_COMBINE); ++rep_) { if (rep_) xcd_barrier(xbar); phase_combine(p, vcu, G, a.sub ? (float*)p.ACT() : p.out); }
#undef IN
#undef SEAM
}

#ifndef ONE_LAUNCH
#define ONE_LAUNCH 1
#endif
#ifndef PROBE_DUP
#define PROBE_DUP -1
#endif
#ifndef PROBE_SUB
#define PROBE_SUB 0
#endif
#ifndef PROBE_DUP_N
#define PROBE_DUP_N 1
#endif
#ifndef FAST_INPROJ
#define FAST_INPROJ 1
#endif
#ifndef FAST_QPROJ
#define FAST_QPROJ 1
#endif
#ifndef FAST_MIX
#define FAST_MIX 1
#endif
#ifndef FAST_MOE
#define FAST_MOE 1
#endif
#ifndef FAST_ATTN
#define FAST_ATTN 1
#endif
#ifndef FAST_MLSTM
#define FAST_MLSTM 1
#endif
static void launch_mk(const Params& p, int lo, int hi, int grid, hipStream_t stream, int sub = 0) {
    MkArgs a{}; a.p = p; a.ph_lo = lo; a.ph_hi = hi; a.sub = sub;
    hipLaunchKernelGGL(mk_fwd, dim3(grid), dim3(MK_THREADS), MK_LDS, stream, a);
}
extern "C" void kernel_launch(void* const* d_in, const int* in_sizes, int n_in, void* d_out, int out_size, void* d_ws, size_t ws_size, hipStream_t stream) {
    static int ok = 0, grid = 0;
    if (!ok) {
        if (n_in != 22 || in_sizes[0] != NT * DM || out_size != NT * DM) { fprintf(stderr, "kernel_launch: unexpected shapes (n_in %d, x %d, out %d)\n", n_in, n_in > 0 ? in_sizes[0] : -1, out_size); return; }
        (void)hipFuncSetAttribute((const void*)k_mlstm_out, hipFuncAttributeMaxDynamicSharedMemorySize, MO_LDS);
        (void)hipFuncSetAttribute((const void*)mk_fwd, hipFuncAttributeMaxDynamicSharedMemorySize, MK_LDS);
        int dev = 0, cus = 0, per_cu = 0; (void)hipGetDevice(&dev); (void)hipDeviceGetAttribute(&cus, hipDeviceAttributeMultiprocessorCount, dev);
        (void)hipOccupancyMaxActiveBlocksPerMultiprocessor(&per_cu, (const void*)mk_fwd, MK_THREADS, MK_LDS);
        if (per_cu < 1) { fprintf(stderr, "kernel_launch: occupancy query says %d blocks/CU\n", per_cu); per_cu = 1; }
        if (cus != 256) { fprintf(stderr, "kernel_launch: built for a 256-CU device (got %d CUs)\n", cus); return; }
        grid = 256;
        ok = 1;
    }
    Params p{};
    const float** ins = (const float**)&p.x;
    for (int i = 0; i < 22; ++i) ins[i] = (const float*)d_in[i];
    p.out = (float*)d_out;
    p.ws = (char*)d_ws;
    if (WS_TOTAL > ws_size) { fprintf(stderr, "kernel_launch: workspace too small (%zu > %zu)\n", (size_t)WS_TOTAL, ws_size); return; }
    (void)hipMemsetAsync(p.BAR(), 0, 16384, stream);
#if ONE_LAUNCH
    { MkArgs a{}; a.p = p; a.ph_lo = 0; a.ph_hi = PH_END; void* args[] = {&a};
      hipError_t e = hipLaunchCooperativeKernel((const void*)mk_fwd, dim3(grid), dim3(MK_THREADS), args, MK_LDS, stream);
      if (e != hipSuccess) fprintf(stderr, "kernel_launch: cooperative launch failed: %s (grid %d)\n", hipGetErrorString(e), grid); }
#else
    for (int ph = 0; ph < PH_END; ++ph) { if (ph == PH_COMBINE && PROBE_DUP == PH_COMBINE) { launch_mk(p, ph, ph + 1, grid, stream, 1); launch_mk(p, ph, ph + 1, grid, stream, 0); continue; }
        launch_mk(p, ph, ph + 1, grid, stream);
        for (int d = 0; d < ((ph == PROBE_DUP) ? PROBE_DUP_N : 0); ++d) { if (ph == PH_ROUTE) (void)hipMemsetAsync(p.CNT(), 0, 4096, stream); launch_mk(p, ph, ph + 1, grid, stream, PROBE_SUB); } }
#endif
}
```

```cpp
#include <hip/hip_runtime.h>
#include <hip/hip_cooperative_groups.h>
#include <cstdio>
#include <cstdint>

typedef unsigned short bf16_t;
__device__ __forceinline__ float bf2f(bf16_t v) { return __uint_as_float(((unsigned)v) << 16); }
__device__ __forceinline__ bf16_t f2bf(float f) { unsigned u = __float_as_uint(f); return (bf16_t)((u + 0x7fffu + ((u >> 16) & 1u)) >> 16); }

constexpr int NB = 8, SEQ = 4096, NT = NB * SEQ, DM = 1024, NMETA = 16, LTOT = SEQ + NMETA;
constexpr int DIN = 5600;
constexpr int OFF_Q = 0, OFF_K = 512, OFF_V = 1024, OFF_O = 2048, OFF_I = 3072, OFF_F = 3088, OFF_CQ = 3104, OFF_CKV = 3360, OFF_KR = 3488, OFF_G = 3552;
constexpr int KVROWS = 4160;
constexpr int NEXP = 32, DFF = 1024;
constexpr int NSLOT = NT * 4 + NEXP * 256;
constexpr float EPS = 1e-6f;
constexpr int CNT_STRIDE = 16;
constexpr float QSCALE = 0.07216878364870322f * 1.4426950408889634f;

constexpr size_t ws_al(size_t x) { return (x + 255) & ~(size_t)255; }
constexpr size_t WS_BAR = 0;
constexpr size_t WS_CNT = WS_BAR + 16384;
constexpr size_t WS_SLOT_TOK = WS_CNT + ws_al(4096);
constexpr size_t WS_TOPI = WS_SLOT_TOK + ws_al((size_t)NSLOT*4);
constexpr size_t WS_TOPW = WS_TOPI + ws_al((size_t)NT*16);
constexpr size_t WS_RANK = WS_TOPW + ws_al((size_t)NT*16);
constexpr size_t WS_SLOTS = WS_RANK + ws_al((size_t)NT*16);
constexpr size_t WS_UM = WS_SLOTS + ws_al((size_t)NT*16);
constexpr size_t WS_ZM = WS_UM + ws_al((size_t)NMETA*DM*4);
constexpr size_t WS_ROPE = WS_ZM + ws_al((size_t)NMETA*DIN*4);
constexpr size_t WS_RSQ = WS_ROPE + ws_al((size_t)LTOT*64*4);
constexpr size_t WS_GI = WS_RSQ + ws_al((size_t)NT*4);
constexpr size_t WS_GF = WS_GI + ws_al((size_t)NT*64);
constexpr size_t WS_NF = WS_GF + ws_al((size_t)NT*64);
constexpr size_t WS_NB_ = WS_NF + ws_al((size_t)4096*256);
constexpr size_t WS_MF = WS_NB_ + ws_al((size_t)4096*256);
constexpr size_t WS_MB = WS_MF + ws_al((size_t)4096*4);
constexpr size_t WS_Kc = WS_MB + ws_al((size_t)4096*4);
constexpr size_t WS_WinT = WS_Kc + ws_al((size_t)NB*KVROWS*192*2);
constexpr size_t WS_WinT8 = WS_WinT + ws_al((size_t)5632*DM*2);
constexpr size_t WS_W1T = WS_WinT8 + ws_al((size_t)3072*DM);
constexpr size_t WS_W2T = WS_W1T + ws_al((size_t)NEXP*2048*DM*2);
constexpr size_t WS_WmT = WS_W2T + ws_al((size_t)NEXP*DM*DFF*2);
constexpr size_t WS_WoutT = WS_WmT + ws_al((size_t)DM*DM*2);
constexpr size_t WS_WoT = WS_WoutT + ws_al((size_t)DM*DM*2);
constexpr size_t WS_WqT = WS_WoT + ws_al((size_t)DM*DM*2);
constexpr size_t WS_CKV = WS_WqT + ws_al((size_t)1536*256*2);
constexpr size_t WS_KR = WS_CKV + ws_al((size_t)NT*128*4);
constexpr size_t WS_CQb = WS_KR + ws_al((size_t)NT*64*4);
constexpr size_t WS_GATE = WS_CQb + ws_al((size_t)NT*256*2);
constexpr size_t WS_WQF = WS_GATE + ws_al((size_t)NT*2048*2);
constexpr size_t WS_WOF = WS_WQF + ws_al((size_t)256*1536*4);
constexpr size_t WS_U = WS_WOF + ws_al((size_t)1024*1024*4);
constexpr size_t WS_Qm = WS_U + ws_al((size_t)NT*DM*2);
constexpr size_t WS_Km = WS_Qm + ws_al((size_t)NT*512*2);
constexpr size_t WS_Vm = WS_Km + ws_al((size_t)NT*512*2);
constexpr size_t WS_OG = WS_Vm + ws_al((size_t)NT*1024*2);
constexpr size_t WS_QP = WS_OG + ws_al((size_t)NT*1024*2);
constexpr size_t WS_CB = WS_QP + ws_al((size_t)NT*1536*2);
constexpr size_t WS_HM = WS_CB + ws_al((size_t)4096*8192*2);
constexpr size_t WS_OA = WS_HM + ws_al((size_t)NT*DM*2);
constexpr size_t WS_TOTAL = WS_OA + ws_al((size_t)NT*DM*2);
constexpr size_t WS_ACT = WS_U, WS_YB = WS_ACT + ws_al((size_t)NSLOT * DFF * 2), WS_MOE_END = WS_YB + ws_al((size_t)NSLOT * DM);
constexpr size_t WS_H1 = WS_OA;
constexpr size_t WS_U8 = WS_CB;
constexpr size_t WS_CF = WS_U, WS_MIX = WS_Qm, WS_XN2 = WS_HM, WS_CQ = WS_HM;
static_assert(WS_MOE_END <= WS_HM && WS_XN2 >= WS_MOE_END && WS_XN2 + (size_t)NT * DM <= WS_H1, "MoE overlay layout");
struct Params {
    const float *x, *meta, *norm_mix, *w_in, *m_b_i, *m_b_f, *m_norm, *w_m_proj, *a_w_uq, *a_w_ukv, *a_norm_q, *a_norm_kv, *w_a_proj, *w_out,
        *norm_ffn, *w_router, *b_router, *w1, *b1, *w2, *b2, *norm_final;
    float* out; char* ws;
    __host__ __device__ __forceinline__ int* CNT() const { return (int*)(ws + WS_CNT); }
    __host__ __device__ __forceinline__ unsigned* BAR() const { return (unsigned*)(ws + WS_BAR); }
    __host__ __device__ __forceinline__ unsigned char* WinT8() const { return (unsigned char*)(ws + WS_WinT8); }
    __host__ __device__ __forceinline__ unsigned char* U8() const { return (unsigned char*)(ws + WS_U8); }
    __host__ __device__ __forceinline__ int* SLOT_TOK() const { return (int*)(ws + WS_SLOT_TOK); }
    __host__ __device__ __forceinline__ int* TOPI() const { return (int*)(ws + WS_TOPI); }
    __host__ __device__ __forceinline__ float* TOPW() const { return (float*)(ws + WS_TOPW); }
    __host__ __device__ __forceinline__ int* RANK() const { return (int*)(ws + WS_RANK); }
    __host__ __device__ __forceinline__ int* SLOTS() const { return (int*)(ws + WS_SLOTS); }
    __host__ __device__ __forceinline__ float* UM() const { return (float*)(ws + WS_UM); }
    __host__ __device__ __forceinline__ float* ZM() const { return (float*)(ws + WS_ZM); }
    __host__ __device__ __forceinline__ float* ROPE() const { return (float*)(ws + WS_ROPE); }
    __host__ __device__ __forceinline__ float* RSQ() const { return (float*)(ws + WS_RSQ); }
    __host__ __device__ __forceinline__ float* GI() const { return (float*)(ws + WS_GI); }
    __host__ __device__ __forceinline__ float* GF() const { return (float*)(ws + WS_GF); }
    __host__ __device__ __forceinline__ float* NF() const { return (float*)(ws + WS_NF); }
    __host__ __device__ __forceinline__ float* NB_() const { return (float*)(ws + WS_NB_); }
    __host__ __device__ __forceinline__ float* MF() const { return (float*)(ws + WS_MF); }
    __host__ __device__ __forceinline__ float* MB() const { return (float*)(ws + WS_MB); }
    __host__ __device__ __forceinline__ bf16_t* Kc() const { return (bf16_t*)(ws + WS_Kc); }
    __host__ __device__ __forceinline__ bf16_t* WinT() const { return (bf16_t*)(ws + WS_WinT); }
    __host__ __device__ __forceinline__ bf16_t* W1T() const { return (bf16_t*)(ws + WS_W1T); }
    __host__ __device__ __forceinline__ bf16_t* W2T() const { return (bf16_t*)(ws + WS_W2T); }
    __host__ __device__ __forceinline__ bf16_t* WmT() const { return (bf16_t*)(ws + WS_WmT); }
    __host__ __device__ __forceinline__ bf16_t* WoutT() const { return (bf16_t*)(ws + WS_WoutT); }
    __host__ __device__ __forceinline__ bf16_t* WoT() const { return (bf16_t*)(ws + WS_WoT); }
    __host__ __device__ __forceinline__ bf16_t* WqT() const { return (bf16_t*)(ws + WS_WqT); }
    __host__ __device__ __forceinline__ float* CKV() const { return (float*)(ws + WS_CKV); }
    __host__ __device__ __forceinline__ float* KR() const { return (float*)(ws + WS_KR); }
    __host__ __device__ __forceinline__ bf16_t* CQb() const { return (bf16_t*)(ws + WS_CQb); }
    __host__ __device__ __forceinline__ bf16_t* GATE() const { return (bf16_t*)(ws + WS_GATE); }
    __host__ __device__ __forceinline__ float* WQF() const { return (float*)(ws + WS_WQF); }
    __host__ __device__ __forceinline__ float* WOF() const { return (float*)(ws + WS_WOF); }
    __host__ __device__ __forceinline__ bf16_t* U() const { return (bf16_t*)(ws + WS_U); }
    __host__ __device__ __forceinline__ bf16_t* Qm() const { return (bf16_t*)(ws + WS_Qm); }
    __host__ __device__ __forceinline__ bf16_t* Km() const { return (bf16_t*)(ws + WS_Km); }
    __host__ __device__ __forceinline__ bf16_t* Vm() const { return (bf16_t*)(ws + WS_Vm); }
    __host__ __device__ __forceinline__ bf16_t* OG() const { return (bf16_t*)(ws + WS_OG); }
    __host__ __device__ __forceinline__ bf16_t* QP() const { return (bf16_t*)(ws + WS_QP); }
    __host__ __device__ __forceinline__ bf16_t* CB() const { return (bf16_t*)(ws + WS_CB); }
    __host__ __device__ __forceinline__ bf16_t* HM() const { return (bf16_t*)(ws + WS_HM); }
    __host__ __device__ __forceinline__ bf16_t* OA() const { return (bf16_t*)(ws + WS_OA); }
    __host__ __device__ __forceinline__ bf16_t* H1() const { return (bf16_t*)(ws + WS_H1); }
    __host__ __device__ __forceinline__ bf16_t* ACT() const { return (bf16_t*)(ws + WS_ACT); }
    __host__ __device__ __forceinline__ bf16_t* YB() const { return (bf16_t*)(ws + WS_YB); }
    __host__ __device__ __forceinline__ bf16_t* CF() const { return (bf16_t*)(ws + WS_CF); }
    __host__ __device__ __forceinline__ bf16_t* MIX() const { return (bf16_t*)(ws + WS_MIX); }
    __host__ __device__ __forceinline__ bf16_t* XN2() const { return (bf16_t*)(ws + WS_XN2); }
    __host__ __device__ __forceinline__ float* CQ() const { return (float*)(ws + WS_CQ); }
};

__device__ __forceinline__ float wave_sum(float v) {
#pragma unroll
    for (int o = 1; o < 64; o <<= 1) v += __shfl_xor(v, o);
    return v;
}
__device__ __forceinline__ float sigmoidf_(float v) { return __builtin_amdgcn_rcpf(1.f + __expf(-v)); }
__device__ __forceinline__ float logsigmoidf_(float v) { return fminf(v, 0.f) - __logf(1.f + __expf(-fabsf(v))); }

__global__ void __launch_bounds__(256) k_prep_rows(Params p) {
    const int lane = threadIdx.x & 63, gw = (blockIdx.x * 256 + threadIdx.x) >> 6, ngw = (gridDim.x * 256) >> 6;
    for (int r = gw; r < NT + NMETA; r += ngw) {
        const float* src = r < NT ? p.x + (size_t)r * DM : p.meta + (size_t)(r - NT) * DM;
        float4 v[4]; float ss = 0.f;
#pragma unroll
        for (int j = 0; j < 4; ++j) { v[j] = *(const float4*)(src + (j * 64 + lane) * 4); ss += v[j].x * v[j].x + v[j].y * v[j].y + v[j].z * v[j].z + v[j].w * v[j].w; }
        const float rstd = rsqrtf(wave_sum(ss) * (1.f / DM) + EPS);
#pragma unroll
        for (int j = 0; j < 4; ++j) {
            const int c = (j * 64 + lane) * 4; const float4 g = *(const float4*)(p.norm_mix + c);
            const float a0 = v[j].x * rstd * g.x, a1 = v[j].y * rstd * g.y, a2 = v[j].z * rstd * g.z, a3 = v[j].w * rstd * g.w;
            if (r < NT) { bf16_t* d = p.U() + (size_t)r * DM + c; d[0] = f2bf(a0); d[1] = f2bf(a1); d[2] = f2bf(a2); d[3] = f2bf(a3); }
            else { float* d = p.UM() + (size_t)(r - NT) * DM + c; d[0] = a0; d[1] = a1; d[2] = a2; d[3] = a3; }
        }
    }
}

__global__ void __launch_bounds__(256) k_fold(Params p) {
    const long gid = (long)blockIdx.x * 256 + threadIdx.x, gn = (long)gridDim.x * 256;
    for (long i = gid; i < 256L * 1536; i += gn) {
        const int r = (int)(i / 1536), hc = (int)(i % 1536), h = hc / 192, c = hc % 192;
        const float* uq = p.a_w_uq + ((size_t)r * 8 + h) * 192; float acc;
        if (c >= 128) acc = uq[c];
        else { const float* kv = p.a_w_ukv + ((size_t)c * 8 + h) * 256; acc = 0.f; for (int d = 0; d < 128; ++d) acc += uq[d] * kv[d]; }
        p.WQF()[i] = acc;
    }
    for (long i = gid; i < 1024L * 1024; i += gn) {
        const int hc = (int)(i >> 10), n = (int)(i & 1023), h = hc >> 7, c = hc & 127;
        const float* kv = p.a_w_ukv + ((size_t)c * 8 + h) * 256 + 128; const float* ap = p.w_a_proj + (size_t)(h * 128) * DM + n;
        float acc = 0.f; for (int d = 0; d < 128; ++d) acc += kv[d] * ap[(size_t)d * DM];
        p.WOF()[i] = acc;
    }
    for (long i = gid; i < (long)LTOT * 32; i += gn) {
        const int pos = (int)(i >> 5), f = (int)(i & 31);
        const float freq = powf(10000.f, -(float)f / 32.f), ang = (float)pos * freq; float s, c; sincosf(ang, &s, &c);
        p.ROPE()[i * 2] = c; p.ROPE()[i * 2 + 1] = s;
    }
}

__global__ void __launch_bounds__(256) k_meta_proj(Params p) {
    const int gid = blockIdx.x * 256 + threadIdx.x;
    if (gid >= NMETA * DIN) return;
    const int j = gid / DIN, n = gid % DIN; const float* u = p.UM() + (size_t)j * DM; float acc = 0.f;
    for (int k = 0; k < DM; ++k) acc += u[k] * p.w_in[(size_t)k * DIN + n];
    p.ZM()[gid] = acc;
}

template <class P> __global__ void __launch_bounds__(256) k_sgemm(P q) {
    __shared__ float As[16][68]; __shared__ float Bs[16][68];
    const int ntn = (q.N + 63) / 64, ntm = q.M / 64, tid = threadIdx.x, tx = tid & 15, ty = tid >> 4;
    for (int tile = blockIdx.x; tile < ntm * ntn; tile += gridDim.x) {
        const int tm = tile / ntn, tn = tile % ntn; int ctx = 0;
        if (!q.setup(tm, ctx)) continue;
        float acc[4][4];
#pragma unroll
        for (int i = 0; i < 4; ++i)
#pragma unroll
            for (int j = 0; j < 4; ++j) acc[i][j] = 0.f;
        const int arow = tm * 64 + (tid >> 2), ak = (tid & 3) * 4, bk = tid >> 4, bcol = tn * 64 + (tid & 15) * 4;
        for (int k0 = 0; k0 < q.K; k0 += 16) {
            const float4 av = q.a4(ctx, arow, k0 + ak);
            const float4 bv = bcol < q.N ? q.b4(ctx, k0 + bk, bcol) : make_float4(0.f, 0.f, 0.f, 0.f);
            __syncthreads();
            As[ak + 0][tid >> 2] = av.x; As[ak + 1][tid >> 2] = av.y; As[ak + 2][tid >> 2] = av.z; As[ak + 3][tid >> 2] = av.w;
            *(float4*)&Bs[bk][(tid & 15) * 4] = bv;
            __syncthreads();
#pragma unroll
            for (int kk = 0; kk < 16; ++kk) {
                const float4 a = *(const float4*)&As[kk][ty * 4]; const float4 b = *(const float4*)&Bs[kk][tx * 4];
                const float aa[4] = {a.x, a.y, a.z, a.w}, bb[4] = {b.x, b.y, b.z, b.w};
#pragma unroll
                for (int i = 0; i < 4; ++i)
#pragma unroll
                    for (int j = 0; j < 4; ++j) acc[i][j] += aa[i] * bb[j];
            }
        }
        const int col = tn * 64 + tx * 4;
        if (col < q.N) {
#pragma unroll
            for (int i = 0; i < 4; ++i) q.epi(ctx, tm * 64 + ty * 4 + i, col, acc[i]);
        }
    }
}
__device__ __forceinline__ float4 ld_bf4(const bf16_t* p) { const uint2 w = *(const uint2*)p; return make_float4(__uint_as_float(w.x << 16), __uint_as_float(w.x & 0xffff0000u), __uint_as_float(w.y << 16), __uint_as_float(w.y & 0xffff0000u)); }

struct ProbIn {
    Params p; int M, N, K, pad;
    __device__ bool setup(int, int&) const { return true; }
    __device__ float4 a4(int, int row, int k) const { return ld_bf4(p.U() + (size_t)row * DM + k); }
    __device__ float4 b4(int, int k, int col) const { return *(const float4*)(p.w_in + (size_t)k * DIN + col); }
    __device__ void epi(int, int row, int col, const float (&v)[4]) const {
#pragma unroll
        for (int j = 0; j < 4; ++j) {
            const int c = col + j; const float z = v[j];
            if (c < OFF_K) p.Qm()[(size_t)row * 512 + c] = f2bf(z * 0.125f);
            else if (c < OFF_V) p.Km()[(size_t)row * 512 + (c - OFF_K)] = f2bf(z);
            else if (c < OFF_O) p.Vm()[(size_t)row * 1024 + (c - OFF_V)] = f2bf(z);
            else if (c < OFF_I) p.OG()[(size_t)row * 1024 + (c - OFF_O)] = f2bf(sigmoidf_(z));
            else if (c < OFF_F) p.GI()[(size_t)row * 16 + (c - OFF_I)] = z + p.m_b_i[c - OFF_I];
            else if (c < OFF_CQ) p.GF()[(size_t)row * 16 + (c - OFF_F)] = logsigmoidf_(z + p.m_b_f[c - OFF_F]);
            else if (c < OFF_CKV) p.CQ()[(size_t)row * 256 + (c - OFF_CQ)] = z;
            else if (c < OFF_KR) p.CKV()[(size_t)row * 128 + (c - OFF_CKV)] = z;
            else if (c < OFF_G) p.KR()[(size_t)row * 64 + (c - OFF_KR)] = z;
            else p.GATE()[(size_t)row * 2048 + (c - OFF_G)] = f2bf(sigmoidf_(z));
        }
    }
};

__global__ void __launch_bounds__(256) k_kprep(Params p) {
    const int lane = threadIdx.x & 63, gw = (blockIdx.x * 256 + threadIdx.x) >> 6, ngw = (gridDim.x * 256) >> 6;
    for (int i = gw; i < NB * KVROWS; i += ngw) {
        const int b = i / KVROWS, key = i % KVROWS; bf16_t* dst = p.Kc() + (size_t)i * 192;
        if (key >= LTOT) { dst[lane] = 0; dst[64 + lane] = 0; dst[128 + lane] = 0; continue; }
        const float *ckv, *kr; int pos;
        if (key < SEQ) { const size_t r = (size_t)b * SEQ + key; ckv = p.CKV() + r * 128; kr = p.KR() + r * 64; pos = NMETA + key; }
        else { const int j = key - SEQ; ckv = p.ZM() + (size_t)j * DIN + OFF_CKV; kr = p.ZM() + (size_t)j * DIN + OFF_KR; pos = j; }
        const float c0 = ckv[lane], c1 = ckv[64 + lane];
        const float rstd = rsqrtf(wave_sum(c0 * c0 + c1 * c1) * (1.f / 128.f) + EPS);
        dst[lane] = f2bf(c0 * rstd * p.a_norm_kv[lane]); dst[64 + lane] = f2bf(c1 * rstd * p.a_norm_kv[64 + lane]);
        if (lane < 32) {
            const float x1 = kr[lane], x2 = kr[32 + lane], cs = p.ROPE()[((size_t)pos * 32 + lane) * 2], sn = p.ROPE()[((size_t)pos * 32 + lane) * 2 + 1];
            dst[128 + lane] = f2bf(x1 * cs - x2 * sn); dst[160 + lane] = f2bf(x1 * sn + x2 * cs);
        }
    }
    for (int r = gw; r < NT; r += ngw) {
        float* cq = p.CQ() + (size_t)r * 256; float v[4]; float ss = 0.f;
#pragma unroll
        for (int j = 0; j < 4; ++j) { v[j] = cq[j * 64 + lane]; ss += v[j] * v[j]; }
        const float rstd = rsqrtf(wave_sum(ss) * (1.f / 256.f) + EPS);
#pragma unroll
        for (int j = 0; j < 4; ++j) cq[j * 64 + lane] = v[j] * rstd * p.a_norm_q[j * 64 + lane];
    }
}

struct ProbQ {
    Params p; int M, N, K, pad;
    __device__ bool setup(int, int&) const { return true; }
    __device__ float4 a4(int, int row, int k) const { return *(const float4*)(p.CQ() + (size_t)row * 256 + k); }
    __device__ float4 b4(int, int k, int col) const { return *(const float4*)(p.WQF() + (size_t)k * 1536 + col); }
    __device__ void epi(int, int row, int col, const float (&v)[4]) const {
        const int h = col / 192, c = col % 192;
        if (c < 128) {
#pragma unroll
            for (int j = 0; j < 4; ++j) p.QP()[(size_t)row * 1536 + col + j] = f2bf(v[j] * QSCALE);
        } else {
#pragma unroll
            for (int j = 0; j < 4; ++j) p.QP()[(size_t)row * 1536 + col + j] = f2bf(v[j] * QSCALE);
        }
        (void)h;
    }
};
__global__ void __launch_bounds__(256) k_rope_q(Params p) {
    const long gid = (long)blockIdx.x * 256 + threadIdx.x;
    if (gid >= (long)NT * 8 * 32) return;
    const int i = (int)(gid & 31), h = (int)((gid >> 5) & 7); const long r = gid >> 8; const int pos = NMETA + (int)(r % SEQ);
    bf16_t* q = p.QP() + (size_t)r * 1536 + h * 192 + 128;
    const float x1 = bf2f(q[i]), x2 = bf2f(q[32 + i]), cs = p.ROPE()[((size_t)pos * 32 + i) * 2], sn = p.ROPE()[((size_t)pos * 32 + i) * 2 + 1];
    q[i] = f2bf(x1 * cs - x2 * sn); q[32 + i] = f2bf(x1 * sn + x2 * cs);
}

__global__ void __launch_bounds__(256) k_mlstm_scan(Params p) {
    __shared__ float ks[64][65]; __shared__ float vs[64][128]; __shared__ float wk[64]; __shared__ float li[64], lf[64]; __shared__ float sc[2];
    const int tid = threadIdx.x, b = blockIdx.x >> 4, h = (blockIdx.x >> 1) & 7, dir = blockIdx.x & 1;
    const int d = tid >> 2, vq = tid & 3;
    float C[32]; float n = 0.f, m = 0.f;
#pragma unroll
    for (int i = 0; i < 32; ++i) C[i] = 0.f;
    bf16_t* CS = dir ? p.CB() : p.CF(); float* NS = dir ? p.NB_() : p.NF(); float* MS = dir ? p.MB() : p.MF();
    const int nsteps = dir ? 64 : 65;
    for (int st = 0; st < nsteps; ++st) {
        const int c = dir ? 63 - st : st - 1;
        if (c >= 0) {
            const size_t sidx = ((size_t)(b * 8 + h) * 64 + c);
            bf16_t* cd = CS + sidx * 8192 + d * 128 + vq * 32;
#pragma unroll
            for (int i = 0; i < 32; ++i) cd[i] = f2bf(C[i]);
            if (vq == 0) NS[sidx * 64 + d] = n;
            if (tid == 0) MS[sidx] = m;
            if ((dir == 0 && c == 63) || (dir == 1 && c == 0)) break;
        }
        const int npos = c < 0 ? NMETA : 64;
        __syncthreads();
        for (int e = tid; e < 64 * 64; e += 256) { const int j = e >> 6, dd = e & 63; float v = 0.f;
            if (j < npos) { if (c < 0) v = p.ZM()[(size_t)j * DIN + OFF_K + h * 64 + dd]; else { const int t = dir ? 63 - j : j; v = bf2f(p.Km()[((size_t)b * SEQ + c * 64 + t) * 512 + h * 64 + dd]); } }
            ks[j][dd] = v; }
        for (int e = tid; e < 64 * 128; e += 256) { const int j = e >> 7, dd = e & 127; float v = 0.f;
            if (j < npos) { if (c < 0) v = p.ZM()[(size_t)j * DIN + OFF_V + h * 128 + dd]; else { const int t = dir ? 63 - j : j; v = bf2f(p.Vm()[((size_t)b * SEQ + c * 64 + t) * 1024 + h * 128 + dd]); } }
            vs[j][dd] = v; }
        if (tid < 64) { float a = -1e30f, f = 0.f; const int j = tid;
            if (j < npos) { if (c < 0) { a = p.ZM()[(size_t)j * DIN + OFF_I + h] + p.m_b_i[h]; f = logsigmoidf_(p.ZM()[(size_t)j * DIN + OFF_F + h] + p.m_b_f[h]); }
                            else { const int t = dir ? 63 - j : j; const size_t r = (size_t)b * SEQ + c * 64 + t; a = p.GI()[r * 16 + dir * 8 + h]; f = p.GF()[r * 16 + dir * 8 + h]; } }
            li[j] = a; lf[j] = f; }
        __syncthreads();
        if (tid == 0) {
            float bl = 0.f; for (int j = 0; j < npos; ++j) bl += lf[j];
            float bc = 0.f, gmax = -1e30f;
            for (int j = 0; j < npos; ++j) { bc += lf[j]; const float g = bl - bc + li[j]; wk[j] = g; gmax = fmaxf(gmax, g); }
            const float mnew = fmaxf(bl + m, gmax);
            for (int j = 0; j < 64; ++j) wk[j] = j < npos ? __expf(wk[j] - mnew) : 0.f;
            sc[0] = __expf(bl + m - mnew); sc[1] = mnew;
        }
        __syncthreads();
        const float decay = sc[0]; m = sc[1];
#pragma unroll
        for (int i = 0; i < 32; ++i) C[i] *= decay;
        n *= decay;
        for (int j = 0; j < npos; ++j) { const float kw = wk[j] * ks[j][d]; n += kw;
#pragma unroll
            for (int i = 0; i < 32; ++i) C[i] += kw * vs[j][vq * 32 + i]; }
    }
}

constexpr int MO_LDS = (64 * 65 * 3 + 64 * 128 * 2 + 64 * 8) * 4;
__global__ void __launch_bounds__(256) k_mlstm_out(Params p) {
    extern __shared__ __attribute__((aligned(16))) float sm[];
    float (*qs)[65] = (float (*)[65])sm; float (*ks)[65] = (float (*)[65])(sm + 64 * 65); float (*Ws)[65] = (float (*)[65])(sm + 2 * 64 * 65);
    float (*vs)[128] = (float (*)[128])(sm + 3 * 64 * 65); float (*Cs)[128] = (float (*)[128])(sm + 3 * 64 * 65 + 64 * 128);
    float* sx = sm + 3 * 64 * 65 + 2 * 64 * 128; float *li = sx, *lf = sx + 64, *bt = sx + 128, *mt = sx + 192, *as = sx + 256, *ns = sx + 320, *msc = sx + 384;
    const int tid = threadIdx.x, c = blockIdx.x & 63, h = (blockIdx.x >> 6) & 7, b = blockIdx.x >> 9;
    const int t = tid >> 2, vq = tid & 3; const size_t r0 = (size_t)b * SEQ + c * 64;
    for (int e = tid; e < 64 * 64; e += 256) { const int j = e >> 6, dd = e & 63; qs[j][dd] = bf2f(p.Qm()[(r0 + j) * 512 + h * 64 + dd]); ks[j][dd] = bf2f(p.Km()[(r0 + j) * 512 + h * 64 + dd]); }
    for (int e = tid; e < 64 * 128; e += 256) { const int j = e >> 7, dd = e & 127; vs[j][dd] = bf2f(p.Vm()[(r0 + j) * 1024 + h * 128 + dd]); }
    __syncthreads();
    float S[16];
#pragma unroll
    for (int i = 0; i < 16; ++i) { const int s = vq * 16 + i; float a = 0.f;
#pragma unroll 4
        for (int dd = 0; dd < 64; ++dd) a += qs[t][dd] * ks[s][dd]; S[i] = a; }
    float hacc[32];
#pragma unroll
    for (int i = 0; i < 32; ++i) hacc[i] = 0.f;
#pragma unroll 1
    for (int dir = 0; dir < 2; ++dir) {
        const size_t sidx = ((size_t)(b * 8 + h) * 64 + c);
        const bf16_t* CS = (dir ? p.CB() : p.CF()) + sidx * 8192; const float* NS = (dir ? p.NB_() : p.NF()) + sidx * 64; const float* MS = (dir ? p.MB() : p.MF()) + sidx;
        __syncthreads();
        for (int e = tid; e < 64 * 128; e += 256) Cs[e >> 7][e & 127] = bf2f(CS[e]);
        if (tid < 64) { ns[tid] = NS[tid]; li[tid] = p.GI()[(r0 + tid) * 16 + dir * 8 + h]; lf[tid] = p.GF()[(r0 + tid) * 16 + dir * 8 + h]; }
        if (tid == 0) msc[0] = MS[0];
        __syncthreads();
        if (tid == 0) {
            const float m = msc[0]; float bc = 0.f, pm = -1e30f;
            if (dir == 0) { for (int j = 0; j < 64; ++j) { bc += lf[j]; const float a = li[j] - bc; as[j] = a; pm = fmaxf(pm, a); bt[j] = bc; mt[j] = fmaxf(bc + m, bc + pm); } }
            else { for (int j = 63; j >= 0; --j) { bc += lf[j]; const float a = li[j] - bc; as[j] = a; pm = fmaxf(pm, a); bt[j] = bc; mt[j] = fmaxf(bc + m, bc + pm); } }
        }
        __syncthreads();
        const float m = msc[0], b_t = bt[t], m_t = mt[t];
#pragma unroll
        for (int i = 0; i < 16; ++i) { const int s = vq * 16 + i; const bool valid = dir ? (s >= t) : (s <= t); Ws[t][s] = valid ? __expf(b_t + as[s] - m_t) * S[i] : 0.f; }
        __syncthreads();
        const float s_inter = __expf(b_t + m - m_t);
        float num[32]; float den = 0.f, qn = 0.f;
#pragma unroll
        for (int i = 0; i < 32; ++i) num[i] = 0.f;
#pragma unroll 2
        for (int dd = 0; dd < 64; ++dd) { const float qv = qs[t][dd]; qn += qv * ns[dd];
#pragma unroll
            for (int i = 0; i < 32; ++i) num[i] += qv * Cs[dd][vq * 32 + i]; }
#pragma unroll
        for (int i = 0; i < 32; ++i) num[i] *= s_inter;
        den = s_inter * qn;
#pragma unroll 2
        for (int s = 0; s < 64; ++s) { const float w = Ws[t][s]; den += w;
#pragma unroll
            for (int i = 0; i < 32; ++i) num[i] += w * vs[s][vq * 32 + i]; }
        const float inv = 1.f / fmaxf(fabsf(den), __expf(-m_t));
#pragma unroll
        for (int i = 0; i < 32; ++i) hacc[i] += num[i] * inv;
    }
    float ss = 0.f;
#pragma unroll
    for (int i = 0; i < 32; ++i) ss += hacc[i] * hacc[i];
    ss += __shfl_xor(ss, 1); ss += __shfl_xor(ss, 2);
    const float rstd = rsqrtf(ss * (1.f / 128.f) + EPS);
#pragma unroll
    for (int i = 0; i < 32; ++i) { const int col = h * 128 + vq * 32 + i; const size_t o = (r0 + t) * 1024 + col;
        p.HM()[o] = f2bf(hacc[i] * rstd * p.m_norm[col] * bf2f(p.OG()[o])); }
}

__global__ void __launch_bounds__(256) k_attn(Params p) {
    __shared__ float kt[32][192];
    const int tid = threadIdx.x, qi = tid >> 2, sl = tid & 3, qb = blockIdx.x & 63, h = (blockIdx.x >> 6) & 7, b = blockIdx.x >> 9;
    const size_t r = (size_t)b * SEQ + qb * 64 + qi;
    float q[48], o[32]; float m = -1e30f, l = 0.f;
#pragma unroll
    for (int i = 0; i < 48; ++i) q[i] = bf2f(p.QP()[r * 1536 + h * 192 + i * 4 + sl]);
#pragma unroll
    for (int i = 0; i < 32; ++i) o[i] = 0.f;
    const bf16_t* Kb = p.Kc() + (size_t)b * KVROWS * 192;
#pragma unroll 1
    for (int tile = 0; tile < KVROWS / 32; ++tile) {
        __syncthreads();
        for (int e = tid; e < 32 * 192; e += 256) kt[e / 192][e % 192] = bf2f(Kb[(size_t)tile * 32 * 192 + e]);
        __syncthreads();
#pragma unroll 1
        for (int g = 0; g < 4; ++g) {
            float s[8]; float tmax = -1e30f;
#pragma unroll
            for (int j = 0; j < 8; ++j) { float a = 0.f; const float* kr = &kt[g * 8 + j][sl];
#pragma unroll
                for (int i = 0; i < 48; ++i) a += q[i] * kr[i * 4];
                a += __shfl_xor(a, 1); a += __shfl_xor(a, 2);
                if (tile * 32 + g * 8 + j >= LTOT) a = -1e30f;
                s[j] = a; tmax = fmaxf(tmax, a); }
            const float mn = fmaxf(m, tmax), alpha = exp2f(m - mn); m = mn; l *= alpha;
#pragma unroll
            for (int i = 0; i < 32; ++i) o[i] *= alpha;
#pragma unroll
            for (int j = 0; j < 8; ++j) { const float pj = (tile * 32 + g * 8 + j >= LTOT) ? 0.f : exp2f(s[j] - mn); l += pj; const float* kr = &kt[g * 8 + j][sl];
#pragma unroll
                for (int i = 0; i < 32; ++i) o[i] += pj * kr[i * 4]; }
        }
    }
    const float inv = 1.f / l;
#pragma unroll
    for (int i = 0; i < 32; ++i) p.OA()[r * 1024 + h * 128 + i * 4 + sl] = f2bf(o[i] * inv);
}

struct ProbYm {
    Params p; int M, N, K, pad;
    __device__ bool setup(int, int&) const { return true; }
    __device__ float4 a4(int, int row, int k) const { return ld_bf4(p.HM() + (size_t)row * DM + k); }
    __device__ float4 b4(int, int k, int col) const { return *(const float4*)(p.w_m_proj + (size_t)k * DM + col); }
    __device__ void epi(int, int row, int col, const float (&v)[4]) const {
#pragma unroll
        for (int j = 0; j < 4; ++j) p.MIX()[(size_t)row * DM + col + j] = f2bf(v[j] * bf2f(p.GATE()[(size_t)row * 2048 + col + j]));
    }
};
struct ProbYa {
    Params p; int M, N, K, pad;
    __device__ bool setup(int, int&) const { return true; }
    __device__ float4 a4(int, int row, int k) const { return ld_bf4(p.OA() + (size_t)row * DM + k); }
    __device__ float4 b4(int, int k, int col) const { return *(const float4*)(p.WOF() + (size_t)k * DM + col); }
    __device__ void epi(int, int row, int col, const float (&v)[4]) const {
#pragma unroll
        for (int j = 0; j < 4; ++j) { const size_t o = (size_t)row * DM + col + j; p.MIX()[o] = f2bf(bf2f(p.MIX()[o]) + v[j] * bf2f(p.GATE()[(size_t)row * 2048 + 1024 + col + j])); }
    }
};
struct ProbOut {
    Params p; int M, N, K, pad;
    __device__ bool setup(int, int&) const { return true; }
    __device__ float4 a4(int, int row, int k) const { return ld_bf4(p.MIX() + (size_t)row * DM + k); }
    __device__ float4 b4(int, int k, int col) const { return *(const float4*)(p.w_out + (size_t)k * DM + col); }
    __device__ void epi(int, int row, int col, const float (&v)[4]) const {
        const float4 xv = *(const float4*)(p.x + (size_t)row * DM + col);
        *(float4*)(p.out + (size_t)row * DM + col) = make_float4(xv.x + v[0], xv.y + v[1], xv.z + v[2], xv.w + v[3]);
    }
};

__global__ void __launch_bounds__(256) k_route(Params p) {
    __shared__ float xn[8][1024];
    const int tid = threadIdx.x, lane = tid & 63, w = tid >> 6;
    for (int base = blockIdx.x * 8; base < NT; base += gridDim.x * 8) {
        __syncthreads();
        for (int rr = 0; rr < 2; ++rr) {
            const int row = base + w * 2 + rr; const float* src = p.out + (size_t)row * DM;
            float4 v[4]; float ss = 0.f;
#pragma unroll
            for (int j = 0; j < 4; ++j) { v[j] = *(const float4*)(src + (j * 64 + lane) * 4); ss += v[j].x * v[j].x + v[j].y * v[j].y + v[j].z * v[j].z + v[j].w * v[j].w; }
            const float rstd = rsqrtf(wave_sum(ss) * (1.f / DM) + EPS);
#pragma unroll
            for (int j = 0; j < 4; ++j) { const int c = (j * 64 + lane) * 4; const float4 g = *(const float4*)(p.norm_ffn + c);
                const float a0 = v[j].x * rstd * g.x, a1 = v[j].y * rstd * g.y, a2 = v[j].z * rstd * g.z, a3 = v[j].w * rstd * g.w;
                float* d = &xn[w * 2 + rr][c]; d[0] = a0; d[1] = a1; d[2] = a2; d[3] = a3;
                bf16_t* o = p.XN2() + (size_t)row * DM + c; o[0] = f2bf(a0); o[1] = f2bf(a1); o[2] = f2bf(a2); o[3] = f2bf(a3); }
        }
        __syncthreads();
        const int rloc = w * 2 + (lane >> 5), e = lane & 31, row = base + rloc;
        float acc = p.b_router[e];
        for (int k = 0; k < DM; ++k) acc += xn[rloc][k] * p.w_router[(size_t)k * NEXP + e];
        float val = acc; int ti[4]; float tv[4];
#pragma unroll
        for (int kk = 0; kk < 4; ++kk) {
            float best = val; int bi = e;
#pragma unroll
            for (int o = 1; o < 32; o <<= 1) { const float ov = __shfl_xor(best, o); const int oi = __shfl_xor(bi, o); if (ov > best || (ov == best && oi < bi)) { best = ov; bi = oi; } }
            ti[kk] = bi; tv[kk] = best; if (e == bi) val = -3.0e38f;
        }
        if (e == 0) {
            const float mx = tv[0]; float ex[4], sum = 0.f;
#pragma unroll
            for (int kk = 0; kk < 4; ++kk) { ex[kk] = __expf(tv[kk] - mx); sum += ex[kk]; }
#pragma unroll
            for (int kk = 0; kk < 4; ++kk) { p.TOPI()[row * 4 + kk] = ti[kk]; p.TOPW()[row * 4 + kk] = ex[kk] / sum; p.RANK()[row * 4 + kk] = atomicAdd(&p.CNT()[ti[kk] * CNT_STRIDE], 1); }
        }
    }
}
__device__ __forceinline__ int expert_pstart(const int* cnt, int e) { int s = 0; for (int i = 0; i < e; ++i) s += (cnt[i * CNT_STRIDE] + 255) / 256 * 256; return s; }
__global__ void __launch_bounds__(256) k_scatter(Params p) {
    __shared__ int ps[NEXP];
    if (threadIdx.x < NEXP) ps[threadIdx.x] = expert_pstart(p.CNT(), threadIdx.x);
    __syncthreads();
    const int gid = blockIdx.x * 256 + threadIdx.x; if (gid >= NT * 4) return;
    const int slot = ps[p.TOPI()[gid]] + p.RANK()[gid]; p.SLOTS()[gid] = slot; p.SLOT_TOK()[slot] = gid >> 2;
}

struct ProbM1 {
    Params p; int M, N, K, pad;
    __device__ bool setup(int tm, int& e) const {
        int s = 0; e = -1;
        for (int i = 0; i < NEXP; ++i) { const int pc = (p.CNT()[i * CNT_STRIDE] + 255) / 256 * 256; if (tm * 64 < s + pc) { e = i; break; } s += pc; }
        return e >= 0;
    }
    __device__ float4 a4(int, int row, int k) const { const int tok = p.SLOT_TOK()[row]; return tok < 0 ? make_float4(0.f, 0.f, 0.f, 0.f) : ld_bf4(p.XN2() + (size_t)tok * DM + k); }
    __device__ float4 b4(int e, int k, int col) const { const float* w = p.w1 + ((size_t)e * DM + k) * 2048 + (col >> 1); const float2 g = *(const float2*)w, l = *(const float2*)(w + 1024); return make_float4(g.x, l.x, g.y, l.y); }
    __device__ void epi(int e, int row, int col, const float (&v)[4]) const {
#pragma unroll
        for (int j = 0; j < 2; ++j) { const int c = (col >> 1) + j; const float g0 = v[2 * j] + p.b1[(size_t)e * 2048 + c], l0 = v[2 * j + 1] + p.b1[(size_t)e * 2048 + 1024 + c];
            const float glu = fminf(g0, 7.f), lin = fminf(fmaxf(l0, -7.f), 7.f);
            p.ACT()[(size_t)row * DFF + c] = f2bf(glu * sigmoidf_(1.702f * glu) * (lin + 1.f)); }
    }
};
struct ProbM2 {
    Params p; int M, N, K, pad;
    __device__ bool setup(int tm, int& e) const {
        int s = 0; e = -1;
        for (int i = 0; i < NEXP; ++i) { const int pc = (p.CNT()[i * CNT_STRIDE] + 255) / 256 * 256; if (tm * 64 < s + pc) { e = i; break; } s += pc; }
        return e >= 0;
    }
    __device__ float4 a4(int, int row, int k) const { return ld_bf4(p.ACT() + (size_t)row * DFF + k); }
    __device__ float4 b4(int e, int k, int col) const { return *(const float4*)(p.w2 + ((size_t)e * DFF + k) * DM + col); }
    __device__ void epi(int e, int row, int col, const float (&v)[4]) const {
#pragma unroll
        for (int j = 0; j < 4; ++j) p.YB()[(size_t)row * DM + col + j] = f2bf(v[j] + p.b2[(size_t)e * DM + col + j]);
    }
};

__global__ void __launch_bounds__(256) k_combine(Params p) {
    const int lane = threadIdx.x & 63, gw = (blockIdx.x * 256 + threadIdx.x) >> 6, ngw = (gridDim.x * 256) >> 6;
    for (int r = gw; r < NT; r += ngw) {
        float4 v[4];
#pragma unroll
        for (int j = 0; j < 4; ++j) v[j] = *(const float4*)(p.out + (size_t)r * DM + (j * 64 + lane) * 4);
#pragma unroll
        for (int kk = 0; kk < 4; ++kk) { const float w = p.TOPW()[r * 4 + kk]; const bf16_t* y = p.YB() + (size_t)p.SLOTS()[r * 4 + kk] * DM;
#pragma unroll
            for (int j = 0; j < 4; ++j) { const float4 t = ld_bf4(y + (j * 64 + lane) * 4); v[j].x += w * t.x; v[j].y += w * t.y; v[j].z += w * t.z; v[j].w += w * t.w; } }
        float ss = 0.f;
#pragma unroll
        for (int j = 0; j < 4; ++j) ss += v[j].x * v[j].x + v[j].y * v[j].y + v[j].z * v[j].z + v[j].w * v[j].w;
        const float rstd = rsqrtf(wave_sum(ss) * (1.f / DM) + EPS);
#pragma unroll
        for (int j = 0; j < 4; ++j) { const int c = (j * 64 + lane) * 4; const float4 g = *(const float4*)(p.norm_final + c);
            *(float4*)(p.out + (size_t)r * DM + c) = make_float4(v[j].x * rstd * g.x, v[j].y * rstd * g.y, v[j].z * rstd * g.z, v[j].w * rstd * g.w); }
    }
}

#define LAS __attribute__((address_space(3)))
typedef short bf16x8 __attribute__((ext_vector_type(8)));
typedef float f32x4 __attribute__((ext_vector_type(4)));
typedef float f32x2 __attribute__((ext_vector_type(2)));
typedef unsigned u32x4 __attribute__((ext_vector_type(4)));
typedef unsigned u32x2 __attribute__((ext_vector_type(2)));
typedef int v4i __attribute__((ext_vector_type(4)));
typedef int v8i __attribute__((ext_vector_type(8)));

constexpr int MK_THREADS = 512;
constexpr int RING_BYTES = 131072, MISC_OFF = RING_BYTES, MK_LDS = 147456;
constexpr int NIN_PAD = 5632;

namespace pg8 {
constexpr int BM = 256, BK = 64, HALF = 128, HTB = HALF * BK * 2, NXCD = 8, WGM = 8;
__host__ __device__ __forceinline__ int lds_byte(int r, int c) { const int st = (r >> 4) * 2 + (c >> 5), rr = r & 15, cc = c & 31, ob = rr * 64 + cc * 2; return st * 1024 + (ob ^ (((ob >> 9) & 1) << 5)); }
__host__ __device__ __forceinline__ void stage_rc(int b, int& R, int& C) { const int st = b / 1024, sb = b % 1024, swz = sb ^ (((sb >> 9) & 1) << 5); R = (st >> 1) * 16 + swz / 64; C = (st & 1) * 32 + (swz % 64) / 2; }
__host__ __device__ __forceinline__ int perm32(int rho) { const int n = rho >> 4, i = rho & 15; return 8 * (i >> 2) + 4 * n + (i & 3); }
__device__ __forceinline__ unsigned cvt_pk_bf16(float lo, float hi) { unsigned r; asm volatile("v_cvt_pk_bf16_f32 %0, %1, %2" : "=v"(r) : "v"(lo), "v"(hi)); return r; }

struct Unit { int pm, pn, e; const char* A; const char* B; };

struct StaticOrder {
    int nM, nN, nwg, G, c; const char* A; const char* Bt; size_t btile;
    __device__ void init(int M, int N, int K, int G_, int c_, const void* A_, const void* Bt_) { nM = M / BM; nN = N / BM; nwg = nM * nN; G = G_; c = c_; A = (const char*)A_; Bt = (const char*)Bt_; btile = (size_t)BM * K * 2; }
    __device__ bool next(int i, Unit& u) const {
        const long L = (long)i * G + c; if (L >= nwg) return false;
        int wgid = (int)L; { const int q = nwg / NXCD, r = nwg % NXCD, xcd = wgid % NXCD, off = wgid / NXCD; wgid = (xcd < r ? xcd * (q + 1) : r * (q + 1) + (xcd - r) * q) + off; }
        const int nig = WGM * nN, gid = wgid / nig, fm = gid * WGM, gsz = (nM - fm) < WGM ? (nM - fm) : WGM;
        u.pm = fm + ((wgid % nig) % gsz); u.pn = (wgid % nig) / gsz; u.e = 0; u.A = A; u.B = Bt + (size_t)u.pn * btile; return true;
    }
    __device__ __forceinline__ int arow(int r) const { return r; }
    __device__ __forceinline__ int arow_l(const volatile LAS int*, int r, int) const { return r; }
    __device__ __forceinline__ const int* rows_src(const Unit&, int) const { return nullptr; }
    static constexpr bool HAS_BIAS = false;
    __device__ __forceinline__ const float* bias_src(const Unit&, int) const { return nullptr; }
};
template <int NN> struct StaticOrderN {
    static constexpr int nM = NT / BM, nwg = nM * NN, nig = WGM * NN;
    static_assert(nM % WGM == 0, "row groups are full");
    int G, c; const char* A; const char* Bt; size_t btile;
    __device__ void init(int K, int G_, int c_, const void* A_, const void* Bt_) { G = G_; c = c_; A = (const char*)A_; Bt = (const char*)Bt_; btile = (size_t)BM * K * 2; }
    __device__ bool next(int i, Unit& u) const {
        const int L = i * G + c; if (L >= nwg) return false;
        constexpr int q = nwg / NXCD, r = nwg % NXCD; const int xcd = L & (NXCD - 1), off = L >> 3;
        const int wgid = (xcd < r ? xcd * (q + 1) : r * (q + 1) + (xcd - r) * q) + off;
        const int gid = wgid / nig, rem = wgid - gid * nig;
        u.pm = gid * WGM + (rem & (WGM - 1)); u.pn = rem >> 3; u.e = 0; u.A = A; u.B = Bt + (size_t)u.pn * btile; return true;
    }
    __device__ __forceinline__ int arow(int r) const { return r; }
    __device__ __forceinline__ int arow_l(const volatile LAS int*, int r, int) const { return r; }
    __device__ __forceinline__ const int* rows_src(const Unit&, int) const { return nullptr; }
    static constexpr bool HAS_BIAS = false;
    __device__ __forceinline__ const float* bias_src(const Unit&, int) const { return nullptr; }
};
struct MoeOrder {
    const volatile LAS int* tstart;
    int npn, G, c; const char* A; const char* W; size_t wexp, btile; const int* rowidx;
    const float* bias; int bsplit;
    __device__ bool next(int i, Unit& u) const {
        const long L = (long)i * G + c; const int ntile = tstart[NEXP]; if (L >= (long)ntile * npn) return false;
        const int mt = (int)(L / npn), pn = (int)(L % npn);
        const int k = (int)(threadIdx.x & 31u); const int tv = tstart[k];
        const int e = __builtin_popcount((unsigned)__ballot(k >= 1 && tv <= mt));
        u.pm = mt; u.pn = pn; u.e = e; u.A = A; u.B = W + (size_t)e * wexp + (size_t)pn * btile; return true;
    }
    __device__ __forceinline__ int arow(int r) const { if (!rowidx) return r; const int t = rowidx[r]; return t < 0 ? 0 : t; }
    __device__ __forceinline__ int arow_l(const volatile LAS int* tab, int r, int rl) const { if (!rowidx) return r; const int t = tab[rl]; return t < 0 ? 0 : t; }
    __device__ __forceinline__ const int* rows_src(const Unit& u, int lane) const { return rowidx ? rowidx + (size_t)u.pm * BM + lane * 4 : nullptr; }
    static constexpr bool HAS_BIAS = true;
    __device__ __forceinline__ const float* bias_src(const Unit& u, int lane) const {
        return bsplit ? bias + (size_t)u.e * 2048 + (lane >> 5) * 1024 + u.pn * 128 + (lane & 31) * 4 : bias + (size_t)u.e * 1024 + u.pn * 256 + lane * 4; }
};

template <class Epi, class Sched, bool F8 = false>
__device__ __forceinline__ void gemm_phase(LAS unsigned char* lds, const int K, const int lda, const Sched& S, const Epi& E) {
    const int tid = threadIdx.x, wid = __builtin_amdgcn_readfirstlane(tid >> 6), lane = tid & 63, wr = wid >> 2, wc = wid & 3, fr = lane & 15, fq = lane >> 4;
    const int nt = K / BK;
    unsigned voffB[2];
#pragma unroll
    for (int i = 0; i < 2; ++i) { int R, C; stage_rc(tid * 16 + i * 8192, R, C); const int Rb = Epi::PERM ? ((R & ~31) + perm32(R & 31)) : R; voffB[i] = (unsigned)(Rb * K + C) * 2u; }
    const size_t kstep = (size_t)(BK * 2);
    const size_t hstepB = (size_t)HALF * K * 2;
    const unsigned ldsw = (unsigned)wid * 1024u;
    const int aoff = lds_byte(wr * 64 + fr, fq * 8), boff = lds_byte(wc * 32 + fr, fq * 8);
#define PG8_SA(b, h) (((b) * 2 + (h)) * HTB)
#define PG8_SB(b, h) ((4 + (b) * 2 + (h)) * HTB)
#define PG8_STAGE(bufoff, gbase, voff) do { _Pragma("unroll") for (int _i = 0; _i < 2; ++_i) \
        __builtin_amdgcn_global_load_lds((const unsigned*)((const char*)(gbase) + (voff)[_i]), (LAS unsigned*)(lds + (bufoff) + ldsw + _i * 8192), 16, 0, 0); } while (0)
#define PG8_STAGE_B(bufoff, gbase) do { if constexpr (F8) { const u32x2 vo_ = *(const LAS u32x2*)vslot; const unsigned vv_[2] = {vo_[0], vo_[1]}; PG8_STAGE(bufoff, gbase, vv_); } else PG8_STAGE(bufoff, gbase, voffB); } while (0)
#define PG8_STAGE_A(bufoff, gbase, h) do { if constexpr (F8) { const u32x2 vo_ = *(const LAS u32x2*)(vslot + 2 + 2 * (h)); const unsigned vv_[2] = {vo_[0], vo_[1]}; PG8_STAGE(bufoff, gbase, vv_); } else PG8_STAGE(bufoff, gbase, vc[h]); } while (0)
#define PG8_LDA(dst, b, h) do { _Pragma("unroll") for (int m = 0; m < 4; ++m) _Pragma("unroll") for (int k = 0; k < 2; ++k) dst[m][k] = *(const LAS bf16x8*)(lds + PG8_SA(b, h) + aoff + m * 2048 + k * 1024); } while (0)
#define PG8_LDB(dst, b, h) do { _Pragma("unroll") for (int n = 0; n < 2; ++n) _Pragma("unroll") for (int k = 0; k < 2; ++k) dst[n][k] = *(const LAS bf16x8*)(lds + PG8_SB(b, h) + boff + n * 2048 + k * 1024); } while (0)
#define PG8_MMA(ai, bj, At, Bt) do { __builtin_amdgcn_s_setprio(1); _Pragma("unroll") for (int m = 0; m < 4; ++m) _Pragma("unroll") for (int n = 0; n < 2; ++n) _Pragma("unroll") for (int k = 0; k < 2; ++k) \
        acc[ai][bj][m][n] = __builtin_amdgcn_mfma_f32_16x16x32_bf16(Bt[n][k], At[m][k], acc[ai][bj][m][n], 0, 0, 0); __builtin_amdgcn_s_setprio(0); } while (0)
#define PG8_LDA8(dst, b, h) do { _Pragma("unroll") for (int m = 0; m < 4; ++m) dst[m] = __builtin_shufflevector(*(const LAS v4i*)(lds + PG8_SA(b, h) + aoff + m * 2048), *(const LAS v4i*)(lds + PG8_SA(b, h) + aoff + m * 2048 + 1024), 0, 1, 2, 3, 4, 5, 6, 7); } while (0)
#define PG8_LDB8(dst, b, h) do { _Pragma("unroll") for (int n = 0; n < 2; ++n) dst[n] = __builtin_shufflevector(*(const LAS v4i*)(lds + PG8_SB(b, h) + boff + n * 2048), *(const LAS v4i*)(lds + PG8_SB(b, h) + boff + n * 2048 + 1024), 0, 1, 2, 3, 4, 5, 6, 7); } while (0)
#define PG8_MMA8(ai, bj, At, Bt) do { __builtin_amdgcn_s_setprio(1); _Pragma("unroll") for (int m = 0; m < 4; ++m) _Pragma("unroll") for (int n = 0; n < 2; ++n) \
        acc[ai][bj][m][n] = __builtin_amdgcn_mfma_scale_f32_16x16x128_f8f6f4(Bt[n], At[m], acc[ai][bj][m][n], 0, 0, 0, 122, 0, 127); __builtin_amdgcn_s_setprio(0); } while (0)
#define PG8_XLDA(b, h) do { if constexpr (F8) PG8_LDA8(At8, b, h); else PG8_LDA(At, b, h); } while (0)
#define PG8_XLDB0(b, h) do { if constexpr (F8) PG8_LDB8(B08, b, h); else PG8_LDB(B0, b, h); } while (0)
#define PG8_XLDB1(b, h) do { if constexpr (F8) PG8_LDB8(B18, b, h); else PG8_LDB(B1, b, h); } while (0)
#define PG8_XMM0(ai, bj) do { if constexpr (F8) PG8_MMA8(ai, bj, At8, B08); else PG8_MMA(ai, bj, At, B0); } while (0)
#define PG8_XMM1(ai, bj) do { if constexpr (F8) PG8_MMA8(ai, bj, At8, B18); else PG8_MMA(ai, bj, At, B1); } while (0)
#define PG8_WAIT_V(n) asm volatile("s_waitcnt vmcnt(" #n ")" ::: "memory")
#define PG8_WAIT_L(n) asm volatile("s_waitcnt lgkmcnt(" #n ")" ::: "memory")
#define PG8_BAR __builtin_amdgcn_s_barrier()
#define PG8_SCHED __builtin_amdgcn_sched_barrier(0)
#define PG8_VOFFL(dst, u) do { int _tt = tid; asm volatile("" : "+v"(_tt)); _Pragma("unroll") for (int _i = 0; _i < 2; ++_i) { int _R, _C; stage_rc(_tt * 16 + _i * 8192, _R, _C); \
        _Pragma("unroll") for (int _h = 0; _h < 2; ++_h) dst[_h][_i] = (unsigned)(S.arow_l(rowtab, (u).pm * BM + _h * HALF + _R, _h * HALF + _R) * lda + _C) * 2u; } } while (0)
#define PG8_VOFF(dst, u) do { int _tt = tid; asm volatile("" : "+v"(_tt)); _Pragma("unroll") for (int _i = 0; _i < 2; ++_i) { int _R, _C; stage_rc(_tt * 16 + _i * 8192, _R, _C); \
        _Pragma("unroll") for (int _h = 0; _h < 2; ++_h) dst[_h][_i] = (unsigned)(S.arow((u).pm * BM + _h * HALF + _R) * lda + _C) * 2u; } } while (0)
    constexpr bool HB = Sched::HAS_BIAS;
    LAS float* bias_l = (LAS float*)(lds + MISC_OFF + 13312);
    volatile LAS int* rowtab = (volatile LAS int*)(lds + MISC_OFF + 14336);
#define PG8_ROWS(u) do { if constexpr (HB) { const int* rs_ = S.rows_src(u, lane); if (wid == 0 && rs_) __builtin_amdgcn_global_load_lds((const unsigned*)rs_, (LAS unsigned*)(lds + MISC_OFF + 14336), 16, 0, 0); } } while (0)
#define PG8_BIAS(u) do { if constexpr (HB) { if (wid == 0) __builtin_amdgcn_global_load_lds((const unsigned*)S.bias_src(u, lane), (LAS unsigned*)bias_l, 16, 0, 0); } } while (0)
#define PG8_ACC_INIT() do { f32x4 bv_[2][2]; _Pragma("unroll") for (int b = 0; b < 2; ++b) _Pragma("unroll") for (int n = 0; n < 2; ++n) { \
        if constexpr (HB) bv_[b][n] = *(const LAS f32x4*)(bias_l + b * 128 + wc * 32 + 8 * fq + 4 * n); else bv_[b][n] = (f32x4){0.f, 0.f, 0.f, 0.f}; } \
        _Pragma("unroll") for (int a = 0; a < 2; ++a) _Pragma("unroll") for (int b = 0; b < 2; ++b) _Pragma("unroll") for (int m = 0; m < 4; ++m) _Pragma("unroll") for (int n = 0; n < 2; ++n) acc[a][b][m][n] = bv_[b][n]; } while (0)
    Unit cur, nxt; int ui = 0;
    if (!S.next(0, cur)) return;
    f32x4 acc[2][2][4][2];
    bf16x8 At[4][2], B0[2][2], B1[2][2]; v8i At8[4], B08[2], B18[2];
    unsigned vc[2][2], vn[2][2];
    LAS unsigned* vslot = (LAS unsigned*)(lds + MISC_OFF + 1024) + tid * 6;
    PG8_VOFF(vc, cur);
    if constexpr (F8) { vslot[0] = voffB[0]; vslot[1] = voffB[1]; vslot[2] = vc[0][0]; vslot[3] = vc[0][1]; vslot[4] = vc[1][0]; vslot[5] = vc[1][1]; }
    const char* cA = cur.A; const char* cB = cur.B;
    PG8_BIAS(cur);
    PG8_STAGE_B(PG8_SB(0, 0), cB); PG8_STAGE_B(PG8_SB(0, 1), cB + hstepB); PG8_STAGE_A(PG8_SA(0, 0), cA, 0); PG8_STAGE_A(PG8_SA(0, 1), cA, 1);
    if (wr == 1) PG8_BAR;
    PG8_WAIT_V(2); PG8_BAR;
    PG8_STAGE_B(PG8_SB(1, 0), cB + kstep); PG8_STAGE_A(PG8_SA(1, 0), cA + kstep, 0); PG8_STAGE_B(PG8_SB(1, 1), cB + hstepB + kstep);
    PG8_WAIT_V(6); PG8_BAR;
    PG8_ACC_INIT();
    for (;;) {
        const bool has_next = S.next(ui + 1, nxt);
        const char* nA = has_next ? nxt.A : cA; const char* nB = has_next ? nxt.B : cB;
#pragma unroll 1
        for (int t = 0; t < nt; t += 2) {
            const bool last = (t == nt - 2);
            const char* a1 = cA + (size_t)(t + 1) * kstep;
            const char* a2 = last ? nA : cA + (size_t)(t + 2) * kstep; const char* b2 = last ? nB : cB + (size_t)(t + 2) * kstep;
            const char* a3 = a2 + kstep; const char* b3 = b2 + kstep;
            if constexpr (HB) { if (t == nt - 4 && has_next) PG8_ROWS(nxt); }
            if (last && has_next) { if constexpr (HB) { PG8_VOFFL(vn, nxt); } else { PG8_VOFF(vn, nxt); } PG8_BIAS(nxt); }
            PG8_XLDB0(0, 0); PG8_XLDB1(0, 1); PG8_SCHED; PG8_XLDA(0, 0); PG8_STAGE_A(PG8_SA(1, 1), a1, 1);
            PG8_WAIT_V(8); PG8_WAIT_L(0); PG8_BAR; PG8_XMM0(0, 0); PG8_XMM1(0, 1); PG8_BAR; PG8_SCHED;
            if (last && has_next) {
                if constexpr (F8) { vslot[2] = vn[0][0]; vslot[3] = vn[0][1]; vslot[4] = vn[1][0]; vslot[5] = vn[1][1]; }
                else {
#pragma unroll
                for (int h = 0; h < 2; ++h)
#pragma unroll
                    for (int i = 0; i < 2; ++i) vc[h][i] = vn[h][i];
                }
            }
            PG8_XLDA(0, 1); PG8_STAGE_B(PG8_SB(0, 0), b2); PG8_STAGE_B(PG8_SB(0, 1), b2 + hstepB); PG8_STAGE_A(PG8_SA(0, 0), a2, 0);
            PG8_WAIT_V(8); PG8_WAIT_L(0); PG8_BAR; PG8_XMM0(1, 0); PG8_XMM1(1, 1); PG8_BAR; PG8_SCHED;
            PG8_XLDB0(1, 0); PG8_XLDB1(1, 1); PG8_SCHED; PG8_XLDA(1, 0); PG8_STAGE_A(PG8_SA(0, 1), a2, 1);
            PG8_WAIT_V(8); PG8_WAIT_L(0); PG8_BAR; PG8_XMM0(0, 0); PG8_XMM1(0, 1); PG8_BAR; PG8_SCHED;
            PG8_XLDA(1, 1); PG8_STAGE_B(PG8_SB(1, 0), b3); PG8_STAGE_B(PG8_SB(1, 1), b3 + hstepB); PG8_STAGE_A(PG8_SA(1, 0), a3, 0);
            PG8_WAIT_V(8); PG8_WAIT_L(0); PG8_BAR; PG8_XMM0(1, 0); PG8_XMM1(1, 1); PG8_BAR; PG8_SCHED;
        }
        if (wr == 0) PG8_BAR;
        E(acc, cur, wr, wc, fr, fq);
        if (!has_next) break;
        PG8_ACC_INIT();
        cur = nxt; cA = nA; cB = nB; ++ui;
        if (wr == 1) PG8_BAR;
    }
    PG8_WAIT_V(0);
    PG8_BAR;
#undef PG8_SA
#undef PG8_SB
#undef PG8_STAGE
#undef PG8_STAGE_A
#undef PG8_STAGE_B
#undef PG8_LDA
#undef PG8_LDB
#undef PG8_MMA
#undef PG8_MMA8
#undef PG8_LDA8
#undef PG8_LDB8
#undef PG8_XLDA
#undef PG8_XLDB0
#undef PG8_XLDB1
#undef PG8_XMM0
#undef PG8_XMM1
#undef PG8_WAIT_V
#undef PG8_WAIT_L
#undef PG8_BAR
#undef PG8_SCHED
#undef PG8_VOFF
#undef PG8_VOFFL
#undef PG8_ROWS
#undef PG8_BIAS
#undef PG8_ACC_INIT
}
}

__device__ __forceinline__ unsigned pk4_fp8(float a, float b, float c, float d) { int p = 0; p = __builtin_amdgcn_cvt_pk_fp8_f32(a, b, p, false); p = __builtin_amdgcn_cvt_pk_fp8_f32(c, d, p, true); return (unsigned)p; }
constexpr float YB_SCALE = 8.f;
constexpr float W8_SCALE = 32.f;
__device__ __forceinline__ void st8_bf16(bf16_t* dst, const f32x4 v0, const f32x4 v1) {
    u32x4 w; w.x = pg8::cvt_pk_bf16(v0[0], v0[1]); w.y = pg8::cvt_pk_bf16(v0[2], v0[3]); w.z = pg8::cvt_pk_bf16(v1[0], v1[1]); w.w = pg8::cvt_pk_bf16(v1[2], v1[3]);
    *(u32x4*)dst = w;
}
__device__ __forceinline__ void ld8_bf16(const bf16_t* src, f32x4& v0, f32x4& v1) {
    const u32x4 w = *(const u32x4*)src;
    v0 = (f32x4){__uint_as_float(w.x << 16), __uint_as_float(w.x & 0xffff0000u), __uint_as_float(w.y << 16), __uint_as_float(w.y & 0xffff0000u)};
    v1 = (f32x4){__uint_as_float(w.z << 16), __uint_as_float(w.z & 0xffff0000u), __uint_as_float(w.w << 16), __uint_as_float(w.w & 0xffff0000u)};
}
__device__ __forceinline__ unsigned pk4_u8(f32x4 v) { const f32x4 s = v * 255.f; unsigned r = 0;
    r = __builtin_amdgcn_cvt_pk_u8_f32(s[0], 0, r); r = __builtin_amdgcn_cvt_pk_u8_f32(s[1], 1, r); r = __builtin_amdgcn_cvt_pk_u8_f32(s[2], 2, r); r = __builtin_amdgcn_cvt_pk_u8_f32(s[3], 3, r); return r; }
__device__ __forceinline__ f32x4 up4_u8(unsigned w) { return (f32x4){(float)(w & 0xffu), (float)((w >> 8) & 0xffu), (float)((w >> 16) & 0xffu), (float)(w >> 24)} * (1.f / 255.f); }
__device__ __forceinline__ void ld8_u8(const unsigned char* src, f32x4& v0, f32x4& v1) { const u32x2 w = *(const u32x2*)src; v0 = up4_u8(w.x); v1 = up4_u8(w.y); }
__device__ __forceinline__ f32x4 sig4(f32x4 v) {
    f32x4 e = v * -1.4426950408889634f;
#pragma unroll
    for (int j = 0; j < 4; ++j) e[j] = __builtin_amdgcn_exp2f(e[j]);
    e = e + 1.f;
#pragma unroll
    for (int j = 0; j < 4; ++j) e[j] = __builtin_amdgcn_rcpf(e[j]);
    return e;
}

template <int PART> struct EpiIn {
    static constexpr bool PERM = true;
    Params p;
    __device__ __forceinline__ void operator()(const f32x4 (&acc)[2][2][4][2], const pg8::Unit& u, int wr, int wc, int fr, int fq) const {
        const int pn = u.pn; const size_t row0 = (size_t)u.pm * 256 + wr * 64 + fr; const int cl0 = wc * 32 + 8 * fq;
        if (PART == 1 || pn < 21) {
            bf16_t* base; int ld, c0; int mode;
            if (PART != 1 && pn < 2) { base = p.Qm(); ld = 512; c0 = pn * 256; mode = 1; }
            else if (PART != 1 && pn < 4) { base = p.Km(); ld = 512; c0 = (pn - 2) * 256; mode = 0; }
            else if (PART != 1 && pn < 8) { base = p.Vm(); ld = 1024; c0 = (pn - 4) * 256; mode = 0; }
            else if (PART != 0 && pn < 12) { base = p.OG(); ld = 1024; c0 = (pn - 8) * 256; mode = 2; }
            else if (PART != 0 && pn < 20) { base = p.GATE(); ld = 2048; c0 = (pn - 12) * 256; mode = 2; }
            else { base = nullptr; ld = 256; c0 = 0; mode = 3; }
#pragma unroll
            for (int ai = 0; ai < 2; ++ai)
#pragma unroll
                for (int m = 0; m < 4; ++m) { const size_t r = row0 + ai * 128 + m * 16;
#pragma unroll
                    for (int bj = 0; bj < 2; ++bj) { f32x4 v0 = acc[ai][bj][m][0], v1 = acc[ai][bj][m][1]; const int c = c0 + bj * 128 + cl0;
                        if (PART != 1 && mode == 3) { float* d = p.CQ() + r * 256 + c; *(f32x4*)d = v0; *(f32x4*)(d + 4) = v1; }
                        else if (PART != 0 && mode == 2) { u32x2 o8; o8.x = pk4_u8(sig4(v0)); o8.y = pk4_u8(sig4(v1)); *(u32x2*)((unsigned char*)base + r * ld + c) = o8; }
                        else { if (PART != 1 && mode == 1) { v0 = v0 * 0.125f; v1 = v1 * 0.125f; }
                               st8_bf16(base + r * ld + c, v0, v1); } } }
        } else if (PART != 1) {
#pragma unroll
            for (int ai = 0; ai < 2; ++ai)
#pragma unroll
                for (int m = 0; m < 4; ++m) { const size_t r = row0 + ai * 128 + m * 16;
                    { float* d = p.CKV() + r * 128 + cl0; *(f32x4*)d = acc[ai][0][m][0]; *(f32x4*)(d + 4) = acc[ai][0][m][1]; }
                    const f32x4 v0 = acc[ai][1][m][0], v1 = acc[ai][1][m][1];
                    if (wc < 2) { float* d = p.KR() + r * 64 + cl0; *(f32x4*)d = v0; *(f32x4*)(d + 4) = v1; }
                    else if (wc == 2) { const int g = 8 * (fq & 1);
                        if (fq < 2) { float* d = p.GI() + r * 16 + g; const f32x4 b0 = *(const f32x4*)(p.m_b_i + g), b1 = *(const f32x4*)(p.m_b_i + g + 4); *(f32x4*)d = v0 + b0; *(f32x4*)(d + 4) = v1 + b1; }
                        else { float* d = p.GF() + r * 16 + g; const f32x4 b0 = *(const f32x4*)(p.m_b_f + g), b1 = *(const f32x4*)(p.m_b_f + g + 4);
                            *(f32x4*)d = (f32x4){logsigmoidf_(v0[0] + b0[0]), logsigmoidf_(v0[1] + b0[1]), logsigmoidf_(v0[2] + b0[2]), logsigmoidf_(v0[3] + b0[3])};
                            *(f32x4*)(d + 4) = (f32x4){logsigmoidf_(v1[0] + b1[0]), logsigmoidf_(v1[1] + b1[1]), logsigmoidf_(v1[2] + b1[2]), logsigmoidf_(v1[3] + b1[3])}; } } }
        }
    }
};
template <int PART> struct EpiInP {
    static constexpr bool PERM = true;
    Params p;
    __device__ __forceinline__ void operator()(const f32x4 (&acc)[2][2][4][2], const pg8::Unit& u, int wr, int wc, int fr, int fq) const {
        pg8::Unit v = u; v.pn = PART == 0 ? (u.pn < 8 ? u.pn : u.pn + 12) : u.pn + 8;
        EpiIn<PART> E{p}; E(acc, v, wr, wc, fr, fq);
    }
};
struct EpiQ {
    static constexpr bool PERM = true;
    Params p;
    __device__ __forceinline__ void operator()(const f32x4 (&acc)[2][2][4][2], const pg8::Unit& u, int wr, int wc, int fr, int fq) const {
        const size_t row0 = (size_t)u.pm * 256 + wr * 64 + fr;
#pragma unroll
        for (int ai = 0; ai < 2; ++ai)
#pragma unroll
            for (int m = 0; m < 4; ++m) { const size_t r = row0 + ai * 128 + m * 16; const float rs = p.RSQ()[r] * QSCALE; const int pos = NMETA + (int)(r & (SEQ - 1));
#pragma unroll
                for (int bj = 0; bj < 2; ++bj) { const int c = u.pn * 256 + bj * 128 + wc * 32 + 8 * fq; const int local = c % 192;
                    f32x4 v0 = acc[ai][bj][m][0] * rs, v1 = acc[ai][bj][m][1] * rs;
                    if (local >= 128) { const int i0 = (local - 128) >> 1; const float* rp = p.ROPE() + ((size_t)pos * 32 + i0) * 2;
                        const f32x4 cs0 = *(const f32x4*)rp, cs1 = *(const f32x4*)(rp + 4);
                        const f32x4 o0 = (f32x4){v0[0] * cs0[0] - v0[1] * cs0[1], v0[0] * cs0[1] + v0[1] * cs0[0], v0[2] * cs0[2] - v0[3] * cs0[3], v0[2] * cs0[3] + v0[3] * cs0[2]};
                        const f32x4 o1 = (f32x4){v1[0] * cs1[0] - v1[1] * cs1[1], v1[0] * cs1[1] + v1[1] * cs1[0], v1[2] * cs1[2] - v1[3] * cs1[3], v1[2] * cs1[3] + v1[3] * cs1[2]};
                        v0 = o0; v1 = o1; }
                    st8_bf16(p.QP() + r * 1536 + c, v0, v1); }
                asm volatile("" ::: "memory"); }
    }
};
template <int PASS> struct EpiMix {
    static constexpr bool PERM = true;
    Params p;
    __device__ __forceinline__ void operator()(const f32x4 (&acc)[2][2][4][2], const pg8::Unit& u, int wr, int wc, int fr, int fq) const {
        const size_t row0 = (size_t)u.pm * 256 + wr * 64 + fr;
#pragma unroll
        for (int ai = 0; ai < 2; ++ai)
#pragma unroll
            for (int m = 0; m < 4; ++m) { const size_t r = row0 + ai * 128 + m * 16;
#pragma unroll
                for (int bj = 0; bj < 2; ++bj) { const int c = u.pn * 256 + bj * 128 + wc * 32 + 8 * fq;
                    f32x4 g0, g1; ld8_u8((const unsigned char*)p.GATE() + r * 2048 + PASS * 1024 + c, g0, g1);
                    f32x4 v0 = acc[ai][bj][m][0] * g0, v1 = acc[ai][bj][m][1] * g1;
                    if (PASS == 1) { f32x4 m0, m1; ld8_bf16(p.MIX() + r * 1024 + c, m0, m1); v0 = v0 + m0; v1 = v1 + m1; }
                    st8_bf16(p.MIX() + r * 1024 + c, v0, v1); } }
    }
};
struct EpiOut {
    static constexpr bool PERM = true;
    Params p;
    __device__ __forceinline__ void operator()(const f32x4 (&acc)[2][2][4][2], const pg8::Unit& u, int wr, int wc, int fr, int fq) const {
        const size_t row0 = (size_t)u.pm * 256 + wr * 64 + fr;
#pragma unroll
        for (int ai = 0; ai < 2; ++ai)
#pragma unroll
            for (int m = 0; m < 4; ++m) { const size_t r = row0 + ai * 128 + m * 16;
#pragma unroll
                for (int bj = 0; bj < 2; ++bj) { const int c = u.pn * 256 + bj * 128 + wc * 32 + 8 * fq; const float* xs = p.x + r * DM + c;
                    const f32x4 x0 = __builtin_nontemporal_load((const f32x4*)xs), x1 = __builtin_nontemporal_load((const f32x4*)(xs + 4));
                    st8_bf16(p.H1() + r * DM + c, acc[ai][bj][m][0] + x0, acc[ai][bj][m][1] + x1); } }
    }
};
__device__ __forceinline__ f32x4 swiglu4(f32x4 g, f32x4 l) {
    f32x4 gg, ll, e;
#pragma unroll
    for (int j = 0; j < 4; ++j) { gg[j] = __builtin_amdgcn_fmed3f(g[j], -3.0e38f, 7.f); ll[j] = __builtin_amdgcn_fmed3f(l[j], -7.f, 7.f); }
    e = gg * (-1.702f * 1.4426950408889634f);
#pragma unroll
    for (int j = 0; j < 4; ++j) e[j] = __builtin_amdgcn_exp2f(e[j]);
    e = e + 1.f;
#pragma unroll
    for (int j = 0; j < 4; ++j) e[j] = __builtin_amdgcn_rcpf(e[j]);
    const f32x4 t = gg * e;
    return t * ll + t;
}
struct EpiM1 {
    static constexpr bool PERM = true;
    Params p;
    __device__ __forceinline__ void operator()(const f32x4 (&acc)[2][2][4][2], const pg8::Unit& u, int wr, int wc, int fr, int fq) const {
        const size_t row0 = (size_t)u.pm * 256 + wr * 64 + fr; const int c = u.pn * 128 + wc * 32 + 8 * fq;
#pragma unroll
        for (int ai = 0; ai < 2; ++ai)
#pragma unroll
            for (int m = 0; m < 4; ++m) { const size_t r = row0 + ai * 128 + m * 16;
                const f32x4 a0 = swiglu4(acc[ai][0][m][0], acc[ai][1][m][0]), a1 = swiglu4(acc[ai][0][m][1], acc[ai][1][m][1]);
                u32x2 o8; o8.x = pk4_fp8(a0[0], a0[1], a0[2], a0[3]); o8.y = pk4_fp8(a1[0], a1[1], a1[2], a1[3]); *(u32x2*)((unsigned char*)p.ACT() + r * DFF + c) = o8; }
    }
};
struct EpiM2 {
    static constexpr bool PERM = true;
    Params p;
    __device__ __forceinline__ void operator()(const f32x4 (&acc)[2][2][4][2], const pg8::Unit& u, int wr, int wc, int fr, int fq) const {
        const size_t row0 = (size_t)u.pm * 256 + wr * 64 + fr;
#pragma unroll
        for (int bj = 0; bj < 2; ++bj) { const int c = u.pn * 256 + bj * 128 + wc * 32 + 8 * fq;
#pragma unroll
            for (int ai = 0; ai < 2; ++ai)
#pragma unroll
                for (int m = 0; m < 4; ++m) { const size_t r = row0 + ai * 128 + m * 16; const f32x4 v0 = acc[ai][bj][m][0] * YB_SCALE, v1 = acc[ai][bj][m][1] * YB_SCALE;
                    u32x2 o8; o8.x = pk4_fp8(v0[0], v0[1], v0[2], v0[3]); o8.y = pk4_fp8(v1[0], v1[1], v1[2], v1[3]); *(u32x2*)((unsigned char*)p.YB() + r * DM + c) = o8; } }
    }
};

__device__ __forceinline__ float4 ntld4(const float* p) { const f32x4 v = __builtin_nontemporal_load((const f32x4*)p); return make_float4(v[0], v[1], v[2], v[3]); }
__device__ __forceinline__ uint2 ntld2u(const bf16_t* p) { const u32x2 v = __builtin_nontemporal_load((const u32x2*)p); return make_uint2(v[0], v[1]); }
__device__ __forceinline__ float4 ntld_h1(const bf16_t* p) { const uint2 u = ntld2u(p); return make_float4(__uint_as_float(u.x << 16), __uint_as_float(u.x & 0xffff0000u), __uint_as_float(u.y << 16), __uint_as_float(u.y & 0xffff0000u)); }
__device__ __forceinline__ unsigned pk2(float lo, float hi) { return (unsigned)f2bf(lo) | ((unsigned)f2bf(hi) << 16); }
struct TrDesc { const float* W; bf16_t* WT; int ldw, K, dr0, sc0, nvalid, k0, f8; };
__device__ __forceinline__ void tr_load(const TrDesc& d, float4 (&v)[16], int lane) {
    const int lr = lane >> 4, lc = (lane & 15) * 4;
#pragma unroll
    for (int i = 0; i < 16; ++i) v[i] = (lc < d.nvalid) ? ntld4(d.W + (size_t)(d.k0 + i * 4 + lr) * d.ldw + d.sc0 + lc) : make_float4(0.f, 0.f, 0.f, 0.f);
}
__device__ __forceinline__ void tr_finish(const TrDesc& d, const float4 (&v)[16], LAS float* scr, int lane) {
    const int lr = lane >> 4, lc = (lane & 15) * 4;
#pragma unroll
    for (int i = 0; i < 16; ++i) { LAS float* q = scr + (i * 4 + lr) * 65 + lc; q[0] = v[i].x; q[1] = v[i].y; q[2] = v[i].z; q[3] = v[i].w; }
    asm volatile("s_waitcnt lgkmcnt(0)" ::: "memory");
    const int c = lane & 7;
    if (d.f8) {
#pragma unroll
        for (int j = 0; j < 8; ++j) { const int n = (lane >> 3) + 8 * j; const LAS float* s = scr + (8 * c) * 65 + n;
            u32x2 o; o.x = pk4_fp8(s[0 * 65] * W8_SCALE, s[1 * 65] * W8_SCALE, s[2 * 65] * W8_SCALE, s[3 * 65] * W8_SCALE); o.y = pk4_fp8(s[4 * 65] * W8_SCALE, s[5 * 65] * W8_SCALE, s[6 * 65] * W8_SCALE, s[7 * 65] * W8_SCALE);
            *(u32x2*)((unsigned char*)d.WT + (size_t)(d.dr0 + n) * d.K + d.k0 + 8 * c) = o; }
    } else {
#pragma unroll
    for (int j = 0; j < 8; ++j) { const int n = (lane >> 3) + 8 * j; const LAS float* s = scr + (8 * c) * 65 + n;
        u32x4 o; o.x = pk2(s[0 * 65], s[1 * 65]); o.y = pk2(s[2 * 65], s[3 * 65]); o.z = pk2(s[4 * 65], s[5 * 65]); o.w = pk2(s[6 * 65], s[7 * 65]);
        *(u32x4*)(d.WT + (size_t)(d.dr0 + n) * d.K + d.k0 + 8 * c) = o; }
    }
    asm volatile("s_waitcnt lgkmcnt(0)" ::: "memory");
}
__device__ __forceinline__ int win_src_col(int np, int& nvalid) {
    nvalid = 64;
    if (np < 3072) return np;
    if (np < 5120) return OFF_G + (np - 3072);
    if (np < 5376) return OFF_CQ + (np - 5120);
    if (np < 5504) return OFF_CKV + (np - 5376);
    if (np < 5568) return OFF_KR + (np - 5504);
    nvalid = 32; return OFF_I;
}

__device__ __forceinline__ void phase_prologue(const Params& p, LAS unsigned char* lds, int vcu, int G, int sub) {
#define SUBP(x) (sub == 0 || sub == (x))
    const int tid = threadIdx.x, lane = tid & 63, wave = tid >> 6;
    const int gw = vcu * 8 + wave, NGW = G * 8;
    LAS float* scr = (LAS float*)(lds + wave * 16640);
    if (SUBP(1)) for (int it = vcu; it < 88; it += G) {
        LAS float* um = (LAS float*)lds;
        LAS float* red = (LAS float*)(lds + 65536);
        __syncthreads();
        for (int j = wave * 2; j < wave * 2 + 2; ++j) {
            const float* src = p.meta + (size_t)j * DM; float4 v[4]; float ss = 0.f;
#pragma unroll
            for (int q = 0; q < 4; ++q) { v[q] = *(const float4*)(src + (q * 64 + lane) * 4); ss += v[q].x * v[q].x + v[q].y * v[q].y + v[q].z * v[q].z + v[q].w * v[q].w; }
            const float rstd = rsqrtf(wave_sum(ss) * (1.f / DM) + EPS);
#pragma unroll
            for (int q = 0; q < 4; ++q) { const int c = (q * 64 + lane) * 4; const float4 g = *(const float4*)(p.norm_mix + c);
                um[j * 1024 + c] = v[q].x * rstd * g.x; um[j * 1024 + c + 1] = v[q].y * rstd * g.y; um[j * 1024 + c + 2] = v[q].z * rstd * g.z; um[j * 1024 + c + 3] = v[q].w * rstd * g.w; }
        }
        __syncthreads();
        const int n = it * 64 + lane; const bool okn = n < DIN;
        float a[16];
#pragma unroll
        for (int j = 0; j < 16; ++j) a[j] = 0.f;
#pragma unroll 8
        for (int kk = 0; kk < 128; ++kk) { const int kq = wave * 128 + kk; const float w = okn ? p.w_in[(size_t)kq * DIN + n] : 0.f;
#pragma unroll
            for (int j = 0; j < 16; ++j) a[j] += um[j * 1024 + kq] * w; }
#pragma unroll
        for (int j = 0; j < 16; ++j) red[(wave * 16 + j) * 64 + lane] = a[j];
        __syncthreads();
        for (int o = tid; o < 1024; o += MK_THREADS) { const int j = o >> 6, nl = o & 63; float s = 0.f;
#pragma unroll
            for (int w8 = 0; w8 < 8; ++w8) s += red[(w8 * 16 + j) * 64 + nl];
            if (it * 64 + nl < DIN) p.ZM()[(size_t)j * DIN + it * 64 + nl] = s; }
        __syncthreads();
    }
    constexpr int I_INA = 16 * 40, I_INB = 16 * 48, I_IN = I_INA + I_INB, I_W1 = NEXP * 16 * 32, I_W2 = NEXP * 16 * 16, I_SQ = 16 * 16;
    constexpr int NITEMS = I_IN + I_W1 + I_W2 + 2 * I_SQ;
    auto decode = [&](int it, TrDesc& d) {
        int r = it;
        if (r < I_INA) { const int kb = r / 40, nb = r % 40, np = nb * 64, nl = np < 2048 ? np : np + 3072; int nv; const int sc = win_src_col(nl, nv); d = TrDesc{p.w_in, p.WinT(), DIN, DM, np, sc, nv, kb * 64, 0}; return; } r -= I_INA;
        if (r < I_INB) { const int kb = r / 48, nb = r % 48, np = nb * 64; int nv; const int sc = win_src_col(2048 + np, nv); d = TrDesc{p.w_in, (bf16_t*)p.WinT8(), DIN, DM, np, sc, nv, kb * 64, 1}; return; } r -= I_INB;
        if (r < I_W1) { const int e = r / 512, q = r % 512, kb = q / 32, nb = q % 32, np = nb * 64, pn = np >> 8, bj = (np >> 7) & 1, j = np & 127;
            d = TrDesc{p.w1 + (size_t)e * DM * 2048, (bf16_t*)((unsigned char*)p.W1T() + (size_t)e * 2048 * DM), 2048, DM, np, 1024 * bj + 128 * pn + j, 64, kb * 64, 1}; return; } r -= I_W1;
        if (r < I_W2) { const int e = r / 256, q = r % 256, kb = q / 16, nb = q % 16; d = TrDesc{p.w2 + (size_t)e * DFF * DM, (bf16_t*)((unsigned char*)p.W2T() + (size_t)e * DM * DFF), DM, DFF, nb * 64, nb * 64, 64, kb * 64, 1}; return; } r -= I_W2;
        if (r < I_SQ) { const int kb = r / 16, nb = r % 16; d = TrDesc{p.w_m_proj, p.WmT(), DM, DM, nb * 64, nb * 64, 64, kb * 64, 0}; return; } r -= I_SQ;
        { const int kb = r / 16, nb = r % 16; d = TrDesc{p.w_out, p.WoutT(), DM, DM, nb * 64, nb * 64, 64, kb * 64, 0}; }
    };
    if (SUBP(2)) {
        float4 va[16], vb[16]; TrDesc da, db; int it = gw;
        if (it < NITEMS) { decode(it, da); tr_load(da, va, lane); }
#pragma unroll 1
        while (it < NITEMS) {
            const int it1 = it + NGW; if (it1 < NITEMS) { decode(it1, db); tr_load(db, vb, lane); }
            tr_finish(da, va, scr, lane);
            if (it1 >= NITEMS) break;
            const int it2 = it1 + NGW; if (it2 < NITEMS) { decode(it2, da); tr_load(da, va, lane); }
            tr_finish(db, vb, scr, lane);
            it = it2;
        }
    }
    if (SUBP(3)) for (int r = gw * 4; r < NT; r += NGW * 4) {
        const float* s0 = p.x + (size_t)r * DM; float4 v[16];
#pragma unroll
        for (int q = 0; q < 4; ++q)
#pragma unroll
            for (int j = 0; j < 4; ++j) v[q * 4 + j] = ntld4(s0 + (size_t)q * DM + (j * 64 + lane) * 4);
        float rs[4];
#pragma unroll
        for (int q = 0; q < 4; ++q) { float s = 0.f;
#pragma unroll
            for (int j = 0; j < 4; ++j) { const float4 t = v[q * 4 + j]; s += t.x * t.x + t.y * t.y + t.z * t.z + t.w * t.w; }
            rs[q] = rsqrtf(wave_sum(s) * (1.f / DM) + EPS); }
#pragma unroll
        for (int j = 0; j < 4; ++j) { const int c = (j * 64 + lane) * 4; const float4 g = *(const float4*)(p.norm_mix + c);
#pragma unroll
            for (int q = 0; q < 4; ++q) { const float4 t = v[q * 4 + j]; const float rr = rs[q];
                const float u0 = t.x * rr * g.x, u1 = t.y * rr * g.y, u2 = t.z * rr * g.z, u3 = t.w * rr * g.w;
                u32x2 o; o.x = pk2(u0, u1); o.y = pk2(u2, u3); *(u32x2*)(p.U() + (size_t)(r + q) * DM + c) = o;
                *(unsigned*)(p.U8() + (size_t)(r + q) * DM + c) = pk4_fp8(u0, u1, u2, u3); } }
    }
    const long gid = (long)vcu * MK_THREADS + tid, gn = (long)G * MK_THREADS;
    if (SUBP(4)) for (long i = gid; i < (long)LTOT * 32; i += gn) {
        const int pos = (int)(i >> 5), f = (int)(i & 31);
        const float freq = powf(10000.f, -(float)f / 32.f), ang = (float)pos * freq; float s, c; sincosf(ang, &s, &c);
        p.ROPE()[i * 2] = c; p.ROPE()[i * 2 + 1] = s;
    }
    const int rot_wo = (vcu + 40) & 255;
    if (SUBP(5)) for (long i = (long)rot_wo * MK_THREADS + tid; i < 8L * 8 * 1024; i += gn) {
        const int n = (int)(i & 1023), hcg = __builtin_amdgcn_readfirstlane((int)(i >> 10)), h = hcg >> 3, c0 = (hcg & 7) * 16;
        const float* ap = p.w_a_proj + (size_t)(h * 128) * DM + n; const float* kv = p.a_w_ukv + ((size_t)c0 * 8 + h) * 256 + 128;
        float acc[16];
#pragma unroll
        for (int q = 0; q < 16; ++q) acc[q] = 0.f;
#pragma unroll 4
        for (int d = 0; d < 128; ++d) { const float b = ap[(size_t)d * DM];
#pragma unroll
            for (int q = 0; q < 16; ++q) acc[q] += kv[(size_t)q * 2048 + d] * b; }
        u32x4 o0, o1; o0.x = pk2(acc[0], acc[1]); o0.y = pk2(acc[2], acc[3]); o0.z = pk2(acc[4], acc[5]); o0.w = pk2(acc[6], acc[7]);
        o1.x = pk2(acc[8], acc[9]); o1.y = pk2(acc[10], acc[11]); o1.z = pk2(acc[12], acc[13]); o1.w = pk2(acc[14], acc[15]);
        bf16_t* dst = p.WoT() + (size_t)n * 1024 + h * 128 + c0; *(u32x4*)dst = o0; *(u32x4*)(dst + 8) = o1;
    }
    if (SUBP(6)) for (int t = ((vcu + 168) & 255) * 8 + wave; t < 8 * 128; t += NGW) {
        const int h = t >> 7, c = t & 127; const float2 kvv = *(const float2*)(p.a_w_ukv + ((size_t)c * 8 + h) * 256 + 2 * lane);
#pragma unroll 1
        for (int r0 = 0; r0 < 256; r0 += 64) { float keep = 0.f;
#pragma unroll 8
            for (int rr = 0; rr < 64; ++rr) { const float2 u = *(const float2*)(p.a_w_uq + ((size_t)(r0 + rr) * 8 + h) * 192 + 2 * lane);
                const float s = wave_sum(u.x * kvv.x + u.y * kvv.y); if (lane == rr) keep = s; }
            p.WqT()[(size_t)(h * 192 + c) * 256 + r0 + lane] = f2bf(keep * p.a_norm_q[r0 + lane]); }
    }
    if (SUBP(6)) for (long i = gid; i < 8L * 64 * 256; i += gn) {
        const int r = (int)(i & 255), hq = (int)(i >> 8), h = hq >> 6, q = hq & 63;
        p.WqT()[(size_t)(h * 192 + 128 + q) * 256 + r] = f2bf(p.a_w_uq[((size_t)r * 8 + h) * 192 + 128 + (q >> 1) + 32 * (q & 1)] * p.a_norm_q[r]);
    }
}

#undef SUBP
__device__ __forceinline__ void phase_kprep(const Params& p, int vcu, int G) {
    const int lane = threadIdx.x & 63, gw = vcu * 8 + (threadIdx.x >> 6), NGW = G * 8;
    const float gk0 = p.a_norm_kv[lane], gk1 = p.a_norm_kv[64 + lane];
    for (int r0 = gw * 4; r0 < NT; r0 += NGW * 4) {
        float c0[4], c1[4], x1[4], x2[4], cs[4], sn[4];
#pragma unroll
        for (int q = 0; q < 4; ++q) { const size_t r = (size_t)r0 + q; const int pos = NMETA + (int)(r & (SEQ - 1));
            c0[q] = p.CKV()[r * 128 + lane]; c1[q] = p.CKV()[r * 128 + 64 + lane];
            const int l32 = lane & 31; x1[q] = p.KR()[r * 64 + l32]; x2[q] = p.KR()[r * 64 + 32 + l32];
            const float2 t = *(const float2*)(p.ROPE() + ((size_t)pos * 32 + l32) * 2); cs[q] = t.x; sn[q] = t.y; }
#pragma unroll
        for (int q = 0; q < 4; ++q) { const size_t r = (size_t)r0 + q; const int b = (int)(r >> 12), key = (int)(r & (SEQ - 1));
            bf16_t* dst = p.Kc() + ((size_t)b * KVROWS + key) * 192;
            const float rstd = rsqrtf(wave_sum(c0[q] * c0[q] + c1[q] * c1[q]) * (1.f / 128.f) + EPS);
            dst[lane] = f2bf(c0[q] * rstd * gk0); dst[64 + lane] = f2bf(c1[q] * rstd * gk1);
            if (lane < 32) *(unsigned*)(dst + 128 + 2 * lane) = pk2(x1[q] * cs[q] - x2[q] * sn[q], x1[q] * sn[q] + x2[q] * cs[q]); }
    }
    for (int i = gw; i < NB * 64; i += NGW) {
        const int b = i >> 6, j = i & 63; bf16_t* dst = p.Kc() + ((size_t)b * KVROWS + SEQ + j) * 192;
        if (j >= NMETA) { dst[lane] = 0; dst[64 + lane] = 0; dst[128 + lane] = 0; continue; }
        const float* ckv = p.ZM() + (size_t)j * DIN + OFF_CKV; const float* kr = p.ZM() + (size_t)j * DIN + OFF_KR;
        const float c0 = ckv[lane], c1 = ckv[64 + lane];
        const float rstd = rsqrtf(wave_sum(c0 * c0 + c1 * c1) * (1.f / 128.f) + EPS);
        dst[lane] = f2bf(c0 * rstd * gk0); dst[64 + lane] = f2bf(c1 * rstd * gk1);
        if (lane < 32) { const float x1 = kr[lane], x2 = kr[32 + lane], cs = p.ROPE()[((size_t)j * 32 + lane) * 2], sn = p.ROPE()[((size_t)j * 32 + lane) * 2 + 1];
            *(unsigned*)(dst + 128 + 2 * lane) = pk2(x1 * cs - x2 * sn, x1 * sn + x2 * cs); }
    }
    for (int r0 = gw * 4; r0 < NT; r0 += NGW * 4) {
        float4 v[4];
#pragma unroll
        for (int q = 0; q < 4; ++q) v[q] = ntld4(p.CQ() + (size_t)(r0 + q) * 256 + lane * 4);
#pragma unroll
        for (int q = 0; q < 4; ++q) { u32x2 o; o.x = pk2(v[q].x, v[q].y); o.y = pk2(v[q].z, v[q].w);
            const float a = __uint_as_float(o.x << 16), b = __uint_as_float(o.x & 0xffff0000u), c = __uint_as_float(o.y << 16), d = __uint_as_float(o.y & 0xffff0000u);
            const float ss = wave_sum(a * a + b * b + c * c + d * d);
            *(u32x2*)(p.CQb() + (size_t)(r0 + q) * 256 + lane * 4) = o;
            if (lane == 0) p.RSQ()[r0 + q] = rsqrtf(ss * (1.f / 256.f) + EPS); }
    }
}

__device__ __forceinline__ void moe_tile_table(const Params& p, volatile LAS int* tst) {
    __syncthreads();
    if (threadIdx.x == 0) { int s = 0; for (int e = 0; e < NEXP; ++e) { tst[e] = s; s += (p.CNT()[e * CNT_STRIDE] + 255) / 256; } tst[NEXP] = s; }
    __syncthreads();
}

namespace att {
using s16x4 = __attribute__((ext_vector_type(4))) short;
using f32x16 = __attribute__((ext_vector_type(16))) float;
constexpr int KN_B = 16384, KR_B = 8192, V_B = 16384;
constexpr int L_KN = 0, L_KR = 2 * KN_B, L_WS = L_KR + 2 * KR_B, L_QR = L_WS + 8 * 256, L_END = L_QR + 8 * 4096;
constexpr float THR = 8.f;
#define KSWZ(row, colB) ((row) * 256 + ((colB) ^ (((((row) & 3) << 2) | (((row) >> 2) & 3)) << 4)))
#define RSWZ(row, colB) ((row) * 128 + ((colB) ^ ((((row) >> 1) & 7) << 4)))
#define SBAR() __builtin_amdgcn_sched_barrier(0)
__device__ __forceinline__ int crow(int r, int hi) { return (r & 3) + 8 * (r >> 2) + 4 * hi; }
__device__ __forceinline__ unsigned cvtpk(float lo, float hi) { unsigned r; asm volatile("v_cvt_pk_bf16_f32 %0, %1, %2" : "=v"(r) : "v"(lo), "v"(hi)); return r; }

__device__ __forceinline__ void partialSM(f32x16& p0, f32x16& p1, float& m_reg, float& alpha) {
    float pmax = p0[0];
#pragma unroll
    for (int r = 1; r < 16; ++r) pmax = fmaxf(pmax, p0[r]);
#pragma unroll
    for (int r = 0; r < 16; ++r) pmax = fmaxf(pmax, p1[r]);
    { auto rr = __builtin_amdgcn_permlane32_swap(__float_as_uint(pmax), __float_as_uint(pmax), false, false);
      pmax = fmaxf(__uint_as_float(rr[0]), __uint_as_float(rr[1])); }
    float mn;
    if (__builtin_expect(__all(pmax - m_reg <= THR), 1)) { mn = m_reg; alpha = 1.f; }
    else { mn = fmaxf(m_reg, pmax); alpha = __builtin_amdgcn_exp2f(m_reg - mn); m_reg = mn; }
#pragma unroll
    for (int r = 0; r < 16; ++r) p0[r] = p0[r] - mn;
#pragma unroll
    for (int r = 0; r < 16; ++r) p1[r] = p1[r] - mn;
#pragma unroll
    for (int r = 0; r < 16; ++r) p0[r] = __builtin_amdgcn_exp2f(p0[r]);
}
__device__ __forceinline__ void finishSM(f32x16& p0, f32x16& p1, float alpha, float& l_reg, bf16x8& pa0, bf16x8& pa1, bf16x8& pa2, bf16x8& pa3) {
#pragma unroll
    for (int r = 0; r < 16; ++r) p1[r] = __builtin_amdgcn_exp2f(p1[r]);
    float ps = 0;
#pragma unroll
    for (int r = 0; r < 16; ++r) ps += p0[r];
#pragma unroll
    for (int r = 0; r < 16; ++r) ps += p1[r];
    { auto rr = __builtin_amdgcn_permlane32_swap(__float_as_uint(ps), __float_as_uint(ps), false, false);
      ps = __uint_as_float(rr[0]) + __uint_as_float(rr[1]); }
    l_reg = l_reg * alpha + ps;
#define PK4(P, BASE, OUT) do { unsigned a0 = cvtpk(P[BASE + 0], P[BASE + 1]), a1 = cvtpk(P[BASE + 2], P[BASE + 3]);   \
    unsigned b0 = cvtpk(P[BASE + 4], P[BASE + 5]), b1 = cvtpk(P[BASE + 6], P[BASE + 7]);                              \
    auto r0 = __builtin_amdgcn_permlane32_swap(a0, b0, false, false); auto r1 = __builtin_amdgcn_permlane32_swap(a1, b1, false, false); \
    u32x4 w = {r0[0], r1[0], r0[1], r1[1]}; OUT = *reinterpret_cast<bf16x8*>(&w); } while (0)
    PK4(p0, 0, pa0); PK4(p0, 8, pa1); PK4(p1, 0, pa2); PK4(p1, 8, pa3);
#undef PK4
}
__device__ __forceinline__ void qkt(f32x16& p0, f32x16& p1, const char* Kn, const char* Kr, const bf16x8* qr, const char* qrl, int r32, int hi) {
    p0 = f32x16{}; p1 = f32x16{};
#pragma unroll
    for (int d0 = 0; d0 < 8; ++d0) { const int cb = (d0 * 16 + hi * 8) * 2;
        const bf16x8 b0 = *reinterpret_cast<const bf16x8*>(Kn + KSWZ(r32, cb));
        const bf16x8 b1 = *reinterpret_cast<const bf16x8*>(Kn + KSWZ(32 + r32, cb));
        p0 = __builtin_amdgcn_mfma_f32_32x32x16_bf16(b0, qr[d0], p0, 0, 0, 0);
        p1 = __builtin_amdgcn_mfma_f32_32x32x16_bf16(b1, qr[d0], p1, 0, 0, 0); }
#pragma unroll
    for (int d0 = 0; d0 < 4; ++d0) { const int cb = (d0 * 16 + hi * 8) * 2;
        const bf16x8 b0 = *reinterpret_cast<const bf16x8*>(Kr + RSWZ(r32, cb));
        const bf16x8 b1 = *reinterpret_cast<const bf16x8*>(Kr + RSWZ(32 + r32, cb));
        const bf16x8 qf = *reinterpret_cast<const bf16x8*>(qrl + d0 * 1024);
        p0 = __builtin_amdgcn_mfma_f32_32x32x16_bf16(b0, qf, p0, 0, 0, 0);
        p1 = __builtin_amdgcn_mfma_f32_32x32x16_bf16(b1, qf, p1, 0, 0, 0); }
}
__device__ __forceinline__ int v_st(int k, int c) { const int kk = (k & ~0xC) | ((k & 4) << 1) | ((k & 8) >> 1); return ((kk >> 3) * 4 + (c >> 5)) * 512 + ((kk & 7) * 32 + (c & 31)) * 2; }
__device__ __forceinline__ int v_rd_base(int lane) { return ((lane & 3) << 3) | (((lane >> 2) & 3) << 6) | (((lane >> 4) & 1) << 5) | (((lane >> 5) & 1) << 8); }
constexpr int v_rd_off(int d0, int ks, int half) { return d0 * 512 + ks * 4096 + half * 2048; }
template <int OFF> __device__ __forceinline__ s16x4 tr_read(int vb) { s16x4 r; asm volatile("ds_read_b64_tr_b16 %0, %1 offset:%2" : "=&v"(r) : "v"(vb), "i"(OFF) : "memory"); return r; }
template <int C> __device__ __forceinline__ void pv_one(f32x16& od, int bt0, int bt1, bf16x8 pa0, bf16x8 pa1, bf16x8 pa2, bf16x8 pa3) {
    const int a0 = bt0 ^ (C << 6), a1 = bt1 ^ (C << 6);
    const s16x4 l0 = tr_read<0>(a0), h0 = tr_read<0>(a1), l1 = tr_read<4096>(a0), h1 = tr_read<4096>(a1);
    const s16x4 l2 = tr_read<8192>(a0), h2 = tr_read<8192>(a1), l3 = tr_read<12288>(a0), h3 = tr_read<12288>(a1);
    asm volatile("s_waitcnt lgkmcnt(0)" ::: "memory"); SBAR();
#define PK(L, H) (bf16x8){L[0], L[1], L[2], L[3], H[0], H[1], H[2], H[3]}
    od = __builtin_amdgcn_mfma_f32_32x32x16_bf16(pa0, PK(l0, h0), od, 0, 0, 0);
    od = __builtin_amdgcn_mfma_f32_32x32x16_bf16(pa1, PK(l1, h1), od, 0, 0, 0);
    od = __builtin_amdgcn_mfma_f32_32x32x16_bf16(pa2, PK(l2, h2), od, 0, 0, 0);
    od = __builtin_amdgcn_mfma_f32_32x32x16_bf16(pa3, PK(l3, h3), od, 0, 0, 0);
#undef PK
}
__device__ __forceinline__ void pv_d0(f32x16* o, int bt0, int bt1, bf16x8 pa0, bf16x8 pa1, bf16x8 pa2, bf16x8 pa3) {
    pv_one<0>(o[0], bt0, bt1, pa0, pa1, pa2, pa3); pv_one<1>(o[1], bt0, bt1, pa0, pa1, pa2, pa3); pv_one<2>(o[2], bt0, bt1, pa0, pa1, pa2, pa3); pv_one<3>(o[3], bt0, bt1, pa0, pa1, pa2, pa3);
}
__device__ __forceinline__ int tr_base(int lane, int t) {
    const int h = lane >> 5, blk = (lane >> 4) & 1, q = (lane & 15) >> 2, p = lane & 3, row = 8 * h + 4 * t + q, ch = 2 * blk + (p >> 1);
    return KSWZ(row, ch * 16) + 8 * (p & 1);
}

__device__ __forceinline__ void attn_unit(const bf16_t* __restrict__ Qb, const bf16_t* __restrict__ Kb, bf16_t* __restrict__ Ob, char* lds) {
    const int tid = threadIdx.x, wid = tid >> 6, lane = tid & 63, r32 = lane & 31, hi = lane >> 5;
    char* Kn_l = lds + L_KN; char* Kr_l = lds + L_KR;
    float* ws = (float*)(lds + L_WS) + wid * 64; float* li_l = ws; float* al_l = ws + 32;
    float m_reg = -1e30f, l_reg = 0; f32x16 o[4] = {}; bf16x8 qr[8];
    const bf16_t* Qw = Qb + (size_t)(wid * 32 + r32) * 1536 + hi * 8;
    char* qrl = lds + L_QR + wid * 4096 + lane * 16;
#pragma unroll
    for (int d0 = 0; d0 < 8; ++d0) qr[d0] = *reinterpret_cast<const bf16x8*>(Qw + d0 * 16);
#pragma unroll
    for (int d0 = 0; d0 < 4; ++d0) *reinterpret_cast<bf16x8*>(qrl + d0 * 1024) = *reinterpret_cast<const bf16x8*>(Qw + (8 + d0) * 16);
    const int sr = tid >> 3, sc8 = tid & 7;
    const int kst0 = KSWZ(sr, sc8 * 16), kst1 = KSWZ(sr, 128 + sc8 * 16), rst = RSWZ(sr, sc8 * 16);
    const int bt0 = (int)(uintptr_t)Kn_l + tr_base(lane, 0), bt1 = (int)(uintptr_t)Kn_l + tr_base(lane, 1);
    bf16x8 s0, s1, s2;
#define SLOAD(mt) do { const bf16_t* kp = Kb + (size_t)((mt) * 64 + sr) * 192 + sc8 * 8; s0 = *reinterpret_cast<const bf16x8*>(kp); s1 = *reinterpret_cast<const bf16x8*>(kp + 64); s2 = *reinterpret_cast<const bf16x8*>(kp + 128); } while (0)
#define SWRITE(b) do { *(bf16x8*)(Kn_l + (b) * KN_B + kst0) = s0; *(bf16x8*)(Kn_l + (b) * KN_B + kst1) = s1; *(bf16x8*)(Kr_l + (b) * KR_B + rst) = s2; } while (0)
#define RESC(a) do { if (__any((a) < 1.f)) { if (hi == 0) al_l[r32] = (a); asm volatile("s_waitcnt lgkmcnt(0)" ::: "memory"); \
        _Pragma("unroll") for (int d = 0; d < 4; ++d) _Pragma("unroll") for (int r = 0; r < 16; ++r) o[d][r] *= al_l[crow(r, hi)]; } } while (0)
    f32x16 pA0, pA1, pB0, pB1; float alA, alB; bf16x8 pa0, pa1, pa2, pa3;
    constexpr int NTL = 65;
    SLOAD(64); asm volatile("s_waitcnt vmcnt(0)" ::: "memory"); SWRITE(0); __syncthreads();
    qkt(pA0, pA1, Kn_l, Kr_l, qr, qrl, r32, hi);
#pragma unroll
    for (int r = 8; r < 16; ++r) pA0[r] = -1e30f;
#pragma unroll
    for (int r = 0; r < 16; ++r) pA1[r] = -1e30f;
    partialSM(pA0, pA1, m_reg, alA);
    SLOAD(0); asm volatile("s_waitcnt vmcnt(0)" ::: "memory"); SWRITE(1); __syncthreads();
#pragma unroll 1
    for (int j = 1; j + 1 < NTL; j += 2) {
        SBAR(); qkt(pB0, pB1, Kn_l + KN_B, Kr_l + KR_B, qr, qrl, r32, hi);
        finishSM(pA0, pA1, alA, l_reg, pa0, pa1, pa2, pa3); SBAR();
        SLOAD(j); SBAR();
        pv_d0(o, bt0, bt1, pa0, pa1, pa2, pa3); partialSM(pB0, pB1, m_reg, alB);
        __syncthreads(); asm volatile("s_waitcnt vmcnt(0)" ::: "memory"); SWRITE(0);
        RESC(alB); __syncthreads();
        SBAR(); qkt(pA0, pA1, Kn_l, Kr_l, qr, qrl, r32, hi);
        finishSM(pB0, pB1, alB, l_reg, pa0, pa1, pa2, pa3); SBAR();
        if (j + 2 < NTL) SLOAD(j + 1); SBAR();
        pv_d0(o, bt0 + KN_B, bt1 + KN_B, pa0, pa1, pa2, pa3); partialSM(pA0, pA1, m_reg, alA);
        __syncthreads(); asm volatile("s_waitcnt vmcnt(0)" ::: "memory"); if (j + 2 < NTL) SWRITE(1);
        RESC(alA); __syncthreads();
    }
    finishSM(pA0, pA1, alA, l_reg, pa0, pa1, pa2, pa3); SBAR();
    pv_d0(o, bt0, bt1, pa0, pa1, pa2, pa3);
    if (hi == 0) li_l[r32] = l_reg; asm volatile("s_waitcnt lgkmcnt(0)" ::: "memory");
    float rli[16];
#pragma unroll
    for (int r = 0; r < 16; ++r) rli[r] = __builtin_amdgcn_rcpf(li_l[crow(r, hi)]);
    bf16_t* Ow = Ob + (size_t)(wid * 32) * 1024;
#pragma unroll
    for (int r = 0; r < 16; ++r) { const int orow = crow(r, hi);
#pragma unroll
        for (int d0 = 0; d0 < 4; ++d0) Ow[(size_t)orow * 1024 + d0 * 32 + r32] = f2bf(o[d0][r] * rli[r]); }
    __syncthreads();
#undef SLOAD
#undef SWRITE
#undef RESC
}
#undef KSWZ
#undef RSWZ
#undef SBAR
}

__device__ __forceinline__ void phase_attn(const Params& p, char* lds, int vcu, int G) {
    for (int u = vcu; u < NB * 8 * 16; u += G) {
        const int b = u >> 7, h = (u >> 4) & 7, qb = u & 15;
        const size_t r0 = (size_t)b * SEQ + qb * 256;
        att::attn_unit(p.QP() + r0 * 1536 + h * 192, p.Kc() + (size_t)b * KVROWS * 192, p.OA() + r0 * 1024 + h * 128, lds);
    }
}

namespace ml {
using att::s16x4; using att::f32x16; using att::crow; using att::cvtpk; using att::v_st; using att::v_rd_base; using att::tr_read; using att::v_rd_off;
#define RSWZ(row, colB) ((row) * 128 + ((colB) ^ ((((row) >> 1) & 7) << 4)))
#define SBAR() __builtin_amdgcn_sched_barrier(0)
__device__ __forceinline__ void pv_blk(f32x16& od, int vb, bf16x8 pa0, bf16x8 pa1, bf16x8 pa2, bf16x8 pa3) {
    const s16x4 l0 = tr_read<v_rd_off(0, 0, 0)>(vb), h0 = tr_read<v_rd_off(0, 0, 1)>(vb), l1 = tr_read<v_rd_off(0, 1, 0)>(vb), h1 = tr_read<v_rd_off(0, 1, 1)>(vb);
    const s16x4 l2 = tr_read<v_rd_off(0, 2, 0)>(vb), h2 = tr_read<v_rd_off(0, 2, 1)>(vb), l3 = tr_read<v_rd_off(0, 3, 0)>(vb), h3 = tr_read<v_rd_off(0, 3, 1)>(vb);
    asm volatile("s_waitcnt lgkmcnt(0)" ::: "memory"); SBAR();
#define PK(L, H) (bf16x8){L[0], L[1], L[2], L[3], H[0], H[1], H[2], H[3]}
    od = __builtin_amdgcn_mfma_f32_32x32x16_bf16(pa0, PK(l0, h0), od, 0, 0, 0);
    od = __builtin_amdgcn_mfma_f32_32x32x16_bf16(pa1, PK(l1, h1), od, 0, 0, 0);
    od = __builtin_amdgcn_mfma_f32_32x32x16_bf16(pa2, PK(l2, h2), od, 0, 0, 0);
    od = __builtin_amdgcn_mfma_f32_32x32x16_bf16(pa3, PK(l3, h3), od, 0, 0, 0);
}
template <int KS0> __device__ __forceinline__ void pv_blk2(f32x16& od, int vb, bf16x8 pa, bf16x8 pb) {
    const s16x4 l0 = tr_read<v_rd_off(0, KS0, 0)>(vb), h0 = tr_read<v_rd_off(0, KS0, 1)>(vb), l1 = tr_read<v_rd_off(0, KS0 + 1, 0)>(vb), h1 = tr_read<v_rd_off(0, KS0 + 1, 1)>(vb);
    asm volatile("s_waitcnt lgkmcnt(0)" ::: "memory"); SBAR();
    od = __builtin_amdgcn_mfma_f32_32x32x16_bf16(pa, PK(l0, h0), od, 0, 0, 0);
    od = __builtin_amdgcn_mfma_f32_32x32x16_bf16(pb, PK(l1, h1), od, 0, 0, 0);
}
__device__ __forceinline__ void tt_blk(f32x16& od, int va, int vb) {
    const s16x4 al0 = tr_read<v_rd_off(0, 0, 0)>(va), ah0 = tr_read<v_rd_off(0, 0, 1)>(va), al1 = tr_read<v_rd_off(0, 1, 0)>(va), ah1 = tr_read<v_rd_off(0, 1, 1)>(va);
    const s16x4 al2 = tr_read<v_rd_off(0, 2, 0)>(va), ah2 = tr_read<v_rd_off(0, 2, 1)>(va), al3 = tr_read<v_rd_off(0, 3, 0)>(va), ah3 = tr_read<v_rd_off(0, 3, 1)>(va);
    const s16x4 l0 = tr_read<v_rd_off(0, 0, 0)>(vb), h0 = tr_read<v_rd_off(0, 0, 1)>(vb), l1 = tr_read<v_rd_off(0, 1, 0)>(vb), h1 = tr_read<v_rd_off(0, 1, 1)>(vb);
    const s16x4 l2 = tr_read<v_rd_off(0, 2, 0)>(vb), h2 = tr_read<v_rd_off(0, 2, 1)>(vb), l3 = tr_read<v_rd_off(0, 3, 0)>(vb), h3 = tr_read<v_rd_off(0, 3, 1)>(vb);
    asm volatile("s_waitcnt lgkmcnt(0)" ::: "memory"); SBAR();
    od = __builtin_amdgcn_mfma_f32_32x32x16_bf16(PK(al0, ah0), PK(l0, h0), od, 0, 0, 0);
    od = __builtin_amdgcn_mfma_f32_32x32x16_bf16(PK(al1, ah1), PK(l1, h1), od, 0, 0, 0);
    od = __builtin_amdgcn_mfma_f32_32x32x16_bf16(PK(al2, ah2), PK(l2, h2), od, 0, 0, 0);
    od = __builtin_amdgcn_mfma_f32_32x32x16_bf16(PK(al3, ah3), PK(l3, h3), od, 0, 0, 0);
#undef PK
}
#define PK4(P, BASE, OUT) do { unsigned a0 = cvtpk(P[BASE + 0], P[BASE + 1]), a1 = cvtpk(P[BASE + 2], P[BASE + 3]);   \
    unsigned b0 = cvtpk(P[BASE + 4], P[BASE + 5]), b1 = cvtpk(P[BASE + 6], P[BASE + 7]);                              \
    auto r0 = __builtin_amdgcn_permlane32_swap(a0, b0, false, false); auto r1 = __builtin_amdgcn_permlane32_swap(a1, b1, false, false); \
    u32x4 w = {r0[0], r1[0], r0[1], r1[1]}; OUT = *reinterpret_cast<bf16x8*>(&w); } while (0)
__device__ __forceinline__ float half_swap_add(float v) { auto rr = __builtin_amdgcn_permlane32_swap(__float_as_uint(v), __float_as_uint(v), false, false); return __uint_as_float(rr[0]) + __uint_as_float(rr[1]); }
__device__ __forceinline__ bf16x8 scale8(bf16x8 v, float s) {
    const u32x4 w = *reinterpret_cast<const u32x4*>(&v); u32x4 o;
    o.x = cvtpk(__uint_as_float(w.x << 16) * s, __uint_as_float(w.x & 0xffff0000u) * s); o.y = cvtpk(__uint_as_float(w.y << 16) * s, __uint_as_float(w.y & 0xffff0000u) * s);
    o.z = cvtpk(__uint_as_float(w.z << 16) * s, __uint_as_float(w.z & 0xffff0000u) * s); o.w = cvtpk(__uint_as_float(w.w << 16) * s, __uint_as_float(w.w & 0xffff0000u) * s);
    return *reinterpret_cast<bf16x8*>(&o);
}
__device__ __forceinline__ bf16x8 f8_to_bf(const float* p, bool ok) {
    if (!ok) return (bf16x8){0, 0, 0, 0, 0, 0, 0, 0};
    const f32x4 a = *(const f32x4*)p, b = *(const f32x4*)(p + 4); u32x4 o = {cvtpk(a[0], a[1]), cvtpk(a[2], a[3]), cvtpk(b[0], b[1]), cvtpk(b[2], b[3])};
    return *reinterpret_cast<bf16x8*>(&o);
}
template <int K> __device__ __forceinline__ float dpp_shr(float v, float ident) {
    return __int_as_float(__builtin_amdgcn_update_dpp(__float_as_int(ident), __float_as_int(v), 0x110 | K, 0xf, 0xf, false));
}
__device__ __forceinline__ float rdlane(float v, int l) { return __int_as_float(__builtin_amdgcn_readlane(__float_as_int(v), l)); }
__device__ __forceinline__ float wave_incl_sum(float v, int lane) {
    v += dpp_shr<1>(v, 0.f); v += dpp_shr<2>(v, 0.f); v += dpp_shr<4>(v, 0.f); v += dpp_shr<8>(v, 0.f);
    const float s0 = rdlane(v, 15), s1 = rdlane(v, 31), s2 = rdlane(v, 47); const int row = lane >> 4;
    return v + (row >= 1 ? s0 : 0.f) + (row >= 2 ? s1 : 0.f) + (row >= 3 ? s2 : 0.f);
}
__device__ __forceinline__ float wave_incl_max(float v, int lane) {
    const float NI = -3.0e38f;
    v = fmaxf(v, dpp_shr<1>(v, NI)); v = fmaxf(v, dpp_shr<2>(v, NI)); v = fmaxf(v, dpp_shr<4>(v, NI)); v = fmaxf(v, dpp_shr<8>(v, NI));
    const float s0 = rdlane(v, 15), s1 = rdlane(v, 31), s2 = rdlane(v, 47); const int row = lane >> 4;
    return fmaxf(fmaxf(v, row >= 1 ? s0 : NI), fmaxf(row >= 2 ? s1 : NI, row >= 3 ? s2 : NI));
}
__device__ __forceinline__ float wave_max(float v) {
    const float NI = -3.0e38f;
    v = fmaxf(v, dpp_shr<1>(v, NI)); v = fmaxf(v, dpp_shr<2>(v, NI)); v = fmaxf(v, dpp_shr<4>(v, NI)); v = fmaxf(v, dpp_shr<8>(v, NI));
    return fmaxf(fmaxf(rdlane(v, 15), rdlane(v, 31)), fmaxf(rdlane(v, 47), rdlane(v, 63)));
}

constexpr int SC_BUF = 32768;
__device__ __forceinline__ void scan_unit(const Params& p, int b, int h, int dir, char* lds) {
    const int tid = threadIdx.x, wid = tid >> 6, lane = tid & 63, r32 = lane & 31, hi = lane >> 5, db = wid & 1, vq = wid >> 1;
    const int sr = tid >> 3, sc8 = tid & 7;
    const int kst = v_st(sr, sc8 * 8), vst0 = v_st(sr, sc8 * 8), vst1 = v_st(sr, 64 + sc8 * 8);
    const int va0 = (int)(uintptr_t)lds + v_rd_base(lane) + db * 512, vb0 = (int)(uintptr_t)lds + 16384 + v_rd_base(lane) + vq * 512;
    bf16_t* CS = dir ? p.CB() : p.CF(); float* NS = dir ? p.NB_() : p.NF(); float* MS = dir ? p.MB() : p.MF();
    const size_t sbase = (size_t)(b * 8 + h) * 64;
    f32x16 acc = {}; float nacc = 0.f, m = 0.f, decay_prev = 1.f;
    const int nsteps = dir ? 64 : 65;
    bf16x8 sk, sv0, sv1; float gli, glf;
#define ML_LOAD(st) do { const int c_ = dir ? 63 - (st) : (st) - 1; \
        if (c_ < 0) { const float* z = p.ZM() + (size_t)(sr & 15) * DIN; const bool okr = sr < NMETA; \
            sk = f8_to_bf(z + OFF_K + h * 64 + sc8 * 8, okr); sv0 = f8_to_bf(z + OFF_V + h * 128 + sc8 * 8, okr); sv1 = f8_to_bf(z + OFF_V + h * 128 + 64 + sc8 * 8, okr); \
            const float* zl = p.ZM() + (size_t)(lane & 15) * DIN; gli = lane < NMETA ? zl[OFF_I + h] + p.m_b_i[h] : -1e30f; glf = lane < NMETA ? logsigmoidf_(zl[OFF_F + h] + p.m_b_f[h]) : 0.f; } \
        else { const size_t r_ = (size_t)b * SEQ + c_ * 64 + sr; sk = *reinterpret_cast<const bf16x8*>(p.Km() + r_ * 512 + h * 64 + sc8 * 8); \
            sv0 = *reinterpret_cast<const bf16x8*>(p.Vm() + r_ * 1024 + h * 128 + sc8 * 8); sv1 = *reinterpret_cast<const bf16x8*>(p.Vm() + r_ * 1024 + h * 128 + 64 + sc8 * 8); \
            const size_t rg = (size_t)b * SEQ + c_ * 64 + (dir ? 63 - lane : lane); gli = p.GI()[rg * 16 + dir * 8 + h]; glf = p.GF()[rg * 16 + dir * 8 + h]; } } while (0)
#define ML_GATES(decay_, mnew_, wk_) do { const float bc_ = wave_incl_sum(glf, lane); const float bl_ = rdlane(bc_, 63); const float g_ = bl_ - bc_ + gli; \
        mnew_ = fmaxf(bl_ + m, wave_max(g_)); decay_ = __expf(bl_ + m - mnew_); wk_ = __expf(g_ - mnew_); } while (0)
    ML_LOAD(0);
    float decay, mnew, wk;
    { asm volatile("s_waitcnt vmcnt(0)" ::: "memory"); ML_GATES(decay, mnew, wk);
      const float w = __shfl(wk, dir ? 63 - sr : sr);
      *(bf16x8*)(lds + kst) = sk; *(bf16x8*)(lds + 16384 + vst0) = scale8(sv0, w); *(bf16x8*)(lds + 16384 + vst1) = scale8(sv1, w); }
    __syncthreads();
#pragma unroll 1
    for (int st = 0; st < nsteps; ++st) {
        const int c = dir ? 63 - st : st - 1, buf = st & 1;
        if (wid == 0 && st > 0) { float s_ = 0.f; const float* np_ = (const float*)(lds + 65536) + ((st - 1) & 1) * 512;
#pragma unroll
            for (int w8 = 0; w8 < 8; ++w8) s_ += np_[w8 * 64 + lane];
            nacc = nacc * decay_prev + s_; }
        if (c >= 0) {
            const size_t sidx = sbase + c; bf16_t* cd = CS + sidx * 8192 + (size_t)(db * 32) * 128 + vq * 32 + r32;
#pragma unroll
            for (int r = 0; r < 16; ++r) cd[(size_t)crow(r, hi) * 128] = f2bf(acc[r]);
            if (wid == 0) NS[sidx * 64 + lane] = nacc;
            if (tid == 0) MS[sidx] = m;
        }
        if (st == nsteps - 1) break;
        if (st + 1 < nsteps - 1) ML_LOAD(st + 1);
#pragma unroll
        for (int r = 0; r < 16; ++r) acc[r] *= decay;
        tt_blk(acc, va0 + buf * SC_BUF, vb0 + buf * SC_BUF);
        {
            float s_ = 0.f;
#pragma unroll
            for (int q = 0; q < 8; ++q) { const int s = wid * 8 + q; const float w = __shfl(wk, dir ? 63 - s : s); s_ += w * bf2f(*(const bf16_t*)(lds + buf * SC_BUF + v_st(s, lane))); }
            ((float*)(lds + 65536))[(st & 1) * 512 + wid * 64 + lane] = s_;
        }
        decay_prev = decay;
        m = mnew;
        if (st + 1 < nsteps - 1) {
            asm volatile("s_waitcnt vmcnt(0)" ::: "memory"); ML_GATES(decay, mnew, wk);
            const float w = __shfl(wk, dir ? 63 - sr : sr); char* lb = lds + (buf ^ 1) * SC_BUF;
            *(bf16x8*)(lb + kst) = sk; *(bf16x8*)(lb + 16384 + vst0) = scale8(sv0, w); *(bf16x8*)(lb + 16384 + vst1) = scale8(sv1, w);
        }
        __syncthreads();
    }
    __syncthreads();
#undef ML_LOAD
#undef ML_GATES
}

constexpr int O_K = 0, O_V = 8192, O_CF = 24576, O_CB = 40960, O_T = 57344, O_ARR = 122880, O_WS = 125440, O_END = 127488;
struct OutPre { bf16x8 kk, v0, v1, f0, f1, b0, b1, q0, q1, q2, q3; float li, lf, mm, nn; };
__device__ __forceinline__ void out_load(const Params& p, int u, OutPre& R) {
    const int tid = threadIdx.x, wid = tid >> 6, lane = tid & 63, r32 = lane & 31, hi = lane >> 5, tb = wid & 1;
    const int b = u >> 9, h = u & 7, c = (u >> 3) & 63; const size_t r0 = (size_t)b * SEQ + c * 64, sidx = (size_t)(b * 8 + h) * 64 + c;
    const int sr = tid >> 3, sc8 = tid & 7;
    R.kk = *reinterpret_cast<const bf16x8*>(p.Km() + (r0 + sr) * 512 + h * 64 + sc8 * 8);
    const bf16_t* vp = p.Vm() + (r0 + sr) * 1024 + h * 128 + sc8 * 8; R.v0 = *reinterpret_cast<const bf16x8*>(vp); R.v1 = *reinterpret_cast<const bf16x8*>(vp + 64);
    const bf16_t* cf = p.CF() + sidx * 8192 + (size_t)sr * 128 + sc8 * 8; R.f0 = *reinterpret_cast<const bf16x8*>(cf); R.f1 = *reinterpret_cast<const bf16x8*>(cf + 64);
    const bf16_t* cb = p.CB() + sidx * 8192 + (size_t)sr * 128 + sc8 * 8; R.b0 = *reinterpret_cast<const bf16x8*>(cb); R.b1 = *reinterpret_cast<const bf16x8*>(cb + 64);
    const bf16_t* qp = p.Qm() + (r0 + tb * 32 + r32) * 512 + h * 64 + hi * 8;
    R.q0 = *reinterpret_cast<const bf16x8*>(qp); R.q1 = *reinterpret_cast<const bf16x8*>(qp + 16); R.q2 = *reinterpret_cast<const bf16x8*>(qp + 32); R.q3 = *reinterpret_cast<const bf16x8*>(qp + 48);
    R.li = 0.f; R.lf = 0.f; R.mm = 0.f; R.nn = 0.f;
    if (wid < 2) { const int dir = wid, t = dir ? 63 - lane : lane; R.li = p.GI()[(r0 + t) * 16 + dir * 8 + h]; R.lf = p.GF()[(r0 + t) * 16 + dir * 8 + h]; R.mm = (dir ? p.MB() : p.MF())[sidx]; }
    else if (wid < 4) { const int dir = wid - 2; R.nn = (dir ? p.NB_() : p.NF())[sidx * 64 + lane]; }
}
__device__ __forceinline__ void phase_mlstm_out_body(const Params& p, char* lds, int vcu, int G) {
    const int tid = threadIdx.x, wid = tid >> 6, lane = tid & 63, r32 = lane & 31, hi = lane >> 5, tb = wid & 1, vq = wid >> 1;
    const int sr = tid >> 3, sc8 = tid & 7;
    float* arr = (float*)(lds + O_ARR);
    float* nbuf = arr + 512;
    float* wsc = (float*)(lds + O_WS) + wid * 64;
    const int NU = NB * 8 * 64;
    OutPre R;
    if (vcu < NU) out_load(p, vcu, R);
#pragma unroll 1
    for (int u = vcu; u < NU; u += G) {
        const int b = u >> 9, h = u & 7, c = (u >> 3) & 63; const size_t r0 = (size_t)b * SEQ + c * 64;
        { *(bf16x8*)(lds + O_K + RSWZ(sr, sc8 * 16)) = R.kk;
          const int s0 = v_st(sr, sc8 * 8), s1 = v_st(sr, 64 + sc8 * 8);
          *(bf16x8*)(lds + O_V + s0) = R.v0; *(bf16x8*)(lds + O_V + s1) = R.v1; *(bf16x8*)(lds + O_CF + s0) = R.f0; *(bf16x8*)(lds + O_CF + s1) = R.f1; *(bf16x8*)(lds + O_CB + s0) = R.b0; *(bf16x8*)(lds + O_CB + s1) = R.b1; }
        if (wid < 2) {
            const int dir = wid, t = dir ? 63 - lane : lane; const float m = R.mm;
            const float bc = wave_incl_sum(R.lf, lane), a = R.li - bc, pm = wave_incl_max(a, lane), mx = fmaxf(m, pm);
            float* ar = arr + dir * 256;
            ar[t] = -mx * 1.4426950408889634f; ar[64 + t] = a * 1.4426950408889634f; ar[128 + t] = __expf(m - mx); ar[192 + t] = __expf(-(bc + mx));
        } else if (wid < 4) nbuf[(wid - 2) * 64 + lane] = R.nn;
        bf16x8 qr[4] = {R.q0, R.q1, R.q2, R.q3};
        __syncthreads();
        if (u + G < NU) out_load(p, u + G, R);
        const int ocol = h * 128 + sc8 * 16; const size_t oo = (r0 + sr) * 1024 + ocol;
        const u32x4 og = *(const u32x4*)((const unsigned char*)p.OG() + oo);
        const f32x4 n0 = *(const f32x4*)(p.m_norm + ocol), n1 = *(const f32x4*)(p.m_norm + ocol + 4), n2 = *(const f32x4*)(p.m_norm + ocol + 8), n3 = *(const f32x4*)(p.m_norm + ocol + 12);
        const int dir = (wid >> 1) & 1, vh = wid >> 2;
        float qn;
        { const float* nv = nbuf + dir * 64 + hi * 8; float s_ = 0.f;
#pragma unroll
          for (int d0 = 0; d0 < 4; ++d0) { const u32x4 w = *reinterpret_cast<const u32x4*>(&qr[d0]); const f32x4 n0 = *(const f32x4*)(nv + d0 * 16), n1 = *(const f32x4*)(nv + d0 * 16 + 4);
              s_ += __uint_as_float(w.x << 16) * n0[0] + __uint_as_float(w.x & 0xffff0000u) * n0[1] + __uint_as_float(w.y << 16) * n0[2] + __uint_as_float(w.y & 0xffff0000u) * n0[3]
                  + __uint_as_float(w.z << 16) * n1[0] + __uint_as_float(w.z & 0xffff0000u) * n1[1] + __uint_as_float(w.w << 16) * n1[2] + __uint_as_float(w.w & 0xffff0000u) * n1[3]; }
          qn = half_swap_add(s_); }
        f32x16 p0 = {}, p1 = {};
        const bool has0 = !(dir == 1 && tb == 1), has1 = !(dir == 0 && tb == 0);
#pragma unroll
        for (int d0 = 0; d0 < 4; ++d0) { const int cb = (d0 * 16 + hi * 8) * 2;
            if (has0) { const bf16x8 k0 = *reinterpret_cast<const bf16x8*>(lds + O_K + RSWZ(r32, cb)); p0 = __builtin_amdgcn_mfma_f32_32x32x16_bf16(k0, qr[d0], p0, 0, 0, 0); }
            if (has1) { const bf16x8 k1 = *reinterpret_cast<const bf16x8*>(lds + O_K + RSWZ(32 + r32, cb)); p1 = __builtin_amdgcn_mfma_f32_32x32x16_bf16(k1, qr[d0], p1, 0, 0, 0); } }
        const int t = tb * 32 + r32;
        const int vbase = (int)(uintptr_t)lds + v_rd_base(lane) + vh * 1024;
#define W_FULL(P, W, SB) _Pragma("unroll") for (int g = 0; g < 4; ++g) { const f32x4 ct = *(const f32x4*)(ar + 64 + (SB) + 8 * g + 4 * hi); \
            _Pragma("unroll") for (int q = 0; q < 4; ++q) { const float x = __builtin_amdgcn_exp2f(rt + ct[q]) * P[4 * g + q]; W[4 * g + q] = x; rs += x; } }
#define W_DIAG(P, W, SB) _Pragma("unroll") for (int g = 0; g < 4; ++g) { const f32x4 ct = *(const f32x4*)(ar + 64 + (SB) + 8 * g + 4 * hi); \
            _Pragma("unroll") for (int q = 0; q < 4; ++q) { const int sl = 8 * g + 4 * hi + q; const bool ok = dir ? (sl >= r32) : (sl <= r32); \
                const float x = ok ? __builtin_amdgcn_exp2f(rt + ct[q]) * P[4 * g + q] : 0.f; W[4 * g + q] = x; rs += x; } }
        {
            const float* ar = arr + dir * 256; const float rt = ar[t], sint = ar[128 + t], efl = ar[192 + t];
            f32x16 w0, w1; float rs = 0.f;
            if (tb == 0) { W_DIAG(p0, w0, 0) if (dir == 1) { W_FULL(p1, w1, 32) } }
            else         { W_DIAG(p1, w1, 32) if (dir == 0) { W_FULL(p0, w0, 0) } }
            rs = half_swap_add(rs);
            bf16x8 pa0, pa1, pa2, pa3;
            if (has0) { PK4(w0, 0, pa0); PK4(w0, 8, pa1); }
            if (has1) { PK4(w1, 0, pa2); PK4(w1, 8, pa3); }
            const float den = rs + sint * qn, inv = 1.f / fmaxf(fabsf(den), efl);
            if (hi == 0) { wsc[r32] = sint; wsc[32 + r32] = inv; }
            f32x16 o0 = {}, o1 = {};
            pv_blk(o0, vbase + (dir ? O_CB : O_CF), qr[0], qr[1], qr[2], qr[3]);
            pv_blk(o1, vbase + (dir ? O_CB : O_CF) + 512, qr[0], qr[1], qr[2], qr[3]);
            asm volatile("s_waitcnt lgkmcnt(0)" ::: "memory");
#pragma unroll
            for (int g = 0; g < 4; ++g) { const f32x4 sc = *(const f32x4*)(wsc + 8 * g + 4 * hi);
#pragma unroll
                for (int q = 0; q < 4; ++q) { o0[4 * g + q] *= sc[q]; o1[4 * g + q] *= sc[q]; } }
            if (has0) { pv_blk2<0>(o0, vbase + O_V, pa0, pa1); pv_blk2<0>(o1, vbase + O_V + 512, pa0, pa1); }
            if (has1) { pv_blk2<2>(o0, vbase + O_V, pa2, pa3); pv_blk2<2>(o1, vbase + O_V + 512, pa2, pa3); }
            float* T = (float*)(lds + O_T + dir * 32768) + (size_t)(tb * 32) * 128 + vh * 64 + r32;
#pragma unroll
            for (int g = 0; g < 4; ++g) { const f32x4 sc = *(const f32x4*)(wsc + 32 + 8 * g + 4 * hi);
#pragma unroll
                for (int q = 0; q < 4; ++q) { const int rw = 8 * g + 4 * hi + q; T[rw * 128] = o0[4 * g + q] * sc[q]; T[rw * 128 + 32] = o1[4 * g + q] * sc[q]; } }
        }
#undef W_FULL
#undef W_DIAG
        __syncthreads();
        { const float* T = (const float*)(lds + O_T) + sr * 128 + sc8 * 16; f32x4 v[4]; float ss = 0.f;
#pragma unroll
          for (int q = 0; q < 4; ++q) { v[q] = *(const f32x4*)(T + q * 4) + *(const f32x4*)(T + 8192 + q * 4); ss += v[q][0] * v[q][0] + v[q][1] * v[q][1] + v[q][2] * v[q][2] + v[q][3] * v[q][3]; }
          ss += __shfl_xor(ss, 1); ss += __shfl_xor(ss, 2); ss += __shfl_xor(ss, 4);
          const float rstd = rsqrtf(ss * (1.f / 128.f) + EPS);
          const f32x4 g0 = up4_u8(og.x), g1 = up4_u8(og.y), g2 = up4_u8(og.z), g3 = up4_u8(og.w);
          st8_bf16(p.HM() + oo, v[0] * rstd * n0 * g0, v[1] * rstd * n1 * g1); st8_bf16(p.HM() + oo + 8, v[2] * rstd * n2 * g2, v[3] * rstd * n3 * g3); }
    }
    __syncthreads();
}
#undef PK4
#undef RSWZ
#undef SBAR
}

__device__ __forceinline__ void phase_mlstm_scan(const Params& p, char* lds, int vcu, int G) {
    for (int u = vcu; u < NB * 8 * 2; u += G) ml::scan_unit(p, u >> 4, (u >> 1) & 7, u & 1, lds);
}
__device__ __forceinline__ void phase_mlstm_out(const Params& p, char* lds, int vcu, int G) {
    ml::phase_mlstm_out_body(p, lds, vcu, G);
}

#define RS_STEP(IN, OUT, N, BIT, MASK) _Pragma("unroll") for (int i_ = 0; i_ < (N); ++i_) { const float keep_ = (BIT) ? IN[(N) + i_] : IN[i_], send_ = (BIT) ? IN[i_] : IN[(N) + i_]; OUT[i_] = keep_ + __shfl_xor(send_, (MASK)); }
__device__ __forceinline__ float route_reduce(const float (&v)[32], int lane) {
    const int b5 = (lane >> 5) & 1, b4 = (lane >> 4) & 1, b3 = (lane >> 3) & 1, b2 = (lane >> 2) & 1, b1 = (lane >> 1) & 1;
    float a16[16], a8[8], a4[4], a2[2], a1[1];
    RS_STEP(v, a16, 16, b5, 32) RS_STEP(a16, a8, 8, b4, 16) RS_STEP(a8, a4, 4, b3, 8) RS_STEP(a4, a2, 2, b2, 4) RS_STEP(a2, a1, 1, b1, 2)
    return a1[0] + __shfl_xor(a1[0], 1);
}
__device__ __forceinline__ int route_rank(float val, int myexp) {
    int cnt = 0;
#pragma unroll
    for (int e = 0; e < 32; ++e) { const float ve = __int_as_float(__builtin_amdgcn_readlane(__float_as_int(val), 2 * e)); cnt += (ve > val || (ve == val && e < myexp)) ? 1 : 0; }
    return cnt;
}
__device__ __forceinline__ void phase_route(const Params& p, char* lds, int vcu, int G) {
    constexpr int XST = 1028;
    float* xs = (float*)lds;
    float* part = (float*)(lds + 65792);
    unsigned short* ent = (unsigned short*)(lds + 84224);
    int* lcount = (int*)(lds + 88320); int* lbase = lcount + 32;
    float* rec = (float*)(lds + 88576);
    const int tid = threadIdx.x, lane = tid & 63, w = tid >> 6, q4 = lane >> 4, l15 = lane & 15;
    __syncthreads();
    if (tid < 32) lcount[tid] = 0;
    float breg0[32], breg1[32];
#pragma unroll
    for (int i = 0; i < 32; ++i) { const float* wr = p.w_router + (size_t)(128 * w + 4 * i + q4) * NEXP + l15; breg0[i] = wr[0]; breg1[i] = wr[16]; }
    const int te = lane & 31, tsel = lane >> 5;
    const float mybias = p.b_router[te];
    int nloc = 0;
    float4 pa_[4], pb_[4];
    if (vcu * 16 < NT) {
#pragma unroll
        for (int j = 0; j < 4; ++j) { pa_[j] = ntld_h1(p.H1() + (size_t)(vcu * 16 + w * 2) * DM + (j * 64 + lane) * 4); pb_[j] = ntld_h1(p.H1() + (size_t)(vcu * 16 + w * 2 + 1) * DM + (j * 64 + lane) * 4); } }
#pragma unroll 1
    for (int base = vcu * 16; base < NT; base += G * 16, nloc += 16) {
        const int row0 = base + w * 2;
        float4 xa[4], xb[4]; float sa = 0.f, sb = 0.f;
#pragma unroll
        for (int j = 0; j < 4; ++j) { xa[j] = pa_[j]; xb[j] = pb_[j]; }
        { const int nb_ = base + G * 16; if (nb_ < NT) {
#pragma unroll
            for (int j = 0; j < 4; ++j) { pa_[j] = ntld_h1(p.H1() + (size_t)(nb_ + w * 2) * DM + (j * 64 + lane) * 4); pb_[j] = ntld_h1(p.H1() + (size_t)(nb_ + w * 2 + 1) * DM + (j * 64 + lane) * 4); } } }
#pragma unroll
        for (int j = 0; j < 4; ++j) { sa += xa[j].x * xa[j].x + xa[j].y * xa[j].y + xa[j].z * xa[j].z + xa[j].w * xa[j].w; sb += xb[j].x * xb[j].x + xb[j].y * xb[j].y + xb[j].z * xb[j].z + xb[j].w * xb[j].w; }
        const float ra = rsqrtf(wave_sum(sa) * (1.f / DM) + EPS), rb = rsqrtf(wave_sum(sb) * (1.f / DM) + EPS);
#pragma unroll
        for (int j = 0; j < 4; ++j) { const int c = (j * 64 + lane) * 4; const float4 g = *(const float4*)(p.norm_ffn + c);
            xa[j] = make_float4(xa[j].x * ra * g.x, xa[j].y * ra * g.y, xa[j].z * ra * g.z, xa[j].w * ra * g.w);
            xb[j] = make_float4(xb[j].x * rb * g.x, xb[j].y * rb * g.y, xb[j].z * rb * g.z, xb[j].w * rb * g.w);
            *(float4*)&xs[(w * 2) * XST + c] = xa[j]; *(float4*)&xs[(w * 2 + 1) * XST + c] = xb[j];
            *(unsigned*)((unsigned char*)p.XN2() + (size_t)row0 * DM + c) = pk4_fp8(xa[j].x, xa[j].y, xa[j].z, xa[j].w);
            *(unsigned*)((unsigned char*)p.XN2() + (size_t)(row0 + 1) * DM + c) = pk4_fp8(xb[j].x, xb[j].y, xb[j].z, xb[j].w); }
        __syncthreads();
        f32x4 acc0 = {0.f, 0.f, 0.f, 0.f}, acc1 = {0.f, 0.f, 0.f, 0.f};
        const float* xp = xs + l15 * XST + 128 * w + q4;
#pragma unroll
        for (int i = 0; i < 32; ++i) { const float a = xp[4 * i];
            acc0 = __builtin_amdgcn_mfma_f32_16x16x4f32(a, breg0[i], acc0, 0, 0, 0); acc1 = __builtin_amdgcn_mfma_f32_16x16x4f32(a, breg1[i], acc1, 0, 0, 0); }
#pragma unroll
        for (int r = 0; r < 4; ++r) { part[(w * 16 + 4 * q4 + r) * 32 + l15] = acc0[r]; part[(w * 16 + 4 * q4 + r) * 32 + 16 + l15] = acc1[r]; }
        __syncthreads();
        float val = mybias;
#pragma unroll
        for (int w8 = 0; w8 < 8; ++w8) val += part[(w8 * 16 + 2 * w + tsel) * 32 + te];
        int cnt = 0;
#pragma unroll
        for (int e = 0; e < 32; ++e) { const float v0 = __int_as_float(__builtin_amdgcn_readlane(__float_as_int(val), e)), v1 = __int_as_float(__builtin_amdgcn_readlane(__float_as_int(val), 32 + e));
            const float ve = tsel ? v1 : v0; cnt += (ve > val || (ve == val && e < te)) ? 1 : 0; }
        float* rc = rec + w * 16 + tsel * 8;
        if (cnt < 4) { rc[cnt * 2] = __int_as_float(te); rc[cnt * 2 + 1] = val; }
        asm volatile("s_waitcnt lgkmcnt(0)" ::: "memory");
        if (te == 0) {
            const int row = row0 + tsel, tl = nloc + w * 2 + tsel; float ex[4], sum = 0.f; int tx[4];
#pragma unroll
            for (int kk = 0; kk < 4; ++kk) { tx[kk] = __float_as_int(rc[kk * 2]); ex[kk] = __expf(rc[kk * 2 + 1] - rc[1]); sum += ex[kk]; }
            const float inv = 1.f / sum;
#pragma unroll
            for (int kk = 0; kk < 4; ++kk) { const int e = tx[kk]; p.TOPI()[row * 4 + kk] = e; p.TOPW()[row * 4 + kk] = ex[kk] * inv;
                const int lr = atomicAdd(&lcount[e], 1); ent[tl * 4 + kk] = (unsigned short)(e | (lr << 5)); }
        }
        asm volatile("s_waitcnt lgkmcnt(0)" ::: "memory");
    }
    __syncthreads();
    if (tid < 32) lbase[tid] = atomicAdd(&p.CNT()[tid * CNT_STRIDE], lcount[tid]);
    __syncthreads();
    for (int idx = tid; idx < nloc * 4; idx += MK_THREADS) { const int tl = idx >> 2, row = vcu * 16 + (tl >> 4) * G * 16 + (tl & 15); const unsigned en = ent[idx];
        p.RANK()[row * 4 + (idx & 3)] = lbase[en & 31] + (int)(en >> 5); }
    __syncthreads();
}
#undef RS_STEP
__device__ __forceinline__ void phase_scatter(const Params& p, char* lds, int vcu, int G) {
    int* ps = (int*)lds;
    __syncthreads();
    if (threadIdx.x == 0) { int s = 0; for (int e = 0; e < NEXP; ++e) { ps[e] = s; s += (p.CNT()[e * CNT_STRIDE] + 255) / 256 * 256; } }
    __syncthreads();
    for (int gid = vcu * MK_THREADS + threadIdx.x; gid < NT * 4; gid += G * MK_THREADS) { const int slot = ps[p.TOPI()[gid]] + p.RANK()[gid]; p.SLOTS()[gid] = slot; p.SLOT_TOK()[slot] = gid >> 2; }
    __syncthreads();
}
__device__ __forceinline__ void phase_combine(const Params& p, int vcu, int G, float* dst) {
    const int lane = threadIdx.x & 63, gw = vcu * 8 + (threadIdx.x >> 6), NGW = G * 8;
    for (int r = gw * 2; r < NT; r += NGW * 2) {
        int sl[8]; float tw[8];
#pragma unroll
        for (int q = 0; q < 8; ++q) { sl[q] = p.SLOTS()[r * 4 + q]; tw[q] = p.TOPW()[r * 4 + q]; }
        float4 v[8];
#pragma unroll
        for (int j = 0; j < 4; ++j) { v[j] = ntld_h1(p.H1() + (size_t)r * DM + (j * 64 + lane) * 4); v[4 + j] = ntld_h1(p.H1() + (size_t)(r + 1) * DM + (j * 64 + lane) * 4); }
        unsigned y[8][4];
#pragma unroll
        for (int q = 0; q < 8; ++q)
#pragma unroll
            for (int j = 0; j < 4; ++j) y[q][j] = __builtin_nontemporal_load((const unsigned*)((const unsigned char*)p.YB() + (size_t)sl[q] * DM + (j * 64 + lane) * 4));
#pragma unroll
        for (int q = 0; q < 8; ++q) { const float w = tw[q] * (1.f / YB_SCALE); const int o = (q >> 2) * 4;
#pragma unroll
            for (int j = 0; j < 4; ++j) { const f32x2 lo = __builtin_amdgcn_cvt_pk_f32_fp8((int)y[q][j], false), hi = __builtin_amdgcn_cvt_pk_f32_fp8((int)y[q][j], true);
                v[o + j].x += w * lo[0]; v[o + j].y += w * lo[1]; v[o + j].z += w * hi[0]; v[o + j].w += w * hi[1]; } }
        float sa = 0.f, sb = 0.f;
#pragma unroll
        for (int j = 0; j < 4; ++j) { sa += v[j].x * v[j].x + v[j].y * v[j].y + v[j].z * v[j].z + v[j].w * v[j].w; sb += v[4 + j].x * v[4 + j].x + v[4 + j].y * v[4 + j].y + v[4 + j].z * v[4 + j].z + v[4 + j].w * v[4 + j].w; }
        const float ra = rsqrtf(wave_sum(sa) * (1.f / DM) + EPS), rb = rsqrtf(wave_sum(sb) * (1.f / DM) + EPS);
#pragma unroll
        for (int j = 0; j < 4; ++j) { const int c = (j * 64 + lane) * 4; const float4 g = *(const float4*)(p.norm_final + c);
            *(float4*)(dst + (size_t)r * DM + c) = make_float4(v[j].x * ra * g.x, v[j].y * ra * g.y, v[j].z * ra * g.z, v[j].w * ra * g.w);
            *(float4*)(dst + (size_t)(r + 1) * DM + c) = make_float4(v[4 + j].x * rb * g.x, v[4 + j].y * rb * g.y, v[4 + j].z * rb * g.z, v[4 + j].w * rb * g.w); }
    }
}
__device__ __forceinline__ void phase_init_ctl(const Params& p, int vcu, int G) {
    if (vcu == 0) for (int i = threadIdx.x; i < NEXP * CNT_STRIDE; i += MK_THREADS) p.CNT()[i] = 0;
    for (int i = vcu * MK_THREADS + threadIdx.x; i < NSLOT; i += G * MK_THREADS) p.SLOT_TOK()[i] = -1;
}

#define XB_TMO      128
#define XB_XCNT(j)  (256  + 64 * (j))
#define XB_XSUB(j)  (1280 + 64 * (j))
#define XB_XGEN(j)  (2304 + 64 * (j))
#define XB_TOP      3328
#define XB_TOPGEN   3392
#define XCD_BAR_WORDS 3456
#define XB_SPIN_CAP (1u << 20)
__device__ __forceinline__ unsigned xb_ld(unsigned* p)              { return __hip_atomic_load(p, __ATOMIC_RELAXED, __HIP_MEMORY_SCOPE_AGENT); }
__device__ __forceinline__ unsigned xb_add(unsigned* p, unsigned v) { return __hip_atomic_fetch_add(p, v, __ATOMIC_RELAXED, __HIP_MEMORY_SCOPE_AGENT); }
__device__ __forceinline__ unsigned xb_xcc_id() { return (unsigned)__builtin_amdgcn_s_getreg((3 << 11) | 20) & 0xFu; }
#define XB_SPIN(cond, bar) do { unsigned _sp = 0; while (cond) { __builtin_amdgcn_s_sleep(1); \
    if ((++_sp & 255u) == 0u) { if (xb_ld(&(bar)[XB_TMO])) break; if (_sp > XB_SPIN_CAP) { atomicAdd(&(bar)[XB_TMO], 1u); break; } } } } while (0)
struct XcdBarrier { unsigned* bar; unsigned x; volatile LAS unsigned* st; };
__device__ __forceinline__ XcdBarrier xcd_barrier_post(unsigned* bar, volatile LAS unsigned* st) {
    XcdBarrier b; b.bar = bar; b.x = xb_xcc_id(); b.st = st;
    if (threadIdx.x == 0) (void)xb_add(&bar[XB_XCNT(b.x)], 1u);
    return b;
}
__device__ __forceinline__ void xcd_barrier_complete(unsigned* bar, unsigned x, unsigned& nloc, unsigned& nx) {
    const unsigned G = gridDim.x * gridDim.y * gridDim.z;
    unsigned sum, cnt, mine, sp = 0u;
    for (;;) {
        sum = 0u; cnt = 0u; mine = 0u;
#pragma unroll
        for (unsigned j = 0; j < 16; ++j) { const unsigned c = xb_ld(&bar[XB_XCNT(j)]); sum += c; cnt += (c > 0u) ? 1u : 0u; mine = (j == x) ? c : mine; }
        if (sum == G) break;
        __builtin_amdgcn_s_sleep(1);
        if ((++sp & 255u) == 0u) { if (xb_ld(&bar[XB_TMO])) break; if (sp > XB_SPIN_CAP) { atomicAdd(&bar[XB_TMO], 1u); break; } }
    }
    nloc = mine > 0u ? mine : 1u; nx = cnt > 0u ? cnt : 1u;
}
__device__ __forceinline__ void xcd_barrier(const XcdBarrier& b) {
    asm volatile("s_waitcnt vmcnt(0)" ::: "memory");
    __syncthreads();
    if (threadIdx.x == 0) {
        unsigned* bar = b.bar;
        __builtin_amdgcn_s_waitcnt(0);
        unsigned nloc = b.st[0], nx = b.st[1];
        if (nloc == 0u) { xcd_barrier_complete(bar, b.x, nloc, nx); b.st[0] = nloc; b.st[1] = nx; }
        const unsigned old = xb_add(&bar[XB_XSUB(b.x)], 1u);
        const unsigned gen = old / nloc;
        if (old + 1u == (gen + 1u) * nloc) {
            __builtin_amdgcn_fence(__ATOMIC_RELEASE, "agent");
            asm volatile("s_waitcnt vmcnt(0)" ::: "memory");
            const unsigned og = xb_add(&bar[XB_TOP], 1u);
            const unsigned tg = og / nx;
            if (og + 1u == (tg + 1u) * nx) xb_add(&bar[XB_TOPGEN], 1u);
            else XB_SPIN(xb_ld(&bar[XB_TOPGEN]) == tg, bar);
            __builtin_amdgcn_fence(__ATOMIC_ACQUIRE, "agent");
            xb_add(&bar[XB_XGEN(b.x)], 1u);
            asm volatile("s_waitcnt vmcnt(0)" ::: "memory");
        } else {
            XB_SPIN(xb_ld(&bar[XB_XGEN(b.x)]) == gen, bar);
            __builtin_amdgcn_fence(__ATOMIC_ACQUIRE, "agent");
            asm volatile("s_waitcnt vmcnt(0)" ::: "memory");
        }
    }
    __syncthreads();
}

struct MkArgs { Params p; int ph_lo, ph_hi, sub, pad; };
enum { PH_PRO = 0, PH_INPROJ = 1, PH_MSCAN = 2, PH_QPROJ = 3, PH_MOUT = 4, PH_ATTN = 5, PH_YM = 6, PH_YA = 7, PH_OUT = 8, PH_ROUTE = 9, PH_SCATTER = 10, PH_M1 = 11, PH_M2 = 12, PH_COMBINE = 13, PH_END = 14 };

__global__ void __launch_bounds__(MK_THREADS, 2) mk_fwd(MkArgs a) {
    extern __shared__ __attribute__((aligned(16))) unsigned char lds_raw[];
    LAS unsigned char* lds = (LAS unsigned char*)lds_raw;
    const Params& p = *(const Params*)__builtin_amdgcn_kernarg_segment_ptr();
    const int G = gridDim.x, bx = blockIdx.x;
    const int vcu = (G % 8 == 0) ? (bx % 8) * (G / 8) + bx / 8 : bx;
    cooperative_groups::grid_group grid = cooperative_groups::this_grid();
    const int lo = a.ph_lo, hi = a.ph_hi;
    volatile LAS unsigned* bst = (volatile LAS unsigned*)(lds + MK_LDS - 16);
    if (threadIdx.x < 4) bst[threadIdx.x] = 0u;
    __syncthreads();
    XcdBarrier xbar; xbar.bar = p.BAR(); xbar.x = 0; xbar.st = bst;
    if (hi - lo > 1) xbar = xcd_barrier_post(p.BAR(), bst);
#ifndef PHASE_MASK
#define PHASE_MASK 0xffffffffu
#endif
#define IN(k) (((PHASE_MASK >> (k)) & 1u) && lo <= (k) && (k) < hi)
#define SEAM(k) do { if (IN(k) && IN((k) + 1)) { if (a.sub == 0x7fffffff) grid.sync(); else xcd_barrier(xbar); } } while (0)
#ifndef PROBE_PHASE
#define PROBE_PHASE -1
#endif
#ifndef PROBE_REPS
#define PROBE_REPS 2
#endif
#define REPS(k) ((k) == PROBE_PHASE ? PROBE_REPS : 1)
    if (IN(PH_PRO)) for (int rep_ = 0; rep_ < REPS(PH_PRO); ++rep_) { if (rep_) xcd_barrier(xbar); phase_init_ctl(p, vcu, G); phase_prologue(p, lds, vcu, G, a.sub); } SEAM(PH_PRO);
    if (IN(PH_INPROJ)) for (int rep_ = 0; rep_ < REPS(PH_INPROJ); ++rep_) { if (rep_) xcd_barrier(xbar); { pg8::StaticOrderN<10> S; S.init(DM, G, bx, p.U(), p.WinT()); EpiInP<0> E{p}; pg8::gemm_phase<EpiInP<0>, pg8::StaticOrderN<10>>(lds, DM, DM, S, E); }
        { pg8::StaticOrderN<12> S; S.init(DM / 2, G, bx, p.U8(), p.WinT8()); EpiInP<1> E{p}; pg8::gemm_phase<EpiInP<1>, pg8::StaticOrderN<12>, true>(lds, DM / 2, DM / 2, S, E); } } SEAM(PH_INPROJ);
    if (IN(PH_MSCAN)) for (int rep_ = 0; rep_ < REPS(PH_MSCAN); ++rep_) { if (rep_) xcd_barrier(xbar);
        { const int half = (bx >> 3) & 1, idx = (bx & 7) * 16 + (bx >> 4);
            if (half == 0) { if (a.sub != 2) phase_mlstm_scan(p, (char*)lds_raw, idx, 128); }
            else if (a.sub != 1) { phase_kprep(p, idx, 128);
                asm volatile("s_waitcnt vmcnt(0)" ::: "memory"); __syncthreads();
                if (threadIdx.x == 0) { unsigned* cw = p.BAR() + 3584; __builtin_amdgcn_fence(__ATOMIC_RELEASE, "agent"); asm volatile("s_waitcnt vmcnt(0)" ::: "memory");
                    xb_add(cw, 1u); unsigned sp = 0; while (xb_ld(cw) < 128u * (unsigned)(rep_ + 1)) { __builtin_amdgcn_s_sleep(2); if (++sp > (1u << 22)) break; }
                    __builtin_amdgcn_fence(__ATOMIC_ACQUIRE, "agent"); asm volatile("s_waitcnt vmcnt(0)" ::: "memory"); }
                __syncthreads();
                pg8::StaticOrderN<6> S; S.init(256, 128, idx, p.CQb(), p.WqT()); EpiQ E{p}; pg8::gemm_phase<EpiQ, pg8::StaticOrderN<6>>(lds, 256, 256, S, E); } }
        } SEAM(PH_MSCAN);
    if (IN(PH_MOUT)) for (int rep_ = 0; rep_ < REPS(PH_MOUT); ++rep_) { if (rep_) xcd_barrier(xbar); phase_mlstm_out(p, (char*)lds_raw, vcu, G); }
    if (IN(PH_ATTN)) for (int rep_ = 0; rep_ < REPS(PH_ATTN); ++rep_) { if (rep_) xcd_barrier(xbar); phase_attn(p, (char*)lds_raw, vcu, G); } SEAM(PH_ATTN);
    if (IN(PH_YM)) for (int rep_ = 0; rep_ < REPS(PH_YM); ++rep_) { if (rep_) xcd_barrier(xbar); pg8::StaticOrderN<4> S; S.init(DM, G, bx, p.HM(), p.WmT()); EpiMix<0> E{p}; pg8::gemm_phase<EpiMix<0>, pg8::StaticOrderN<4>>(lds, DM, DM, S, E); }
    if (IN(PH_YA)) for (int rep_ = 0; rep_ < REPS(PH_YA); ++rep_) { if (rep_) xcd_barrier(xbar); pg8::StaticOrderN<4> S; S.init(DM, G, bx, p.OA(), p.WoT()); EpiMix<1> E{p}; pg8::gemm_phase<EpiMix<1>, pg8::StaticOrderN<4>>(lds, DM, DM, S, E); } SEAM(PH_YA);
    if (IN(PH_OUT)) for (int rep_ = 0; rep_ < REPS(PH_OUT); ++rep_) { if (rep_) xcd_barrier(xbar); pg8::StaticOrderN<4> S; S.init(DM, G, bx, p.MIX(), p.WoutT()); EpiOut E{p}; pg8::gemm_phase<EpiOut, pg8::StaticOrderN<4>>(lds, DM, DM, S, E); } SEAM(PH_OUT);
    if (IN(PH_ROUTE)) for (int rep_ = 0; rep_ < REPS(PH_ROUTE); ++rep_) { if (rep_) xcd_barrier(xbar); phase_route(p, (char*)lds_raw, vcu, G); } SEAM(PH_ROUTE);
    if (IN(PH_SCATTER)) for (int rep_ = 0; rep_ < REPS(PH_SCATTER); ++rep_) { if (rep_) xcd_barrier(xbar); phase_scatter(p, (char*)lds_raw, vcu, G); } SEAM(PH_SCATTER);
    if (IN(PH_M1)) for (int rep_ = 0; rep_ < REPS(PH_M1); ++rep_) { if (rep_) xcd_barrier(xbar); volatile LAS int* tst = (volatile LAS int*)(lds + MISC_OFF); moe_tile_table(p, tst);
        pg8::MoeOrder S; S.tstart = tst; S.npn = 8; S.G = G; S.c = bx; S.A = (const char*)p.XN2(); S.W = (const char*)p.W1T(); S.wexp = (size_t)2048 * DM; S.btile = (size_t)256 * DM;     S.rowidx = p.SLOT_TOK(); S.bias = p.b1; S.bsplit = 1;
        EpiM1 E{p}; pg8::gemm_phase<EpiM1, pg8::MoeOrder, true>(lds, DM / 2, DM / 2, S, E); } SEAM(PH_M1);
    if (IN(PH_M2)) for (int rep_ = 0; rep_ < REPS(PH_M2); ++rep_) { if (rep_) xcd_barrier(xbar); volatile LAS int* tst = (volatile LAS int*)(lds + MISC_OFF); moe_tile_table(p, tst);
        pg8::MoeOrder S; S.tstart = tst; S.npn = 4; S.G = G; S.c = bx; S.A = (const char*)p.ACT(); S.W = (const char*)p.W2T(); S.wexp = (size_t)DM * DFF; S.btile = (size_t)256 * DFF; S.rowidx = nullptr; S.bias = p.b2; S.bsplit = 0;
        EpiM2 E{p}; pg8::gemm_phase<EpiM2, pg8::MoeOrder, true>(lds, DFF / 2, DFF / 2, S, E); } SEAM(PH_M2);
    if (IN(PH_COMBINE)) for (int rep_ = 0; rep_ < REPS(PH_COMBINE); ++rep_) { if (rep_) xcd_barrier(xbar); phase_combine(p, vcu, G, a.sub ? (float*)p.ACT() : p.out); }
#undef IN
#undef SEAM
}

#ifndef ONE_LAUNCH
#define ONE_LAUNCH 1
#endif
#ifndef PROBE_DUP
#define PROBE_DUP -1
#endif
#ifndef PROBE_SUB
#define PROBE_SUB 0
#endif
#ifndef PROBE_DUP_N
#define PROBE_DUP_N 1
#endif
#ifndef FAST_INPROJ
#define FAST_INPROJ 1
#endif
#ifndef FAST_QPROJ
#define FAST_QPROJ 1
#endif
#ifndef FAST_MIX
#define FAST_MIX 1
#endif
#ifndef FAST_MOE
#define FAST_MOE 1
#endif
#ifndef FAST_ATTN
#define FAST_ATTN 1
#endif
#ifndef FAST_MLSTM
#define FAST_MLSTM 1
#endif
static void launch_mk(const Params& p, int lo, int hi, int grid, hipStream_t stream, int sub = 0) {
    MkArgs a{}; a.p = p; a.ph_lo = lo; a.ph_hi = hi; a.sub = sub;
    hipLaunchKernelGGL(mk_fwd, dim3(grid), dim3(MK_THREADS), MK_LDS, stream, a);
}
extern "C" void kernel_launch(void* const* d_in, const int* in_sizes, int n_in, void* d_out, int out_size, void* d_ws, size_t ws_size, hipStream_t stream) {
    static int ok = 0, grid = 0;
    if (!ok) {
        if (n_in != 22 || in_sizes[0] != NT * DM || out_size != NT * DM) { fprintf(stderr, "kernel_launch: unexpected shapes (n_in %d, x %d, out %d)\n", n_in, n_in > 0 ? in_sizes[0] : -1, out_size); return; }
        (void)hipFuncSetAttribute((const void*)k_mlstm_out, hipFuncAttributeMaxDynamicSharedMemorySize, MO_LDS);
        (void)hipFuncSetAttribute((const void*)mk_fwd, hipFuncAttributeMaxDynamicSharedMemorySize, MK_LDS);
        int dev = 0, cus = 0, per_cu = 0; (void)hipGetDevice(&dev); (void)hipDeviceGetAttribute(&cus, hipDeviceAttributeMultiprocessorCount, dev);
        (void)hipOccupancyMaxActiveBlocksPerMultiprocessor(&per_cu, (const void*)mk_fwd, MK_THREADS, MK_LDS);
        if (per_cu < 1) { fprintf(stderr, "kernel_launch: occupancy query says %d blocks/CU\n", per_cu); per_cu = 1; }
        if (cus != 256) { fprintf(stderr, "kernel_launch: built for a 256-CU device (got %d CUs)\n", cus); return; }
        grid = 256;
        ok = 1;
    }
    Params p{};
    const float** ins = (const float**)&p.x;
    for (int i = 0; i < 22; ++i) ins[i] = (const float*)d_in[i];
    p.out = (float*)d_out;
    p.ws = (char*)d_ws;
    if (WS_TOTAL > ws_size) { fprintf(stderr, "kernel_launch: workspace too small (%zu > %zu)\n", (size_t)WS_TOTAL, ws_size); return; }
    (void)hipMemsetAsync(p.BAR(), 0, 16384, stream);
#if ONE_LAUNCH
    { MkArgs a{}; a.p = p; a.ph_lo = 0; a.ph_hi = PH_END; void* args[] = {&a};
      hipError_t e = hipLaunchCooperativeKernel((const void*)mk_fwd, dim3(grid), dim3(MK_THREADS), args, MK_LDS, stream);
      if (e != hipSuccess) fprintf(stderr, "kernel_launch: cooperative launch failed: %s (grid %d)\n", hipGetErrorString(e), grid); }
#else
    for (int ph = 0; ph < PH_END; ++ph) { if (ph == PH_COMBINE && PROBE_DUP == PH_COMBINE) { launch_mk(p, ph, ph + 1, grid, stream, 1); launch_mk(p, ph, ph + 1, grid, stream, 0); continue; }
        launch_mk(p, ph, ph + 1, grid, stream);
        for (int d = 0; d < ((ph == PROBE_DUP) ? PROBE_DUP_N : 0); ++d) { if (ph == PH_ROUTE) (void)hipMemsetAsync(p.CNT(), 0, 4096, stream); launch_mk(p, ph, ph + 1, grid, stream, PROBE_SUB); } }
#endif
}
```

```cpp
#include <hip/hip_runtime.h>
#include <hip/hip_cooperative_groups.h>
#include <cstdio>
#include <cstdint>

typedef unsigned short bf16_t;
__device__ __forceinline__ float bf2f(bf16_t v) { return __uint_as_float(((unsigned)v) << 16); }
__device__ __forceinline__ bf16_t f2bf(float f) { unsigned u = __float_as_uint(f); return (bf16_t)((u + 0x7fffu + ((u >> 16) & 1u)) >> 16); }

constexpr int NB = 8, SEQ = 4096, NT = NB * SEQ, DM = 1024, NMETA = 16, LTOT = SEQ + NMETA;
constexpr int DIN = 5600;
constexpr int OFF_Q = 0, OFF_K = 512, OFF_V = 1024, OFF_O = 2048, OFF_I = 3072, OFF_F = 3088, OFF_CQ = 3104, OFF_CKV = 3360, OFF_KR = 3488, OFF_G = 3552;
constexpr int KVROWS = 4160;
constexpr int NEXP = 32, DFF = 1024;
constexpr int NSLOT = NT * 4 + NEXP * 256;
constexpr float EPS = 1e-6f;
constexpr int CNT_STRIDE = 16;
constexpr float QSCALE = 0.07216878364870322f * 1.4426950408889634f;

constexpr size_t ws_al(size_t x) { return (x + 255) & ~(size_t)255; }
constexpr size_t WS_BAR = 0;
constexpr size_t WS_CNT = WS_BAR + 16384;
constexpr size_t WS_SLOT_TOK = WS_CNT + ws_al(4096);
constexpr size_t WS_TOPI = WS_SLOT_TOK + ws_al((size_t)NSLOT*4);
constexpr size_t WS_TOPW = WS_TOPI + ws_al((size_t)NT*16);
constexpr size_t WS_RANK = WS_TOPW + ws_al((size_t)NT*16);
constexpr size_t WS_SLOTS = WS_RANK + ws_al((size_t)NT*16);
constexpr size_t WS_UM = WS_SLOTS + ws_al((size_t)NT*16);
constexpr size_t WS_ZM = WS_UM + ws_al((size_t)NMETA*DM*4);
constexpr size_t WS_ROPE = WS_ZM + ws_al((size_t)NMETA*DIN*4);
constexpr size_t WS_RSQ = WS_ROPE + ws_al((size_t)LTOT*64*4);
constexpr size_t WS_GI = WS_RSQ + ws_al((size_t)NT*4);
constexpr size_t WS_GF = WS_GI + ws_al((size_t)NT*64);
constexpr size_t WS_NF = WS_GF + ws_al((size_t)NT*64);
constexpr size_t WS_NB_ = WS_NF + ws_al((size_t)4096*256);
constexpr size_t WS_MF = WS_NB_ + ws_al((size_t)4096*256);
constexpr size_t WS_MB = WS_MF + ws_al((size_t)4096*4);
constexpr size_t WS_Kc = WS_MB + ws_al((size_t)4096*4);
constexpr size_t WS_WinT = WS_Kc + ws_al((size_t)NB*KVROWS*192*2);
constexpr size_t WS_WinT8 = WS_WinT + ws_al((size_t)5632*DM*2);
constexpr size_t WS_W1T = WS_WinT8 + ws_al((size_t)3072*DM);
constexpr size_t WS_W2T = WS_W1T + ws_al((size_t)NEXP*2048*DM*2);
constexpr size_t WS_WmT = WS_W2T + ws_al((size_t)NEXP*DM*DFF*2);
constexpr size_t WS_WoutT = WS_WmT + ws_al((size_t)DM*DM*2);
constexpr size_t WS_WoT = WS_WoutT + ws_al((size_t)DM*DM*2);
constexpr size_t WS_WqT = WS_WoT + ws_al((size_t)DM*DM*2);
constexpr size_t WS_CKV = WS_WqT + ws_al((size_t)1536*256*2);
constexpr size_t WS_KR = WS_CKV + ws_al((size_t)NT*128*4);
constexpr size_t WS_CQb = WS_KR + ws_al((size_t)NT*64*4);
constexpr size_t WS_GATE = WS_CQb + ws_al((size_t)NT*256*2);
constexpr size_t WS_WQF = WS_GATE + ws_al((size_t)NT*2048*2);
constexpr size_t WS_WOF = WS_WQF + ws_al((size_t)256*1536*4);
constexpr size_t WS_U = WS_WOF + ws_al((size_t)1024*1024*4);
constexpr size_t WS_Qm = WS_U + ws_al((size_t)NT*DM*2);
constexpr size_t WS_Km = WS_Qm + ws_al((size_t)NT*512*2);
constexpr size_t WS_Vm = WS_Km + ws_al((size_t)NT*512*2);
constexpr size_t WS_OG = WS_Vm + ws_al((size_t)NT*1024*2);
constexpr size_t WS_QP = WS_OG + ws_al((size_t)NT*1024*2);
constexpr size_t WS_CB = WS_QP + ws_al((size_t)NT*1536*2);
constexpr size_t WS_HM = WS_CB + ws_al((size_t)4096*8192*2);
constexpr size_t WS_OA = WS_HM + ws_al((size_t)NT*DM*2);
constexpr size_t WS_TOTAL = WS_OA + ws_al((size_t)NT*DM*2);
constexpr size_t WS_ACT = WS_U, WS_YB = WS_ACT + ws_al((size_t)NSLOT * DFF * 2), WS_MOE_END = WS_YB + ws_al((size_t)NSLOT * DM);
constexpr size_t WS_H1 = WS_OA;
constexpr size_t WS_U8 = WS_CB;
constexpr size_t WS_CF = WS_U, WS_MIX = WS_Qm, WS_XN2 = WS_HM, WS_CQ = WS_HM;
static_assert(WS_MOE_END <= WS_HM && WS_XN2 >= WS_MOE_END && WS_XN2 + (size_t)NT * DM <= WS_H1, "MoE overlay layout");
struct Params {
    const float *x, *meta, *norm_mix, *w_in, *m_b_i, *m_b_f, *m_norm, *w_m_proj, *a_w_uq, *a_w_ukv, *a_norm_q, *a_norm_kv, *w_a_proj, *w_out,
        *norm_ffn, *w_router, *b_router, *w1, *b1, *w2, *b2, *norm_final;
    float* out; char* ws;
    __host__ __device__ __forceinline__ int* CNT() const { return (int*)(ws + WS_CNT); }
    __host__ __device__ __forceinline__ unsigned* BAR() const { return (unsigned*)(ws + WS_BAR); }
    __host__ __device__ __forceinline__ unsigned char* WinT8() const { return (unsigned char*)(ws + WS_WinT8); }
    __host__ __device__ __forceinline__ unsigned char* U8() const { return (unsigned char*)(ws + WS_U8); }
    __host__ __device__ __forceinline__ int* SLOT_TOK() const { return (int*)(ws + WS_SLOT_TOK); }
    __host__ __device__ __forceinline__ int* TOPI() const { return (int*)(ws + WS_TOPI); }
    __host__ __device__ __forceinline__ float* TOPW() const { return (float*)(ws + WS_TOPW); }
    __host__ __device__ __forceinline__ int* RANK() const { return (int*)(ws + WS_RANK); }
    __host__ __device__ __forceinline__ int* SLOTS() const { return (int*)(ws + WS_SLOTS); }
    __host__ __device__ __forceinline__ float* UM() const { return (float*)(ws + WS_UM); }
    __host__ __device__ __forceinline__ float* ZM() const { return (float*)(ws + WS_ZM); }
    __host__ __device__ __forceinline__ float* ROPE() const { return (float*)(ws + WS_ROPE); }
    __host__ __device__ __forceinline__ float* RSQ() const { return (float*)(ws + WS_RSQ); }
    __host__ __device__ __forceinline__ float* GI() const { return (float*)(ws + WS_GI); }
    __host__ __device__ __forceinline__ float* GF() const { return (float*)(ws + WS_GF); }
    __host__ __device__ __forceinline__ float* NF() const { return (float*)(ws + WS_NF); }
    __host__ __device__ __forceinline__ float* NB_() const { return (float*)(ws + WS_NB_); }
    __host__ __device__ __forceinline__ float* MF() const { return (float*)(ws + WS_MF); }
    __host__ __device__ __forceinline__ float* MB() const { return (float*)(ws + WS_MB); }
    __host__ __device__ __forceinline__ bf16_t* Kc() const { return (bf16_t*)(ws + WS_Kc); }
    __host__ __device__ __forceinline__ bf16_t* WinT() const { return (bf16_t*)(ws + WS_WinT); }
    __host__ __device__ __forceinline__ bf16_t* W1T() const { return (bf16_t*)(ws + WS_W1T); }
    __host__ __device__ __forceinline__ bf16_t* W2T() const { return (bf16_t*)(ws + WS_W2T); }
    __host__ __device__ __forceinline__ bf16_t* WmT() const { return (bf16_t*)(ws + WS_WmT); }
    __host__ __device__ __forceinline__ bf16_t* WoutT() const { return (bf16_t*)(ws + WS_WoutT); }
    __host__ __device__ __forceinline__ bf16_t* WoT() const { return (bf16_t*)(ws + WS_WoT); }
    __host__ __device__ __forceinline__ bf16_t* WqT() const { return (bf16_t*)(ws + WS_WqT); }
    __host__ __device__ __forceinline__ float* CKV() const { return (float*)(ws + WS_CKV); }
    __host__ __device__ __forceinline__ float* KR() const { return (float*)(ws + WS_KR); }
    __host__ __device__ __forceinline__ bf16_t* CQb() const { return (bf16_t*)(ws + WS_CQb); }
    __host__ __device__ __forceinline__ bf16_t* GATE() const { return (bf16_t*)(ws + WS_GATE); }
    __host__ __device__ __forceinline__ float* WQF() const { return (float*)(ws + WS_WQF); }
    __host__ __device__ __forceinline__ float* WOF() const { return (float*)(ws + WS_WOF); }
    __host__ __device__ __forceinline__ bf16_t* U() const { return (bf16_t*)(ws + WS_U); }
    __host__ __device__ __forceinline__ bf16_t* Qm() const { return (bf16_t*)(ws + WS_Qm); }
    __host__ __device__ __forceinline__ bf16_t* Km() const { return (bf16_t*)(ws + WS_Km); }
    __host__ __device__ __forceinline__ bf16_t* Vm() const { return (bf16_t*)(ws + WS_Vm); }
    __host__ __device__ __forceinline__ bf16_t* OG() const { return (bf16_t*)(ws + WS_OG); }
    __host__ __device__ __forceinline__ bf16_t* QP() const { return (bf16_t*)(ws + WS_QP); }
    __host__ __device__ __forceinline__ bf16_t* CB() const { return (bf16_t*)(ws + WS_CB); }
    __host__ __device__ __forceinline__ bf16_t* HM() const { return (bf16_t*)(ws + WS_HM); }
    __host__ __device__ __forceinline__ bf16_t* OA() const { return (bf16_t*)(ws + WS_OA); }
    __host__ __device__ __forceinline__ bf16_t* H1() const { return (bf16_t*)(ws + WS_H1); }
    __host__ __device__ __forceinline__ bf16_t* ACT() const { return (bf16_t*)(ws + WS_ACT); }
    __host__ __device__ __forceinline__ bf16_t* YB() const { return (bf16_t*)(ws + WS_YB); }
    __host__ __device__ __forceinline__ bf16_t* CF() const { return (bf16_t*)(ws + WS_CF); }
    __host__ __device__ __forceinline__ bf16_t* MIX() const { return (bf16_t*)(ws + WS_MIX); }
    __host__ __device__ __forceinline__ bf16_t* XN2() const { return (bf16_t*)(ws + WS_XN2); }
    __host__ __device__ __forceinline__ float* CQ() const { return (float*)(ws + WS_CQ); }
};

__device__ __forceinline__ float wave_sum(float v) {
#pragma unroll
    for (int o = 1; o < 64; o <<= 1) v += __shfl_xor(v, o);
    return v;
}
__device__ __forceinline__ float sigmoidf_(float v) { return __builtin_amdgcn_rcpf(1.f + __expf(-v)); }
__device__ __forceinline__ float logsigmoidf_(float v) { return fminf(v, 0.f) - __logf(1.f + __expf(-fabsf(v))); }

__global__ void __launch_bounds__(256) k_prep_rows(Params p) {
    const int lane = threadIdx.x & 63, gw = (blockIdx.x * 256 + threadIdx.x) >> 6, ngw = (gridDim.x * 256) >> 6;
    for (int r = gw; r < NT + NMETA; r += ngw) {
        const float* src = r < NT ? p.x + (size_t)r * DM : p.meta + (size_t)(r - NT) * DM;
        float4 v[4]; float ss = 0.f;
#pragma unroll
        for (int j = 0; j < 4; ++j) { v[j] = *(const float4*)(src + (j * 64 + lane) * 4); ss += v[j].x * v[j].x + v[j].y * v[j].y + v[j].z * v[j].z + v[j].w * v[j].w; }
        const float rstd = rsqrtf(wave_sum(ss) * (1.f / DM) + EPS);
#pragma unroll
        for (int j = 0; j < 4; ++j) {
            const int c = (j * 64 + lane) * 4; const float4 g = *(const float4*)(p.norm_mix + c);
            const float a0 = v[j].x * rstd * g.x, a1 = v[j].y * rstd * g.y, a2 = v[j].z * rstd * g.z, a3 = v[j].w * rstd * g.w;
            if (r < NT) { bf16_t* d = p.U() + (size_t)r * DM + c; d[0] = f2bf(a0); d[1] = f2bf(a1); d[2] = f2bf(a2); d[3] = f2bf(a3); }
            else { float* d = p.UM() + (size_t)(r - NT) * DM + c; d[0] = a0; d[1] = a1; d[2] = a2; d[3] = a3; }
        }
    }
}

__global__ void __launch_bounds__(256) k_fold(Params p) {
    const long gid = (long)blockIdx.x * 256 + threadIdx.x, gn = (long)gridDim.x * 256;
    for (long i = gid; i < 256L * 1536; i += gn) {
        const int r = (int)(i / 1536), hc = (int)(i % 1536), h = hc / 192, c = hc % 192;
        const float* uq = p.a_w_uq + ((size_t)r * 8 + h) * 192; float acc;
        if (c >= 128) acc = uq[c];
        else { const float* kv = p.a_w_ukv + ((size_t)c * 8 + h) * 256; acc = 0.f; for (int d = 0; d < 128; ++d) acc += uq[d] * kv[d]; }
        p.WQF()[i] = acc;
    }
    for (long i = gid; i < 1024L * 1024; i += gn) {
        const int hc = (int)(i >> 10), n = (int)(i & 1023), h = hc >> 7, c = hc & 127;
        const float* kv = p.a_w_ukv + ((size_t)c * 8 + h) * 256 + 128; const float* ap = p.w_a_proj + (size_t)(h * 128) * DM + n;
        float acc = 0.f; for (int d = 0; d < 128; ++d) acc += kv[d] * ap[(size_t)d * DM];
        p.WOF()[i] = acc;
    }
    for (long i = gid; i < (long)LTOT * 32; i += gn) {
        const int pos = (int)(i >> 5), f = (int)(i & 31);
        const float freq = powf(10000.f, -(float)f / 32.f), ang = (float)pos * freq; float s, c; sincosf(ang, &s, &c);
        p.ROPE()[i * 2] = c; p.ROPE()[i * 2 + 1] = s;
    }
}

__global__ void __launch_bounds__(256) k_meta_proj(Params p) {
    const int gid = blockIdx.x * 256 + threadIdx.x;
    if (gid >= NMETA * DIN) return;
    const int j = gid / DIN, n = gid % DIN; const float* u = p.UM() + (size_t)j * DM; float acc = 0.f;
    for (int k = 0; k < DM; ++k) acc += u[k] * p.w_in[(size_t)k * DIN + n];
    p.ZM()[gid] = acc;
}

template <class P> __global__ void __launch_bounds__(256) k_sgemm(P q) {
    __shared__ float As[16][68]; __shared__ float Bs[16][68];
    const int ntn = (q.N + 63) / 64, ntm = q.M / 64, tid = threadIdx.x, tx = tid & 15, ty = tid >> 4;
    for (int tile = blockIdx.x; tile < ntm * ntn; tile += gridDim.x) {
        const int tm = tile / ntn, tn = tile % ntn; int ctx = 0;
        if (!q.setup(tm, ctx)) continue;
        float acc[4][4];
#pragma unroll
        for (int i = 0; i < 4; ++i)
#pragma unroll
            for (int j = 0; j < 4; ++j) acc[i][j] = 0.f;
        const int arow = tm * 64 + (tid >> 2), ak = (tid & 3) * 4, bk = tid >> 4, bcol = tn * 64 + (tid & 15) * 4;
        for (int k0 = 0; k0 < q.K; k0 += 16) {
            const float4 av = q.a4(ctx, arow, k0 + ak);
            const float4 bv = bcol < q.N ? q.b4(ctx, k0 + bk, bcol) : make_float4(0.f, 0.f, 0.f, 0.f);
            __syncthreads();
            As[ak + 0][tid >> 2] = av.x; As[ak + 1][tid >> 2] = av.y; As[ak + 2][tid >> 2] = av.z; As[ak + 3][tid >> 2] = av.w;
            *(float4*)&Bs[bk][(tid & 15) * 4] = bv;
            __syncthreads();
#pragma unroll
            for (int kk = 0; kk < 16; ++kk) {
                const float4 a = *(const float4*)&As[kk][ty * 4]; const float4 b = *(const float4*)&Bs[kk][tx * 4];
                const float aa[4] = {a.x, a.y, a.z, a.w}, bb[4] = {b.x, b.y, b.z, b.w};
#pragma unroll
                for (int i = 0; i < 4; ++i)
#pragma unroll
                    for (int j = 0; j < 4; ++j) acc[i][j] += aa[i] * bb[j];
            }
        }
        const int col = tn * 64 + tx * 4;
        if (col < q.N) {
#pragma unroll
            for (int i = 0; i < 4; ++i) q.epi(ctx, tm * 64 + ty * 4 + i, col, acc[i]);
        }
    }
}
__device__ __forceinline__ float4 ld_bf4(const bf16_t* p) { const uint2 w = *(const uint2*)p; return make_float4(__uint_as_float(w.x << 16), __uint_as_float(w.x & 0xffff0000u), __uint_as_float(w.y << 16), __uint_as_float(w.y & 0xffff0000u)); }

struct ProbIn {
    Params p; int M, N, K, pad;
    __device__ bool setup(int, int&) const { return true; }
    __device__ float4 a4(int, int row, int k) const { return ld_bf4(p.U() + (size_t)row * DM + k); }
    __device__ float4 b4(int, int k, int col) const { return *(const float4*)(p.w_in + (size_t)k * DIN + col); }
    __device__ void epi(int, int row, int col, const float (&v)[4]) const {
#pragma unroll
        for (int j = 0; j < 4; ++j) {
            const int c = col + j; const float z = v[j];
            if (c < OFF_K) p.Qm()[(size_t)row * 512 + c] = f2bf(z * 0.125f);
            else if (c < OFF_V) p.Km()[(size_t)row * 512 + (c - OFF_K)] = f2bf(z);
            else if (c < OFF_O) p.Vm()[(size_t)row * 1024 + (c - OFF_V)] = f2bf(z);
            else if (c < OFF_I) p.OG()[(size_t)row * 1024 + (c - OFF_O)] = f2bf(sigmoidf_(z));
            else if (c < OFF_F) p.GI()[(size_t)row * 16 + (c - OFF_I)] = z + p.m_b_i[c - OFF_I];
            else if (c < OFF_CQ) p.GF()[(size_t)row * 16 + (c - OFF_F)] = logsigmoidf_(z + p.m_b_f[c - OFF_F]);
            else if (c < OFF_CKV) p.CQ()[(size_t)row * 256 + (c - OFF_CQ)] = z;
            else if (c < OFF_KR) p.CKV()[(size_t)row * 128 + (c - OFF_CKV)] = z;
            else if (c < OFF_G) p.KR()[(size_t)row * 64 + (c - OFF_KR)] = z;
            else p.GATE()[(size_t)row * 2048 + (c - OFF_G)] = f2bf(sigmoidf_(z));
        }
    }
};

__global__ void __launch_bounds__(256) k_kprep(Params p) {
    const int lane = threadIdx.x & 63, gw = (blockIdx.x * 256 + threadIdx.x) >> 6, ngw = (gridDim.x * 256) >> 6;
    for (int i = gw; i < NB * KVROWS; i += ngw) {
        const int b = i / KVROWS, key = i % KVROWS; bf16_t* dst = p.Kc() + (size_t)i * 192;
        if (key >= LTOT) { dst[lane] = 0; dst[64 + lane] = 0; dst[128 + lane] = 0; continue; }
        const float *ckv, *kr; int pos;
        if (key < SEQ) { const size_t r = (size_t)b * SEQ + key; ckv = p.CKV() + r * 128; kr = p.KR() + r * 64; pos = NMETA + key; }
        else { const int j = key - SEQ; ckv = p.ZM() + (size_t)j * DIN + OFF_CKV; kr = p.ZM() + (size_t)j * DIN + OFF_KR; pos = j; }
        const float c0 = ckv[lane], c1 = ckv[64 + lane];
        const float rstd = rsqrtf(wave_sum(c0 * c0 + c1 * c1) * (1.f / 128.f) + EPS);
        dst[lane] = f2bf(c0 * rstd * p.a_norm_kv[lane]); dst[64 + lane] = f2bf(c1 * rstd * p.a_norm_kv[64 + lane]);
        if (lane < 32) {
            const float x1 = kr[lane], x2 = kr[32 + lane], cs = p.ROPE()[((size_t)pos * 32 + lane) * 2], sn = p.ROPE()[((size_t)pos * 32 + lane) * 2 + 1];
            dst[128 + lane] = f2bf(x1 * cs - x2 * sn); dst[160 + lane] = f2bf(x1 * sn + x2 * cs);
        }
    }
    for (int r = gw; r < NT; r += ngw) {
        float* cq = p.CQ() + (size_t)r * 256; float v[4]; float ss = 0.f;
#pragma unroll
        for (int j = 0; j < 4; ++j) { v[j] = cq[j * 64 + lane]; ss += v[j] * v[j]; }
        const float rstd = rsqrtf(wave_sum(ss) * (1.f / 256.f) + EPS);
#pragma unroll
        for (int j = 0; j < 4; ++j) cq[j * 64 + lane] = v[j] * rstd * p.a_norm_q[j * 64 + lane];
    }
}

struct ProbQ {
    Params p; int M, N, K, pad;
    __device__ bool setup(int, int&) const { return true; }
    __device__ float4 a4(int, int row, int k) const { return *(const float4*)(p.CQ() + (size_t)row * 256 + k); }
    __device__ float4 b4(int, int k, int col) const { return *(const float4*)(p.WQF() + (size_t)k * 1536 + col); }
    __device__ void epi(int, int row, int col, const float (&v)[4]) const {
        const int h = col / 192, c = col % 192;
        if (c < 128) {
#pragma unroll
            for (int j = 0; j < 4; ++j) p.QP()[(size_t)row * 1536 + col + j] = f2bf(v[j] * QSCALE);
        } else {
#pragma unroll
            for (int j = 0; j < 4; ++j) p.QP()[(size_t)row * 1536 + col + j] = f2bf(v[j] * QSCALE);
        }
        (void)h;
    }
};
__global__ void __launch_bounds__(256) k_rope_q(Params p) {
    const long gid = (long)blockIdx.x * 256 + threadIdx.x;
    if (gid >= (long)NT * 8 * 32) return;
    const int i = (int)(gid & 31), h = (int)((gid >> 5) & 7); const long r = gid >> 8; const int pos = NMETA + (int)(r % SEQ);
    bf16_t* q = p.QP() + (size_t)r * 1536 + h * 192 + 128;
    const float x1 = bf2f(q[i]), x2 = bf2f(q[32 + i]), cs = p.ROPE()[((size_t)pos * 32 + i) * 2], sn = p.ROPE()[((size_t)pos * 32 + i) * 2 + 1];
    q[i] = f2bf(x1 * cs - x2 * sn); q[32 + i] = f2bf(x1 * sn + x2 * cs);
}

__global__ void __launch_bounds__(256) k_mlstm_scan(Params p) {
    __shared__ float ks[64][65]; __shared__ float vs[64][128]; __shared__ float wk[64]; __shared__ float li[64], lf[64]; __shared__ float sc[2];
    const int tid = threadIdx.x, b = blockIdx.x >> 4, h = (blockIdx.x >> 1) & 7, dir = blockIdx.x & 1;
    const int d = tid >> 2, vq = tid & 3;
    float C[32]; float n = 0.f, m = 0.f;
#pragma unroll
    for (int i = 0; i < 32; ++i) C[i] = 0.f;
    bf16_t* CS = dir ? p.CB() : p.CF(); float* NS = dir ? p.NB_() : p.NF(); float* MS = dir ? p.MB() : p.MF();
    const int nsteps = dir ? 64 : 65;
    for (int st = 0; st < nsteps; ++st) {
        const int c = dir ? 63 - st : st - 1;
        if (c >= 0) {
            const size_t sidx = ((size_t)(b * 8 + h) * 64 + c);
            bf16_t* cd = CS + sidx * 8192 + d * 128 + vq * 32;
#pragma unroll
            for (int i = 0; i < 32; ++i) cd[i] = f2bf(C[i]);
            if (vq == 0) NS[sidx * 64 + d] = n;
            if (tid == 0) MS[sidx] = m;
            if ((dir == 0 && c == 63) || (dir == 1 && c == 0)) break;
        }
        const int npos = c < 0 ? NMETA : 64;
        __syncthreads();
        for (int e = tid; e < 64 * 64; e += 256) { const int j = e >> 6, dd = e & 63; float v = 0.f;
            if (j < npos) { if (c < 0) v = p.ZM()[(size_t)j * DIN + OFF_K + h * 64 + dd]; else { const int t = dir ? 63 - j : j; v = bf2f(p.Km()[((size_t)b * SEQ + c * 64 + t) * 512 + h * 64 + dd]); } }
            ks[j][dd] = v; }
        for (int e = tid; e < 64 * 128; e += 256) { const int j = e >> 7, dd = e & 127; float v = 0.f;
            if (j < npos) { if (c < 0) v = p.ZM()[(size_t)j * DIN + OFF_V + h * 128 + dd]; else { const int t = dir ? 63 - j : j; v = bf2f(p.Vm()[((size_t)b * SEQ + c * 64 + t) * 1024 + h * 128 + dd]); } }
            vs[j][dd] = v; }
        if (tid < 64) { float a = -1e30f, f = 0.f; const int j = tid;
            if (j < npos) { if (c < 0) { a = p.ZM()[(size_t)j * DIN + OFF_I + h] + p.m_b_i[h]; f = logsigmoidf_(p.ZM()[(size_t)j * DIN + OFF_F + h] + p.m_b_f[h]); }
                            else { const int t = dir ? 63 - j : j; const size_t r = (size_t)b * SEQ + c * 64 + t; a = p.GI()[r * 16 + dir * 8 + h]; f = p.GF()[r * 16 + dir * 8 + h]; } }
            li[j] = a; lf[j] = f; }
        __syncthreads();
        if (tid == 0) {
            float bl = 0.f; for (int j = 0; j < npos; ++j) bl += lf[j];
            float bc = 0.f, gmax = -1e30f;
            for (int j = 0; j < npos; ++j) { bc += lf[j]; const float g = bl - bc + li[j]; wk[j] = g; gmax = fmaxf(gmax, g); }
            const float mnew = fmaxf(bl + m, gmax);
            for (int j = 0; j < 64; ++j) wk[j] = j < npos ? __expf(wk[j] - mnew) : 0.f;
            sc[0] = __expf(bl + m - mnew); sc[1] = mnew;
        }
        __syncthreads();
        const float decay = sc[0]; m = sc[1];
#pragma unroll
        for (int i = 0; i < 32; ++i) C[i] *= decay;
        n *= decay;
        for (int j = 0; j < npos; ++j) { const float kw = wk[j] * ks[j][d]; n += kw;
#pragma unroll
            for (int i = 0; i < 32; ++i) C[i] += kw * vs[j][vq * 32 + i]; }
    }
}

constexpr int MO_LDS = (64 * 65 * 3 + 64 * 128 * 2 + 64 * 8) * 4;
__global__ void __launch_bounds__(256) k_mlstm_out(Params p) {
    extern __shared__ __attribute__((aligned(16))) float sm[];
    float (*qs)[65] = (float (*)[65])sm; float (*ks)[65] = (float (*)[65])(sm + 64 * 65); float (*Ws)[65] = (float (*)[65])(sm + 2 * 64 * 65);
    float (*vs)[128] = (float (*)[128])(sm + 3 * 64 * 65); float (*Cs)[128] = (float (*)[128])(sm + 3 * 64 * 65 + 64 * 128);
    float* sx = sm + 3 * 64 * 65 + 2 * 64 * 128; float *li = sx, *lf = sx + 64, *bt = sx + 128, *mt = sx + 192, *as = sx + 256, *ns = sx + 320, *msc = sx + 384;
    const int tid = threadIdx.x, c = blockIdx.x & 63, h = (blockIdx.x >> 6) & 7, b = blockIdx.x >> 9;
    const int t = tid >> 2, vq = tid & 3; const size_t r0 = (size_t)b * SEQ + c * 64;
    for (int e = tid; e < 64 * 64; e += 256) { const int j = e >> 6, dd = e & 63; qs[j][dd] = bf2f(p.Qm()[(r0 + j) * 512 + h * 64 + dd]); ks[j][dd] = bf2f(p.Km()[(r0 + j) * 512 + h * 64 + dd]); }
    for (int e = tid; e < 64 * 128; e += 256) { const int j = e >> 7, dd = e & 127; vs[j][dd] = bf2f(p.Vm()[(r0 + j) * 1024 + h * 128 + dd]); }
    __syncthreads();
    float S[16];
#pragma unroll
    for (int i = 0; i < 16; ++i) { const int s = vq * 16 + i; float a = 0.f;
#pragma unroll 4
        for (int dd = 0; dd < 64; ++dd) a += qs[t][dd] * ks[s][dd]; S[i] = a; }
    float hacc[32];
#pragma unroll
    for (int i = 0; i < 32; ++i) hacc[i] = 0.f;
#pragma unroll 1
    for (int dir = 0; dir < 2; ++dir) {
        const size_t sidx = ((size_t)(b * 8 + h) * 64 + c);
        const bf16_t* CS = (dir ? p.CB() : p.CF()) + sidx * 8192; const float* NS = (dir ? p.NB_() : p.NF()) + sidx * 64; const float* MS = (dir ? p.MB() : p.MF()) + sidx;
        __syncthreads();
        for (int e = tid; e < 64 * 128; e += 256) Cs[e >> 7][e & 127] = bf2f(CS[e]);
        if (tid < 64) { ns[tid] = NS[tid]; li[tid] = p.GI()[(r0 + tid) * 16 + dir * 8 + h]; lf[tid] = p.GF()[(r0 + tid) * 16 + dir * 8 + h]; }
        if (tid == 0) msc[0] = MS[0];
        __syncthreads();
        if (tid == 0) {
            const float m = msc[0]; float bc = 0.f, pm = -1e30f;
            if (dir == 0) { for (int j = 0; j < 64; ++j) { bc += lf[j]; const float a = li[j] - bc; as[j] = a; pm = fmaxf(pm, a); bt[j] = bc; mt[j] = fmaxf(bc + m, bc + pm); } }
            else { for (int j = 63; j >= 0; --j) { bc += lf[j]; const float a = li[j] - bc; as[j] = a; pm = fmaxf(pm, a); bt[j] = bc; mt[j] = fmaxf(bc + m, bc + pm); } }
        }
        __syncthreads();
        const float m = msc[0], b_t = bt[t], m_t = mt[t];
#pragma unroll
        for (int i = 0; i < 16; ++i) { const int s = vq * 16 + i; const bool valid = dir ? (s >= t) : (s <= t); Ws[t][s] = valid ? __expf(b_t + as[s] - m_t) * S[i] : 0.f; }
        __syncthreads();
        const float s_inter = __expf(b_t + m - m_t);
        float num[32]; float den = 0.f, qn = 0.f;
#pragma unroll
        for (int i = 0; i < 32; ++i) num[i] = 0.f;
#pragma unroll 2
        for (int dd = 0; dd < 64; ++dd) { const float qv = qs[t][dd]; qn += qv * ns[dd];
#pragma unroll
            for (int i = 0; i < 32; ++i) num[i] += qv * Cs[dd][vq * 32 + i]; }
#pragma unroll
        for (int i = 0; i < 32; ++i) num[i] *= s_inter;
        den = s_inter * qn;
#pragma unroll 2
        for (int s = 0; s < 64; ++s) { const float w = Ws[t][s]; den += w;
#pragma unroll
            for (int i = 0; i < 32; ++i) num[i] += w * vs[s][vq * 32 + i]; }
        const float inv = 1.f / fmaxf(fabsf(den), __expf(-m_t));
#pragma unroll
        for (int i = 0; i < 32; ++i) hacc[i] += num[i] * inv;
    }
    float ss = 0.f;
#pragma unroll
    for (int i = 0; i < 32; ++i) ss += hacc[i] * hacc[i];
    ss += __shfl_xor(ss, 1); ss += __shfl_xor(ss, 2);
    const float rstd = rsqrtf(ss * (1.f / 128.f) + EPS);
#pragma unroll
    for (int i = 0; i < 32; ++i) { const int col = h * 128 + vq * 32 + i; const size_t o = (r0 + t) * 1024 + col;
        p.HM()[o] = f2bf(hacc[i] * rstd * p.m_norm[col] * bf2f(p.OG()[o])); }
}

__global__ void __launch_bounds__(256) k_attn(Params p) {
    __shared__ float kt[32][192];
    const int tid = threadIdx.x, qi = tid >> 2, sl = tid & 3, qb = blockIdx.x & 63, h = (blockIdx.x >> 6) & 7, b = blockIdx.x >> 9;
    const size_t r = (size_t)b * SEQ + qb * 64 + qi;
    float q[48], o[32]; float m = -1e30f, l = 0.f;
#pragma unroll
    for (int i = 0; i < 48; ++i) q[i] = bf2f(p.QP()[r * 1536 + h * 192 + i * 4 + sl]);
#pragma unroll
    for (int i = 0; i < 32; ++i) o[i] = 0.f;
    const bf16_t* Kb = p.Kc() + (size_t)b * KVROWS * 192;
#pragma unroll 1
    for (int tile = 0; tile < KVROWS / 32; ++tile) {
        __syncthreads();
        for (int e = tid; e < 32 * 192; e += 256) kt[e / 192][e % 192] = bf2f(Kb[(size_t)tile * 32 * 192 + e]);
        __syncthreads();
#pragma unroll 1
        for (int g = 0; g < 4; ++g) {
            float s[8]; float tmax = -1e30f;
#pragma unroll
            for (int j = 0; j < 8; ++j) { float a = 0.f; const float* kr = &kt[g * 8 + j][sl];
#pragma unroll
                for (int i = 0; i < 48; ++i) a += q[i] * kr[i * 4];
                a += __shfl_xor(a, 1); a += __shfl_xor(a, 2);
                if (tile * 32 + g * 8 + j >= LTOT) a = -1e30f;
                s[j] = a; tmax = fmaxf(tmax, a); }
            const float mn = fmaxf(m, tmax), alpha = exp2f(m - mn); m = mn; l *= alpha;
#pragma unroll
            for (int i = 0; i < 32; ++i) o[i] *= alpha;
#pragma unroll
            for (int j = 0; j < 8; ++j) { const float pj = (tile * 32 + g * 8 + j >= LTOT) ? 0.f : exp2f(s[j] - mn); l += pj; const float* kr = &kt[g * 8 + j][sl];
#pragma unroll
                for (int i = 0; i < 32; ++i) o[i] += pj * kr[i * 4]; }
        }
    }
    const float inv = 1.f / l;
#pragma unroll
    for (int i = 0; i < 32; ++i) p.OA()[r * 1024 + h * 128 + i * 4 + sl] = f2bf(o[i] * inv);
}

struct ProbYm {
    Params p; int M, N, K, pad;
    __device__ bool setup(int, int&) const { return true; }
    __device__ float4 a4(int, int row, int k) const { return ld_bf4(p.HM() + (size_t)row * DM + k); }
    __device__ float4 b4(int, int k, int col) const { return *(const float4*)(p.w_m_proj + (size_t)k * DM + col); }
    __device__ void epi(int, int row, int col, const float (&v)[4]) const {
#pragma unroll
        for (int j = 0; j < 4; ++j) p.MIX()[(size_t)row * DM + col + j] = f2bf(v[j] * bf2f(p.GATE()[(size_t)row * 2048 + col + j]));
    }
};
struct ProbYa {
    Params p; int M, N, K, pad;
    __device__ bool setup(int, int&) const { return true; }
    __device__ float4 a4(int, int row, int k) const { return ld_bf4(p.OA() + (size_t)row * DM + k); }
    __device__ float4 b4(int, int k, int col) const { return *(const float4*)(p.WOF() + (size_t)k * DM + col); }
    __device__ void epi(int, int row, int col, const float (&v)[4]) const {
#pragma unroll
        for (int j = 0; j < 4; ++j) { const size_t o = (size_t)row * DM + col + j; p.MIX()[o] = f2bf(bf2f(p.MIX()[o]) + v[j] * bf2f(p.GATE()[(size_t)row * 2048 + 1024 + col + j])); }
    }
};
struct ProbOut {
    Params p; int M, N, K, pad;
    __device__ bool setup(int, int&) const { return true; }
    __device__ float4 a4(int, int row, int k) const { return ld_bf4(p.MIX() + (size_t)row * DM + k); }
    __device__ float4 b4(int, int k, int col) const { return *(const float4*)(p.w_out + (size_t)k * DM + col); }
    __device__ void epi(int, int row, int col, const float (&v)[4]) const {
        const float4 xv = *(const float4*)(p.x + (size_t)row * DM + col);
        *(float4*)(p.out + (size_t)row * DM + col) = make_float4(xv.x + v[0], xv.y + v[1], xv.z + v[2], xv.w + v[3]);
    }
};

__global__ void __launch_bounds__(256) k_route(Params p) {
    __shared__ float xn[8][1024];
    const int tid = threadIdx.x, lane = tid & 63, w = tid >> 6;
    for (int base = blockIdx.x * 8; base < NT; base += gridDim.x * 8) {
        __syncthreads();
        for (int rr = 0; rr < 2; ++rr) {
            const int row = base + w * 2 + rr; const float* src = p.out + (size_t)row * DM;
            float4 v[4]; float ss = 0.f;
#pragma unroll
            for (int j = 0; j < 4; ++j) { v[j] = *(const float4*)(src + (j * 64 + lane) * 4); ss += v[j].x * v[j].x + v[j].y * v[j].y + v[j].z * v[j].z + v[j].w * v[j].w; }
            const float rstd = rsqrtf(wave_sum(ss) * (1.f / DM) + EPS);
#pragma unroll
            for (int j = 0; j < 4; ++j) { const int c = (j * 64 + lane) * 4; const float4 g = *(const float4*)(p.norm_ffn + c);
                const float a0 = v[j].x * rstd * g.x, a1 = v[j].y * rstd * g.y, a2 = v[j].z * rstd * g.z, a3 = v[j].w * rstd * g.w;
                float* d = &xn[w * 2 + rr][c]; d[0] = a0; d[1] = a1; d[2] = a2; d[3] = a3;
                bf16_t* o = p.XN2() + (size_t)row * DM + c; o[0] = f2bf(a0); o[1] = f2bf(a1); o[2] = f2bf(a2); o[3] = f2bf(a3); }
        }
        __syncthreads();
        const int rloc = w * 2 + (lane >> 5), e = lane & 31, row = base + rloc;
        float acc = p.b_router[e];
        for (int k = 0; k < DM; ++k) acc += xn[rloc][k] * p.w_router[(size_t)k * NEXP + e];
        float val = acc; int ti[4]; float tv[4];
#pragma unroll
        for (int kk = 0; kk < 4; ++kk) {
            float best = val; int bi = e;
#pragma unroll
            for (int o = 1; o < 32; o <<= 1) { const float ov = __shfl_xor(best, o); const int oi = __shfl_xor(bi, o); if (ov > best || (ov == best && oi < bi)) { best = ov; bi = oi; } }
            ti[kk] = bi; tv[kk] = best; if (e == bi) val = -3.0e38f;
        }
        if (e == 0) {
            const float mx = tv[0]; float ex[4], sum = 0.f;
#pragma unroll
            for (int kk = 0; kk < 4; ++kk) { ex[kk] = __expf(tv[kk] - mx); sum += ex[kk]; }
#pragma unroll
            for (int kk = 0; kk < 4; ++kk) { p.TOPI()[row * 4 + kk] = ti[kk]; p.TOPW()[row * 4 + kk] = ex[kk] / sum; p.RANK()[row * 4 + kk] = atomicAdd(&p.CNT()[ti[kk] * CNT_STRIDE], 1); }
        }
    }
}
__device__ __forceinline__ int expert_pstart(const int* cnt, int e) { int s = 0; for (int i = 0; i < e; ++i) s += (cnt[i * CNT_STRIDE] + 255) / 256 * 256; return s; }
__global__ void __launch_bounds__(256) k_scatter(Params p) {
    __shared__ int ps[NEXP];
    if (threadIdx.x < NEXP) ps[threadIdx.x] = expert_pstart(p.CNT(), threadIdx.x);
    __syncthreads();
    const int gid = blockIdx.x * 256 + threadIdx.x; if (gid >= NT * 4) return;
    const int slot = ps[p.TOPI()[gid]] + p.RANK()[gid]; p.SLOTS()[gid] = slot; p.SLOT_TOK()[slot] = gid >> 2;
}

struct ProbM1 {
    Params p; int M, N, K, pad;
    __device__ bool setup(int tm, int& e) const {
        int s = 0; e = -1;
        for (int i = 0; i < NEXP; ++i) { const int pc = (p.CNT()[i * CNT_STRIDE] + 255) / 256 * 256; if (tm * 64 < s + pc) { e = i; break; } s += pc; }
        return e >= 0;
    }
    __device__ float4 a4(int, int row, int k) const { const int tok = p.SLOT_TOK()[row]; return tok < 0 ? make_float4(0.f, 0.f, 0.f, 0.f) : ld_bf4(p.XN2() + (size_t)tok * DM + k); }
    __device__ float4 b4(int e, int k, int col) const { const float* w = p.w1 + ((size_t)e * DM + k) * 2048 + (col >> 1); const float2 g = *(const float2*)w, l = *(const float2*)(w + 1024); return make_float4(g.x, l.x, g.y, l.y); }
    __device__ void epi(int e, int row, int col, const float (&v)[4]) const {
#pragma unroll
        for (int j = 0; j < 2; ++j) { const int c = (col >> 1) + j; const float g0 = v[2 * j] + p.b1[(size_t)e * 2048 + c], l0 = v[2 * j + 1] + p.b1[(size_t)e * 2048 + 1024 + c];
            const float glu = fminf(g0, 7.f), lin = fminf(fmaxf(l0, -7.f), 7.f);
            p.ACT()[(size_t)row * DFF + c] = f2bf(glu * sigmoidf_(1.702f * glu) * (lin + 1.f)); }
    }
};
struct ProbM2 {
    Params p; int M, N, K, pad;
    __device__ bool setup(int tm, int& e) const {
        int s = 0; e = -1;
        for (int i = 0; i < NEXP; ++i) { const int pc = (p.CNT()[i * CNT_STRIDE] + 255) / 256 * 256; if (tm * 64 < s + pc) { e = i; break; } s += pc; }
        return e >= 0;
    }
    __device__ float4 a4(int, int row, int k) const { return ld_bf4(p.ACT() + (size_t)row * DFF + k); }
    __device__ float4 b4(int e, int k, int col) const { return *(const float4*)(p.w2 + ((size_t)e * DFF + k) * DM + col); }
    __device__ void epi(int e, int row, int col, const float (&v)[4]) const {
#pragma unroll
        for (int j = 0; j < 4; ++j) p.YB()[(size_t)row * DM + col + j] = f2bf(v[j] + p.b2[(size_t)e * DM + col + j]);
    }
};

__global__ void __launch_bounds__(256) k_combine(Params p) {
    const int lane = threadIdx.x & 63, gw = (blockIdx.x * 256 + threadIdx.x) >> 6, ngw = (gridDim.x * 256) >> 6;
    for (int r = gw; r < NT; r += ngw) {
        float4 v[4];
#pragma unroll
        for (int j = 0; j < 4; ++j) v[j] = *(const float4*)(p.out + (size_t)r * DM + (j * 64 + lane) * 4);
#pragma unroll
        for (int kk = 0; kk < 4; ++kk) { const float w = p.TOPW()[r * 4 + kk]; const bf16_t* y = p.YB() + (size_t)p.SLOTS()[r * 4 + kk] * DM;
#pragma unroll
            for (int j = 0; j < 4; ++j) { const float4 t = ld_bf4(y + (j * 64 + lane) * 4); v[j].x += w * t.x; v[j].y += w * t.y; v[j].z += w * t.z; v[j].w += w * t.w; } }
        float ss = 0.f;
#pragma unroll
        for (int j = 0; j < 4; ++j) ss += v[j].x * v[j].x + v[j].y * v[j].y + v[j].z * v[j].z + v[j].w * v[j].w;
        const float rstd = rsqrtf(wave_sum(ss) * (1.f / DM) + EPS);
#pragma unroll
        for (int j = 0; j < 4; ++j) { const int c = (j * 64 + lane) * 4; const float4 g = *(const float4*)(p.norm_final + c);
            *(float4*)(p.out + (size_t)r * DM + c) = make_float4(v[j].x * rstd * g.x, v[j].y * rstd * g.y, v[j].z * rstd * g.z, v[j].w * rstd * g.w); }
    }
}

#define LAS __attribute__((address_space(3)))
typedef short bf16x8 __attribute__((ext_vector_type(8)));
typedef float f32x4 __attribute__((ext_vector_type(4)));
typedef float f32x2 __attribute__((ext_vector_type(2)));
typedef unsigned u32x4 __attribute__((ext_vector_type(4)));
typedef unsigned u32x2 __attribute__((ext_vector_type(2)));
typedef int v4i __attribute__((ext_vector_type(4)));
typedef int v8i __attribute__((ext_vector_type(8)));

constexpr int MK_THREADS = 512;
constexpr int RING_BYTES = 131072, MISC_OFF = RING_BYTES, MK_LDS = 147456;
constexpr int NIN_PAD = 5632;

namespace pg8 {
constexpr int BM = 256, BK = 64, HALF = 128, HTB = HALF * BK * 2, NXCD = 8, WGM = 8;
__host__ __device__ __forceinline__ int lds_byte(int r, int c) { const int st = (r >> 4) * 2 + (c >> 5), rr = r & 15, cc = c & 31, ob = rr * 64 + cc * 2; return st * 1024 + (ob ^ (((ob >> 9) & 1) << 5)); }
__host__ __device__ __forceinline__ void stage_rc(int b, int& R, int& C) { const int st = b / 1024, sb = b % 1024, swz = sb ^ (((sb >> 9) & 1) << 5); R = (st >> 1) * 16 + swz / 64; C = (st & 1) * 32 + (swz % 64) / 2; }
__host__ __device__ __forceinline__ int perm32(int rho) { const int n = rho >> 4, i = rho & 15; return 8 * (i >> 2) + 4 * n + (i & 3); }
__device__ __forceinline__ unsigned cvt_pk_bf16(float lo, float hi) { unsigned r; asm volatile("v_cvt_pk_bf16_f32 %0, %1, %2" : "=v"(r) : "v"(lo), "v"(hi)); return r; }

struct Unit { int pm, pn, e; const char* A; const char* B; };

struct StaticOrder {
    int nM, nN, nwg, G, c; const char* A; const char* Bt; size_t btile;
    __device__ void init(int M, int N, int K, int G_, int c_, const void* A_, const void* Bt_) { nM = M / BM; nN = N / BM; nwg = nM * nN; G = G_; c = c_; A = (const char*)A_; Bt = (const char*)Bt_; btile = (size_t)BM * K * 2; }
    __device__ bool next(int i, Unit& u) const {
        const long L = (long)i * G + c; if (L >= nwg) return false;
        int wgid = (int)L; { const int q = nwg / NXCD, r = nwg % NXCD, xcd = wgid % NXCD, off = wgid / NXCD; wgid = (xcd < r ? xcd * (q + 1) : r * (q + 1) + (xcd - r) * q) + off; }
        const int nig = WGM * nN, gid = wgid / nig, fm = gid * WGM, gsz = (nM - fm) < WGM ? (nM - fm) : WGM;
        u.pm = fm + ((wgid % nig) % gsz); u.pn = (wgid % nig) / gsz; u.e = 0; u.A = A; u.B = Bt + (size_t)u.pn * btile; return true;
    }
    __device__ __forceinline__ int arow(int r) const { return r; }
    __device__ __forceinline__ int arow_l(const volatile LAS int*, int r, int) const { return r; }
    __device__ __forceinline__ const int* rows_src(const Unit&, int) const { return nullptr; }
    static constexpr bool HAS_BIAS = false;
    __device__ __forceinline__ const float* bias_src(const Unit&, int) const { return nullptr; }
};
template <int NN> struct StaticOrderN {
    static constexpr int nM = NT / BM, nwg = nM * NN, nig = WGM * NN;
    static_assert(nM % WGM == 0, "row groups are full");
    int G, c; const char* A; const char* Bt; size_t btile;
    __device__ void init(int K, int G_, int c_, const void* A_, const void* Bt_) { G = G_; c = c_; A = (const char*)A_; Bt = (const char*)Bt_; btile = (size_t)BM * K * 2; }
    __device__ bool next(int i, Unit& u) const {
        const int L = i * G + c; if (L >= nwg) return false;
        constexpr int q = nwg / NXCD, r = nwg % NXCD; const int xcd = L & (NXCD - 1), off = L >> 3;
        const int wgid = (xcd < r ? xcd * (q + 1) : r * (q + 1) + (xcd - r) * q) + off;
        const int gid = wgid / nig, rem = wgid - gid * nig;
        u.pm = gid * WGM + (rem & (WGM - 1)); u.pn = rem >> 3; u.e = 0; u.A = A; u.B = Bt + (size_t)u.pn * btile; return true;
    }
    __device__ __forceinline__ int arow(int r) const { return r; }
    __device__ __forceinline__ int arow_l(const volatile LAS int*, int r, int) const { return r; }
    __device__ __forceinline__ const int* rows_src(const Unit&, int) const { return nullptr; }
    static constexpr bool HAS_BIAS = false;
    __device__ __forceinline__ const float* bias_src(const Unit&, int) const { return nullptr; }
};
struct MixOrder {
    static constexpr int NN = 4, nM = NT / BM, nwg = nM * NN, nig = WGM * NN;
    int G, c; const char* A0; const char* B0; const char* A1; const char* B1; size_t btile;
    __device__ bool next(int i, Unit& u) const {
        const int L = (i >> 1) * G + c; if (L >= nwg) return false;
        constexpr int q = nwg / NXCD, r = nwg % NXCD; const int xcd = L & (NXCD - 1), off = L >> 3;
        const int wgid = (xcd < r ? xcd * (q + 1) : r * (q + 1) + (xcd - r) * q) + off;
        const int gid = wgid / nig, rem = wgid - gid * nig;
        u.pm = gid * WGM + (rem & (WGM - 1)); u.pn = rem >> 3; u.e = i & 1; u.A = u.e ? A1 : A0; u.B = (u.e ? B1 : B0) + (size_t)u.pn * btile; return true;
    }
    __device__ __forceinline__ int arow(int r) const { return r; }
    __device__ __forceinline__ int arow_l(const volatile LAS int*, int r, int) const { return r; }
    __device__ __forceinline__ const int* rows_src(const Unit&, int) const { return nullptr; }
    static constexpr bool HAS_BIAS = false;
    __device__ __forceinline__ const float* bias_src(const Unit&, int) const { return nullptr; }
};
template <int NPN> struct MoeOrder {
    static constexpr int npn = NPN;
    const volatile LAS int* tstart;
    int G, c; const char* A; const char* W; size_t wexp, btile; const int* rowidx;
    const float* bias; int bsplit;
    __device__ bool next(int i, Unit& u) const {
        const int L = i * G + c; const int ntile = __builtin_amdgcn_readfirstlane(tstart[NEXP]); const int R = (ntile + 7) >> 3, t = L >> 3;
        const int ml = t / npn, pn = t % npn, mt = (L & 7) * R + ml; if (ml >= R || mt >= ntile) return false;
        const int k = (int)(threadIdx.x & 31u); const int tv = tstart[k];
        const int e = __builtin_popcount((unsigned)__ballot(k >= 1 && tv <= mt));
        u.pm = mt; u.pn = pn; u.e = e; u.A = A; u.B = W + (size_t)e * wexp + (size_t)pn * btile; return true;
    }
    __device__ __forceinline__ int arow(int r) const { if (!rowidx) return r; const int t = rowidx[r]; return t < 0 ? 0 : t; }
    __device__ __forceinline__ int arow_l(const volatile LAS int* tab, int r, int rl) const { if (!rowidx) return r; const int t = tab[rl]; return t < 0 ? 0 : t; }
    __device__ __forceinline__ const int* rows_src(const Unit& u, int lane) const { return rowidx ? rowidx + (size_t)u.pm * BM + lane * 4 : nullptr; }
    static constexpr bool HAS_BIAS = true;
    __device__ __forceinline__ const float* bias_src(const Unit& u, int lane) const {
        return bsplit ? bias + (size_t)u.e * 2048 + (lane >> 5) * 1024 + u.pn * 128 + (lane & 31) * 4 : bias + (size_t)u.e * 1024 + u.pn * 256 + lane * 4; }
};

template <class Epi, class Sched, bool F8 = false>
__device__ __forceinline__ void gemm_phase(LAS unsigned char* lds, const int K, const int lda, const Sched& S, const Epi& E) {
    const int tid = threadIdx.x, wid = __builtin_amdgcn_readfirstlane(tid >> 6), lane = tid & 63, wr = wid >> 2, wc = wid & 3, fr = lane & 15, fq = lane >> 4;
    const int nt = K / BK;
    unsigned voffB[2];
#pragma unroll
    for (int i = 0; i < 2; ++i) { int R, C; stage_rc(tid * 16 + i * 8192, R, C); const int Rb = Epi::PERM ? ((R & ~31) + perm32(R & 31)) : R; voffB[i] = (unsigned)(Rb * K + C) * 2u; }
    const size_t kstep = (size_t)(BK * 2);
    const size_t hstepB = (size_t)HALF * K * 2;
    const unsigned ldsw = (unsigned)wid * 1024u;
    const int aoff = lds_byte(wr * 64 + fr, fq * 8), boff = lds_byte(wc * 32 + fr, fq * 8);
#define PG8_SA(b, h) (((b) * 2 + (h)) * HTB)
#define PG8_SB(b, h) ((4 + (b) * 2 + (h)) * HTB)
#define PG8_STAGE(bufoff, gbase, voff) do { _Pragma("unroll") for (int _i = 0; _i < 2; ++_i) \
        __builtin_amdgcn_global_load_lds((const unsigned*)((const char*)(gbase) + (voff)[_i]), (LAS unsigned*)(lds + (bufoff) + ldsw + _i * 8192), 16, 0, 0); } while (0)
#define PG8_STAGE_B(bufoff, gbase) do { if constexpr (F8) { const u32x2 vo_ = *(const LAS u32x2*)vslot; const unsigned vv_[2] = {vo_[0], vo_[1]}; PG8_STAGE(bufoff, gbase, vv_); } else PG8_STAGE(bufoff, gbase, voffB); } while (0)
#define PG8_STAGE_A(bufoff, gbase, h) do { if constexpr (F8) { const u32x2 vo_ = *(const LAS u32x2*)(vslot + 2 + 2 * (h)); const unsigned vv_[2] = {vo_[0], vo_[1]}; PG8_STAGE(bufoff, gbase, vv_); } else PG8_STAGE(bufoff, gbase, vc[h]); } while (0)
#define PG8_LDA(dst, b, h) do { _Pragma("unroll") for (int m = 0; m < 4; ++m) _Pragma("unroll") for (int k = 0; k < 2; ++k) dst[m][k] = *(const LAS bf16x8*)(lds + PG8_SA(b, h) + aoff + m * 2048 + k * 1024); } while (0)
#define PG8_LDB(dst, b, h) do { _Pragma("unroll") for (int n = 0; n < 2; ++n) _Pragma("unroll") for (int k = 0; k < 2; ++k) dst[n][k] = *(const LAS bf16x8*)(lds + PG8_SB(b, h) + boff + n * 2048 + k * 1024); } while (0)
#define PG8_MMA(ai, bj, At, Bt) do { __builtin_amdgcn_s_setprio(1); _Pragma("unroll") for (int m = 0; m < 4; ++m) _Pragma("unroll") for (int n = 0; n < 2; ++n) _Pragma("unroll") for (int k = 0; k < 2; ++k) \
        acc[ai][bj][m][n] = __builtin_amdgcn_mfma_f32_16x16x32_bf16(Bt[n][k], At[m][k], acc[ai][bj][m][n], 0, 0, 0); __builtin_amdgcn_s_setprio(0); } while (0)
#define PG8_LDA8(dst, b, h) do { _Pragma("unroll") for (int m = 0; m < 4; ++m) dst[m] = __builtin_shufflevector(*(const LAS v4i*)(lds + PG8_SA(b, h) + aoff + m * 2048), *(const LAS v4i*)(lds + PG8_SA(b, h) + aoff + m * 2048 + 1024), 0, 1, 2, 3, 4, 5, 6, 7); } while (0)
#define PG8_LDB8(dst, b, h) do { _Pragma("unroll") for (int n = 0; n < 2; ++n) dst[n] = __builtin_shufflevector(*(const LAS v4i*)(lds + PG8_SB(b, h) + boff + n * 2048), *(const LAS v4i*)(lds + PG8_SB(b, h) + boff + n * 2048 + 1024), 0, 1, 2, 3, 4, 5, 6, 7); } while (0)
#define PG8_MMA8(ai, bj, At, Bt) do { __builtin_amdgcn_s_setprio(1); _Pragma("unroll") for (int m = 0; m < 4; ++m) _Pragma("unroll") for (int n = 0; n < 2; ++n) \
        acc[ai][bj][m][n] = __builtin_amdgcn_mfma_scale_f32_16x16x128_f8f6f4(Bt[n], At[m], acc[ai][bj][m][n], 0, 0, 0, 122, 0, 127); __builtin_amdgcn_s_setprio(0); } while (0)
#define PG8_XLDA(b, h) do { if constexpr (F8) PG8_LDA8(At8, b, h); else PG8_LDA(At, b, h); } while (0)
#define PG8_XLDB0(b, h) do { if constexpr (F8) PG8_LDB8(B08, b, h); else PG8_LDB(B0, b, h); } while (0)
#define PG8_XLDB1(b, h) do { if constexpr (F8) PG8_LDB8(B18, b, h); else PG8_LDB(B1, b, h); } while (0)
#define PG8_XMM0(ai, bj) do { if constexpr (F8) PG8_MMA8(ai, bj, At8, B08); else PG8_MMA(ai, bj, At, B0); } while (0)
#define PG8_XMM1(ai, bj) do { if constexpr (F8) PG8_MMA8(ai, bj, At8, B18); else PG8_MMA(ai, bj, At, B1); } while (0)
#define PG8_WAIT_V(n) asm volatile("s_waitcnt vmcnt(" #n ")" ::: "memory")
#define PG8_WAIT_L(n) asm volatile("s_waitcnt lgkmcnt(" #n ")" ::: "memory")
#define PG8_BAR __builtin_amdgcn_s_barrier()
#define PG8_SCHED __builtin_amdgcn_sched_barrier(0)
#define PG8_VOFFL(dst, u) do { int _tt = tid; asm volatile("" : "+v"(_tt)); _Pragma("unroll") for (int _i = 0; _i < 2; ++_i) { int _R, _C; stage_rc(_tt * 16 + _i * 8192, _R, _C); \
        _Pragma("unroll") for (int _h = 0; _h < 2; ++_h) dst[_h][_i] = (unsigned)(S.arow_l(rowtab, (u).pm * BM + _h * HALF + _R, _h * HALF + _R) * lda + _C) * 2u; } } while (0)
#define PG8_VOFF(dst, u) do { int _tt = tid; asm volatile("" : "+v"(_tt)); _Pragma("unroll") for (int _i = 0; _i < 2; ++_i) { int _R, _C; stage_rc(_tt * 16 + _i * 8192, _R, _C); \
        _Pragma("unroll") for (int _h = 0; _h < 2; ++_h) dst[_h][_i] = (unsigned)(S.arow((u).pm * BM + _h * HALF + _R) * lda + _C) * 2u; } } while (0)
    constexpr bool HB = Sched::HAS_BIAS;
    LAS float* bias_l = (LAS float*)(lds + MISC_OFF + 13312);
    volatile LAS int* rowtab = (volatile LAS int*)(lds + MISC_OFF + 14336);
#define PG8_ROWS(u) do { if constexpr (HB) { const int* rs_ = S.rows_src(u, lane); if (wid == 0 && rs_) __builtin_amdgcn_global_load_lds((const unsigned*)rs_, (LAS unsigned*)(lds + MISC_OFF + 14336), 16, 0, 0); } } while (0)
#define PG8_BIAS(u) do { if constexpr (HB) { if (wid == 0) __builtin_amdgcn_global_load_lds((const unsigned*)S.bias_src(u, lane), (LAS unsigned*)bias_l, 16, 0, 0); } } while (0)
#define PG8_ACC_INIT() do { f32x4 bv_[2][2]; _Pragma("unroll") for (int b = 0; b < 2; ++b) _Pragma("unroll") for (int n = 0; n < 2; ++n) { \
        if constexpr (HB) bv_[b][n] = *(const LAS f32x4*)(bias_l + b * 128 + wc * 32 + 8 * fq + 4 * n); else bv_[b][n] = (f32x4){0.f, 0.f, 0.f, 0.f}; } \
        _Pragma("unroll") for (int a = 0; a < 2; ++a) _Pragma("unroll") for (int b = 0; b < 2; ++b) _Pragma("unroll") for (int m = 0; m < 4; ++m) _Pragma("unroll") for (int n = 0; n < 2; ++n) acc[a][b][m][n] = bv_[b][n]; } while (0)
    Unit cur, nxt; int ui = 0;
    if (!S.next(0, cur)) return;
    f32x4 acc[2][2][4][2];
    bf16x8 At[4][2], B0[2][2], B1[2][2]; v8i At8[4], B08[2], B18[2];
    unsigned vc[2][2], vn[2][2];
    LAS unsigned* vslot = (LAS unsigned*)(lds + MISC_OFF + 1024) + tid * 6;
    PG8_VOFF(vc, cur);
    if constexpr (F8) { vslot[0] = voffB[0]; vslot[1] = voffB[1]; vslot[2] = vc[0][0]; vslot[3] = vc[0][1]; vslot[4] = vc[1][0]; vslot[5] = vc[1][1]; }
    const char* cA = cur.A; const char* cB = cur.B;
    PG8_BIAS(cur);
    PG8_STAGE_B(PG8_SB(0, 0), cB); PG8_STAGE_B(PG8_SB(0, 1), cB + hstepB); PG8_STAGE_A(PG8_SA(0, 0), cA, 0); PG8_STAGE_A(PG8_SA(0, 1), cA, 1);
    if (wr == 1) PG8_BAR;
    PG8_WAIT_V(2); PG8_BAR;
    PG8_STAGE_B(PG8_SB(1, 0), cB + kstep); PG8_STAGE_A(PG8_SA(1, 0), cA + kstep, 0); PG8_STAGE_B(PG8_SB(1, 1), cB + hstepB + kstep);
    PG8_WAIT_V(6); PG8_BAR;
    PG8_ACC_INIT();
    for (;;) {
        const bool has_next = S.next(ui + 1, nxt);
        const char* nA = has_next ? nxt.A : cA; const char* nB = has_next ? nxt.B : cB;
#pragma unroll 1
        for (int t = 0; t < nt; t += 2) {
            const bool last = (t == nt - 2);
            const char* a1 = cA + (size_t)(t + 1) * kstep;
            const char* a2 = last ? nA : cA + (size_t)(t + 2) * kstep; const char* b2 = last ? nB : cB + (size_t)(t + 2) * kstep;
            const char* a3 = a2 + kstep; const char* b3 = b2 + kstep;
            if constexpr (HB) { if (t == nt - 4 && has_next) PG8_ROWS(nxt); }
            if (last && has_next) { if constexpr (HB) { PG8_VOFFL(vn, nxt); } else { PG8_VOFF(vn, nxt); } PG8_BIAS(nxt); }
            PG8_XLDB0(0, 0); PG8_XLDB1(0, 1); PG8_SCHED; PG8_XLDA(0, 0); PG8_STAGE_A(PG8_SA(1, 1), a1, 1);
            PG8_WAIT_V(8); PG8_WAIT_L(0); PG8_BAR; PG8_XMM0(0, 0); PG8_XMM1(0, 1); PG8_BAR; PG8_SCHED;
            if (last && has_next) {
                if constexpr (F8) { vslot[2] = vn[0][0]; vslot[3] = vn[0][1]; vslot[4] = vn[1][0]; vslot[5] = vn[1][1]; }
                else {
#pragma unroll
                for (int h = 0; h < 2; ++h)
#pragma unroll
                    for (int i = 0; i < 2; ++i) vc[h][i] = vn[h][i];
                }
            }
            PG8_XLDA(0, 1); PG8_STAGE_B(PG8_SB(0, 0), b2); PG8_STAGE_B(PG8_SB(0, 1), b2 + hstepB); PG8_STAGE_A(PG8_SA(0, 0), a2, 0);
            PG8_WAIT_V(8); PG8_WAIT_L(0); PG8_BAR; PG8_XMM0(1, 0); PG8_XMM1(1, 1); PG8_BAR; PG8_SCHED;
            PG8_XLDB0(1, 0); PG8_XLDB1(1, 1); PG8_SCHED; PG8_XLDA(1, 0); PG8_STAGE_A(PG8_SA(0, 1), a2, 1);
            PG8_WAIT_V(8); PG8_WAIT_L(0); PG8_BAR; PG8_XMM0(0, 0); PG8_XMM1(0, 1); PG8_BAR; PG8_SCHED;
            PG8_XLDA(1, 1); PG8_STAGE_B(PG8_SB(1, 0), b3); PG8_STAGE_B(PG8_SB(1, 1), b3 + hstepB); PG8_STAGE_A(PG8_SA(1, 0), a3, 0);
            PG8_WAIT_V(8); PG8_WAIT_L(0); PG8_BAR; PG8_XMM0(1, 0); PG8_XMM1(1, 1); PG8_BAR; PG8_SCHED;
        }
        if (wr == 0) PG8_BAR;
        E(acc, cur, wr, wc, fr, fq);
        if (!has_next) break;
        if constexpr (Epi::TWO_PASS) { if (cur.e != 0) PG8_ACC_INIT(); }
        else PG8_ACC_INIT();
        cur = nxt; cA = nA; cB = nB; ++ui;
        if (wr == 1) PG8_BAR;
    }
    PG8_WAIT_V(0);
    PG8_BAR;
#undef PG8_SA
#undef PG8_SB
#undef PG8_STAGE
#undef PG8_STAGE_A
#undef PG8_STAGE_B
#undef PG8_LDA
#undef PG8_LDB
#undef PG8_MMA
#undef PG8_MMA8
#undef PG8_LDA8
#undef PG8_LDB8
#undef PG8_XLDA
#undef PG8_XLDB0
#undef PG8_XLDB1
#undef PG8_XMM0
#undef PG8_XMM1
#undef PG8_WAIT_V
#undef PG8_WAIT_L
#undef PG8_BAR
#undef PG8_SCHED
#undef PG8_VOFF
#undef PG8_VOFFL
#undef PG8_ROWS
#undef PG8_BIAS
#undef PG8_ACC_INIT
}
}

__device__ __forceinline__ unsigned pk4_fp8(float a, float b, float c, float d) { int p = 0; p = __builtin_amdgcn_cvt_pk_fp8_f32(a, b, p, false); p = __builtin_amdgcn_cvt_pk_fp8_f32(c, d, p, true); return (unsigned)p; }
constexpr float YB_SCALE = 8.f;
constexpr float W8_SCALE = 32.f;
__device__ __forceinline__ void st8_bf16(bf16_t* dst, const f32x4 v0, const f32x4 v1) {
    u32x4 w; w.x = pg8::cvt_pk_bf16(v0[0], v0[1]); w.y = pg8::cvt_pk_bf16(v0[2], v0[3]); w.z = pg8::cvt_pk_bf16(v1[0], v1[1]); w.w = pg8::cvt_pk_bf16(v1[2], v1[3]);
    *(u32x4*)dst = w;
}
__device__ __forceinline__ void ld8_bf16(const bf16_t* src, f32x4& v0, f32x4& v1) {
    const u32x4 w = *(const u32x4*)src;
    v0 = (f32x4){__uint_as_float(w.x << 16), __uint_as_float(w.x & 0xffff0000u), __uint_as_float(w.y << 16), __uint_as_float(w.y & 0xffff0000u)};
    v1 = (f32x4){__uint_as_float(w.z << 16), __uint_as_float(w.z & 0xffff0000u), __uint_as_float(w.w << 16), __uint_as_float(w.w & 0xffff0000u)};
}
__device__ __forceinline__ unsigned pk4_u8(f32x4 v) { const f32x4 s = v * 255.f; unsigned r = 0;
    r = __builtin_amdgcn_cvt_pk_u8_f32(s[0], 0, r); r = __builtin_amdgcn_cvt_pk_u8_f32(s[1], 1, r); r = __builtin_amdgcn_cvt_pk_u8_f32(s[2], 2, r); r = __builtin_amdgcn_cvt_pk_u8_f32(s[3], 3, r); return r; }
__device__ __forceinline__ f32x4 up4_u8(unsigned w) { return (f32x4){(float)(w & 0xffu), (float)((w >> 8) & 0xffu), (float)((w >> 16) & 0xffu), (float)(w >> 24)} * (1.f / 255.f); }
__device__ __forceinline__ void ld8_u8(const unsigned char* src, f32x4& v0, f32x4& v1) { const u32x2 w = *(const u32x2*)src; v0 = up4_u8(w.x); v1 = up4_u8(w.y); }
__device__ __forceinline__ f32x4 sig4(f32x4 v) {
    f32x4 e = v * -1.4426950408889634f;
#pragma unroll
    for (int j = 0; j < 4; ++j) e[j] = __builtin_amdgcn_exp2f(e[j]);
    e = e + 1.f;
#pragma unroll
    for (int j = 0; j < 4; ++j) e[j] = __builtin_amdgcn_rcpf(e[j]);
    return e;
}

template <int PART> struct EpiIn {
    static constexpr bool PERM = true; static constexpr bool TWO_PASS = false;
    Params p;
    __device__ __forceinline__ void operator()(const f32x4 (&acc)[2][2][4][2], const pg8::Unit& u, int wr, int wc, int fr, int fq) const {
        const int pn = u.pn; const size_t row0 = (size_t)u.pm * 256 + wr * 64 + fr; const int cl0 = wc * 32 + 8 * fq;
        if (PART == 1 || pn < 21) {
            bf16_t* base; int ld, c0; int mode;
            if (PART != 1 && pn < 2) { base = p.Qm(); ld = 512; c0 = pn * 256; mode = 1; }
            else if (PART != 1 && pn < 4) { base = p.Km(); ld = 512; c0 = (pn - 2) * 256; mode = 0; }
            else if (PART != 1 && pn < 8) { base = p.Vm(); ld = 1024; c0 = (pn - 4) * 256; mode = 0; }
            else if (PART != 0 && pn < 12) { base = p.OG(); ld = 1024; c0 = (pn - 8) * 256; mode = 2; }
            else if (PART != 0 && pn < 20) { base = p.GATE(); ld = 2048; c0 = (pn - 12) * 256; mode = 2; }
            else { base = nullptr; ld = 256; c0 = 0; mode = 3; }
#pragma unroll
            for (int ai = 0; ai < 2; ++ai)
#pragma unroll
                for (int m = 0; m < 4; ++m) { const size_t r = row0 + ai * 128 + m * 16;
#pragma unroll
                    for (int bj = 0; bj < 2; ++bj) { f32x4 v0 = acc[ai][bj][m][0], v1 = acc[ai][bj][m][1]; const int c = c0 + bj * 128 + cl0;
                        if (PART != 1 && mode == 3) { st8_bf16(p.CQb() + r * 256 + c, v0, v1); }
                        else if (PART != 0 && mode == 2) { u32x2 o8; o8.x = pk4_u8(sig4(v0)); o8.y = pk4_u8(sig4(v1)); *(u32x2*)((unsigned char*)base + r * ld + c) = o8; }
                        else { if (PART != 1 && mode == 1) { v0 = v0 * 0.125f; v1 = v1 * 0.125f; }
                               st8_bf16(base + r * ld + c, v0, v1); } } }
        } else if (PART != 1) {
#pragma unroll
            for (int ai = 0; ai < 2; ++ai)
#pragma unroll
                for (int m = 0; m < 4; ++m) { const size_t r = row0 + ai * 128 + m * 16;
                    { float* d = p.CKV() + r * 128 + cl0; *(f32x4*)d = acc[ai][0][m][0]; *(f32x4*)(d + 4) = acc[ai][0][m][1]; }
                    const f32x4 v0 = acc[ai][1][m][0], v1 = acc[ai][1][m][1];
                    if (wc < 2) { float* d = p.KR() + r * 64 + cl0; *(f32x4*)d = v0; *(f32x4*)(d + 4) = v1; }
                    else if (wc == 2) { const int g = 8 * (fq & 1);
                        if (fq < 2) { float* d = p.GI() + r * 16 + g; const f32x4 b0 = *(const f32x4*)(p.m_b_i + g), b1 = *(const f32x4*)(p.m_b_i + g + 4); *(f32x4*)d = v0 + b0; *(f32x4*)(d + 4) = v1 + b1; }
                        else { float* d = p.GF() + r * 16 + g; const f32x4 b0 = *(const f32x4*)(p.m_b_f + g), b1 = *(const f32x4*)(p.m_b_f + g + 4);
                            *(f32x4*)d = (f32x4){logsigmoidf_(v0[0] + b0[0]), logsigmoidf_(v0[1] + b0[1]), logsigmoidf_(v0[2] + b0[2]), logsigmoidf_(v0[3] + b0[3])};
                            *(f32x4*)(d + 4) = (f32x4){logsigmoidf_(v1[0] + b1[0]), logsigmoidf_(v1[1] + b1[1]), logsigmoidf_(v1[2] + b1[2]), logsigmoidf_(v1[3] + b1[3])}; } } }
        }
    }
};
template <int PART> struct EpiInP {
    static constexpr bool PERM = true; static constexpr bool TWO_PASS = false;
    Params p;
    __device__ __forceinline__ void operator()(const f32x4 (&acc)[2][2][4][2], const pg8::Unit& u, int wr, int wc, int fr, int fq) const {
        pg8::Unit v = u; v.pn = PART == 0 ? (u.pn < 8 ? u.pn : u.pn + 12) : u.pn + 8;
        EpiIn<PART> E{p}; E(acc, v, wr, wc, fr, fq);
    }
};
struct EpiQ {
    static constexpr bool PERM = true; static constexpr bool TWO_PASS = false;
    Params p;
    __device__ __forceinline__ void operator()(const f32x4 (&acc)[2][2][4][2], const pg8::Unit& u, int wr, int wc, int fr, int fq) const {
        const size_t row0 = (size_t)u.pm * 256 + wr * 64 + fr;
#pragma unroll
        for (int ai = 0; ai < 2; ++ai)
#pragma unroll
            for (int m = 0; m < 4; ++m) { const size_t r = row0 + ai * 128 + m * 16; const float rs = p.RSQ()[r] * QSCALE; const int pos = NMETA + (int)(r & (SEQ - 1));
#pragma unroll
                for (int bj = 0; bj < 2; ++bj) { const int c = u.pn * 256 + bj * 128 + wc * 32 + 8 * fq; const int local = c % 192;
                    f32x4 v0 = acc[ai][bj][m][0] * rs, v1 = acc[ai][bj][m][1] * rs;
                    if (local >= 128) { const int i0 = (local - 128) >> 1; const float* rp = p.ROPE() + ((size_t)pos * 32 + i0) * 2;
                        const f32x4 cs0 = *(const f32x4*)rp, cs1 = *(const f32x4*)(rp + 4);
                        const f32x4 o0 = (f32x4){v0[0] * cs0[0] - v0[1] * cs0[1], v0[0] * cs0[1] + v0[1] * cs0[0], v0[2] * cs0[2] - v0[3] * cs0[3], v0[2] * cs0[3] + v0[3] * cs0[2]};
                        const f32x4 o1 = (f32x4){v1[0] * cs1[0] - v1[1] * cs1[1], v1[0] * cs1[1] + v1[1] * cs1[0], v1[2] * cs1[2] - v1[3] * cs1[3], v1[2] * cs1[3] + v1[3] * cs1[2]};
                        v0 = o0; v1 = o1; }
                    st8_bf16(p.QP() + r * 1536 + c, v0, v1); }
                asm volatile("" ::: "memory"); }
    }
};
template <int PASS> struct EpiMix {
    static constexpr bool PERM = true; static constexpr bool TWO_PASS = false;
    Params p;
    __device__ __forceinline__ void operator()(const f32x4 (&acc)[2][2][4][2], const pg8::Unit& u, int wr, int wc, int fr, int fq) const {
        const size_t row0 = (size_t)u.pm * 256 + wr * 64 + fr;
#pragma unroll
        for (int ai = 0; ai < 2; ++ai)
#pragma unroll
            for (int m = 0; m < 4; ++m) { const size_t r = row0 + ai * 128 + m * 16;
#pragma unroll
                for (int bj = 0; bj < 2; ++bj) { const int c = u.pn * 256 + bj * 128 + wc * 32 + 8 * fq;
                    f32x4 g0, g1; ld8_u8((const unsigned char*)p.GATE() + r * 2048 + PASS * 1024 + c, g0, g1);
                    f32x4 v0 = acc[ai][bj][m][0] * g0, v1 = acc[ai][bj][m][1] * g1;
                    if (PASS == 1) { f32x4 m0, m1; ld8_bf16(p.MIX() + r * 1024 + c, m0, m1); v0 = v0 + m0; v1 = v1 + m1; }
                    if (PASS == 1) { u32x2 o8; o8.x = pk4_fp8(v0[0], v0[1], v0[2], v0[3]); o8.y = pk4_fp8(v1[0], v1[1], v1[2], v1[3]); *(u32x2*)((unsigned char*)p.Vm() + r * 1024 + c) = o8; }
                    else st8_bf16(p.MIX() + r * 1024 + c, v0, v1); } }
    }
};
struct EpiMix2 {
    static constexpr bool PERM = true; static constexpr bool TWO_PASS = true;
    Params p;
    __device__ __forceinline__ void operator()(f32x4 (&acc)[2][2][4][2], const pg8::Unit& u, int wr, int wc, int fr, int fq) const {
        const size_t row0 = (size_t)u.pm * 256 + wr * 64 + fr;
#pragma unroll
        for (int ai = 0; ai < 2; ++ai)
#pragma unroll
            for (int m = 0; m < 4; ++m) { const size_t r = row0 + ai * 128 + m * 16;
#pragma unroll
                for (int bj = 0; bj < 2; ++bj) { const int c = u.pn * 256 + bj * 128 + wc * 32 + 8 * fq;
                    f32x4 a0, a1; ld8_u8((const unsigned char*)p.GATE() + r * 2048 + 1024 + c, a0, a1);
#pragma unroll
                    for (int j = 0; j < 4; ++j) { a0[j] = fmaxf(a0[j], 0.5f / 255.f); a1[j] = fmaxf(a1[j], 0.5f / 255.f); }
                    if (u.e == 0) { f32x4 m0, m1; ld8_u8((const unsigned char*)p.GATE() + r * 2048 + c, m0, m1);
#pragma unroll
                        for (int j = 0; j < 4; ++j) { m0[j] *= __builtin_amdgcn_rcpf(a0[j]); m1[j] *= __builtin_amdgcn_rcpf(a1[j]); }
                        acc[ai][bj][m][0] = acc[ai][bj][m][0] * m0; acc[ai][bj][m][1] = acc[ai][bj][m][1] * m1; }
                    else { const f32x4 v0 = acc[ai][bj][m][0] * a0, v1 = acc[ai][bj][m][1] * a1;
                        u32x2 o8; o8.x = pk4_fp8(v0[0], v0[1], v0[2], v0[3]); o8.y = pk4_fp8(v1[0], v1[1], v1[2], v1[3]); *(u32x2*)((unsigned char*)p.Vm() + r * 1024 + c) = o8; } } }
    }
};
struct EpiOut {
    static constexpr bool PERM = true; static constexpr bool TWO_PASS = false;
    Params p;
    __device__ __forceinline__ void operator()(const f32x4 (&acc)[2][2][4][2], const pg8::Unit& u, int wr, int wc, int fr, int fq) const {
        const size_t row0 = (size_t)u.pm * 256 + wr * 64 + fr;
#pragma unroll
        for (int ai = 0; ai < 2; ++ai)
#pragma unroll
            for (int m = 0; m < 4; ++m) { const size_t r = row0 + ai * 128 + m * 16;
#pragma unroll
                for (int bj = 0; bj < 2; ++bj) { const int c = u.pn * 256 + bj * 128 + wc * 32 + 8 * fq; const float* xs = p.x + r * DM + c;
                    const f32x4 x0 = __builtin_nontemporal_load((const f32x4*)xs), x1 = __builtin_nontemporal_load((const f32x4*)(xs + 4));
                    st8_bf16(p.H1() + r * DM + c, acc[ai][bj][m][0] + x0, acc[ai][bj][m][1] + x1); } }
    }
};
__device__ __forceinline__ f32x4 swiglu4(f32x4 g, f32x4 l) {
    f32x4 gg, ll, e;
#pragma unroll
    for (int j = 0; j < 4; ++j) { gg[j] = __builtin_amdgcn_fmed3f(g[j], -3.0e38f, 7.f); ll[j] = __builtin_amdgcn_fmed3f(l[j], -7.f, 7.f); }
    e = gg * (-1.702f * 1.4426950408889634f);
#pragma unroll
    for (int j = 0; j < 4; ++j) e[j] = __builtin_amdgcn_exp2f(e[j]);
    e = e + 1.f;
#pragma unroll
    for (int j = 0; j < 4; ++j) e[j] = __builtin_amdgcn_rcpf(e[j]);
    const f32x4 t = gg * e;
    return t * ll + t;
}
struct EpiM1 {
    static constexpr bool PERM = true; static constexpr bool TWO_PASS = false;
    Params p;
    __device__ __forceinline__ void operator()(const f32x4 (&acc)[2][2][4][2], const pg8::Unit& u, int wr, int wc, int fr, int fq) const {
        const size_t row0 = (size_t)u.pm * 256 + wr * 64 + fr; const int c = u.pn * 128 + wc * 32 + 8 * fq;
#pragma unroll
        for (int ai = 0; ai < 2; ++ai)
#pragma unroll
            for (int m = 0; m < 4; ++m) { const size_t r = row0 + ai * 128 + m * 16;
                const f32x4 a0 = swiglu4(acc[ai][0][m][0], acc[ai][1][m][0]), a1 = swiglu4(acc[ai][0][m][1], acc[ai][1][m][1]);
                u32x2 o8; o8.x = pk4_fp8(a0[0], a0[1], a0[2], a0[3]); o8.y = pk4_fp8(a1[0], a1[1], a1[2], a1[3]); *(u32x2*)((unsigned char*)p.ACT() + r * DFF + c) = o8; }
    }
};
struct EpiM2 {
    static constexpr bool PERM = true; static constexpr bool TWO_PASS = false;
    Params p;
    __device__ __forceinline__ void operator()(const f32x4 (&acc)[2][2][4][2], const pg8::Unit& u, int wr, int wc, int fr, int fq) const {
        const size_t row0 = (size_t)u.pm * 256 + wr * 64 + fr;
#pragma unroll
        for (int bj = 0; bj < 2; ++bj) { const int c = u.pn * 256 + bj * 128 + wc * 32 + 8 * fq;
#pragma unroll
            for (int ai = 0; ai < 2; ++ai)
#pragma unroll
                for (int m = 0; m < 4; ++m) { const size_t r = row0 + ai * 128 + m * 16; const f32x4 v0 = acc[ai][bj][m][0] * YB_SCALE, v1 = acc[ai][bj][m][1] * YB_SCALE;
                    u32x2 o8; o8.x = pk4_fp8(v0[0], v0[1], v0[2], v0[3]); o8.y = pk4_fp8(v1[0], v1[1], v1[2], v1[3]); *(u32x2*)((unsigned char*)p.YB() + r * DM + c) = o8; } }
    }
};

__device__ __forceinline__ float4 ntld4(const float* p) { const f32x4 v = __builtin_nontemporal_load((const f32x4*)p); return make_float4(v[0], v[1], v[2], v[3]); }
__device__ __forceinline__ uint2 ntld2u(const bf16_t* p) { const u32x2 v = __builtin_nontemporal_load((const u32x2*)p); return make_uint2(v[0], v[1]); }
__device__ __forceinline__ float4 ntld_h1(const bf16_t* p) { const uint2 u = ntld2u(p); return make_float4(__uint_as_float(u.x << 16), __uint_as_float(u.x & 0xffff0000u), __uint_as_float(u.y << 16), __uint_as_float(u.y & 0xffff0000u)); }
__device__ __forceinline__ unsigned pk2(float lo, float hi) { return (unsigned)f2bf(lo) | ((unsigned)f2bf(hi) << 16); }
struct TrDesc { const float* W; bf16_t* WT; int ldw, K, dr0, sc0, nvalid, k0, f8; };
__device__ __forceinline__ void tr_load(const TrDesc& d, float4 (&v)[16], int lane) {
    const int lr = lane >> 4, lc = (lane & 15) * 4;
#pragma unroll
    for (int i = 0; i < 16; ++i) v[i] = (lc < d.nvalid) ? ntld4(d.W + (size_t)(d.k0 + i * 4 + lr) * d.ldw + d.sc0 + lc) : make_float4(0.f, 0.f, 0.f, 0.f);
}
__device__ __forceinline__ void tr_finish(const TrDesc& d, const float4 (&v)[16], LAS float* scr, int lane) {
    const int lr = lane >> 4, lc = (lane & 15) * 4;
#pragma unroll
    for (int i = 0; i < 16; ++i) { LAS float* q = scr + (i * 4 + lr) * 65 + lc; q[0] = v[i].x; q[1] = v[i].y; q[2] = v[i].z; q[3] = v[i].w; }
    asm volatile("s_waitcnt lgkmcnt(0)" ::: "memory");
    const int c = lane & 7;
    if (d.f8) {
#pragma unroll
        for (int j = 0; j < 8; ++j) { const int n = (lane >> 3) + 8 * j; const LAS float* s = scr + (8 * c) * 65 + n;
            u32x2 o; o.x = pk4_fp8(s[0 * 65] * W8_SCALE, s[1 * 65] * W8_SCALE, s[2 * 65] * W8_SCALE, s[3 * 65] * W8_SCALE); o.y = pk4_fp8(s[4 * 65] * W8_SCALE, s[5 * 65] * W8_SCALE, s[6 * 65] * W8_SCALE, s[7 * 65] * W8_SCALE);
            *(u32x2*)((unsigned char*)d.WT + (size_t)(d.dr0 + n) * d.K + d.k0 + 8 * c) = o; }
    } else {
#pragma unroll
    for (int j = 0; j < 8; ++j) { const int n = (lane >> 3) + 8 * j; const LAS float* s = scr + (8 * c) * 65 + n;
        u32x4 o; o.x = pk2(s[0 * 65], s[1 * 65]); o.y = pk2(s[2 * 65], s[3 * 65]); o.z = pk2(s[4 * 65], s[5 * 65]); o.w = pk2(s[6 * 65], s[7 * 65]);
        *(u32x4*)(d.WT + (size_t)(d.dr0 + n) * d.K + d.k0 + 8 * c) = o; }
    }
    asm volatile("s_waitcnt lgkmcnt(0)" ::: "memory");
}
__device__ __forceinline__ int win_src_col(int np, int& nvalid) {
    nvalid = 64;
    if (np < 3072) return np;
    if (np < 5120) return OFF_G + (np - 3072);
    if (np < 5376) return OFF_CQ + (np - 5120);
    if (np < 5504) return OFF_CKV + (np - 5376);
    if (np < 5568) return OFF_KR + (np - 5504);
    nvalid = 32; return OFF_I;
}

__device__ __forceinline__ void phase_prologue(const Params& p, LAS unsigned char* lds, int vcu, int G, int sub) {
#define SUBP(x) (sub == 0 || sub == (x))
    const int tid = threadIdx.x, lane = tid & 63, wave = tid >> 6;
    const int gw = vcu * 8 + wave, NGW = G * 8;
    LAS float* scr = (LAS float*)(lds + wave * 16640);
    if (SUBP(1)) for (int it = vcu; it < 88; it += G) {
        LAS float* um = (LAS float*)lds;
        LAS float* red = (LAS float*)(lds + 65536);
        __syncthreads();
        for (int j = wave * 2; j < wave * 2 + 2; ++j) {
            const float* src = p.meta + (size_t)j * DM; float4 v[4]; float ss = 0.f;
#pragma unroll
            for (int q = 0; q < 4; ++q) { v[q] = *(const float4*)(src + (q * 64 + lane) * 4); ss += v[q].x * v[q].x + v[q].y * v[q].y + v[q].z * v[q].z + v[q].w * v[q].w; }
            const float rstd = rsqrtf(wave_sum(ss) * (1.f / DM) + EPS);
#pragma unroll
            for (int q = 0; q < 4; ++q) { const int c = (q * 64 + lane) * 4; const float4 g = *(const float4*)(p.norm_mix + c);
                um[j * 1024 + c] = v[q].x * rstd * g.x; um[j * 1024 + c + 1] = v[q].y * rstd * g.y; um[j * 1024 + c + 2] = v[q].z * rstd * g.z; um[j * 1024 + c + 3] = v[q].w * rstd * g.w; }
        }
        __syncthreads();
        const int n = it * 64 + lane; const bool okn = n < DIN;
        float a[16];
#pragma unroll
        for (int j = 0; j < 16; ++j) a[j] = 0.f;
#pragma unroll 8
        for (int kk = 0; kk < 128; ++kk) { const int kq = wave * 128 + kk; const float w = okn ? p.w_in[(size_t)kq * DIN + n] : 0.f;
#pragma unroll
            for (int j = 0; j < 16; ++j) a[j] += um[j * 1024 + kq] * w; }
#pragma unroll
        for (int j = 0; j < 16; ++j) red[(wave * 16 + j) * 64 + lane] = a[j];
        __syncthreads();
        for (int o = tid; o < 1024; o += MK_THREADS) { const int j = o >> 6, nl = o & 63; float s = 0.f;
#pragma unroll
            for (int w8 = 0; w8 < 8; ++w8) s += red[(w8 * 16 + j) * 64 + nl];
            if (it * 64 + nl < DIN) p.ZM()[(size_t)j * DIN + it * 64 + nl] = s; }
        __syncthreads();
    }
    constexpr int I_INA = 16 * 40, I_INB = 16 * 48, I_IN = I_INA + I_INB, I_W1 = NEXP * 16 * 32, I_W2 = NEXP * 16 * 16, I_SQ = 16 * 16;
    constexpr int NITEMS = I_IN + I_W1 + I_W2 + 2 * I_SQ;
    auto decode = [&](int it, TrDesc& d) {
        int r = it;
        if (r < I_INA) { const int kb = r / 40, nb = r % 40, np = nb * 64, nl = np < 2048 ? np : np + 3072; int nv; const int sc = win_src_col(nl, nv); d = TrDesc{p.w_in, p.WinT(), DIN, DM, np, sc, nv, kb * 64, 0}; return; } r -= I_INA;
        if (r < I_INB) { const int kb = r / 48, nb = r % 48, np = nb * 64; int nv; const int sc = win_src_col(2048 + np, nv); d = TrDesc{p.w_in, (bf16_t*)p.WinT8(), DIN, DM, np, sc, nv, kb * 64, 1}; return; } r -= I_INB;
        if (r < I_W1) { const int e = r / 512, q = r % 512, kb = q / 32, nb = q % 32, np = nb * 64, pn = np >> 8, bj = (np >> 7) & 1, j = np & 127;
            d = TrDesc{p.w1 + (size_t)e * DM * 2048, (bf16_t*)((unsigned char*)p.W1T() + (size_t)e * 2048 * DM), 2048, DM, np, 1024 * bj + 128 * pn + j, 64, kb * 64, 1}; return; } r -= I_W1;
        if (r < I_W2) { const int e = r / 256, q = r % 256, kb = q / 16, nb = q % 16; d = TrDesc{p.w2 + (size_t)e * DFF * DM, (bf16_t*)((unsigned char*)p.W2T() + (size_t)e * DM * DFF), DM, DFF, nb * 64, nb * 64, 64, kb * 64, 1}; return; } r -= I_W2;
        if (r < I_SQ) { const int kb = r / 16, nb = r % 16; d = TrDesc{p.w_m_proj, p.WmT(), DM, DM, nb * 64, nb * 64, 64, kb * 64, 1}; return; } r -= I_SQ;
        { const int kb = r / 16, nb = r % 16; d = TrDesc{p.w_out, p.WoutT(), DM, DM, nb * 64, nb * 64, 64, kb * 64, 1}; }
    };
    constexpr int DEF_E0 = 16, DEF_LO = I_IN + I_W1 + DEF_E0 * 256, DEF_HI = I_IN + I_W1 + I_W2, NDEF = DEF_HI - DEF_LO;
    if (SUBP(2) || sub == 16) {
        const int nit = sub == 16 ? NDEF : NITEMS - NDEF;
        auto item = [&](int j) { return sub == 16 ? DEF_LO + j : (j < DEF_LO ? j : j + NDEF); };
        float4 va[16], vb[16]; TrDesc da, db; int it = gw;
        if (it < nit) { decode(item(it), da); tr_load(da, va, lane); }
#pragma unroll 1
        while (it < nit) {
            const int it1 = it + NGW; if (it1 < nit) { decode(item(it1), db); tr_load(db, vb, lane); }
            tr_finish(da, va, scr, lane);
            if (it1 >= nit) break;
            const int it2 = it1 + NGW; if (it2 < nit) { decode(item(it2), da); tr_load(da, va, lane); }
            tr_finish(db, vb, scr, lane);
            it = it2;
        }
    }
    if (sub == 16) return;
    if (SUBP(3)) for (int r = gw * 4; r < NT; r += NGW * 4) {
        const float* s0 = p.x + (size_t)r * DM; float4 v[16];
#pragma unroll
        for (int q = 0; q < 4; ++q)
#pragma unroll
            for (int j = 0; j < 4; ++j) v[q * 4 + j] = ntld4(s0 + (size_t)q * DM + (j * 64 + lane) * 4);
        float rs[4];
#pragma unroll
        for (int q = 0; q < 4; ++q) { float s = 0.f;
#pragma unroll
            for (int j = 0; j < 4; ++j) { const float4 t = v[q * 4 + j]; s += t.x * t.x + t.y * t.y + t.z * t.z + t.w * t.w; }
            rs[q] = rsqrtf(wave_sum(s) * (1.f / DM) + EPS); }
#pragma unroll
        for (int j = 0; j < 4; ++j) { const int c = (j * 64 + lane) * 4; const float4 g = *(const float4*)(p.norm_mix + c);
#pragma unroll
            for (int q = 0; q < 4; ++q) { const float4 t = v[q * 4 + j]; const float rr = rs[q];
                const float u0 = t.x * rr * g.x, u1 = t.y * rr * g.y, u2 = t.z * rr * g.z, u3 = t.w * rr * g.w;
                u32x2 o; o.x = pk2(u0, u1); o.y = pk2(u2, u3); *(u32x2*)(p.U() + (size_t)(r + q) * DM + c) = o;
                *(unsigned*)(p.U8() + (size_t)(r + q) * DM + c) = pk4_fp8(u0, u1, u2, u3); } }
    }
    const long gid = (long)vcu * MK_THREADS + tid, gn = (long)G * MK_THREADS;
    if (SUBP(4)) for (long i = gid; i < (long)LTOT * 32; i += gn) {
        const int pos = (int)(i >> 5), f = (int)(i & 31);
        const float freq = powf(10000.f, -(float)f / 32.f), ang = (float)pos * freq; float s, c; sincosf(ang, &s, &c);
        p.ROPE()[i * 2] = c; p.ROPE()[i * 2 + 1] = s;
    }
    const int rot_wo = (vcu + 40) & 255;
    if (SUBP(5)) for (long i = (long)rot_wo * MK_THREADS + tid; i < 8L * 8 * 1024; i += gn) {
        const int n = (int)(i & 1023), hcg = __builtin_amdgcn_readfirstlane((int)(i >> 10)), h = hcg >> 3, c0 = (hcg & 7) * 16;
        const float* ap = p.w_a_proj + (size_t)(h * 128) * DM + n; const float* kv = p.a_w_ukv + ((size_t)c0 * 8 + h) * 256 + 128;
        float acc[16];
#pragma unroll
        for (int q = 0; q < 16; ++q) acc[q] = 0.f;
#pragma unroll 4
        for (int d = 0; d < 128; ++d) { const float b = ap[(size_t)d * DM];
#pragma unroll
            for (int q = 0; q < 16; ++q) acc[q] += kv[(size_t)q * 2048 + d] * b; }
#pragma unroll
        for (int q = 0; q < 16; ++q) acc[q] *= W8_SCALE;
        u32x4 o0; o0.x = pk4_fp8(acc[0], acc[1], acc[2], acc[3]); o0.y = pk4_fp8(acc[4], acc[5], acc[6], acc[7]); o0.z = pk4_fp8(acc[8], acc[9], acc[10], acc[11]); o0.w = pk4_fp8(acc[12], acc[13], acc[14], acc[15]);
        *(u32x4*)((unsigned char*)p.WoT() + (size_t)n * 1024 + h * 128 + c0) = o0;
    }
    if (SUBP(6)) for (int t = ((vcu + 168) & 255) * 8 + wave; t < 8 * 128; t += NGW) {
        const int h = t >> 7, c = t & 127; const float2 kvv = *(const float2*)(p.a_w_ukv + ((size_t)c * 8 + h) * 256 + 2 * lane);
#pragma unroll 1
        for (int r0 = 0; r0 < 256; r0 += 64) { float keep = 0.f;
#pragma unroll 8
            for (int rr = 0; rr < 64; ++rr) { const float2 u = *(const float2*)(p.a_w_uq + ((size_t)(r0 + rr) * 8 + h) * 192 + 2 * lane);
                const float s = wave_sum(u.x * kvv.x + u.y * kvv.y); if (lane == rr) keep = s; }
            p.WqT()[(size_t)(h * 192 + c) * 256 + r0 + lane] = f2bf(keep * p.a_norm_q[r0 + lane]); }
    }
    if (SUBP(6)) for (long i = gid; i < 8L * 64 * 256; i += gn) {
        const int r = (int)(i & 255), hq = (int)(i >> 8), h = hq >> 6, q = hq & 63;
        p.WqT()[(size_t)(h * 192 + 128 + q) * 256 + r] = f2bf(p.a_w_uq[((size_t)r * 8 + h) * 192 + 128 + (q >> 1) + 32 * (q & 1)] * p.a_norm_q[r]);
    }
}

#undef SUBP
__device__ __forceinline__ void phase_kprep(const Params& p, int vcu, int G) {
    const int lane = threadIdx.x & 63, gw = vcu * 8 + (threadIdx.x >> 6), NGW = G * 8;
    const float gk0 = p.a_norm_kv[lane], gk1 = p.a_norm_kv[64 + lane];
    for (int r0 = gw * 4; r0 < NT; r0 += NGW * 4) {
        float c0[4], c1[4], x1[4], x2[4], cs[4], sn[4];
#pragma unroll
        for (int q = 0; q < 4; ++q) { const size_t r = (size_t)r0 + q; const int pos = NMETA + (int)(r & (SEQ - 1));
            c0[q] = p.CKV()[r * 128 + lane]; c1[q] = p.CKV()[r * 128 + 64 + lane];
            const int l32 = lane & 31; x1[q] = p.KR()[r * 64 + l32]; x2[q] = p.KR()[r * 64 + 32 + l32];
            const float2 t = *(const float2*)(p.ROPE() + ((size_t)pos * 32 + l32) * 2); cs[q] = t.x; sn[q] = t.y; }
#pragma unroll
        for (int q = 0; q < 4; ++q) { const size_t r = (size_t)r0 + q; const int b = (int)(r >> 12), key = (int)(r & (SEQ - 1));
            bf16_t* dst = p.Kc() + ((size_t)b * KVROWS + key) * 192;
            const float rstd = rsqrtf(wave_sum(c0[q] * c0[q] + c1[q] * c1[q]) * (1.f / 128.f) + EPS);
            dst[lane] = f2bf(c0[q] * rstd * gk0); dst[64 + lane] = f2bf(c1[q] * rstd * gk1);
            if (lane < 32) *(unsigned*)(dst + 128 + 2 * lane) = pk2(x1[q] * cs[q] - x2[q] * sn[q], x1[q] * sn[q] + x2[q] * cs[q]); }
    }
    for (int i = gw; i < NB * 64; i += NGW) {
        const int b = i >> 6, j = i & 63; bf16_t* dst = p.Kc() + ((size_t)b * KVROWS + SEQ + j) * 192;
        if (j >= NMETA) { dst[lane] = 0; dst[64 + lane] = 0; dst[128 + lane] = 0; continue; }
        const float* ckv = p.ZM() + (size_t)j * DIN + OFF_CKV; const float* kr = p.ZM() + (size_t)j * DIN + OFF_KR;
        const float c0 = ckv[lane], c1 = ckv[64 + lane];
        const float rstd = rsqrtf(wave_sum(c0 * c0 + c1 * c1) * (1.f / 128.f) + EPS);
        dst[lane] = f2bf(c0 * rstd * gk0); dst[64 + lane] = f2bf(c1 * rstd * gk1);
        if (lane < 32) { const float x1 = kr[lane], x2 = kr[32 + lane], cs = p.ROPE()[((size_t)j * 32 + lane) * 2], sn = p.ROPE()[((size_t)j * 32 + lane) * 2 + 1];
            *(unsigned*)(dst + 128 + 2 * lane) = pk2(x1 * cs - x2 * sn, x1 * sn + x2 * cs); }
    }
    for (int r0 = gw * 4; r0 < NT; r0 += NGW * 4) {
        uint2 v[4];
#pragma unroll
        for (int q = 0; q < 4; ++q) v[q] = *(const uint2*)(p.CQb() + (size_t)(r0 + q) * 256 + lane * 4);
#pragma unroll
        for (int q = 0; q < 4; ++q) { const uint2 o = v[q];
            const float a = __uint_as_float(o.x << 16), b = __uint_as_float(o.x & 0xffff0000u), c = __uint_as_float(o.y << 16), d = __uint_as_float(o.y & 0xffff0000u);
            const float ss = wave_sum(a * a + b * b + c * c + d * d);
            if (lane == 0) p.RSQ()[r0 + q] = rsqrtf(ss * (1.f / 256.f) + EPS); }
    }
}

__device__ __forceinline__ void moe_tile_table(const Params& p, volatile LAS int* tst) {
    __syncthreads();
    if (threadIdx.x == 0) { int s = 0; for (int e = 0; e < NEXP; ++e) { tst[e] = s; s += (p.CNT()[e * CNT_STRIDE] + 255) / 256; } tst[NEXP] = s; }
    __syncthreads();
}

namespace att {
using s16x4 = __attribute__((ext_vector_type(4))) short;
using f32x16 = __attribute__((ext_vector_type(16))) float;
constexpr int KN_B = 16384, KR_B = 8192, V_B = 16384;
constexpr int L_KN = 0, L_KR = 2 * KN_B, L_WS = L_KR + 2 * KR_B, L_QR = L_WS + 8 * 256, L_END = L_QR + 8 * 4096;
constexpr float THR = 8.f;
#define KSWZ(row, colB) ((row) * 256 + ((colB) ^ (((((row) & 3) << 2) | (((row) >> 2) & 3)) << 4)))
#define RSWZ(row, colB) ((row) * 128 + ((colB) ^ ((((row) >> 1) & 7) << 4)))
#define SBAR() __builtin_amdgcn_sched_barrier(0)
__device__ __forceinline__ int crow(int r, int hi) { return (r & 3) + 8 * (r >> 2) + 4 * hi; }
__device__ __forceinline__ unsigned cvtpk(float lo, float hi) { unsigned r; asm volatile("v_cvt_pk_bf16_f32 %0, %1, %2" : "=v"(r) : "v"(lo), "v"(hi)); return r; }

__device__ __forceinline__ void partialSM(f32x16& p0, f32x16& p1, float& m_reg, float& alpha) {
    float pmax = p0[0];
#pragma unroll
    for (int r = 1; r < 16; ++r) pmax = fmaxf(pmax, p0[r]);
#pragma unroll
    for (int r = 0; r < 16; ++r) pmax = fmaxf(pmax, p1[r]);
    { auto rr = __builtin_amdgcn_permlane32_swap(__float_as_uint(pmax), __float_as_uint(pmax), false, false);
      pmax = fmaxf(__uint_as_float(rr[0]), __uint_as_float(rr[1])); }
    float mn;
    if (__builtin_expect(__all(pmax - m_reg <= THR), 1)) { mn = m_reg; alpha = 1.f; }
    else { mn = fmaxf(m_reg, pmax); alpha = __builtin_amdgcn_exp2f(m_reg - mn); m_reg = mn; }
    { const float nm = -mn; f32x2 m2 = {nm, nm}; asm volatile("" : "+v"(m2));
#pragma unroll
      for (int r = 0; r < 8; ++r) { f32x2 t = {p0[2 * r], p0[2 * r + 1]}; t = t + m2; p0[2 * r] = t[0]; p0[2 * r + 1] = t[1]; f32x2 u = {p1[2 * r], p1[2 * r + 1]}; u = u + m2; p1[2 * r] = u[0]; p1[2 * r + 1] = u[1]; } }
#pragma unroll
    for (int r = 0; r < 16; ++r) p0[r] = __builtin_amdgcn_exp2f(p0[r]);
}
__device__ __forceinline__ void finishSM(f32x16& p0, f32x16& p1, float alpha, float& l_reg, bf16x8& pa0, bf16x8& pa1, bf16x8& pa2, bf16x8& pa3) {
#pragma unroll
    for (int r = 0; r < 16; ++r) p1[r] = __builtin_amdgcn_exp2f(p1[r]);
    float ps;
    { const f32x16 s16 = p0 + p1;
      typedef float f32x8_ __attribute__((ext_vector_type(8)));
      const f32x8_ s8 = __builtin_shufflevector(s16, s16, 0, 1, 2, 3, 4, 5, 6, 7) + __builtin_shufflevector(s16, s16, 8, 9, 10, 11, 12, 13, 14, 15);
      const f32x4 s4 = __builtin_shufflevector(s8, s8, 0, 1, 2, 3) + __builtin_shufflevector(s8, s8, 4, 5, 6, 7);
      const f32x2 s2 = __builtin_shufflevector(s4, s4, 0, 1) + __builtin_shufflevector(s4, s4, 2, 3);
      ps = s2[0] + s2[1]; }
    { auto rr = __builtin_amdgcn_permlane32_swap(__float_as_uint(ps), __float_as_uint(ps), false, false);
      ps = __uint_as_float(rr[0]) + __uint_as_float(rr[1]); }
    l_reg = l_reg * alpha + ps;
#define PK4(P, BASE, OUT) do { u32x4 w = {cvtpk(P[BASE + 0], P[BASE + 1]), cvtpk(P[BASE + 2], P[BASE + 3]), cvtpk(P[BASE + 4], P[BASE + 5]), cvtpk(P[BASE + 6], P[BASE + 7])}; \
    OUT = *reinterpret_cast<bf16x8*>(&w); } while (0)
    PK4(p0, 0, pa0); PK4(p0, 8, pa1); PK4(p1, 0, pa2); PK4(p1, 8, pa3);
#undef PK4
}
__device__ __forceinline__ void qkt(f32x16& p0, f32x16& p1, const char* Kn, const char* Kr, const bf16x8* qr, const char* qrl, int r32, int hi) {
    p0 = f32x16{}; p1 = f32x16{};
#pragma unroll
    for (int d0 = 0; d0 < 8; ++d0) { const int cb = (d0 * 16 + hi * 8) * 2;
        const bf16x8 b0 = *reinterpret_cast<const bf16x8*>(Kn + KSWZ(r32, cb));
        const bf16x8 b1 = *reinterpret_cast<const bf16x8*>(Kn + KSWZ(32 + r32, cb));
        p0 = __builtin_amdgcn_mfma_f32_32x32x16_bf16(b0, qr[d0], p0, 0, 0, 0);
        p1 = __builtin_amdgcn_mfma_f32_32x32x16_bf16(b1, qr[d0], p1, 0, 0, 0); }
#pragma unroll
    for (int d0 = 0; d0 < 4; ++d0) { const int cb = (d0 * 16 + hi * 8) * 2;
        const bf16x8 b0 = *reinterpret_cast<const bf16x8*>(Kr + RSWZ(r32, cb));
        const bf16x8 b1 = *reinterpret_cast<const bf16x8*>(Kr + RSWZ(32 + r32, cb));
        const bf16x8 qf = *reinterpret_cast<const bf16x8*>(qrl + d0 * 1024);
        p0 = __builtin_amdgcn_mfma_f32_32x32x16_bf16(b0, qf, p0, 0, 0, 0);
        p1 = __builtin_amdgcn_mfma_f32_32x32x16_bf16(b1, qf, p1, 0, 0, 0); }
}
__device__ __forceinline__ int v_st(int k, int c) { const int kk = (k & ~0xC) | ((k & 4) << 1) | ((k & 8) >> 1); return ((kk >> 3) * 4 + (c >> 5)) * 512 + ((kk & 7) * 32 + (c & 31)) * 2; }
__device__ __forceinline__ int v_rd_base(int lane) { return ((lane & 3) << 3) | (((lane >> 2) & 3) << 6) | (((lane >> 4) & 1) << 5) | (((lane >> 5) & 1) << 8); }
constexpr int v_rd_off(int d0, int ks, int half) { return d0 * 512 + ks * 4096 + half * 2048; }
template <int OFF> __device__ __forceinline__ s16x4 tr_read(int vb) { s16x4 r; asm volatile("ds_read_b64_tr_b16 %0, %1 offset:%2" : "=&v"(r) : "v"(vb), "i"(OFF) : "memory"); return r; }
template <int C> __device__ __forceinline__ void pv_one(f32x16& od, int bt0, int bt1, bf16x8 pa0, bf16x8 pa1, bf16x8 pa2, bf16x8 pa3) {
    const int a0 = bt0 ^ (C << 6), a1 = bt1 ^ (C << 6);
    const s16x4 l0 = tr_read<0>(a0), h0 = tr_read<0>(a1), l1 = tr_read<4096>(a0), h1 = tr_read<4096>(a1);
    const s16x4 l2 = tr_read<8192>(a0), h2 = tr_read<8192>(a1), l3 = tr_read<12288>(a0), h3 = tr_read<12288>(a1);
    asm volatile("s_waitcnt lgkmcnt(0)" ::: "memory"); SBAR();
#define PK(L, H) (bf16x8){L[0], L[1], L[2], L[3], H[0], H[1], H[2], H[3]}
    od = __builtin_amdgcn_mfma_f32_32x32x16_bf16(pa0, PK(l0, h0), od, 0, 0, 0);
    od = __builtin_amdgcn_mfma_f32_32x32x16_bf16(pa1, PK(l1, h1), od, 0, 0, 0);
    od = __builtin_amdgcn_mfma_f32_32x32x16_bf16(pa2, PK(l2, h2), od, 0, 0, 0);
    od = __builtin_amdgcn_mfma_f32_32x32x16_bf16(pa3, PK(l3, h3), od, 0, 0, 0);
#undef PK
}
__device__ __forceinline__ void pv_d0(f32x16* o, int bt0, int bt1, bf16x8 pa0, bf16x8 pa1, bf16x8 pa2, bf16x8 pa3) {
    pv_one<0>(o[0], bt0, bt1, pa0, pa1, pa2, pa3); pv_one<1>(o[1], bt0, bt1, pa0, pa1, pa2, pa3); pv_one<2>(o[2], bt0, bt1, pa0, pa1, pa2, pa3); pv_one<3>(o[3], bt0, bt1, pa0, pa1, pa2, pa3);
}
__device__ __forceinline__ int tr_base(int lane, int t) {
    const int h = lane >> 5, blk = (lane >> 4) & 1, q = (lane & 15) >> 2, p = lane & 3, row = 8 * t + 4 * h + q, ch = 2 * blk + (p >> 1);
    return KSWZ(row, ch * 16) + 8 * (p & 1);
}

__device__ __forceinline__ void attn_unit(const bf16_t* __restrict__ Qb, const bf16_t* __restrict__ Kb, bf16_t* __restrict__ Ob, char* lds) {
    const int tid = threadIdx.x, wid = tid >> 6, lane = tid & 63, r32 = lane & 31, hi = lane >> 5;
    char* Kn_l = lds + L_KN; char* Kr_l = lds + L_KR;
    float* ws = (float*)(lds + L_WS) + wid * 64; float* li_l = ws; float* al_l = ws + 32;
    float m_reg = -1e30f, l_reg = 0; f32x16 o[4] = {}; bf16x8 qr[8];
    const bf16_t* Qw = Qb + (size_t)(wid * 32 + r32) * 1536 + hi * 8;
    char* qrl = lds + L_QR + wid * 4096 + lane * 16;
#pragma unroll
    for (int d0 = 0; d0 < 8; ++d0) qr[d0] = *reinterpret_cast<const bf16x8*>(Qw + d0 * 16);
#pragma unroll
    for (int d0 = 0; d0 < 4; ++d0) *reinterpret_cast<bf16x8*>(qrl + d0 * 1024) = *reinterpret_cast<const bf16x8*>(Qw + (8 + d0) * 16);
    const int sr = tid >> 3, sc8 = tid & 7;
    const int kst0 = KSWZ(sr, sc8 * 16), kst1 = KSWZ(sr, 128 + sc8 * 16), rst = RSWZ(sr, sc8 * 16);
    const int bt0 = (int)(uintptr_t)Kn_l + tr_base(lane, 0), bt1 = (int)(uintptr_t)Kn_l + tr_base(lane, 1);
    bf16x8 s0, s1, s2;
#define SLOAD(mt) do { const bf16_t* kp = Kb + (size_t)((mt) * 64 + sr) * 192 + sc8 * 8; s0 = *reinterpret_cast<const bf16x8*>(kp); s1 = *reinterpret_cast<const bf16x8*>(kp + 64); s2 = *reinterpret_cast<const bf16x8*>(kp + 128); } while (0)
#define SWRITE(b) do { *(bf16x8*)(Kn_l + (b) * KN_B + kst0) = s0; *(bf16x8*)(Kn_l + (b) * KN_B + kst1) = s1; *(bf16x8*)(Kr_l + (b) * KR_B + rst) = s2; } while (0)
#define RESC(a) do { if (__any((a) < 1.f)) { if (hi == 0) al_l[r32] = (a); asm volatile("s_waitcnt lgkmcnt(0)" ::: "memory"); \
        _Pragma("unroll") for (int d = 0; d < 4; ++d) _Pragma("unroll") for (int r = 0; r < 16; ++r) o[d][r] *= al_l[crow(r, hi)]; } } while (0)
    f32x16 pA0, pA1, pB0, pB1; float alA, alB; bf16x8 pa0, pa1, pa2, pa3;
    constexpr int NTL = 65;
    SLOAD(64); asm volatile("s_waitcnt vmcnt(0)" ::: "memory"); SWRITE(0); __syncthreads();
    qkt(pA0, pA1, Kn_l, Kr_l, qr, qrl, r32, hi);
#pragma unroll
    for (int r = 8; r < 16; ++r) pA0[r] = -1e30f;
#pragma unroll
    for (int r = 0; r < 16; ++r) pA1[r] = -1e30f;
    partialSM(pA0, pA1, m_reg, alA);
    SLOAD(0); asm volatile("s_waitcnt vmcnt(0)" ::: "memory"); SWRITE(1); __syncthreads();
#pragma unroll 1
    for (int j = 1; j + 1 < NTL; j += 2) {
        SBAR(); qkt(pB0, pB1, Kn_l + KN_B, Kr_l + KR_B, qr, qrl, r32, hi);
        finishSM(pA0, pA1, alA, l_reg, pa0, pa1, pa2, pa3); SBAR();
        SLOAD(j); SBAR();
        pv_d0(o, bt0, bt1, pa0, pa1, pa2, pa3); partialSM(pB0, pB1, m_reg, alB);
        __syncthreads(); asm volatile("s_waitcnt vmcnt(0)" ::: "memory"); SWRITE(0);
        RESC(alB); __syncthreads();
        SBAR(); qkt(pA0, pA1, Kn_l, Kr_l, qr, qrl, r32, hi);
        finishSM(pB0, pB1, alB, l_reg, pa0, pa1, pa2, pa3); SBAR();
        if (j + 2 < NTL) SLOAD(j + 1); SBAR();
        pv_d0(o, bt0 + KN_B, bt1 + KN_B, pa0, pa1, pa2, pa3); partialSM(pA0, pA1, m_reg, alA);
        __syncthreads(); asm volatile("s_waitcnt vmcnt(0)" ::: "memory"); if (j + 2 < NTL) SWRITE(1);
        RESC(alA); __syncthreads();
    }
    finishSM(pA0, pA1, alA, l_reg, pa0, pa1, pa2, pa3); SBAR();
    pv_d0(o, bt0, bt1, pa0, pa1, pa2, pa3);
    if (hi == 0) li_l[r32] = l_reg; asm volatile("s_waitcnt lgkmcnt(0)" ::: "memory");
    float rli[16];
#pragma unroll
    for (int r = 0; r < 16; ++r) rli[r] = __builtin_amdgcn_rcpf(li_l[crow(r, hi)]);
    unsigned char* Ow = (unsigned char*)Ob + (size_t)(wid * 32) * 1024;
#pragma unroll
    for (int r = 0; r < 16; ++r) { const int orow = crow(r, hi);
#pragma unroll
        for (int d0 = 0; d0 < 4; ++d0) { const float ov = o[d0][r] * rli[r]; Ow[(size_t)orow * 1024 + d0 * 32 + r32] = (unsigned char)(__builtin_amdgcn_cvt_pk_fp8_f32(ov, ov, 0, false) & 0xff); } }
    __syncthreads();
#undef SLOAD
#undef SWRITE
#undef RESC
}
#undef KSWZ
#undef RSWZ
#undef SBAR
}

__device__ __forceinline__ void phase_attn(const Params& p, char* lds, int vcu, int G) {
    for (int u = vcu; u < NB * 8 * 16; u += G) {
        const int b = u >> 7, h = (u >> 4) & 7, qb = u & 15;
        const size_t r0 = (size_t)b * SEQ + qb * 256;
        att::attn_unit(p.QP() + r0 * 1536 + h * 192, p.Kc() + (size_t)b * KVROWS * 192, (bf16_t*)((unsigned char*)p.OA() + r0 * 1024 + h * 128), lds);
    }
}

namespace ml {
using att::s16x4; using att::f32x16; using att::crow; using att::cvtpk; using att::v_st; using att::v_rd_base; using att::tr_read; using att::v_rd_off;
#define RSWZ(row, colB) ((row) * 128 + ((colB) ^ ((((row) >> 1) & 7) << 4)))
#define SBAR() __builtin_amdgcn_sched_barrier(0)
__device__ __forceinline__ void pv_blk(f32x16& od, int vb, bf16x8 pa0, bf16x8 pa1, bf16x8 pa2, bf16x8 pa3) {
    const s16x4 l0 = tr_read<v_rd_off(0, 0, 0)>(vb), h0 = tr_read<v_rd_off(0, 0, 1)>(vb), l1 = tr_read<v_rd_off(0, 1, 0)>(vb), h1 = tr_read<v_rd_off(0, 1, 1)>(vb);
    const s16x4 l2 = tr_read<v_rd_off(0, 2, 0)>(vb), h2 = tr_read<v_rd_off(0, 2, 1)>(vb), l3 = tr_read<v_rd_off(0, 3, 0)>(vb), h3 = tr_read<v_rd_off(0, 3, 1)>(vb);
    asm volatile("s_waitcnt lgkmcnt(0)" ::: "memory"); SBAR();
#define PK(L, H) (bf16x8){L[0], L[1], L[2], L[3], H[0], H[1], H[2], H[3]}
    od = __builtin_amdgcn_mfma_f32_32x32x16_bf16(pa0, PK(l0, h0), od, 0, 0, 0);
    od = __builtin_amdgcn_mfma_f32_32x32x16_bf16(pa1, PK(l1, h1), od, 0, 0, 0);
    od = __builtin_amdgcn_mfma_f32_32x32x16_bf16(pa2, PK(l2, h2), od, 0, 0, 0);
    od = __builtin_amdgcn_mfma_f32_32x32x16_bf16(pa3, PK(l3, h3), od, 0, 0, 0);
}
template <int KS0> __device__ __forceinline__ void pv_blk2(f32x16& od, int vb, bf16x8 pa, bf16x8 pb) {
    const s16x4 l0 = tr_read<v_rd_off(0, KS0, 0)>(vb), h0 = tr_read<v_rd_off(0, KS0, 1)>(vb), l1 = tr_read<v_rd_off(0, KS0 + 1, 0)>(vb), h1 = tr_read<v_rd_off(0, KS0 + 1, 1)>(vb);
    asm volatile("s_waitcnt lgkmcnt(0)" ::: "memory"); SBAR();
    od = __builtin_amdgcn_mfma_f32_32x32x16_bf16(pa, PK(l0, h0), od, 0, 0, 0);
    od = __builtin_amdgcn_mfma_f32_32x32x16_bf16(pb, PK(l1, h1), od, 0, 0, 0);
}
__device__ __forceinline__ void tt_blk(f32x16& od, int va, int vb) {
    const s16x4 al0 = tr_read<v_rd_off(0, 0, 0)>(va), ah0 = tr_read<v_rd_off(0, 0, 1)>(va), al1 = tr_read<v_rd_off(0, 1, 0)>(va), ah1 = tr_read<v_rd_off(0, 1, 1)>(va);
    const s16x4 al2 = tr_read<v_rd_off(0, 2, 0)>(va), ah2 = tr_read<v_rd_off(0, 2, 1)>(va), al3 = tr_read<v_rd_off(0, 3, 0)>(va), ah3 = tr_read<v_rd_off(0, 3, 1)>(va);
    const s16x4 l0 = tr_read<v_rd_off(0, 0, 0)>(vb), h0 = tr_read<v_rd_off(0, 0, 1)>(vb), l1 = tr_read<v_rd_off(0, 1, 0)>(vb), h1 = tr_read<v_rd_off(0, 1, 1)>(vb);
    const s16x4 l2 = tr_read<v_rd_off(0, 2, 0)>(vb), h2 = tr_read<v_rd_off(0, 2, 1)>(vb), l3 = tr_read<v_rd_off(0, 3, 0)>(vb), h3 = tr_read<v_rd_off(0, 3, 1)>(vb);
    asm volatile("s_waitcnt lgkmcnt(0)" ::: "memory"); SBAR();
    od = __builtin_amdgcn_mfma_f32_32x32x16_bf16(PK(al0, ah0), PK(l0, h0), od, 0, 0, 0);
    od = __builtin_amdgcn_mfma_f32_32x32x16_bf16(PK(al1, ah1), PK(l1, h1), od, 0, 0, 0);
    od = __builtin_amdgcn_mfma_f32_32x32x16_bf16(PK(al2, ah2), PK(l2, h2), od, 0, 0, 0);
    od = __builtin_amdgcn_mfma_f32_32x32x16_bf16(PK(al3, ah3), PK(l3, h3), od, 0, 0, 0);
#undef PK
}
#define PK4(P, BASE, OUT) do { unsigned a0 = cvtpk(P[BASE + 0], P[BASE + 1]), a1 = cvtpk(P[BASE + 2], P[BASE + 3]);   \
    unsigned b0 = cvtpk(P[BASE + 4], P[BASE + 5]), b1 = cvtpk(P[BASE + 6], P[BASE + 7]);                              \
    auto r0 = __builtin_amdgcn_permlane32_swap(a0, b0, false, false); auto r1 = __builtin_amdgcn_permlane32_swap(a1, b1, false, false); \
    u32x4 w = {r0[0], r1[0], r0[1], r1[1]}; OUT = *reinterpret_cast<bf16x8*>(&w); } while (0)
__device__ __forceinline__ float half_swap_add(float v) { auto rr = __builtin_amdgcn_permlane32_swap(__float_as_uint(v), __float_as_uint(v), false, false); return __uint_as_float(rr[0]) + __uint_as_float(rr[1]); }
__device__ __forceinline__ bf16x8 scale8(bf16x8 v, float s) {
    const u32x4 w = *reinterpret_cast<const u32x4*>(&v); u32x4 o;
    o.x = cvtpk(__uint_as_float(w.x << 16) * s, __uint_as_float(w.x & 0xffff0000u) * s); o.y = cvtpk(__uint_as_float(w.y << 16) * s, __uint_as_float(w.y & 0xffff0000u) * s);
    o.z = cvtpk(__uint_as_float(w.z << 16) * s, __uint_as_float(w.z & 0xffff0000u) * s); o.w = cvtpk(__uint_as_float(w.w << 16) * s, __uint_as_float(w.w & 0xffff0000u) * s);
    return *reinterpret_cast<bf16x8*>(&o);
}
__device__ __forceinline__ bf16x8 f8_to_bf(const float* p, bool ok) {
    if (!ok) return (bf16x8){0, 0, 0, 0, 0, 0, 0, 0};
    const f32x4 a = *(const f32x4*)p, b = *(const f32x4*)(p + 4); u32x4 o = {cvtpk(a[0], a[1]), cvtpk(a[2], a[3]), cvtpk(b[0], b[1]), cvtpk(b[2], b[3])};
    return *reinterpret_cast<bf16x8*>(&o);
}
template <int K> __device__ __forceinline__ float dpp_shr(float v, float ident) {
    return __int_as_float(__builtin_amdgcn_update_dpp(__float_as_int(ident), __float_as_int(v), 0x110 | K, 0xf, 0xf, false));
}
__device__ __forceinline__ float rdlane(float v, int l) { return __int_as_float(__builtin_amdgcn_readlane(__float_as_int(v), l)); }
__device__ __forceinline__ float wave_incl_sum(float v, int lane) {
    v += dpp_shr<1>(v, 0.f); v += dpp_shr<2>(v, 0.f); v += dpp_shr<4>(v, 0.f); v += dpp_shr<8>(v, 0.f);
    const float s0 = rdlane(v, 15), s1 = rdlane(v, 31), s2 = rdlane(v, 47); const int row = lane >> 4;
    return v + (row >= 1 ? s0 : 0.f) + (row >= 2 ? s1 : 0.f) + (row >= 3 ? s2 : 0.f);
}
__device__ __forceinline__ float wave_incl_max(float v, int lane) {
    const float NI = -3.0e38f;
    v = fmaxf(v, dpp_shr<1>(v, NI)); v = fmaxf(v, dpp_shr<2>(v, NI)); v = fmaxf(v, dpp_shr<4>(v, NI)); v = fmaxf(v, dpp_shr<8>(v, NI));
    const float s0 = rdlane(v, 15), s1 = rdlane(v, 31), s2 = rdlane(v, 47); const int row = lane >> 4;
    return fmaxf(fmaxf(v, row >= 1 ? s0 : NI), fmaxf(row >= 2 ? s1 : NI, row >= 3 ? s2 : NI));
}
__device__ __forceinline__ float wave_max(float v) {
    const float NI = -3.0e38f;
    v = fmaxf(v, dpp_shr<1>(v, NI)); v = fmaxf(v, dpp_shr<2>(v, NI)); v = fmaxf(v, dpp_shr<4>(v, NI)); v = fmaxf(v, dpp_shr<8>(v, NI));
    return fmaxf(fmaxf(rdlane(v, 15), rdlane(v, 31)), fmaxf(rdlane(v, 47), rdlane(v, 63)));
}

constexpr int SC_BUF = 32768;
__device__ __forceinline__ void scan_unit(const Params& p, int b, int h, int dir, char* lds) {
    const int tid = threadIdx.x, wid = tid >> 6, lane = tid & 63, r32 = lane & 31, hi = lane >> 5, db = wid & 1, vq = wid >> 1;
    const int sr = tid >> 3, sc8 = tid & 7;
    const int kst = v_st(sr, sc8 * 8), vst0 = v_st(sr, sc8 * 8), vst1 = v_st(sr, 64 + sc8 * 8);
    const int va0 = (int)(uintptr_t)lds + v_rd_base(lane) + db * 512, vb0 = (int)(uintptr_t)lds + 16384 + v_rd_base(lane) + vq * 512;
    bf16_t* CS = dir ? p.CB() : p.CF(); float* NS = dir ? p.NB_() : p.NF(); float* MS = dir ? p.MB() : p.MF();
    const size_t sbase = (size_t)(b * 8 + h) * 64;
    f32x16 acc = {}; float nacc = 0.f, m = 0.f, decay_prev = 1.f;
    const int nsteps = dir ? 64 : 65;
    bf16x8 sk, sv0, sv1; float gli, glf;
#define ML_LOAD(st) do { const int c_ = dir ? 63 - (st) : (st) - 1; \
        if (c_ < 0) { const float* z = p.ZM() + (size_t)(sr & 15) * DIN; const bool okr = sr < NMETA; \
            sk = f8_to_bf(z + OFF_K + h * 64 + sc8 * 8, okr); sv0 = f8_to_bf(z + OFF_V + h * 128 + sc8 * 8, okr); sv1 = f8_to_bf(z + OFF_V + h * 128 + 64 + sc8 * 8, okr); \
            const float* zl = p.ZM() + (size_t)(lane & 15) * DIN; gli = lane < NMETA ? zl[OFF_I + h] + p.m_b_i[h] : -1e30f; glf = lane < NMETA ? logsigmoidf_(zl[OFF_F + h] + p.m_b_f[h]) : 0.f; } \
        else { const size_t r_ = (size_t)b * SEQ + c_ * 64 + sr; sk = *reinterpret_cast<const bf16x8*>(p.Km() + r_ * 512 + h * 64 + sc8 * 8); \
            sv0 = *reinterpret_cast<const bf16x8*>(p.Vm() + r_ * 1024 + h * 128 + sc8 * 8); sv1 = *reinterpret_cast<const bf16x8*>(p.Vm() + r_ * 1024 + h * 128 + 64 + sc8 * 8); \
            const size_t rg = (size_t)b * SEQ + c_ * 64 + (dir ? 63 - lane : lane); gli = p.GI()[rg * 16 + dir * 8 + h]; glf = p.GF()[rg * 16 + dir * 8 + h]; } } while (0)
#define ML_GATES(decay_, mnew_, wk_) do { const float bc_ = wave_incl_sum(glf, lane); const float bl_ = rdlane(bc_, 63); const float g_ = bl_ - bc_ + gli; \
        mnew_ = fmaxf(bl_ + m, wave_max(g_)); decay_ = __expf(bl_ + m - mnew_); wk_ = __expf(g_ - mnew_); } while (0)
    ML_LOAD(0);
    float decay, mnew, wk;
    { asm volatile("s_waitcnt vmcnt(0)" ::: "memory"); ML_GATES(decay, mnew, wk);
      const float w = __shfl(wk, dir ? 63 - sr : sr);
      *(bf16x8*)(lds + kst) = sk; *(bf16x8*)(lds + 16384 + vst0) = scale8(sv0, w); *(bf16x8*)(lds + 16384 + vst1) = scale8(sv1, w); }
    __syncthreads();
#pragma unroll 1
    for (int st = 0; st < nsteps; ++st) {
        const int c = dir ? 63 - st : st - 1, buf = st & 1;
        if (wid == 0 && st > 0) { float s_ = 0.f; const float* np_ = (const float*)(lds + 65536) + ((st - 1) & 1) * 512;
#pragma unroll
            for (int w8 = 0; w8 < 8; ++w8) s_ += np_[w8 * 64 + lane];
            nacc = nacc * decay_prev + s_; }
        unsigned spk[8];
#pragma unroll
        for (int r = 0; r < 8; ++r) spk[r] = (unsigned)f2bf(acc[2 * r]) | ((unsigned)f2bf(acc[2 * r + 1]) << 16);
        const float ns_v = nacc, ms_v = m;
#define ML_STORE() do { if (c >= 0) { const size_t sidx = sbase + c; bf16_t* cd = CS + sidx * 8192 + (size_t)(db * 32) * 128 + vq * 32 + r32; \
            _Pragma("unroll") for (int r = 0; r < 8; ++r) { cd[(size_t)crow(2 * r, hi) * 128] = (bf16_t)(spk[r] & 0xffffu); cd[(size_t)crow(2 * r + 1, hi) * 128] = (bf16_t)(spk[r] >> 16); } \
            if (wid == 0) NS[sidx * 64 + lane] = ns_v; if (tid == 0) MS[sidx] = ms_v; } } while (0)
        if (st == nsteps - 1) { ML_STORE(); break; }
        if (st + 1 < nsteps - 1) ML_LOAD(st + 1);
#pragma unroll
        for (int r = 0; r < 16; ++r) acc[r] *= decay;
        tt_blk(acc, va0 + buf * SC_BUF, vb0 + buf * SC_BUF);
        {
            float s_ = 0.f;
#pragma unroll
            for (int q = 0; q < 8; ++q) { const int s = wid * 8 + q; const float w = __shfl(wk, dir ? 63 - s : s); s_ += w * bf2f(*(const bf16_t*)(lds + buf * SC_BUF + v_st(s, lane))); }
            ((float*)(lds + 65536))[(st & 1) * 512 + wid * 64 + lane] = s_;
        }
        decay_prev = decay;
        m = mnew;
        if (st + 1 < nsteps - 1) {
            asm volatile("s_waitcnt vmcnt(0)" ::: "memory"); ML_GATES(decay, mnew, wk);
            const float w = __shfl(wk, dir ? 63 - sr : sr); char* lb = lds + (buf ^ 1) * SC_BUF;
            *(bf16x8*)(lb + kst) = sk; *(bf16x8*)(lb + 16384 + vst0) = scale8(sv0, w); *(bf16x8*)(lb + 16384 + vst1) = scale8(sv1, w);
        }
        ML_STORE();
        __syncthreads();
    }
    __syncthreads();
#undef ML_LOAD
#undef ML_STORE
#undef ML_GATES
}

constexpr int O_K = 0, O_V = 8192, O_CF = 24576, O_CB = 40960, O_T = 57344, O_ARR = 122880, O_WS = 125440, O_END = 127488;
struct OutPre { bf16x8 kk, v0, v1, f0, f1, b0, b1, q0, q1, q2, q3; float li, lf, mm, nn; };
__device__ __forceinline__ void out_load(const Params& p, int u, OutPre& R) {
    const int tid = threadIdx.x, wid = tid >> 6, lane = tid & 63, r32 = lane & 31, hi = lane >> 5, tb = wid & 1;
    const int b = u >> 9, h = u & 7, c = (u >> 3) & 63; const size_t r0 = (size_t)b * SEQ + c * 64, sidx = (size_t)(b * 8 + h) * 64 + c;
    const int sr = tid >> 3, sc8 = tid & 7;
    R.kk = *reinterpret_cast<const bf16x8*>(p.Km() + (r0 + sr) * 512 + h * 64 + sc8 * 8);
    const bf16_t* vp = p.Vm() + (r0 + sr) * 1024 + h * 128 + sc8 * 8; R.v0 = *reinterpret_cast<const bf16x8*>(vp); R.v1 = *reinterpret_cast<const bf16x8*>(vp + 64);
    const bf16_t* cf = p.CF() + sidx * 8192 + (size_t)sr * 128 + sc8 * 8; R.f0 = *reinterpret_cast<const bf16x8*>(cf); R.f1 = *reinterpret_cast<const bf16x8*>(cf + 64);
    const bf16_t* cb = p.CB() + sidx * 8192 + (size_t)sr * 128 + sc8 * 8; R.b0 = *reinterpret_cast<const bf16x8*>(cb); R.b1 = *reinterpret_cast<const bf16x8*>(cb + 64);
    const bf16_t* qp = p.Qm() + (r0 + tb * 32 + r32) * 512 + h * 64 + hi * 8;
    R.q0 = *reinterpret_cast<const bf16x8*>(qp); R.q1 = *reinterpret_cast<const bf16x8*>(qp + 16); R.q2 = *reinterpret_cast<const bf16x8*>(qp + 32); R.q3 = *reinterpret_cast<const bf16x8*>(qp + 48);
    R.li = 0.f; R.lf = 0.f; R.mm = 0.f; R.nn = 0.f;
    if (wid < 2) { const int dir = wid, t = dir ? 63 - lane : lane; R.li = p.GI()[(r0 + t) * 16 + dir * 8 + h]; R.lf = p.GF()[(r0 + t) * 16 + dir * 8 + h]; R.mm = (dir ? p.MB() : p.MF())[sidx]; }
    else if (wid < 4) { const int dir = wid - 2; R.nn = (dir ? p.NB_() : p.NF())[sidx * 64 + lane]; }
}
__device__ __forceinline__ void phase_mlstm_out_body(const Params& p, char* lds, int vcu, int G) {
    const int tid = threadIdx.x, wid = tid >> 6, lane = tid & 63, r32 = lane & 31, hi = lane >> 5, tb = wid & 1, vq = wid >> 1;
    const int sr = tid >> 3, sc8 = tid & 7;
    float* arr = (float*)(lds + O_ARR);
    float* nbuf = arr + 512;
    float* wsc = (float*)(lds + O_WS) + wid * 64;
    const int NU = NB * 8 * 64;
    OutPre R;
    if (vcu < NU) out_load(p, vcu, R);
#pragma unroll 1
    for (int u = vcu; u < NU; u += G) {
        const int b = u >> 9, h = u & 7, c = (u >> 3) & 63; const size_t r0 = (size_t)b * SEQ + c * 64;
        { *(bf16x8*)(lds + O_K + RSWZ(sr, sc8 * 16)) = R.kk;
          const int s0 = v_st(sr, sc8 * 8), s1 = v_st(sr, 64 + sc8 * 8);
          *(bf16x8*)(lds + O_V + s0) = R.v0; *(bf16x8*)(lds + O_V + s1) = R.v1; *(bf16x8*)(lds + O_CF + s0) = R.f0; *(bf16x8*)(lds + O_CF + s1) = R.f1; *(bf16x8*)(lds + O_CB + s0) = R.b0; *(bf16x8*)(lds + O_CB + s1) = R.b1; }
        if (wid < 2) {
            const int dir = wid, t = dir ? 63 - lane : lane; const float m = R.mm;
            const float bc = wave_incl_sum(R.lf, lane), a = R.li - bc, pm = wave_incl_max(a, lane), mx = fmaxf(m, pm);
            float* ar = arr + dir * 256;
            ar[t] = -mx * 1.4426950408889634f; ar[64 + t] = a * 1.4426950408889634f; ar[128 + t] = __expf(m - mx); ar[192 + t] = __expf(-(bc + mx));
        } else if (wid < 4) nbuf[(wid - 2) * 64 + lane] = R.nn;
        bf16x8 qr[4] = {R.q0, R.q1, R.q2, R.q3};
        __syncthreads();
        if (u + G < NU) out_load(p, u + G, R);
        const int ocol = h * 128 + sc8 * 16; const size_t oo = (r0 + sr) * 1024 + ocol;
        const u32x4 og = *(const u32x4*)((const unsigned char*)p.OG() + oo);
        const f32x4 n0 = *(const f32x4*)(p.m_norm + ocol), n1 = *(const f32x4*)(p.m_norm + ocol + 4), n2 = *(const f32x4*)(p.m_norm + ocol + 8), n3 = *(const f32x4*)(p.m_norm + ocol + 12);
        const int dir = (wid >> 1) & 1, vh = wid >> 2;
        float qn;
        { const float* nv = nbuf + dir * 64 + hi * 8; float s_ = 0.f;
#pragma unroll
          for (int d0 = 0; d0 < 4; ++d0) { const u32x4 w = *reinterpret_cast<const u32x4*>(&qr[d0]); const f32x4 n0 = *(const f32x4*)(nv + d0 * 16), n1 = *(const f32x4*)(nv + d0 * 16 + 4);
              s_ += __uint_as_float(w.x << 16) * n0[0] + __uint_as_float(w.x & 0xffff0000u) * n0[1] + __uint_as_float(w.y << 16) * n0[2] + __uint_as_float(w.y & 0xffff0000u) * n0[3]
                  + __uint_as_float(w.z << 16) * n1[0] + __uint_as_float(w.z & 0xffff0000u) * n1[1] + __uint_as_float(w.w << 16) * n1[2] + __uint_as_float(w.w & 0xffff0000u) * n1[3]; }
          qn = half_swap_add(s_); }
        f32x16 p0 = {}, p1 = {};
        const bool has0 = !(dir == 1 && tb == 1), has1 = !(dir == 0 && tb == 0);
#pragma unroll
        for (int d0 = 0; d0 < 4; ++d0) { const int cb = (d0 * 16 + hi * 8) * 2;
            if (has0) { const bf16x8 k0 = *reinterpret_cast<const bf16x8*>(lds + O_K + RSWZ(r32, cb)); p0 = __builtin_amdgcn_mfma_f32_32x32x16_bf16(k0, qr[d0], p0, 0, 0, 0); }
            if (has1) { const bf16x8 k1 = *reinterpret_cast<const bf16x8*>(lds + O_K + RSWZ(32 + r32, cb)); p1 = __builtin_amdgcn_mfma_f32_32x32x16_bf16(k1, qr[d0], p1, 0, 0, 0); } }
        const int t = tb * 32 + r32;
        const int vbase = (int)(uintptr_t)lds + v_rd_base(lane) + vh * 1024;
#define W_FULL(P, W, SB) _Pragma("unroll") for (int g = 0; g < 4; ++g) { const f32x4 ct = *(const f32x4*)(ar + 64 + (SB) + 8 * g + 4 * hi); \
            _Pragma("unroll") for (int q = 0; q < 4; ++q) { const float x = __builtin_amdgcn_exp2f(rt + ct[q]) * P[4 * g + q]; W[4 * g + q] = x; rs += x; } }
#define W_DIAG(P, W, SB) _Pragma("unroll") for (int g = 0; g < 4; ++g) { const f32x4 ct = *(const f32x4*)(ar + 64 + (SB) + 8 * g + 4 * hi); \
            _Pragma("unroll") for (int q = 0; q < 4; ++q) { const int sl = 8 * g + 4 * hi + q; const bool ok = dir ? (sl >= r32) : (sl <= r32); \
                const float x = ok ? __builtin_amdgcn_exp2f(rt + ct[q]) * P[4 * g + q] : 0.f; W[4 * g + q] = x; rs += x; } }
        {
            const float* ar = arr + dir * 256; const float rt = ar[t], sint = ar[128 + t], efl = ar[192 + t];
            f32x16 w0, w1; float rs = 0.f;
            if (tb == 0) { W_DIAG(p0, w0, 0) if (dir == 1) { W_FULL(p1, w1, 32) } }
            else         { W_DIAG(p1, w1, 32) if (dir == 0) { W_FULL(p0, w0, 0) } }
            rs = half_swap_add(rs);
            bf16x8 pa0, pa1, pa2, pa3;
            if (has0) { PK4(w0, 0, pa0); PK4(w0, 8, pa1); }
            if (has1) { PK4(w1, 0, pa2); PK4(w1, 8, pa3); }
            const float den = rs + sint * qn, inv = 1.f / fmaxf(fabsf(den), efl);
            if (hi == 0) { wsc[r32] = sint; wsc[32 + r32] = inv; }
            f32x16 o0 = {}, o1 = {};
            pv_blk(o0, vbase + (dir ? O_CB : O_CF), qr[0], qr[1], qr[2], qr[3]);
            pv_blk(o1, vbase + (dir ? O_CB : O_CF) + 512, qr[0], qr[1], qr[2], qr[3]);
            asm volatile("s_waitcnt lgkmcnt(0)" ::: "memory");
#pragma unroll
            for (int g = 0; g < 4; ++g) { const f32x4 sc = *(const f32x4*)(wsc + 8 * g + 4 * hi);
#pragma unroll
                for (int q = 0; q < 4; ++q) { o0[4 * g + q] *= sc[q]; o1[4 * g + q] *= sc[q]; } }
            if (has0) { pv_blk2<0>(o0, vbase + O_V, pa0, pa1); pv_blk2<0>(o1, vbase + O_V + 512, pa0, pa1); }
            if (has1) { pv_blk2<2>(o0, vbase + O_V, pa2, pa3); pv_blk2<2>(o1, vbase + O_V + 512, pa2, pa3); }
            float* T = (float*)(lds + O_T + dir * 32768) + (size_t)(tb * 32) * 128 + vh * 64 + r32;
#pragma unroll
            for (int g = 0; g < 4; ++g) { const f32x4 sc = *(const f32x4*)(wsc + 32 + 8 * g + 4 * hi);
#pragma unroll
                for (int q = 0; q < 4; ++q) { const int rw = 8 * g + 4 * hi + q; T[rw * 128] = o0[4 * g + q] * sc[q]; T[rw * 128 + 32] = o1[4 * g + q] * sc[q]; } }
        }
#undef W_FULL
#undef W_DIAG
        __syncthreads();
        { const float* T = (const float*)(lds + O_T) + sr * 128 + sc8 * 16; f32x4 v[4]; float ss = 0.f;
#pragma unroll
          for (int q = 0; q < 4; ++q) { v[q] = *(const f32x4*)(T + q * 4) + *(const f32x4*)(T + 8192 + q * 4); ss += v[q][0] * v[q][0] + v[q][1] * v[q][1] + v[q][2] * v[q][2] + v[q][3] * v[q][3]; }
          ss += __shfl_xor(ss, 1); ss += __shfl_xor(ss, 2); ss += __shfl_xor(ss, 4);
          const float rstd = rsqrtf(ss * (1.f / 128.f) + EPS);
          const f32x4 g0 = up4_u8(og.x), g1 = up4_u8(og.y), g2 = up4_u8(og.z), g3 = up4_u8(og.w);
          const f32x4 h0 = v[0] * rstd * n0 * g0, h1 = v[1] * rstd * n1 * g1, h2 = v[2] * rstd * n2 * g2, h3 = v[3] * rstd * n3 * g3;
          u32x4 o8; o8.x = pk4_fp8(h0[0], h0[1], h0[2], h0[3]); o8.y = pk4_fp8(h1[0], h1[1], h1[2], h1[3]); o8.z = pk4_fp8(h2[0], h2[1], h2[2], h2[3]); o8.w = pk4_fp8(h3[0], h3[1], h3[2], h3[3]);
          *(u32x4*)((unsigned char*)p.HM() + oo) = o8; }
    }
    __syncthreads();
}
#undef PK4
#undef RSWZ
#undef SBAR
}

__device__ __forceinline__ void phase_mlstm_scan(const Params& p, char* lds, int vcu, int G) {
    for (int u = vcu; u < NB * 8 * 2; u += G) ml::scan_unit(p, u >> 4, (u >> 1) & 7, u & 1, lds);
}
__device__ __forceinline__ void phase_mlstm_out(const Params& p, char* lds, int vcu, int G) {
    ml::phase_mlstm_out_body(p, lds, vcu, G);
}

#define RS_STEP(IN, OUT, N, BIT, MASK) _Pragma("unroll") for (int i_ = 0; i_ < (N); ++i_) { const float keep_ = (BIT) ? IN[(N) + i_] : IN[i_], send_ = (BIT) ? IN[i_] : IN[(N) + i_]; OUT[i_] = keep_ + __shfl_xor(send_, (MASK)); }
__device__ __forceinline__ float route_reduce(const float (&v)[32], int lane) {
    const int b5 = (lane >> 5) & 1, b4 = (lane >> 4) & 1, b3 = (lane >> 3) & 1, b2 = (lane >> 2) & 1, b1 = (lane >> 1) & 1;
    float a16[16], a8[8], a4[4], a2[2], a1[1];
    RS_STEP(v, a16, 16, b5, 32) RS_STEP(a16, a8, 8, b4, 16) RS_STEP(a8, a4, 4, b3, 8) RS_STEP(a4, a2, 2, b2, 4) RS_STEP(a2, a1, 1, b1, 2)
    return a1[0] + __shfl_xor(a1[0], 1);
}
__device__ __forceinline__ int route_rank(float val, int myexp) {
    int cnt = 0;
#pragma unroll
    for (int e = 0; e < 32; ++e) { const float ve = __int_as_float(__builtin_amdgcn_readlane(__float_as_int(val), 2 * e)); cnt += (ve > val || (ve == val && e < myexp)) ? 1 : 0; }
    return cnt;
}
__device__ __forceinline__ void phase_route(const Params& p, char* lds, int vcu, int G) {
    constexpr int XST = 1028;
    float* xs = (float*)lds;
    float* part = (float*)(lds + 65792);
    unsigned short* ent = (unsigned short*)(lds + 84224);
    int* lcount = (int*)(lds + 88320); int* lbase = lcount + 32;
    float* rec = (float*)(lds + 88576);
    const int tid = threadIdx.x, lane = tid & 63, w = tid >> 6, q4 = lane >> 4, l15 = lane & 15;
    __syncthreads();
    if (tid < 32) lcount[tid] = 0;
    float breg0[32], breg1[32];
#pragma unroll
    for (int i = 0; i < 32; ++i) { const float* wr = p.w_router + (size_t)(128 * w + 4 * i + q4) * NEXP + l15; breg0[i] = wr[0]; breg1[i] = wr[16]; }
    const int te = lane & 31, tsel = lane >> 5;
    const float mybias = p.b_router[te];
    int nloc = 0;
    float4 pa_[4], pb_[4];
    if (vcu * 16 < NT) {
#pragma unroll
        for (int j = 0; j < 4; ++j) { pa_[j] = ntld_h1(p.H1() + (size_t)(vcu * 16 + w * 2) * DM + (j * 64 + lane) * 4); pb_[j] = ntld_h1(p.H1() + (size_t)(vcu * 16 + w * 2 + 1) * DM + (j * 64 + lane) * 4); } }
#pragma unroll 1
    for (int base = vcu * 16; base < NT; base += G * 16, nloc += 16) {
        const int row0 = base + w * 2;
        float4 xa[4], xb[4]; float sa = 0.f, sb = 0.f;
#pragma unroll
        for (int j = 0; j < 4; ++j) { xa[j] = pa_[j]; xb[j] = pb_[j]; }
        { const int nb_ = base + G * 16; if (nb_ < NT) {
#pragma unroll
            for (int j = 0; j < 4; ++j) { pa_[j] = ntld_h1(p.H1() + (size_t)(nb_ + w * 2) * DM + (j * 64 + lane) * 4); pb_[j] = ntld_h1(p.H1() + (size_t)(nb_ + w * 2 + 1) * DM + (j * 64 + lane) * 4); } } }
#pragma unroll
        for (int j = 0; j < 4; ++j) { sa += xa[j].x * xa[j].x + xa[j].y * xa[j].y + xa[j].z * xa[j].z + xa[j].w * xa[j].w; sb += xb[j].x * xb[j].x + xb[j].y * xb[j].y + xb[j].z * xb[j].z + xb[j].w * xb[j].w; }
        const float ra = rsqrtf(wave_sum(sa) * (1.f / DM) + EPS), rb = rsqrtf(wave_sum(sb) * (1.f / DM) + EPS);
#pragma unroll
        for (int j = 0; j < 4; ++j) { const int c = (j * 64 + lane) * 4; const float4 g = *(const float4*)(p.norm_ffn + c);
            xa[j] = make_float4(xa[j].x * ra * g.x, xa[j].y * ra * g.y, xa[j].z * ra * g.z, xa[j].w * ra * g.w);
            xb[j] = make_float4(xb[j].x * rb * g.x, xb[j].y * rb * g.y, xb[j].z * rb * g.z, xb[j].w * rb * g.w);
            *(float4*)&xs[(w * 2) * XST + c] = xa[j]; *(float4*)&xs[(w * 2 + 1) * XST + c] = xb[j];
            *(unsigned*)((unsigned char*)p.XN2() + (size_t)row0 * DM + c) = pk4_fp8(xa[j].x, xa[j].y, xa[j].z, xa[j].w);
            *(unsigned*)((unsigned char*)p.XN2() + (size_t)(row0 + 1) * DM + c) = pk4_fp8(xb[j].x, xb[j].y, xb[j].z, xb[j].w); }
        __syncthreads();
        f32x4 acc0 = {0.f, 0.f, 0.f, 0.f}, acc1 = {0.f, 0.f, 0.f, 0.f};
        const float* xp = xs + l15 * XST + 128 * w + q4;
#pragma unroll
        for (int i = 0; i < 32; ++i) { const float a = xp[4 * i];
            acc0 = __builtin_amdgcn_mfma_f32_16x16x4f32(a, breg0[i], acc0, 0, 0, 0); acc1 = __builtin_amdgcn_mfma_f32_16x16x4f32(a, breg1[i], acc1, 0, 0, 0); }
#pragma unroll
        for (int r = 0; r < 4; ++r) { part[(w * 16 + 4 * q4 + r) * 32 + l15] = acc0[r]; part[(w * 16 + 4 * q4 + r) * 32 + 16 + l15] = acc1[r]; }
        __syncthreads();
        float val = mybias;
#pragma unroll
        for (int w8 = 0; w8 < 8; ++w8) val += part[(w8 * 16 + 2 * w + tsel) * 32 + te];
        int cnt = 0;
#pragma unroll
        for (int e = 0; e < 32; ++e) { const float v0 = __int_as_float(__builtin_amdgcn_readlane(__float_as_int(val), e)), v1 = __int_as_float(__builtin_amdgcn_readlane(__float_as_int(val), 32 + e));
            const float ve = tsel ? v1 : v0; cnt += (ve > val || (ve == val && e < te)) ? 1 : 0; }
        float* rc = rec + w * 16 + tsel * 8;
        if (cnt < 4) { rc[cnt * 2] = __int_as_float(te); rc[cnt * 2 + 1] = val; }
        asm volatile("s_waitcnt lgkmcnt(0)" ::: "memory");
        if (te == 0) {
            const int row = row0 + tsel, tl = nloc + w * 2 + tsel; float ex[4], sum = 0.f; int tx[4];
#pragma unroll
            for (int kk = 0; kk < 4; ++kk) { tx[kk] = __float_as_int(rc[kk * 2]); ex[kk] = __expf(rc[kk * 2 + 1] - rc[1]); sum += ex[kk]; }
            const float inv = 1.f / sum;
#pragma unroll
            for (int kk = 0; kk < 4; ++kk) { const int e = tx[kk]; p.TOPI()[row * 4 + kk] = e; p.TOPW()[row * 4 + kk] = ex[kk] * inv;
                const int lr = atomicAdd(&lcount[e], 1); ent[tl * 4 + kk] = (unsigned short)(e | (lr << 5)); }
        }
        asm volatile("s_waitcnt lgkmcnt(0)" ::: "memory");
    }
    __syncthreads();
    if (tid < 32) lbase[tid] = atomicAdd(&p.CNT()[tid * CNT_STRIDE], lcount[tid]);
    __syncthreads();
    for (int idx = tid; idx < nloc * 4; idx += MK_THREADS) { const int tl = idx >> 2, row = vcu * 16 + (tl >> 4) * G * 16 + (tl & 15); const unsigned en = ent[idx];
        p.RANK()[row * 4 + (idx & 3)] = lbase[en & 31] + (int)(en >> 5); }
    __syncthreads();
}
#undef RS_STEP
__device__ __forceinline__ void phase_scatter(const Params& p, char* lds, int vcu, int G) {
    int* ps = (int*)lds;
    __syncthreads();
    if (threadIdx.x == 0) { int s = 0; for (int e = 0; e < NEXP; ++e) { ps[e] = s; s += (p.CNT()[e * CNT_STRIDE] + 255) / 256 * 256; } }
    __syncthreads();
    for (int gid = vcu * MK_THREADS + threadIdx.x; gid < NT * 4; gid += G * MK_THREADS) { const int slot = ps[p.TOPI()[gid]] + p.RANK()[gid]; p.SLOTS()[gid] = slot; p.SLOT_TOK()[slot] = gid >> 2; }
    __syncthreads();
}
__device__ __forceinline__ void phase_combine(const Params& p, int vcu, int G, float* dst) {
    const int lane = threadIdx.x & 63, gw = vcu * 8 + (threadIdx.x >> 6), NGW = G * 8;
    constexpr int RW = 4;
    for (int r = gw * RW; r < NT; r += NGW * RW) {
        int sl[RW * 4]; float tw[RW * 4];
#pragma unroll
        for (int q = 0; q < RW * 4; ++q) { sl[q] = p.SLOTS()[r * 4 + q]; tw[q] = p.TOPW()[r * 4 + q] * (1.f / YB_SCALE); }
        float4 v[RW * 4];
#pragma unroll
        for (int t = 0; t < RW; ++t)
#pragma unroll
            for (int j = 0; j < 4; ++j) v[t * 4 + j] = ntld_h1(p.H1() + (size_t)(r + t) * DM + (j * 64 + lane) * 4);
        unsigned y[RW * 4][4];
#pragma unroll
        for (int q = 0; q < RW * 4; ++q)
#pragma unroll
            for (int j = 0; j < 4; ++j) y[q][j] = __builtin_nontemporal_load((const unsigned*)((const unsigned char*)p.YB() + (size_t)sl[q] * DM + (j * 64 + lane) * 4));
#pragma unroll
        for (int q = 0; q < RW * 4; ++q) { const float w = tw[q]; const int o = (q >> 2) * 4;
#pragma unroll
            for (int j = 0; j < 4; ++j) { const f32x2 lo = __builtin_amdgcn_cvt_pk_f32_fp8((int)y[q][j], false), hi = __builtin_amdgcn_cvt_pk_f32_fp8((int)y[q][j], true);
                v[o + j].x += w * lo[0]; v[o + j].y += w * lo[1]; v[o + j].z += w * hi[0]; v[o + j].w += w * hi[1]; } }
        float rs[RW];
#pragma unroll
        for (int t = 0; t < RW; ++t) { float s = 0.f;
#pragma unroll
            for (int j = 0; j < 4; ++j) { const float4 a = v[t * 4 + j]; s += a.x * a.x + a.y * a.y + a.z * a.z + a.w * a.w; }
            rs[t] = rsqrtf(wave_sum(s) * (1.f / DM) + EPS); }
#pragma unroll
        for (int j = 0; j < 4; ++j) { const int c = (j * 64 + lane) * 4; const float4 g = *(const float4*)(p.norm_final + c);
#pragma unroll
            for (int t = 0; t < RW; ++t) { const float4 a = v[t * 4 + j]; const float ra = rs[t];
                *(float4*)(dst + (size_t)(r + t) * DM + c) = make_float4(a.x * ra * g.x, a.y * ra * g.y, a.z * ra * g.z, a.w * ra * g.w); } }
    }
}
__device__ __forceinline__ void phase_init_ctl(const Params& p, int vcu, int G) {
    if (vcu == 0) for (int i = threadIdx.x; i < NEXP * CNT_STRIDE; i += MK_THREADS) p.CNT()[i] = 0;
    for (int i = vcu * MK_THREADS + threadIdx.x; i < NSLOT; i += G * MK_THREADS) p.SLOT_TOK()[i] = -1;
}

#define XB_TMO      128
#define XB_XCNT(j)  (256  + 64 * (j))
#define XB_XSUB(j)  (1280 + 64 * (j))
#define XB_XGEN(j)  (2304 + 64 * (j))
#define XB_TOP      3328
#define XB_TOPGEN   3392
#define XCD_BAR_WORDS 3456
#define XB_SPIN_CAP (1u << 20)
__device__ __forceinline__ unsigned xb_ld(unsigned* p)              { return __hip_atomic_load(p, __ATOMIC_RELAXED, __HIP_MEMORY_SCOPE_AGENT); }
__device__ __forceinline__ unsigned xb_add(unsigned* p, unsigned v) { return __hip_atomic_fetch_add(p, v, __ATOMIC_RELAXED, __HIP_MEMORY_SCOPE_AGENT); }
__device__ __forceinline__ unsigned xb_xcc_id() { return (unsigned)__builtin_amdgcn_s_getreg((3 << 11) | 20) & 0xFu; }
#define XB_SPIN(cond, bar) do { unsigned _sp = 0; while (cond) { __builtin_amdgcn_s_sleep(1); \
    if ((++_sp & 255u) == 0u) { if (xb_ld(&(bar)[XB_TMO])) break; if (_sp > XB_SPIN_CAP) { atomicAdd(&(bar)[XB_TMO], 1u); break; } } } } while (0)
struct XcdBarrier { unsigned* bar; unsigned x; volatile LAS unsigned* st; };
__device__ __forceinline__ XcdBarrier xcd_barrier_post(unsigned* bar, volatile LAS unsigned* st) {
    XcdBarrier b; b.bar = bar; b.x = xb_xcc_id(); b.st = st;
    if (threadIdx.x == 0) (void)xb_add(&bar[XB_XCNT(b.x)], 1u);
    return b;
}
__device__ __forceinline__ void xcd_barrier_complete(unsigned* bar, unsigned x, unsigned& nloc, unsigned& nx) {
    const unsigned G = gridDim.x * gridDim.y * gridDim.z;
    unsigned sum, cnt, mine, sp = 0u;
    for (;;) {
        sum = 0u; cnt = 0u; mine = 0u;
#pragma unroll
        for (unsigned j = 0; j < 16; ++j) { const unsigned c = xb_ld(&bar[XB_XCNT(j)]); sum += c; cnt += (c > 0u) ? 1u : 0u; mine = (j == x) ? c : mine; }
        if (sum == G) break;
        __builtin_amdgcn_s_sleep(1);
        if ((++sp & 255u) == 0u) { if (xb_ld(&bar[XB_TMO])) break; if (sp > XB_SPIN_CAP) { atomicAdd(&bar[XB_TMO], 1u); break; } }
    }
    nloc = mine > 0u ? mine : 1u; nx = cnt > 0u ? cnt : 1u;
}
__device__ __forceinline__ void xcd_barrier(const XcdBarrier& b) {
    asm volatile("s_waitcnt vmcnt(0)" ::: "memory");
    __syncthreads();
    if (threadIdx.x == 0) {
        unsigned* bar = b.bar;
        __builtin_amdgcn_s_waitcnt(0);
        unsigned nloc = b.st[0], nx = b.st[1];
        if (nloc == 0u) { xcd_barrier_complete(bar, b.x, nloc, nx); b.st[0] = nloc; b.st[1] = nx; }
        const unsigned old = xb_add(&bar[XB_XSUB(b.x)], 1u);
        const unsigned gen = old / nloc;
        if (old + 1u == (gen + 1u) * nloc) {
            __builtin_amdgcn_fence(__ATOMIC_RELEASE, "agent");
            asm volatile("s_waitcnt vmcnt(0)" ::: "memory");
            const unsigned og = xb_add(&bar[XB_TOP], 1u);
            const unsigned tg = og / nx;
            if (og + 1u == (tg + 1u) * nx) xb_add(&bar[XB_TOPGEN], 1u);
            else XB_SPIN(xb_ld(&bar[XB_TOPGEN]) == tg, bar);
            __builtin_amdgcn_fence(__ATOMIC_ACQUIRE, "agent");
            xb_add(&bar[XB_XGEN(b.x)], 1u);
            asm volatile("s_waitcnt vmcnt(0)" ::: "memory");
        } else {
            XB_SPIN(xb_ld(&bar[XB_XGEN(b.x)]) == gen, bar);
            __builtin_amdgcn_fence(__ATOMIC_ACQUIRE, "agent");
            asm volatile("s_waitcnt vmcnt(0)" ::: "memory");
        }
    }
    __syncthreads();
}

struct MkArgs { Params p; int ph_lo, ph_hi, sub, pad; };
enum { PH_PRO = 0, PH_INPROJ = 1, PH_MSCAN = 2, PH_QPROJ = 3, PH_MOUT = 4, PH_ATTN = 5, PH_YM = 6, PH_YA = 7, PH_OUT = 8, PH_ROUTE = 9, PH_SCATTER = 10, PH_M1 = 11, PH_M2 = 12, PH_COMBINE = 13, PH_END = 14 };

__global__ void __launch_bounds__(MK_THREADS, 2) mk_fwd(MkArgs a) {
    extern __shared__ __attribute__((aligned(16))) unsigned char lds_raw[];
    LAS unsigned char* lds = (LAS unsigned char*)lds_raw;
    const Params& p = *(const Params*)__builtin_amdgcn_kernarg_segment_ptr();
    const int G = gridDim.x, bx = blockIdx.x;
    const int vcu = (G % 8 == 0) ? (bx % 8) * (G / 8) + bx / 8 : bx;
    cooperative_groups::grid_group grid = cooperative_groups::this_grid();
    const int lo = a.ph_lo, hi = a.ph_hi;
    volatile LAS unsigned* bst = (volatile LAS unsigned*)(lds + MK_LDS - 16);
    if (threadIdx.x < 4) bst[threadIdx.x] = 0u;
    __syncthreads();
    XcdBarrier xbar; xbar.bar = p.BAR(); xbar.x = 0; xbar.st = bst;
    if (hi - lo > 1) xbar = xcd_barrier_post(p.BAR(), bst);
#ifndef PHASE_MASK
#define PHASE_MASK 0xffffffffu
#endif
#define IN(k) (((PHASE_MASK >> (k)) & 1u) && lo <= (k) && (k) < hi)
#define SEAM(k) do { if (IN(k) && IN((k) + 1)) { if (a.sub == 0x7fffffff) grid.sync(); else xcd_barrier(xbar); } } while (0)
#ifndef PROBE_PHASE
#define PROBE_PHASE -1
#endif
#ifndef PROBE_REPS
#define PROBE_REPS 2
#endif
#define REPS(k) ((k) == PROBE_PHASE ? PROBE_REPS : 1)
    if (IN(PH_PRO)) for (int rep_ = 0; rep_ < REPS(PH_PRO); ++rep_) { if (rep_) xcd_barrier(xbar); phase_init_ctl(p, vcu, G); phase_prologue(p, lds, vcu, G, a.sub); } SEAM(PH_PRO);
    if (IN(PH_INPROJ)) for (int rep_ = 0; rep_ < REPS(PH_INPROJ); ++rep_) { if (rep_) xcd_barrier(xbar); { pg8::StaticOrderN<10> S; S.init(DM, G, bx, p.U(), p.WinT()); EpiInP<0> E{p}; pg8::gemm_phase<EpiInP<0>, pg8::StaticOrderN<10>>(lds, DM, DM, S, E); }
        { pg8::StaticOrderN<12> S; S.init(DM / 2, G, bx, p.U8(), p.WinT8()); EpiInP<1> E{p}; pg8::gemm_phase<EpiInP<1>, pg8::StaticOrderN<12>, true>(lds, DM / 2, DM / 2, S, E); } } SEAM(PH_INPROJ);
    if (IN(PH_MSCAN)) for (int rep_ = 0; rep_ < REPS(PH_MSCAN); ++rep_) { if (rep_) xcd_barrier(xbar);
        { const int half = (bx >> 3) & 1, idx = (bx & 7) * 16 + (bx >> 4);
            if (half == 0) { if (a.sub != 2) phase_mlstm_scan(p, (char*)lds_raw, idx, 128);
                if (a.sub == 0) { __syncthreads(); phase_prologue(p, lds, idx, 128, 16); } }
            else if (a.sub != 1) { phase_kprep(p, idx, 128);
                asm volatile("s_waitcnt vmcnt(0)" ::: "memory"); __syncthreads();
                if (threadIdx.x == 0) { unsigned* cw = p.BAR() + 3584; __builtin_amdgcn_fence(__ATOMIC_RELEASE, "agent"); asm volatile("s_waitcnt vmcnt(0)" ::: "memory");
                    xb_add(cw, 1u); unsigned sp = 0; while (xb_ld(cw) < 128u * (unsigned)(rep_ + 1)) { __builtin_amdgcn_s_sleep(2); if (++sp > (1u << 22)) break; }
                    __builtin_amdgcn_fence(__ATOMIC_ACQUIRE, "agent"); asm volatile("s_waitcnt vmcnt(0)" ::: "memory"); }
                __syncthreads();
                pg8::StaticOrderN<6> S; S.init(256, 128, idx, p.CQb(), p.WqT()); EpiQ E{p}; pg8::gemm_phase<EpiQ, pg8::StaticOrderN<6>>(lds, 256, 256, S, E); } }
        } SEAM(PH_MSCAN);
    if (IN(PH_MOUT)) for (int rep_ = 0; rep_ < REPS(PH_MOUT); ++rep_) { if (rep_) xcd_barrier(xbar); phase_mlstm_out(p, (char*)lds_raw, vcu, G); }
    if (IN(PH_ATTN)) for (int rep_ = 0; rep_ < REPS(PH_ATTN); ++rep_) { if (rep_) xcd_barrier(xbar); phase_attn(p, (char*)lds_raw, vcu, G); } SEAM(PH_ATTN);
    if (IN(PH_YM)) for (int rep_ = 0; rep_ < REPS(PH_YM); ++rep_) { if (rep_) xcd_barrier(xbar);
        pg8::MixOrder S; S.G = G; S.c = bx; S.A0 = (const char*)p.HM(); S.B0 = (const char*)p.WmT(); S.A1 = (const char*)p.OA(); S.B1 = (const char*)p.WoT(); S.btile = (size_t)256 * DM;
        EpiMix2 E{p}; pg8::gemm_phase<EpiMix2, pg8::MixOrder, true>(lds, DM / 2, DM / 2, S, E); }     SEAM(PH_YA);
    if (IN(PH_OUT)) for (int rep_ = 0; rep_ < REPS(PH_OUT); ++rep_) { if (rep_) xcd_barrier(xbar); pg8::StaticOrderN<4> S; S.init(DM / 2, G, bx, p.Vm(), p.WoutT()); EpiOut E{p}; pg8::gemm_phase<EpiOut, pg8::StaticOrderN<4>, true>(lds, DM / 2, DM / 2, S, E); } SEAM(PH_OUT);
    if (IN(PH_ROUTE)) for (int rep_ = 0; rep_ < REPS(PH_ROUTE); ++rep_) { if (rep_) xcd_barrier(xbar); phase_route(p, (char*)lds_raw, vcu, G); } SEAM(PH_ROUTE);
    if (IN(PH_SCATTER)) for (int rep_ = 0; rep_ < REPS(PH_SCATTER); ++rep_) { if (rep_) xcd_barrier(xbar); phase_scatter(p, (char*)lds_raw, vcu, G); } SEAM(PH_SCATTER);
    if (IN(PH_M1)) for (int rep_ = 0; rep_ < REPS(PH_M1); ++rep_) { if (rep_) xcd_barrier(xbar); volatile LAS int* tst = (volatile LAS int*)(lds + MISC_OFF); moe_tile_table(p, tst);
        pg8::MoeOrder<8> S; S.tstart = tst; S.G = G; S.c = bx; S.A = (const char*)p.XN2(); S.W = (const char*)p.W1T(); S.wexp = (size_t)2048 * DM; S.btile = (size_t)256 * DM;     S.rowidx = p.SLOT_TOK(); S.bias = p.b1; S.bsplit = 1;
        EpiM1 E{p}; pg8::gemm_phase<EpiM1, pg8::MoeOrder<8>, true>(lds, DM / 2, DM / 2, S, E); } SEAM(PH_M1);
    if (IN(PH_M2)) for (int rep_ = 0; rep_ < REPS(PH_M2); ++rep_) { if (rep_) xcd_barrier(xbar); volatile LAS int* tst = (volatile LAS int*)(lds + MISC_OFF); moe_tile_table(p, tst);
        pg8::MoeOrder<4> S; S.tstart = tst; S.G = G; S.c = bx; S.A = (const char*)p.ACT(); S.W = (const char*)p.W2T(); S.wexp = (size_t)DM * DFF; S.btile = (size_t)256 * DFF; S.rowidx = nullptr; S.bias = p.b2; S.bsplit = 0;
        EpiM2 E{p}; pg8::gemm_phase<EpiM2, pg8::MoeOrder<4>, true>(lds, DFF / 2, DFF / 2, S, E); } SEAM(PH_M2);
    if (IN(PH_COMBINE)) for (int rep_ = 0; rep_ < REPS(PH_COMBINE); ++rep_) { if (rep_) xcd_barrier(xbar); phase_combine(p, vcu, G, a.sub ? (float*)p.ACT() : p.out); }
#undef IN
#undef SEAM
}

#ifndef ONE_LAUNCH
#define ONE_LAUNCH 1
#endif
#ifndef PROBE_DUP
#define PROBE_DUP -1
#endif
#ifndef PROBE_SUB
#define PROBE_SUB 0
#endif
#ifndef PROBE_DUP_N
#define PROBE_DUP_N 1
#endif
#ifndef FAST_INPROJ
#define FAST_INPROJ 1
#endif
#ifndef FAST_QPROJ
#define FAST_QPROJ 1
#endif
#ifndef FAST_MIX
#define FAST_MIX 1
#endif
#ifndef FAST_MOE
#define FAST_MOE 1
#endif
#ifndef FAST_ATTN
#define FAST_ATTN 1
#endif
#ifndef FAST_MLSTM
#define FAST_MLSTM 1
#endif
static void launch_mk(const Params& p, int lo, int hi, int grid, hipStream_t stream, int sub = 0) {
    MkArgs a{}; a.p = p; a.ph_lo = lo; a.ph_hi = hi; a.sub = sub;
    hipLaunchKernelGGL(mk_fwd, dim3(grid), dim3(MK_THREADS), MK_LDS, stream, a);
}
extern "C" void kernel_launch(void* const* d_in, const int* in_sizes, int n_in, void* d_out, int out_size, void* d_ws, size_t ws_size, hipStream_t stream) {
    static int ok = 0, grid = 0;
    if (!ok) {
        if (n_in != 22 || in_sizes[0] != NT * DM || out_size != NT * DM) { fprintf(stderr, "kernel_launch: unexpected shapes (n_in %d, x %d, out %d)\n", n_in, n_in > 0 ? in_sizes[0] : -1, out_size); return; }
        (void)hipFuncSetAttribute((const void*)k_mlstm_out, hipFuncAttributeMaxDynamicSharedMemorySize, MO_LDS);
        (void)hipFuncSetAttribute((const void*)mk_fwd, hipFuncAttributeMaxDynamicSharedMemorySize, MK_LDS);
        int dev = 0, cus = 0, per_cu = 0; (void)hipGetDevice(&dev); (void)hipDeviceGetAttribute(&cus, hipDeviceAttributeMultiprocessorCount, dev);
        (void)hipOccupancyMaxActiveBlocksPerMultiprocessor(&per_cu, (const void*)mk_fwd, MK_THREADS, MK_LDS);
        if (per_cu < 1) { fprintf(stderr, "kernel_launch: occupancy query says %d blocks/CU\n", per_cu); per_cu = 1; }
        if (cus != 256) { fprintf(stderr, "kernel_launch: built for a 256-CU device (got %d CUs)\n", cus); return; }
        grid = 256;
        ok = 1;
    }
    Params p{};
    const float** ins = (const float**)&p.x;
    for (int i = 0; i < 22; ++i) ins[i] = (const float*)d_in[i];
    p.out = (float*)d_out;
    p.ws = (char*)d_ws;
    if (WS_TOTAL > ws_size) { fprintf(stderr, "kernel_launch: workspace too small (%zu > %zu)\n", (size_t)WS_TOTAL, ws_size); return; }
    (void)hipMemsetAsync(p.BAR(), 0, 16384, stream);
#if ONE_LAUNCH
    { MkArgs a{}; a.p = p; a.ph_lo = 0; a.ph_hi = PH_END; void* args[] = {&a};
      hipError_t e = hipLaunchCooperativeKernel((const void*)mk_fwd, dim3(grid), dim3(MK_THREADS), args, MK_LDS, stream);
      if (e != hipSuccess) fprintf(stderr, "kernel_launch: cooperative launch failed: %s (grid %d)\n", hipGetErrorString(e), grid); }
#else
    for (int ph = 0; ph < PH_END; ++ph) { if (ph == PH_COMBINE && PROBE_DUP == PH_COMBINE) { launch_mk(p, ph, ph + 1, grid, stream, 1); launch_mk(p, ph, ph + 1, grid, stream, 0); continue; }
        launch_mk(p, ph, ph + 1, grid, stream);
        for (int d = 0; d < ((ph == PROBE_DUP) ? PROBE_DUP_N : 0); ++d) { if (ph == PH_ROUTE) (void)hipMemsetAsync(p.CNT(), 0, 4096, stream); launch_mk(p, ph, ph + 1, grid, stream, PROBE_SUB); } }
#endif
}
```
